# Optimizing an MI355X kernel written in HIP

```python
import jax, jax.numpy as jnp
from jax import lax
import numpy as np

D_MODEL = 1024
BATCH = 8
SEQ = 4096
DEPTH = 4

CHUNK = 64
N_META = 16
EPS = 1e-6
GLA_HEADS = 4
GLA_DV = D_MODEL // 2 // GLA_HEADS
GLA_DK = GLA_DV // 2
GLA_LOWRANK = 16
GLA_TAU = 16.0
FOX_DH = 64
FOX_HEADS = D_MODEL // 2 // FOX_DH
Q_BLOCK = 128
FORGET_BIAS_INIT = 4.0
D_FF = 128 * (-(-8 * D_MODEL // (3 * 128)))
CONV_W = 3
GLA_WIDTH = GLA_HEADS * GLA_DV
FOX_WIDTH = FOX_HEADS * FOX_DH
MIX_WIDTH = GLA_WIDTH + FOX_WIDTH
IN_SIZES = (GLA_HEADS * GLA_DK, GLA_HEADS * GLA_DK, GLA_WIDTH, GLA_WIDTH, GLA_LOWRANK,
            FOX_WIDTH, FOX_WIDTH, FOX_WIDTH, FOX_HEADS)
N_IN = sum(IN_SIZES)

kernel_name = "hymba_style_gla_fox_convffn_streaming"


def rms_norm(x, g):
    xf = x.astype(jnp.float32)
    y = xf * lax.rsqrt(jnp.mean(xf * xf, axis=-1, keepdims=True) + EPS)
    return (y * g.astype(jnp.float32)).astype(x.dtype)


def chunk_kv_summary(k, v, log_a):
    log_b = jnp.cumsum(log_a, axis=3)
    log_end = log_b[:, :, :, -1:, :]
    u = jnp.einsum('bhntk,bhntv->bhnkv', k * jnp.exp(log_end - log_b), v)
    return u, jnp.exp(log_end[:, :, :, 0, :])


def gla_chunk_causal(q, k, v, log_a):
    B, L, H, _ = q.shape
    dv = v.shape[-1]
    n_chunks = (L - N_META) // CHUNK

    def split(t):
        t = jnp.transpose(t.astype(jnp.float32), (0, 2, 1, 3))
        d = t.shape[-1]
        return (t[:, :, :N_META].reshape(B, H, 1, N_META, d),
                t[:, :, N_META:].reshape(B, H, n_chunks, CHUNK, d))

    q_m, q_r = split(q)
    k_m, k_r = split(k)
    v_m, v_r = split(v)
    a_m, a_r = split(log_a)
    u_m, _ = chunk_kv_summary(k_m, v_m, a_m)
    s_meta = u_m[:, :, 0]
    u_r, decay_r = chunk_kv_summary(k_r, v_r, a_r)

    def step(s, inp):
        u_c, d_c = inp
        s = d_c[..., None] * s + u_c
        return s, s

    _, states = lax.scan(step, s_meta, (jnp.moveaxis(u_r, 2, 0), jnp.moveaxis(decay_r, 2, 0)))
    states = jnp.moveaxis(states, 0, 2)
    o_m = jnp.einsum('bhtk,bhkv->bhtv', q_m[:, :, 0], s_meta)
    o_r = jnp.einsum('bhntk,bhnkv->bhntv', q_r, states).reshape(B, H, n_chunks * CHUNK, dv)
    o = jnp.concatenate([o_m, o_r], axis=2)
    return jnp.transpose(o, (0, 2, 1, 3))


def forgetting_attention(q, k, v, log_f):
    B, L, H, dh = q.shape
    n_blk = -(-L // Q_BLOCK)
    pad = n_blk * Q_BLOCK - L
    c = jnp.cumsum(log_f.astype(jnp.float32), axis=1)
    c_k = jnp.transpose(c, (0, 2, 1))
    c_q = jnp.pad(c, ((0, 0), (0, pad), (0, 0)), mode='edge')
    q_pad = jnp.pad(q.astype(jnp.float32) * dh ** -0.5, ((0, 0), (0, pad), (0, 0), (0, 0)))
    q_blocks = jnp.moveaxis(q_pad.reshape(B, n_blk, Q_BLOCK, H, dh), 1, 0)
    c_blocks = jnp.moveaxis(jnp.transpose(c_q.reshape(B, n_blk, Q_BLOCK, H), (0, 1, 3, 2)), 1, 0)
    kf = k.astype(jnp.float32)
    vf = v.astype(jnp.float32)
    key_pos = jnp.arange(L)

    def block(inp):
        q_b, c_b, start = inp
        logits = (jnp.einsum('bqhd,bkhd->bhqk', q_b, kf)
                  + c_b[..., None] - c_k[:, :, None, :])
        q_pos = start + jnp.arange(Q_BLOCK)
        logits = jnp.where(key_pos[None, :] <= q_pos[:, None], logits, -jnp.inf)
        return jnp.einsum('bhqk,bkhd->bqhd', jax.nn.softmax(logits, axis=-1), vf)

    out = lax.map(block, (q_blocks, c_blocks, jnp.arange(n_blk) * Q_BLOCK))
    out = jnp.moveaxis(out, 0, 1).reshape(B, n_blk * Q_BLOCK, H, dh)
    return out[:, :L]


def conv_ffn(x, w_up, conv_w, conv_b, w_down):
    h = x @ w_up
    L = h.shape[1]
    hp = jnp.pad(h, ((0, 0), (CONV_W - 1, 0), (0, 0)))
    hc = conv_b
    for j in range(CONV_W):
        hc = hc + hp[:, j:j + L] * conv_w[j]
    u, g = jnp.split(hc, 2, axis=-1)
    return (jax.nn.silu(g) * u) @ w_down


def setup_inputs(seed: int = 0) -> dict:
    key = jax.random.key(seed)
    ks = jax.random.split(key, 16)

    def nrm(k, shape, scale):
        return jax.random.normal(k, shape, jnp.float32) * scale

    return {
        'x': nrm(ks[0], (BATCH, SEQ, D_MODEL), 1.0),
        'meta_tokens': nrm(ks[1], (N_META, D_MODEL), 1.0),
        'attn_norm': 1.0 + nrm(ks[2], (DEPTH, D_MODEL), 0.02),
        'w_in': nrm(ks[3], (DEPTH, D_MODEL, N_IN), D_MODEL ** -0.5),
        'w_alpha_up': nrm(ks[4], (DEPTH, GLA_LOWRANK, GLA_HEADS * GLA_DK), GLA_LOWRANK ** -0.5),
        'b_alpha': nrm(ks[5], (DEPTH, GLA_HEADS * GLA_DK), 0.1),
        'b_forget': FORGET_BIAS_INIT + nrm(ks[6], (DEPTH, FOX_HEADS), 0.5),
        'gla_norm': 1.0 + nrm(ks[7], (DEPTH, GLA_WIDTH), 0.02),
        'fox_norm': 1.0 + nrm(ks[8], (DEPTH, FOX_WIDTH), 0.02),
        'w_out': nrm(ks[9], (DEPTH, MIX_WIDTH, D_MODEL), MIX_WIDTH ** -0.5),
        'ffn_norm': 1.0 + nrm(ks[10], (DEPTH, D_MODEL), 0.02),
        'w_up': nrm(ks[11], (DEPTH, D_MODEL, 2 * D_FF), D_MODEL ** -0.5),
        'conv_w': nrm(ks[12], (DEPTH, CONV_W, 2 * D_FF), CONV_W ** -0.5),
        'conv_b': nrm(ks[13], (DEPTH, 2 * D_FF), 0.02),
        'w_down': nrm(ks[14], (DEPTH, D_FF, D_MODEL), D_FF ** -0.5),
        'final_norm': 1.0 + nrm(ks[15], (D_MODEL,), 0.02),
    }


def reference(x, meta_tokens, attn_norm, w_in, w_alpha_up, b_alpha, b_forget, gla_norm,
              fox_norm, w_out, ffn_norm, w_up, conv_w, conv_b, w_down, final_norm):
    B = x.shape[0]
    meta = jnp.broadcast_to(meta_tokens[None].astype(x.dtype), (B, N_META, D_MODEL))
    h = jnp.concatenate([meta, x], axis=1)
    L = h.shape[1]
    cuts = np.cumsum(IN_SIZES)[:-1].tolist()
    for i in range(DEPTH):
        xn = rms_norm(h, attn_norm[i])
        gq, gk, gv, gr, glr, fq, fk, fv, ff = jnp.split(xn @ w_in[i], cuts, axis=-1)
        log_a = jax.nn.log_sigmoid((glr @ w_alpha_up[i] + b_alpha[i]).astype(jnp.float32)) / GLA_TAU
        o_gla = gla_chunk_causal(gq.reshape(B, L, GLA_HEADS, GLA_DK) * GLA_DK ** -0.5,
                                 gk.reshape(B, L, GLA_HEADS, GLA_DK),
                                 gv.reshape(B, L, GLA_HEADS, GLA_DV),
                                 log_a.reshape(B, L, GLA_HEADS, GLA_DK)).astype(h.dtype)
        o_gla = rms_norm(o_gla, gla_norm[i].reshape(GLA_HEADS, GLA_DV)).reshape(B, L, GLA_WIDTH)
        o_gla = o_gla * jax.nn.silu(gr)
        log_f = jax.nn.log_sigmoid((ff + b_forget[i]).astype(jnp.float32))
        o_fox = forgetting_attention(fq.reshape(B, L, FOX_HEADS, FOX_DH),
                                     fk.reshape(B, L, FOX_HEADS, FOX_DH),
                                     fv.reshape(B, L, FOX_HEADS, FOX_DH), log_f).astype(h.dtype)
        o_fox = rms_norm(o_fox, fox_norm[i].reshape(FOX_HEADS, FOX_DH)).reshape(B, L, FOX_WIDTH)
        h = h + jnp.concatenate([o_gla, o_fox], axis=-1) @ w_out[i]
        h = h + conv_ffn(rms_norm(h, ffn_norm[i]), w_up[i], conv_w[i], conv_b[i], w_down[i])
    return rms_norm(h, final_norm)[:, N_META:]
```

```cpp
#include <hip/hip_runtime.h>
#include <hip/hip_cooperative_groups.h>
#include <cstdio>
#include <cstdint>
namespace cg = cooperative_groups;
namespace pg8 {
#define PG8_LAS __attribute__((address_space(3)))
typedef unsigned short bf16_t;
typedef short bf16x8 __attribute__((ext_vector_type(8)));
typedef float f32x4 __attribute__((ext_vector_type(4)));
typedef unsigned u32x4 __attribute__((ext_vector_type(4)));
constexpr int BM = 256, BK = 64, HALF = 128, HTB = HALF * BK * 2  , STAGE_BYTES = 8 * HTB, NXCD = 8, WGM = 8;

__host__ __device__ __forceinline__ int lds_byte(int r, int c) { const int st = (r >> 4) * 2 + (c >> 5), rr = r & 15, cc = c & 31, ob = rr * 64 + cc * 2; return st * 1024 + (ob ^ (((ob >> 9) & 1) << 5)); }
__host__ __device__ __forceinline__ void stage_rc(int b, int& R, int& C) { const int st = b / 1024, sb = b % 1024, swz = sb ^ (((sb >> 9) & 1) << 5); R = (st >> 1) * 16 + swz / 64; C = (st & 1) * 32 + (swz % 64) / 2; }
__host__ __device__ __forceinline__ int perm32(int rho) { const int n = rho >> 4, i = rho & 15; return 8 * (i >> 2) + 4 * n + (i & 3); }

struct Unit { int pm, pn; };
struct Gemm { const bf16_t* A; const bf16_t* Bt; int M, N, K; };

struct StaticOrder {
    int nM, nN, nwg, G, c;
    __host__ __device__ void init(int M, int N, int G_, int c_) { nM = M / BM; nN = N / BM; nwg = nM * nN; G = G_; c = c_; }
    __host__ __device__ bool next(int i, Unit& u) const {
        const long L = (long)i * G + c; if (L >= nwg) return false;
        int wgid = (int)L; { const int q = nwg / NXCD, r = nwg % NXCD, xcd = wgid % NXCD, off = wgid / NXCD; wgid = (xcd < r ? xcd * (q + 1) : r * (q + 1) + (xcd - r) * q) + off; }
        const int nig = WGM * nN, gid = wgid / nig, fm = gid * WGM, gsz = (nM - fm) < WGM ? (nM - fm) : WGM;
        u.pm = fm + ((wgid % nig) % gsz); u.pn = (wgid % nig) / gsz; return true;
    }
    __device__ __forceinline__ void a_ready(const Unit&) const {}
    __device__ __forceinline__ void done(const Unit&) const {}
};

__device__ __forceinline__ unsigned cvt_pk_bf16(float lo, float hi) { unsigned r; asm volatile("v_cvt_pk_bf16_f32 %0, %1, %2" : "=v"(r) : "v"(lo), "v"(hi)); return r; }
typedef float f32x2 __attribute__((ext_vector_type(2)));
template <class Epi, class Sched, bool ALIGN_EPI = false, bool SP2 = false>
__device__ __forceinline__ void gemm_phase(PG8_LAS unsigned char* lds, const Gemm g, const Sched& S, const Epi& E) {
    int tid_ = threadIdx.x; asm volatile("" : "+v"(tid_)); const int tid = tid_, wid = __builtin_amdgcn_readfirstlane(tid >> 6), lane = tid & 63, wr = wid >> 2, wc = wid & 3, fr = lane & 15, fq = lane >> 4;
    const int K = g.K, nt = K / BK;
    unsigned voffA[2], voffB[2];
#pragma unroll
    for (int i = 0; i < 2; ++i) { int R, C; stage_rc(tid * 16 + i * 8192, R, C); const int Rb = Epi::PERM ? ((R & ~31) + perm32(R & 31)) : R;
        voffA[i] = (unsigned)(R * K + C) * 2u; voffB[i] = (unsigned)(Rb * K + C) * 2u; }
    const size_t kstep = (size_t)(BK * 2);
    const size_t hstep = (size_t)HALF * K * 2;
    const size_t tstep = 2 * hstep;
    const unsigned ldsw = (unsigned)wid * 1024u;
    const int aoff = lds_byte(wr * 64 + fr, fq * 8), boff = lds_byte(wc * 32 + fr, fq * 8);
#define PG8_SA(b, h) (((b) * 2 + (h)) * HTB)
#define PG8_SB(b, h) ((4 + (b) * 2 + (h)) * HTB)
#define PG8_STAGE(bufoff, gbase, voff) do { _Pragma("unroll") for (int _i = 0; _i < 2; ++_i) \
        __builtin_amdgcn_global_load_lds((const unsigned*)((const char*)(gbase) + (voff)[_i]), (PG8_LAS unsigned*)(lds + (bufoff) + ldsw + _i * 8192), 16, 0, 0); } while (0)
#define PG8_LDA(dst, b, h) do { _Pragma("unroll") for (int m = 0; m < 4; ++m) _Pragma("unroll") for (int k = 0; k < 2; ++k) dst[m][k] = *(const PG8_LAS bf16x8*)(lds + PG8_SA(b, h) + aoff + m * 2048 + k * 1024); } while (0)
#define PG8_LDB(dst, b, h) do { _Pragma("unroll") for (int n = 0; n < 2; ++n) _Pragma("unroll") for (int k = 0; k < 2; ++k) dst[n][k] = *(const PG8_LAS bf16x8*)(lds + PG8_SB(b, h) + boff + n * 2048 + k * 1024); } while (0)
#define PG8_MMA(ai, bj, At, Bt) do { __builtin_amdgcn_s_setprio(1); _Pragma("unroll") for (int m = 0; m < 4; ++m) _Pragma("unroll") for (int n = 0; n < 2; ++n) _Pragma("unroll") for (int k = 0; k < 2; ++k) \
        acc[ai][bj][m][n] = __builtin_amdgcn_mfma_f32_16x16x32_bf16(Bt[n][k], At[m][k], acc[ai][bj][m][n], 0, 0, 0); __builtin_amdgcn_s_setprio(0); } while (0)
#define PG8_WAIT_V(n) asm volatile("s_waitcnt vmcnt(" #n ")" ::: "memory")
#define PG8_WAIT_L(n) asm volatile("s_waitcnt lgkmcnt(" #n ")" ::: "memory")
#define PG8_BAR __builtin_amdgcn_s_barrier()
#define PG8_SCHED __builtin_amdgcn_sched_barrier(0)
    Unit cur, nxt; int ui = 0;
    if (!S.next(0, cur)) return;
    f32x4 acc[2][2][4][2];
#pragma unroll
    for (int a = 0; a < 2; ++a)
#pragma unroll
        for (int b = 0; b < 2; ++b)
#pragma unroll
            for (int m = 0; m < 4; ++m)
#pragma unroll
                for (int n = 0; n < 2; ++n) acc[a][b][m][n] = (f32x4){0.f, 0.f, 0.f, 0.f};
    bf16x8 At[4][2], B0[2][2], B1[2][2];
    const char* cA = (const char*)g.A + (size_t)cur.pm * tstep; const char* cB = (const char*)g.Bt + (size_t)cur.pn * tstep;
    S.a_ready(cur);
    if constexpr (SP2) {
        PG8_STAGE(PG8_SB(0, 0), cB, voffB); PG8_STAGE(PG8_SB(0, 1), cB + hstep, voffB); PG8_STAGE(PG8_SA(0, 0), cA, voffA); PG8_STAGE(PG8_SA(0, 1), cA + hstep, voffA);
        if (wr == 1) PG8_BAR;
        PG8_WAIT_V(2); PG8_BAR;
        PG8_STAGE(PG8_SB(1, 0), cB + kstep, voffB); PG8_STAGE(PG8_SA(1, 0), cA + kstep, voffA); PG8_STAGE(PG8_SB(1, 1), cB + hstep + kstep, voffB);
        PG8_WAIT_V(6); PG8_BAR;
    } else {
        PG8_STAGE(PG8_SB(0, 0), cB, voffB); PG8_STAGE(PG8_SA(0, 0), cA, voffA); PG8_STAGE(PG8_SB(0, 1), cB + hstep, voffB); PG8_STAGE(PG8_SA(0, 1), cA + hstep, voffA);
        if (wr == 1) PG8_BAR;
        PG8_WAIT_V(4); PG8_BAR;
        PG8_STAGE(PG8_SB(1, 0), cB + kstep, voffB); PG8_STAGE(PG8_SA(1, 0), cA + kstep, voffA); PG8_STAGE(PG8_SB(1, 1), cB + hstep + kstep, voffB);
        PG8_WAIT_V(6); PG8_BAR;
    }
    for (;;) {
        const bool has_next = S.next(ui + 1, nxt);
        const char* nA = has_next ? (const char*)g.A + (size_t)nxt.pm * tstep : cA; const char* nB = has_next ? (const char*)g.Bt + (size_t)nxt.pn * tstep : cB;
        for (int t = 0; t < nt; t += 2) {
            const bool last = (t == nt - 2);
            const char* a1 = cA + (size_t)(t + 1) * kstep;
            const char* a2 = last ? nA : cA + (size_t)(t + 2) * kstep; const char* b2 = last ? nB : cB + (size_t)(t + 2) * kstep;
            const char* a3 = a2 + kstep; const char* b3 = b2 + kstep;
            if (last && has_next) S.a_ready(nxt);
            if constexpr (SP2) {
            PG8_LDB(B0, 0, 0); PG8_LDB(B1, 0, 1); PG8_SCHED; PG8_LDA(At, 0, 0); PG8_STAGE(PG8_SA(1, 1), a1 + hstep, voffA);
            PG8_WAIT_V(8); PG8_WAIT_L(0); PG8_BAR; PG8_MMA(0, 0, At, B0); PG8_MMA(0, 1, At, B1); PG8_BAR; PG8_SCHED;
            PG8_LDA(At, 0, 1); PG8_STAGE(PG8_SB(0, 0), b2, voffB); PG8_STAGE(PG8_SB(0, 1), b2 + hstep, voffB); PG8_STAGE(PG8_SA(0, 0), a2, voffA);
            PG8_WAIT_V(8); PG8_WAIT_L(0); PG8_BAR; PG8_MMA(1, 0, At, B0); PG8_MMA(1, 1, At, B1); PG8_BAR; PG8_SCHED;
            PG8_LDB(B0, 1, 0); PG8_LDB(B1, 1, 1); PG8_SCHED; PG8_LDA(At, 1, 0); PG8_STAGE(PG8_SA(0, 1), a2 + hstep, voffA);
            PG8_WAIT_V(8); PG8_WAIT_L(0); PG8_BAR; PG8_MMA(0, 0, At, B0); PG8_MMA(0, 1, At, B1); PG8_BAR; PG8_SCHED;
            PG8_LDA(At, 1, 1); PG8_STAGE(PG8_SB(1, 0), b3, voffB); PG8_STAGE(PG8_SB(1, 1), b3 + hstep, voffB); PG8_STAGE(PG8_SA(1, 0), a3, voffA);
            PG8_WAIT_V(8); PG8_WAIT_L(0); PG8_BAR; PG8_MMA(1, 0, At, B0); PG8_MMA(1, 1, At, B1); PG8_BAR; PG8_SCHED;
            } else {
            PG8_LDB(B0, 0, 0); PG8_SCHED; PG8_LDA(At, 0, 0); PG8_STAGE(PG8_SA(1, 1), a1 + hstep, voffA);
            PG8_WAIT_L(8); PG8_BAR; PG8_WAIT_L(0); PG8_MMA(0, 0, At, B0); PG8_BAR; PG8_SCHED;
            PG8_LDB(B1, 0, 1); PG8_STAGE(PG8_SB(0, 0), b2, voffB);
            PG8_BAR; PG8_WAIT_L(0); PG8_MMA(0, 1, At, B1); PG8_BAR;
            PG8_LDA(At, 0, 1); PG8_STAGE(PG8_SA(0, 0), a2, voffA);
            PG8_BAR; PG8_WAIT_L(0); PG8_MMA(1, 0, At, B0); PG8_BAR; PG8_SCHED;
            PG8_STAGE(PG8_SB(0, 1), b2 + hstep, voffB);
            PG8_WAIT_V(6); PG8_BAR; PG8_MMA(1, 1, At, B1); PG8_BAR;
            PG8_LDB(B0, 1, 0); PG8_SCHED; PG8_LDA(At, 1, 0); PG8_STAGE(PG8_SA(0, 1), a2 + hstep, voffA);
            PG8_WAIT_L(8); PG8_BAR; PG8_WAIT_L(0); PG8_MMA(0, 0, At, B0); PG8_BAR; PG8_SCHED;
            PG8_LDB(B1, 1, 1); PG8_STAGE(PG8_SB(1, 0), b3, voffB);
            PG8_BAR; PG8_WAIT_L(0); PG8_MMA(0, 1, At, B1); PG8_BAR;
            PG8_LDA(At, 1, 1); PG8_STAGE(PG8_SA(1, 0), a3, voffA);
            PG8_BAR; PG8_WAIT_L(0); PG8_MMA(1, 0, At, B0); PG8_BAR; PG8_SCHED;
            PG8_STAGE(PG8_SB(1, 1), b3 + hstep, voffB);
            PG8_WAIT_V(6); PG8_BAR; PG8_MMA(1, 1, At, B1); PG8_BAR;
            }
        }
        if constexpr (ALIGN_EPI) { if (wr == 0) PG8_BAR; }
        if constexpr (!Epi::AFTER_DRAIN) { E(acc, cur, wr, wc, fr, fq); S.done(cur); }
        if (!has_next) break;
#pragma unroll
        for (int a = 0; a < 2; ++a)
#pragma unroll
            for (int b = 0; b < 2; ++b)
#pragma unroll
                for (int m = 0; m < 4; ++m)
#pragma unroll
                    for (int n = 0; n < 2; ++n) acc[a][b][m][n] = (f32x4){0.f, 0.f, 0.f, 0.f};
        cur = nxt; cA = nA; cB = nB; ++ui;
        if constexpr (ALIGN_EPI) { if (wr == 1) PG8_BAR; }
    }
    PG8_WAIT_V(0);
    if constexpr (!ALIGN_EPI) { if (wr == 0) PG8_BAR; }
    PG8_BAR;
    if constexpr (Epi::AFTER_DRAIN) { E.fused(acc, cur, wr, wc, fr, fq, lds, wid, lane); S.done(cur); }
#undef PG8_SA
#undef PG8_SB
#undef PG8_STAGE
#undef PG8_LDA
#undef PG8_LDB
#undef PG8_MMA
#undef PG8_WAIT_V
#undef PG8_WAIT_L
#undef PG8_BAR
#undef PG8_SCHED
}
}
#define LAS __attribute__((address_space(3)))
typedef unsigned short bf16;
typedef short bf16x8 __attribute__((ext_vector_type(8)));
typedef short s16x4 __attribute__((ext_vector_type(4)));
typedef float f32x4 __attribute__((ext_vector_type(4)));
typedef float f32x16 __attribute__((ext_vector_type(16)));
typedef unsigned u32x4 __attribute__((ext_vector_type(4)));
typedef unsigned u32x2 __attribute__((ext_vector_type(2)));

constexpr int NB = 8, SEQ = 4096, DM = 1024, DEPTH = 4, NMETA = 16;
constexpr int MREAL = NB * SEQ;
constexpr int META0 = MREAL;
constexpr int MROWS = 129 * 256;
constexpr int NINP = 3328, QP = 3072;
constexpr int C_FQ = 0, C_FK = 512, C_FV = 1024, C_GQ = 1536, C_GK = 1792, C_GV = 2048, C_GR = 2560;
constexpr int DFF = 2816, NUP = 5632;
constexpr float EPS = 1e-6f, LOG2E = 1.4426950408889634f, C2 = 0.125f * LOG2E;
constexpr int CKP = 4160;
constexpr int NCH = 65;

constexpr size_t MiB = 1u << 20;
constexpr size_t WL_IN = 0, WL_OUT = 6815744, WL_UP = 8912896, WL_DN = 20447232, WL_SIZE = 26214400;
constexpr size_t WS_W = 0, WS_HB = 100 * MiB, WS_OB = WS_HB + 67633152, WS_QKV = WS_OB + 67633152, WS_UT = WS_QKV + 202899456;
constexpr size_t WS_SM = WS_UT + 68157440, WS_CK = WS_SM + 4456448, WS_DEC = WS_CK + 1310720, WS_HM = WS_DEC + 786432, WS_SSQ = WS_HM + MiB, WS_END = WS_SSQ + 1835008;
static_assert(WS_END <= 512 * MiB, "workspace map");
constexpr size_t HFL_SIZE = (size_t)129 * 2 * NUP * 4;
static_assert(2 * HFL_SIZE <= 68157440, "halo overlay");

constexpr int LDS_BYTES = 147456, HALO_OFF = 131072;

struct Args {
    const float *x, *meta, *attn_norm, *w_in, *w_au, *b_alpha, *b_forget, *gla_norm, *fox_norm, *w_out, *ffn_norm, *w_up, *conv_w, *conv_b, *w_down, *final_norm;
    float* out; unsigned char* ws;
};

__device__ __forceinline__ const Args* kargs() { const Args* p = (const Args*)__builtin_amdgcn_kernarg_segment_ptr(); asm volatile("" : "+s"(p)); return p; }
__device__ __forceinline__ float bf2f(bf16 v) { return __uint_as_float((unsigned)v << 16); }
__device__ __forceinline__ unsigned pk2(float lo, float hi) { return pg8::cvt_pk_bf16(lo, hi); }
__device__ __forceinline__ bf16 f2bf(float v) { return (bf16)(pk2(v, 0.f) & 0xffffu); }
__device__ __forceinline__ float wave_sum(float v) {
#pragma unroll
    for (int o = 1; o < 64; o <<= 1) v += __shfl_xor(v, o);
    return v;
}
__device__ __forceinline__ float logsigmoidf(float z) { return -(fmaxf(-z, 0.f) + log1pf(__expf(-fabsf(z)))); }
__device__ __forceinline__ float siluf(float v) { return v / (1.f + __expf(-v)); }
__device__ __forceinline__ int crow(int r, int hi) { return (r & 3) + 8 * (r >> 2) + 4 * hi; }
__device__ __forceinline__ s16x4 vtr(const LAS unsigned char* p) { return __builtin_bit_cast(s16x4, __builtin_amdgcn_ds_read_tr16_b64_v4i16((LAS s16x4*)p)); }
__device__ __forceinline__ bf16x8 cat8(s16x4 a, s16x4 b) { return (bf16x8){a[0], a[1], a[2], a[3], b[0], b[1], b[2], b[3]}; }
__device__ __forceinline__ float dppf(float old, float src, int ctrl_unused);
#define DPP_MOV(old, src, ctrl) __builtin_bit_cast(float, __builtin_amdgcn_update_dpp(__builtin_bit_cast(int, (float)(old)), __builtin_bit_cast(int, (float)(src)), (ctrl), 0xf, 0xf, false))
#define LDS_WAIT() asm volatile("s_waitcnt lgkmcnt(0)" ::: "memory")

__device__ __forceinline__ const float* ssq_arr(unsigned char* wsb, int si) { return (const float*)(wsb + WS_SSQ) + (size_t)(si % 3) * MROWS * 4; }
__device__ __forceinline__ float row_rstd(const float* ssqp, int row) { const f32x4 s = *(const f32x4*)(ssqp + (size_t)row * 4); return rsqrtf(((s[0] + s[1]) + (s[2] + s[3])) * (1.0f / DM) + EPS); }
__device__ __forceinline__ LAS float* tile_rstd(const float* ssqp, int pm, int wr, int wc, int fr, int fq) {
    extern __shared__ __attribute__((aligned(16))) unsigned char lds_dyn_[];
    LAS float* rsl = (LAS float*)((LAS unsigned char*)lds_dyn_ + HALO_OFF + 8192);
    const int tl = (wr * 4 + wc) * 64 + fq * 16 + fr;
    if (tl < 256) rsl[tl] = row_rstd(ssqp, pm * 256 + tl);
    asm volatile("s_waitcnt lgkmcnt(0)" ::: "memory"); __builtin_amdgcn_s_barrier(); asm volatile("" ::: "memory");
    return rsl;
}
struct EpiIn {
    static constexpr bool PERM = true, AFTER_DRAIN = false;
    int si;
    __device__ __forceinline__ void operator()(const pg8::f32x4 (&acc)[2][2][4][2], const pg8::Unit& u, int wr, int wc, int fr, int fq) const {
        asm volatile("" : "+v"(fr), "+v"(fq));
        unsigned char* wsb = kargs()->ws;
        bf16* Q = (bf16*)(wsb + WS_QKV); float* SM = (float*)(wsb + WS_SM); const LAS float* rsl = tile_rstd(ssq_arr(wsb, si), u.pm, wr, wc, fr, fq);
#pragma unroll
        for (int ai = 0; ai < 2; ++ai)
#pragma unroll
            for (int m = 0; m < 4; ++m) {
                const int row = u.pm * 256 + ai * 128 + wr * 64 + m * 16 + fr;
                const float rs = rsl[ai * 128 + wr * 64 + m * 16 + fr];
                if (u.pn < 12) {
#pragma unroll
                    for (int bj = 0; bj < 2; ++bj) {
                        const pg8::f32x4 v0 = acc[ai][bj][m][0] * rs, v1 = acc[ai][bj][m][1] * rs;
                        u32x4 w; w.x = pk2(v0[0], v0[1]); w.y = pk2(v0[2], v0[3]); w.z = pk2(v1[0], v1[1]); w.w = pk2(v1[2], v1[3]);
                        *(u32x4*)(Q + (size_t)row * QP + u.pn * 256 + bj * 128 + wc * 32 + 8 * fq) = w;
                    }
                } else if (wc == 0) {
                    *(f32x4*)(SM + (size_t)row * 32 + 8 * fq) = acc[ai][0][m][0] * rs;
                    *(f32x4*)(SM + (size_t)row * 32 + 8 * fq + 4) = acc[ai][0][m][1] * rs;
                }
            }
    }
};
struct EpiRes {
    static constexpr bool PERM = false, AFTER_DRAIN = false;
    int from_x, si;
    __device__ __forceinline__ void operator()(const pg8::f32x4 (&acc)[2][2][4][2], const pg8::Unit& u, int wr, int wc, int fr, int fq) const {
        asm volatile("" : "+v"(fr), "+v"(fq));
        const Args* ka = kargs(); unsigned char* wsb = ka->ws;
        float* out = ka->out; const float* base = from_x ? ka->x : out; float* hmeta = (float*)(wsb + WS_HM); bf16* HB = (bf16*)(wsb + WS_HB); float* ssq_next = (float*)ssq_arr(wsb, si);
        extern __shared__ __attribute__((aligned(16))) unsigned char lds_dyn_[];
        LAS float* red = (LAS float*)((LAS unsigned char*)lds_dyn_ + HALO_OFF);
#pragma unroll
        for (int ai = 0; ai < 2; ++ai)
#pragma unroll
            for (int m = 0; m < 4; ++m) {
                const int row = u.pm * 256 + ai * 128 + wr * 64 + m * 16 + fr;
                const float* bp = row < MREAL ? base + (size_t)row * DM : hmeta + (size_t)(row - MREAL) * DM;
                float* op = row < MREAL ? out + (size_t)row * DM : hmeta + (size_t)(row - MREAL) * DM;
                float ss = 0.f;
#pragma unroll
                for (int bj = 0; bj < 2; ++bj)
#pragma unroll
                    for (int n = 0; n < 2; ++n) {
                        const int col = u.pn * 256 + bj * 128 + wc * 32 + 16 * n + 4 * fq;
                        const f32x4 h = *(const f32x4*)(bp + col) + acc[ai][bj][m][n];
                        *(f32x4*)(op + col) = h;
                        ss += (h[0] * h[0] + h[1] * h[1]) + (h[2] * h[2] + h[3] * h[3]);
                        u32x2 w; w.x = pk2(h[0], h[1]); w.y = pk2(h[2], h[3]);
                        *(u32x2*)(HB + (size_t)row * DM + col) = w;
                    }
                ss += __shfl_xor(ss, 16); ss += __shfl_xor(ss, 32);
                if (fq == 0) red[wc * 256 + ai * 128 + wr * 64 + m * 16 + fr] = ss;
            }
        asm volatile("s_waitcnt lgkmcnt(0)" ::: "memory"); __builtin_amdgcn_s_barrier(); asm volatile("" ::: "memory");
        {
            const int tl = (wr * 4 + wc) * 64 + fq * 16 + fr;
            if (tl < 256) ssq_next[(size_t)(u.pm * 256 + tl) * 4 + u.pn] = (red[tl] + red[256 + tl]) + (red[512 + tl] + red[768 + tl]);
        }
    }
};
struct EpiUp {
    static constexpr bool PERM = true, AFTER_DRAIN = false;
    int L;
    __device__ __forceinline__ void operator()(pg8::f32x4 (&acc)[2][2][4][2], const pg8::Unit& u, int wr, int wc, int fr, int fq) const {
        asm volatile("" : "+v"(fr), "+v"(fq));
        const Args* ka = kargs(); unsigned char* wsb = ka->ws;
        const LAS float* rsl = tile_rstd(ssq_arr(wsb, 2 * L + 1), u.pm, wr, wc, fr, fq); const float* cw = ka->conv_w + (size_t)L * 3 * NUP; const float* cb = ka->conv_b + (size_t)L * NUP;
        extern __shared__ __attribute__((aligned(16))) unsigned char lds_dyn_[];
        LAS float* halo = (LAS float*)((LAS unsigned char*)lds_dyn_ + HALO_OFF);
        const int colw = wc * 32 + 8 * fq;
#pragma unroll
        for (int ai = 0; ai < 2; ++ai)
#pragma unroll
            for (int m = 0; m < 4; ++m) {
                const int row = u.pm * 256 + ai * 128 + wr * 64 + m * 16 + fr;
                const float rs = rsl[ai * 128 + wr * 64 + m * 16 + fr]; (void)row;
#pragma unroll
                for (int bj = 0; bj < 2; ++bj)
#pragma unroll
                    for (int n = 0; n < 2; ++n) acc[ai][bj][m][n] *= rs;
            }
#ifdef SIMPLE_UP
        {
            const int ch0s = u.pn * 128 + colw;
#pragma unroll
            for (int n = 0; n < 2; ++n)
#pragma unroll
                for (int ai = 0; ai < 2; ++ai)
#pragma unroll
                    for (int m = 0; m < 4; ++m) {
                        const int row = u.pm * 256 + ai * 128 + wr * 64 + m * 16 + fr;
                        const f32x4 hu = acc[ai][0][m][n], hg = acc[ai][1][m][n];
                        u32x2 w; w.x = pk2(hu[0] + hg[0], hu[1] + hg[1]); w.y = pk2(hu[2] + hg[2], hu[3] + hg[3]);
                        *(u32x2*)(wsb + (unsigned)(WS_QKV + (unsigned)((row * DFF + ch0s + 4 * n) * 2))) = w;
                    }
            return;
        }
#endif
        if (fr >= 14) {
#pragma unroll
            for (int ai = 0; ai < 2; ++ai)
#pragma unroll
                for (int bj = 0; bj < 2; ++bj)
#pragma unroll
                    for (int n = 0; n < 2; ++n)
                        *(LAS f32x4*)(halo + (((2 * ai + wr) * 2 + (fr - 14)) * 256 + bj * 128 + colw + 4 * n)) = acc[ai][bj][3][n];
        }
        asm volatile("s_waitcnt lgkmcnt(0)" ::: "memory"); __builtin_amdgcn_s_barrier(); asm volatile("" ::: "memory");
        const int ch0 = u.pn * 128 + colw;
#pragma unroll
        for (int n = 0; n < 2; ++n) {
            __builtin_amdgcn_sched_barrier(0);
            f32x4 w0[2], w1[2], w2[2], bb[2];
#pragma unroll
            for (int bj = 0; bj < 2; ++bj) {
                const int c = bj * DFF + ch0 + 4 * n;
                w0[bj] = *(const f32x4*)((const char*)cw + (unsigned)(c * 4)); w1[bj] = *(const f32x4*)((const char*)cw + (unsigned)((NUP + c) * 4)); w2[bj] = *(const f32x4*)((const char*)cw + (unsigned)((2 * NUP + c) * 4)); bb[bj] = *(const f32x4*)((const char*)cb + (unsigned)(c * 4));
            }
#pragma unroll
            for (int ai = 0; ai < 2; ++ai)
#pragma unroll
                for (int m = 0; m < 4; ++m) {
                    __builtin_amdgcn_sched_barrier(0);
                    const int g = 2 * ai + wr;
                    const int row = u.pm * 256 + ai * 128 + wr * 64 + m * 16 + fr;
                    f32x4 hc[2];
#pragma unroll
                    for (int bj = 0; bj < 2; ++bj) {
                        const int c = bj * DFF + ch0 + 4 * n;
                        const f32x4 cur = acc[ai][bj][m][n];
                        f32x4 pb;
                        if (m > 0) pb = acc[ai][bj][m - 1][n];
                        else pb = *(const LAS f32x4*)(halo + ((((g > 0 ? g - 1 : 0) * 2) + (fr & 1)) * 256 + bj * 128 + colw + 4 * n));
                        f32x4 p1, p2;
#pragma unroll
                        for (int j = 0; j < 4; ++j) {
                            const float t1 = DPP_MOV(0.f, pb[j], 0x121);
                            p1[j] = DPP_MOV(t1, cur[j], 0x111);
                            const float t2 = DPP_MOV(0.f, pb[j], 0x122);
                            p2[j] = DPP_MOV(t2, cur[j], 0x112);
                        }
                        hc[bj] = bb[bj] + w0[bj] * p2 + w1[bj] * p1 + w2[bj] * cur;
                        if (g == 0 && m == 0 && fr < 2) *(f32x4*)(wsb + (unsigned)(WS_UT + (unsigned)(((u.pm * 2 + fr) * NUP + c) * 4))) = cur;
                        if (u.pm == 128 ? (g == 0 && m == 0 && fr >= 14) : (g == 3 && m == 3 && fr >= 14))
                            *(f32x4*)(wsb + (unsigned)(WS_UT + HFL_SIZE + (unsigned)(((u.pm * 2 + fr - 14) * NUP + c) * 4))) = cur;
                    }
                    u32x2 w;
                    w.x = pk2(siluf(hc[1][0]) * hc[0][0], siluf(hc[1][1]) * hc[0][1]);
                    w.y = pk2(siluf(hc[1][2]) * hc[0][2], siluf(hc[1][3]) * hc[0][3]);
                    *(u32x2*)(wsb + (unsigned)(WS_QKV + (unsigned)((row * DFF + ch0 + 4 * n) * 2))) = w;
                }
        }
    }
};
__device__ __forceinline__ int win_src(int n) {
    if (n < 512) return 1552 + n;
    if (n < 1024) return 2064 + (n - 512);
    if (n < 1536) return 2576 + (n - 1024);
    if (n < 1792) return n - 1536;
    if (n < 2048) return 256 + (n - 1792);
    if (n < 2560) return 512 + (n - 2048);
    if (n < 3072) return 1024 + (n - 2560);
    if (n < 3088) return 1536 + (n - 3072);
    if (n < 3096) return n;
    return -1;
}
__device__ __forceinline__ void tr_item(const float* W, int Nsrc, bf16* WT, int K, const float* gk, int mode, LAS float* scr, int k0, int n0, int lane) {
    const int nl = lane & 31, n = n0 + nl;
    int src = n; float cs = 1.f;
    if (mode == 0) { src = win_src(n); cs = n < 512 ? C2 : ((n >= 1536 && n < 1792) ? 0.125f : 1.f); }
    else if (mode == 2) { const int pn = n >> 8, j = n & 255; src = j < 128 ? pn * 128 + j : DFF + pn * 128 + (j - 128); }
#pragma unroll 8
    for (int i = 0; i < 32; ++i) {
        const int kk = 2 * i + (lane >> 5);
        float v = 0.f;
        if (src >= 0) v = W[(size_t)(k0 + kk) * Nsrc + src] * cs;
        if (gk) v *= gk[k0 + kk];
        scr[kk * 33 + nl] = v;
    }
    LDS_WAIT(); asm volatile("" ::: "memory");
    const int c = lane & 7;
#pragma unroll
    for (int j = 0; j < 4; ++j) {
        const int nn = (lane >> 3) + 8 * j; const LAS float* s = scr + (8 * c) * 33 + nn;
        u32x4 o; o.x = pk2(s[0 * 33], s[1 * 33]); o.y = pk2(s[2 * 33], s[3 * 33]); o.z = pk2(s[4 * 33], s[5 * 33]); o.w = pk2(s[6 * 33], s[7 * 33]);
        *(u32x4*)(WT + (size_t)(n0 + nn) * K + k0 + 8 * c) = o;
    }
    LDS_WAIT(); asm volatile("" ::: "memory");
}
__device__ __forceinline__ void row_to_bf16(const float* xrow, bf16* orow, float* ssq_slot, float* copy_row, int lane) {
    const f32x4* xr = (const f32x4*)xrow + lane;
    f32x4 v[4]; float s = 0.f;
#pragma unroll
    for (int j = 0; j < 4; ++j) { v[j] = xr[64 * j]; s += (v[j][0] * v[j][0] + v[j][1] * v[j][1]) + (v[j][2] * v[j][2] + v[j][3] * v[j][3]); }
    s = wave_sum(s);
    if (lane == 0) *(f32x4*)ssq_slot = (f32x4){s, 0.f, 0.f, 0.f};
    u32x2* o8 = (u32x2*)orow + lane;
#pragma unroll
    for (int j = 0; j < 4; ++j) { u32x2 w; w.x = pk2(v[j][0], v[j][1]); w.y = pk2(v[j][2], v[j][3]); o8[64 * j] = w; }
    if (copy_row) {
#pragma unroll
        for (int j = 0; j < 4; ++j) ((f32x4*)copy_row + lane)[64 * j] = v[j];
    }
}

__device__ __forceinline__ void gla_u_unit(LAS unsigned char* lds, const bf16* QKV, const float* SM, const float* wau, const float* balpha, float* UT, float* DEC, int bh, int cc) {
    int tid_ = threadIdx.x; asm volatile("" : "+v"(tid_)); const int tid = tid_, lane = tid & 63, wid = __builtin_amdgcn_readfirstlane(tid >> 6), hi = lane >> 5, r32 = lane & 31;
    const int b = bh >> 2, h = bh & 3;
    const int row0 = cc == 0 ? META0 : b * SEQ + (cc - 1) * 64, tvalid = cc == 0 ? NMETA : 64;
    LAS unsigned char* KD = lds;
    LAS unsigned char* VT = lds + 9216;
    LAS float* TOT = (LAS float*)(lds + 9216 + 17408);
    const int dk = lane, sg = wid;
    float w[16];
#pragma unroll
    for (int r = 0; r < 16; ++r) w[r] = wau[r * 256 + h * 64 + dk];
    const float bias = balpha[h * 64 + dk];
    float la[8];
#pragma unroll
    for (int i = 0; i < 8; ++i) {
        const int s = 8 * sg + i;
        const f32x4* g4 = (const f32x4*)(SM + (size_t)(row0 + s) * 32);
        float z = bias;
#pragma unroll
        for (int q = 0; q < 4; ++q) { const f32x4 gv = g4[q]; z += gv[0] * w[4 * q] + gv[1] * w[4 * q + 1] + gv[2] * w[4 * q + 2] + gv[3] * w[4 * q + 3]; }
        la[i] = (s < tvalid) ? logsigmoidf(z) * (1.0f / 16.0f) : 0.f;
    }
#pragma unroll
    for (int i = 1; i < 8; ++i) la[i] += la[i - 1];
    TOT[sg * 64 + dk] = la[7];
#pragma unroll
    for (int i = 0; i < 2; ++i) {
        const int idx = tid + 512 * i, row = idx >> 4, ch = idx & 15;
        const u32x4 v = *(const u32x4*)(QKV + (size_t)(row0 + row) * QP + C_GV + h * 128 + ch * 8);
        *(LAS u32x4*)(VT + row * 272 + ch * 16) = v;
    }
    __syncthreads();
    float pre = 0.f, tot = 0.f;
#pragma unroll
    for (int g2 = 0; g2 < 8; ++g2) { const float t = TOT[g2 * 64 + dk]; if (g2 < sg) pre += t; tot += t; }
    if (sg == 0) DEC[(size_t)(bh * NCH + cc) * 64 + dk] = __expf(tot);
#pragma unroll
    for (int i = 0; i < 8; ++i) {
        const int s = 8 * sg + i;
        const float kf = bf2f(QKV[(size_t)(row0 + s) * QP + C_GK + h * 64 + dk]);
        const float kd = (s < tvalid) ? kf * __expf(tot - (pre + la[i])) : 0.f;
        *(LAS bf16*)(KD + s * 144 + dk * 2) = f2bf(kd);
    }
    __syncthreads();
    const int dvb = wid >> 1, dkb = wid & 1;
    const int qq = (lane & 15) >> 2, pp = lane & 3, half = (lane >> 4) & 1;
    f32x16 acc = {};
#pragma unroll
    for (int j = 0; j < 4; ++j) {
        const LAS unsigned char* ap = VT + (16 * j + 4 * hi + qq) * 272 + (32 * dvb + 16 * half + 4 * pp) * 2;
        const LAS unsigned char* bp = KD + (16 * j + 4 * hi + qq) * 144 + (32 * dkb + 16 * half + 4 * pp) * 2;
        const bf16x8 af = cat8(vtr(ap), vtr(ap + 8 * 272));
        const bf16x8 bfr = cat8(vtr(bp), vtr(bp + 8 * 144));
        acc = __builtin_amdgcn_mfma_f32_32x32x16_bf16(af, bfr, acc, 0, 0, 0);
    }
    float* up = UT + ((size_t)(bh * NCH + cc) * 128 + 32 * dvb) * 64 + 32 * dkb + r32;
#pragma unroll
    for (int r = 0; r < 16; ++r) up[crow(r, hi) * 64] = acc[r];
    __syncthreads();
}
__device__ __forceinline__ void fox_cumsum_unit(LAS unsigned char* lds, const float* SM, const float* bforget, float* CK, int bh) {
    int tid_ = threadIdx.x; asm volatile("" : "+v"(tid_)); const int tid = tid_, lane = tid & 63, wid = tid >> 6;
    const int b = bh >> 3, h = bh & 7;
    const float bf_ = bforget[h];
    LAS float* WT_ = (LAS float*)lds;
    float mtot = 0.f, mine = 0.f;
    for (int p = 0; p < NMETA; ++p) { mtot += logsigmoidf(SM[(size_t)(META0 + p) * 32 + 16 + h] + bf_); if (tid == p) mine = mtot; }
    if (tid < 64) CK[(size_t)bh * CKP + tid] = tid < NMETA ? -LOG2E * mine : -INFINITY;
    float v[8]; float run = 0.f;
#pragma unroll
    for (int i = 0; i < 8; ++i) { run += logsigmoidf(SM[(size_t)(b * SEQ + 8 * tid + i) * 32 + 16 + h] + bf_); v[i] = run; }
    float inc = run;
#pragma unroll
    for (int o = 1; o < 64; o <<= 1) { const float t = __shfl_up(inc, o); if (lane >= o) inc += t; }
    if (lane == 63) WT_[wid] = inc;
    __syncthreads();
    float off = mtot + (inc - run);
    for (int w2 = 0; w2 < wid; ++w2) off += WT_[w2];
#pragma unroll
    for (int i = 0; i < 8; ++i) CK[(size_t)bh * CKP + 64 + 8 * tid + i] = -LOG2E * (off + v[i]);
    __syncthreads();
}

__device__ __forceinline__ void attn_unit(LAS unsigned char* lds, const bf16* QKV, const float* CK, bf16* OB, const float* fnorm, int b, int h, int qb) {
    int tid_ = threadIdx.x; asm volatile("" : "+v"(tid_)); const int tid = tid_, lane = tid & 63, wid = __builtin_amdgcn_readfirstlane(tid >> 6), r32 = lane & 31, hi = lane >> 5;
    constexpr int KB = 9216, KOFF = 0, VOFF = 2 * KB, COFF = 4 * KB, WOFF = COFF + 512;
    LAS float* wsf = (LAS float*)(lds + WOFF) + wid * 64;
    const size_t rowb = (size_t)b * SEQ; const int q0 = qb * 256;
    const int NT = 1 + 4 * (qb + 1);
    const bf16* qp = QKV + (rowb + q0 + wid * 32 + r32) * QP + C_FQ + h * 64 + hi * 8;
    bf16x8 qr[4];
#pragma unroll
    for (int d0 = 0; d0 < 4; ++d0) qr[d0] = *(const bf16x8*)(qp + d0 * 16);
    const int srow = tid >> 3, sch = tid & 7;
    const float* ckp = CK + (size_t)(b * 8 + h) * CKP;
    u32x4 kreg, vreg; float creg = 0.f;
#define ATT_LOAD(t) do { const size_t r0_ = (t) == 0 ? (size_t)META0 : rowb + (size_t)((t) - 1) * 64; const bf16* p_ = QKV + (r0_ + srow) * QP + h * 64 + sch * 8; \
        kreg = *(const u32x4*)(p_ + C_FK); vreg = *(const u32x4*)(p_ + C_FV); if (tid < 64) creg = ckp[(t) * 64 + tid]; } while (0)
#define ATT_STORE(buf) do { *(LAS u32x4*)(lds + KOFF + (buf) * KB + srow * 144 + sch * 16) = kreg; *(LAS u32x4*)(lds + VOFF + (buf) * KB + srow * 144 + sch * 16) = vreg; \
        if (tid < 64) *(LAS float*)(lds + COFF + (buf) * 256 + tid * 4) = creg; } while (0)
    float m = -1e30f, l = 0.f; f32x16 o0 = {}, o1 = {};
    const int qrel = 32 * wid + r32;
    const int qq = (lane & 15) >> 2, pp = lane & 3, half = (lane >> 4) & 1;
    ATT_LOAD(0); ATT_STORE(0);
    for (int t = 0; t < NT; ++t) {
        const int buf = t & 1;
        if (t + 1 < NT) ATT_LOAD(t + 1);
        __syncthreads();
        const int jb = t - (NT - 4);
        const bool skip = (jb >= 0) && (64 * jb > 32 * wid + 31);
        if (!skip) {
            const LAS unsigned char* Kb = lds + KOFF + buf * KB; const LAS unsigned char* Vb = lds + VOFF + buf * KB; const LAS float* Cb = (const LAS float*)(lds + COFF + buf * 256);
            f32x16 p0 = {}, p1 = {};
#pragma unroll
            for (int d0 = 0; d0 < 4; ++d0) {
                const bf16x8 a0 = *(const LAS bf16x8*)(Kb + r32 * 144 + (16 * d0 + 8 * hi) * 2);
                const bf16x8 a1 = *(const LAS bf16x8*)(Kb + (32 + r32) * 144 + (16 * d0 + 8 * hi) * 2);
                p0 = __builtin_amdgcn_mfma_f32_32x32x16_bf16(a0, qr[d0], p0, 0, 0, 0);
                p1 = __builtin_amdgcn_mfma_f32_32x32x16_bf16(a1, qr[d0], p1, 0, 0, 0);
            }
#pragma unroll
            for (int g = 0; g < 4; ++g) {
                const f32x4 c0 = *(const LAS f32x4*)(Cb + 8 * g + 4 * hi), c1 = *(const LAS f32x4*)(Cb + 32 + 8 * g + 4 * hi);
#pragma unroll
                for (int i = 0; i < 4; ++i) { p0[4 * g + i] += c0[i]; p1[4 * g + i] += c1[i]; }
            }
            if (jb >= 0 && 64 * jb + 63 > 32 * wid) {
#pragma unroll
                for (int r = 0; r < 16; ++r) { const int kv = 64 * jb + crow(r, hi); if (kv > qrel) p0[r] = -INFINITY; if (kv + 32 > qrel) p1[r] = -INFINITY; }
            }
            float mx = fmaxf(p0[0], p1[0]);
#pragma unroll
            for (int r = 1; r < 16; ++r) mx = fmaxf(mx, fmaxf(p0[r], p1[r]));
            mx = fmaxf(mx, __shfl_xor(mx, 32));
            const float mn = fmaxf(m, mx);
            const float alpha = __builtin_amdgcn_exp2f(m - mn);
            m = mn;
            float rsum = 0.f;
#pragma unroll
            for (int r = 0; r < 16; ++r) { p0[r] = __builtin_amdgcn_exp2f(p0[r] - mn); p1[r] = __builtin_amdgcn_exp2f(p1[r] - mn); rsum += p0[r] + p1[r]; }
            l = l * alpha + rsum;
            if (hi == 0) wsf[r32] = alpha;
            LDS_WAIT();
#pragma unroll
            for (int g = 0; g < 4; ++g) {
                const f32x4 a = *(const LAS f32x4*)(wsf + 8 * g + 4 * hi);
#pragma unroll
                for (int i = 0; i < 4; ++i) { o0[4 * g + i] *= a[i]; o1[4 * g + i] *= a[i]; }
            }
            bf16x8 pa[4];
            { u32x4 w;
              w.x = pk2(p0[0], p0[1]); w.y = pk2(p0[2], p0[3]); w.z = pk2(p0[4], p0[5]); w.w = pk2(p0[6], p0[7]); pa[0] = __builtin_bit_cast(bf16x8, w);
              w.x = pk2(p0[8], p0[9]); w.y = pk2(p0[10], p0[11]); w.z = pk2(p0[12], p0[13]); w.w = pk2(p0[14], p0[15]); pa[1] = __builtin_bit_cast(bf16x8, w);
              w.x = pk2(p1[0], p1[1]); w.y = pk2(p1[2], p1[3]); w.z = pk2(p1[4], p1[5]); w.w = pk2(p1[6], p1[7]); pa[2] = __builtin_bit_cast(bf16x8, w);
              w.x = pk2(p1[8], p1[9]); w.y = pk2(p1[10], p1[11]); w.z = pk2(p1[12], p1[13]); w.w = pk2(p1[14], p1[15]); pa[3] = __builtin_bit_cast(bf16x8, w); }
#pragma unroll
            for (int j = 0; j < 4; ++j) {
                const LAS unsigned char* vp = Vb + (16 * j + 4 * hi + qq) * 144 + (16 * half + 4 * pp) * 2;
                const bf16x8 v0 = cat8(vtr(vp), vtr(vp + 8 * 144));
                const bf16x8 v1 = cat8(vtr(vp + 64), vtr(vp + 64 + 8 * 144));
                o0 = __builtin_amdgcn_mfma_f32_32x32x16_bf16(pa[j], v0, o0, 0, 0, 0);
                o1 = __builtin_amdgcn_mfma_f32_32x32x16_bf16(pa[j], v1, o1, 0, 0, 0);
            }
        }
        if (t + 1 < NT) ATT_STORE(buf ^ 1);
    }
#undef ATT_LOAD
#undef ATT_STORE
    l += __shfl_xor(l, 32);
    if (hi == 0) wsf[r32] = 1.0f / l;
    LDS_WAIT();
#pragma unroll
    for (int g = 0; g < 4; ++g) {
        const f32x4 a = *(const LAS f32x4*)(wsf + 8 * g + 4 * hi);
#pragma unroll
        for (int i = 0; i < 4; ++i) { o0[4 * g + i] *= a[i]; o1[4 * g + i] *= a[i]; }
    }
    const float w0 = fnorm[h * 64 + r32], w1 = fnorm[h * 64 + 32 + r32];
#pragma unroll
    for (int r = 0; r < 16; ++r) {
        float s = o0[r] * o0[r] + o1[r] * o1[r];
        s += __shfl_xor(s, 1); s += __shfl_xor(s, 2); s += __shfl_xor(s, 4); s += __shfl_xor(s, 8); s += __shfl_xor(s, 16);
        const float rs = rsqrtf(s * (1.0f / 64.0f) + EPS);
        bf16* op = OB + (rowb + q0 + wid * 32 + crow(r, hi)) * DM + 512 + h * 64 + r32;
        op[0] = f2bf(o0[r] * rs * w0); op[32] = f2bf(o1[r] * rs * w1);
    }
    __syncthreads();
}
__device__ __forceinline__ void meta_attn(const bf16* QKV, const float* CK, bf16* OB, const float* fnorm) {
    int tid_ = threadIdx.x; asm volatile("" : "+v"(tid_)); const int lane = tid_ & 63, wid = tid_ >> 6;
    for (int pair = wid; pair < 128; pair += 8) {
        const int p = pair >> 3, h = pair & 7;
        const float q = bf2f(QKV[(size_t)(META0 + p) * QP + C_FQ + h * 64 + lane]);
        float m = -1e30f, l = 0.f, o = 0.f;
        for (int s = 0; s <= p; ++s) {
            const float kd = bf2f(QKV[(size_t)(META0 + s) * QP + C_FK + h * 64 + lane]);
            const float sc = wave_sum(q * kd) + CK[(size_t)h * CKP + s];
            const float mn = fmaxf(m, sc), a = __builtin_amdgcn_exp2f(m - mn), pw = __builtin_amdgcn_exp2f(sc - mn);
            l = l * a + pw; o = o * a + pw * bf2f(QKV[(size_t)(META0 + s) * QP + C_FV + h * 64 + lane]); m = mn;
        }
        o /= l;
        const float ss = wave_sum(o * o);
        OB[(size_t)(META0 + p) * DM + 512 + h * 64 + lane] = f2bf(o * rsqrtf(ss * (1.0f / 64.0f) + EPS) * fnorm[h * 64 + lane]);
    }
}
__device__ __forceinline__ void gla_readout_wave(const bf16* QKV, const float* UT, bf16* OB, const float* gnorm, int wu, int lane) {
    asm volatile("" : "+v"(lane));
    const int half = wu & 1, t = wu >> 1, cc = t % NCH, bh = t / NCH, b = bh >> 2, h = bh & 3;
    if (cc == 0 && (half == 1 || b != 0)) return;
    const int r32 = lane & 31, hi = lane >> 5;
    const int row0 = cc == 0 ? META0 : b * SEQ + (cc - 1) * 64 + 32 * half, nvalid = cc == 0 ? NMETA : 32;
    const float* Sp = UT + (size_t)(bh * NCH + cc) * 8192;
    f32x16 acc[4] = {};
#pragma unroll
    for (int j = 0; j < 4; ++j) {
        const bf16x8 bq = *(const bf16x8*)(QKV + (size_t)(row0 + r32) * QP + C_GQ + h * 64 + 16 * j + 8 * hi);
#pragma unroll
        for (int blk = 0; blk < 4; ++blk) {
            const float* sp = Sp + (32 * blk + r32) * 64 + 16 * j + 8 * hi;
            const f32x4 s0 = *(const f32x4*)sp, s1 = *(const f32x4*)(sp + 4);
            u32x4 w; w.x = pk2(s0[0], s0[1]); w.y = pk2(s0[2], s0[3]); w.z = pk2(s1[0], s1[1]); w.w = pk2(s1[2], s1[3]);
            acc[blk] = __builtin_amdgcn_mfma_f32_32x32x16_bf16(__builtin_bit_cast(bf16x8, w), bq, acc[blk], 0, 0, 0);
        }
    }
    float ss = 0.f;
#pragma unroll
    for (int blk = 0; blk < 4; ++blk)
#pragma unroll
        for (int r = 0; r < 16; ++r) ss += acc[blk][r] * acc[blk][r];
    ss += __shfl_xor(ss, 32);
    const float rs = rsqrtf(ss * (1.0f / 128.0f) + EPS);
    if (r32 < nvalid) {
        const size_t row = (size_t)row0 + r32;
#pragma unroll
        for (int blk = 0; blk < 4; ++blk)
#pragma unroll
            for (int g = 0; g < 4; ++g) {
                const int dv = 32 * blk + 8 * g + 4 * hi;
                const u32x2 gt = *(const u32x2*)(QKV + row * QP + C_GR + h * 128 + dv);
                const f32x4 wn = *(const f32x4*)(gnorm + h * 128 + dv);
                const float g0 = __uint_as_float(gt.x << 16), g1 = __uint_as_float(gt.x & 0xffff0000u), g2 = __uint_as_float(gt.y << 16), g3 = __uint_as_float(gt.y & 0xffff0000u);
                u32x2 w;
                w.x = pk2(acc[blk][4 * g] * rs * wn[0] * siluf(g0), acc[blk][4 * g + 1] * rs * wn[1] * siluf(g1));
                w.y = pk2(acc[blk][4 * g + 2] * rs * wn[2] * siluf(g2), acc[blk][4 * g + 3] * rs * wn[3] * siluf(g3));
                *(u32x2*)(OB + row * DM + h * 128 + dv) = w;
            }
    }
}

#define FRESH() const Args& a = *kargs(); unsigned char* ws = a.ws; \
    bf16* HB = (bf16*)(ws + WS_HB); bf16* OB = (bf16*)(ws + WS_OB); bf16* QKV = (bf16*)(ws + WS_QKV); bf16* A2 = (bf16*)(ws + WS_QKV); \
    float* UT = (float*)(ws + WS_UT); float* HF = (float*)(ws + WS_UT); float* HL = (float*)(ws + WS_UT + HFL_SIZE); \
    float* SM = (float*)(ws + WS_SM); float* CK = (float*)(ws + WS_CK); float* DEC = (float*)(ws + WS_DEC); float* HM = (float*)(ws + WS_HM); float* SSQ = (float*)(ws + WS_SSQ); \
    unsigned char* wl = ws + WS_W + (size_t)L * WL_SIZE; \
    (void)HB; (void)OB; (void)QKV; (void)A2; (void)UT; (void)HF; (void)HL; (void)SM; (void)CK; (void)DEC; (void)HM; (void)SSQ; (void)wl; \
    int tid_ = threadIdx.x; asm volatile("" : "+v"(tid_)); const int tid = tid_, lane = tid & 63, wid = __builtin_amdgcn_readfirstlane(tid >> 6); \
    const int gw = bx * 8 + wid, NGW = G * 8, gt = bx * 512 + tid, NGT = G * 512; (void)lane; (void)gw; (void)NGW; (void)gt; (void)NGT;
#define GSYNC() do { __threadfence(); grid.sync(); __threadfence(); } while (0)
__global__ void __launch_bounds__(512, 2) fwd_kernel(Args a_unused) {
    extern __shared__ __attribute__((aligned(16))) unsigned char lds_raw[];
    LAS unsigned char* lds = (LAS unsigned char*)lds_raw;
    cg::grid_group grid = cg::this_grid();
    const int G = gridDim.x, bx = blockIdx.x;
    {
        const int L = 0; FRESH();
        LAS float* scr = (LAS float*)(lds + wid * 16384);
        constexpr int I_IN = 16 * (NINP / 32), I_OUT = 16 * 32, I_UP = 16 * (NUP / 32), I_DN = (DFF / 64) * 32, I_L = I_IN + I_OUT + I_UP + I_DN;
        for (int it = gw; it < DEPTH * I_L; it += NGW) {
            const int L = it / I_L; int r = it % I_L;
            unsigned char* wl = ws + WS_W + (size_t)L * WL_SIZE;
            if (r < I_IN) { const int nb = NINP / 32; tr_item(a.w_in + (size_t)L * DM * 3096, 3096, (bf16*)(wl + WL_IN), DM, a.attn_norm + L * DM, 0, scr, 64 * (r / nb), 32 * (r % nb), lane); continue; } r -= I_IN;
            if (r < I_OUT) { tr_item(a.w_out + (size_t)L * DM * DM, DM, (bf16*)(wl + WL_OUT), DM, nullptr, 1, scr, 64 * (r / 32), 32 * (r % 32), lane); continue; } r -= I_OUT;
            if (r < I_UP) { const int nb = NUP / 32; tr_item(a.w_up + (size_t)L * DM * NUP, NUP, (bf16*)(wl + WL_UP), DM, a.ffn_norm + L * DM, 2, scr, 64 * (r / nb), 32 * (r % nb), lane); continue; } r -= I_UP;
            tr_item(a.w_down + (size_t)L * DFF * DM, DM, (bf16*)(wl + WL_DN), DFF, nullptr, 3, scr, 64 * (r / 32), 32 * (r % 32), lane);
        }
        for (int i = gt; i < (256 - NMETA) * 4; i += NGT) SSQ[(size_t)(META0 + NMETA) * 4 + i] = 0.f;
        for (int r = gw; r < MREAL + 256; r += NGW) {
            if (r < MREAL) row_to_bf16(a.x + (size_t)r * DM, HB + (size_t)r * DM, SSQ + (size_t)r * 4, nullptr, lane);
            else if (r < MREAL + NMETA) row_to_bf16(a.meta + (size_t)(r - MREAL) * DM, HB + (size_t)r * DM, SSQ + (size_t)r * 4, HM + (size_t)(r - MREAL) * DM, lane);
            else {
#pragma unroll
                for (int j = 0; j < 4; ++j) { ((f32x4*)(HM + (size_t)(r - MREAL) * DM) + lane)[64 * j] = (f32x4){0.f, 0.f, 0.f, 0.f};
                    ((u32x2*)(HB + (size_t)r * DM) + lane)[64 * j] = (u32x2){0u, 0u}; ((u32x2*)(OB + (size_t)r * DM) + lane)[64 * j] = (u32x2){0u, 0u}; }
            }
        }
    }
    GSYNC();

    for (int L = 0; L < DEPTH; ++L) {
#ifndef SKIP_A
        {
            FRESH();
            pg8::Gemm g{HB, (const bf16*)(wl + WL_IN), MROWS, NINP, DM}; pg8::StaticOrder S; S.init(MROWS, NINP, G, bx);
            EpiIn E{2 * L};
            pg8::gemm_phase<EpiIn, pg8::StaticOrder, true, true>(lds, g, S, E);
        }
#endif
        GSYNC();
#ifndef SKIP_B
        { FRESH();
        for (int u = bx; u < 32 * NCH + 64; u += G) {
            if (u < 32 * NCH) gla_u_unit(lds, QKV, SM, a.w_au + (size_t)L * 16 * 256, a.b_alpha + L * 256, UT, DEC, u / NCH, u % NCH);
            else fox_cumsum_unit(lds, SM, a.b_forget + L * 8, CK, u - 32 * NCH);
        }
        }
#endif
        GSYNC();
#ifndef SKIP_CS
        { FRESH();
        for (int e = gt; e < 32 * 8192; e += NGT) {
            const int bh = e >> 13, rem = e & 8191, dk = rem & 63;
            float* up = UT + (size_t)bh * NCH * 8192 + rem; const float* dp = DEC + (size_t)bh * NCH * 64 + dk;
            float Sv = up[0];
            for (int c0 = 1; c0 <= 64; c0 += 8) {
                float uu[8], dd[8];
#pragma unroll
                for (int i = 0; i < 8; ++i) { uu[i] = up[(size_t)(c0 + i) * 8192]; dd[i] = dp[(c0 + i) * 64]; }
#pragma unroll
                for (int i = 0; i < 8; ++i) { Sv = dd[i] * Sv + uu[i]; up[(size_t)(c0 + i) * 8192] = Sv; }
            }
        }
#endif
#ifndef SKIP_CA
        }
        { FRESH();
        for (int v = bx; v < 256; v += G) {
            const int bhh = v >> 2, s = v & 3;
#pragma unroll 1
            for (int i = 0; i < 4; ++i) {
                const int qb = (i == 0) ? s : (i == 1) ? 7 - s : (i == 2) ? 8 + s : 15 - s;
                attn_unit(lds, QKV, CK, OB, a.fox_norm + L * 512, bhh >> 3, bhh & 7, qb);
            }
        }
#endif
#ifndef SKIP_CM
        }
        { FRESH();
        if (bx == G - 1) meta_attn(QKV, CK, OB, a.fox_norm + L * 512);
        }
#endif
        GSYNC();
#ifndef SKIP_D
        { FRESH();
        for (int wu = gw; wu < 32 * NCH * 2; wu += NGW) gla_readout_wave(QKV, UT, OB, a.gla_norm + L * 512, wu, lane);
        }
#endif
        GSYNC();
#ifndef SKIP_E
        {
            FRESH();
            pg8::Gemm g{OB, (const bf16*)(wl + WL_OUT), MROWS, DM, DM}; pg8::StaticOrder S; S.init(MROWS, DM, G, bx);
            EpiRes E{L == 0 ? 1 : 0, 2 * L + 1};
            pg8::gemm_phase<EpiRes, pg8::StaticOrder, true, true>(lds, g, S, E);
        }
#endif
        GSYNC();
#ifndef SKIP_F
        {
            FRESH();
            pg8::Gemm g{HB, (const bf16*)(wl + WL_UP), MROWS, NUP, DM}; pg8::StaticOrder S; S.init(MROWS, NUP, G, bx);
            EpiUp E{L};
            pg8::gemm_phase<EpiUp, pg8::StaticOrder, true, true>(lds, g, S, E);
        }
#endif
        GSYNC();
#ifndef SKIP_G
        {
            FRESH();
            const float* cw = a.conv_w + (size_t)L * 3 * NUP; const float* cb = a.conv_b + (size_t)L * NUP;
            for (int i = gt; i < 129 * 2 * (DFF / 4); i += NGT) {
                const int c4 = i % (DFF / 4), rr = (i / (DFF / 4)) & 1, pm = i / (2 * (DFF / 4));
                const int ch = 4 * c4;
                f32x4 hc[2];
#pragma unroll
                for (int bj = 0; bj < 2; ++bj) {
                    const int c = bj * DFF + ch;
                    f32x4 P0 = {0.f, 0.f, 0.f, 0.f}, P1 = P0;
                    if (pm != 128) { const int src = (pm % 16 == 0) ? 128 : pm - 1; P0 = *(const f32x4*)(HL + (size_t)(src * 2) * NUP + c); P1 = *(const f32x4*)(HL + (size_t)(src * 2 + 1) * NUP + c); }
                    const f32x4 H0 = *(const f32x4*)(HF + (size_t)(pm * 2) * NUP + c), H1 = *(const f32x4*)(HF + (size_t)(pm * 2 + 1) * NUP + c);
                    const f32x4 x2 = rr == 0 ? P0 : P1, x1 = rr == 0 ? P1 : H0, x0 = rr == 0 ? H0 : H1;
                    hc[bj] = *(const f32x4*)(cb + c) + *(const f32x4*)(cw + c) * x2 + *(const f32x4*)(cw + NUP + c) * x1 + *(const f32x4*)(cw + 2 * NUP + c) * x0;
                }
                u32x2 w;
                w.x = pk2(siluf(hc[1][0]) * hc[0][0], siluf(hc[1][1]) * hc[0][1]);
                w.y = pk2(siluf(hc[1][2]) * hc[0][2], siluf(hc[1][3]) * hc[0][3]);
                *(u32x2*)(A2 + (size_t)(pm * 256 + rr) * DFF + ch) = w;
            }
        }
#endif
        GSYNC();
#ifndef SKIP_H
        {
            FRESH();
            pg8::Gemm g{A2, (const bf16*)(wl + WL_DN), MROWS, DM, DFF}; pg8::StaticOrder S; S.init(MROWS, DM, G, bx);
            EpiRes E{0, 2 * L + 2};
            pg8::gemm_phase<EpiRes, pg8::StaticOrder, true, true>(lds, g, S, E);
        }
#endif
        GSYNC();
    }
    {
        const int L = 0; FRESH();
        const float* ssq = ssq_arr(ws, 8);
        for (int r = gw; r < MREAL; r += NGW) {
            const float rs = row_rstd(ssq, r);
            f32x4* p = (f32x4*)(a.out + (size_t)r * DM) + lane; const f32x4* wn = (const f32x4*)a.final_norm + lane;
#pragma unroll
            for (int j = 0; j < 4; ++j) p[64 * j] = p[64 * j] * rs * wn[64 * j];
        }
    }
}

extern "C" void kernel_launch(void* const* d_in, const int* in_sizes, int n_in, void* d_out, int out_size, void* d_ws, size_t ws_size, hipStream_t stream) {
    static int grid = 0;
    if (grid == 0) {
        if (n_in != 16 || out_size != MREAL * DM || ws_size < WS_END) { fprintf(stderr, "kernel_launch: unexpected problem (n_in %d out %d ws %zu, need %zu)\n", n_in, out_size, ws_size, (size_t)WS_END); grid = -1; return; }
        int dev = 0, cus = 0, per = 0;
        (void)hipGetDevice(&dev); (void)hipDeviceGetAttribute(&cus, hipDeviceAttributeMultiprocessorCount, dev);
        (void)hipFuncSetAttribute((const void*)fwd_kernel, hipFuncAttributeMaxDynamicSharedMemorySize, LDS_BYTES);
        (void)hipOccupancyMaxActiveBlocksPerMultiprocessor(&per, (const void*)fwd_kernel, 512, LDS_BYTES);
        if (per < 1) per = 1;
        grid = cus * per;
        fprintf(stderr, "kernel_launch: grid %d (cus %d x %d), ws %zu\n", grid, cus, per, ws_size);
    }
    if (grid < 0) return;
    Args a{};
    const float** f = (const float**)&a;
    for (int i = 0; i < 16; ++i) f[i] = (const float*)d_in[i];
    a.out = (float*)d_out; a.ws = (unsigned char*)d_ws;
    void* args[] = {&a};
    hipError_t e = hipLaunchCooperativeKernel((const void*)fwd_kernel, dim3(grid), dim3(512), args, LDS_BYTES, stream);
    if (e != hipSuccess) fprintf(stderr, "cooperative launch failed: %s (grid %d)\n", hipGetErrorString(e), grid);
}
```

```cpp
#include <hip/hip_runtime.h>
#include <hip/hip_cooperative_groups.h>
#include <cstdio>
#include <cstdint>
namespace cg = cooperative_groups;
namespace pg8 {
#define PG8_LAS __attribute__((address_space(3)))
typedef unsigned short bf16_t;
typedef short bf16x8 __attribute__((ext_vector_type(8)));
typedef float f32x4 __attribute__((ext_vector_type(4)));
typedef unsigned u32x4 __attribute__((ext_vector_type(4)));
constexpr int BM = 256, BK = 64, HALF = 128, HTB = HALF * BK * 2  , STAGE_BYTES = 8 * HTB, NXCD = 8, WGM = 8;

__host__ __device__ __forceinline__ int lds_byte(int r, int c) { const int st = (r >> 4) * 2 + (c >> 5), rr = r & 15, cc = c & 31, ob = rr * 64 + cc * 2; return st * 1024 + (ob ^ (((ob >> 9) & 1) << 5)); }
__host__ __device__ __forceinline__ void stage_rc(int b, int& R, int& C) { const int st = b / 1024, sb = b % 1024, swz = sb ^ (((sb >> 9) & 1) << 5); R = (st >> 1) * 16 + swz / 64; C = (st & 1) * 32 + (swz % 64) / 2; }
__host__ __device__ __forceinline__ int perm32(int rho) { const int n = rho >> 4, i = rho & 15; return 8 * (i >> 2) + 4 * n + (i & 3); }

struct Unit { int pm, pn; };
struct Gemm { const bf16_t* A; const bf16_t* Bt; int M, N, K; };

struct StaticOrder {
    int nM, nN, nwg, G, c;
    __host__ __device__ void init(int M, int N, int G_, int c_) { nM = M / BM; nN = N / BM; nwg = nM * nN; G = G_; c = c_; }
    __host__ __device__ bool next(int i, Unit& u) const {
        const long L = (long)i * G + c; if (L >= nwg) return false;
        int wgid = (int)L; { const int q = nwg / NXCD, r = nwg % NXCD, xcd = wgid % NXCD, off = wgid / NXCD; wgid = (xcd < r ? xcd * (q + 1) : r * (q + 1) + (xcd - r) * q) + off; }
        const int nig = WGM * nN, gid = wgid / nig, fm = gid * WGM, gsz = (nM - fm) < WGM ? (nM - fm) : WGM;
        u.pm = fm + ((wgid % nig) % gsz); u.pn = (wgid % nig) / gsz; return true;
    }
    __device__ __forceinline__ void a_ready(const Unit&) const {}
    __device__ __forceinline__ void done(const Unit&) const {}
};

__device__ __forceinline__ unsigned cvt_pk_bf16(float lo, float hi) { unsigned r; asm volatile("v_cvt_pk_bf16_f32 %0, %1, %2" : "=v"(r) : "v"(lo), "v"(hi)); return r; }
typedef float f32x2 __attribute__((ext_vector_type(2)));
template <class Epi, class Sched, bool ALIGN_EPI = false, bool SP2 = false>
__device__ __forceinline__ void gemm_phase(PG8_LAS unsigned char* lds, const Gemm g, const Sched& S, const Epi& E) {
    int tid_ = threadIdx.x; asm volatile("" : "+v"(tid_)); const int tid = tid_, wid = __builtin_amdgcn_readfirstlane(tid >> 6), lane = tid & 63, wr = wid >> 2, wc = wid & 3, fr = lane & 15, fq = lane >> 4;
    const int K = g.K, nt = K / BK;
    unsigned voffA[2], voffB[2];
#pragma unroll
    for (int i = 0; i < 2; ++i) { int R, C; stage_rc(tid * 16 + i * 8192, R, C); const int Rb = Epi::PERM ? ((R & ~31) + perm32(R & 31)) : R;
        voffA[i] = (unsigned)(R * K + C) * 2u; voffB[i] = (unsigned)(Rb * K + C) * 2u; }
    const size_t kstep = (size_t)(BK * 2);
    const size_t hstep = (size_t)HALF * K * 2;
    const size_t tstep = 2 * hstep;
    const unsigned ldsw = (unsigned)wid * 1024u;
    const int aoff = lds_byte(wr * 64 + fr, fq * 8), boff = lds_byte(wc * 32 + fr, fq * 8);
#define PG8_SA(b, h) (((b) * 2 + (h)) * HTB)
#define PG8_SB(b, h) ((4 + (b) * 2 + (h)) * HTB)
#define PG8_STAGE(bufoff, gbase, voff) do { _Pragma("unroll") for (int _i = 0; _i < 2; ++_i) \
        __builtin_amdgcn_global_load_lds((const unsigned*)((const char*)(gbase) + (voff)[_i]), (PG8_LAS unsigned*)(lds + (bufoff) + ldsw + _i * 8192), 16, 0, 0); } while (0)
#define PG8_LDA(dst, b, h) do { _Pragma("unroll") for (int m = 0; m < 4; ++m) _Pragma("unroll") for (int k = 0; k < 2; ++k) dst[m][k] = *(const PG8_LAS bf16x8*)(lds + PG8_SA(b, h) + aoff + m * 2048 + k * 1024); } while (0)
#define PG8_LDB(dst, b, h) do { _Pragma("unroll") for (int n = 0; n < 2; ++n) _Pragma("unroll") for (int k = 0; k < 2; ++k) dst[n][k] = *(const PG8_LAS bf16x8*)(lds + PG8_SB(b, h) + boff + n * 2048 + k * 1024); } while (0)
#define PG8_MMA(ai, bj, At, Bt) do { __builtin_amdgcn_s_setprio(1); _Pragma("unroll") for (int m = 0; m < 4; ++m) _Pragma("unroll") for (int n = 0; n < 2; ++n) _Pragma("unroll") for (int k = 0; k < 2; ++k) \
        acc[ai][bj][m][n] = __builtin_amdgcn_mfma_f32_16x16x32_bf16(Bt[n][k], At[m][k], acc[ai][bj][m][n], 0, 0, 0); __builtin_amdgcn_s_setprio(0); } while (0)
#define PG8_WAIT_V(n) asm volatile("s_waitcnt vmcnt(" #n ")" ::: "memory")
#define PG8_WAIT_L(n) asm volatile("s_waitcnt lgkmcnt(" #n ")" ::: "memory")
#define PG8_BAR __builtin_amdgcn_s_barrier()
#define PG8_SCHED __builtin_amdgcn_sched_barrier(0)
    Unit cur, nxt; int ui = 0;
    if (!S.next(0, cur)) return;
    f32x4 acc[2][2][4][2];
#pragma unroll
    for (int a = 0; a < 2; ++a)
#pragma unroll
        for (int b = 0; b < 2; ++b)
#pragma unroll
            for (int m = 0; m < 4; ++m)
#pragma unroll
                for (int n = 0; n < 2; ++n) acc[a][b][m][n] = (f32x4){0.f, 0.f, 0.f, 0.f};
    bf16x8 At[4][2], B0[2][2], B1[2][2];
    const char* cA = (const char*)g.A + (size_t)cur.pm * tstep; const char* cB = (const char*)g.Bt + (size_t)cur.pn * tstep;
    S.a_ready(cur);
    if constexpr (SP2) {
        PG8_STAGE(PG8_SB(0, 0), cB, voffB); PG8_STAGE(PG8_SB(0, 1), cB + hstep, voffB); PG8_STAGE(PG8_SA(0, 0), cA, voffA); PG8_STAGE(PG8_SA(0, 1), cA + hstep, voffA);
        if (wr == 1) PG8_BAR;
        PG8_WAIT_V(2); PG8_BAR;
        PG8_STAGE(PG8_SB(1, 0), cB + kstep, voffB); PG8_STAGE(PG8_SA(1, 0), cA + kstep, voffA); PG8_STAGE(PG8_SB(1, 1), cB + hstep + kstep, voffB);
        PG8_WAIT_V(6); PG8_BAR;
    } else {
        PG8_STAGE(PG8_SB(0, 0), cB, voffB); PG8_STAGE(PG8_SA(0, 0), cA, voffA); PG8_STAGE(PG8_SB(0, 1), cB + hstep, voffB); PG8_STAGE(PG8_SA(0, 1), cA + hstep, voffA);
        if (wr == 1) PG8_BAR;
        PG8_WAIT_V(4); PG8_BAR;
        PG8_STAGE(PG8_SB(1, 0), cB + kstep, voffB); PG8_STAGE(PG8_SA(1, 0), cA + kstep, voffA); PG8_STAGE(PG8_SB(1, 1), cB + hstep + kstep, voffB);
        PG8_WAIT_V(6); PG8_BAR;
    }
    for (;;) {
        const bool has_next = S.next(ui + 1, nxt);
        const char* nA = has_next ? (const char*)g.A + (size_t)nxt.pm * tstep : cA; const char* nB = has_next ? (const char*)g.Bt + (size_t)nxt.pn * tstep : cB;
        for (int t = 0; t < nt; t += 2) {
            const bool last = (t == nt - 2);
            const char* a1 = cA + (size_t)(t + 1) * kstep;
            const char* a2 = last ? nA : cA + (size_t)(t + 2) * kstep; const char* b2 = last ? nB : cB + (size_t)(t + 2) * kstep;
            const char* a3 = a2 + kstep; const char* b3 = b2 + kstep;
            if (last && has_next) S.a_ready(nxt);
            if constexpr (SP2) {
            PG8_LDB(B0, 0, 0); PG8_LDB(B1, 0, 1); PG8_SCHED; PG8_LDA(At, 0, 0); PG8_STAGE(PG8_SA(1, 1), a1 + hstep, voffA);
            PG8_WAIT_V(8); PG8_WAIT_L(0); PG8_BAR; PG8_MMA(0, 0, At, B0); PG8_MMA(0, 1, At, B1); PG8_BAR; PG8_SCHED;
            PG8_LDA(At, 0, 1); PG8_STAGE(PG8_SB(0, 0), b2, voffB); PG8_STAGE(PG8_SB(0, 1), b2 + hstep, voffB); PG8_STAGE(PG8_SA(0, 0), a2, voffA);
            PG8_WAIT_V(8); PG8_WAIT_L(0); PG8_BAR; PG8_MMA(1, 0, At, B0); PG8_MMA(1, 1, At, B1); PG8_BAR; PG8_SCHED;
            PG8_LDB(B0, 1, 0); PG8_LDB(B1, 1, 1); PG8_SCHED; PG8_LDA(At, 1, 0); PG8_STAGE(PG8_SA(0, 1), a2 + hstep, voffA);
            PG8_WAIT_V(8); PG8_WAIT_L(0); PG8_BAR; PG8_MMA(0, 0, At, B0); PG8_MMA(0, 1, At, B1); PG8_BAR; PG8_SCHED;
            PG8_LDA(At, 1, 1); PG8_STAGE(PG8_SB(1, 0), b3, voffB); PG8_STAGE(PG8_SB(1, 1), b3 + hstep, voffB); PG8_STAGE(PG8_SA(1, 0), a3, voffA);
            PG8_WAIT_V(8); PG8_WAIT_L(0); PG8_BAR; PG8_MMA(1, 0, At, B0); PG8_MMA(1, 1, At, B1); PG8_BAR; PG8_SCHED;
            } else {
            PG8_LDB(B0, 0, 0); PG8_SCHED; PG8_LDA(At, 0, 0); PG8_STAGE(PG8_SA(1, 1), a1 + hstep, voffA);
            PG8_WAIT_L(8); PG8_BAR; PG8_WAIT_L(0); PG8_MMA(0, 0, At, B0); PG8_BAR; PG8_SCHED;
            PG8_LDB(B1, 0, 1); PG8_STAGE(PG8_SB(0, 0), b2, voffB);
            PG8_BAR; PG8_WAIT_L(0); PG8_MMA(0, 1, At, B1); PG8_BAR;
            PG8_LDA(At, 0, 1); PG8_STAGE(PG8_SA(0, 0), a2, voffA);
            PG8_BAR; PG8_WAIT_L(0); PG8_MMA(1, 0, At, B0); PG8_BAR; PG8_SCHED;
            PG8_STAGE(PG8_SB(0, 1), b2 + hstep, voffB);
            PG8_WAIT_V(6); PG8_BAR; PG8_MMA(1, 1, At, B1); PG8_BAR;
            PG8_LDB(B0, 1, 0); PG8_SCHED; PG8_LDA(At, 1, 0); PG8_STAGE(PG8_SA(0, 1), a2 + hstep, voffA);
            PG8_WAIT_L(8); PG8_BAR; PG8_WAIT_L(0); PG8_MMA(0, 0, At, B0); PG8_BAR; PG8_SCHED;
            PG8_LDB(B1, 1, 1); PG8_STAGE(PG8_SB(1, 0), b3, voffB);
            PG8_BAR; PG8_WAIT_L(0); PG8_MMA(0, 1, At, B1); PG8_BAR;
            PG8_LDA(At, 1, 1); PG8_STAGE(PG8_SA(1, 0), a3, voffA);
            PG8_BAR; PG8_WAIT_L(0); PG8_MMA(1, 0, At, B0); PG8_BAR; PG8_SCHED;
            PG8_STAGE(PG8_SB(1, 1), b3 + hstep, voffB);
            PG8_WAIT_V(6); PG8_BAR; PG8_MMA(1, 1, At, B1); PG8_BAR;
            }
        }
        if constexpr (ALIGN_EPI) { if (wr == 0) PG8_BAR; }
        if constexpr (!Epi::AFTER_DRAIN) { E(acc, cur, wr, wc, fr, fq); S.done(cur); }
        if (!has_next) break;
#pragma unroll
        for (int a = 0; a < 2; ++a)
#pragma unroll
            for (int b = 0; b < 2; ++b)
#pragma unroll
                for (int m = 0; m < 4; ++m)
#pragma unroll
                    for (int n = 0; n < 2; ++n) acc[a][b][m][n] = (f32x4){0.f, 0.f, 0.f, 0.f};
        cur = nxt; cA = nA; cB = nB; ++ui;
        if constexpr (ALIGN_EPI) { if (wr == 1) PG8_BAR; }
    }
    PG8_WAIT_V(0);
    if constexpr (!ALIGN_EPI) { if (wr == 0) PG8_BAR; }
    PG8_BAR;
    if constexpr (Epi::AFTER_DRAIN) { E.fused(acc, cur, wr, wc, fr, fq, lds, wid, lane); S.done(cur); }
#undef PG8_SA
#undef PG8_SB
#undef PG8_STAGE
#undef PG8_LDA
#undef PG8_LDB
#undef PG8_MMA
#undef PG8_WAIT_V
#undef PG8_WAIT_L
#undef PG8_BAR
#undef PG8_SCHED
}
}
#define LAS __attribute__((address_space(3)))
typedef unsigned short bf16;
typedef short bf16x8 __attribute__((ext_vector_type(8)));
typedef short s16x4 __attribute__((ext_vector_type(4)));
typedef float f32x4 __attribute__((ext_vector_type(4)));
typedef float f32x16 __attribute__((ext_vector_type(16)));
typedef unsigned u32x4 __attribute__((ext_vector_type(4)));
typedef unsigned u32x2 __attribute__((ext_vector_type(2)));

constexpr int NB = 8, SEQ = 4096, DM = 1024, DEPTH = 4, NMETA = 16;
constexpr int MREAL = NB * SEQ;
constexpr int META0 = MREAL;
constexpr int MROWS = 129 * 256;
constexpr int NINP = 3328, QP = 3072;
constexpr int C_FQ = 0, C_FK = 512, C_FV = 1024, C_GQ = 1536, C_GK = 1792, C_GV = 2048, C_GR = 2560;
constexpr int DFF = 2816, NUP = 5632;
constexpr float EPS = 1e-6f, LOG2E = 1.4426950408889634f, C2 = 0.125f * LOG2E;
constexpr int CKP = 4160;
constexpr int NCH = 65;

constexpr size_t MiB = 1u << 20;
constexpr size_t WL_IN = 0, WL_OUT = 6815744, WL_UP = 8912896, WL_DN = 20447232, WL_SIZE = 26214400;
constexpr size_t WS_W = 0, WS_HB = 100 * MiB, WS_OB = WS_HB + 67633152, WS_QKV = WS_OB + 67633152, WS_UT = WS_QKV + 202899456;
constexpr size_t WS_SM = WS_UT + 68157440, WS_CK = WS_SM + 4456448, WS_DEC = WS_CK + 1310720, WS_HM = WS_DEC + 786432, WS_SSQ = WS_HM + MiB, WS_END = WS_SSQ + 1835008;
static_assert(WS_END <= 512 * MiB, "workspace map");
constexpr size_t HFL_SIZE = (size_t)129 * 2 * NUP * 4;
static_assert(2 * HFL_SIZE <= 68157440, "halo overlay");

constexpr int LDS_BYTES = 147456, HALO_OFF = 131072;

struct Args {
    const float *x, *meta, *attn_norm, *w_in, *w_au, *b_alpha, *b_forget, *gla_norm, *fox_norm, *w_out, *ffn_norm, *w_up, *conv_w, *conv_b, *w_down, *final_norm;
    float* out; unsigned char* ws;
};

__device__ __forceinline__ const Args* kargs() { const Args* p = (const Args*)__builtin_amdgcn_kernarg_segment_ptr(); asm volatile("" : "+s"(p)); return p; }
__device__ __forceinline__ float bf2f(bf16 v) { return __uint_as_float((unsigned)v << 16); }
__device__ __forceinline__ unsigned pk2(float lo, float hi) { return pg8::cvt_pk_bf16(lo, hi); }
__device__ __forceinline__ bf16 f2bf(float v) { return (bf16)(pk2(v, 0.f) & 0xffffu); }
__device__ __forceinline__ float wave_sum(float v) {
#pragma unroll
    for (int o = 1; o < 64; o <<= 1) v += __shfl_xor(v, o);
    return v;
}
__device__ __forceinline__ float logsigmoidf(float z) { return -(fmaxf(-z, 0.f) + log1pf(__expf(-fabsf(z)))); }
__device__ __forceinline__ float siluf(float v) { return v * __builtin_amdgcn_rcpf(1.f + __builtin_amdgcn_exp2f(-LOG2E * v)); }
__device__ __forceinline__ int crow(int r, int hi) { return (r & 3) + 8 * (r >> 2) + 4 * hi; }
__device__ __forceinline__ s16x4 vtr(const LAS unsigned char* p) { return __builtin_bit_cast(s16x4, __builtin_amdgcn_ds_read_tr16_b64_v4i16((LAS s16x4*)p)); }
__device__ __forceinline__ bf16x8 cat8(s16x4 a, s16x4 b) { return (bf16x8){a[0], a[1], a[2], a[3], b[0], b[1], b[2], b[3]}; }
__device__ __forceinline__ float dppf(float old, float src, int ctrl_unused);
#define DPP_MOV(old, src, ctrl) __builtin_bit_cast(float, __builtin_amdgcn_update_dpp(__builtin_bit_cast(int, (float)(old)), __builtin_bit_cast(int, (float)(src)), (ctrl), 0xf, 0xf, false))
#define LDS_WAIT() asm volatile("s_waitcnt lgkmcnt(0)" ::: "memory")

__device__ __forceinline__ const float* ssq_arr(unsigned char* wsb, int si) { return (const float*)(wsb + WS_SSQ) + (size_t)(si % 3) * MROWS * 4; }
__device__ __forceinline__ float row_rstd(const float* ssqp, int row) { const f32x4 s = *(const f32x4*)(ssqp + (size_t)row * 4); return rsqrtf(((s[0] + s[1]) + (s[2] + s[3])) * (1.0f / DM) + EPS); }
__device__ __forceinline__ LAS float* tile_rstd(const float* ssqp, int pm, int wr, int wc, int fr, int fq) {
    extern __shared__ __attribute__((aligned(16))) unsigned char lds_dyn_[];
    LAS float* rsl = (LAS float*)((LAS unsigned char*)lds_dyn_ + HALO_OFF + 8192);
    const int tl = (wr * 4 + wc) * 64 + fq * 16 + fr;
    if (tl < 256) rsl[tl] = row_rstd(ssqp, pm * 256 + tl);
    asm volatile("s_waitcnt lgkmcnt(0)" ::: "memory"); __builtin_amdgcn_s_barrier(); asm volatile("" ::: "memory");
    return rsl;
}
struct EpiIn {
    static constexpr bool PERM = true, AFTER_DRAIN = false;
    int si;
    __device__ __forceinline__ void operator()(const pg8::f32x4 (&acc)[2][2][4][2], const pg8::Unit& u, int wr, int wc, int fr, int fq) const {
        asm volatile("" : "+v"(fr), "+v"(fq));
        unsigned char* wsb = kargs()->ws;
        bf16* Q = (bf16*)(wsb + WS_QKV); float* SM = (float*)(wsb + WS_SM); const LAS float* rsl = tile_rstd(ssq_arr(wsb, si), u.pm, wr, wc, fr, fq);
#pragma unroll
        for (int ai = 0; ai < 2; ++ai)
#pragma unroll
            for (int m = 0; m < 4; ++m) {
                const int row = u.pm * 256 + ai * 128 + wr * 64 + m * 16 + fr;
                const float rs = rsl[ai * 128 + wr * 64 + m * 16 + fr];
                if (u.pn < 12) {
#pragma unroll
                    for (int bj = 0; bj < 2; ++bj) {
                        const pg8::f32x4 v0 = acc[ai][bj][m][0] * rs, v1 = acc[ai][bj][m][1] * rs;
                        u32x4 w; w.x = pk2(v0[0], v0[1]); w.y = pk2(v0[2], v0[3]); w.z = pk2(v1[0], v1[1]); w.w = pk2(v1[2], v1[3]);
                        *(u32x4*)(Q + (size_t)row * QP + u.pn * 256 + bj * 128 + wc * 32 + 8 * fq) = w;
                    }
                } else if (wc == 0) {
                    *(f32x4*)(SM + (size_t)row * 32 + 8 * fq) = acc[ai][0][m][0] * rs;
                    *(f32x4*)(SM + (size_t)row * 32 + 8 * fq + 4) = acc[ai][0][m][1] * rs;
                }
            }
    }
};
struct EpiRes {
    static constexpr bool PERM = false, AFTER_DRAIN = false;
    int from_x, si;
    __device__ __forceinline__ void operator()(const pg8::f32x4 (&acc)[2][2][4][2], const pg8::Unit& u, int wr, int wc, int fr, int fq) const {
        asm volatile("" : "+v"(fr), "+v"(fq));
        const Args* ka = kargs(); unsigned char* wsb = ka->ws;
        float* out = ka->out; const float* base = from_x ? ka->x : out; float* hmeta = (float*)(wsb + WS_HM); bf16* HB = (bf16*)(wsb + WS_HB); float* ssq_next = (float*)ssq_arr(wsb, si);
        extern __shared__ __attribute__((aligned(16))) unsigned char lds_dyn_[];
        LAS float* red = (LAS float*)((LAS unsigned char*)lds_dyn_ + HALO_OFF);
#pragma unroll
        for (int ai = 0; ai < 2; ++ai)
#pragma unroll
            for (int m = 0; m < 4; ++m) {
                const int row = u.pm * 256 + ai * 128 + wr * 64 + m * 16 + fr;
                const float* bp = row < MREAL ? base + (size_t)row * DM : hmeta + (size_t)(row - MREAL) * DM;
                float* op = row < MREAL ? out + (size_t)row * DM : hmeta + (size_t)(row - MREAL) * DM;
                float ss = 0.f;
#pragma unroll
                for (int bj = 0; bj < 2; ++bj)
#pragma unroll
                    for (int n = 0; n < 2; ++n) {
                        const int col = u.pn * 256 + bj * 128 + wc * 32 + 16 * n + 4 * fq;
                        const f32x4 h = *(const f32x4*)(bp + col) + acc[ai][bj][m][n];
                        *(f32x4*)(op + col) = h;
                        ss += (h[0] * h[0] + h[1] * h[1]) + (h[2] * h[2] + h[3] * h[3]);
                        u32x2 w; w.x = pk2(h[0], h[1]); w.y = pk2(h[2], h[3]);
                        *(u32x2*)(HB + (size_t)row * DM + col) = w;
                    }
                ss += __shfl_xor(ss, 16); ss += __shfl_xor(ss, 32);
                if (fq == 0) red[wc * 256 + ai * 128 + wr * 64 + m * 16 + fr] = ss;
            }
        asm volatile("s_waitcnt lgkmcnt(0)" ::: "memory"); __builtin_amdgcn_s_barrier(); asm volatile("" ::: "memory");
        {
            const int tl = (wr * 4 + wc) * 64 + fq * 16 + fr;
            if (tl < 256) ssq_next[(size_t)(u.pm * 256 + tl) * 4 + u.pn] = (red[tl] + red[256 + tl]) + (red[512 + tl] + red[768 + tl]);
        }
    }
};
struct EpiUp {
    static constexpr bool PERM = true, AFTER_DRAIN = false;
    int L;
    __device__ __forceinline__ void operator()(pg8::f32x4 (&acc)[2][2][4][2], const pg8::Unit& u, int wr, int wc, int fr, int fq) const {
        asm volatile("" : "+v"(fr), "+v"(fq));
        const Args* ka = kargs(); unsigned char* wsb = ka->ws;
        const LAS float* rsl = tile_rstd(ssq_arr(wsb, 2 * L + 1), u.pm, wr, wc, fr, fq); const float* cw = ka->conv_w + (size_t)L * 3 * NUP; const float* cb = ka->conv_b + (size_t)L * NUP;
        extern __shared__ __attribute__((aligned(16))) unsigned char lds_dyn_[];
        LAS float* halo = (LAS float*)((LAS unsigned char*)lds_dyn_ + HALO_OFF);
        const int colw = wc * 32 + 8 * fq;
#pragma unroll
        for (int ai = 0; ai < 2; ++ai)
#pragma unroll
            for (int m = 0; m < 4; ++m) {
                const int row = u.pm * 256 + ai * 128 + wr * 64 + m * 16 + fr;
                const float rs = rsl[ai * 128 + wr * 64 + m * 16 + fr]; (void)row;
#pragma unroll
                for (int bj = 0; bj < 2; ++bj)
#pragma unroll
                    for (int n = 0; n < 2; ++n) acc[ai][bj][m][n] *= rs;
            }
#ifdef SIMPLE_UP
        {
            const int ch0s = u.pn * 128 + colw;
#pragma unroll
            for (int n = 0; n < 2; ++n)
#pragma unroll
                for (int ai = 0; ai < 2; ++ai)
#pragma unroll
                    for (int m = 0; m < 4; ++m) {
                        const int row = u.pm * 256 + ai * 128 + wr * 64 + m * 16 + fr;
                        const f32x4 hu = acc[ai][0][m][n], hg = acc[ai][1][m][n];
                        u32x2 w; w.x = pk2(hu[0] + hg[0], hu[1] + hg[1]); w.y = pk2(hu[2] + hg[2], hu[3] + hg[3]);
                        *(u32x2*)(wsb + (unsigned)(WS_QKV + (unsigned)((row * DFF + ch0s + 4 * n) * 2))) = w;
                    }
            return;
        }
#endif
        if (fr >= 14) {
#pragma unroll
            for (int ai = 0; ai < 2; ++ai)
#pragma unroll
                for (int bj = 0; bj < 2; ++bj)
#pragma unroll
                    for (int n = 0; n < 2; ++n)
                        *(LAS f32x4*)(halo + (((2 * ai + wr) * 2 + (fr - 14)) * 256 + bj * 128 + colw + 4 * n)) = acc[ai][bj][3][n];
        }
        asm volatile("s_waitcnt lgkmcnt(0)" ::: "memory"); __builtin_amdgcn_s_barrier(); asm volatile("" ::: "memory");
        const int ch0 = u.pn * 128 + colw;
        u32x2 wout[2][4][2];
#pragma unroll
        for (int n = 0; n < 2; ++n) {
            f32x4 w0[2], w1[2], w2[2], bb[2];
#pragma unroll
            for (int bj = 0; bj < 2; ++bj) {
                const int c = bj * DFF + ch0 + 4 * n;
                w0[bj] = *(const f32x4*)((const char*)cw + (unsigned)(c * 4)); w1[bj] = *(const f32x4*)((const char*)cw + (unsigned)((NUP + c) * 4)); w2[bj] = *(const f32x4*)((const char*)cw + (unsigned)((2 * NUP + c) * 4)); bb[bj] = *(const f32x4*)((const char*)cb + (unsigned)(c * 4));
            }
#pragma unroll
            for (int ai = 0; ai < 2; ++ai)
#pragma unroll
                for (int m = 0; m < 4; ++m) {
                    const int g = 2 * ai + wr;
                    f32x4 hc[2];
#pragma unroll
                    for (int bj = 0; bj < 2; ++bj) {
                        const int c = bj * DFF + ch0 + 4 * n;
                        const f32x4 cur = acc[ai][bj][m][n];
                        f32x4 pb;
                        if (m > 0) pb = acc[ai][bj][m - 1][n];
                        else pb = *(const LAS f32x4*)(halo + ((((g > 0 ? g - 1 : 0) * 2) + (fr & 1)) * 256 + bj * 128 + colw + 4 * n));
                        f32x4 p1, p2;
#pragma unroll
                        for (int j = 0; j < 4; ++j) {
                            const float t1 = DPP_MOV(0.f, pb[j], 0x121);
                            p1[j] = DPP_MOV(t1, cur[j], 0x111);
                            const float t2 = DPP_MOV(0.f, pb[j], 0x122);
                            p2[j] = DPP_MOV(t2, cur[j], 0x112);
                        }
                        hc[bj] = bb[bj] + w0[bj] * p2 + w1[bj] * p1 + w2[bj] * cur;
                        if (g == 0 && m == 0 && fr < 2) *(f32x4*)(wsb + (unsigned)(WS_UT + (unsigned)(((u.pm * 2 + fr) * NUP + c) * 4))) = cur;
                        if (u.pm == 128 ? (g == 0 && m == 0 && fr >= 14) : (g == 3 && m == 3 && fr >= 14))
                            *(f32x4*)(wsb + (unsigned)(WS_UT + HFL_SIZE + (unsigned)(((u.pm * 2 + fr - 14) * NUP + c) * 4))) = cur;
                    }
                    wout[ai][m][n].x = pk2(siluf(hc[1][0]) * hc[0][0], siluf(hc[1][1]) * hc[0][1]);
                    wout[ai][m][n].y = pk2(siluf(hc[1][2]) * hc[0][2], siluf(hc[1][3]) * hc[0][3]);
                }
        }
#pragma unroll
        for (int ai = 0; ai < 2; ++ai)
#pragma unroll
            for (int m = 0; m < 4; ++m) {
                const int row = u.pm * 256 + ai * 128 + wr * 64 + m * 16 + fr;
                u32x4 w; w.x = wout[ai][m][0].x; w.y = wout[ai][m][0].y; w.z = wout[ai][m][1].x; w.w = wout[ai][m][1].y;
                *(u32x4*)(wsb + (unsigned)(WS_QKV + (unsigned)((row * DFF + ch0) * 2))) = w;
            }
    }
};
__device__ __forceinline__ int win_src(int n) {
    if (n < 512) return 1552 + n;
    if (n < 1024) return 2064 + (n - 512);
    if (n < 1536) return 2576 + (n - 1024);
    if (n < 1792) return n - 1536;
    if (n < 2048) return 256 + (n - 1792);
    if (n < 2560) return 512 + (n - 2048);
    if (n < 3072) return 1024 + (n - 2560);
    if (n < 3088) return 1536 + (n - 3072);
    if (n < 3096) return n;
    return -1;
}
__device__ __forceinline__ void tr_item(const float* W, int Nsrc, bf16* WT, int K, const float* gk, int mode, LAS float* scr, int k0, int n0, int lane) {
    const int nl = lane & 31, n = n0 + nl;
    int src = n; float cs = 1.f;
    if (mode == 0) { src = win_src(n); cs = n < 512 ? C2 : ((n >= 1536 && n < 1792) ? 0.125f : 1.f); }
    else if (mode == 2) { const int pn = n >> 8, j = n & 255; src = j < 128 ? pn * 128 + j : DFF + pn * 128 + (j - 128); }
#pragma unroll 8
    for (int i = 0; i < 32; ++i) {
        const int kk = 2 * i + (lane >> 5);
        float v = 0.f;
        if (src >= 0) v = W[(size_t)(k0 + kk) * Nsrc + src] * cs;
        if (gk) v *= gk[k0 + kk];
        scr[kk * 33 + nl] = v;
    }
    LDS_WAIT(); asm volatile("" ::: "memory");
    const int c = lane & 7;
#pragma unroll
    for (int j = 0; j < 4; ++j) {
        const int nn = (lane >> 3) + 8 * j; const LAS float* s = scr + (8 * c) * 33 + nn;
        u32x4 o; o.x = pk2(s[0 * 33], s[1 * 33]); o.y = pk2(s[2 * 33], s[3 * 33]); o.z = pk2(s[4 * 33], s[5 * 33]); o.w = pk2(s[6 * 33], s[7 * 33]);
        *(u32x4*)(WT + (size_t)(n0 + nn) * K + k0 + 8 * c) = o;
    }
    LDS_WAIT(); asm volatile("" ::: "memory");
}
__device__ __forceinline__ void row_to_bf16(const float* xrow, bf16* orow, float* ssq_slot, float* copy_row, int lane) {
    const f32x4* xr = (const f32x4*)xrow + lane;
    f32x4 v[4]; float s = 0.f;
#pragma unroll
    for (int j = 0; j < 4; ++j) { v[j] = xr[64 * j]; s += (v[j][0] * v[j][0] + v[j][1] * v[j][1]) + (v[j][2] * v[j][2] + v[j][3] * v[j][3]); }
    s = wave_sum(s);
    if (lane == 0) *(f32x4*)ssq_slot = (f32x4){s, 0.f, 0.f, 0.f};
    u32x2* o8 = (u32x2*)orow + lane;
#pragma unroll
    for (int j = 0; j < 4; ++j) { u32x2 w; w.x = pk2(v[j][0], v[j][1]); w.y = pk2(v[j][2], v[j][3]); o8[64 * j] = w; }
    if (copy_row) {
#pragma unroll
        for (int j = 0; j < 4; ++j) ((f32x4*)copy_row + lane)[64 * j] = v[j];
    }
}

__device__ __forceinline__ void gla_u_unit(LAS unsigned char* lds, const bf16* QKV, const float* SM, const float* wau, const float* balpha, float* UT, float* DEC, int bh, int cc) {
    int tid_ = threadIdx.x; asm volatile("" : "+v"(tid_)); const int tid = tid_, lane = tid & 63, wid = __builtin_amdgcn_readfirstlane(tid >> 6), hi = lane >> 5, r32 = lane & 31;
    const int b = bh >> 2, h = bh & 3;
    const int row0 = cc == 0 ? META0 : b * SEQ + (cc - 1) * 64, tvalid = cc == 0 ? NMETA : 64;
    LAS unsigned char* KD = lds;
    LAS unsigned char* VT = lds + 9216;
    LAS float* TOT = (LAS float*)(lds + 9216 + 17408);
    const int dk = lane, sg = wid;
    float w[16];
#pragma unroll
    for (int r = 0; r < 16; ++r) w[r] = wau[r * 256 + h * 64 + dk];
    const float bias = balpha[h * 64 + dk];
    float la[8];
#pragma unroll
    for (int i = 0; i < 8; ++i) {
        const int s = 8 * sg + i;
        const f32x4* g4 = (const f32x4*)(SM + (size_t)(row0 + s) * 32);
        float z = bias;
#pragma unroll
        for (int q = 0; q < 4; ++q) { const f32x4 gv = g4[q]; z += gv[0] * w[4 * q] + gv[1] * w[4 * q + 1] + gv[2] * w[4 * q + 2] + gv[3] * w[4 * q + 3]; }
        la[i] = (s < tvalid) ? logsigmoidf(z) * (1.0f / 16.0f) : 0.f;
    }
#pragma unroll
    for (int i = 1; i < 8; ++i) la[i] += la[i - 1];
    TOT[sg * 64 + dk] = la[7];
#pragma unroll
    for (int i = 0; i < 2; ++i) {
        const int idx = tid + 512 * i, row = idx >> 4, ch = idx & 15;
        const u32x4 v = *(const u32x4*)(QKV + (size_t)(row0 + row) * QP + C_GV + h * 128 + ch * 8);
        *(LAS u32x4*)(VT + row * 272 + ch * 16) = v;
    }
    __syncthreads();
    float pre = 0.f, tot = 0.f;
#pragma unroll
    for (int g2 = 0; g2 < 8; ++g2) { const float t = TOT[g2 * 64 + dk]; if (g2 < sg) pre += t; tot += t; }
    if (sg == 0) DEC[(size_t)(bh * NCH + cc) * 64 + dk] = __expf(tot);
#pragma unroll
    for (int i = 0; i < 8; ++i) {
        const int s = 8 * sg + i;
        const float kf = bf2f(QKV[(size_t)(row0 + s) * QP + C_GK + h * 64 + dk]);
        const float kd = (s < tvalid) ? kf * __expf(tot - (pre + la[i])) : 0.f;
        *(LAS bf16*)(KD + s * 144 + dk * 2) = f2bf(kd);
    }
    __syncthreads();
    const int dvb = wid >> 1, dkb = wid & 1;
    const int qq = (lane & 15) >> 2, pp = lane & 3, half = (lane >> 4) & 1;
    f32x16 acc = {};
#pragma unroll
    for (int j = 0; j < 4; ++j) {
        const LAS unsigned char* ap = VT + (16 * j + 4 * hi + qq) * 272 + (32 * dvb + 16 * half + 4 * pp) * 2;
        const LAS unsigned char* bp = KD + (16 * j + 4 * hi + qq) * 144 + (32 * dkb + 16 * half + 4 * pp) * 2;
        const bf16x8 af = cat8(vtr(ap), vtr(ap + 8 * 272));
        const bf16x8 bfr = cat8(vtr(bp), vtr(bp + 8 * 144));
        acc = __builtin_amdgcn_mfma_f32_32x32x16_bf16(af, bfr, acc, 0, 0, 0);
    }
    float* up = UT + ((size_t)(bh * NCH + cc) * 128 + 32 * dvb) * 64 + 32 * dkb + r32;
#pragma unroll
    for (int r = 0; r < 16; ++r) up[crow(r, hi) * 64] = acc[r];
    __syncthreads();
}
__device__ __forceinline__ void fox_cumsum_unit(LAS unsigned char* lds, const float* SM, const float* bforget, float* CK, int bh) {
    int tid_ = threadIdx.x; asm volatile("" : "+v"(tid_)); const int tid = tid_, lane = tid & 63, wid = tid >> 6;
    const int b = bh >> 3, h = bh & 7;
    const float bf_ = bforget[h];
    LAS float* WT_ = (LAS float*)lds;
    float mtot = 0.f, mine = 0.f;
    for (int p = 0; p < NMETA; ++p) { mtot += logsigmoidf(SM[(size_t)(META0 + p) * 32 + 16 + h] + bf_); if (tid == p) mine = mtot; }
    if (tid < 64) CK[(size_t)bh * CKP + tid] = tid < NMETA ? -LOG2E * mine : -INFINITY;
    float v[8]; float run = 0.f;
#pragma unroll
    for (int i = 0; i < 8; ++i) { run += logsigmoidf(SM[(size_t)(b * SEQ + 8 * tid + i) * 32 + 16 + h] + bf_); v[i] = run; }
    float inc = run;
#pragma unroll
    for (int o = 1; o < 64; o <<= 1) { const float t = __shfl_up(inc, o); if (lane >= o) inc += t; }
    if (lane == 63) WT_[wid] = inc;
    __syncthreads();
    float off = mtot + (inc - run);
    for (int w2 = 0; w2 < wid; ++w2) off += WT_[w2];
#pragma unroll
    for (int i = 0; i < 8; ++i) CK[(size_t)bh * CKP + 64 + 8 * tid + i] = -LOG2E * (off + v[i]);
    __syncthreads();
}

__device__ __forceinline__ void attn_unit(LAS unsigned char* lds, const bf16* QKV, const float* CK, bf16* OB, const float* fnorm, int b, int h, int qb) {
    int tid_ = threadIdx.x; asm volatile("" : "+v"(tid_)); const int tid = tid_, lane = tid & 63, wid = __builtin_amdgcn_readfirstlane(tid >> 6), r32 = lane & 31, hi = lane >> 5;
    constexpr int KB = 9216, KOFF = 0, VOFF = 2 * KB, COFF = 4 * KB, WOFF = COFF + 512;
    LAS float* wsf = (LAS float*)(lds + WOFF) + wid * 64;
    const size_t rowb = (size_t)b * SEQ; const int q0 = qb * 256;
    const int NT = 1 + 4 * (qb + 1);
    const bf16* qp = QKV + (rowb + q0 + wid * 32 + r32) * QP + C_FQ + h * 64 + hi * 8;
    bf16x8 qr[4];
#pragma unroll
    for (int d0 = 0; d0 < 4; ++d0) qr[d0] = *(const bf16x8*)(qp + d0 * 16);
    const int srow = tid >> 3, sch = tid & 7;
    const float* ckp = CK + (size_t)(b * 8 + h) * CKP;
    u32x4 kreg, vreg; float creg = 0.f;
#define ATT_LOAD(t) do { const size_t r0_ = (t) == 0 ? (size_t)META0 : rowb + (size_t)((t) - 1) * 64; const bf16* p_ = QKV + (r0_ + srow) * QP + h * 64 + sch * 8; \
        kreg = *(const u32x4*)(p_ + C_FK); vreg = *(const u32x4*)(p_ + C_FV); if (tid < 64) creg = ckp[(t) * 64 + tid]; } while (0)
#define ATT_STORE(buf) do { *(LAS u32x4*)(lds + KOFF + (buf) * KB + srow * 144 + sch * 16) = kreg; *(LAS u32x4*)(lds + VOFF + (buf) * KB + srow * 144 + sch * 16) = vreg; \
        if (tid < 64) *(LAS float*)(lds + COFF + (buf) * 256 + tid * 4) = creg; } while (0)
    float m = -1e30f, l = 0.f; f32x16 o0 = {}, o1 = {};
    const int qrel = 32 * wid + r32;
    const int qq = (lane & 15) >> 2, pp = lane & 3, half = (lane >> 4) & 1;
    ATT_LOAD(0); ATT_STORE(0);
    for (int t = 0; t < NT; ++t) {
        const int buf = t & 1;
        if (t + 1 < NT) ATT_LOAD(t + 1);
        __syncthreads();
        const int jb = t - (NT - 4);
        const bool skip = (jb >= 0) && (64 * jb > 32 * wid + 31);
        if (!skip) {
            const LAS unsigned char* Kb = lds + KOFF + buf * KB; const LAS unsigned char* Vb = lds + VOFF + buf * KB; const LAS float* Cb = (const LAS float*)(lds + COFF + buf * 256);
            f32x16 p0 = {}, p1 = {};
#pragma unroll
            for (int d0 = 0; d0 < 4; ++d0) {
                const bf16x8 a0 = *(const LAS bf16x8*)(Kb + r32 * 144 + (16 * d0 + 8 * hi) * 2);
                const bf16x8 a1 = *(const LAS bf16x8*)(Kb + (32 + r32) * 144 + (16 * d0 + 8 * hi) * 2);
                p0 = __builtin_amdgcn_mfma_f32_32x32x16_bf16(a0, qr[d0], p0, 0, 0, 0);
                p1 = __builtin_amdgcn_mfma_f32_32x32x16_bf16(a1, qr[d0], p1, 0, 0, 0);
            }
#pragma unroll
            for (int g = 0; g < 4; ++g) {
                const f32x4 c0 = *(const LAS f32x4*)(Cb + 8 * g + 4 * hi), c1 = *(const LAS f32x4*)(Cb + 32 + 8 * g + 4 * hi);
#pragma unroll
                for (int i = 0; i < 4; ++i) { p0[4 * g + i] += c0[i]; p1[4 * g + i] += c1[i]; }
            }
            if (jb >= 0 && 64 * jb + 63 > 32 * wid) {
#pragma unroll
                for (int r = 0; r < 16; ++r) { const int kv = 64 * jb + crow(r, hi); if (kv > qrel) p0[r] = -INFINITY; if (kv + 32 > qrel) p1[r] = -INFINITY; }
            }
            float mx = fmaxf(p0[0], p1[0]);
#pragma unroll
            for (int r = 1; r < 16; ++r) mx = fmaxf(mx, fmaxf(p0[r], p1[r]));
            mx = fmaxf(mx, __shfl_xor(mx, 32));
            const float mn = fmaxf(m, mx);
            const float alpha = __builtin_amdgcn_exp2f(m - mn);
            m = mn;
            float rsum = 0.f;
#pragma unroll
            for (int r = 0; r < 16; ++r) { p0[r] = __builtin_amdgcn_exp2f(p0[r] - mn); p1[r] = __builtin_amdgcn_exp2f(p1[r] - mn); rsum += p0[r] + p1[r]; }
            l = l * alpha + rsum;
            if (hi == 0) wsf[r32] = alpha;
            LDS_WAIT();
#pragma unroll
            for (int g = 0; g < 4; ++g) {
                const f32x4 a = *(const LAS f32x4*)(wsf + 8 * g + 4 * hi);
#pragma unroll
                for (int i = 0; i < 4; ++i) { o0[4 * g + i] *= a[i]; o1[4 * g + i] *= a[i]; }
            }
            bf16x8 pa[4];
            { u32x4 w;
              w.x = pk2(p0[0], p0[1]); w.y = pk2(p0[2], p0[3]); w.z = pk2(p0[4], p0[5]); w.w = pk2(p0[6], p0[7]); pa[0] = __builtin_bit_cast(bf16x8, w);
              w.x = pk2(p0[8], p0[9]); w.y = pk2(p0[10], p0[11]); w.z = pk2(p0[12], p0[13]); w.w = pk2(p0[14], p0[15]); pa[1] = __builtin_bit_cast(bf16x8, w);
              w.x = pk2(p1[0], p1[1]); w.y = pk2(p1[2], p1[3]); w.z = pk2(p1[4], p1[5]); w.w = pk2(p1[6], p1[7]); pa[2] = __builtin_bit_cast(bf16x8, w);
              w.x = pk2(p1[8], p1[9]); w.y = pk2(p1[10], p1[11]); w.z = pk2(p1[12], p1[13]); w.w = pk2(p1[14], p1[15]); pa[3] = __builtin_bit_cast(bf16x8, w); }
#pragma unroll
            for (int j = 0; j < 4; ++j) {
                const LAS unsigned char* vp = Vb + (16 * j + 4 * hi + qq) * 144 + (16 * half + 4 * pp) * 2;
                const bf16x8 v0 = cat8(vtr(vp), vtr(vp + 8 * 144));
                const bf16x8 v1 = cat8(vtr(vp + 64), vtr(vp + 64 + 8 * 144));
                o0 = __builtin_amdgcn_mfma_f32_32x32x16_bf16(pa[j], v0, o0, 0, 0, 0);
                o1 = __builtin_amdgcn_mfma_f32_32x32x16_bf16(pa[j], v1, o1, 0, 0, 0);
            }
        }
        if (t + 1 < NT) ATT_STORE(buf ^ 1);
    }
#undef ATT_LOAD
#undef ATT_STORE
    l += __shfl_xor(l, 32);
    if (hi == 0) wsf[r32] = 1.0f / l;
    LDS_WAIT();
#pragma unroll
    for (int g = 0; g < 4; ++g) {
        const f32x4 a = *(const LAS f32x4*)(wsf + 8 * g + 4 * hi);
#pragma unroll
        for (int i = 0; i < 4; ++i) { o0[4 * g + i] *= a[i]; o1[4 * g + i] *= a[i]; }
    }
    const float w0 = fnorm[h * 64 + r32], w1 = fnorm[h * 64 + 32 + r32];
#pragma unroll
    for (int r = 0; r < 16; ++r) {
        float s = o0[r] * o0[r] + o1[r] * o1[r];
        s += __shfl_xor(s, 1); s += __shfl_xor(s, 2); s += __shfl_xor(s, 4); s += __shfl_xor(s, 8); s += __shfl_xor(s, 16);
        const float rs = rsqrtf(s * (1.0f / 64.0f) + EPS);
        bf16* op = OB + (rowb + q0 + wid * 32 + crow(r, hi)) * DM + 512 + h * 64 + r32;
        op[0] = f2bf(o0[r] * rs * w0); op[32] = f2bf(o1[r] * rs * w1);
    }
    __syncthreads();
}
__device__ __forceinline__ void meta_attn(const bf16* QKV, const float* CK, bf16* OB, const float* fnorm, int p) {
    int tid_ = threadIdx.x; asm volatile("" : "+v"(tid_)); const int lane = tid_ & 63, h = tid_ >> 6;
    const float q = bf2f(QKV[(size_t)(META0 + p) * QP + C_FQ + h * 64 + lane]);
    float sc[NMETA], vv[NMETA];
#pragma unroll
    for (int s = 0; s < NMETA; ++s) {
        sc[s] = q * bf2f(QKV[(size_t)(META0 + s) * QP + C_FK + h * 64 + lane]);
        vv[s] = bf2f(QKV[(size_t)(META0 + s) * QP + C_FV + h * 64 + lane]);
    }
    float m = -1e30f;
#pragma unroll
    for (int s = 0; s < NMETA; ++s) { sc[s] = (s <= p) ? wave_sum(sc[s]) + CK[(size_t)h * CKP + s] : -INFINITY; m = fmaxf(m, sc[s]); }
    float l = 0.f, o = 0.f;
#pragma unroll
    for (int s = 0; s < NMETA; ++s) { const float pw = __builtin_amdgcn_exp2f(sc[s] - m); l += pw; o += pw * vv[s]; }
    o /= l;
    const float ss = wave_sum(o * o);
    OB[(size_t)(META0 + p) * DM + 512 + h * 64 + lane] = f2bf(o * rsqrtf(ss * (1.0f / 64.0f) + EPS) * fnorm[h * 64 + lane]);
}
__device__ __forceinline__ void gla_readout_wave(const bf16* QKV, const float* UT, bf16* OB, const float* gnorm, int wu, int lane) {
    asm volatile("" : "+v"(lane));
    const int half = wu & 1, t = wu >> 1, cc = t % NCH, bh = t / NCH, b = bh >> 2, h = bh & 3;
    if (cc == 0 && (half == 1 || b != 0)) return;
    const int r32 = lane & 31, hi = lane >> 5;
    const int row0 = cc == 0 ? META0 : b * SEQ + (cc - 1) * 64 + 32 * half, nvalid = cc == 0 ? NMETA : 32;
    const float* Sp = UT + (size_t)(bh * NCH + cc) * 8192;
    f32x16 acc[4] = {};
#pragma unroll
    for (int j = 0; j < 4; ++j) {
        const bf16x8 bq = *(const bf16x8*)(QKV + (size_t)(row0 + r32) * QP + C_GQ + h * 64 + 16 * j + 8 * hi);
#pragma unroll
        for (int blk = 0; blk < 4; ++blk) {
            const float* sp = Sp + (32 * blk + r32) * 64 + 16 * j + 8 * hi;
            const f32x4 s0 = *(const f32x4*)sp, s1 = *(const f32x4*)(sp + 4);
            u32x4 w; w.x = pk2(s0[0], s0[1]); w.y = pk2(s0[2], s0[3]); w.z = pk2(s1[0], s1[1]); w.w = pk2(s1[2], s1[3]);
            acc[blk] = __builtin_amdgcn_mfma_f32_32x32x16_bf16(__builtin_bit_cast(bf16x8, w), bq, acc[blk], 0, 0, 0);
        }
    }
    float ss = 0.f;
#pragma unroll
    for (int blk = 0; blk < 4; ++blk)
#pragma unroll
        for (int r = 0; r < 16; ++r) ss += acc[blk][r] * acc[blk][r];
    ss += __shfl_xor(ss, 32);
    const float rs = rsqrtf(ss * (1.0f / 128.0f) + EPS);
    if (r32 < nvalid) {
        const size_t row = (size_t)row0 + r32;
#pragma unroll
        for (int blk = 0; blk < 4; ++blk)
#pragma unroll
            for (int g = 0; g < 4; ++g) {
                const int dv = 32 * blk + 8 * g + 4 * hi;
                const u32x2 gt = *(const u32x2*)(QKV + row * QP + C_GR + h * 128 + dv);
                const f32x4 wn = *(const f32x4*)(gnorm + h * 128 + dv);
                const float g0 = __uint_as_float(gt.x << 16), g1 = __uint_as_float(gt.x & 0xffff0000u), g2 = __uint_as_float(gt.y << 16), g3 = __uint_as_float(gt.y & 0xffff0000u);
                u32x2 w;
                w.x = pk2(acc[blk][4 * g] * rs * wn[0] * siluf(g0), acc[blk][4 * g + 1] * rs * wn[1] * siluf(g1));
                w.y = pk2(acc[blk][4 * g + 2] * rs * wn[2] * siluf(g2), acc[blk][4 * g + 3] * rs * wn[3] * siluf(g3));
                *(u32x2*)(OB + row * DM + h * 128 + dv) = w;
            }
    }
}

#define FRESH() const Args& a = *kargs(); unsigned char* ws = a.ws; \
    bf16* HB = (bf16*)(ws + WS_HB); bf16* OB = (bf16*)(ws + WS_OB); bf16* QKV = (bf16*)(ws + WS_QKV); bf16* A2 = (bf16*)(ws + WS_QKV); \
    float* UT = (float*)(ws + WS_UT); float* HF = (float*)(ws + WS_UT); float* HL = (float*)(ws + WS_UT + HFL_SIZE); \
    float* SM = (float*)(ws + WS_SM); float* CK = (float*)(ws + WS_CK); float* DEC = (float*)(ws + WS_DEC); float* HM = (float*)(ws + WS_HM); float* SSQ = (float*)(ws + WS_SSQ); \
    unsigned char* wl = ws + WS_W + (size_t)L * WL_SIZE; \
    (void)HB; (void)OB; (void)QKV; (void)A2; (void)UT; (void)HF; (void)HL; (void)SM; (void)CK; (void)DEC; (void)HM; (void)SSQ; (void)wl; \
    int tid_ = threadIdx.x; asm volatile("" : "+v"(tid_)); const int tid = tid_, lane = tid & 63, wid = __builtin_amdgcn_readfirstlane(tid >> 6); \
    const int gw = bx * 8 + wid, NGW = G * 8, gt = bx * 512 + tid, NGT = G * 512; (void)lane; (void)gw; (void)NGW; (void)gt; (void)NGT;
#ifndef REP_A
#define REP_A 1
#endif
#ifndef REP_CA
#define REP_CA 1
#endif
#ifndef REP_F
#define REP_F 1
#endif
#ifndef REP_B
#define REP_B 1
#endif
#ifndef REP_D
#define REP_D 1
#endif
#define GSYNC() do { asm volatile("s_waitcnt vmcnt(0) lgkmcnt(0)" ::: "memory"); grid.sync(); __builtin_amdgcn_fence(__ATOMIC_ACQUIRE, "agent"); asm volatile("s_waitcnt vmcnt(0)" ::: "memory"); } while (0)
__global__ void __launch_bounds__(512, 2) fwd_kernel(Args a_unused) {
    extern __shared__ __attribute__((aligned(16))) unsigned char lds_raw[];
    LAS unsigned char* lds = (LAS unsigned char*)lds_raw;
    cg::grid_group grid = cg::this_grid();
    const int G = gridDim.x, bx = blockIdx.x;
    {
        const int L = 0; FRESH();
        LAS float* scr = (LAS float*)(lds + wid * 16384);
        constexpr int I_IN = 16 * (NINP / 32), I_OUT = 16 * 32, I_UP = 16 * (NUP / 32), I_DN = (DFF / 64) * 32, I_L = I_IN + I_OUT + I_UP + I_DN;
        for (int it = gw; it < DEPTH * I_L; it += NGW) {
            const int L = it / I_L; int r = it % I_L;
            unsigned char* wl = ws + WS_W + (size_t)L * WL_SIZE;
            if (r < I_IN) { const int nb = NINP / 32; tr_item(a.w_in + (size_t)L * DM * 3096, 3096, (bf16*)(wl + WL_IN), DM, a.attn_norm + L * DM, 0, scr, 64 * (r / nb), 32 * (r % nb), lane); continue; } r -= I_IN;
            if (r < I_OUT) { tr_item(a.w_out + (size_t)L * DM * DM, DM, (bf16*)(wl + WL_OUT), DM, nullptr, 1, scr, 64 * (r / 32), 32 * (r % 32), lane); continue; } r -= I_OUT;
            if (r < I_UP) { const int nb = NUP / 32; tr_item(a.w_up + (size_t)L * DM * NUP, NUP, (bf16*)(wl + WL_UP), DM, a.ffn_norm + L * DM, 2, scr, 64 * (r / nb), 32 * (r % nb), lane); continue; } r -= I_UP;
            tr_item(a.w_down + (size_t)L * DFF * DM, DM, (bf16*)(wl + WL_DN), DFF, nullptr, 3, scr, 64 * (r / 32), 32 * (r % 32), lane);
        }
        for (int i = gt; i < (256 - NMETA) * 4; i += NGT) SSQ[(size_t)(META0 + NMETA) * 4 + i] = 0.f;
        for (int r = gw; r < MREAL + 256; r += NGW) {
            if (r < MREAL) row_to_bf16(a.x + (size_t)r * DM, HB + (size_t)r * DM, SSQ + (size_t)r * 4, nullptr, lane);
            else if (r < MREAL + NMETA) row_to_bf16(a.meta + (size_t)(r - MREAL) * DM, HB + (size_t)r * DM, SSQ + (size_t)r * 4, HM + (size_t)(r - MREAL) * DM, lane);
            else {
#pragma unroll
                for (int j = 0; j < 4; ++j) { ((f32x4*)(HM + (size_t)(r - MREAL) * DM) + lane)[64 * j] = (f32x4){0.f, 0.f, 0.f, 0.f};
                    ((u32x2*)(HB + (size_t)r * DM) + lane)[64 * j] = (u32x2){0u, 0u}; ((u32x2*)(OB + (size_t)r * DM) + lane)[64 * j] = (u32x2){0u, 0u}; }
            }
        }
    }
    GSYNC();

    for (int L = 0; L < DEPTH; ++L) {
#ifndef SKIP_A
        {
            FRESH();
            pg8::Gemm g{HB, (const bf16*)(wl + WL_IN), MROWS, NINP, DM}; pg8::StaticOrder S; S.init(MROWS, NINP, G, bx);
            EpiIn E{2 * L};
            for (int rep = 0; rep < REP_A; ++rep) pg8::gemm_phase<EpiIn, pg8::StaticOrder, true, true>(lds, g, S, E);
        }
#endif
        GSYNC();
#ifndef SKIP_B
        { FRESH();
        for (int rep = 0; rep < REP_B; ++rep)
        for (int u = bx; u < 32 * NCH + 64; u += G) {
            if (u < 32 * NCH) gla_u_unit(lds, QKV, SM, a.w_au + (size_t)L * 16 * 256, a.b_alpha + L * 256, UT, DEC, u / NCH, u % NCH);
            else fox_cumsum_unit(lds, SM, a.b_forget + L * 8, CK, u - 32 * NCH);
        }
        }
#endif
        GSYNC();
#ifndef SKIP_CS
        { FRESH();
        for (int e = gt; e < 32 * 8192; e += NGT) {
            const int bh = e >> 13, rem = e & 8191, dk = rem & 63;
            float* up = UT + (size_t)bh * NCH * 8192 + rem; const float* dp = DEC + (size_t)bh * NCH * 64 + dk;
            float Sv = up[0];
            for (int c0 = 1; c0 <= 64; c0 += 8) {
                float uu[8], dd[8];
#pragma unroll
                for (int i = 0; i < 8; ++i) { uu[i] = up[(size_t)(c0 + i) * 8192]; dd[i] = dp[(c0 + i) * 64]; }
#pragma unroll
                for (int i = 0; i < 8; ++i) { Sv = dd[i] * Sv + uu[i]; up[(size_t)(c0 + i) * 8192] = Sv; }
            }
        }
#endif
#ifndef SKIP_CA
        }
        { FRESH();
        for (int rep = 0; rep < REP_CA; ++rep)
        for (int v = bx; v < 256; v += G) {
            const int bhh = v >> 2, s = v & 3;
#pragma unroll 1
            for (int i = 0; i < 4; ++i) {
                const int qb = (i == 0) ? s : (i == 1) ? 7 - s : (i == 2) ? 8 + s : 15 - s;
                attn_unit(lds, QKV, CK, OB, a.fox_norm + L * 512, bhh >> 3, bhh & 7, qb);
            }
        }
#endif
#ifndef SKIP_CM
        }
        { FRESH();
#ifndef REP_CM
#define REP_CM 1
#endif
        for (int rep = 0; rep < REP_CM; ++rep)
        if (bx < NMETA) meta_attn(QKV, CK, OB, a.fox_norm + L * 512, bx);
        }
#endif
        GSYNC();
#ifndef SKIP_D
        { FRESH();
        for (int rep = 0; rep < REP_D; ++rep)
        for (int wu = gw; wu < 32 * NCH * 2; wu += NGW) gla_readout_wave(QKV, UT, OB, a.gla_norm + L * 512, wu, lane);
        }
#endif
        GSYNC();
#ifndef SKIP_E
        {
            FRESH();
            pg8::Gemm g{OB, (const bf16*)(wl + WL_OUT), MROWS, DM, DM}; pg8::StaticOrder S; S.init(MROWS, DM, G, bx);
            EpiRes E{L == 0 ? 1 : 0, 2 * L + 1};
            pg8::gemm_phase<EpiRes, pg8::StaticOrder, true, true>(lds, g, S, E);
        }
#endif
        GSYNC();
#ifndef SKIP_F
        {
            FRESH();
            pg8::Gemm g{HB, (const bf16*)(wl + WL_UP), MROWS, NUP, DM}; pg8::StaticOrder S; S.init(MROWS, NUP, G, bx);
            EpiUp E{L};
            for (int rep = 0; rep < REP_F; ++rep) pg8::gemm_phase<EpiUp, pg8::StaticOrder, true, true>(lds, g, S, E);
        }
#endif
        GSYNC();
#ifndef SKIP_G
        {
            FRESH();
            const float* cw = a.conv_w + (size_t)L * 3 * NUP; const float* cb = a.conv_b + (size_t)L * NUP;
            for (int i = gt; i < 129 * 2 * (DFF / 4); i += NGT) {
                const int c4 = i % (DFF / 4), rr = (i / (DFF / 4)) & 1, pm = i / (2 * (DFF / 4));
                const int ch = 4 * c4;
                f32x4 hc[2];
#pragma unroll
                for (int bj = 0; bj < 2; ++bj) {
                    const int c = bj * DFF + ch;
                    f32x4 P0 = {0.f, 0.f, 0.f, 0.f}, P1 = P0;
                    if (pm != 128) { const int src = (pm % 16 == 0) ? 128 : pm - 1; P0 = *(const f32x4*)(HL + (size_t)(src * 2) * NUP + c); P1 = *(const f32x4*)(HL + (size_t)(src * 2 + 1) * NUP + c); }
                    const f32x4 H0 = *(const f32x4*)(HF + (size_t)(pm * 2) * NUP + c), H1 = *(const f32x4*)(HF + (size_t)(pm * 2 + 1) * NUP + c);
                    const f32x4 x2 = rr == 0 ? P0 : P1, x1 = rr == 0 ? P1 : H0, x0 = rr == 0 ? H0 : H1;
                    hc[bj] = *(const f32x4*)(cb + c) + *(const f32x4*)(cw + c) * x2 + *(const f32x4*)(cw + NUP + c) * x1 + *(const f32x4*)(cw + 2 * NUP + c) * x0;
                }
                u32x2 w;
                w.x = pk2(siluf(hc[1][0]) * hc[0][0], siluf(hc[1][1]) * hc[0][1]);
                w.y = pk2(siluf(hc[1][2]) * hc[0][2], siluf(hc[1][3]) * hc[0][3]);
                *(u32x2*)(A2 + (size_t)(pm * 256 + rr) * DFF + ch) = w;
            }
        }
#endif
        GSYNC();
#ifndef SKIP_H
        {
            FRESH();
            pg8::Gemm g{A2, (const bf16*)(wl + WL_DN), MROWS, DM, DFF}; pg8::StaticOrder S; S.init(MROWS, DM, G, bx);
            EpiRes E{0, 2 * L + 2};
            pg8::gemm_phase<EpiRes, pg8::StaticOrder, true, true>(lds, g, S, E);
        }
#endif
        GSYNC();
    }
    {
        const int L = 0; FRESH();
        const float* ssq = ssq_arr(ws, 8);
        for (int r = gw; r < MREAL; r += NGW) {
            const float rs = row_rstd(ssq, r);
            f32x4* p = (f32x4*)(a.out + (size_t)r * DM) + lane; const f32x4* wn = (const f32x4*)a.final_norm + lane;
#pragma unroll
            for (int j = 0; j < 4; ++j) p[64 * j] = p[64 * j] * rs * wn[64 * j];
        }
    }
}

extern "C" void kernel_launch(void* const* d_in, const int* in_sizes, int n_in, void* d_out, int out_size, void* d_ws, size_t ws_size, hipStream_t stream) {
    static int grid = 0;
    if (grid == 0) {
        if (n_in != 16 || out_size != MREAL * DM || ws_size < WS_END) { fprintf(stderr, "kernel_launch: unexpected problem (n_in %d out %d ws %zu, need %zu)\n", n_in, out_size, ws_size, (size_t)WS_END); grid = -1; return; }
        int dev = 0, cus = 0, per = 0;
        (void)hipGetDevice(&dev); (void)hipDeviceGetAttribute(&cus, hipDeviceAttributeMultiprocessorCount, dev);
        (void)hipFuncSetAttribute((const void*)fwd_kernel, hipFuncAttributeMaxDynamicSharedMemorySize, LDS_BYTES);
        (void)hipOccupancyMaxActiveBlocksPerMultiprocessor(&per, (const void*)fwd_kernel, 512, LDS_BYTES);
        if (per < 1) per = 1;
        grid = cus * per;
        fprintf(stderr, "kernel_launch: grid %d (cus %d x %d), ws %zu\n", grid, cus, per, ws_size);
    }
    if (grid < 0) return;
    Args a{};
    const float** f = (const float**)&a;
    for (int i = 0; i < 16; ++i) f[i] = (const float*)d_in[i];
    a.out = (float*)d_out; a.ws = (unsigned char*)d_ws;
    void* args[] = {&a};
    hipError_t e = hipLaunchCooperativeKernel((const void*)fwd_kernel, dim3(grid), dim3(512), args, LDS_BYTES, stream);
    if (e != hipSuccess) fprintf(stderr, "cooperative launch failed: %s (grid %d)\n", hipGetErrorString(e), grid);
}
```

```cpp
#include <hip/hip_runtime.h>
#include <hip/hip_cooperative_groups.h>
#include <cstdio>
#include <cstdint>
namespace cg = cooperative_groups;
namespace pg8 {
#define PG8_LAS __attribute__((address_space(3)))
typedef unsigned short bf16_t;
typedef short bf16x8 __attribute__((ext_vector_type(8)));
typedef float f32x4 __attribute__((ext_vector_type(4)));
typedef unsigned u32x4 __attribute__((ext_vector_type(4)));
constexpr int BM = 256, BK = 64, HALF = 128, HTB = HALF * BK * 2  , STAGE_BYTES = 8 * HTB, NXCD = 8, WGM = 8;

__host__ __device__ __forceinline__ int lds_byte(int r, int c) { const int st = (r >> 4) * 2 + (c >> 5), rr = r & 15, cc = c & 31, ob = rr * 64 + cc * 2; return st * 1024 + (ob ^ (((ob >> 9) & 1) << 5)); }
__host__ __device__ __forceinline__ void stage_rc(int b, int& R, int& C) { const int st = b / 1024, sb = b % 1024, swz = sb ^ (((sb >> 9) & 1) << 5); R = (st >> 1) * 16 + swz / 64; C = (st & 1) * 32 + (swz % 64) / 2; }
__host__ __device__ __forceinline__ int perm32(int rho) { const int n = rho >> 4, i = rho & 15; return 8 * (i >> 2) + 4 * n + (i & 3); }

struct Unit { int pm, pn; };
struct Gemm { const bf16_t* A; const bf16_t* Bt; int M, N, K; };

struct StaticOrder {
    int nM, nN, nwg, G, c;
    __host__ __device__ void init(int M, int N, int G_, int c_) { nM = M / BM; nN = N / BM; nwg = nM * nN; G = G_; c = c_; }
    __host__ __device__ bool next(int i, Unit& u) const {
        const long L = (long)i * G + c; if (L >= nwg) return false;
        int wgid = (int)L; { const int q = nwg / NXCD, r = nwg % NXCD, xcd = wgid % NXCD, off = wgid / NXCD; wgid = (xcd < r ? xcd * (q + 1) : r * (q + 1) + (xcd - r) * q) + off; }
        const int nig = WGM * nN, gid = wgid / nig, fm = gid * WGM, gsz = (nM - fm) < WGM ? (nM - fm) : WGM;
        u.pm = fm + ((wgid % nig) % gsz); u.pn = (wgid % nig) / gsz; return true;
    }
    __device__ __forceinline__ void a_ready(const Unit&) const {}
    __device__ __forceinline__ void done(const Unit&) const {}
};

__device__ __forceinline__ unsigned cvt_pk_bf16(float lo, float hi) { unsigned r; asm volatile("v_cvt_pk_bf16_f32 %0, %1, %2" : "=v"(r) : "v"(lo), "v"(hi)); return r; }
typedef float f32x2 __attribute__((ext_vector_type(2)));
template <class Epi, class Sched, bool ALIGN_EPI = false, bool SP2 = false>
__device__ __forceinline__ void gemm_phase(PG8_LAS unsigned char* lds, const Gemm g, const Sched& S, const Epi& E) {
    int tid_ = threadIdx.x; asm volatile("" : "+v"(tid_)); const int tid = tid_, wid = __builtin_amdgcn_readfirstlane(tid >> 6), lane = tid & 63, wr = wid >> 2, wc = wid & 3, fr = lane & 15, fq = lane >> 4;
    const int K = g.K, nt = K / BK;
    unsigned voffA[2], voffB[2];
#pragma unroll
    for (int i = 0; i < 2; ++i) { int R, C; stage_rc(tid * 16 + i * 8192, R, C); const int Rb = Epi::PERM ? ((R & ~31) + perm32(R & 31)) : R;
        voffA[i] = (unsigned)(R * K + C) * 2u; voffB[i] = (unsigned)(Rb * K + C) * 2u; }
    const size_t kstep = (size_t)(BK * 2);
    const size_t hstep = (size_t)HALF * K * 2;
    const size_t tstep = 2 * hstep;
    const unsigned ldsw = (unsigned)wid * 1024u;
    const int aoff = lds_byte(wr * 64 + fr, fq * 8), boff = lds_byte(wc * 32 + fr, fq * 8);
#define PG8_SA(b, h) (((b) * 2 + (h)) * HTB)
#define PG8_SB(b, h) ((4 + (b) * 2 + (h)) * HTB)
#define PG8_STAGE(bufoff, gbase, voff) do { _Pragma("unroll") for (int _i = 0; _i < 2; ++_i) \
        __builtin_amdgcn_global_load_lds((const unsigned*)((const char*)(gbase) + (voff)[_i]), (PG8_LAS unsigned*)(lds + (bufoff) + ldsw + _i * 8192), 16, 0, 0); } while (0)
#define PG8_LDA(dst, b, h) do { _Pragma("unroll") for (int m = 0; m < 4; ++m) _Pragma("unroll") for (int k = 0; k < 2; ++k) dst[m][k] = *(const PG8_LAS bf16x8*)(lds + PG8_SA(b, h) + aoff + m * 2048 + k * 1024); } while (0)
#define PG8_LDB(dst, b, h) do { _Pragma("unroll") for (int n = 0; n < 2; ++n) _Pragma("unroll") for (int k = 0; k < 2; ++k) dst[n][k] = *(const PG8_LAS bf16x8*)(lds + PG8_SB(b, h) + boff + n * 2048 + k * 1024); } while (0)
#define PG8_MMA(ai, bj, At, Bt) do { __builtin_amdgcn_s_setprio(1); _Pragma("unroll") for (int m = 0; m < 4; ++m) _Pragma("unroll") for (int n = 0; n < 2; ++n) _Pragma("unroll") for (int k = 0; k < 2; ++k) \
        acc[ai][bj][m][n] = __builtin_amdgcn_mfma_f32_16x16x32_bf16(Bt[n][k], At[m][k], acc[ai][bj][m][n], 0, 0, 0); __builtin_amdgcn_s_setprio(0); } while (0)
#define PG8_WAIT_V(n) asm volatile("s_waitcnt vmcnt(" #n ")" ::: "memory")
#define PG8_WAIT_L(n) asm volatile("s_waitcnt lgkmcnt(" #n ")" ::: "memory")
#define PG8_BAR __builtin_amdgcn_s_barrier()
#define PG8_SCHED __builtin_amdgcn_sched_barrier(0)
    Unit cur, nxt; int ui = 0;
    if (!S.next(0, cur)) return;
    f32x4 acc[2][2][4][2];
#pragma unroll
    for (int a = 0; a < 2; ++a)
#pragma unroll
        for (int b = 0; b < 2; ++b)
#pragma unroll
            for (int m = 0; m < 4; ++m)
#pragma unroll
                for (int n = 0; n < 2; ++n) acc[a][b][m][n] = (f32x4){0.f, 0.f, 0.f, 0.f};
    bf16x8 At[4][2], B0[2][2], B1[2][2];
    const char* cA = (const char*)g.A + (size_t)cur.pm * tstep; const char* cB = (const char*)g.Bt + (size_t)cur.pn * tstep;
    S.a_ready(cur);
    if constexpr (SP2) {
        PG8_STAGE(PG8_SB(0, 0), cB, voffB); PG8_STAGE(PG8_SB(0, 1), cB + hstep, voffB); PG8_STAGE(PG8_SA(0, 0), cA, voffA); PG8_STAGE(PG8_SA(0, 1), cA + hstep, voffA);
        if (wr == 1) PG8_BAR;
        PG8_WAIT_V(2); PG8_BAR;
        PG8_STAGE(PG8_SB(1, 0), cB + kstep, voffB); PG8_STAGE(PG8_SA(1, 0), cA + kstep, voffA); PG8_STAGE(PG8_SB(1, 1), cB + hstep + kstep, voffB);
        PG8_WAIT_V(6); PG8_BAR;
    } else {
        PG8_STAGE(PG8_SB(0, 0), cB, voffB); PG8_STAGE(PG8_SA(0, 0), cA, voffA); PG8_STAGE(PG8_SB(0, 1), cB + hstep, voffB); PG8_STAGE(PG8_SA(0, 1), cA + hstep, voffA);
        if (wr == 1) PG8_BAR;
        PG8_WAIT_V(4); PG8_BAR;
        PG8_STAGE(PG8_SB(1, 0), cB + kstep, voffB); PG8_STAGE(PG8_SA(1, 0), cA + kstep, voffA); PG8_STAGE(PG8_SB(1, 1), cB + hstep + kstep, voffB);
        PG8_WAIT_V(6); PG8_BAR;
    }
    for (;;) {
        const bool has_next = S.next(ui + 1, nxt);
        const char* nA = has_next ? (const char*)g.A + (size_t)nxt.pm * tstep : cA; const char* nB = has_next ? (const char*)g.Bt + (size_t)nxt.pn * tstep : cB;
        for (int t = 0; t < nt; t += 2) {
            const bool last = (t == nt - 2);
            const char* a1 = cA + (size_t)(t + 1) * kstep;
            const char* a2 = last ? nA : cA + (size_t)(t + 2) * kstep; const char* b2 = last ? nB : cB + (size_t)(t + 2) * kstep;
            const char* a3 = a2 + kstep; const char* b3 = b2 + kstep;
            if (last && has_next) S.a_ready(nxt);
            if constexpr (SP2) {
            PG8_LDB(B0, 0, 0); PG8_LDB(B1, 0, 1); PG8_SCHED; PG8_LDA(At, 0, 0); PG8_STAGE(PG8_SA(1, 1), a1 + hstep, voffA);
            PG8_WAIT_V(8); PG8_WAIT_L(0); PG8_BAR; PG8_MMA(0, 0, At, B0); PG8_MMA(0, 1, At, B1); PG8_BAR; PG8_SCHED;
            PG8_LDA(At, 0, 1); PG8_STAGE(PG8_SB(0, 0), b2, voffB); PG8_STAGE(PG8_SB(0, 1), b2 + hstep, voffB); PG8_STAGE(PG8_SA(0, 0), a2, voffA);
            PG8_WAIT_V(8); PG8_WAIT_L(0); PG8_BAR; PG8_MMA(1, 0, At, B0); PG8_MMA(1, 1, At, B1); PG8_BAR; PG8_SCHED;
            PG8_LDB(B0, 1, 0); PG8_LDB(B1, 1, 1); PG8_SCHED; PG8_LDA(At, 1, 0); PG8_STAGE(PG8_SA(0, 1), a2 + hstep, voffA);
            PG8_WAIT_V(8); PG8_WAIT_L(0); PG8_BAR; PG8_MMA(0, 0, At, B0); PG8_MMA(0, 1, At, B1); PG8_BAR; PG8_SCHED;
            PG8_LDA(At, 1, 1); PG8_STAGE(PG8_SB(1, 0), b3, voffB); PG8_STAGE(PG8_SB(1, 1), b3 + hstep, voffB); PG8_STAGE(PG8_SA(1, 0), a3, voffA);
            PG8_WAIT_V(8); PG8_WAIT_L(0); PG8_BAR; PG8_MMA(1, 0, At, B0); PG8_MMA(1, 1, At, B1); PG8_BAR; PG8_SCHED;
            } else {
            PG8_LDB(B0, 0, 0); PG8_SCHED; PG8_LDA(At, 0, 0); PG8_STAGE(PG8_SA(1, 1), a1 + hstep, voffA);
            PG8_WAIT_L(8); PG8_BAR; PG8_WAIT_L(0); PG8_MMA(0, 0, At, B0); PG8_BAR; PG8_SCHED;
            PG8_LDB(B1, 0, 1); PG8_STAGE(PG8_SB(0, 0), b2, voffB);
            PG8_BAR; PG8_WAIT_L(0); PG8_MMA(0, 1, At, B1); PG8_BAR;
            PG8_LDA(At, 0, 1); PG8_STAGE(PG8_SA(0, 0), a2, voffA);
            PG8_BAR; PG8_WAIT_L(0); PG8_MMA(1, 0, At, B0); PG8_BAR; PG8_SCHED;
            PG8_STAGE(PG8_SB(0, 1), b2 + hstep, voffB);
            PG8_WAIT_V(6); PG8_BAR; PG8_MMA(1, 1, At, B1); PG8_BAR;
            PG8_LDB(B0, 1, 0); PG8_SCHED; PG8_LDA(At, 1, 0); PG8_STAGE(PG8_SA(0, 1), a2 + hstep, voffA);
            PG8_WAIT_L(8); PG8_BAR; PG8_WAIT_L(0); PG8_MMA(0, 0, At, B0); PG8_BAR; PG8_SCHED;
            PG8_LDB(B1, 1, 1); PG8_STAGE(PG8_SB(1, 0), b3, voffB);
            PG8_BAR; PG8_WAIT_L(0); PG8_MMA(0, 1, At, B1); PG8_BAR;
            PG8_LDA(At, 1, 1); PG8_STAGE(PG8_SA(1, 0), a3, voffA);
            PG8_BAR; PG8_WAIT_L(0); PG8_MMA(1, 0, At, B0); PG8_BAR; PG8_SCHED;
            PG8_STAGE(PG8_SB(1, 1), b3 + hstep, voffB);
            PG8_WAIT_V(6); PG8_BAR; PG8_MMA(1, 1, At, B1); PG8_BAR;
            }
        }
        if constexpr (ALIGN_EPI) { if (wr == 0) PG8_BAR; }
        if constexpr (!Epi::AFTER_DRAIN) { E(acc, cur, wr, wc, fr, fq); S.done(cur); }
        if (!has_next) break;
#pragma unroll
        for (int a = 0; a < 2; ++a)
#pragma unroll
            for (int b = 0; b < 2; ++b)
#pragma unroll
                for (int m = 0; m < 4; ++m)
#pragma unroll
                    for (int n = 0; n < 2; ++n) acc[a][b][m][n] = (f32x4){0.f, 0.f, 0.f, 0.f};
        cur = nxt; cA = nA; cB = nB; ++ui;
        if constexpr (ALIGN_EPI) { if (wr == 1) PG8_BAR; }
    }
    PG8_WAIT_V(0);
    if constexpr (!ALIGN_EPI) { if (wr == 0) PG8_BAR; }
    PG8_BAR;
    if constexpr (Epi::AFTER_DRAIN) { E.fused(acc, cur, wr, wc, fr, fq, lds, wid, lane); S.done(cur); }
#undef PG8_SA
#undef PG8_SB
#undef PG8_STAGE
#undef PG8_LDA
#undef PG8_LDB
#undef PG8_MMA
#undef PG8_WAIT_V
#undef PG8_WAIT_L
#undef PG8_BAR
#undef PG8_SCHED
}
}
#define LAS __attribute__((address_space(3)))
typedef unsigned short bf16;
typedef short bf16x8 __attribute__((ext_vector_type(8)));
typedef short s16x4 __attribute__((ext_vector_type(4)));
typedef float f32x4 __attribute__((ext_vector_type(4)));
typedef float f32x16 __attribute__((ext_vector_type(16)));
typedef unsigned u32x4 __attribute__((ext_vector_type(4)));
typedef unsigned u32x2 __attribute__((ext_vector_type(2)));

constexpr int NB = 8, SEQ = 4096, DM = 1024, DEPTH = 4, NMETA = 16;
constexpr int MREAL = NB * SEQ;
constexpr int META0 = MREAL;
constexpr int MROWS = 129 * 256;
constexpr int NINP = 3328, QP = 3072;
constexpr int C_FQ = 0, C_FK = 512, C_FV = 1024, C_GQ = 1536, C_GK = 1792, C_GV = 2048, C_GR = 2560;
constexpr int DFF = 2816, NUP = 5632;
constexpr float EPS = 1e-6f, LOG2E = 1.4426950408889634f, C2 = 0.125f * LOG2E;
constexpr int CKP = 4160;
constexpr int NCH = 65;

constexpr size_t MiB = 1u << 20;
constexpr size_t WL_IN = 0, WL_OUT = 6815744, WL_UP = 8912896, WL_DN = 20447232, WL_SIZE = 26214400;
constexpr size_t WS_W = 0, WS_HB = 100 * MiB, WS_OB = WS_HB + 67633152, WS_QKV = WS_OB + 67633152, WS_UT = WS_QKV + 202899456;
constexpr size_t WS_SM = WS_UT + 68157440, WS_CK = WS_SM + 4456448, WS_DEC = WS_CK + 1310720, WS_HM = WS_DEC + 786432, WS_SSQ = WS_HM + MiB, WS_BAR = WS_SSQ + 1835008, BAR_BYTES = 16384, WS_END = WS_BAR + BAR_BYTES;
static_assert(WS_END <= 512 * MiB, "workspace map");
constexpr size_t HFL_SIZE = (size_t)129 * 2 * NUP * 4;
static_assert(2 * HFL_SIZE <= 68157440, "halo overlay");

constexpr int LDS_BYTES = 147456, HALO_OFF = 131072;

struct Args {
    const float *x, *meta, *attn_norm, *w_in, *w_au, *b_alpha, *b_forget, *gla_norm, *fox_norm, *w_out, *ffn_norm, *w_up, *conv_w, *conv_b, *w_down, *final_norm;
    float* out; unsigned char* ws;
};

#define GAS __attribute__((address_space(1)))
#define CAS __attribute__((address_space(4)))
typedef const CAS Args* KArgs;
__device__ __forceinline__ KArgs kargs() { KArgs p = (KArgs)__builtin_amdgcn_kernarg_segment_ptr(); asm volatile("" : "+s"(p)); return p; }
template <class T> __device__ __forceinline__ T* gptr(T* p) { return (T*)(GAS T*)p; }
__device__ __forceinline__ float bf2f(bf16 v) { return __uint_as_float((unsigned)v << 16); }
__device__ __forceinline__ unsigned pk2(float lo, float hi) { return pg8::cvt_pk_bf16(lo, hi); }
__device__ __forceinline__ bf16 f2bf(float v) { return (bf16)(pk2(v, 0.f) & 0xffffu); }
__device__ __forceinline__ float wave_sum(float v) {
#pragma unroll
    for (int o = 1; o < 64; o <<= 1) v += __shfl_xor(v, o);
    return v;
}
__device__ __forceinline__ float logsigmoidf(float z) { return -(fmaxf(-z, 0.f) + log1pf(__expf(-fabsf(z)))); }
__device__ __forceinline__ float siluf(float v) { return v * __builtin_amdgcn_rcpf(1.f + __builtin_amdgcn_exp2f(-LOG2E * v)); }
__device__ __forceinline__ int crow(int r, int hi) { return (r & 3) + 8 * (r >> 2) + 4 * hi; }
__device__ __forceinline__ s16x4 vtr(const LAS unsigned char* p) { return __builtin_bit_cast(s16x4, __builtin_amdgcn_ds_read_tr16_b64_v4i16((LAS s16x4*)p)); }
__device__ __forceinline__ bf16x8 cat8(s16x4 a, s16x4 b) { return (bf16x8){a[0], a[1], a[2], a[3], b[0], b[1], b[2], b[3]}; }
__device__ __forceinline__ float dppf(float old, float src, int ctrl_unused);
#define DPP_MOV(old, src, ctrl) __builtin_bit_cast(float, __builtin_amdgcn_update_dpp(__builtin_bit_cast(int, (float)(old)), __builtin_bit_cast(int, (float)(src)), (ctrl), 0xf, 0xf, false))
#define LDS_WAIT() asm volatile("s_waitcnt lgkmcnt(0)" ::: "memory")

__device__ __forceinline__ const float* ssq_arr(unsigned char* wsb, int si) { return (const float*)(wsb + WS_SSQ) + (size_t)(si % 3) * MROWS * 4; }
__device__ __forceinline__ float row_rstd(const float* ssqp, int row) { const f32x4 s = *(const f32x4*)(ssqp + (size_t)row * 4); return rsqrtf(((s[0] + s[1]) + (s[2] + s[3])) * (1.0f / DM) + EPS); }
__device__ __forceinline__ LAS float* tile_rstd(const float* ssqp, int pm, int wr, int wc, int fr, int fq) {
    extern __shared__ __attribute__((aligned(16))) unsigned char lds_dyn_[];
    LAS float* rsl = (LAS float*)((LAS unsigned char*)lds_dyn_ + HALO_OFF + 8192);
    const int tl = (wr * 4 + wc) * 64 + fq * 16 + fr;
    if (tl < 256) rsl[tl] = row_rstd(ssqp, pm * 256 + tl);
    asm volatile("s_waitcnt lgkmcnt(0)" ::: "memory"); __builtin_amdgcn_s_barrier(); asm volatile("" ::: "memory");
    return rsl;
}
struct EpiIn {
    static constexpr bool PERM = true, AFTER_DRAIN = false;
    int si;
    __device__ __forceinline__ void operator()(const pg8::f32x4 (&acc)[2][2][4][2], const pg8::Unit& u, int wr, int wc, int fr, int fq) const {
        asm volatile("" : "+v"(fr), "+v"(fq));
        unsigned char* wsb = gptr(kargs()->ws);
        bf16* Q = (bf16*)(wsb + WS_QKV); float* SM = (float*)(wsb + WS_SM); const LAS float* rsl = tile_rstd(ssq_arr(wsb, si), u.pm, wr, wc, fr, fq);
#pragma unroll
        for (int ai = 0; ai < 2; ++ai)
#pragma unroll
            for (int m = 0; m < 4; ++m) {
                const int row = u.pm * 256 + ai * 128 + wr * 64 + m * 16 + fr;
                const float rs = rsl[ai * 128 + wr * 64 + m * 16 + fr];
                if (u.pn < 12) {
#pragma unroll
                    for (int bj = 0; bj < 2; ++bj) {
                        const pg8::f32x4 v0 = acc[ai][bj][m][0] * rs, v1 = acc[ai][bj][m][1] * rs;
                        u32x4 w; w.x = pk2(v0[0], v0[1]); w.y = pk2(v0[2], v0[3]); w.z = pk2(v1[0], v1[1]); w.w = pk2(v1[2], v1[3]);
                        *(u32x4*)(Q + (size_t)row * QP + u.pn * 256 + bj * 128 + wc * 32 + 8 * fq) = w;
                    }
                } else if (wc == 0) {
                    *(f32x4*)(SM + (size_t)row * 32 + 8 * fq) = acc[ai][0][m][0] * rs;
                    *(f32x4*)(SM + (size_t)row * 32 + 8 * fq + 4) = acc[ai][0][m][1] * rs;
                }
            }
    }
};
struct EpiRes {
    static constexpr bool PERM = false, AFTER_DRAIN = false;
    int from_x, si;
    __device__ __forceinline__ void operator()(const pg8::f32x4 (&acc)[2][2][4][2], const pg8::Unit& u, int wr, int wc, int fr, int fq) const {
        asm volatile("" : "+v"(fr), "+v"(fq));
        KArgs ka = kargs(); unsigned char* wsb = gptr(ka->ws);
        float* out = gptr(ka->out); const float* base = from_x ? gptr(ka->x) : out; float* hmeta = (float*)(wsb + WS_HM); bf16* HB = (bf16*)(wsb + WS_HB); float* ssq_next = (float*)ssq_arr(wsb, si);
        extern __shared__ __attribute__((aligned(16))) unsigned char lds_dyn_[];
        LAS float* red = (LAS float*)((LAS unsigned char*)lds_dyn_ + HALO_OFF);
#pragma unroll
        for (int ai = 0; ai < 2; ++ai)
#pragma unroll
            for (int m = 0; m < 4; ++m) {
                const int row = u.pm * 256 + ai * 128 + wr * 64 + m * 16 + fr;
                const float* bp = row < MREAL ? base + (size_t)row * DM : hmeta + (size_t)(row - MREAL) * DM;
                float* op = row < MREAL ? out + (size_t)row * DM : hmeta + (size_t)(row - MREAL) * DM;
                float ss = 0.f;
#pragma unroll
                for (int bj = 0; bj < 2; ++bj)
#pragma unroll
                    for (int n = 0; n < 2; ++n) {
                        const int col = u.pn * 256 + bj * 128 + wc * 32 + 16 * n + 4 * fq;
                        const f32x4 h = *(const f32x4*)(bp + col) + acc[ai][bj][m][n];
                        *(f32x4*)(op + col) = h;
                        ss += (h[0] * h[0] + h[1] * h[1]) + (h[2] * h[2] + h[3] * h[3]);
                        u32x2 w; w.x = pk2(h[0], h[1]); w.y = pk2(h[2], h[3]);
                        *(u32x2*)(HB + (size_t)row * DM + col) = w;
                    }
                ss += __shfl_xor(ss, 16); ss += __shfl_xor(ss, 32);
                if (fq == 0) red[wc * 256 + ai * 128 + wr * 64 + m * 16 + fr] = ss;
            }
        asm volatile("s_waitcnt lgkmcnt(0)" ::: "memory"); __builtin_amdgcn_s_barrier(); asm volatile("" ::: "memory");
        {
            const int tl = (wr * 4 + wc) * 64 + fq * 16 + fr;
            if (tl < 256) ssq_next[(size_t)(u.pm * 256 + tl) * 4 + u.pn] = (red[tl] + red[256 + tl]) + (red[512 + tl] + red[768 + tl]);
        }
    }
};
struct EpiUp {
    static constexpr bool PERM = true, AFTER_DRAIN = false;
    int L;
    __device__ __forceinline__ void operator()(pg8::f32x4 (&acc)[2][2][4][2], const pg8::Unit& u, int wr, int wc, int fr, int fq) const {
        asm volatile("" : "+v"(fr), "+v"(fq));
        KArgs ka = kargs(); unsigned char* wsb = gptr(ka->ws);
        const LAS float* rsl = tile_rstd(ssq_arr(wsb, 2 * L + 1), u.pm, wr, wc, fr, fq); const float* cw = gptr(ka->conv_w) + (size_t)L * 3 * NUP; const float* cb = gptr(ka->conv_b) + (size_t)L * NUP;
        extern __shared__ __attribute__((aligned(16))) unsigned char lds_dyn_[];
        LAS float* halo = (LAS float*)((LAS unsigned char*)lds_dyn_ + HALO_OFF);
        const int colw = wc * 32 + 8 * fq;
#pragma unroll
        for (int ai = 0; ai < 2; ++ai)
#pragma unroll
            for (int m = 0; m < 4; ++m) {
                const int row = u.pm * 256 + ai * 128 + wr * 64 + m * 16 + fr;
                const float rs = rsl[ai * 128 + wr * 64 + m * 16 + fr]; (void)row;
#pragma unroll
                for (int bj = 0; bj < 2; ++bj)
#pragma unroll
                    for (int n = 0; n < 2; ++n) acc[ai][bj][m][n] *= rs;
            }
#ifdef SIMPLE_UP
        {
            const int ch0s = u.pn * 128 + colw;
#pragma unroll
            for (int n = 0; n < 2; ++n)
#pragma unroll
                for (int ai = 0; ai < 2; ++ai)
#pragma unroll
                    for (int m = 0; m < 4; ++m) {
                        const int row = u.pm * 256 + ai * 128 + wr * 64 + m * 16 + fr;
                        const f32x4 hu = acc[ai][0][m][n], hg = acc[ai][1][m][n];
                        u32x2 w; w.x = pk2(hu[0] + hg[0], hu[1] + hg[1]); w.y = pk2(hu[2] + hg[2], hu[3] + hg[3]);
                        *(u32x2*)(wsb + (unsigned)(WS_QKV + (unsigned)((row * DFF + ch0s + 4 * n) * 2))) = w;
                    }
            return;
        }
#endif
        if (fr >= 14) {
#pragma unroll
            for (int ai = 0; ai < 2; ++ai)
#pragma unroll
                for (int bj = 0; bj < 2; ++bj)
#pragma unroll
                    for (int n = 0; n < 2; ++n)
                        *(LAS f32x4*)(halo + (((2 * ai + wr) * 2 + (fr - 14)) * 256 + bj * 128 + colw + 4 * n)) = acc[ai][bj][3][n];
        }
        asm volatile("s_waitcnt lgkmcnt(0)" ::: "memory"); __builtin_amdgcn_s_barrier(); asm volatile("" ::: "memory");
        const int ch0 = u.pn * 128 + colw;
        u32x2 wout[2][4][2];
#pragma unroll
        for (int n = 0; n < 2; ++n) {
            f32x4 w0[2], w1[2], w2[2], bb[2];
#pragma unroll
            for (int bj = 0; bj < 2; ++bj) {
                const int c = bj * DFF + ch0 + 4 * n;
                w0[bj] = *(const f32x4*)((const char*)cw + (unsigned)(c * 4)); w1[bj] = *(const f32x4*)((const char*)cw + (unsigned)((NUP + c) * 4)); w2[bj] = *(const f32x4*)((const char*)cw + (unsigned)((2 * NUP + c) * 4)); bb[bj] = *(const f32x4*)((const char*)cb + (unsigned)(c * 4));
            }
#pragma unroll
            for (int ai = 0; ai < 2; ++ai)
#pragma unroll
                for (int m = 0; m < 4; ++m) {
                    const int g = 2 * ai + wr;
                    f32x4 hc[2];
#pragma unroll
                    for (int bj = 0; bj < 2; ++bj) {
                        const int c = bj * DFF + ch0 + 4 * n;
                        const f32x4 cur = acc[ai][bj][m][n];
                        f32x4 pb;
                        if (m > 0) pb = acc[ai][bj][m - 1][n];
                        else pb = *(const LAS f32x4*)(halo + ((((g > 0 ? g - 1 : 0) * 2) + (fr & 1)) * 256 + bj * 128 + colw + 4 * n));
                        f32x4 p1, p2;
#pragma unroll
                        for (int j = 0; j < 4; ++j) {
                            const float t1 = DPP_MOV(0.f, pb[j], 0x121);
                            p1[j] = DPP_MOV(t1, cur[j], 0x111);
                            const float t2 = DPP_MOV(0.f, pb[j], 0x122);
                            p2[j] = DPP_MOV(t2, cur[j], 0x112);
                        }
                        hc[bj] = bb[bj] + w0[bj] * p2 + w1[bj] * p1 + w2[bj] * cur;
                        if (g == 0 && m == 0 && fr < 2) *(f32x4*)(wsb + (unsigned)(WS_UT + (unsigned)(((u.pm * 2 + fr) * NUP + c) * 4))) = cur;
                        if (u.pm == 128 ? (g == 0 && m == 0 && fr >= 14) : (g == 3 && m == 3 && fr >= 14))
                            *(f32x4*)(wsb + (unsigned)(WS_UT + HFL_SIZE + (unsigned)(((u.pm * 2 + fr - 14) * NUP + c) * 4))) = cur;
                    }
                    wout[ai][m][n].x = pk2(siluf(hc[1][0]) * hc[0][0], siluf(hc[1][1]) * hc[0][1]);
                    wout[ai][m][n].y = pk2(siluf(hc[1][2]) * hc[0][2], siluf(hc[1][3]) * hc[0][3]);
                }
        }
#pragma unroll
        for (int ai = 0; ai < 2; ++ai)
#pragma unroll
            for (int m = 0; m < 4; ++m) {
                const int row = u.pm * 256 + ai * 128 + wr * 64 + m * 16 + fr;
                u32x4 w; w.x = wout[ai][m][0].x; w.y = wout[ai][m][0].y; w.z = wout[ai][m][1].x; w.w = wout[ai][m][1].y;
                *(u32x4*)(wsb + (unsigned)(WS_QKV + (unsigned)((row * DFF + ch0) * 2))) = w;
            }
    }
};
#define XB_TMO      128
#define XB_XCNT(j)  (256  + 64 * (j))
#define XB_XSUB(j)  (1280 + 64 * (j))
#define XB_XGEN(j)  (2304 + 64 * (j))
#define XB_TOP      3328
#define XB_TOPGEN   3392
#define XCD_BAR_WORDS 3456
#define XB_SPIN_CAP (1u << 18)

__device__ __forceinline__ unsigned xb_ld(unsigned* p)              { return __hip_atomic_load(p, __ATOMIC_RELAXED, __HIP_MEMORY_SCOPE_AGENT); }
__device__ __forceinline__ unsigned xb_add(unsigned* p, unsigned v) { return __hip_atomic_fetch_add(p, v, __ATOMIC_RELAXED, __HIP_MEMORY_SCOPE_AGENT); }
__device__ __forceinline__ unsigned xb_xcc_id() { return (unsigned)__builtin_amdgcn_s_getreg((3 << 11) | 20) & 0xFu; }
#define XB_SPIN(cond, bar) do { unsigned _sp = 0; while (cond) { __builtin_amdgcn_s_sleep(1); \
    if ((++_sp & 255u) == 0u) { if (xb_ld(&(bar)[XB_TMO])) break; if (_sp > XB_SPIN_CAP) { atomicAdd(&(bar)[XB_TMO], 1u); break; } } } } while (0)

struct XcdBarrier {
    unsigned* bar; unsigned x;
    volatile LAS unsigned* st;
};

__device__ __forceinline__ XcdBarrier xcd_barrier_post(unsigned* bar, volatile LAS unsigned* st) {
    XcdBarrier b; b.bar = bar; b.x = xb_xcc_id(); b.st = st;
    if (threadIdx.x == 0) (void)xb_add(&bar[XB_XCNT(b.x)], 1u);
    return b;
}
__device__ __forceinline__ void xcd_barrier_complete(unsigned* bar, unsigned x, unsigned& nloc, unsigned& nx) {
    const unsigned G = gridDim.x * gridDim.y * gridDim.z;
    unsigned sum, cnt, mine, sp = 0u;
    for (;;) {
        sum = 0u; cnt = 0u; mine = 0u;
#pragma unroll
        for (unsigned j = 0; j < 16; ++j) { const unsigned c = xb_ld(&bar[XB_XCNT(j)]); sum += c; cnt += (c > 0u) ? 1u : 0u; mine = (j == x) ? c : mine; }
        if (sum == G) break;
        __builtin_amdgcn_s_sleep(1);
        if ((++sp & 255u) == 0u) { if (xb_ld(&bar[XB_TMO])) break; if (sp > XB_SPIN_CAP) { atomicAdd(&bar[XB_TMO], 1u); break; } }
    }
    nloc = mine > 0u ? mine : 1u; nx = cnt > 0u ? cnt : 1u;
}

__device__ __forceinline__ void xcd_barrier(const XcdBarrier& b) {
    asm volatile("s_waitcnt vmcnt(0)" ::: "memory");
    __syncthreads();
    if (threadIdx.x == 0) {
        unsigned* bar = b.bar;
        __builtin_amdgcn_s_waitcnt(0);
        unsigned nloc = b.st[0], nx = b.st[1];
        if (nloc == 0u) { xcd_barrier_complete(bar, b.x, nloc, nx); b.st[0] = nloc; b.st[1] = nx; }
        const unsigned old = xb_add(&bar[XB_XSUB(b.x)], 1u);
        const unsigned gen = old / nloc;
        if (old + 1u == (gen + 1u) * nloc) {
            __builtin_amdgcn_fence(__ATOMIC_RELEASE, "agent");
            asm volatile("s_waitcnt vmcnt(0)" ::: "memory");
            const unsigned og = xb_add(&bar[XB_TOP], 1u);
            const unsigned tg = og / nx;
            if (og + 1u == (tg + 1u) * nx) xb_add(&bar[XB_TOPGEN], 1u);
            else XB_SPIN(xb_ld(&bar[XB_TOPGEN]) == tg, bar);
            __builtin_amdgcn_fence(__ATOMIC_ACQUIRE, "agent");
            xb_add(&bar[XB_XGEN(b.x)], 1u);
            asm volatile("s_waitcnt vmcnt(0)" ::: "memory");
        } else {
            XB_SPIN(xb_ld(&bar[XB_XGEN(b.x)]) == gen, bar);
            __builtin_amdgcn_fence(__ATOMIC_ACQUIRE, "agent");
            asm volatile("s_waitcnt vmcnt(0)" ::: "memory");
        }
    }
    __syncthreads();
}
__device__ __forceinline__ int win_src(int n) {
    if (n < 512) return 1552 + n;
    if (n < 1024) return 2064 + (n - 512);
    if (n < 1536) return 2576 + (n - 1024);
    if (n < 1792) return n - 1536;
    if (n < 2048) return 256 + (n - 1792);
    if (n < 2560) return 512 + (n - 2048);
    if (n < 3072) return 1024 + (n - 2560);
    if (n < 3088) return 1536 + (n - 3072);
    if (n < 3096) return n;
    return -1;
}
__device__ __forceinline__ void tr_item(const float* W, int Nsrc, bf16* WT, int K, const float* gk, int mode, LAS float* scr, int k0, int n0, int lane) {
    const int nl = lane & 31, n = n0 + nl;
    int src = n; float cs = 1.f;
    if (mode == 0) { src = win_src(n); cs = n < 512 ? C2 : ((n >= 1536 && n < 1792) ? 0.125f : 1.f); }
    else if (mode == 2) { const int pn = n >> 8, j = n & 255; src = j < 128 ? pn * 128 + j : DFF + pn * 128 + (j - 128); }
#pragma unroll 8
    for (int i = 0; i < 32; ++i) {
        const int kk = 2 * i + (lane >> 5);
        float v = 0.f;
        if (src >= 0) v = W[(size_t)(k0 + kk) * Nsrc + src] * cs;
        if (gk) v *= gk[k0 + kk];
        scr[kk * 33 + nl] = v;
    }
    LDS_WAIT(); asm volatile("" ::: "memory");
    const int c = lane & 7;
#pragma unroll
    for (int j = 0; j < 4; ++j) {
        const int nn = (lane >> 3) + 8 * j; const LAS float* s = scr + (8 * c) * 33 + nn;
        u32x4 o; o.x = pk2(s[0 * 33], s[1 * 33]); o.y = pk2(s[2 * 33], s[3 * 33]); o.z = pk2(s[4 * 33], s[5 * 33]); o.w = pk2(s[6 * 33], s[7 * 33]);
        *(u32x4*)(WT + (size_t)(n0 + nn) * K + k0 + 8 * c) = o;
    }
    LDS_WAIT(); asm volatile("" ::: "memory");
}
__device__ __forceinline__ void row_to_bf16(const float* xrow, bf16* orow, float* ssq_slot, float* copy_row, int lane) {
    const f32x4* xr = (const f32x4*)xrow + lane;
    f32x4 v[4]; float s = 0.f;
#pragma unroll
    for (int j = 0; j < 4; ++j) { v[j] = xr[64 * j]; s += (v[j][0] * v[j][0] + v[j][1] * v[j][1]) + (v[j][2] * v[j][2] + v[j][3] * v[j][3]); }
    s = wave_sum(s);
    if (lane == 0) *(f32x4*)ssq_slot = (f32x4){s, 0.f, 0.f, 0.f};
    u32x2* o8 = (u32x2*)orow + lane;
#pragma unroll
    for (int j = 0; j < 4; ++j) { u32x2 w; w.x = pk2(v[j][0], v[j][1]); w.y = pk2(v[j][2], v[j][3]); o8[64 * j] = w; }
    if (copy_row) {
#pragma unroll
        for (int j = 0; j < 4; ++j) ((f32x4*)copy_row + lane)[64 * j] = v[j];
    }
}

__device__ __forceinline__ void gla_u_unit(LAS unsigned char* lds, const bf16* QKV, const float* SM, const float* wau, const float* balpha, float* UT, float* DEC, int bh, int cc) {
    int tid_ = threadIdx.x; asm volatile("" : "+v"(tid_)); const int tid = tid_, lane = tid & 63, wid = __builtin_amdgcn_readfirstlane(tid >> 6), hi = lane >> 5, r32 = lane & 31;
    const int b = bh >> 2, h = bh & 3;
    const int row0 = cc == 0 ? META0 : b * SEQ + (cc - 1) * 64, tvalid = cc == 0 ? NMETA : 64;
    LAS unsigned char* KD = lds;
    LAS unsigned char* VT = lds + 9216;
    LAS float* TOT = (LAS float*)(lds + 9216 + 17408);
    const int dk = lane, sg = wid;
    float w[16];
#pragma unroll
    for (int r = 0; r < 16; ++r) w[r] = wau[r * 256 + h * 64 + dk];
    const float bias = balpha[h * 64 + dk];
    float la[8];
#pragma unroll
    for (int i = 0; i < 8; ++i) {
        const int s = 8 * sg + i;
        const f32x4* g4 = (const f32x4*)(SM + (size_t)(row0 + s) * 32);
        float z = bias;
#pragma unroll
        for (int q = 0; q < 4; ++q) { const f32x4 gv = g4[q]; z += gv[0] * w[4 * q] + gv[1] * w[4 * q + 1] + gv[2] * w[4 * q + 2] + gv[3] * w[4 * q + 3]; }
        la[i] = (s < tvalid) ? logsigmoidf(z) * (1.0f / 16.0f) : 0.f;
    }
#pragma unroll
    for (int i = 1; i < 8; ++i) la[i] += la[i - 1];
    TOT[sg * 64 + dk] = la[7];
#pragma unroll
    for (int i = 0; i < 2; ++i) {
        const int idx = tid + 512 * i, row = idx >> 4, ch = idx & 15;
        const u32x4 v = *(const u32x4*)(QKV + (size_t)(row0 + row) * QP + C_GV + h * 128 + ch * 8);
        *(LAS u32x4*)(VT + row * 272 + ch * 16) = v;
    }
    __syncthreads();
    float pre = 0.f, tot = 0.f;
#pragma unroll
    for (int g2 = 0; g2 < 8; ++g2) { const float t = TOT[g2 * 64 + dk]; if (g2 < sg) pre += t; tot += t; }
    if (sg == 0) DEC[(size_t)(bh * NCH + cc) * 64 + dk] = __expf(tot);
#pragma unroll
    for (int i = 0; i < 8; ++i) {
        const int s = 8 * sg + i;
        const float kf = bf2f(QKV[(size_t)(row0 + s) * QP + C_GK + h * 64 + dk]);
        const float kd = (s < tvalid) ? kf * __expf(tot - (pre + la[i])) : 0.f;
        *(LAS bf16*)(KD + s * 144 + dk * 2) = f2bf(kd);
    }
    __syncthreads();
    const int dvb = wid >> 1, dkb = wid & 1;
    const int qq = (lane & 15) >> 2, pp = lane & 3, half = (lane >> 4) & 1;
    f32x16 acc = {};
#pragma unroll
    for (int j = 0; j < 4; ++j) {
        const LAS unsigned char* ap = VT + (16 * j + 4 * hi + qq) * 272 + (32 * dvb + 16 * half + 4 * pp) * 2;
        const LAS unsigned char* bp = KD + (16 * j + 4 * hi + qq) * 144 + (32 * dkb + 16 * half + 4 * pp) * 2;
        const bf16x8 af = cat8(vtr(ap), vtr(ap + 8 * 272));
        const bf16x8 bfr = cat8(vtr(bp), vtr(bp + 8 * 144));
        acc = __builtin_amdgcn_mfma_f32_32x32x16_bf16(af, bfr, acc, 0, 0, 0);
    }
    float* up = UT + ((size_t)(bh * NCH + cc) * 128 + 32 * dvb) * 64 + 32 * dkb + r32;
#pragma unroll
    for (int r = 0; r < 16; ++r) up[crow(r, hi) * 64] = acc[r];
    __syncthreads();
}
__device__ __forceinline__ void fox_cumsum_unit(LAS unsigned char* lds, const float* SM, const float* bforget, float* CK, int bh) {
    int tid_ = threadIdx.x; asm volatile("" : "+v"(tid_)); const int tid = tid_, lane = tid & 63, wid = tid >> 6;
    const int b = bh >> 3, h = bh & 7;
    const float bf_ = bforget[h];
    LAS float* WT_ = (LAS float*)lds;
    float mtot = 0.f, mine = 0.f;
    for (int p = 0; p < NMETA; ++p) { mtot += logsigmoidf(SM[(size_t)(META0 + p) * 32 + 16 + h] + bf_); if (tid == p) mine = mtot; }
    if (tid < 64) CK[(size_t)bh * CKP + tid] = tid < NMETA ? -LOG2E * mine : -INFINITY;
    float v[8]; float run = 0.f;
#pragma unroll
    for (int i = 0; i < 8; ++i) { run += logsigmoidf(SM[(size_t)(b * SEQ + 8 * tid + i) * 32 + 16 + h] + bf_); v[i] = run; }
    float inc = run;
#pragma unroll
    for (int o = 1; o < 64; o <<= 1) { const float t = __shfl_up(inc, o); if (lane >= o) inc += t; }
    if (lane == 63) WT_[wid] = inc;
    __syncthreads();
    float off = mtot + (inc - run);
    for (int w2 = 0; w2 < wid; ++w2) off += WT_[w2];
#pragma unroll
    for (int i = 0; i < 8; ++i) CK[(size_t)bh * CKP + 64 + 8 * tid + i] = -LOG2E * (off + v[i]);
    __syncthreads();
}

__device__ __forceinline__ void attn_unit(LAS unsigned char* lds, const bf16* QKV, const float* CK, bf16* OB, const float* fnorm, int b, int h, int qb) {
    int tid_ = threadIdx.x; asm volatile("" : "+v"(tid_)); const int tid = tid_, lane = tid & 63, wid = __builtin_amdgcn_readfirstlane(tid >> 6), r32 = lane & 31, hi = lane >> 5;
    constexpr int KB = 9216, KOFF = 0, VOFF = 2 * KB, COFF = 4 * KB, WOFF = COFF + 512;
    LAS float* wsf = (LAS float*)(lds + WOFF) + wid * 64;
    const size_t rowb = (size_t)b * SEQ; const int q0 = qb * 256;
    const int NT = 1 + 4 * (qb + 1);
    const bf16* qp = QKV + (rowb + q0 + wid * 32 + r32) * QP + C_FQ + h * 64 + hi * 8;
    bf16x8 qr[4];
#pragma unroll
    for (int d0 = 0; d0 < 4; ++d0) qr[d0] = *(const bf16x8*)(qp + d0 * 16);
    const int srow = tid >> 3, sch = tid & 7;
    const float* ckp = CK + (size_t)(b * 8 + h) * CKP;
    u32x4 kreg, vreg; float creg = 0.f;
#define ATT_LOAD(t) do { const size_t r0_ = (t) == 0 ? (size_t)META0 : rowb + (size_t)((t) - 1) * 64; const bf16* p_ = QKV + (r0_ + srow) * QP + h * 64 + sch * 8; \
        kreg = *(const u32x4*)(p_ + C_FK); vreg = *(const u32x4*)(p_ + C_FV); if (tid < 64) creg = ckp[(t) * 64 + tid]; } while (0)
#define ATT_STORE(buf) do { *(LAS u32x4*)(lds + KOFF + (buf) * KB + srow * 144 + sch * 16) = kreg; *(LAS u32x4*)(lds + VOFF + (buf) * KB + srow * 144 + sch * 16) = vreg; \
        if (tid < 64) *(LAS float*)(lds + COFF + (buf) * 256 + tid * 4) = creg; } while (0)
    float m = -1e30f, l = 0.f; f32x16 o0 = {}, o1 = {};
    const int qrel = 32 * wid + r32;
    const int qq = (lane & 15) >> 2, pp = lane & 3, half = (lane >> 4) & 1;
    ATT_LOAD(0); ATT_STORE(0);
    for (int t = 0; t < NT; ++t) {
        const int buf = t & 1;
        if (t + 1 < NT) ATT_LOAD(t + 1);
        __syncthreads();
        const int jb = t - (NT - 4);
        const bool skip = (jb >= 0) && (64 * jb > 32 * wid + 31);
        if (!skip) {
            const LAS unsigned char* Kb = lds + KOFF + buf * KB; const LAS unsigned char* Vb = lds + VOFF + buf * KB; const LAS float* Cb = (const LAS float*)(lds + COFF + buf * 256);
            f32x16 p0, p1;
#pragma unroll
            for (int g = 0; g < 4; ++g) {
                const f32x4 c0 = *(const LAS f32x4*)(Cb + 8 * g + 4 * hi), c1 = *(const LAS f32x4*)(Cb + 32 + 8 * g + 4 * hi);
#pragma unroll
                for (int i = 0; i < 4; ++i) { p0[4 * g + i] = c0[i]; p1[4 * g + i] = c1[i]; }
            }
#pragma unroll
            for (int d0 = 0; d0 < 4; ++d0) {
                const bf16x8 a0 = *(const LAS bf16x8*)(Kb + r32 * 144 + (16 * d0 + 8 * hi) * 2);
                const bf16x8 a1 = *(const LAS bf16x8*)(Kb + (32 + r32) * 144 + (16 * d0 + 8 * hi) * 2);
                p0 = __builtin_amdgcn_mfma_f32_32x32x16_bf16(a0, qr[d0], p0, 0, 0, 0);
                p1 = __builtin_amdgcn_mfma_f32_32x32x16_bf16(a1, qr[d0], p1, 0, 0, 0);
            }
            if (jb >= 0 && 64 * jb + 63 > 32 * wid) {
#pragma unroll
                for (int r = 0; r < 16; ++r) { const int kv = 64 * jb + crow(r, hi); if (kv > qrel) p0[r] = -INFINITY; if (kv + 32 > qrel) p1[r] = -INFINITY; }
            }
            float mx = fmaxf(fmaxf(p0[0], p1[0]), fmaxf(p0[1], p1[1]));
#pragma unroll
            for (int r = 2; r < 16; r += 2) mx = fmaxf(fmaxf(mx, fmaxf(p0[r], p1[r])), fmaxf(p0[r + 1], p1[r + 1]));
            mx = fmaxf(mx, __shfl_xor(mx, 32));
            if (__any(mx > m + 8.0f)) {
                const float mn = fmaxf(m, mx);
                const float alpha = __builtin_amdgcn_exp2f(m - mn);
                m = mn; l *= alpha;
                if (hi == 0) wsf[r32] = alpha;
                LDS_WAIT();
#pragma unroll
                for (int g = 0; g < 4; ++g) {
                    const f32x4 a = *(const LAS f32x4*)(wsf + 8 * g + 4 * hi);
#pragma unroll
                    for (int i = 0; i < 4; ++i) { o0[4 * g + i] *= a[i]; o1[4 * g + i] *= a[i]; }
                }
            }
            float rsum = 0.f;
#pragma unroll
            for (int r = 0; r < 16; ++r) { p0[r] = __builtin_amdgcn_exp2f(p0[r] - m); p1[r] = __builtin_amdgcn_exp2f(p1[r] - m); rsum += p0[r] + p1[r]; }
            l += rsum;
            bf16x8 pa[4];
            { u32x4 w;
              w.x = pk2(p0[0], p0[1]); w.y = pk2(p0[2], p0[3]); w.z = pk2(p0[4], p0[5]); w.w = pk2(p0[6], p0[7]); pa[0] = __builtin_bit_cast(bf16x8, w);
              w.x = pk2(p0[8], p0[9]); w.y = pk2(p0[10], p0[11]); w.z = pk2(p0[12], p0[13]); w.w = pk2(p0[14], p0[15]); pa[1] = __builtin_bit_cast(bf16x8, w);
              w.x = pk2(p1[0], p1[1]); w.y = pk2(p1[2], p1[3]); w.z = pk2(p1[4], p1[5]); w.w = pk2(p1[6], p1[7]); pa[2] = __builtin_bit_cast(bf16x8, w);
              w.x = pk2(p1[8], p1[9]); w.y = pk2(p1[10], p1[11]); w.z = pk2(p1[12], p1[13]); w.w = pk2(p1[14], p1[15]); pa[3] = __builtin_bit_cast(bf16x8, w); }
#pragma unroll
            for (int j = 0; j < 4; ++j) {
                const LAS unsigned char* vp = Vb + (16 * j + 4 * hi + qq) * 144 + (16 * half + 4 * pp) * 2;
                const bf16x8 v0 = cat8(vtr(vp), vtr(vp + 8 * 144));
                const bf16x8 v1 = cat8(vtr(vp + 64), vtr(vp + 64 + 8 * 144));
                o0 = __builtin_amdgcn_mfma_f32_32x32x16_bf16(pa[j], v0, o0, 0, 0, 0);
                o1 = __builtin_amdgcn_mfma_f32_32x32x16_bf16(pa[j], v1, o1, 0, 0, 0);
            }
        }
        if (t + 1 < NT) ATT_STORE(buf ^ 1);
    }
#undef ATT_LOAD
#undef ATT_STORE
    l += __shfl_xor(l, 32);
    if (hi == 0) wsf[r32] = 1.0f / l;
    LDS_WAIT();
#pragma unroll
    for (int g = 0; g < 4; ++g) {
        const f32x4 a = *(const LAS f32x4*)(wsf + 8 * g + 4 * hi);
#pragma unroll
        for (int i = 0; i < 4; ++i) { o0[4 * g + i] *= a[i]; o1[4 * g + i] *= a[i]; }
    }
    const float w0 = fnorm[h * 64 + r32], w1 = fnorm[h * 64 + 32 + r32];
#pragma unroll
    for (int r = 0; r < 16; ++r) {
        float s = o0[r] * o0[r] + o1[r] * o1[r];
        s += __shfl_xor(s, 1); s += __shfl_xor(s, 2); s += __shfl_xor(s, 4); s += __shfl_xor(s, 8); s += __shfl_xor(s, 16);
        const float rs = rsqrtf(s * (1.0f / 64.0f) + EPS);
        bf16* op = OB + (rowb + q0 + wid * 32 + crow(r, hi)) * DM + 512 + h * 64 + r32;
        op[0] = f2bf(o0[r] * rs * w0); op[32] = f2bf(o1[r] * rs * w1);
    }
    __syncthreads();
}
__device__ __forceinline__ void meta_attn(const bf16* QKV, const float* CK, bf16* OB, const float* fnorm, int p) {
    int tid_ = threadIdx.x; asm volatile("" : "+v"(tid_)); const int lane = tid_ & 63, h = tid_ >> 6;
    const float q = bf2f(QKV[(size_t)(META0 + p) * QP + C_FQ + h * 64 + lane]);
    float sc[NMETA], vv[NMETA];
#pragma unroll
    for (int s = 0; s < NMETA; ++s) {
        sc[s] = q * bf2f(QKV[(size_t)(META0 + s) * QP + C_FK + h * 64 + lane]);
        vv[s] = bf2f(QKV[(size_t)(META0 + s) * QP + C_FV + h * 64 + lane]);
    }
    float m = -1e30f;
#pragma unroll
    for (int s = 0; s < NMETA; ++s) { sc[s] = (s <= p) ? wave_sum(sc[s]) + CK[(size_t)h * CKP + s] : -INFINITY; m = fmaxf(m, sc[s]); }
    float l = 0.f, o = 0.f;
#pragma unroll
    for (int s = 0; s < NMETA; ++s) { const float pw = __builtin_amdgcn_exp2f(sc[s] - m); l += pw; o += pw * vv[s]; }
    o /= l;
    const float ss = wave_sum(o * o);
    OB[(size_t)(META0 + p) * DM + 512 + h * 64 + lane] = f2bf(o * rsqrtf(ss * (1.0f / 64.0f) + EPS) * fnorm[h * 64 + lane]);
}
__device__ __forceinline__ void gla_readout_wave(const bf16* QKV, const float* UT, bf16* OB, const float* gnorm, int wu, int lane) {
    asm volatile("" : "+v"(lane));
    const int half = wu & 1, t = wu >> 1, cc = t % NCH, bh = t / NCH, b = bh >> 2, h = bh & 3;
    if (cc == 0 && (half == 1 || b != 0)) return;
    const int r32 = lane & 31, hi = lane >> 5;
    const int row0 = cc == 0 ? META0 : b * SEQ + (cc - 1) * 64 + 32 * half, nvalid = cc == 0 ? NMETA : 32;
    const float* Sp = UT + (size_t)(bh * NCH + cc) * 8192;
    f32x16 acc[4] = {};
#pragma unroll
    for (int j = 0; j < 4; ++j) {
        const bf16x8 bq = *(const bf16x8*)(QKV + (size_t)(row0 + r32) * QP + C_GQ + h * 64 + 16 * j + 8 * hi);
#pragma unroll
        for (int blk = 0; blk < 4; ++blk) {
            const float* sp = Sp + (32 * blk + r32) * 64 + 16 * j + 8 * hi;
            const f32x4 s0 = *(const f32x4*)sp, s1 = *(const f32x4*)(sp + 4);
            u32x4 w; w.x = pk2(s0[0], s0[1]); w.y = pk2(s0[2], s0[3]); w.z = pk2(s1[0], s1[1]); w.w = pk2(s1[2], s1[3]);
            acc[blk] = __builtin_amdgcn_mfma_f32_32x32x16_bf16(__builtin_bit_cast(bf16x8, w), bq, acc[blk], 0, 0, 0);
        }
    }
    float ss = 0.f;
#pragma unroll
    for (int blk = 0; blk < 4; ++blk)
#pragma unroll
        for (int r = 0; r < 16; ++r) ss += acc[blk][r] * acc[blk][r];
    ss += __shfl_xor(ss, 32);
    const float rs = rsqrtf(ss * (1.0f / 128.0f) + EPS);
    if (r32 < nvalid) {
        const size_t row = (size_t)row0 + r32;
#pragma unroll
        for (int blk = 0; blk < 4; ++blk)
#pragma unroll
            for (int g = 0; g < 4; ++g) {
                const int dv = 32 * blk + 8 * g + 4 * hi;
                const u32x2 gt = *(const u32x2*)(QKV + row * QP + C_GR + h * 128 + dv);
                const f32x4 wn = *(const f32x4*)(gnorm + h * 128 + dv);
                const float g0 = __uint_as_float(gt.x << 16), g1 = __uint_as_float(gt.x & 0xffff0000u), g2 = __uint_as_float(gt.y << 16), g3 = __uint_as_float(gt.y & 0xffff0000u);
                u32x2 w;
                w.x = pk2(acc[blk][4 * g] * rs * wn[0] * siluf(g0), acc[blk][4 * g + 1] * rs * wn[1] * siluf(g1));
                w.y = pk2(acc[blk][4 * g + 2] * rs * wn[2] * siluf(g2), acc[blk][4 * g + 3] * rs * wn[3] * siluf(g3));
                *(u32x2*)(OB + row * DM + h * 128 + dv) = w;
            }
    }
}

#define FRESH() KArgs ka_ = kargs(); Args a; a.x = gptr(ka_->x); a.meta = gptr(ka_->meta); a.attn_norm = gptr(ka_->attn_norm); a.w_in = gptr(ka_->w_in); a.w_au = gptr(ka_->w_au); a.b_alpha = gptr(ka_->b_alpha); a.b_forget = gptr(ka_->b_forget); a.gla_norm = gptr(ka_->gla_norm); a.fox_norm = gptr(ka_->fox_norm); a.w_out = gptr(ka_->w_out); a.ffn_norm = gptr(ka_->ffn_norm); a.w_up = gptr(ka_->w_up); a.conv_w = gptr(ka_->conv_w); a.conv_b = gptr(ka_->conv_b); a.w_down = gptr(ka_->w_down); a.final_norm = gptr(ka_->final_norm); a.out = gptr(ka_->out); a.ws = gptr(ka_->ws); unsigned char* ws = a.ws; \
    bf16* HB = (bf16*)(ws + WS_HB); bf16* OB = (bf16*)(ws + WS_OB); bf16* QKV = (bf16*)(ws + WS_QKV); bf16* A2 = (bf16*)(ws + WS_QKV); \
    float* UT = (float*)(ws + WS_UT); float* HF = (float*)(ws + WS_UT); float* HL = (float*)(ws + WS_UT + HFL_SIZE); \
    float* SM = (float*)(ws + WS_SM); float* CK = (float*)(ws + WS_CK); float* DEC = (float*)(ws + WS_DEC); float* HM = (float*)(ws + WS_HM); float* SSQ = (float*)(ws + WS_SSQ); \
    unsigned char* wl = ws + WS_W + (size_t)L * WL_SIZE; \
    (void)HB; (void)OB; (void)QKV; (void)A2; (void)UT; (void)HF; (void)HL; (void)SM; (void)CK; (void)DEC; (void)HM; (void)SSQ; (void)wl; \
    int tid_ = threadIdx.x; asm volatile("" : "+v"(tid_)); const int tid = tid_, lane = tid & 63, wid = __builtin_amdgcn_readfirstlane(tid >> 6); \
    const int gw = bx * 8 + wid, NGW = G * 8, gt = bx * 512 + tid, NGT = G * 512; (void)lane; (void)gw; (void)NGW; (void)gt; (void)NGT;
#ifndef REP_A
#define REP_A 1
#endif
#ifndef REP_CA
#define REP_CA 1
#endif
#ifndef REP_F
#define REP_F 1
#endif
#ifndef REP_B
#define REP_B 1
#endif
#ifndef REP_D
#define REP_D 1
#endif
#define GSYNC_CG() do { asm volatile("s_waitcnt vmcnt(0) lgkmcnt(0)" ::: "memory"); grid.sync(); __builtin_amdgcn_fence(__ATOMIC_ACQUIRE, "agent"); asm volatile("s_waitcnt vmcnt(0)" ::: "memory"); } while (0)
#define GSYNC() xcd_barrier(xbar)
__global__ void __launch_bounds__(512, 2) fwd_kernel(Args a_unused) {
    extern __shared__ __attribute__((aligned(16))) unsigned char lds_raw[];
    LAS unsigned char* lds = (LAS unsigned char*)lds_raw;
    cg::grid_group grid = cg::this_grid();
    const int G = gridDim.x, bx = blockIdx.x;
    volatile LAS unsigned* xst = (volatile LAS unsigned*)(lds + HALO_OFF + 8192 + 1024);
    if (threadIdx.x < 2) xst[threadIdx.x] = 0u;
    __syncthreads();
    const XcdBarrier xbar = xcd_barrier_post((unsigned*)(gptr(kargs()->ws) + WS_BAR), xst);
#ifndef REP_P
#define REP_P 1
#endif
    for (int rep = 0; rep < REP_P; ++rep) {
        const int L = 0; FRESH();
        LAS float* scr = (LAS float*)(lds + wid * 16384);
        constexpr int I_IN = 16 * (NINP / 32), I_OUT = 16 * 32, I_UP = 16 * (NUP / 32), I_DN = (DFF / 64) * 32, I_L = I_IN + I_OUT + I_UP + I_DN;
        for (int it = gw; it < DEPTH * I_L; it += NGW) {
            const int L = it / I_L; int r = it % I_L;
            unsigned char* wl = ws + WS_W + (size_t)L * WL_SIZE;
            if (r < I_IN) { const int nb = NINP / 32; tr_item(a.w_in + (size_t)L * DM * 3096, 3096, (bf16*)(wl + WL_IN), DM, a.attn_norm + L * DM, 0, scr, 64 * (r / nb), 32 * (r % nb), lane); continue; } r -= I_IN;
            if (r < I_OUT) { tr_item(a.w_out + (size_t)L * DM * DM, DM, (bf16*)(wl + WL_OUT), DM, nullptr, 1, scr, 64 * (r / 32), 32 * (r % 32), lane); continue; } r -= I_OUT;
            if (r < I_UP) { const int nb = NUP / 32; tr_item(a.w_up + (size_t)L * DM * NUP, NUP, (bf16*)(wl + WL_UP), DM, a.ffn_norm + L * DM, 2, scr, 64 * (r / nb), 32 * (r % nb), lane); continue; } r -= I_UP;
            tr_item(a.w_down + (size_t)L * DFF * DM, DM, (bf16*)(wl + WL_DN), DFF, nullptr, 3, scr, 64 * (r / 32), 32 * (r % 32), lane);
        }
        for (int i = gt; i < (256 - NMETA) * 4; i += NGT) SSQ[(size_t)(META0 + NMETA) * 4 + i] = 0.f;
        for (int r = gw; r < MREAL + 256; r += NGW) {
            if (r < MREAL) row_to_bf16(a.x + (size_t)r * DM, HB + (size_t)r * DM, SSQ + (size_t)r * 4, nullptr, lane);
            else if (r < MREAL + NMETA) row_to_bf16(a.meta + (size_t)(r - MREAL) * DM, HB + (size_t)r * DM, SSQ + (size_t)r * 4, HM + (size_t)(r - MREAL) * DM, lane);
            else {
#pragma unroll
                for (int j = 0; j < 4; ++j) { ((f32x4*)(HM + (size_t)(r - MREAL) * DM) + lane)[64 * j] = (f32x4){0.f, 0.f, 0.f, 0.f};
                    ((u32x2*)(HB + (size_t)r * DM) + lane)[64 * j] = (u32x2){0u, 0u}; ((u32x2*)(OB + (size_t)r * DM) + lane)[64 * j] = (u32x2){0u, 0u}; }
            }
        }
    }
    GSYNC_CG();

    for (int L = 0; L < DEPTH; ++L) {
#ifndef SKIP_A
        {
            FRESH();
            pg8::Gemm g{HB, (const bf16*)(wl + WL_IN), MROWS, NINP, DM}; pg8::StaticOrder S; S.init(MROWS, NINP, G, bx);
            EpiIn E{2 * L};
            for (int rep = 0; rep < REP_A; ++rep) pg8::gemm_phase<EpiIn, pg8::StaticOrder, true, true>(lds, g, S, E);
        }
#endif
        GSYNC();
#ifndef SKIP_B
        { FRESH();
        for (int rep = 0; rep < REP_B; ++rep)
        for (int u = bx; u < 32 * NCH + 64; u += G) {
            if (u < 32 * NCH) gla_u_unit(lds, QKV, SM, a.w_au + (size_t)L * 16 * 256, a.b_alpha + L * 256, UT, DEC, u / NCH, u % NCH);
            else fox_cumsum_unit(lds, SM, a.b_forget + L * 8, CK, u - 32 * NCH);
        }
        }
#endif
        GSYNC();
#ifndef SKIP_CS
        { FRESH();
        for (int e = gt; e < 32 * 2048; e += NGT) {
            const int bh = e >> 11, rem = (e & 2047) * 4, dk = rem & 63;
            float* up = UT + (size_t)bh * NCH * 8192 + rem; const float* dp = DEC + (size_t)bh * NCH * 64 + dk;
            f32x4 Sv = *(const f32x4*)up;
            for (int c0 = 1; c0 <= 64; c0 += 8) {
                f32x4 uu[8], dd[8];
#pragma unroll
                for (int i = 0; i < 8; ++i) { uu[i] = *(const f32x4*)(up + (size_t)(c0 + i) * 8192); dd[i] = *(const f32x4*)(dp + (c0 + i) * 64); }
#pragma unroll
                for (int i = 0; i < 8; ++i) { Sv = dd[i] * Sv + uu[i]; *(f32x4*)(up + (size_t)(c0 + i) * 8192) = Sv; }
            }
        }
        }
        { FRESH();
        for (int rep = 0; rep < REP_CA; ++rep)
        for (int v = bx; v < 256; v += G) {
            const int bhh = v >> 2, s = v & 3;
#pragma unroll 1
            for (int i = 0; i < 4; ++i) {
                const int qb = (i == 0) ? s : (i == 1) ? 7 - s : (i == 2) ? 8 + s : 15 - s;
                attn_unit(lds, QKV, CK, OB, a.fox_norm + L * 512, bhh >> 3, bhh & 7, qb);
            }
        }
#endif
#ifndef SKIP_CM
        }
        { FRESH();
#ifndef REP_CM
#define REP_CM 1
#endif
        for (int rep = 0; rep < REP_CM; ++rep)
        if (bx < NMETA) meta_attn(QKV, CK, OB, a.fox_norm + L * 512, bx);
        }
#endif
        GSYNC();
#ifndef SKIP_D
        { FRESH();
        for (int rep = 0; rep < REP_D; ++rep)
        for (int wu = gw; wu < 32 * NCH * 2; wu += NGW) gla_readout_wave(QKV, UT, OB, a.gla_norm + L * 512, wu, lane);
        }
#endif
        GSYNC();
#ifndef SKIP_E
        {
            FRESH();
            pg8::Gemm g{OB, (const bf16*)(wl + WL_OUT), MROWS, DM, DM}; pg8::StaticOrder S; S.init(MROWS, DM, G, bx);
            EpiRes E{L == 0 ? 1 : 0, 2 * L + 1};
            pg8::gemm_phase<EpiRes, pg8::StaticOrder, true, true>(lds, g, S, E);
        }
#endif
        GSYNC();
#ifndef SKIP_F
        {
            FRESH();
            pg8::Gemm g{HB, (const bf16*)(wl + WL_UP), MROWS, NUP, DM}; pg8::StaticOrder S; S.init(MROWS, NUP, G, bx);
            EpiUp E{L};
            for (int rep = 0; rep < REP_F; ++rep) pg8::gemm_phase<EpiUp, pg8::StaticOrder, true, true>(lds, g, S, E);
        }
#endif
        GSYNC();
#ifndef SKIP_G
        {
            FRESH();
            const float* cw = a.conv_w + (size_t)L * 3 * NUP; const float* cb = a.conv_b + (size_t)L * NUP;
            for (int i = gt; i < 129 * 2 * (DFF / 4); i += NGT) {
                const int c4 = i % (DFF / 4), rr = (i / (DFF / 4)) & 1, pm = i / (2 * (DFF / 4));
                const int ch = 4 * c4;
                f32x4 hc[2];
#pragma unroll
                for (int bj = 0; bj < 2; ++bj) {
                    const int c = bj * DFF + ch;
                    f32x4 P0 = {0.f, 0.f, 0.f, 0.f}, P1 = P0;
                    if (pm != 128) { const int src = (pm % 16 == 0) ? 128 : pm - 1; P0 = *(const f32x4*)(HL + (size_t)(src * 2) * NUP + c); P1 = *(const f32x4*)(HL + (size_t)(src * 2 + 1) * NUP + c); }
                    const f32x4 H0 = *(const f32x4*)(HF + (size_t)(pm * 2) * NUP + c), H1 = *(const f32x4*)(HF + (size_t)(pm * 2 + 1) * NUP + c);
                    const f32x4 x2 = rr == 0 ? P0 : P1, x1 = rr == 0 ? P1 : H0, x0 = rr == 0 ? H0 : H1;
                    hc[bj] = *(const f32x4*)(cb + c) + *(const f32x4*)(cw + c) * x2 + *(const f32x4*)(cw + NUP + c) * x1 + *(const f32x4*)(cw + 2 * NUP + c) * x0;
                }
                u32x2 w;
                w.x = pk2(siluf(hc[1][0]) * hc[0][0], siluf(hc[1][1]) * hc[0][1]);
                w.y = pk2(siluf(hc[1][2]) * hc[0][2], siluf(hc[1][3]) * hc[0][3]);
                *(u32x2*)(A2 + (size_t)(pm * 256 + rr) * DFF + ch) = w;
            }
        }
#endif
        GSYNC();
#ifndef SKIP_H
        {
            FRESH();
            pg8::Gemm g{A2, (const bf16*)(wl + WL_DN), MROWS, DM, DFF}; pg8::StaticOrder S; S.init(MROWS, DM, G, bx);
            EpiRes E{0, 2 * L + 2};
            pg8::gemm_phase<EpiRes, pg8::StaticOrder, true, true>(lds, g, S, E);
        }
#endif
        GSYNC();
    }
    {
        const int L = 0; FRESH();
        const float* ssq = ssq_arr(ws, 8);
        for (int r = gw; r < MREAL; r += NGW) {
            const float rs = row_rstd(ssq, r);
            f32x4* p = (f32x4*)(a.out + (size_t)r * DM) + lane; const f32x4* wn = (const f32x4*)a.final_norm + lane;
#pragma unroll
            for (int j = 0; j < 4; ++j) p[64 * j] = p[64 * j] * rs * wn[64 * j];
        }
    }
}

extern "C" void kernel_launch(void* const* d_in, const int* in_sizes, int n_in, void* d_out, int out_size, void* d_ws, size_t ws_size, hipStream_t stream) {
    static int grid = 0;
    if (grid == 0) {
        if (n_in != 16 || out_size != MREAL * DM || ws_size < WS_END) { fprintf(stderr, "kernel_launch: unexpected problem (n_in %d out %d ws %zu, need %zu)\n", n_in, out_size, ws_size, (size_t)WS_END); grid = -1; return; }
        int dev = 0, cus = 0, per = 0;
        (void)hipGetDevice(&dev); (void)hipDeviceGetAttribute(&cus, hipDeviceAttributeMultiprocessorCount, dev);
        (void)hipFuncSetAttribute((const void*)fwd_kernel, hipFuncAttributeMaxDynamicSharedMemorySize, LDS_BYTES);
        (void)hipOccupancyMaxActiveBlocksPerMultiprocessor(&per, (const void*)fwd_kernel, 512, LDS_BYTES);
        if (per < 1) per = 1;
        grid = cus * per;
        fprintf(stderr, "kernel_launch: grid %d (cus %d x %d), ws %zu\n", grid, cus, per, ws_size);
    }
    if (grid < 0) return;
    Args a{};
    const float** f = (const float**)&a;
    for (int i = 0; i < 16; ++i) f[i] = (const float*)d_in[i];
    a.out = (float*)d_out; a.ws = (unsigned char*)d_ws;
    (void)hipMemsetAsync((unsigned char*)d_ws + WS_BAR, 0, BAR_BYTES, stream);
    void* args[] = {&a};
    hipError_t e = hipLaunchCooperativeKernel((const void*)fwd_kernel, dim3(grid), dim3(512), args, LDS_BYTES, stream);
    if (e != hipSuccess) fprintf(stderr, "cooperative launch failed: %s (grid %d)\n", hipGetErrorString(e), grid);
}
```

```cpp
#include <hip/hip_runtime.h>
#include <hip/hip_cooperative_groups.h>
#include <cstdio>
#include <cstdint>
namespace cg = cooperative_groups;
namespace pg8 {
#define PG8_LAS __attribute__((address_space(3)))
typedef unsigned short bf16_t;
typedef short bf16x8 __attribute__((ext_vector_type(8)));
typedef float f32x4 __attribute__((ext_vector_type(4)));
typedef unsigned u32x4 __attribute__((ext_vector_type(4)));
constexpr int BM = 256, BK = 64, HALF = 128, HTB = HALF * BK * 2  , STAGE_BYTES = 8 * HTB, NXCD = 8, WGM = 8;

__host__ __device__ __forceinline__ int lds_byte(int r, int c) { const int st = (r >> 4) * 2 + (c >> 5), rr = r & 15, cc = c & 31, ob = rr * 64 + cc * 2; return st * 1024 + (ob ^ (((ob >> 9) & 1) << 5)); }
__host__ __device__ __forceinline__ void stage_rc(int b, int& R, int& C) { const int st = b / 1024, sb = b % 1024, swz = sb ^ (((sb >> 9) & 1) << 5); R = (st >> 1) * 16 + swz / 64; C = (st & 1) * 32 + (swz % 64) / 2; }
__host__ __device__ __forceinline__ int perm32(int rho) { const int n = rho >> 4, i = rho & 15; return 8 * (i >> 2) + 4 * n + (i & 3); }

struct Unit { int pm, pn; };
struct Gemm { const bf16_t* A; const bf16_t* Bt; int M, N, K; };

struct StaticOrder {
    int nM, nN, nwg, G, c;
    __host__ __device__ void init(int M, int N, int G_, int c_) { nM = M / BM; nN = N / BM; nwg = nM * nN; G = G_; c = c_; }
    __host__ __device__ bool next(int i, Unit& u) const {
        const long L = (long)i * G + c; if (L >= nwg) return false;
        int wgid = (int)L; { const int q = nwg / NXCD, r = nwg % NXCD, xcd = wgid % NXCD, off = wgid / NXCD; wgid = (xcd < r ? xcd * (q + 1) : r * (q + 1) + (xcd - r) * q) + off; }
        const int nig = WGM * nN, gid = wgid / nig, fm = gid * WGM, gsz = (nM - fm) < WGM ? (nM - fm) : WGM;
        u.pm = fm + ((wgid % nig) % gsz); u.pn = (wgid % nig) / gsz; return true;
    }
    __device__ __forceinline__ void a_ready(const Unit&) const {}
    __device__ __forceinline__ void done(const Unit&) const {}
};

__device__ __forceinline__ unsigned cvt_pk_bf16(float lo, float hi) { unsigned r; asm volatile("v_cvt_pk_bf16_f32 %0, %1, %2" : "=v"(r) : "v"(lo), "v"(hi)); return r; }
typedef float f32x2 __attribute__((ext_vector_type(2)));
template <class Epi, class Sched, bool ALIGN_EPI = false, bool SP2 = false>
__device__ __forceinline__ void gemm_phase(PG8_LAS unsigned char* lds, const Gemm g, const Sched& S, const Epi& E) {
    int tid_ = threadIdx.x; asm volatile("" : "+v"(tid_)); const int tid = tid_, wid = __builtin_amdgcn_readfirstlane(tid >> 6), lane = tid & 63, wr = wid >> 2, wc = wid & 3, fr = lane & 15, fq = lane >> 4;
    const int K = g.K, nt = K / BK;
    unsigned voffA[2], voffB[2];
#pragma unroll
    for (int i = 0; i < 2; ++i) { int R, C; stage_rc(tid * 16 + i * 8192, R, C); const int Rb = Epi::PERM ? ((R & ~31) + perm32(R & 31)) : R;
        voffA[i] = (unsigned)(R * K + C) * 2u; voffB[i] = (unsigned)(Rb * K + C) * 2u; }
    const size_t kstep = (size_t)(BK * 2);
    const size_t hstep = (size_t)HALF * K * 2;
    const size_t tstep = 2 * hstep;
    const unsigned ldsw = (unsigned)wid * 1024u;
    const int aoff = lds_byte(wr * 64 + fr, fq * 8), boff = lds_byte(wc * 32 + fr, fq * 8);
#define PG8_SA(b, h) (((b) * 2 + (h)) * HTB)
#define PG8_SB(b, h) ((4 + (b) * 2 + (h)) * HTB)
#define PG8_STAGE(bufoff, gbase, voff) do { _Pragma("unroll") for (int _i = 0; _i < 2; ++_i) \
        __builtin_amdgcn_global_load_lds((const unsigned*)((const char*)(gbase) + (voff)[_i]), (PG8_LAS unsigned*)(lds + (bufoff) + ldsw + _i * 8192), 16, 0, 0); } while (0)
#define PG8_LDA(dst, b, h) do { _Pragma("unroll") for (int m = 0; m < 4; ++m) _Pragma("unroll") for (int k = 0; k < 2; ++k) dst[m][k] = *(const PG8_LAS bf16x8*)(lds + PG8_SA(b, h) + aoff + m * 2048 + k * 1024); } while (0)
#define PG8_LDB(dst, b, h) do { _Pragma("unroll") for (int n = 0; n < 2; ++n) _Pragma("unroll") for (int k = 0; k < 2; ++k) dst[n][k] = *(const PG8_LAS bf16x8*)(lds + PG8_SB(b, h) + boff + n * 2048 + k * 1024); } while (0)
#define PG8_MMA(ai, bj, At, Bt) do { __builtin_amdgcn_s_setprio(1); _Pragma("unroll") for (int m = 0; m < 4; ++m) _Pragma("unroll") for (int n = 0; n < 2; ++n) _Pragma("unroll") for (int k = 0; k < 2; ++k) \
        acc[ai][bj][m][n] = __builtin_amdgcn_mfma_f32_16x16x32_bf16(Bt[n][k], At[m][k], acc[ai][bj][m][n], 0, 0, 0); __builtin_amdgcn_s_setprio(0); } while (0)
#define PG8_WAIT_V(n) asm volatile("s_waitcnt vmcnt(" #n ")" ::: "memory")
#define PG8_WAIT_L(n) asm volatile("s_waitcnt lgkmcnt(" #n ")" ::: "memory")
#define PG8_BAR __builtin_amdgcn_s_barrier()
#define PG8_SCHED __builtin_amdgcn_sched_barrier(0)
    Unit cur, nxt; int ui = 0;
    if (!S.next(0, cur)) return;
    f32x4 acc[2][2][4][2];
#pragma unroll
    for (int a = 0; a < 2; ++a)
#pragma unroll
        for (int b = 0; b < 2; ++b)
#pragma unroll
            for (int m = 0; m < 4; ++m)
#pragma unroll
                for (int n = 0; n < 2; ++n) acc[a][b][m][n] = (f32x4){0.f, 0.f, 0.f, 0.f};
    bf16x8 At[4][2], B0[2][2], B1[2][2];
    const char* cA = (const char*)g.A + (size_t)cur.pm * tstep; const char* cB = (const char*)g.Bt + (size_t)cur.pn * tstep;
    S.a_ready(cur);
    if constexpr (SP2) {
        PG8_STAGE(PG8_SB(0, 0), cB, voffB); PG8_STAGE(PG8_SB(0, 1), cB + hstep, voffB); PG8_STAGE(PG8_SA(0, 0), cA, voffA); PG8_STAGE(PG8_SA(0, 1), cA + hstep, voffA);
        if (wr == 1) PG8_BAR;
        PG8_WAIT_V(2); PG8_BAR;
        PG8_STAGE(PG8_SB(1, 0), cB + kstep, voffB); PG8_STAGE(PG8_SA(1, 0), cA + kstep, voffA); PG8_STAGE(PG8_SB(1, 1), cB + hstep + kstep, voffB);
        PG8_WAIT_V(6); PG8_BAR;
    } else {
        PG8_STAGE(PG8_SB(0, 0), cB, voffB); PG8_STAGE(PG8_SA(0, 0), cA, voffA); PG8_STAGE(PG8_SB(0, 1), cB + hstep, voffB); PG8_STAGE(PG8_SA(0, 1), cA + hstep, voffA);
        if (wr == 1) PG8_BAR;
        PG8_WAIT_V(4); PG8_BAR;
        PG8_STAGE(PG8_SB(1, 0), cB + kstep, voffB); PG8_STAGE(PG8_SA(1, 0), cA + kstep, voffA); PG8_STAGE(PG8_SB(1, 1), cB + hstep + kstep, voffB);
        PG8_WAIT_V(6); PG8_BAR;
    }
    for (;;) {
        const bool has_next = S.next(ui + 1, nxt);
        const char* nA = has_next ? (const char*)g.A + (size_t)nxt.pm * tstep : cA; const char* nB = has_next ? (const char*)g.Bt + (size_t)nxt.pn * tstep : cB;
        for (int t = 0; t < nt; t += 2) {
            const bool last = (t == nt - 2);
            const char* a1 = cA + (size_t)(t + 1) * kstep;
            const char* a2 = last ? nA : cA + (size_t)(t + 2) * kstep; const char* b2 = last ? nB : cB + (size_t)(t + 2) * kstep;
            const char* a3 = a2 + kstep; const char* b3 = b2 + kstep;
            if (last && has_next) S.a_ready(nxt);
            if constexpr (SP2) {
            PG8_LDB(B0, 0, 0); PG8_LDB(B1, 0, 1); PG8_SCHED; PG8_LDA(At, 0, 0); PG8_STAGE(PG8_SA(1, 1), a1 + hstep, voffA);
            PG8_WAIT_V(8); PG8_WAIT_L(0); PG8_BAR; PG8_MMA(0, 0, At, B0); PG8_MMA(0, 1, At, B1); PG8_BAR; PG8_SCHED;
            PG8_LDA(At, 0, 1); PG8_STAGE(PG8_SB(0, 0), b2, voffB); PG8_STAGE(PG8_SB(0, 1), b2 + hstep, voffB); PG8_STAGE(PG8_SA(0, 0), a2, voffA);
            PG8_WAIT_V(8); PG8_WAIT_L(0); PG8_BAR; PG8_MMA(1, 0, At, B0); PG8_MMA(1, 1, At, B1); PG8_BAR; PG8_SCHED;
            PG8_LDB(B0, 1, 0); PG8_LDB(B1, 1, 1); PG8_SCHED; PG8_LDA(At, 1, 0); PG8_STAGE(PG8_SA(0, 1), a2 + hstep, voffA);
            PG8_WAIT_V(8); PG8_WAIT_L(0); PG8_BAR; PG8_MMA(0, 0, At, B0); PG8_MMA(0, 1, At, B1); PG8_BAR; PG8_SCHED;
            PG8_LDA(At, 1, 1); PG8_STAGE(PG8_SB(1, 0), b3, voffB); PG8_STAGE(PG8_SB(1, 1), b3 + hstep, voffB); PG8_STAGE(PG8_SA(1, 0), a3, voffA);
            PG8_WAIT_V(8); PG8_WAIT_L(0); PG8_BAR; PG8_MMA(1, 0, At, B0); PG8_MMA(1, 1, At, B1); PG8_BAR; PG8_SCHED;
            } else {
            PG8_LDB(B0, 0, 0); PG8_SCHED; PG8_LDA(At, 0, 0); PG8_STAGE(PG8_SA(1, 1), a1 + hstep, voffA);
            PG8_WAIT_L(8); PG8_BAR; PG8_WAIT_L(0); PG8_MMA(0, 0, At, B0); PG8_BAR; PG8_SCHED;
            PG8_LDB(B1, 0, 1); PG8_STAGE(PG8_SB(0, 0), b2, voffB);
            PG8_BAR; PG8_WAIT_L(0); PG8_MMA(0, 1, At, B1); PG8_BAR;
            PG8_LDA(At, 0, 1); PG8_STAGE(PG8_SA(0, 0), a2, voffA);
            PG8_BAR; PG8_WAIT_L(0); PG8_MMA(1, 0, At, B0); PG8_BAR; PG8_SCHED;
            PG8_STAGE(PG8_SB(0, 1), b2 + hstep, voffB);
            PG8_WAIT_V(6); PG8_BAR; PG8_MMA(1, 1, At, B1); PG8_BAR;
            PG8_LDB(B0, 1, 0); PG8_SCHED; PG8_LDA(At, 1, 0); PG8_STAGE(PG8_SA(0, 1), a2 + hstep, voffA);
            PG8_WAIT_L(8); PG8_BAR; PG8_WAIT_L(0); PG8_MMA(0, 0, At, B0); PG8_BAR; PG8_SCHED;
            PG8_LDB(B1, 1, 1); PG8_STAGE(PG8_SB(1, 0), b3, voffB);
            PG8_BAR; PG8_WAIT_L(0); PG8_MMA(0, 1, At, B1); PG8_BAR;
            PG8_LDA(At, 1, 1); PG8_STAGE(PG8_SA(1, 0), a3, voffA);
            PG8_BAR; PG8_WAIT_L(0); PG8_MMA(1, 0, At, B0); PG8_BAR; PG8_SCHED;
            PG8_STAGE(PG8_SB(1, 1), b3 + hstep, voffB);
            PG8_WAIT_V(6); PG8_BAR; PG8_MMA(1, 1, At, B1); PG8_BAR;
            }
        }
        if constexpr (ALIGN_EPI) { if (wr == 0) PG8_BAR; }
        if constexpr (!Epi::AFTER_DRAIN) { E(acc, cur, wr, wc, fr, fq); S.done(cur); }
        if (!has_next) break;
#pragma unroll
        for (int a = 0; a < 2; ++a)
#pragma unroll
            for (int b = 0; b < 2; ++b)
#pragma unroll
                for (int m = 0; m < 4; ++m)
#pragma unroll
                    for (int n = 0; n < 2; ++n) acc[a][b][m][n] = (f32x4){0.f, 0.f, 0.f, 0.f};
        cur = nxt; cA = nA; cB = nB; ++ui;
        if constexpr (ALIGN_EPI) { if (wr == 1) PG8_BAR; }
    }
    PG8_WAIT_V(0);
    if constexpr (!ALIGN_EPI) { if (wr == 0) PG8_BAR; }
    PG8_BAR;
    if constexpr (Epi::AFTER_DRAIN) { E.fused(acc, cur, wr, wc, fr, fq, lds, wid, lane); S.done(cur); }
#undef PG8_SA
#undef PG8_SB
#undef PG8_STAGE
#undef PG8_LDA
#undef PG8_LDB
#undef PG8_MMA
#undef PG8_WAIT_V
#undef PG8_WAIT_L
#undef PG8_BAR
#undef PG8_SCHED
}
}
#define LAS __attribute__((address_space(3)))
typedef unsigned short bf16;
typedef short bf16x8 __attribute__((ext_vector_type(8)));
typedef short s16x4 __attribute__((ext_vector_type(4)));
typedef float f32x4 __attribute__((ext_vector_type(4)));
typedef float f32x16 __attribute__((ext_vector_type(16)));
typedef unsigned u32x4 __attribute__((ext_vector_type(4)));
typedef unsigned u32x2 __attribute__((ext_vector_type(2)));

constexpr int NB = 8, SEQ = 4096, DM = 1024, DEPTH = 4, NMETA = 16;
constexpr int MREAL = NB * SEQ;
constexpr int META0 = MREAL;
constexpr int MROWS = 129 * 256;
constexpr int NINP = 3328, QP = 3072;
constexpr int C_FQ = 0, C_FK = 512, C_FV = 1024, C_GQ = 1536, C_GK = 1792, C_GV = 2048, C_GR = 2560;
constexpr int DFF = 2816, NUP = 5632;
constexpr float EPS = 1e-6f, LOG2E = 1.4426950408889634f, C2 = 0.125f * LOG2E;
constexpr int CKP = 4160;
constexpr int NCH = 65;

constexpr size_t MiB = 1u << 20;
constexpr size_t WL_IN = 0, WL_OUT = 6815744, WL_UP = 8912896, WL_DN = 20447232, WL_SIZE = 26214400;
constexpr size_t WS_W = 0, WS_HB = 100 * MiB, WS_OB = WS_HB + 67633152, WS_QKV = WS_OB + 67633152, WS_UT = WS_QKV + 202899456;
constexpr size_t WS_SM = WS_UT + 68157440, WS_CK = WS_SM + 4456448, WS_DEC = WS_CK + 1310720, WS_HM = WS_DEC + 786432, WS_SSQ = WS_HM + MiB, WS_BAR = WS_SSQ + 1835008, BAR_BYTES = 16384, WS_END = WS_BAR + BAR_BYTES;
static_assert(WS_END <= 512 * MiB, "workspace map");
constexpr size_t HFL_SIZE = (size_t)129 * 2 * NUP * 4;
static_assert(2 * HFL_SIZE <= 68157440, "halo overlay");

constexpr int LDS_BYTES = 147456, HALO_OFF = 131072;

struct Args {
    const float *x, *meta, *attn_norm, *w_in, *w_au, *b_alpha, *b_forget, *gla_norm, *fox_norm, *w_out, *ffn_norm, *w_up, *conv_w, *conv_b, *w_down, *final_norm;
    float* out; unsigned char* ws;
};

#define GAS __attribute__((address_space(1)))
#define CAS __attribute__((address_space(4)))
typedef const CAS Args* KArgs;
__device__ __forceinline__ KArgs kargs() { KArgs p = (KArgs)__builtin_amdgcn_kernarg_segment_ptr(); asm volatile("" : "+s"(p)); return p; }
template <class T> __device__ __forceinline__ T* gptr(T* p) { return (T*)(GAS T*)p; }
__device__ __forceinline__ float bf2f(bf16 v) { return __uint_as_float((unsigned)v << 16); }
__device__ __forceinline__ unsigned pk2(float lo, float hi) { return pg8::cvt_pk_bf16(lo, hi); }
__device__ __forceinline__ bf16 f2bf(float v) { return (bf16)(pk2(v, 0.f) & 0xffffu); }
__device__ __forceinline__ float wave_sum(float v) {
#pragma unroll
    for (int o = 1; o < 64; o <<= 1) v += __shfl_xor(v, o);
    return v;
}
__device__ __forceinline__ float logsigmoidf(float z) { return -(fmaxf(-z, 0.f) + log1pf(__expf(-fabsf(z)))); }
__device__ __forceinline__ float siluf(float v) { return v * __builtin_amdgcn_rcpf(1.f + __builtin_amdgcn_exp2f(-LOG2E * v)); }
__device__ __forceinline__ int crow(int r, int hi) { return (r & 3) + 8 * (r >> 2) + 4 * hi; }
__device__ __forceinline__ s16x4 vtr(const LAS unsigned char* p) { return __builtin_bit_cast(s16x4, __builtin_amdgcn_ds_read_tr16_b64_v4i16((LAS s16x4*)p)); }
__device__ __forceinline__ bf16x8 cat8(s16x4 a, s16x4 b) { return (bf16x8){a[0], a[1], a[2], a[3], b[0], b[1], b[2], b[3]}; }
__device__ __forceinline__ float dppf(float old, float src, int ctrl_unused);
#define DPP_MOV(old, src, ctrl) __builtin_bit_cast(float, __builtin_amdgcn_update_dpp(__builtin_bit_cast(int, (float)(old)), __builtin_bit_cast(int, (float)(src)), (ctrl), 0xf, 0xf, false))
#define LDS_WAIT() asm volatile("s_waitcnt lgkmcnt(0)" ::: "memory")

__device__ __forceinline__ const float* ssq_arr(unsigned char* wsb, int si) { return (const float*)(wsb + WS_SSQ) + (size_t)(si % 3) * MROWS * 4; }
__device__ __forceinline__ float row_rstd(const float* ssqp, int row) { const f32x4 s = *(const f32x4*)(ssqp + (size_t)row * 4); return rsqrtf(((s[0] + s[1]) + (s[2] + s[3])) * (1.0f / DM) + EPS); }
__device__ __forceinline__ LAS float* tile_rstd(unsigned char* wsb, int si, int pm, int wr, int wc, int fr, int fq) {
    extern __shared__ __attribute__((aligned(16))) unsigned char lds_dyn_[];
    LAS float* rsl = (LAS float*)((LAS unsigned char*)lds_dyn_ + HALO_OFF + 8192);
    const int tl = (wr * 4 + wc) * 64 + fq * 16 + fr;
    if (pm != 128) {
        if (tl < 256) rsl[tl] = row_rstd(ssq_arr(wsb, si), pm * 256 + tl);
    } else {
        const int row = tl >> 5, part = tl & 31;
        const f32x4* hp = (const f32x4*)((const float*)(wsb + WS_HM) + (size_t)row * DM) + part;
        float s = 0.f;
#pragma unroll
        for (int j = 0; j < 8; ++j) { const f32x4 v = hp[32 * j]; s += (v[0] * v[0] + v[1] * v[1]) + (v[2] * v[2] + v[3] * v[3]); }
        s += __shfl_xor(s, 1); s += __shfl_xor(s, 2); s += __shfl_xor(s, 4); s += __shfl_xor(s, 8); s += __shfl_xor(s, 16);
        if (part == 0) rsl[row] = rsqrtf(s * (1.0f / DM) + EPS);
        if (tl < 240) rsl[16 + tl] = 0.f;
    }
    asm volatile("s_waitcnt lgkmcnt(0)" ::: "memory"); __builtin_amdgcn_s_barrier(); asm volatile("" ::: "memory");
    return rsl;
}
__device__ __forceinline__ void meta_rowgemm(const bf16* A, int lda, const bf16* Bt, int K, float* HM, bf16* HB, int G, int bx) {
    int tid_ = threadIdx.x; asm volatile("" : "+v"(tid_)); const int r = tid_ >> 5, kp = tid_ & 31;
    for (int cg = bx; cg < 256; cg += G) {
        float acc[4] = {0.f, 0.f, 0.f, 0.f};
        for (int k0 = kp * 8; k0 < K; k0 += 256) {
            const u32x4 av = *(const u32x4*)(A + (size_t)r * lda + k0);
#pragma unroll
            for (int j = 0; j < 4; ++j) {
                const u32x4 bv = *(const u32x4*)(Bt + (size_t)(4 * cg + j) * K + k0);
#pragma unroll
                for (int q = 0; q < 4; ++q) {
                    acc[j] += __uint_as_float(av[q] << 16) * __uint_as_float(bv[q] << 16);
                    acc[j] += __uint_as_float(av[q] & 0xffff0000u) * __uint_as_float(bv[q] & 0xffff0000u);
                }
            }
        }
#pragma unroll
        for (int j = 0; j < 4; ++j) { float s = acc[j]; s += __shfl_xor(s, 1); s += __shfl_xor(s, 2); s += __shfl_xor(s, 4); s += __shfl_xor(s, 8); s += __shfl_xor(s, 16); acc[j] = s; }
        if (kp == 0) {
            float* hp = HM + (size_t)r * DM + 4 * cg;
            const f32x4 h = *(const f32x4*)hp + (f32x4){acc[0], acc[1], acc[2], acc[3]};
            *(f32x4*)hp = h;
            u32x2 w; w.x = pk2(h[0], h[1]); w.y = pk2(h[2], h[3]);
            *(u32x2*)(HB + (size_t)(META0 + r) * DM + 4 * cg) = w;
        }
    }
}
struct EpiIn {
    static constexpr bool PERM = true, AFTER_DRAIN = false;
    int si;
    __device__ __forceinline__ void operator()(const pg8::f32x4 (&acc)[2][2][4][2], const pg8::Unit& u, int wr, int wc, int fr, int fq) const {
        asm volatile("" : "+v"(fr), "+v"(fq));
        unsigned char* wsb = gptr(kargs()->ws);
        bf16* Q = (bf16*)(wsb + WS_QKV); float* SM = (float*)(wsb + WS_SM); const LAS float* rsl = tile_rstd(wsb, si, u.pm, wr, wc, fr, fq);
#pragma unroll
        for (int ai = 0; ai < 2; ++ai)
#pragma unroll
            for (int m = 0; m < 4; ++m) {
                const int row = u.pm * 256 + ai * 128 + wr * 64 + m * 16 + fr;
                const float rs = rsl[ai * 128 + wr * 64 + m * 16 + fr];
                if (u.pn < 12) {
#pragma unroll
                    for (int bj = 0; bj < 2; ++bj) {
                        const pg8::f32x4 v0 = acc[ai][bj][m][0] * rs, v1 = acc[ai][bj][m][1] * rs;
                        u32x4 w; w.x = pk2(v0[0], v0[1]); w.y = pk2(v0[2], v0[3]); w.z = pk2(v1[0], v1[1]); w.w = pk2(v1[2], v1[3]);
                        *(u32x4*)(Q + (size_t)row * QP + u.pn * 256 + bj * 128 + wc * 32 + 8 * fq) = w;
                    }
                } else if (wc == 0) {
                    *(f32x4*)(SM + (size_t)row * 32 + 8 * fq) = acc[ai][0][m][0] * rs;
                    *(f32x4*)(SM + (size_t)row * 32 + 8 * fq + 4) = acc[ai][0][m][1] * rs;
                }
            }
    }
};
struct EpiRes {
    static constexpr bool PERM = false, AFTER_DRAIN = false;
    int from_x, si;
    __device__ __forceinline__ void operator()(const pg8::f32x4 (&acc)[2][2][4][2], const pg8::Unit& u, int wr, int wc, int fr, int fq) const {
        asm volatile("" : "+v"(fr), "+v"(fq));
        KArgs ka = kargs(); unsigned char* wsb = gptr(ka->ws);
        float* out = gptr(ka->out); const float* base = from_x ? gptr(ka->x) : out; float* hmeta = (float*)(wsb + WS_HM); bf16* HB = (bf16*)(wsb + WS_HB); float* ssq_next = (float*)ssq_arr(wsb, si);
        extern __shared__ __attribute__((aligned(16))) unsigned char lds_dyn_[];
        LAS float* red = (LAS float*)((LAS unsigned char*)lds_dyn_ + HALO_OFF);
#pragma unroll
        for (int ai = 0; ai < 2; ++ai)
#pragma unroll
            for (int m = 0; m < 4; ++m) {
                const int row = u.pm * 256 + ai * 128 + wr * 64 + m * 16 + fr;
                const float* bp = row < MREAL ? base + (size_t)row * DM : hmeta + (size_t)(row - MREAL) * DM;
                float* op = row < MREAL ? out + (size_t)row * DM : hmeta + (size_t)(row - MREAL) * DM;
                float ss = 0.f;
#pragma unroll
                for (int bj = 0; bj < 2; ++bj)
#pragma unroll
                    for (int n = 0; n < 2; ++n) {
                        const int col = u.pn * 256 + bj * 128 + wc * 32 + 16 * n + 4 * fq;
                        const f32x4 h = *(const f32x4*)(bp + col) + acc[ai][bj][m][n];
                        *(f32x4*)(op + col) = h;
                        ss += (h[0] * h[0] + h[1] * h[1]) + (h[2] * h[2] + h[3] * h[3]);
                        u32x2 w; w.x = pk2(h[0], h[1]); w.y = pk2(h[2], h[3]);
                        *(u32x2*)(HB + (size_t)row * DM + col) = w;
                    }
                ss += __shfl_xor(ss, 16); ss += __shfl_xor(ss, 32);
                if (fq == 0) red[wc * 256 + ai * 128 + wr * 64 + m * 16 + fr] = ss;
            }
        asm volatile("s_waitcnt lgkmcnt(0)" ::: "memory"); __builtin_amdgcn_s_barrier(); asm volatile("" ::: "memory");
        {
            const int tl = (wr * 4 + wc) * 64 + fq * 16 + fr;
            if (tl < 256) ssq_next[(size_t)(u.pm * 256 + tl) * 4 + u.pn] = (red[tl] + red[256 + tl]) + (red[512 + tl] + red[768 + tl]);
        }
    }
};
struct EpiUp {
    static constexpr bool PERM = true, AFTER_DRAIN = false;
    int L;
    __device__ __forceinline__ void operator()(pg8::f32x4 (&acc)[2][2][4][2], const pg8::Unit& u, int wr, int wc, int fr, int fq) const {
        asm volatile("" : "+v"(fr), "+v"(fq));
        KArgs ka = kargs(); unsigned char* wsb = gptr(ka->ws);
        const LAS float* rsl = tile_rstd(wsb, 2 * L + 1, u.pm, wr, wc, fr, fq); const float* cw = gptr(ka->conv_w) + (size_t)L * 3 * NUP; const float* cb = gptr(ka->conv_b) + (size_t)L * NUP;
        extern __shared__ __attribute__((aligned(16))) unsigned char lds_dyn_[];
        LAS float* halo = (LAS float*)((LAS unsigned char*)lds_dyn_ + HALO_OFF);
        const int colw = wc * 32 + 8 * fq;
#pragma unroll
        for (int ai = 0; ai < 2; ++ai)
#pragma unroll
            for (int m = 0; m < 4; ++m) {
                const int row = u.pm * 256 + ai * 128 + wr * 64 + m * 16 + fr;
                const float rs = rsl[ai * 128 + wr * 64 + m * 16 + fr]; (void)row;
#pragma unroll
                for (int bj = 0; bj < 2; ++bj)
#pragma unroll
                    for (int n = 0; n < 2; ++n) acc[ai][bj][m][n] *= rs;
            }
#ifdef SIMPLE_UP
        {
            const int ch0s = u.pn * 128 + colw;
#pragma unroll
            for (int n = 0; n < 2; ++n)
#pragma unroll
                for (int ai = 0; ai < 2; ++ai)
#pragma unroll
                    for (int m = 0; m < 4; ++m) {
                        const int row = u.pm * 256 + ai * 128 + wr * 64 + m * 16 + fr;
                        const f32x4 hu = acc[ai][0][m][n], hg = acc[ai][1][m][n];
                        u32x2 w; w.x = pk2(hu[0] + hg[0], hu[1] + hg[1]); w.y = pk2(hu[2] + hg[2], hu[3] + hg[3]);
                        *(u32x2*)(wsb + (unsigned)(WS_QKV + (unsigned)((row * DFF + ch0s + 4 * n) * 2))) = w;
                    }
            return;
        }
#endif
        if (fr >= 14) {
#pragma unroll
            for (int ai = 0; ai < 2; ++ai)
#pragma unroll
                for (int bj = 0; bj < 2; ++bj)
#pragma unroll
                    for (int n = 0; n < 2; ++n)
                        *(LAS f32x4*)(halo + (((2 * ai + wr) * 2 + (fr - 14)) * 256 + bj * 128 + colw + 4 * n)) = acc[ai][bj][3][n];
        }
        asm volatile("s_waitcnt lgkmcnt(0)" ::: "memory"); __builtin_amdgcn_s_barrier(); asm volatile("" ::: "memory");
        const int ch0 = u.pn * 128 + colw;
        u32x2 wout[2][4][2];
#pragma unroll
        for (int n = 0; n < 2; ++n) {
            f32x4 w0[2], w1[2], w2[2], bb[2];
#pragma unroll
            for (int bj = 0; bj < 2; ++bj) {
                const int c = bj * DFF + ch0 + 4 * n;
                w0[bj] = *(const f32x4*)((const char*)cw + (unsigned)(c * 4)); w1[bj] = *(const f32x4*)((const char*)cw + (unsigned)((NUP + c) * 4)); w2[bj] = *(const f32x4*)((const char*)cw + (unsigned)((2 * NUP + c) * 4)); bb[bj] = *(const f32x4*)((const char*)cb + (unsigned)(c * 4));
            }
#pragma unroll
            for (int ai = 0; ai < 2; ++ai)
#pragma unroll
                for (int m = 0; m < 4; ++m) {
                    const int g = 2 * ai + wr;
                    f32x4 hc[2];
#pragma unroll
                    for (int bj = 0; bj < 2; ++bj) {
                        const int c = bj * DFF + ch0 + 4 * n;
                        const f32x4 cur = acc[ai][bj][m][n];
                        f32x4 pb;
                        if (m > 0) pb = acc[ai][bj][m - 1][n];
                        else pb = *(const LAS f32x4*)(halo + ((((g > 0 ? g - 1 : 0) * 2) + (fr & 1)) * 256 + bj * 128 + colw + 4 * n));
                        f32x4 p1, p2;
#pragma unroll
                        for (int j = 0; j < 4; ++j) {
                            const float t1 = DPP_MOV(0.f, pb[j], 0x121);
                            p1[j] = DPP_MOV(t1, cur[j], 0x111);
                            const float t2 = DPP_MOV(0.f, pb[j], 0x122);
                            p2[j] = DPP_MOV(t2, cur[j], 0x112);
                        }
                        hc[bj] = bb[bj] + w0[bj] * p2 + w1[bj] * p1 + w2[bj] * cur;
                        if (g == 0 && m == 0 && fr < 2) *(f32x4*)(wsb + (unsigned)(WS_UT + (unsigned)(((u.pm * 2 + fr) * NUP + c) * 4))) = cur;
                        if (u.pm == 128 ? (g == 0 && m == 0 && fr >= 14) : (g == 3 && m == 3 && fr >= 14))
                            *(f32x4*)(wsb + (unsigned)(WS_UT + HFL_SIZE + (unsigned)(((u.pm * 2 + fr - 14) * NUP + c) * 4))) = cur;
                    }
                    wout[ai][m][n].x = pk2(siluf(hc[1][0]) * hc[0][0], siluf(hc[1][1]) * hc[0][1]);
                    wout[ai][m][n].y = pk2(siluf(hc[1][2]) * hc[0][2], siluf(hc[1][3]) * hc[0][3]);
                }
        }
#pragma unroll
        for (int ai = 0; ai < 2; ++ai)
#pragma unroll
            for (int m = 0; m < 4; ++m) {
                const int row = u.pm * 256 + ai * 128 + wr * 64 + m * 16 + fr;
                u32x4 w; w.x = wout[ai][m][0].x; w.y = wout[ai][m][0].y; w.z = wout[ai][m][1].x; w.w = wout[ai][m][1].y;
                *(u32x4*)(wsb + (unsigned)(WS_QKV + (unsigned)((row * DFF + ch0) * 2))) = w;
            }
    }
};
#define XB_TMO      128
#define XB_XCNT(j)  (256  + 64 * (j))
#define XB_XSUB(j)  (1280 + 64 * (j))
#define XB_XGEN(j)  (2304 + 64 * (j))
#define XB_TOP      3328
#define XB_TOPGEN   3392
#define XCD_BAR_WORDS 3456
#define XB_SPIN_CAP (1u << 18)

__device__ __forceinline__ unsigned xb_ld(unsigned* p)              { return __hip_atomic_load(p, __ATOMIC_RELAXED, __HIP_MEMORY_SCOPE_AGENT); }
__device__ __forceinline__ unsigned xb_add(unsigned* p, unsigned v) { return __hip_atomic_fetch_add(p, v, __ATOMIC_RELAXED, __HIP_MEMORY_SCOPE_AGENT); }
__device__ __forceinline__ unsigned xb_xcc_id() { return (unsigned)__builtin_amdgcn_s_getreg((3 << 11) | 20) & 0xFu; }
#define XB_SPIN(cond, bar) do { unsigned _sp = 0; while (cond) { __builtin_amdgcn_s_sleep(1); \
    if ((++_sp & 255u) == 0u) { if (xb_ld(&(bar)[XB_TMO])) break; if (_sp > XB_SPIN_CAP) { atomicAdd(&(bar)[XB_TMO], 1u); break; } } } } while (0)

struct XcdBarrier {
    unsigned* bar; unsigned x;
    volatile LAS unsigned* st;
};

__device__ __forceinline__ XcdBarrier xcd_barrier_post(unsigned* bar, volatile LAS unsigned* st) {
    XcdBarrier b; b.bar = bar; b.x = xb_xcc_id(); b.st = st;
    if (threadIdx.x == 0) (void)xb_add(&bar[XB_XCNT(b.x)], 1u);
    return b;
}
__device__ __forceinline__ void xcd_barrier_complete(unsigned* bar, unsigned x, unsigned& nloc, unsigned& nx) {
    const unsigned G = gridDim.x * gridDim.y * gridDim.z;
    unsigned sum, cnt, mine, sp = 0u;
    for (;;) {
        sum = 0u; cnt = 0u; mine = 0u;
#pragma unroll
        for (unsigned j = 0; j < 16; ++j) { const unsigned c = xb_ld(&bar[XB_XCNT(j)]); sum += c; cnt += (c > 0u) ? 1u : 0u; mine = (j == x) ? c : mine; }
        if (sum == G) break;
        __builtin_amdgcn_s_sleep(1);
        if ((++sp & 255u) == 0u) { if (xb_ld(&bar[XB_TMO])) break; if (sp > XB_SPIN_CAP) { atomicAdd(&bar[XB_TMO], 1u); break; } }
    }
    nloc = mine > 0u ? mine : 1u; nx = cnt > 0u ? cnt : 1u;
}

__device__ __forceinline__ void xcd_barrier(const XcdBarrier& b) {
    asm volatile("s_waitcnt vmcnt(0)" ::: "memory");
    __syncthreads();
    if (threadIdx.x == 0) {
        unsigned* bar = b.bar;
        __builtin_amdgcn_s_waitcnt(0);
        unsigned nloc = b.st[0], nx = b.st[1];
        if (nloc == 0u) { xcd_barrier_complete(bar, b.x, nloc, nx); b.st[0] = nloc; b.st[1] = nx; }
        const unsigned old = xb_add(&bar[XB_XSUB(b.x)], 1u);
        const unsigned gen = old / nloc;
        if (old + 1u == (gen + 1u) * nloc) {
            __builtin_amdgcn_fence(__ATOMIC_RELEASE, "agent");
            asm volatile("s_waitcnt vmcnt(0)" ::: "memory");
            const unsigned og = xb_add(&bar[XB_TOP], 1u);
            const unsigned tg = og / nx;
            if (og + 1u == (tg + 1u) * nx) xb_add(&bar[XB_TOPGEN], 1u);
            else XB_SPIN(xb_ld(&bar[XB_TOPGEN]) == tg, bar);
            __builtin_amdgcn_fence(__ATOMIC_ACQUIRE, "agent");
            xb_add(&bar[XB_XGEN(b.x)], 1u);
            asm volatile("s_waitcnt vmcnt(0)" ::: "memory");
        } else {
            XB_SPIN(xb_ld(&bar[XB_XGEN(b.x)]) == gen, bar);
            __builtin_amdgcn_fence(__ATOMIC_ACQUIRE, "agent");
            asm volatile("s_waitcnt vmcnt(0)" ::: "memory");
        }
    }
    __syncthreads();
}
__device__ __forceinline__ int win_src(int n) {
    if (n < 512) return 1552 + n;
    if (n < 1024) return 2064 + (n - 512);
    if (n < 1536) return 2576 + (n - 1024);
    if (n < 1792) return n - 1536;
    if (n < 2048) return 256 + (n - 1792);
    if (n < 2560) return 512 + (n - 2048);
    if (n < 3072) return 1024 + (n - 2560);
    if (n < 3088) return 1536 + (n - 3072);
    if (n < 3096) return n;
    return -1;
}
__device__ __forceinline__ void tr_item(const float* W, int Nsrc, bf16* WT, int K, const float* gk, int mode, LAS float* scr, int k0, int n0, int lane) {
    const int nl = lane & 31, n = n0 + nl;
    int src = n; float cs = 1.f;
    if (mode == 0) { src = win_src(n); cs = n < 512 ? C2 : ((n >= 1536 && n < 1792) ? 0.125f : 1.f); }
    else if (mode == 2) { const int pn = n >> 8, j = n & 255; src = j < 128 ? pn * 128 + j : DFF + pn * 128 + (j - 128); }
#pragma unroll
    for (int i = 0; i < 32; ++i) {
        const int kk = 2 * i + (lane >> 5);
        float v = 0.f;
        if (src >= 0) v = W[(size_t)(k0 + kk) * Nsrc + src] * cs;
        if (gk) v *= gk[k0 + kk];
        scr[kk * 33 + nl] = v;
    }
    LDS_WAIT(); asm volatile("" ::: "memory");
    const int c = lane & 7;
#pragma unroll
    for (int j = 0; j < 4; ++j) {
        const int nn = (lane >> 3) + 8 * j; const LAS float* s = scr + (8 * c) * 33 + nn;
        u32x4 o; o.x = pk2(s[0 * 33], s[1 * 33]); o.y = pk2(s[2 * 33], s[3 * 33]); o.z = pk2(s[4 * 33], s[5 * 33]); o.w = pk2(s[6 * 33], s[7 * 33]);
        *(u32x4*)(WT + (size_t)(n0 + nn) * K + k0 + 8 * c) = o;
    }
    LDS_WAIT(); asm volatile("" ::: "memory");
}
__device__ __forceinline__ void row_to_bf16(const float* xrow, bf16* orow, float* ssq_slot, float* copy_row, int lane) {
    const f32x4* xr = (const f32x4*)xrow + lane;
    f32x4 v[4]; float s = 0.f;
#pragma unroll
    for (int j = 0; j < 4; ++j) { v[j] = xr[64 * j]; s += (v[j][0] * v[j][0] + v[j][1] * v[j][1]) + (v[j][2] * v[j][2] + v[j][3] * v[j][3]); }
    s = wave_sum(s);
    if (lane == 0) *(f32x4*)ssq_slot = (f32x4){s, 0.f, 0.f, 0.f};
    u32x2* o8 = (u32x2*)orow + lane;
#pragma unroll
    for (int j = 0; j < 4; ++j) { u32x2 w; w.x = pk2(v[j][0], v[j][1]); w.y = pk2(v[j][2], v[j][3]); o8[64 * j] = w; }
    if (copy_row) {
#pragma unroll
        for (int j = 0; j < 4; ++j) ((f32x4*)copy_row + lane)[64 * j] = v[j];
    }
}

__device__ __forceinline__ void gla_u_unit(LAS unsigned char* lds, const bf16* QKV, const float* SM, const float* wau, const float* balpha, float* UT, float* DEC, int bh, int cc) {
    int tid_ = threadIdx.x; asm volatile("" : "+v"(tid_)); const int tid = tid_, lane = tid & 63, wid = __builtin_amdgcn_readfirstlane(tid >> 6), hi = lane >> 5, r32 = lane & 31;
    const int b = bh >> 2, h = bh & 3;
    const int row0 = cc == 0 ? META0 : b * SEQ + (cc - 1) * 64, tvalid = cc == 0 ? NMETA : 64;
    LAS unsigned char* KD = lds;
    LAS unsigned char* VT = lds + 9216;
    LAS float* TOT = (LAS float*)(lds + 9216 + 17408);
    const int dk = lane, sg = wid;
    float w[16];
#pragma unroll
    for (int r = 0; r < 16; ++r) w[r] = wau[r * 256 + h * 64 + dk];
    const float bias = balpha[h * 64 + dk];
    float la[8];
#pragma unroll
    for (int i = 0; i < 8; ++i) {
        const int s = 8 * sg + i;
        const f32x4* g4 = (const f32x4*)(SM + (size_t)(row0 + s) * 32);
        float z = bias;
#pragma unroll
        for (int q = 0; q < 4; ++q) { const f32x4 gv = g4[q]; z += gv[0] * w[4 * q] + gv[1] * w[4 * q + 1] + gv[2] * w[4 * q + 2] + gv[3] * w[4 * q + 3]; }
        la[i] = (s < tvalid) ? logsigmoidf(z) * (1.0f / 16.0f) : 0.f;
    }
#pragma unroll
    for (int i = 1; i < 8; ++i) la[i] += la[i - 1];
    TOT[sg * 64 + dk] = la[7];
#pragma unroll
    for (int i = 0; i < 2; ++i) {
        const int idx = tid + 512 * i, row = idx >> 4, ch = idx & 15;
        const u32x4 v = *(const u32x4*)(QKV + (size_t)(row0 + row) * QP + C_GV + h * 128 + ch * 8);
        *(LAS u32x4*)(VT + row * 272 + ch * 16) = v;
    }
    __syncthreads();
    float pre = 0.f, tot = 0.f;
#pragma unroll
    for (int g2 = 0; g2 < 8; ++g2) { const float t = TOT[g2 * 64 + dk]; if (g2 < sg) pre += t; tot += t; }
    if (sg == 0) DEC[(size_t)(bh * NCH + cc) * 64 + dk] = __expf(tot);
#pragma unroll
    for (int i = 0; i < 8; ++i) {
        const int s = 8 * sg + i;
        const float kf = bf2f(QKV[(size_t)(row0 + s) * QP + C_GK + h * 64 + dk]);
        const float kd = (s < tvalid) ? kf * __expf(tot - (pre + la[i])) : 0.f;
        *(LAS bf16*)(KD + s * 144 + dk * 2) = f2bf(kd);
    }
    __syncthreads();
    const int dvb = wid >> 1, dkb = wid & 1;
    const int qq = (lane & 15) >> 2, pp = lane & 3, half = (lane >> 4) & 1;
    f32x16 acc = {};
#pragma unroll
    for (int j = 0; j < 4; ++j) {
        const LAS unsigned char* ap = VT + (16 * j + 4 * hi + qq) * 272 + (32 * dvb + 16 * half + 4 * pp) * 2;
        const LAS unsigned char* bp = KD + (16 * j + 4 * hi + qq) * 144 + (32 * dkb + 16 * half + 4 * pp) * 2;
        const bf16x8 af = cat8(vtr(ap), vtr(ap + 8 * 272));
        const bf16x8 bfr = cat8(vtr(bp), vtr(bp + 8 * 144));
        acc = __builtin_amdgcn_mfma_f32_32x32x16_bf16(af, bfr, acc, 0, 0, 0);
    }
    float* up = UT + ((size_t)(bh * NCH + cc) * 128 + 32 * dvb) * 64 + 32 * dkb + r32;
#pragma unroll
    for (int r = 0; r < 16; ++r) up[crow(r, hi) * 64] = acc[r];
    __syncthreads();
}
__device__ __forceinline__ void fox_cumsum_unit(LAS unsigned char* lds, const float* SM, const float* bforget, float* CK, int bh) {
    int tid_ = threadIdx.x; asm volatile("" : "+v"(tid_)); const int tid = tid_, lane = tid & 63, wid = tid >> 6;
    const int b = bh >> 3, h = bh & 7;
    const float bf_ = bforget[h];
    LAS float* WT_ = (LAS float*)lds;
    float mtot = 0.f, mine = 0.f;
    for (int p = 0; p < NMETA; ++p) { mtot += logsigmoidf(SM[(size_t)(META0 + p) * 32 + 16 + h] + bf_); if (tid == p) mine = mtot; }
    if (tid < 64) CK[(size_t)bh * CKP + tid] = tid < NMETA ? -LOG2E * mine : -INFINITY;
    float v[8]; float run = 0.f;
#pragma unroll
    for (int i = 0; i < 8; ++i) { run += logsigmoidf(SM[(size_t)(b * SEQ + 8 * tid + i) * 32 + 16 + h] + bf_); v[i] = run; }
    float inc = run;
#pragma unroll
    for (int o = 1; o < 64; o <<= 1) { const float t = __shfl_up(inc, o); if (lane >= o) inc += t; }
    if (lane == 63) WT_[wid] = inc;
    __syncthreads();
    float off = mtot + (inc - run);
    for (int w2 = 0; w2 < wid; ++w2) off += WT_[w2];
#pragma unroll
    for (int i = 0; i < 8; ++i) CK[(size_t)bh * CKP + 64 + 8 * tid + i] = -LOG2E * (off + v[i]);
    __syncthreads();
}

__device__ __forceinline__ void attn_unit(LAS unsigned char* lds, const bf16* QKV, const float* CK, bf16* OB, const float* fnorm, int b, int h, int qb) {
    int tid_ = threadIdx.x; asm volatile("" : "+v"(tid_)); const int tid = tid_, lane = tid & 63, wid = __builtin_amdgcn_readfirstlane(tid >> 6), r32 = lane & 31, hi = lane >> 5;
    constexpr int KB = 9216, KOFF = 0, VOFF = 2 * KB, COFF = 4 * KB, WOFF = COFF + 512;
    LAS float* wsf = (LAS float*)(lds + WOFF) + wid * 64;
    const size_t rowb = (size_t)b * SEQ; const int q0 = qb * 256;
    const int NT = 1 + 4 * (qb + 1);
    const bf16* qp = QKV + (rowb + q0 + wid * 32 + r32) * QP + C_FQ + h * 64 + hi * 8;
    bf16x8 qr[4];
#pragma unroll
    for (int d0 = 0; d0 < 4; ++d0) qr[d0] = *(const bf16x8*)(qp + d0 * 16);
    const int srow = tid >> 3, sch = tid & 7;
    const float* ckp = CK + (size_t)(b * 8 + h) * CKP;
    u32x4 kreg, vreg; float creg = 0.f;
#define ATT_LOAD(t) do { const size_t r0_ = (t) == 0 ? (size_t)META0 : rowb + (size_t)((t) - 1) * 64; const bf16* p_ = QKV + (r0_ + srow) * QP + h * 64 + sch * 8; \
        kreg = *(const u32x4*)(p_ + C_FK); vreg = *(const u32x4*)(p_ + C_FV); if (tid < 64) creg = ckp[(t) * 64 + tid]; } while (0)
#define ATT_STORE(buf) do { *(LAS u32x4*)(lds + KOFF + (buf) * KB + srow * 144 + sch * 16) = kreg; *(LAS u32x4*)(lds + VOFF + (buf) * KB + srow * 144 + sch * 16) = vreg; \
        if (tid < 64) *(LAS float*)(lds + COFF + (buf) * 256 + tid * 4) = creg; } while (0)
    float m = -1e30f, l = 0.f; f32x16 o0 = {}, o1 = {};
    const int qrel = 32 * wid + r32;
    const int qq = (lane & 15) >> 2, pp = lane & 3, half = (lane >> 4) & 1;
    ATT_LOAD(0); ATT_STORE(0);
    for (int t = 0; t < NT; ++t) {
        const int buf = t & 1;
        if (t + 1 < NT) ATT_LOAD(t + 1);
        __syncthreads();
        const int jb = t - (NT - 4);
        const bool skip = (jb >= 0) && (64 * jb > 32 * wid + 31);
        if (!skip) {
            const LAS unsigned char* Kb = lds + KOFF + buf * KB; const LAS unsigned char* Vb = lds + VOFF + buf * KB; const LAS float* Cb = (const LAS float*)(lds + COFF + buf * 256);
            f32x16 p0, p1;
#pragma unroll
            for (int g = 0; g < 4; ++g) {
                const f32x4 c0 = *(const LAS f32x4*)(Cb + 8 * g + 4 * hi), c1 = *(const LAS f32x4*)(Cb + 32 + 8 * g + 4 * hi);
#pragma unroll
                for (int i = 0; i < 4; ++i) { p0[4 * g + i] = c0[i]; p1[4 * g + i] = c1[i]; }
            }
#pragma unroll
            for (int d0 = 0; d0 < 4; ++d0) {
                const bf16x8 a0 = *(const LAS bf16x8*)(Kb + r32 * 144 + (16 * d0 + 8 * hi) * 2);
                const bf16x8 a1 = *(const LAS bf16x8*)(Kb + (32 + r32) * 144 + (16 * d0 + 8 * hi) * 2);
                p0 = __builtin_amdgcn_mfma_f32_32x32x16_bf16(a0, qr[d0], p0, 0, 0, 0);
                p1 = __builtin_amdgcn_mfma_f32_32x32x16_bf16(a1, qr[d0], p1, 0, 0, 0);
            }
            if (jb >= 0 && 64 * jb + 63 > 32 * wid) {
#pragma unroll
                for (int r = 0; r < 16; ++r) { const int kv = 64 * jb + crow(r, hi); if (kv > qrel) p0[r] = -INFINITY; if (kv + 32 > qrel) p1[r] = -INFINITY; }
            }
            float mx = fmaxf(fmaxf(p0[0], p1[0]), fmaxf(p0[1], p1[1]));
#pragma unroll
            for (int r = 2; r < 16; r += 2) mx = fmaxf(fmaxf(mx, fmaxf(p0[r], p1[r])), fmaxf(p0[r + 1], p1[r + 1]));
            mx = fmaxf(mx, __shfl_xor(mx, 32));
            if (__any(mx > m + 8.0f)) {
                const float mn = fmaxf(m, mx);
                const float alpha = __builtin_amdgcn_exp2f(m - mn);
                m = mn; l *= alpha;
                if (hi == 0) wsf[r32] = alpha;
                LDS_WAIT();
#pragma unroll
                for (int g = 0; g < 4; ++g) {
                    const f32x4 a = *(const LAS f32x4*)(wsf + 8 * g + 4 * hi);
#pragma unroll
                    for (int i = 0; i < 4; ++i) { o0[4 * g + i] *= a[i]; o1[4 * g + i] *= a[i]; }
                }
            }
            float rsum = 0.f;
#pragma unroll
            for (int r = 0; r < 16; ++r) { p0[r] = __builtin_amdgcn_exp2f(p0[r] - m); p1[r] = __builtin_amdgcn_exp2f(p1[r] - m); rsum += p0[r] + p1[r]; }
            l += rsum;
            bf16x8 pa[4];
            { u32x4 w;
              w.x = pk2(p0[0], p0[1]); w.y = pk2(p0[2], p0[3]); w.z = pk2(p0[4], p0[5]); w.w = pk2(p0[6], p0[7]); pa[0] = __builtin_bit_cast(bf16x8, w);
              w.x = pk2(p0[8], p0[9]); w.y = pk2(p0[10], p0[11]); w.z = pk2(p0[12], p0[13]); w.w = pk2(p0[14], p0[15]); pa[1] = __builtin_bit_cast(bf16x8, w);
              w.x = pk2(p1[0], p1[1]); w.y = pk2(p1[2], p1[3]); w.z = pk2(p1[4], p1[5]); w.w = pk2(p1[6], p1[7]); pa[2] = __builtin_bit_cast(bf16x8, w);
              w.x = pk2(p1[8], p1[9]); w.y = pk2(p1[10], p1[11]); w.z = pk2(p1[12], p1[13]); w.w = pk2(p1[14], p1[15]); pa[3] = __builtin_bit_cast(bf16x8, w); }
#pragma unroll
            for (int j = 0; j < 4; ++j) {
                const LAS unsigned char* vp = Vb + (16 * j + 4 * hi + qq) * 144 + (16 * half + 4 * pp) * 2;
                const bf16x8 v0 = cat8(vtr(vp), vtr(vp + 8 * 144));
                const bf16x8 v1 = cat8(vtr(vp + 64), vtr(vp + 64 + 8 * 144));
                o0 = __builtin_amdgcn_mfma_f32_32x32x16_bf16(pa[j], v0, o0, 0, 0, 0);
                o1 = __builtin_amdgcn_mfma_f32_32x32x16_bf16(pa[j], v1, o1, 0, 0, 0);
            }
        }
        if (t + 1 < NT) ATT_STORE(buf ^ 1);
    }
#undef ATT_LOAD
#undef ATT_STORE
    l += __shfl_xor(l, 32);
    if (hi == 0) wsf[r32] = 1.0f / l;
    LDS_WAIT();
#pragma unroll
    for (int g = 0; g < 4; ++g) {
        const f32x4 a = *(const LAS f32x4*)(wsf + 8 * g + 4 * hi);
#pragma unroll
        for (int i = 0; i < 4; ++i) { o0[4 * g + i] *= a[i]; o1[4 * g + i] *= a[i]; }
    }
    const float w0 = fnorm[h * 64 + r32], w1 = fnorm[h * 64 + 32 + r32];
#pragma unroll
    for (int r = 0; r < 16; ++r) {
        float s = o0[r] * o0[r] + o1[r] * o1[r];
        s += __shfl_xor(s, 1); s += __shfl_xor(s, 2); s += __shfl_xor(s, 4); s += __shfl_xor(s, 8); s += __shfl_xor(s, 16);
        const float rs = rsqrtf(s * (1.0f / 64.0f) + EPS);
        bf16* op = OB + (rowb + q0 + wid * 32 + crow(r, hi)) * DM + 512 + h * 64 + r32;
        op[0] = f2bf(o0[r] * rs * w0); op[32] = f2bf(o1[r] * rs * w1);
    }
    __syncthreads();
}
__device__ __forceinline__ void meta_attn(const bf16* QKV, const float* CK, bf16* OB, const float* fnorm, int p) {
    int tid_ = threadIdx.x; asm volatile("" : "+v"(tid_)); const int lane = tid_ & 63, h = tid_ >> 6;
    const float q = bf2f(QKV[(size_t)(META0 + p) * QP + C_FQ + h * 64 + lane]);
    float sc[NMETA], vv[NMETA];
#pragma unroll
    for (int s = 0; s < NMETA; ++s) {
        sc[s] = q * bf2f(QKV[(size_t)(META0 + s) * QP + C_FK + h * 64 + lane]);
        vv[s] = bf2f(QKV[(size_t)(META0 + s) * QP + C_FV + h * 64 + lane]);
    }
    float m = -1e30f;
#pragma unroll
    for (int s = 0; s < NMETA; ++s) { sc[s] = (s <= p) ? wave_sum(sc[s]) + CK[(size_t)h * CKP + s] : -INFINITY; m = fmaxf(m, sc[s]); }
    float l = 0.f, o = 0.f;
#pragma unroll
    for (int s = 0; s < NMETA; ++s) { const float pw = __builtin_amdgcn_exp2f(sc[s] - m); l += pw; o += pw * vv[s]; }
    o /= l;
    const float ss = wave_sum(o * o);
    OB[(size_t)(META0 + p) * DM + 512 + h * 64 + lane] = f2bf(o * rsqrtf(ss * (1.0f / 64.0f) + EPS) * fnorm[h * 64 + lane]);
}
__device__ __forceinline__ void gla_readout_wave(const bf16* QKV, const float* UT, bf16* OB, const float* gnorm, int wu, int lane) {
    asm volatile("" : "+v"(lane));
    const int half = wu & 1, t = wu >> 1, cc = t % NCH, bh = t / NCH, b = bh >> 2, h = bh & 3;
    if (cc == 0 && (half == 1 || b != 0)) return;
    const int r32 = lane & 31, hi = lane >> 5;
    const int row0 = cc == 0 ? META0 : b * SEQ + (cc - 1) * 64 + 32 * half, nvalid = cc == 0 ? NMETA : 32;
    const float* Sp = UT + (size_t)(bh * NCH + cc) * 8192;
    f32x16 acc[4] = {};
#pragma unroll
    for (int j = 0; j < 4; ++j) {
        const bf16x8 bq = *(const bf16x8*)(QKV + (size_t)(row0 + r32) * QP + C_GQ + h * 64 + 16 * j + 8 * hi);
#pragma unroll
        for (int blk = 0; blk < 4; ++blk) {
            const float* sp = Sp + (32 * blk + r32) * 64 + 16 * j + 8 * hi;
            const f32x4 s0 = *(const f32x4*)sp, s1 = *(const f32x4*)(sp + 4);
            u32x4 w; w.x = pk2(s0[0], s0[1]); w.y = pk2(s0[2], s0[3]); w.z = pk2(s1[0], s1[1]); w.w = pk2(s1[2], s1[3]);
            acc[blk] = __builtin_amdgcn_mfma_f32_32x32x16_bf16(__builtin_bit_cast(bf16x8, w), bq, acc[blk], 0, 0, 0);
        }
    }
    float ss = 0.f;
#pragma unroll
    for (int blk = 0; blk < 4; ++blk)
#pragma unroll
        for (int r = 0; r < 16; ++r) ss += acc[blk][r] * acc[blk][r];
    ss += __shfl_xor(ss, 32);
    const float rs = rsqrtf(ss * (1.0f / 128.0f) + EPS);
    if (r32 < nvalid) {
        const size_t row = (size_t)row0 + r32;
#pragma unroll
        for (int blk = 0; blk < 4; ++blk)
#pragma unroll
            for (int g = 0; g < 4; ++g) {
                const int dv = 32 * blk + 8 * g + 4 * hi;
                const u32x2 gt = *(const u32x2*)(QKV + row * QP + C_GR + h * 128 + dv);
                const f32x4 wn = *(const f32x4*)(gnorm + h * 128 + dv);
                const float g0 = __uint_as_float(gt.x << 16), g1 = __uint_as_float(gt.x & 0xffff0000u), g2 = __uint_as_float(gt.y << 16), g3 = __uint_as_float(gt.y & 0xffff0000u);
                u32x2 w;
                w.x = pk2(acc[blk][4 * g] * rs * wn[0] * siluf(g0), acc[blk][4 * g + 1] * rs * wn[1] * siluf(g1));
                w.y = pk2(acc[blk][4 * g + 2] * rs * wn[2] * siluf(g2), acc[blk][4 * g + 3] * rs * wn[3] * siluf(g3));
                *(u32x2*)(OB + row * DM + h * 128 + dv) = w;
            }
    }
}

#define FRESH() KArgs ka_ = kargs(); Args a; a.x = gptr(ka_->x); a.meta = gptr(ka_->meta); a.attn_norm = gptr(ka_->attn_norm); a.w_in = gptr(ka_->w_in); a.w_au = gptr(ka_->w_au); a.b_alpha = gptr(ka_->b_alpha); a.b_forget = gptr(ka_->b_forget); a.gla_norm = gptr(ka_->gla_norm); a.fox_norm = gptr(ka_->fox_norm); a.w_out = gptr(ka_->w_out); a.ffn_norm = gptr(ka_->ffn_norm); a.w_up = gptr(ka_->w_up); a.conv_w = gptr(ka_->conv_w); a.conv_b = gptr(ka_->conv_b); a.w_down = gptr(ka_->w_down); a.final_norm = gptr(ka_->final_norm); a.out = gptr(ka_->out); a.ws = gptr(ka_->ws); unsigned char* ws = a.ws; \
    bf16* HB = (bf16*)(ws + WS_HB); bf16* OB = (bf16*)(ws + WS_OB); bf16* QKV = (bf16*)(ws + WS_QKV); bf16* A2 = (bf16*)(ws + WS_QKV); \
    float* UT = (float*)(ws + WS_UT); float* HF = (float*)(ws + WS_UT); float* HL = (float*)(ws + WS_UT + HFL_SIZE); \
    float* SM = (float*)(ws + WS_SM); float* CK = (float*)(ws + WS_CK); float* DEC = (float*)(ws + WS_DEC); float* HM = (float*)(ws + WS_HM); float* SSQ = (float*)(ws + WS_SSQ); \
    unsigned char* wl = ws + WS_W + (size_t)L * WL_SIZE; \
    (void)HB; (void)OB; (void)QKV; (void)A2; (void)UT; (void)HF; (void)HL; (void)SM; (void)CK; (void)DEC; (void)HM; (void)SSQ; (void)wl; \
    int tid_ = threadIdx.x; asm volatile("" : "+v"(tid_)); const int tid = tid_, lane = tid & 63, wid = __builtin_amdgcn_readfirstlane(tid >> 6); \
    const int gw = bx * 8 + wid, NGW = G * 8, gt = bx * 512 + tid, NGT = G * 512; (void)lane; (void)gw; (void)NGW; (void)gt; (void)NGT;
#ifndef REP_A
#define REP_A 1
#endif
#ifndef REP_CA
#define REP_CA 1
#endif
#ifndef REP_F
#define REP_F 1
#endif
#ifndef REP_B
#define REP_B 1
#endif
#ifndef REP_D
#define REP_D 1
#endif
#define GSYNC_CG() do { asm volatile("s_waitcnt vmcnt(0) lgkmcnt(0)" ::: "memory"); grid.sync(); __builtin_amdgcn_fence(__ATOMIC_ACQUIRE, "agent"); asm volatile("s_waitcnt vmcnt(0)" ::: "memory"); } while (0)
#define GSYNC() xcd_barrier(xbar)
__global__ void __launch_bounds__(512, 2) fwd_kernel(Args a_unused) {
    extern __shared__ __attribute__((aligned(16))) unsigned char lds_raw[];
    LAS unsigned char* lds = (LAS unsigned char*)lds_raw;
    cg::grid_group grid = cg::this_grid();
    const int G = gridDim.x, bx = blockIdx.x;
    volatile LAS unsigned* xst = (volatile LAS unsigned*)(lds + HALO_OFF + 8192 + 1024);
    if (threadIdx.x < 2) xst[threadIdx.x] = 0u;
    __syncthreads();
    const XcdBarrier xbar = xcd_barrier_post((unsigned*)(gptr(kargs()->ws) + WS_BAR), xst);
#ifndef REP_P
#define REP_P 1
#endif
    for (int rep = 0; rep < REP_P; ++rep) {
        const int L = 0; FRESH();
        LAS float* scr = (LAS float*)(lds + wid * 16384);
        constexpr int I_IN = 16 * (NINP / 32), I_OUT = 16 * 32, I_UP = 16 * (NUP / 32), I_DN = (DFF / 64) * 32, I_L = I_IN + I_OUT + I_UP + I_DN;
        for (int it = gw; it < DEPTH * I_L; it += NGW) {
            const int L = it / I_L; int r = it % I_L;
            unsigned char* wl = ws + WS_W + (size_t)L * WL_SIZE;
            if (r < I_IN) { const int nb = NINP / 32; tr_item(a.w_in + (size_t)L * DM * 3096, 3096, (bf16*)(wl + WL_IN), DM, a.attn_norm + L * DM, 0, scr, 64 * (r / nb), 32 * (r % nb), lane); continue; } r -= I_IN;
            if (r < I_OUT) { tr_item(a.w_out + (size_t)L * DM * DM, DM, (bf16*)(wl + WL_OUT), DM, nullptr, 1, scr, 64 * (r / 32), 32 * (r % 32), lane); continue; } r -= I_OUT;
            if (r < I_UP) { const int nb = NUP / 32; tr_item(a.w_up + (size_t)L * DM * NUP, NUP, (bf16*)(wl + WL_UP), DM, a.ffn_norm + L * DM, 2, scr, 64 * (r / nb), 32 * (r % nb), lane); continue; } r -= I_UP;
            tr_item(a.w_down + (size_t)L * DFF * DM, DM, (bf16*)(wl + WL_DN), DFF, nullptr, 3, scr, 64 * (r / 32), 32 * (r % 32), lane);
        }
        for (int i = gt; i < (256 - NMETA) * 4; i += NGT) SSQ[(size_t)(META0 + NMETA) * 4 + i] = 0.f;
        for (int r = gw; r < MREAL + 256; r += NGW) {
            if (r < MREAL) row_to_bf16(a.x + (size_t)r * DM, HB + (size_t)r * DM, SSQ + (size_t)r * 4, nullptr, lane);
            else if (r < MREAL + NMETA) row_to_bf16(a.meta + (size_t)(r - MREAL) * DM, HB + (size_t)r * DM, SSQ + (size_t)r * 4, HM + (size_t)(r - MREAL) * DM, lane);
            else {
#pragma unroll
                for (int j = 0; j < 4; ++j) { ((f32x4*)(HM + (size_t)(r - MREAL) * DM) + lane)[64 * j] = (f32x4){0.f, 0.f, 0.f, 0.f};
                    ((u32x2*)(HB + (size_t)r * DM) + lane)[64 * j] = (u32x2){0u, 0u}; ((u32x2*)(OB + (size_t)r * DM) + lane)[64 * j] = (u32x2){0u, 0u}; }
            }
        }
    }
    GSYNC_CG();

    for (int L = 0; L < DEPTH; ++L) {
#ifndef SKIP_A
        {
            FRESH();
            pg8::Gemm g{HB, (const bf16*)(wl + WL_IN), MROWS, NINP, DM}; pg8::StaticOrder S; S.init(MROWS, NINP, G, bx);
            EpiIn E{2 * L};
            for (int rep = 0; rep < REP_A; ++rep) pg8::gemm_phase<EpiIn, pg8::StaticOrder, true, true>(lds, g, S, E);
        }
#endif
        GSYNC();
#ifndef SKIP_B
        { FRESH();
        for (int rep = 0; rep < REP_B; ++rep)
        for (int u = bx; u < 32 * NCH + 64; u += G) {
            if (u < 32 * NCH) gla_u_unit(lds, QKV, SM, a.w_au + (size_t)L * 16 * 256, a.b_alpha + L * 256, UT, DEC, u / NCH, u % NCH);
            else fox_cumsum_unit(lds, SM, a.b_forget + L * 8, CK, u - 32 * NCH);
        }
        }
#endif
        GSYNC();
#ifndef SKIP_CS
        { FRESH();
        for (int e = gt; e < 32 * 2048; e += NGT) {
            const int bh = e >> 11, rem = (e & 2047) * 4, dk = rem & 63;
            float* up = UT + (size_t)bh * NCH * 8192 + rem; const float* dp = DEC + (size_t)bh * NCH * 64 + dk;
            f32x4 Sv = *(const f32x4*)up;
            for (int c0 = 1; c0 <= 64; c0 += 8) {
                f32x4 uu[8], dd[8];
#pragma unroll
                for (int i = 0; i < 8; ++i) { uu[i] = *(const f32x4*)(up + (size_t)(c0 + i) * 8192); dd[i] = *(const f32x4*)(dp + (c0 + i) * 64); }
#pragma unroll
                for (int i = 0; i < 8; ++i) { Sv = dd[i] * Sv + uu[i]; *(f32x4*)(up + (size_t)(c0 + i) * 8192) = Sv; }
            }
        }
        }
        { FRESH();
        for (int rep = 0; rep < REP_CA; ++rep)
        for (int v = bx; v < 256; v += G) {
            const int bhh = v >> 2, s = v & 3;
#pragma unroll 1
            for (int i = 0; i < 4; ++i) {
                const int qb = (i == 0) ? s : (i == 1) ? 7 - s : (i == 2) ? 8 + s : 15 - s;
                attn_unit(lds, QKV, CK, OB, a.fox_norm + L * 512, bhh >> 3, bhh & 7, qb);
            }
        }
#endif
#ifndef SKIP_CM
        }
        { FRESH();
#ifndef REP_CM
#define REP_CM 1
#endif
        for (int rep = 0; rep < REP_CM; ++rep)
        if (bx < NMETA) meta_attn(QKV, CK, OB, a.fox_norm + L * 512, bx);
        }
#endif
        GSYNC();
#ifndef SKIP_D
        { FRESH();
        for (int rep = 0; rep < REP_D; ++rep)
        for (int wu = gw; wu < 32 * NCH * 2; wu += NGW) gla_readout_wave(QKV, UT, OB, a.gla_norm + L * 512, wu, lane);
        }
#endif
        GSYNC();
#ifndef SKIP_E
        {
            FRESH();
            meta_rowgemm(OB + (size_t)META0 * DM, DM, (const bf16*)(wl + WL_OUT), DM, HM, HB, G, bx);
            pg8::Gemm g{OB, (const bf16*)(wl + WL_OUT), MREAL, DM, DM}; pg8::StaticOrder S; S.init(MREAL, DM, G, bx);
            EpiRes E{L == 0 ? 1 : 0, 2 * L + 1};
            pg8::gemm_phase<EpiRes, pg8::StaticOrder, true, true>(lds, g, S, E);
        }
#endif
        GSYNC();
#ifndef SKIP_F
        {
            FRESH();
            pg8::Gemm g{HB, (const bf16*)(wl + WL_UP), MROWS, NUP, DM}; pg8::StaticOrder S; S.init(MROWS, NUP, G, bx);
            EpiUp E{L};
            for (int rep = 0; rep < REP_F; ++rep) pg8::gemm_phase<EpiUp, pg8::StaticOrder, true, true>(lds, g, S, E);
        }
#endif
        GSYNC();
#ifndef SKIP_H
        {
            FRESH();
            const float* cw = a.conv_w + (size_t)L * 3 * NUP; const float* cb = a.conv_b + (size_t)L * NUP;
            { pg8::StaticOrder S0; S0.init(MREAL, DM, G, bx); pg8::Unit uu; uu.pm = 128; uu.pn = 0;
              for (int ui = -1; ui < 0 || S0.next(ui, uu); ++ui) {
                const int pm = uu.pm;
                for (int i = tid; i < 2 * (DFF / 4); i += 512) {
                    const int c4 = i % (DFF / 4), rr = i / (DFF / 4);
                    const int ch = 4 * c4;
                    f32x4 hc[2];
#pragma unroll
                    for (int bj = 0; bj < 2; ++bj) {
                        const int c = bj * DFF + ch;
                        f32x4 P0 = {0.f, 0.f, 0.f, 0.f}, P1 = P0;
                        if (pm != 128) { const int src = (pm % 16 == 0) ? 128 : pm - 1; P0 = *(const f32x4*)(HL + (size_t)(src * 2) * NUP + c); P1 = *(const f32x4*)(HL + (size_t)(src * 2 + 1) * NUP + c); }
                        const f32x4 H0 = *(const f32x4*)(HF + (size_t)(pm * 2) * NUP + c), H1 = *(const f32x4*)(HF + (size_t)(pm * 2 + 1) * NUP + c);
                        const f32x4 x2 = rr == 0 ? P0 : P1, x1 = rr == 0 ? P1 : H0, x0 = rr == 0 ? H0 : H1;
                        hc[bj] = *(const f32x4*)(cb + c) + *(const f32x4*)(cw + c) * x2 + *(const f32x4*)(cw + NUP + c) * x1 + *(const f32x4*)(cw + 2 * NUP + c) * x0;
                    }
                    u32x2 w;
                    w.x = pk2(siluf(hc[1][0]) * hc[0][0], siluf(hc[1][1]) * hc[0][1]);
                    w.y = pk2(siluf(hc[1][2]) * hc[0][2], siluf(hc[1][3]) * hc[0][3]);
                    *(u32x2*)(A2 + (size_t)(pm * 256 + rr) * DFF + ch) = w;
                }
              }
            }
            asm volatile("s_waitcnt vmcnt(0)" ::: "memory"); __syncthreads();
            meta_rowgemm(A2 + (size_t)META0 * DFF, DFF, (const bf16*)(wl + WL_DN), DFF, HM, HB, G, bx);
            pg8::Gemm g{A2, (const bf16*)(wl + WL_DN), MREAL, DM, DFF}; pg8::StaticOrder S; S.init(MREAL, DM, G, bx);
            EpiRes E{0, 2 * L + 2};
            pg8::gemm_phase<EpiRes, pg8::StaticOrder, true, true>(lds, g, S, E);
        }
#endif
        GSYNC();
    }
    {
        const int L = 0; FRESH();
        const float* ssq = ssq_arr(ws, 8);
        for (int r = gw; r < MREAL; r += NGW) {
            const float rs = row_rstd(ssq, r);
            f32x4* p = (f32x4*)(a.out + (size_t)r * DM) + lane; const f32x4* wn = (const f32x4*)a.final_norm + lane;
#pragma unroll
            for (int j = 0; j < 4; ++j) p[64 * j] = p[64 * j] * rs * wn[64 * j];
        }
    }
}

extern "C" void kernel_launch(void* const* d_in, const int* in_sizes, int n_in, void* d_out, int out_size, void* d_ws, size_t ws_size, hipStream_t stream) {
    static int grid = 0;
    if (grid == 0) {
        if (n_in != 16 || out_size != MREAL * DM || ws_size < WS_END) { fprintf(stderr, "kernel_launch: unexpected problem (n_in %d out %d ws %zu, need %zu)\n", n_in, out_size, ws_size, (size_t)WS_END); grid = -1; return; }
        int dev = 0, cus = 0, per = 0;
        (void)hipGetDevice(&dev); (void)hipDeviceGetAttribute(&cus, hipDeviceAttributeMultiprocessorCount, dev);
        (void)hipFuncSetAttribute((const void*)fwd_kernel, hipFuncAttributeMaxDynamicSharedMemorySize, LDS_BYTES);
        (void)hipOccupancyMaxActiveBlocksPerMultiprocessor(&per, (const void*)fwd_kernel, 512, LDS_BYTES);
        if (per < 1) per = 1;
        grid = cus * per;
        fprintf(stderr, "kernel_launch: grid %d (cus %d x %d), ws %zu\n", grid, cus, per, ws_size);
    }
    if (grid < 0) return;
    Args a{};
    const float** f = (const float**)&a;
    for (int i = 0; i < 16; ++i) f[i] = (const float*)d_in[i];
    a.out = (float*)d_out; a.ws = (unsigned char*)d_ws;
    (void)hipMemsetAsync((unsigned char*)d_ws + WS_BAR, 0, BAR_BYTES, stream);
    void* args[] = {&a};
    hipError_t e = hipLaunchCooperativeKernel((const void*)fwd_kernel, dim3(grid), dim3(512), args, LDS_BYTES, stream);
    if (e != hipSuccess) fprintf(stderr, "cooperative launch failed: %s (grid %d)\n", hipGetErrorString(e), grid);
}
```

```cpp
#include <hip/hip_runtime.h>
#include <hip/hip_cooperative_groups.h>
#include <cstdio>
#include <cstdint>
namespace cg = cooperative_groups;
namespace pg8 {
#define PG8_LAS __attribute__((address_space(3)))
typedef unsigned short bf16_t;
typedef short bf16x8 __attribute__((ext_vector_type(8)));
typedef float f32x4 __attribute__((ext_vector_type(4)));
typedef unsigned u32x4 __attribute__((ext_vector_type(4)));
constexpr int BM = 256, BK = 64, HALF = 128, HTB = HALF * BK * 2  , STAGE_BYTES = 8 * HTB, NXCD = 8, WGM = 8;

__host__ __device__ __forceinline__ int lds_byte(int r, int c) { const int st = (r >> 4) * 2 + (c >> 5), rr = r & 15, cc = c & 31, ob = rr * 64 + cc * 2; return st * 1024 + (ob ^ (((ob >> 9) & 1) << 5)); }
__host__ __device__ __forceinline__ void stage_rc(int b, int& R, int& C) { const int st = b / 1024, sb = b % 1024, swz = sb ^ (((sb >> 9) & 1) << 5); R = (st >> 1) * 16 + swz / 64; C = (st & 1) * 32 + (swz % 64) / 2; }
__host__ __device__ __forceinline__ int perm32(int rho) { const int n = rho >> 4, i = rho & 15; return 8 * (i >> 2) + 4 * n + (i & 3); }

struct Unit { int pm, pn; };
struct Gemm { const bf16_t* A; const bf16_t* Bt; int M, N, K; };

struct StaticOrder {
    int nM, nN, nwg, G, c;
    __host__ __device__ void init(int M, int N, int G_, int c_) { nM = M / BM; nN = N / BM; nwg = nM * nN; G = G_; c = c_; }
    __host__ __device__ bool next(int i, Unit& u) const {
        const long L = (long)i * G + c; if (L >= nwg) return false;
        int wgid = (int)L; { const int q = nwg / NXCD, r = nwg % NXCD, xcd = wgid % NXCD, off = wgid / NXCD; wgid = (xcd < r ? xcd * (q + 1) : r * (q + 1) + (xcd - r) * q) + off; }
        const int nig = WGM * nN, gid = wgid / nig, fm = gid * WGM, gsz = (nM - fm) < WGM ? (nM - fm) : WGM;
        u.pm = fm + ((wgid % nig) % gsz); u.pn = (wgid % nig) / gsz; return true;
    }
    __device__ __forceinline__ void a_ready(const Unit&) const {}
    __device__ __forceinline__ void done(const Unit&) const {}
};

__device__ __forceinline__ unsigned cvt_pk_bf16(float lo, float hi) { unsigned r; asm volatile("v_cvt_pk_bf16_f32 %0, %1, %2" : "=v"(r) : "v"(lo), "v"(hi)); return r; }
typedef float f32x2 __attribute__((ext_vector_type(2)));
template <class Epi, class Sched, bool ALIGN_EPI = false, bool SP2 = false>
__device__ __forceinline__ void gemm_phase(PG8_LAS unsigned char* lds, const Gemm g, const Sched& S, const Epi& E) {
    int tid_ = threadIdx.x; asm volatile("" : "+v"(tid_)); const int tid = tid_, wid = __builtin_amdgcn_readfirstlane(tid >> 6), lane = tid & 63, wr = wid >> 2, wc = wid & 3, fr = lane & 15, fq = lane >> 4;
    const int K = g.K, nt = K / BK;
    unsigned voffA[2], voffB[2];
#pragma unroll
    for (int i = 0; i < 2; ++i) { int R, C; stage_rc(tid * 16 + i * 8192, R, C); const int Rb = Epi::PERM ? ((R & ~31) + perm32(R & 31)) : R;
        voffA[i] = (unsigned)(R * K + C) * 2u; voffB[i] = (unsigned)(Rb * K + C) * 2u; }
    const size_t kstep = (size_t)(BK * 2);
    const size_t hstep = (size_t)HALF * K * 2;
    const size_t tstep = 2 * hstep;
    const unsigned ldsw = (unsigned)wid * 1024u;
    const int aoff = lds_byte(wr * 64 + fr, fq * 8), boff = lds_byte(wc * 32 + fr, fq * 8);
#define PG8_SA(b, h) (((b) * 2 + (h)) * HTB)
#define PG8_SB(b, h) ((4 + (b) * 2 + (h)) * HTB)
#define PG8_STAGE(bufoff, gbase, voff) do { _Pragma("unroll") for (int _i = 0; _i < 2; ++_i) \
        __builtin_amdgcn_global_load_lds((const unsigned*)((const char*)(gbase) + (voff)[_i]), (PG8_LAS unsigned*)(lds + (bufoff) + ldsw + _i * 8192), 16, 0, 0); } while (0)
#define PG8_LDA(dst, b, h) do { _Pragma("unroll") for (int m = 0; m < 4; ++m) _Pragma("unroll") for (int k = 0; k < 2; ++k) dst[m][k] = *(const PG8_LAS bf16x8*)(lds + PG8_SA(b, h) + aoff + m * 2048 + k * 1024); } while (0)
#define PG8_LDB(dst, b, h) do { _Pragma("unroll") for (int n = 0; n < 2; ++n) _Pragma("unroll") for (int k = 0; k < 2; ++k) dst[n][k] = *(const PG8_LAS bf16x8*)(lds + PG8_SB(b, h) + boff + n * 2048 + k * 1024); } while (0)
#define PG8_MMA(ai, bj, At, Bt) do { __builtin_amdgcn_s_setprio(1); _Pragma("unroll") for (int m = 0; m < 4; ++m) _Pragma("unroll") for (int n = 0; n < 2; ++n) _Pragma("unroll") for (int k = 0; k < 2; ++k) \
        acc[ai][bj][m][n] = __builtin_amdgcn_mfma_f32_16x16x32_bf16(Bt[n][k], At[m][k], acc[ai][bj][m][n], 0, 0, 0); __builtin_amdgcn_s_setprio(0); } while (0)
#define PG8_WAIT_V(n) asm volatile("s_waitcnt vmcnt(" #n ")" ::: "memory")
#define PG8_WAIT_L(n) asm volatile("s_waitcnt lgkmcnt(" #n ")" ::: "memory")
#define PG8_BAR __builtin_amdgcn_s_barrier()
#define PG8_SCHED __builtin_amdgcn_sched_barrier(0)
    Unit cur, nxt; int ui = 0;
    if (!S.next(0, cur)) return;
    f32x4 acc[2][2][4][2];
#pragma unroll
    for (int a = 0; a < 2; ++a)
#pragma unroll
        for (int b = 0; b < 2; ++b)
#pragma unroll
            for (int m = 0; m < 4; ++m)
#pragma unroll
                for (int n = 0; n < 2; ++n) acc[a][b][m][n] = (f32x4){0.f, 0.f, 0.f, 0.f};
    bf16x8 At[4][2], B0[2][2], B1[2][2];
    const char* cA = (const char*)g.A + (size_t)cur.pm * tstep; const char* cB = (const char*)g.Bt + (size_t)cur.pn * tstep;
    S.a_ready(cur);
    if constexpr (SP2) {
        PG8_STAGE(PG8_SB(0, 0), cB, voffB); PG8_STAGE(PG8_SB(0, 1), cB + hstep, voffB); PG8_STAGE(PG8_SA(0, 0), cA, voffA); PG8_STAGE(PG8_SA(0, 1), cA + hstep, voffA);
        if (wr == 1) PG8_BAR;
        PG8_WAIT_V(2); PG8_BAR;
        PG8_STAGE(PG8_SB(1, 0), cB + kstep, voffB); PG8_STAGE(PG8_SA(1, 0), cA + kstep, voffA); PG8_STAGE(PG8_SB(1, 1), cB + hstep + kstep, voffB);
        PG8_WAIT_V(6); PG8_BAR;
    } else {
        PG8_STAGE(PG8_SB(0, 0), cB, voffB); PG8_STAGE(PG8_SA(0, 0), cA, voffA); PG8_STAGE(PG8_SB(0, 1), cB + hstep, voffB); PG8_STAGE(PG8_SA(0, 1), cA + hstep, voffA);
        if (wr == 1) PG8_BAR;
        PG8_WAIT_V(4); PG8_BAR;
        PG8_STAGE(PG8_SB(1, 0), cB + kstep, voffB); PG8_STAGE(PG8_SA(1, 0), cA + kstep, voffA); PG8_STAGE(PG8_SB(1, 1), cB + hstep + kstep, voffB);
        PG8_WAIT_V(6); PG8_BAR;
    }
    for (;;) {
        const bool has_next = S.next(ui + 1, nxt);
        const char* nA = has_next ? (const char*)g.A + (size_t)nxt.pm * tstep : cA; const char* nB = has_next ? (const char*)g.Bt + (size_t)nxt.pn * tstep : cB;
        for (int t = 0; t < nt; t += 2) {
            const bool last = (t == nt - 2);
            const char* a1 = cA + (size_t)(t + 1) * kstep;
            const char* a2 = last ? nA : cA + (size_t)(t + 2) * kstep; const char* b2 = last ? nB : cB + (size_t)(t + 2) * kstep;
            const char* a3 = a2 + kstep; const char* b3 = b2 + kstep;
            if (last && has_next) S.a_ready(nxt);
            if constexpr (SP2) {
            PG8_LDB(B0, 0, 0); PG8_LDB(B1, 0, 1); PG8_SCHED; PG8_LDA(At, 0, 0); PG8_STAGE(PG8_SA(1, 1), a1 + hstep, voffA);
            PG8_WAIT_V(8); PG8_WAIT_L(0); PG8_BAR; PG8_MMA(0, 0, At, B0); PG8_MMA(0, 1, At, B1); PG8_BAR; PG8_SCHED;
            PG8_LDA(At, 0, 1); PG8_STAGE(PG8_SB(0, 0), b2, voffB); PG8_STAGE(PG8_SB(0, 1), b2 + hstep, voffB); PG8_STAGE(PG8_SA(0, 0), a2, voffA);
            PG8_WAIT_V(8); PG8_WAIT_L(0); PG8_BAR; PG8_MMA(1, 0, At, B0); PG8_MMA(1, 1, At, B1); PG8_BAR; PG8_SCHED;
            PG8_LDB(B0, 1, 0); PG8_LDB(B1, 1, 1); PG8_SCHED; PG8_LDA(At, 1, 0); PG8_STAGE(PG8_SA(0, 1), a2 + hstep, voffA);
            PG8_WAIT_V(8); PG8_WAIT_L(0); PG8_BAR; PG8_MMA(0, 0, At, B0); PG8_MMA(0, 1, At, B1); PG8_BAR; PG8_SCHED;
            PG8_LDA(At, 1, 1); PG8_STAGE(PG8_SB(1, 0), b3, voffB); PG8_STAGE(PG8_SB(1, 1), b3 + hstep, voffB); PG8_STAGE(PG8_SA(1, 0), a3, voffA);
            PG8_WAIT_V(8); PG8_WAIT_L(0); PG8_BAR; PG8_MMA(1, 0, At, B0); PG8_MMA(1, 1, At, B1); PG8_BAR; PG8_SCHED;
            } else {
            PG8_LDB(B0, 0, 0); PG8_SCHED; PG8_LDA(At, 0, 0); PG8_STAGE(PG8_SA(1, 1), a1 + hstep, voffA);
            PG8_WAIT_L(8); PG8_BAR; PG8_WAIT_L(0); PG8_MMA(0, 0, At, B0); PG8_BAR; PG8_SCHED;
            PG8_LDB(B1, 0, 1); PG8_STAGE(PG8_SB(0, 0), b2, voffB);
            PG8_BAR; PG8_WAIT_L(0); PG8_MMA(0, 1, At, B1); PG8_BAR;
            PG8_LDA(At, 0, 1); PG8_STAGE(PG8_SA(0, 0), a2, voffA);
            PG8_BAR; PG8_WAIT_L(0); PG8_MMA(1, 0, At, B0); PG8_BAR; PG8_SCHED;
            PG8_STAGE(PG8_SB(0, 1), b2 + hstep, voffB);
            PG8_WAIT_V(6); PG8_BAR; PG8_MMA(1, 1, At, B1); PG8_BAR;
            PG8_LDB(B0, 1, 0); PG8_SCHED; PG8_LDA(At, 1, 0); PG8_STAGE(PG8_SA(0, 1), a2 + hstep, voffA);
            PG8_WAIT_L(8); PG8_BAR; PG8_WAIT_L(0); PG8_MMA(0, 0, At, B0); PG8_BAR; PG8_SCHED;
            PG8_LDB(B1, 1, 1); PG8_STAGE(PG8_SB(1, 0), b3, voffB);
            PG8_BAR; PG8_WAIT_L(0); PG8_MMA(0, 1, At, B1); PG8_BAR;
            PG8_LDA(At, 1, 1); PG8_STAGE(PG8_SA(1, 0), a3, voffA);
            PG8_BAR; PG8_WAIT_L(0); PG8_MMA(1, 0, At, B0); PG8_BAR; PG8_SCHED;
            PG8_STAGE(PG8_SB(1, 1), b3 + hstep, voffB);
            PG8_WAIT_V(6); PG8_BAR; PG8_MMA(1, 1, At, B1); PG8_BAR;
            }
        }
        if constexpr (ALIGN_EPI) { if (wr == 0) PG8_BAR; }
        if constexpr (!Epi::AFTER_DRAIN) { E(acc, cur, wr, wc, fr, fq); S.done(cur); }
        if (!has_next) break;
#pragma unroll
        for (int a = 0; a < 2; ++a)
#pragma unroll
            for (int b = 0; b < 2; ++b)
#pragma unroll
                for (int m = 0; m < 4; ++m)
#pragma unroll
                    for (int n = 0; n < 2; ++n) acc[a][b][m][n] = (f32x4){0.f, 0.f, 0.f, 0.f};
        cur = nxt; cA = nA; cB = nB; ++ui;
        if constexpr (ALIGN_EPI) { if (wr == 1) PG8_BAR; }
    }
    PG8_WAIT_V(0);
    if constexpr (!ALIGN_EPI) { if (wr == 0) PG8_BAR; }
    PG8_BAR;
    if constexpr (Epi::AFTER_DRAIN) { E.fused(acc, cur, wr, wc, fr, fq, lds, wid, lane); S.done(cur); }
#undef PG8_SA
#undef PG8_SB
#undef PG8_STAGE
#undef PG8_LDA
#undef PG8_LDB
#undef PG8_MMA
#undef PG8_WAIT_V
#undef PG8_WAIT_L
#undef PG8_BAR
#undef PG8_SCHED
}
}
#define LAS __attribute__((address_space(3)))
typedef unsigned short bf16;
typedef short bf16x8 __attribute__((ext_vector_type(8)));
typedef short s16x4 __attribute__((ext_vector_type(4)));
typedef float f32x4 __attribute__((ext_vector_type(4)));
typedef float f32x16 __attribute__((ext_vector_type(16)));
typedef unsigned u32x4 __attribute__((ext_vector_type(4)));
typedef unsigned u32x2 __attribute__((ext_vector_type(2)));

constexpr int NB = 8, SEQ = 4096, DM = 1024, DEPTH = 4, NMETA = 16;
constexpr int MREAL = NB * SEQ;
constexpr int META0 = MREAL;
constexpr int MROWS = 129 * 256;
constexpr int NINP = 3328, QP = 3072;
constexpr int C_FQ = 0, C_FK = 512, C_FV = 1024, C_GQ = 1536, C_GK = 1792, C_GV = 2048, C_GR = 2560;
constexpr int DFF = 2816, NUP = 5632;
constexpr float EPS = 1e-6f, LOG2E = 1.4426950408889634f, C2 = 0.125f * LOG2E;
constexpr int CKP = 4160;
constexpr int NCH = 65;

constexpr size_t MiB = 1u << 20;
constexpr size_t WL_IN = 0, WL_OUT = 6815744, WL_UP = 8912896, WL_DN = 20447232, WL_SIZE = 26214400;
constexpr size_t WS_W = 0, WS_HB = 100 * MiB, WS_OB = WS_HB + 67633152, WS_QKV = WS_OB + 67633152, WS_UT = WS_QKV + 202899456;
constexpr size_t WS_SM = WS_UT + 68157440, WS_CK = WS_SM + 4456448, WS_DEC = WS_CK + 1310720, WS_HM = WS_DEC + 786432, WS_SSQ = WS_HM + MiB, WS_BAR = WS_SSQ + 1835008, BAR_BYTES = 16384, WS_END = WS_BAR + BAR_BYTES;
static_assert(WS_END <= 512 * MiB, "workspace map");
constexpr size_t HFL_SIZE = (size_t)129 * 2 * NUP * 4;
static_assert(2 * HFL_SIZE <= 68157440, "halo overlay");

constexpr int LDS_BYTES = 147456, HALO_OFF = 131072;

struct Args {
    const float *x, *meta, *attn_norm, *w_in, *w_au, *b_alpha, *b_forget, *gla_norm, *fox_norm, *w_out, *ffn_norm, *w_up, *conv_w, *conv_b, *w_down, *final_norm;
    float* out; unsigned char* ws;
};

#define GAS __attribute__((address_space(1)))
#define CAS __attribute__((address_space(4)))
typedef const CAS Args* KArgs;
__device__ __forceinline__ KArgs kargs() { KArgs p = (KArgs)__builtin_amdgcn_kernarg_segment_ptr(); asm volatile("" : "+s"(p)); return p; }
template <class T> __device__ __forceinline__ T* gptr(T* p) { return (T*)(GAS T*)p; }
__device__ __forceinline__ float bf2f(bf16 v) { return __uint_as_float((unsigned)v << 16); }
__device__ __forceinline__ unsigned pk2(float lo, float hi) { return pg8::cvt_pk_bf16(lo, hi); }
__device__ __forceinline__ bf16 f2bf(float v) { return (bf16)(pk2(v, 0.f) & 0xffffu); }
__device__ __forceinline__ float wave_sum(float v) {
#pragma unroll
    for (int o = 1; o < 64; o <<= 1) v += __shfl_xor(v, o);
    return v;
}
__device__ __forceinline__ float logsigmoidf(float z) { return -(fmaxf(-z, 0.f) + log1pf(__expf(-fabsf(z)))); }
__device__ __forceinline__ float siluf(float v) { return v * __builtin_amdgcn_rcpf(1.f + __builtin_amdgcn_exp2f(-LOG2E * v)); }
__device__ __forceinline__ int crow(int r, int hi) { return (r & 3) + 8 * (r >> 2) + 4 * hi; }
__device__ __forceinline__ s16x4 vtr(const LAS unsigned char* p) { return __builtin_bit_cast(s16x4, __builtin_amdgcn_ds_read_tr16_b64_v4i16((LAS s16x4*)p)); }
__device__ __forceinline__ bf16x8 cat8(s16x4 a, s16x4 b) { return (bf16x8){a[0], a[1], a[2], a[3], b[0], b[1], b[2], b[3]}; }
__device__ __forceinline__ float dppf(float old, float src, int ctrl_unused);
#define DPP_MOV(old, src, ctrl) __builtin_bit_cast(float, __builtin_amdgcn_update_dpp(__builtin_bit_cast(int, (float)(old)), __builtin_bit_cast(int, (float)(src)), (ctrl), 0xf, 0xf, false))
#define LDS_WAIT() asm volatile("s_waitcnt lgkmcnt(0)" ::: "memory")

__device__ __forceinline__ const float* ssq_arr(unsigned char* wsb, int si) { return (const float*)(wsb + WS_SSQ) + (size_t)(si % 3) * MROWS * 4; }
__device__ __forceinline__ float row_rstd(const float* ssqp, int row) { const f32x4 s = *(const f32x4*)(ssqp + (size_t)row * 4); return rsqrtf(((s[0] + s[1]) + (s[2] + s[3])) * (1.0f / DM) + EPS); }
__device__ __forceinline__ LAS float* tile_rstd(unsigned char* wsb, int si, int pm, int wr, int wc, int fr, int fq) {
    extern __shared__ __attribute__((aligned(16))) unsigned char lds_dyn_[];
    LAS float* rsl = (LAS float*)((LAS unsigned char*)lds_dyn_ + HALO_OFF + 8192);
    const int tl = (wr * 4 + wc) * 64 + fq * 16 + fr;
    if (pm != 128) {
        if (tl < 256) rsl[tl] = row_rstd(ssq_arr(wsb, si), pm * 256 + tl);
    } else {
        const int row = tl >> 5, part = tl & 31;
        const f32x4* hp = (const f32x4*)((const float*)(wsb + WS_HM) + (size_t)row * DM) + part;
        float s = 0.f;
#pragma unroll
        for (int j = 0; j < 8; ++j) { const f32x4 v = hp[32 * j]; s += (v[0] * v[0] + v[1] * v[1]) + (v[2] * v[2] + v[3] * v[3]); }
        s += __shfl_xor(s, 1); s += __shfl_xor(s, 2); s += __shfl_xor(s, 4); s += __shfl_xor(s, 8); s += __shfl_xor(s, 16);
        if (part == 0) rsl[row] = rsqrtf(s * (1.0f / DM) + EPS);
        if (tl < 240) rsl[16 + tl] = 0.f;
    }
    asm volatile("s_waitcnt lgkmcnt(0)" ::: "memory"); __builtin_amdgcn_s_barrier(); asm volatile("" ::: "memory");
    return rsl;
}
__device__ __forceinline__ void meta_rowgemm(const bf16* A, int lda, const bf16* Bt, int K, float* HM, bf16* HB, int G, int bx) {
    int tid_ = threadIdx.x; asm volatile("" : "+v"(tid_)); const int r = tid_ >> 5, kp = tid_ & 31;
    for (int cg = bx; cg < 256; cg += G) {
        float acc[4] = {0.f, 0.f, 0.f, 0.f};
        for (int k0 = kp * 8; k0 < K; k0 += 256) {
            const u32x4 av = *(const u32x4*)(A + (size_t)r * lda + k0);
#pragma unroll
            for (int j = 0; j < 4; ++j) {
                const u32x4 bv = *(const u32x4*)(Bt + (size_t)(4 * cg + j) * K + k0);
#pragma unroll
                for (int q = 0; q < 4; ++q) {
                    acc[j] += __uint_as_float(av[q] << 16) * __uint_as_float(bv[q] << 16);
                    acc[j] += __uint_as_float(av[q] & 0xffff0000u) * __uint_as_float(bv[q] & 0xffff0000u);
                }
            }
        }
#pragma unroll
        for (int j = 0; j < 4; ++j) { float s = acc[j]; s += __shfl_xor(s, 1); s += __shfl_xor(s, 2); s += __shfl_xor(s, 4); s += __shfl_xor(s, 8); s += __shfl_xor(s, 16); acc[j] = s; }
        if (kp == 0) {
            float* hp = HM + (size_t)r * DM + 4 * cg;
            const f32x4 h = *(const f32x4*)hp + (f32x4){acc[0], acc[1], acc[2], acc[3]};
            *(f32x4*)hp = h;
            u32x2 w; w.x = pk2(h[0], h[1]); w.y = pk2(h[2], h[3]);
            *(u32x2*)(HB + (size_t)(META0 + r) * DM + 4 * cg) = w;
        }
    }
}
struct EpiIn {
    static constexpr bool PERM = true, AFTER_DRAIN = false;
    int si;
    __device__ __forceinline__ void operator()(const pg8::f32x4 (&acc)[2][2][4][2], const pg8::Unit& u, int wr, int wc, int fr, int fq) const {
        asm volatile("" : "+v"(fr), "+v"(fq));
        unsigned char* wsb = gptr(kargs()->ws);
        bf16* Q = (bf16*)(wsb + WS_QKV); float* SM = (float*)(wsb + WS_SM); const LAS float* rsl = tile_rstd(wsb, si, u.pm, wr, wc, fr, fq);
#pragma unroll
        for (int ai = 0; ai < 2; ++ai)
#pragma unroll
            for (int m = 0; m < 4; ++m) {
                const int row = u.pm * 256 + ai * 128 + wr * 64 + m * 16 + fr;
                const float rs = rsl[ai * 128 + wr * 64 + m * 16 + fr];
                if (u.pn < 12) {
#pragma unroll
                    for (int bj = 0; bj < 2; ++bj) {
                        const pg8::f32x4 v0 = acc[ai][bj][m][0] * rs, v1 = acc[ai][bj][m][1] * rs;
                        u32x4 w; w.x = pk2(v0[0], v0[1]); w.y = pk2(v0[2], v0[3]); w.z = pk2(v1[0], v1[1]); w.w = pk2(v1[2], v1[3]);
                        *(u32x4*)(Q + (size_t)row * QP + u.pn * 256 + bj * 128 + wc * 32 + 8 * fq) = w;
                    }
                } else if (wc == 0) {
                    *(f32x4*)(SM + (size_t)row * 32 + 8 * fq) = acc[ai][0][m][0] * rs;
                    *(f32x4*)(SM + (size_t)row * 32 + 8 * fq + 4) = acc[ai][0][m][1] * rs;
                }
            }
    }
};
struct EpiRes {
    static constexpr bool PERM = false, AFTER_DRAIN = false;
    int from_x, si;
    __device__ __forceinline__ void operator()(const pg8::f32x4 (&acc)[2][2][4][2], const pg8::Unit& u, int wr, int wc, int fr, int fq) const {
        asm volatile("" : "+v"(fr), "+v"(fq));
        KArgs ka = kargs(); unsigned char* wsb = gptr(ka->ws);
        float* out = gptr(ka->out); const float* base = from_x ? gptr(ka->x) : out; float* hmeta = (float*)(wsb + WS_HM); bf16* HB = (bf16*)(wsb + WS_HB); float* ssq_next = (float*)ssq_arr(wsb, si);
        extern __shared__ __attribute__((aligned(16))) unsigned char lds_dyn_[];
        LAS float* red = (LAS float*)((LAS unsigned char*)lds_dyn_ + HALO_OFF);
#pragma unroll
        for (int ai = 0; ai < 2; ++ai)
#pragma unroll
            for (int m = 0; m < 4; ++m) {
                const int row = u.pm * 256 + ai * 128 + wr * 64 + m * 16 + fr;
                const float* bp = row < MREAL ? base + (size_t)row * DM : hmeta + (size_t)(row - MREAL) * DM;
                float* op = row < MREAL ? out + (size_t)row * DM : hmeta + (size_t)(row - MREAL) * DM;
                float ss = 0.f;
#pragma unroll
                for (int bj = 0; bj < 2; ++bj)
#pragma unroll
                    for (int n = 0; n < 2; ++n) {
                        const int col = u.pn * 256 + bj * 128 + wc * 32 + 16 * n + 4 * fq;
                        const f32x4 h = *(const f32x4*)(bp + col) + acc[ai][bj][m][n];
                        *(f32x4*)(op + col) = h;
                        ss += (h[0] * h[0] + h[1] * h[1]) + (h[2] * h[2] + h[3] * h[3]);
                        u32x2 w; w.x = pk2(h[0], h[1]); w.y = pk2(h[2], h[3]);
                        *(u32x2*)(HB + (size_t)row * DM + col) = w;
                    }
                ss += __shfl_xor(ss, 16); ss += __shfl_xor(ss, 32);
                if (fq == 0) red[wc * 256 + ai * 128 + wr * 64 + m * 16 + fr] = ss;
            }
        asm volatile("s_waitcnt lgkmcnt(0)" ::: "memory"); __builtin_amdgcn_s_barrier(); asm volatile("" ::: "memory");
        {
            const int tl = (wr * 4 + wc) * 64 + fq * 16 + fr;
            if (tl < 256) ssq_next[(size_t)(u.pm * 256 + tl) * 4 + u.pn] = (red[tl] + red[256 + tl]) + (red[512 + tl] + red[768 + tl]);
        }
    }
};
struct EpiUp {
    static constexpr bool PERM = true, AFTER_DRAIN = false;
    int L;
    __device__ __forceinline__ void operator()(pg8::f32x4 (&acc)[2][2][4][2], const pg8::Unit& u, int wr, int wc, int fr, int fq) const {
        asm volatile("" : "+v"(fr), "+v"(fq));
        KArgs ka = kargs(); unsigned char* wsb = gptr(ka->ws);
        const LAS float* rsl = tile_rstd(wsb, 2 * L + 1, u.pm, wr, wc, fr, fq); const float* cw = gptr(ka->conv_w) + (size_t)L * 3 * NUP; const float* cb = gptr(ka->conv_b) + (size_t)L * NUP;
        extern __shared__ __attribute__((aligned(16))) unsigned char lds_dyn_[];
        LAS float* halo = (LAS float*)((LAS unsigned char*)lds_dyn_ + HALO_OFF);
        const int colw = wc * 32 + 8 * fq;
#pragma unroll
        for (int ai = 0; ai < 2; ++ai)
#pragma unroll
            for (int m = 0; m < 4; ++m) {
                const int row = u.pm * 256 + ai * 128 + wr * 64 + m * 16 + fr;
                const float rs = rsl[ai * 128 + wr * 64 + m * 16 + fr]; (void)row;
#pragma unroll
                for (int bj = 0; bj < 2; ++bj)
#pragma unroll
                    for (int n = 0; n < 2; ++n) acc[ai][bj][m][n] *= rs;
            }
#ifdef SIMPLE_UP
        {
            const int ch0s = u.pn * 128 + colw;
#pragma unroll
            for (int n = 0; n < 2; ++n)
#pragma unroll
                for (int ai = 0; ai < 2; ++ai)
#pragma unroll
                    for (int m = 0; m < 4; ++m) {
                        const int row = u.pm * 256 + ai * 128 + wr * 64 + m * 16 + fr;
                        const f32x4 hu = acc[ai][0][m][n], hg = acc[ai][1][m][n];
                        u32x2 w; w.x = pk2(hu[0] + hg[0], hu[1] + hg[1]); w.y = pk2(hu[2] + hg[2], hu[3] + hg[3]);
                        *(u32x2*)(wsb + (unsigned)(WS_QKV + (unsigned)((row * DFF + ch0s + 4 * n) * 2))) = w;
                    }
            return;
        }
#endif
        if (fr >= 14) {
#pragma unroll
            for (int ai = 0; ai < 2; ++ai)
#pragma unroll
                for (int bj = 0; bj < 2; ++bj)
#pragma unroll
                    for (int n = 0; n < 2; ++n)
                        *(LAS f32x4*)(halo + (((2 * ai + wr) * 2 + (fr - 14)) * 256 + bj * 128 + colw + 4 * n)) = acc[ai][bj][3][n];
        }
        asm volatile("s_waitcnt lgkmcnt(0)" ::: "memory"); __builtin_amdgcn_s_barrier(); asm volatile("" ::: "memory");
        const int ch0 = u.pn * 128 + colw;
        u32x2 wout[2][4][2];
#pragma unroll
        for (int n = 0; n < 2; ++n) {
            f32x4 w0[2], w1[2], w2[2], bb[2];
#pragma unroll
            for (int bj = 0; bj < 2; ++bj) {
                const int c = bj * DFF + ch0 + 4 * n;
                w0[bj] = *(const f32x4*)((const char*)cw + (unsigned)(c * 4)); w1[bj] = *(const f32x4*)((const char*)cw + (unsigned)((NUP + c) * 4)); w2[bj] = *(const f32x4*)((const char*)cw + (unsigned)((2 * NUP + c) * 4)); bb[bj] = *(const f32x4*)((const char*)cb + (unsigned)(c * 4));
            }
#pragma unroll
            for (int ai = 0; ai < 2; ++ai)
#pragma unroll
                for (int m = 0; m < 4; ++m) {
                    const int g = 2 * ai + wr;
                    f32x4 hc[2];
#pragma unroll
                    for (int bj = 0; bj < 2; ++bj) {
                        const int c = bj * DFF + ch0 + 4 * n;
                        const f32x4 cur = acc[ai][bj][m][n];
                        f32x4 pb;
                        if (m > 0) pb = acc[ai][bj][m - 1][n];
                        else pb = *(const LAS f32x4*)(halo + ((((g > 0 ? g - 1 : 0) * 2) + (fr & 1)) * 256 + bj * 128 + colw + 4 * n));
                        f32x4 p1, p2;
#pragma unroll
                        for (int j = 0; j < 4; ++j) {
                            const float t1 = DPP_MOV(0.f, pb[j], 0x121);
                            p1[j] = DPP_MOV(t1, cur[j], 0x111);
                            const float t2 = DPP_MOV(0.f, pb[j], 0x122);
                            p2[j] = DPP_MOV(t2, cur[j], 0x112);
                        }
                        hc[bj] = bb[bj] + w0[bj] * p2 + w1[bj] * p1 + w2[bj] * cur;
                        if (g == 0 && m == 0 && fr < 2) *(f32x4*)(wsb + (unsigned)(WS_UT + (unsigned)(((u.pm * 2 + fr) * NUP + c) * 4))) = cur;
                        if (u.pm == 128 ? (g == 0 && m == 0 && fr >= 14) : (g == 3 && m == 3 && fr >= 14))
                            *(f32x4*)(wsb + (unsigned)(WS_UT + HFL_SIZE + (unsigned)(((u.pm * 2 + fr - 14) * NUP + c) * 4))) = cur;
                    }
                    wout[ai][m][n].x = pk2(siluf(hc[1][0]) * hc[0][0], siluf(hc[1][1]) * hc[0][1]);
                    wout[ai][m][n].y = pk2(siluf(hc[1][2]) * hc[0][2], siluf(hc[1][3]) * hc[0][3]);
                }
        }
#pragma unroll
        for (int ai = 0; ai < 2; ++ai)
#pragma unroll
            for (int m = 0; m < 4; ++m) {
                const int row = u.pm * 256 + ai * 128 + wr * 64 + m * 16 + fr;
                u32x4 w; w.x = wout[ai][m][0].x; w.y = wout[ai][m][0].y; w.z = wout[ai][m][1].x; w.w = wout[ai][m][1].y;
                *(u32x4*)(wsb + (unsigned)(WS_QKV + (unsigned)((row * DFF + ch0) * 2))) = w;
            }
    }
};
#define XB_TMO      128
#define XB_XCNT(j)  (256  + 64 * (j))
#define XB_XSUB(j)  (1280 + 64 * (j))
#define XB_XGEN(j)  (2304 + 64 * (j))
#define XB_TOP      3328
#define XB_TOPGEN   3392
#define XCD_BAR_WORDS 3456
#define XB_SPIN_CAP (1u << 18)

__device__ __forceinline__ unsigned xb_ld(unsigned* p)              { return __hip_atomic_load(p, __ATOMIC_RELAXED, __HIP_MEMORY_SCOPE_AGENT); }
__device__ __forceinline__ unsigned xb_add(unsigned* p, unsigned v) { return __hip_atomic_fetch_add(p, v, __ATOMIC_RELAXED, __HIP_MEMORY_SCOPE_AGENT); }
__device__ __forceinline__ unsigned xb_xcc_id() { return (unsigned)__builtin_amdgcn_s_getreg((3 << 11) | 20) & 0xFu; }
#define XB_SPIN(cond, bar) do { unsigned _sp = 0; while (cond) { __builtin_amdgcn_s_sleep(1); \
    if ((++_sp & 255u) == 0u) { if (xb_ld(&(bar)[XB_TMO])) break; if (_sp > XB_SPIN_CAP) { atomicAdd(&(bar)[XB_TMO], 1u); break; } } } } while (0)

struct XcdBarrier {
    unsigned* bar; unsigned x;
    volatile LAS unsigned* st;
};

__device__ __forceinline__ XcdBarrier xcd_barrier_post(unsigned* bar, volatile LAS unsigned* st) {
    XcdBarrier b; b.bar = bar; b.x = xb_xcc_id(); b.st = st;
    if (threadIdx.x == 0) (void)xb_add(&bar[XB_XCNT(b.x)], 1u);
    return b;
}
__device__ __forceinline__ void xcd_barrier_complete(unsigned* bar, unsigned x, unsigned& nloc, unsigned& nx) {
    const unsigned G = gridDim.x * gridDim.y * gridDim.z;
    unsigned sum, cnt, mine, sp = 0u;
    for (;;) {
        sum = 0u; cnt = 0u; mine = 0u;
#pragma unroll
        for (unsigned j = 0; j < 16; ++j) { const unsigned c = xb_ld(&bar[XB_XCNT(j)]); sum += c; cnt += (c > 0u) ? 1u : 0u; mine = (j == x) ? c : mine; }
        if (sum == G) break;
        __builtin_amdgcn_s_sleep(1);
        if ((++sp & 255u) == 0u) { if (xb_ld(&bar[XB_TMO])) break; if (sp > XB_SPIN_CAP) { atomicAdd(&bar[XB_TMO], 1u); break; } }
    }
    nloc = mine > 0u ? mine : 1u; nx = cnt > 0u ? cnt : 1u;
}

__device__ __forceinline__ void xcd_barrier(const XcdBarrier& b) {
    asm volatile("s_waitcnt vmcnt(0)" ::: "memory");
    __syncthreads();
    if (threadIdx.x == 0) {
        unsigned* bar = b.bar;
        __builtin_amdgcn_s_waitcnt(0);
        unsigned nloc = b.st[0], nx = b.st[1];
        if (nloc == 0u) { xcd_barrier_complete(bar, b.x, nloc, nx); b.st[0] = nloc; b.st[1] = nx; }
        const unsigned old = xb_add(&bar[XB_XSUB(b.x)], 1u);
        const unsigned gen = old / nloc;
        if (old + 1u == (gen + 1u) * nloc) {
            __builtin_amdgcn_fence(__ATOMIC_RELEASE, "agent");
            asm volatile("s_waitcnt vmcnt(0)" ::: "memory");
            const unsigned og = xb_add(&bar[XB_TOP], 1u);
            const unsigned tg = og / nx;
            if (og + 1u == (tg + 1u) * nx) xb_add(&bar[XB_TOPGEN], 1u);
            else XB_SPIN(xb_ld(&bar[XB_TOPGEN]) == tg, bar);
            __builtin_amdgcn_fence(__ATOMIC_ACQUIRE, "agent");
            xb_add(&bar[XB_XGEN(b.x)], 1u);
            asm volatile("s_waitcnt vmcnt(0)" ::: "memory");
        } else {
            XB_SPIN(xb_ld(&bar[XB_XGEN(b.x)]) == gen, bar);
            __builtin_amdgcn_fence(__ATOMIC_ACQUIRE, "agent");
            asm volatile("s_waitcnt vmcnt(0)" ::: "memory");
        }
    }
    __syncthreads();
}
__device__ __forceinline__ int win_src(int n) {
    if (n < 512) return 1552 + n;
    if (n < 1024) return 2064 + (n - 512);
    if (n < 1536) return 2576 + (n - 1024);
    if (n < 1792) return n - 1536;
    if (n < 2048) return 256 + (n - 1792);
    if (n < 2560) return 512 + (n - 2048);
    if (n < 3072) return 1024 + (n - 2560);
    if (n < 3088) return 1536 + (n - 3072);
    if (n < 3096) return n;
    return -1;
}
__device__ __forceinline__ void tr_item(const float* W, int Nsrc, bf16* WT, int K, const float* gk, int mode, LAS float* scr, int k0, int n0, int lane) {
    const int nl = lane & 31, n = n0 + nl;
    int src = n; float cs = 1.f;
    if (mode == 0) { src = win_src(n); cs = n < 512 ? C2 : ((n >= 1536 && n < 1792) ? 0.125f : 1.f); }
    else if (mode == 2) { const int pn = n >> 8, j = n & 255; src = j < 128 ? pn * 128 + j : DFF + pn * 128 + (j - 128); }
#pragma unroll
    for (int i = 0; i < 32; ++i) {
        const int kk = 2 * i + (lane >> 5);
        float v = 0.f;
        if (src >= 0) v = W[(size_t)(k0 + kk) * Nsrc + src] * cs;
        if (gk) v *= gk[k0 + kk];
        scr[kk * 33 + nl] = v;
    }
    LDS_WAIT(); asm volatile("" ::: "memory");
    const int c = lane & 7;
#pragma unroll
    for (int j = 0; j < 4; ++j) {
        const int nn = (lane >> 3) + 8 * j; const LAS float* s = scr + (8 * c) * 33 + nn;
        u32x4 o; o.x = pk2(s[0 * 33], s[1 * 33]); o.y = pk2(s[2 * 33], s[3 * 33]); o.z = pk2(s[4 * 33], s[5 * 33]); o.w = pk2(s[6 * 33], s[7 * 33]);
        *(u32x4*)(WT + (size_t)(n0 + nn) * K + k0 + 8 * c) = o;
    }
    LDS_WAIT(); asm volatile("" ::: "memory");
}
__device__ __forceinline__ void row_to_bf16(const float* xrow, bf16* orow, float* ssq_slot, float* copy_row, int lane) {
    const f32x4* xr = (const f32x4*)xrow + lane;
    f32x4 v[4]; float s = 0.f;
#pragma unroll
    for (int j = 0; j < 4; ++j) { v[j] = xr[64 * j]; s += (v[j][0] * v[j][0] + v[j][1] * v[j][1]) + (v[j][2] * v[j][2] + v[j][3] * v[j][3]); }
    s = wave_sum(s);
    if (lane == 0) *(f32x4*)ssq_slot = (f32x4){s, 0.f, 0.f, 0.f};
    u32x2* o8 = (u32x2*)orow + lane;
#pragma unroll
    for (int j = 0; j < 4; ++j) { u32x2 w; w.x = pk2(v[j][0], v[j][1]); w.y = pk2(v[j][2], v[j][3]); o8[64 * j] = w; }
    if (copy_row) {
#pragma unroll
        for (int j = 0; j < 4; ++j) ((f32x4*)copy_row + lane)[64 * j] = v[j];
    }
}

__device__ __forceinline__ void gla_u_pair(LAS unsigned char* lds, const bf16* QKV, const float* SM, const float* wau, const float* balpha, float* UT, float* DEC, int pair) {
    int tid_ = threadIdx.x; asm volatile("" : "+v"(tid_)); const int tid = tid_, lane = tid & 63, wid = __builtin_amdgcn_readfirstlane(tid >> 6), hi = lane >> 5, r32 = lane & 31;
    constexpr int SUB = 9216 + 17408 + 2048;
    const int dk = lane, sg = wid;
    int bhq[2], ccq[2], hq[2], row0q[2], tvq[2];
    float la[2][8], kf[2][8];
#pragma unroll
    for (int q = 0; q < 2; ++q) {
        const int u = 2 * pair + q; bhq[q] = u / NCH; ccq[q] = u % NCH; hq[q] = bhq[q] & 3;
        row0q[q] = ccq[q] == 0 ? META0 : (bhq[q] >> 2) * SEQ + (ccq[q] - 1) * 64; tvq[q] = ccq[q] == 0 ? NMETA : 64;
        LAS unsigned char* VT = lds + q * SUB + 9216;
        LAS float* TOT = (LAS float*)(lds + q * SUB + 9216 + 17408);
#pragma unroll
        for (int i = 0; i < 2; ++i) {
            const int idx = tid + 512 * i, row = idx >> 4, ch = idx & 15;
            const u32x4 v = *(const u32x4*)(QKV + (size_t)(row0q[q] + row) * QP + C_GV + hq[q] * 128 + ch * 8);
            *(LAS u32x4*)(VT + row * 272 + ch * 16) = v;
        }
#pragma unroll
        for (int i = 0; i < 8; ++i) kf[q][i] = bf2f(QKV[(size_t)(row0q[q] + 8 * sg + i) * QP + C_GK + hq[q] * 64 + dk]);
        float w[16];
#pragma unroll
        for (int r = 0; r < 16; ++r) w[r] = wau[r * 256 + hq[q] * 64 + dk];
        const float bias = balpha[hq[q] * 64 + dk];
#pragma unroll
        for (int i = 0; i < 8; ++i) {
            const int s = 8 * sg + i;
            const f32x4* g4 = (const f32x4*)(SM + (size_t)(row0q[q] + s) * 32);
            float z = bias;
#pragma unroll
            for (int k = 0; k < 4; ++k) { const f32x4 gv = g4[k]; z += gv[0] * w[4 * k] + gv[1] * w[4 * k + 1] + gv[2] * w[4 * k + 2] + gv[3] * w[4 * k + 3]; }
            la[q][i] = (s < tvq[q]) ? logsigmoidf(z) * (1.0f / 16.0f) : 0.f;
        }
#pragma unroll
        for (int i = 1; i < 8; ++i) la[q][i] += la[q][i - 1];
        TOT[sg * 64 + dk] = la[q][7];
    }
    __syncthreads();
#pragma unroll
    for (int q = 0; q < 2; ++q) {
        LAS unsigned char* KD = lds + q * SUB;
        const LAS float* TOT = (const LAS float*)(lds + q * SUB + 9216 + 17408);
        float pre = 0.f, tot = 0.f;
#pragma unroll
        for (int g2 = 0; g2 < 8; ++g2) { const float t = TOT[g2 * 64 + dk]; if (g2 < sg) pre += t; tot += t; }
        if (sg == 0) DEC[(size_t)(bhq[q] * NCH + ccq[q]) * 64 + dk] = __expf(tot);
#pragma unroll
        for (int i = 0; i < 8; ++i) {
            const int s = 8 * sg + i;
            const float kd = (s < tvq[q]) ? kf[q][i] * __expf(tot - (pre + la[q][i])) : 0.f;
            *(LAS bf16*)(KD + s * 144 + dk * 2) = f2bf(kd);
        }
    }
    __syncthreads();
    const int dvb = wid >> 1, dkb = wid & 1;
    const int qq = (lane & 15) >> 2, pp = lane & 3, half = (lane >> 4) & 1;
#pragma unroll
    for (int q = 0; q < 2; ++q) {
        const LAS unsigned char* KD = lds + q * SUB; const LAS unsigned char* VT = lds + q * SUB + 9216;
        f32x16 acc = {};
#pragma unroll
        for (int j = 0; j < 4; ++j) {
            const LAS unsigned char* ap = VT + (16 * j + 4 * hi + qq) * 272 + (32 * dvb + 16 * half + 4 * pp) * 2;
            const LAS unsigned char* bp = KD + (16 * j + 4 * hi + qq) * 144 + (32 * dkb + 16 * half + 4 * pp) * 2;
            const bf16x8 af = cat8(vtr(ap), vtr(ap + 8 * 272));
            const bf16x8 bfr = cat8(vtr(bp), vtr(bp + 8 * 144));
            acc = __builtin_amdgcn_mfma_f32_32x32x16_bf16(af, bfr, acc, 0, 0, 0);
        }
        float* up = UT + ((size_t)(bhq[q] * NCH + ccq[q]) * 128 + 32 * dvb) * 64 + 32 * dkb + r32;
#pragma unroll
        for (int r = 0; r < 16; ++r) up[crow(r, hi) * 64] = acc[r];
    }
    __syncthreads();
}
__device__ __forceinline__ void fox_cumsum_unit(LAS unsigned char* lds, const float* SM, const float* bforget, float* CK, int bh) {
    int tid_ = threadIdx.x; asm volatile("" : "+v"(tid_)); const int tid = tid_, lane = tid & 63, wid = tid >> 6;
    const int b = bh >> 3, h = bh & 7;
    const float bf_ = bforget[h];
    LAS float* WT_ = (LAS float*)lds;
    float mtot = 0.f, mine = 0.f;
    for (int p = 0; p < NMETA; ++p) { mtot += logsigmoidf(SM[(size_t)(META0 + p) * 32 + 16 + h] + bf_); if (tid == p) mine = mtot; }
    if (tid < 64) CK[(size_t)bh * CKP + tid] = tid < NMETA ? -LOG2E * mine : -INFINITY;
    float v[8]; float run = 0.f;
#pragma unroll
    for (int i = 0; i < 8; ++i) { run += logsigmoidf(SM[(size_t)(b * SEQ + 8 * tid + i) * 32 + 16 + h] + bf_); v[i] = run; }
    float inc = run;
#pragma unroll
    for (int o = 1; o < 64; o <<= 1) { const float t = __shfl_up(inc, o); if (lane >= o) inc += t; }
    if (lane == 63) WT_[wid] = inc;
    __syncthreads();
    float off = mtot + (inc - run);
    for (int w2 = 0; w2 < wid; ++w2) off += WT_[w2];
#pragma unroll
    for (int i = 0; i < 8; ++i) CK[(size_t)bh * CKP + 64 + 8 * tid + i] = -LOG2E * (off + v[i]);
    __syncthreads();
}

__device__ __forceinline__ void attn_unit(LAS unsigned char* lds, const bf16* QKV, const float* CK, bf16* OB, const float* fnorm, int b, int h, int qb) {
    int tid_ = threadIdx.x; asm volatile("" : "+v"(tid_)); const int tid = tid_, lane = tid & 63, wid = __builtin_amdgcn_readfirstlane(tid >> 6), r32 = lane & 31, hi = lane >> 5;
    constexpr int KB = 9216, KOFF = 0, VOFF = 2 * KB, COFF = 4 * KB, WOFF = COFF + 512;
    LAS float* wsf = (LAS float*)(lds + WOFF) + wid * 64;
    const size_t rowb = (size_t)b * SEQ; const int q0 = qb * 256;
    const int NT = 1 + 4 * (qb + 1);
    const bf16* qp = QKV + (rowb + q0 + wid * 32 + r32) * QP + C_FQ + h * 64 + hi * 8;
    bf16x8 qr[4];
#pragma unroll
    for (int d0 = 0; d0 < 4; ++d0) qr[d0] = *(const bf16x8*)(qp + d0 * 16);
    const int srow = tid >> 3, sch = tid & 7;
    const float* ckp = CK + (size_t)(b * 8 + h) * CKP;
    u32x4 kreg, vreg; float creg = 0.f;
#define ATT_LOAD(t) do { const size_t r0_ = (t) == 0 ? (size_t)META0 : rowb + (size_t)((t) - 1) * 64; const bf16* p_ = QKV + (r0_ + srow) * QP + h * 64 + sch * 8; \
        kreg = *(const u32x4*)(p_ + C_FK); vreg = *(const u32x4*)(p_ + C_FV); if (tid < 64) creg = ckp[(t) * 64 + tid]; } while (0)
#define ATT_STORE(buf) do { *(LAS u32x4*)(lds + KOFF + (buf) * KB + srow * 144 + sch * 16) = kreg; *(LAS u32x4*)(lds + VOFF + (buf) * KB + srow * 144 + sch * 16) = vreg; \
        if (tid < 64) *(LAS float*)(lds + COFF + (buf) * 256 + tid * 4) = creg; } while (0)
    float m = -1e30f, l = 0.f; f32x16 o0 = {}, o1 = {};
    const int qrel = 32 * wid + r32;
    const int qq = (lane & 15) >> 2, pp = lane & 3, half = (lane >> 4) & 1;
    ATT_LOAD(0); ATT_STORE(0);
    for (int t = 0; t < NT; ++t) {
        const int buf = t & 1;
        if (t + 1 < NT) ATT_LOAD(t + 1);
        __syncthreads();
        const int jb = t - (NT - 4);
        const bool skip = (jb >= 0) && (64 * jb > 32 * wid + 31);
        if (!skip) {
            const LAS unsigned char* Kb = lds + KOFF + buf * KB; const LAS unsigned char* Vb = lds + VOFF + buf * KB; const LAS float* Cb = (const LAS float*)(lds + COFF + buf * 256);
            f32x16 p0, p1;
#pragma unroll
            for (int g = 0; g < 4; ++g) {
                const f32x4 c0 = *(const LAS f32x4*)(Cb + 8 * g + 4 * hi), c1 = *(const LAS f32x4*)(Cb + 32 + 8 * g + 4 * hi);
#pragma unroll
                for (int i = 0; i < 4; ++i) { p0[4 * g + i] = c0[i]; p1[4 * g + i] = c1[i]; }
            }
#pragma unroll
            for (int d0 = 0; d0 < 4; ++d0) {
                const bf16x8 a0 = *(const LAS bf16x8*)(Kb + r32 * 144 + (16 * d0 + 8 * hi) * 2);
                const bf16x8 a1 = *(const LAS bf16x8*)(Kb + (32 + r32) * 144 + (16 * d0 + 8 * hi) * 2);
                p0 = __builtin_amdgcn_mfma_f32_32x32x16_bf16(a0, qr[d0], p0, 0, 0, 0);
                p1 = __builtin_amdgcn_mfma_f32_32x32x16_bf16(a1, qr[d0], p1, 0, 0, 0);
            }
            if (jb >= 0 && 64 * jb + 63 > 32 * wid) {
#pragma unroll
                for (int r = 0; r < 16; ++r) { const int kv = 64 * jb + crow(r, hi); if (kv > qrel) p0[r] = -INFINITY; if (kv + 32 > qrel) p1[r] = -INFINITY; }
            }
            float mx = fmaxf(fmaxf(p0[0], p1[0]), fmaxf(p0[1], p1[1]));
#pragma unroll
            for (int r = 2; r < 16; r += 2) mx = fmaxf(fmaxf(mx, fmaxf(p0[r], p1[r])), fmaxf(p0[r + 1], p1[r + 1]));
            mx = fmaxf(mx, __shfl_xor(mx, 32));
            if (__any(mx > m + 8.0f)) {
                const float mn = fmaxf(m, mx);
                const float alpha = __builtin_amdgcn_exp2f(m - mn);
                m = mn; l *= alpha;
                if (hi == 0) wsf[r32] = alpha;
                LDS_WAIT();
#pragma unroll
                for (int g = 0; g < 4; ++g) {
                    const f32x4 a = *(const LAS f32x4*)(wsf + 8 * g + 4 * hi);
#pragma unroll
                    for (int i = 0; i < 4; ++i) { o0[4 * g + i] *= a[i]; o1[4 * g + i] *= a[i]; }
                }
            }
            float rsum = 0.f;
#pragma unroll
            for (int r = 0; r < 16; ++r) { p0[r] = __builtin_amdgcn_exp2f(p0[r] - m); p1[r] = __builtin_amdgcn_exp2f(p1[r] - m); rsum += p0[r] + p1[r]; }
            l += rsum;
            bf16x8 pa[4];
            { u32x4 w;
              w.x = pk2(p0[0], p0[1]); w.y = pk2(p0[2], p0[3]); w.z = pk2(p0[4], p0[5]); w.w = pk2(p0[6], p0[7]); pa[0] = __builtin_bit_cast(bf16x8, w);
              w.x = pk2(p0[8], p0[9]); w.y = pk2(p0[10], p0[11]); w.z = pk2(p0[12], p0[13]); w.w = pk2(p0[14], p0[15]); pa[1] = __builtin_bit_cast(bf16x8, w);
              w.x = pk2(p1[0], p1[1]); w.y = pk2(p1[2], p1[3]); w.z = pk2(p1[4], p1[5]); w.w = pk2(p1[6], p1[7]); pa[2] = __builtin_bit_cast(bf16x8, w);
              w.x = pk2(p1[8], p1[9]); w.y = pk2(p1[10], p1[11]); w.z = pk2(p1[12], p1[13]); w.w = pk2(p1[14], p1[15]); pa[3] = __builtin_bit_cast(bf16x8, w); }
#pragma unroll
            for (int j = 0; j < 4; ++j) {
                const LAS unsigned char* vp = Vb + (16 * j + 4 * hi + qq) * 144 + (16 * half + 4 * pp) * 2;
                const bf16x8 v0 = cat8(vtr(vp), vtr(vp + 8 * 144));
                const bf16x8 v1 = cat8(vtr(vp + 64), vtr(vp + 64 + 8 * 144));
                o0 = __builtin_amdgcn_mfma_f32_32x32x16_bf16(pa[j], v0, o0, 0, 0, 0);
                o1 = __builtin_amdgcn_mfma_f32_32x32x16_bf16(pa[j], v1, o1, 0, 0, 0);
            }
        }
        if (t + 1 < NT) ATT_STORE(buf ^ 1);
    }
#undef ATT_LOAD
#undef ATT_STORE
    l += __shfl_xor(l, 32);
    if (hi == 0) wsf[r32] = 1.0f / l;
    LDS_WAIT();
#pragma unroll
    for (int g = 0; g < 4; ++g) {
        const f32x4 a = *(const LAS f32x4*)(wsf + 8 * g + 4 * hi);
#pragma unroll
        for (int i = 0; i < 4; ++i) { o0[4 * g + i] *= a[i]; o1[4 * g + i] *= a[i]; }
    }
    const float w0 = fnorm[h * 64 + r32], w1 = fnorm[h * 64 + 32 + r32];
#pragma unroll
    for (int r = 0; r < 16; ++r) {
        float s = o0[r] * o0[r] + o1[r] * o1[r];
        s += __shfl_xor(s, 1); s += __shfl_xor(s, 2); s += __shfl_xor(s, 4); s += __shfl_xor(s, 8); s += __shfl_xor(s, 16);
        const float rs = rsqrtf(s * (1.0f / 64.0f) + EPS);
        bf16* op = OB + (rowb + q0 + wid * 32 + crow(r, hi)) * DM + 512 + h * 64 + r32;
        op[0] = f2bf(o0[r] * rs * w0); op[32] = f2bf(o1[r] * rs * w1);
    }
    __syncthreads();
}
__device__ __forceinline__ void meta_attn(const bf16* QKV, const float* CK, bf16* OB, const float* fnorm, int p) {
    int tid_ = threadIdx.x; asm volatile("" : "+v"(tid_)); const int lane = tid_ & 63, h = tid_ >> 6;
    const float q = bf2f(QKV[(size_t)(META0 + p) * QP + C_FQ + h * 64 + lane]);
    float sc[NMETA], vv[NMETA];
#pragma unroll
    for (int s = 0; s < NMETA; ++s) {
        sc[s] = q * bf2f(QKV[(size_t)(META0 + s) * QP + C_FK + h * 64 + lane]);
        vv[s] = bf2f(QKV[(size_t)(META0 + s) * QP + C_FV + h * 64 + lane]);
    }
    float m = -1e30f;
#pragma unroll
    for (int s = 0; s < NMETA; ++s) { sc[s] = (s <= p) ? wave_sum(sc[s]) + CK[(size_t)h * CKP + s] : -INFINITY; m = fmaxf(m, sc[s]); }
    float l = 0.f, o = 0.f;
#pragma unroll
    for (int s = 0; s < NMETA; ++s) { const float pw = __builtin_amdgcn_exp2f(sc[s] - m); l += pw; o += pw * vv[s]; }
    o /= l;
    const float ss = wave_sum(o * o);
    OB[(size_t)(META0 + p) * DM + 512 + h * 64 + lane] = f2bf(o * rsqrtf(ss * (1.0f / 64.0f) + EPS) * fnorm[h * 64 + lane]);
}
__device__ __forceinline__ void gla_readout_wave(const bf16* QKV, const float* UT, bf16* OB, const float* gnorm, int bh, int cc, int half, int lane) {
    asm volatile("" : "+v"(lane));
    const int b = bh >> 2, h = bh & 3;
    const int r32 = lane & 31, hi = lane >> 5;
    const int row0 = cc == 0 ? META0 : b * SEQ + (cc - 1) * 64 + 32 * half, nvalid = cc == 0 ? NMETA : 32;
    const float* Sp = UT + (size_t)(bh * NCH + cc) * 8192;
    f32x16 acc[4] = {};
#pragma unroll
    for (int j = 0; j < 4; ++j) {
        const bf16x8 bq = *(const bf16x8*)(QKV + (size_t)(row0 + r32) * QP + C_GQ + h * 64 + 16 * j + 8 * hi);
#pragma unroll
        for (int blk = 0; blk < 4; ++blk) {
            const float* sp = Sp + (32 * blk + r32) * 64 + 16 * j + 8 * hi;
            const f32x4 s0 = *(const f32x4*)sp, s1 = *(const f32x4*)(sp + 4);
            u32x4 w; w.x = pk2(s0[0], s0[1]); w.y = pk2(s0[2], s0[3]); w.z = pk2(s1[0], s1[1]); w.w = pk2(s1[2], s1[3]);
            acc[blk] = __builtin_amdgcn_mfma_f32_32x32x16_bf16(__builtin_bit_cast(bf16x8, w), bq, acc[blk], 0, 0, 0);
        }
    }
    float ss = 0.f;
#pragma unroll
    for (int blk = 0; blk < 4; ++blk)
#pragma unroll
        for (int r = 0; r < 16; ++r) ss += acc[blk][r] * acc[blk][r];
    ss += __shfl_xor(ss, 32);
    const float rs = rsqrtf(ss * (1.0f / 128.0f) + EPS);
    if (r32 < nvalid) {
        const size_t row = (size_t)row0 + r32;
#pragma unroll
        for (int blk = 0; blk < 4; ++blk)
#pragma unroll
            for (int g = 0; g < 4; ++g) {
                const int dv = 32 * blk + 8 * g + 4 * hi;
                const u32x2 gt = *(const u32x2*)(QKV + row * QP + C_GR + h * 128 + dv);
                const f32x4 wn = *(const f32x4*)(gnorm + h * 128 + dv);
                const float g0 = __uint_as_float(gt.x << 16), g1 = __uint_as_float(gt.x & 0xffff0000u), g2 = __uint_as_float(gt.y << 16), g3 = __uint_as_float(gt.y & 0xffff0000u);
                u32x2 w;
                w.x = pk2(acc[blk][4 * g] * rs * wn[0] * siluf(g0), acc[blk][4 * g + 1] * rs * wn[1] * siluf(g1));
                w.y = pk2(acc[blk][4 * g + 2] * rs * wn[2] * siluf(g2), acc[blk][4 * g + 3] * rs * wn[3] * siluf(g3));
                *(u32x2*)(OB + row * DM + h * 128 + dv) = w;
            }
    }
}

#define FRESH() KArgs ka_ = kargs(); Args a; a.x = gptr(ka_->x); a.meta = gptr(ka_->meta); a.attn_norm = gptr(ka_->attn_norm); a.w_in = gptr(ka_->w_in); a.w_au = gptr(ka_->w_au); a.b_alpha = gptr(ka_->b_alpha); a.b_forget = gptr(ka_->b_forget); a.gla_norm = gptr(ka_->gla_norm); a.fox_norm = gptr(ka_->fox_norm); a.w_out = gptr(ka_->w_out); a.ffn_norm = gptr(ka_->ffn_norm); a.w_up = gptr(ka_->w_up); a.conv_w = gptr(ka_->conv_w); a.conv_b = gptr(ka_->conv_b); a.w_down = gptr(ka_->w_down); a.final_norm = gptr(ka_->final_norm); a.out = gptr(ka_->out); a.ws = gptr(ka_->ws); unsigned char* ws = a.ws; \
    bf16* HB = (bf16*)(ws + WS_HB); bf16* OB = (bf16*)(ws + WS_OB); bf16* QKV = (bf16*)(ws + WS_QKV); bf16* A2 = (bf16*)(ws + WS_QKV); \
    float* UT = (float*)(ws + WS_UT); float* HF = (float*)(ws + WS_UT); float* HL = (float*)(ws + WS_UT + HFL_SIZE); \
    float* SM = (float*)(ws + WS_SM); float* CK = (float*)(ws + WS_CK); float* DEC = (float*)(ws + WS_DEC); float* HM = (float*)(ws + WS_HM); float* SSQ = (float*)(ws + WS_SSQ); \
    unsigned char* wl = ws + WS_W + (size_t)L * WL_SIZE; \
    (void)HB; (void)OB; (void)QKV; (void)A2; (void)UT; (void)HF; (void)HL; (void)SM; (void)CK; (void)DEC; (void)HM; (void)SSQ; (void)wl; \
    int tid_ = threadIdx.x; asm volatile("" : "+v"(tid_)); const int tid = tid_, lane = tid & 63, wid = __builtin_amdgcn_readfirstlane(tid >> 6); \
    const int gw = bx * 8 + wid, NGW = G * 8, gt = bx * 512 + tid, NGT = G * 512; (void)lane; (void)gw; (void)NGW; (void)gt; (void)NGT;
#ifndef REP_A
#define REP_A 1
#endif
#ifndef REP_CA
#define REP_CA 1
#endif
#ifndef REP_F
#define REP_F 1
#endif
#ifndef REP_B
#define REP_B 1
#endif
#ifndef REP_D
#define REP_D 1
#endif
#define GSYNC_CG() do { asm volatile("s_waitcnt vmcnt(0) lgkmcnt(0)" ::: "memory"); grid.sync(); __builtin_amdgcn_fence(__ATOMIC_ACQUIRE, "agent"); asm volatile("s_waitcnt vmcnt(0)" ::: "memory"); } while (0)
#define GSYNC() xcd_barrier(xbar)
__global__ void __launch_bounds__(512, 2) fwd_kernel(Args a_unused) {
    extern __shared__ __attribute__((aligned(16))) unsigned char lds_raw[];
    LAS unsigned char* lds = (LAS unsigned char*)lds_raw;
    cg::grid_group grid = cg::this_grid();
    const int G = gridDim.x, bx = blockIdx.x;
    volatile LAS unsigned* xst = (volatile LAS unsigned*)(lds + HALO_OFF + 8192 + 1024);
    if (threadIdx.x < 2) xst[threadIdx.x] = 0u;
    __syncthreads();
    const XcdBarrier xbar = xcd_barrier_post((unsigned*)(gptr(kargs()->ws) + WS_BAR), xst);
#ifndef REP_P
#define REP_P 1
#endif
    for (int rep = 0; rep < REP_P; ++rep) {
        const int L = 0; FRESH();
        LAS float* scr = (LAS float*)(lds + wid * 16384);
        constexpr int I_IN = 16 * (NINP / 32), I_OUT = 16 * 32, I_UP = 16 * (NUP / 32), I_DN = (DFF / 64) * 32, I_L = I_IN + I_OUT + I_UP + I_DN;
        for (int it = gw; it < DEPTH * I_L; it += NGW) {
            const int L = it / I_L; int r = it % I_L;
            unsigned char* wl = ws + WS_W + (size_t)L * WL_SIZE;
            if (r < I_IN) { const int nb = NINP / 32; tr_item(a.w_in + (size_t)L * DM * 3096, 3096, (bf16*)(wl + WL_IN), DM, a.attn_norm + L * DM, 0, scr, 64 * (r / nb), 32 * (r % nb), lane); continue; } r -= I_IN;
            if (r < I_OUT) { tr_item(a.w_out + (size_t)L * DM * DM, DM, (bf16*)(wl + WL_OUT), DM, nullptr, 1, scr, 64 * (r / 32), 32 * (r % 32), lane); continue; } r -= I_OUT;
            if (r < I_UP) { const int nb = NUP / 32; tr_item(a.w_up + (size_t)L * DM * NUP, NUP, (bf16*)(wl + WL_UP), DM, a.ffn_norm + L * DM, 2, scr, 64 * (r / nb), 32 * (r % nb), lane); continue; } r -= I_UP;
            tr_item(a.w_down + (size_t)L * DFF * DM, DM, (bf16*)(wl + WL_DN), DFF, nullptr, 3, scr, 64 * (r / 32), 32 * (r % 32), lane);
        }
        for (int i = gt; i < (256 - NMETA) * 4; i += NGT) SSQ[(size_t)(META0 + NMETA) * 4 + i] = 0.f;
        for (int r = gw; r < MREAL + 256; r += NGW) {
            if (r < MREAL) row_to_bf16(a.x + (size_t)r * DM, HB + (size_t)r * DM, SSQ + (size_t)r * 4, nullptr, lane);
            else if (r < MREAL + NMETA) row_to_bf16(a.meta + (size_t)(r - MREAL) * DM, HB + (size_t)r * DM, SSQ + (size_t)r * 4, HM + (size_t)(r - MREAL) * DM, lane);
            else {
#pragma unroll
                for (int j = 0; j < 4; ++j) { ((f32x4*)(HM + (size_t)(r - MREAL) * DM) + lane)[64 * j] = (f32x4){0.f, 0.f, 0.f, 0.f};
                    ((u32x2*)(HB + (size_t)r * DM) + lane)[64 * j] = (u32x2){0u, 0u}; ((u32x2*)(OB + (size_t)r * DM) + lane)[64 * j] = (u32x2){0u, 0u}; }
            }
        }
    }
    GSYNC_CG();

    for (int L = 0; L < DEPTH; ++L) {
#ifndef SKIP_A
        {
            FRESH();
            pg8::Gemm g{HB, (const bf16*)(wl + WL_IN), MROWS, NINP, DM}; pg8::StaticOrder S; S.init(MROWS, NINP, G, bx);
            EpiIn E{2 * L};
            for (int rep = 0; rep < REP_A; ++rep) pg8::gemm_phase<EpiIn, pg8::StaticOrder, true, true>(lds, g, S, E);
        }
#endif
        GSYNC();
#ifndef SKIP_B
        { FRESH();
        for (int rep = 0; rep < REP_B; ++rep) {
        for (int pr = bx; pr < 16 * NCH; pr += G) gla_u_pair(lds, QKV, SM, a.w_au + (size_t)L * 16 * 256, a.b_alpha + L * 256, UT, DEC, pr);
        for (int u = bx - 64 + ((bx < 64) ? G : 0); u < 64; u += G) fox_cumsum_unit(lds, SM, a.b_forget + L * 8, CK, u);
        }
        }
#endif
        GSYNC();
#ifndef SKIP_CS
        { FRESH();
        for (int e = gt; e < 32 * 2048; e += NGT) {
            const int bh = e >> 11, rem = (e & 2047) * 4, dk = rem & 63;
            float* up = UT + (size_t)bh * NCH * 8192 + rem; const float* dp = DEC + (size_t)bh * NCH * 64 + dk;
            f32x4 Sv = *(const f32x4*)up;
            for (int c0 = 1; c0 <= 64; c0 += 8) {
                f32x4 uu[8], dd[8];
#pragma unroll
                for (int i = 0; i < 8; ++i) { uu[i] = *(const f32x4*)(up + (size_t)(c0 + i) * 8192); dd[i] = *(const f32x4*)(dp + (c0 + i) * 64); }
#pragma unroll
                for (int i = 0; i < 8; ++i) { Sv = dd[i] * Sv + uu[i]; *(f32x4*)(up + (size_t)(c0 + i) * 8192) = Sv; }
            }
        }
#ifdef REP_SCAN
        for (int e = gt; e < 32 * 2048; e += NGT) {
            const int bh = e >> 11, rem = (e & 2047) * 4, dk = rem & 63;
            float* up = UT + (size_t)bh * NCH * 8192 + rem; const float* dp = DEC + (size_t)bh * NCH * 64 + dk;
            for (int c0 = 1; c0 <= 64; c0 += 8) {
                f32x4 uu[8], dd[8];
#pragma unroll
                for (int i = 0; i < 8; ++i) { uu[i] = *(const f32x4*)(up + (size_t)(c0 + i) * 8192); dd[i] = *(const f32x4*)(dp + (c0 + i) * 64); }
#pragma unroll
                for (int i = 0; i < 8; ++i) { *(f32x4*)(up + (size_t)(c0 + i) * 8192) = uu[i] + dd[i] * 0.f; }
            }
        }
#endif
        }
        { FRESH();
        for (int rep = 0; rep < REP_CA; ++rep)
        for (int v0 = bx; v0 < 256; v0 += G) {
            const int v = (G == 256) ? (v0 & 7) * 32 + (v0 >> 3) : v0;
            const int bhh = v >> 2, s = v & 3;
#pragma unroll 1
            for (int i = 0; i < 4; ++i) {
                const int qb = (i == 0) ? s : (i == 1) ? 7 - s : (i == 2) ? 8 + s : 15 - s;
                attn_unit(lds, QKV, CK, OB, a.fox_norm + L * 512, bhh >> 3, bhh & 7, qb);
            }
        }
#endif
#ifndef SKIP_CM
        }
        { FRESH();
#ifndef REP_CM
#define REP_CM 1
#endif
        for (int rep = 0; rep < REP_CM; ++rep)
        if (bx < NMETA) meta_attn(QKV, CK, OB, a.fox_norm + L * 512, bx);
        if (bx >= NMETA && bx < NMETA + 4 && wid == 0) gla_readout_wave(QKV, UT, OB, a.gla_norm + L * 512, bx - NMETA, 0, 0, lane);
        }
#endif
        GSYNC();
#ifndef SKIP_D
        { FRESH();
        for (int rep = 0; rep < REP_D; ++rep)
        for (int wu = gw; wu < 32 * 64 * 2; wu += NGW) gla_readout_wave(QKV, UT, OB, a.gla_norm + L * 512, wu >> 7, 1 + ((wu >> 1) & 63), wu & 1, lane);
        }
#endif
        GSYNC();
#ifndef SKIP_E
        {
            FRESH();
            meta_rowgemm(OB + (size_t)META0 * DM, DM, (const bf16*)(wl + WL_OUT), DM, HM, HB, G, bx);
            pg8::Gemm g{OB, (const bf16*)(wl + WL_OUT), MREAL, DM, DM}; pg8::StaticOrder S; S.init(MREAL, DM, G, bx);
            EpiRes E{L == 0 ? 1 : 0, 2 * L + 1};
            pg8::gemm_phase<EpiRes, pg8::StaticOrder, true, true>(lds, g, S, E);
        }
#endif
        GSYNC();
#ifndef SKIP_F
        {
            FRESH();
            pg8::Gemm g{HB, (const bf16*)(wl + WL_UP), MROWS, NUP, DM}; pg8::StaticOrder S; S.init(MROWS, NUP, G, bx);
            EpiUp E{L};
            for (int rep = 0; rep < REP_F; ++rep) pg8::gemm_phase<EpiUp, pg8::StaticOrder, true, true>(lds, g, S, E);
        }
#endif
        GSYNC();
#ifndef SKIP_H
        {
            FRESH();
            const float* cw = a.conv_w + (size_t)L * 3 * NUP; const float* cb = a.conv_b + (size_t)L * NUP;
            { pg8::StaticOrder S0; S0.init(MREAL, DM, G, bx); pg8::Unit uu; uu.pm = 128; uu.pn = 0;
              for (int ui = -1; ui < 0 || S0.next(ui, uu); ++ui) {
                const int pm = uu.pm;
                for (int i = tid; i < 2 * (DFF / 4); i += 512) {
                    const int c4 = i % (DFF / 4), rr = i / (DFF / 4);
                    const int ch = 4 * c4;
                    f32x4 hc[2];
#pragma unroll
                    for (int bj = 0; bj < 2; ++bj) {
                        const int c = bj * DFF + ch;
                        f32x4 P0 = {0.f, 0.f, 0.f, 0.f}, P1 = P0;
                        if (pm != 128) { const int src = (pm % 16 == 0) ? 128 : pm - 1; P0 = *(const f32x4*)(HL + (size_t)(src * 2) * NUP + c); P1 = *(const f32x4*)(HL + (size_t)(src * 2 + 1) * NUP + c); }
                        const f32x4 H0 = *(const f32x4*)(HF + (size_t)(pm * 2) * NUP + c), H1 = *(const f32x4*)(HF + (size_t)(pm * 2 + 1) * NUP + c);
                        const f32x4 x2 = rr == 0 ? P0 : P1, x1 = rr == 0 ? P1 : H0, x0 = rr == 0 ? H0 : H1;
                        hc[bj] = *(const f32x4*)(cb + c) + *(const f32x4*)(cw + c) * x2 + *(const f32x4*)(cw + NUP + c) * x1 + *(const f32x4*)(cw + 2 * NUP + c) * x0;
                    }
                    u32x2 w;
                    w.x = pk2(siluf(hc[1][0]) * hc[0][0], siluf(hc[1][1]) * hc[0][1]);
                    w.y = pk2(siluf(hc[1][2]) * hc[0][2], siluf(hc[1][3]) * hc[0][3]);
                    *(u32x2*)(A2 + (size_t)(pm * 256 + rr) * DFF + ch) = w;
                }
              }
            }
            asm volatile("s_waitcnt vmcnt(0)" ::: "memory"); __syncthreads();
            meta_rowgemm(A2 + (size_t)META0 * DFF, DFF, (const bf16*)(wl + WL_DN), DFF, HM, HB, G, bx);
            pg8::Gemm g{A2, (const bf16*)(wl + WL_DN), MREAL, DM, DFF}; pg8::StaticOrder S; S.init(MREAL, DM, G, bx);
            EpiRes E{0, 2 * L + 2};
            pg8::gemm_phase<EpiRes, pg8::StaticOrder, true, true>(lds, g, S, E);
        }
#endif
        GSYNC();
    }
    {
        const int L = 0; FRESH();
        const float* ssq = ssq_arr(ws, 8);
        for (int r = gw; r < MREAL; r += NGW) {
            const float rs = row_rstd(ssq, r);
            f32x4* p = (f32x4*)(a.out + (size_t)r * DM) + lane; const f32x4* wn = (const f32x4*)a.final_norm + lane;
#pragma unroll
            for (int j = 0; j < 4; ++j) p[64 * j] = p[64 * j] * rs * wn[64 * j];
        }
    }
}

extern "C" void kernel_launch(void* const* d_in, const int* in_sizes, int n_in, void* d_out, int out_size, void* d_ws, size_t ws_size, hipStream_t stream) {
    static int grid = 0;
    if (grid == 0) {
        if (n_in != 16 || out_size != MREAL * DM || ws_size < WS_END) { fprintf(stderr, "kernel_launch: unexpected problem (n_in %d out %d ws %zu, need %zu)\n", n_in, out_size, ws_size, (size_t)WS_END); grid = -1; return; }
        int dev = 0, cus = 0, per = 0;
        (void)hipGetDevice(&dev); (void)hipDeviceGetAttribute(&cus, hipDeviceAttributeMultiprocessorCount, dev);
        (void)hipFuncSetAttribute((const void*)fwd_kernel, hipFuncAttributeMaxDynamicSharedMemorySize, LDS_BYTES);
        (void)hipOccupancyMaxActiveBlocksPerMultiprocessor(&per, (const void*)fwd_kernel, 512, LDS_BYTES);
        if (per < 1) per = 1;
        grid = cus * per;
        fprintf(stderr, "kernel_launch: grid %d (cus %d x %d), ws %zu\n", grid, cus, per, ws_size);
    }
    if (grid < 0) return;
    Args a{};
    const float** f = (const float**)&a;
    for (int i = 0; i < 16; ++i) f[i] = (const float*)d_in[i];
    a.out = (float*)d_out; a.ws = (unsigned char*)d_ws;
    (void)hipMemsetAsync((unsigned char*)d_ws + WS_BAR, 0, BAR_BYTES, stream);
    void* args[] = {&a};
    hipError_t e = hipLaunchCooperativeKernel((const void*)fwd_kernel, dim3(grid), dim3(512), args, LDS_BYTES, stream);
    if (e != hipSuccess) fprintf(stderr, "cooperative launch failed: %s (grid %d)\n", hipGetErrorString(e), grid);
}
```

```cpp
#include <hip/hip_runtime.h>
#include <hip/hip_cooperative_groups.h>
#include <cstdio>
#include <cstdint>
namespace cg = cooperative_groups;
namespace pg8 {
#define PG8_LAS __attribute__((address_space(3)))
typedef unsigned short bf16_t;
typedef short bf16x8 __attribute__((ext_vector_type(8)));
typedef float f32x4 __attribute__((ext_vector_type(4)));
typedef unsigned u32x4 __attribute__((ext_vector_type(4)));
constexpr int BM = 256, BK = 64, HALF = 128, HTB = HALF * BK * 2  , STAGE_BYTES = 8 * HTB, NXCD = 8, WGM = 8;

__host__ __device__ __forceinline__ int lds_byte(int r, int c) { const int st = (r >> 4) * 2 + (c >> 5), rr = r & 15, cc = c & 31, ob = rr * 64 + cc * 2; return st * 1024 + (ob ^ (((ob >> 9) & 1) << 5)); }
__host__ __device__ __forceinline__ void stage_rc(int b, int& R, int& C) { const int st = b / 1024, sb = b % 1024, swz = sb ^ (((sb >> 9) & 1) << 5); R = (st >> 1) * 16 + swz / 64; C = (st & 1) * 32 + (swz % 64) / 2; }
__host__ __device__ __forceinline__ int perm32(int rho) { const int n = rho >> 4, i = rho & 15; return 8 * (i >> 2) + 4 * n + (i & 3); }

struct Unit { int pm, pn; };
struct Gemm { const bf16_t* A; const bf16_t* Bt; int M, N, K; };

struct StaticOrder {
    int nM, nN, nwg, G, c;
    __host__ __device__ void init(int M, int N, int G_, int c_) { nM = M / BM; nN = N / BM; nwg = nM * nN; G = G_; c = c_; }
    __host__ __device__ bool next(int i, Unit& u) const {
        const long L = (long)i * G + c; if (L >= nwg) return false;
        int wgid = (int)L; { const int q = nwg / NXCD, r = nwg % NXCD, xcd = wgid % NXCD, off = wgid / NXCD; wgid = (xcd < r ? xcd * (q + 1) : r * (q + 1) + (xcd - r) * q) + off; }
        const int nig = WGM * nN, gid = wgid / nig, fm = gid * WGM, gsz = (nM - fm) < WGM ? (nM - fm) : WGM;
        u.pm = fm + ((wgid % nig) % gsz); u.pn = (wgid % nig) / gsz; return true;
    }
    __device__ __forceinline__ void a_ready(const Unit&) const {}
    __device__ __forceinline__ void done(const Unit&) const {}
};

__device__ __forceinline__ unsigned cvt_pk_bf16(float lo, float hi) { unsigned r; asm volatile("v_cvt_pk_bf16_f32 %0, %1, %2" : "=v"(r) : "v"(lo), "v"(hi)); return r; }
typedef float f32x2 __attribute__((ext_vector_type(2)));
template <class Epi, class Sched, bool ALIGN_EPI = false, bool SP2 = false>
__device__ __forceinline__ void gemm_phase(PG8_LAS unsigned char* lds, const Gemm g, const Sched& S, const Epi& E) {
    int tid_ = threadIdx.x; asm volatile("" : "+v"(tid_)); const int tid = tid_, wid = __builtin_amdgcn_readfirstlane(tid >> 6), lane = tid & 63, wr = wid >> 2, wc = wid & 3, fr = lane & 15, fq = lane >> 4;
    const int K = g.K, nt = K / BK;
    unsigned voffA[2], voffB[2];
#pragma unroll
    for (int i = 0; i < 2; ++i) { int R, C; stage_rc(tid * 16 + i * 8192, R, C); const int Rb = Epi::PERM ? ((R & ~31) + perm32(R & 31)) : R;
        voffA[i] = (unsigned)(R * K + C) * 2u; voffB[i] = (unsigned)(Rb * K + C) * 2u; }
    const size_t kstep = (size_t)(BK * 2);
    const size_t hstep = (size_t)HALF * K * 2;
    const size_t tstep = 2 * hstep;
    const unsigned ldsw = (unsigned)wid * 1024u;
    const int aoff = lds_byte(wr * 64 + fr, fq * 8), boff = lds_byte(wc * 32 + fr, fq * 8);
#define PG8_SA(b, h) (((b) * 2 + (h)) * HTB)
#define PG8_SB(b, h) ((4 + (b) * 2 + (h)) * HTB)
#define PG8_STAGE(bufoff, gbase, voff) do { _Pragma("unroll") for (int _i = 0; _i < 2; ++_i) \
        __builtin_amdgcn_global_load_lds((const unsigned*)((const char*)(gbase) + (voff)[_i]), (PG8_LAS unsigned*)(lds + (bufoff) + ldsw + _i * 8192), 16, 0, 0); } while (0)
#define PG8_LDA(dst, b, h) do { _Pragma("unroll") for (int m = 0; m < 4; ++m) _Pragma("unroll") for (int k = 0; k < 2; ++k) dst[m][k] = *(const PG8_LAS bf16x8*)(lds + PG8_SA(b, h) + aoff + m * 2048 + k * 1024); } while (0)
#define PG8_LDB(dst, b, h) do { _Pragma("unroll") for (int n = 0; n < 2; ++n) _Pragma("unroll") for (int k = 0; k < 2; ++k) dst[n][k] = *(const PG8_LAS bf16x8*)(lds + PG8_SB(b, h) + boff + n * 2048 + k * 1024); } while (0)
#define PG8_MMA(ai, bj, At, Bt) do { __builtin_amdgcn_s_setprio(1); _Pragma("unroll") for (int m = 0; m < 4; ++m) _Pragma("unroll") for (int n = 0; n < 2; ++n) _Pragma("unroll") for (int k = 0; k < 2; ++k) \
        acc[ai][bj][m][n] = __builtin_amdgcn_mfma_f32_16x16x32_bf16(Bt[n][k], At[m][k], acc[ai][bj][m][n], 0, 0, 0); __builtin_amdgcn_s_setprio(0); } while (0)
#define PG8_WAIT_V(n) asm volatile("s_waitcnt vmcnt(" #n ")" ::: "memory")
#define PG8_WAIT_L(n) asm volatile("s_waitcnt lgkmcnt(" #n ")" ::: "memory")
#define PG8_BAR __builtin_amdgcn_s_barrier()
#define PG8_SCHED __builtin_amdgcn_sched_barrier(0)
    Unit cur, nxt; int ui = 0;
    if (!S.next(0, cur)) return;
    f32x4 acc[2][2][4][2];
#pragma unroll
    for (int a = 0; a < 2; ++a)
#pragma unroll
        for (int b = 0; b < 2; ++b)
#pragma unroll
            for (int m = 0; m < 4; ++m)
#pragma unroll
                for (int n = 0; n < 2; ++n) acc[a][b][m][n] = (f32x4){0.f, 0.f, 0.f, 0.f};
    bf16x8 At[4][2], B0[2][2], B1[2][2];
    const char* cA = (const char*)g.A + (size_t)cur.pm * tstep; const char* cB = (const char*)g.Bt + (size_t)cur.pn * tstep;
    S.a_ready(cur);
    if constexpr (SP2) {
        PG8_STAGE(PG8_SB(0, 0), cB, voffB); PG8_STAGE(PG8_SB(0, 1), cB + hstep, voffB); PG8_STAGE(PG8_SA(0, 0), cA, voffA); PG8_STAGE(PG8_SA(0, 1), cA + hstep, voffA);
        if (wr == 1) PG8_BAR;
        PG8_WAIT_V(2); PG8_BAR;
        PG8_STAGE(PG8_SB(1, 0), cB + kstep, voffB); PG8_STAGE(PG8_SA(1, 0), cA + kstep, voffA); PG8_STAGE(PG8_SB(1, 1), cB + hstep + kstep, voffB);
        PG8_WAIT_V(6); PG8_BAR;
    } else {
        PG8_STAGE(PG8_SB(0, 0), cB, voffB); PG8_STAGE(PG8_SA(0, 0), cA, voffA); PG8_STAGE(PG8_SB(0, 1), cB + hstep, voffB); PG8_STAGE(PG8_SA(0, 1), cA + hstep, voffA);
        if (wr == 1) PG8_BAR;
        PG8_WAIT_V(4); PG8_BAR;
        PG8_STAGE(PG8_SB(1, 0), cB + kstep, voffB); PG8_STAGE(PG8_SA(1, 0), cA + kstep, voffA); PG8_STAGE(PG8_SB(1, 1), cB + hstep + kstep, voffB);
        PG8_WAIT_V(6); PG8_BAR;
    }
    for (;;) {
        const bool has_next = S.next(ui + 1, nxt);
        const char* nA = has_next ? (const char*)g.A + (size_t)nxt.pm * tstep : cA; const char* nB = has_next ? (const char*)g.Bt + (size_t)nxt.pn * tstep : cB;
        for (int t = 0; t < nt; t += 2) {
            const bool last = (t == nt - 2);
            const char* a1 = cA + (size_t)(t + 1) * kstep;
            const char* a2 = last ? nA : cA + (size_t)(t + 2) * kstep; const char* b2 = last ? nB : cB + (size_t)(t + 2) * kstep;
            const char* a3 = a2 + kstep; const char* b3 = b2 + kstep;
            if (last && has_next) S.a_ready(nxt);
            if constexpr (SP2) {
            PG8_LDB(B0, 0, 0); PG8_LDB(B1, 0, 1); PG8_SCHED; PG8_LDA(At, 0, 0); PG8_STAGE(PG8_SA(1, 1), a1 + hstep, voffA);
            PG8_WAIT_V(8); PG8_WAIT_L(0); PG8_BAR; PG8_MMA(0, 0, At, B0); PG8_MMA(0, 1, At, B1); PG8_BAR; PG8_SCHED;
            PG8_LDA(At, 0, 1); PG8_STAGE(PG8_SB(0, 0), b2, voffB); PG8_STAGE(PG8_SB(0, 1), b2 + hstep, voffB); PG8_STAGE(PG8_SA(0, 0), a2, voffA);
            PG8_WAIT_V(8); PG8_WAIT_L(0); PG8_BAR; PG8_MMA(1, 0, At, B0); PG8_MMA(1, 1, At, B1); PG8_BAR; PG8_SCHED;
            PG8_LDB(B0, 1, 0); PG8_LDB(B1, 1, 1); PG8_SCHED; PG8_LDA(At, 1, 0); PG8_STAGE(PG8_SA(0, 1), a2 + hstep, voffA);
            PG8_WAIT_V(8); PG8_WAIT_L(0); PG8_BAR; PG8_MMA(0, 0, At, B0); PG8_MMA(0, 1, At, B1); PG8_BAR; PG8_SCHED;
            PG8_LDA(At, 1, 1); PG8_STAGE(PG8_SB(1, 0), b3, voffB); PG8_STAGE(PG8_SB(1, 1), b3 + hstep, voffB); PG8_STAGE(PG8_SA(1, 0), a3, voffA);
            PG8_WAIT_V(8); PG8_WAIT_L(0); PG8_BAR; PG8_MMA(1, 0, At, B0); PG8_MMA(1, 1, At, B1); PG8_BAR; PG8_SCHED;
            } else {
            PG8_LDB(B0, 0, 0); PG8_SCHED; PG8_LDA(At, 0, 0); PG8_STAGE(PG8_SA(1, 1), a1 + hstep, voffA);
            PG8_WAIT_L(8); PG8_BAR; PG8_WAIT_L(0); PG8_MMA(0, 0, At, B0); PG8_BAR; PG8_SCHED;
            PG8_LDB(B1, 0, 1); PG8_STAGE(PG8_SB(0, 0), b2, voffB);
            PG8_BAR; PG8_WAIT_L(0); PG8_MMA(0, 1, At, B1); PG8_BAR;
            PG8_LDA(At, 0, 1); PG8_STAGE(PG8_SA(0, 0), a2, voffA);
            PG8_BAR; PG8_WAIT_L(0); PG8_MMA(1, 0, At, B0); PG8_BAR; PG8_SCHED;
            PG8_STAGE(PG8_SB(0, 1), b2 + hstep, voffB);
            PG8_WAIT_V(6); PG8_BAR; PG8_MMA(1, 1, At, B1); PG8_BAR;
            PG8_LDB(B0, 1, 0); PG8_SCHED; PG8_LDA(At, 1, 0); PG8_STAGE(PG8_SA(0, 1), a2 + hstep, voffA);
            PG8_WAIT_L(8); PG8_BAR; PG8_WAIT_L(0); PG8_MMA(0, 0, At, B0); PG8_BAR; PG8_SCHED;
            PG8_LDB(B1, 1, 1); PG8_STAGE(PG8_SB(1, 0), b3, voffB);
            PG8_BAR; PG8_WAIT_L(0); PG8_MMA(0, 1, At, B1); PG8_BAR;
            PG8_LDA(At, 1, 1); PG8_STAGE(PG8_SA(1, 0), a3, voffA);
            PG8_BAR; PG8_WAIT_L(0); PG8_MMA(1, 0, At, B0); PG8_BAR; PG8_SCHED;
            PG8_STAGE(PG8_SB(1, 1), b3 + hstep, voffB);
            PG8_WAIT_V(6); PG8_BAR; PG8_MMA(1, 1, At, B1); PG8_BAR;
            }
        }
        if constexpr (ALIGN_EPI) { if (wr == 0) PG8_BAR; }
        if constexpr (!Epi::AFTER_DRAIN) { E(acc, cur, wr, wc, fr, fq); S.done(cur); }
        if (!has_next) break;
#pragma unroll
        for (int a = 0; a < 2; ++a)
#pragma unroll
            for (int b = 0; b < 2; ++b)
#pragma unroll
                for (int m = 0; m < 4; ++m)
#pragma unroll
                    for (int n = 0; n < 2; ++n) acc[a][b][m][n] = (f32x4){0.f, 0.f, 0.f, 0.f};
        cur = nxt; cA = nA; cB = nB; ++ui;
        if constexpr (ALIGN_EPI) { if (wr == 1) PG8_BAR; }
    }
    PG8_WAIT_V(0);
    if constexpr (!ALIGN_EPI) { if (wr == 0) PG8_BAR; }
    PG8_BAR;
    if constexpr (Epi::AFTER_DRAIN) { E.fused(acc, cur, wr, wc, fr, fq, lds, wid, lane); S.done(cur); }
#undef PG8_SA
#undef PG8_SB
#undef PG8_STAGE
#undef PG8_LDA
#undef PG8_LDB
#undef PG8_MMA
#undef PG8_WAIT_V
#undef PG8_WAIT_L
#undef PG8_BAR
#undef PG8_SCHED
}
}
#define LAS __attribute__((address_space(3)))
typedef unsigned short bf16;
typedef short bf16x8 __attribute__((ext_vector_type(8)));
typedef short s16x4 __attribute__((ext_vector_type(4)));
typedef float f32x4 __attribute__((ext_vector_type(4)));
typedef float f32x16 __attribute__((ext_vector_type(16)));
typedef unsigned u32x4 __attribute__((ext_vector_type(4)));
typedef unsigned u32x2 __attribute__((ext_vector_type(2)));

constexpr int NB = 8, SEQ = 4096, DM = 1024, DEPTH = 4, NMETA = 16;
constexpr int MREAL = NB * SEQ;
constexpr int META0 = MREAL;
constexpr int MROWS = 129 * 256;
constexpr int NINP = 3328, QP = 3072;
constexpr int C_FQ = 0, C_FK = 512, C_FV = 1024, C_GQ = 1536, C_GK = 1792, C_GV = 2048, C_GR = 2560;
constexpr int DFF = 2816, NUP = 5632;
constexpr float EPS = 1e-6f, LOG2E = 1.4426950408889634f, C2 = 0.125f * LOG2E;
constexpr int CKP = 4160;
constexpr int NCH = 65;

constexpr size_t MiB = 1u << 20;
constexpr size_t WL_IN = 0, WL_OUT = 6815744, WL_UP = 8912896, WL_DN = 20447232, WL_SIZE = 26214400;
constexpr size_t WS_W = 0, WS_HB = 100 * MiB, WS_OB = WS_HB + 67633152, WS_QKV = WS_OB + 67633152, WS_UT = WS_QKV + 202899456;
constexpr size_t WS_SM = WS_UT + 68157440, WS_CK = WS_SM + 4456448, WS_DEC = WS_CK + 1310720, WS_HM = WS_DEC + 786432, WS_SSQ = WS_HM + MiB, WS_BAR = WS_SSQ + 1835008, BAR_BYTES = 16384, WS_END = WS_BAR + BAR_BYTES;
static_assert(WS_END <= 512 * MiB, "workspace map");
constexpr size_t HFL_SIZE = (size_t)129 * 2 * NUP * 4;
static_assert(2 * HFL_SIZE <= 68157440, "halo overlay");

constexpr int LDS_BYTES = 147456, HALO_OFF = 131072;

struct Args {
    const float *x, *meta, *attn_norm, *w_in, *w_au, *b_alpha, *b_forget, *gla_norm, *fox_norm, *w_out, *ffn_norm, *w_up, *conv_w, *conv_b, *w_down, *final_norm;
    float* out; unsigned char* ws;
};

#define GAS __attribute__((address_space(1)))
#define CAS __attribute__((address_space(4)))
typedef const CAS Args* KArgs;
__device__ __forceinline__ KArgs kargs() { KArgs p = (KArgs)__builtin_amdgcn_kernarg_segment_ptr(); asm volatile("" : "+s"(p)); return p; }
template <class T> __device__ __forceinline__ T* gptr(T* p) { return (T*)(GAS T*)p; }
__device__ __forceinline__ float bf2f(bf16 v) { return __uint_as_float((unsigned)v << 16); }
__device__ __forceinline__ unsigned pk2(float lo, float hi) { return pg8::cvt_pk_bf16(lo, hi); }
__device__ __forceinline__ bf16 f2bf(float v) { return (bf16)(pk2(v, 0.f) & 0xffffu); }
__device__ __forceinline__ float wave_sum(float v) {
#pragma unroll
    for (int o = 1; o < 64; o <<= 1) v += __shfl_xor(v, o);
    return v;
}
__device__ __forceinline__ float logsigmoidf(float z) { return -(fmaxf(-z, 0.f) + log1pf(__expf(-fabsf(z)))); }
__device__ __forceinline__ float siluf(float v) { return v * __builtin_amdgcn_rcpf(1.f + __builtin_amdgcn_exp2f(-LOG2E * v)); }
__device__ __forceinline__ int crow(int r, int hi) { return (r & 3) + 8 * (r >> 2) + 4 * hi; }
__device__ __forceinline__ s16x4 vtr(const LAS unsigned char* p) { return __builtin_bit_cast(s16x4, __builtin_amdgcn_ds_read_tr16_b64_v4i16((LAS s16x4*)p)); }
__device__ __forceinline__ bf16x8 cat8(s16x4 a, s16x4 b) { return (bf16x8){a[0], a[1], a[2], a[3], b[0], b[1], b[2], b[3]}; }
__device__ __forceinline__ float dppf(float old, float src, int ctrl_unused);
#define DPP_MOV(old, src, ctrl) __builtin_bit_cast(float, __builtin_amdgcn_update_dpp(__builtin_bit_cast(int, (float)(old)), __builtin_bit_cast(int, (float)(src)), (ctrl), 0xf, 0xf, false))
#define LDS_WAIT() asm volatile("s_waitcnt lgkmcnt(0)" ::: "memory")

__device__ __forceinline__ const float* ssq_arr(unsigned char* wsb, int si) { return (const float*)(wsb + WS_SSQ) + (size_t)(si % 3) * MROWS * 4; }
__device__ __forceinline__ float row_rstd(const float* ssqp, int row) { const f32x4 s = *(const f32x4*)(ssqp + (size_t)row * 4); return rsqrtf(((s[0] + s[1]) + (s[2] + s[3])) * (1.0f / DM) + EPS); }
__device__ __forceinline__ LAS float* tile_rstd(unsigned char* wsb, int si, int pm, int wr, int wc, int fr, int fq) {
    extern __shared__ __attribute__((aligned(16))) unsigned char lds_dyn_[];
    LAS float* rsl = (LAS float*)((LAS unsigned char*)lds_dyn_ + HALO_OFF + 8192);
    const int tl = (wr * 4 + wc) * 64 + fq * 16 + fr;
    if (pm != 128) {
        if (tl < 256) rsl[tl] = row_rstd(ssq_arr(wsb, si), pm * 256 + tl);
    } else {
        const int row = tl >> 5, part = tl & 31;
        const f32x4* hp = (const f32x4*)((const float*)(wsb + WS_HM) + (size_t)row * DM) + part;
        float s = 0.f;
#pragma unroll
        for (int j = 0; j < 8; ++j) { const f32x4 v = hp[32 * j]; s += (v[0] * v[0] + v[1] * v[1]) + (v[2] * v[2] + v[3] * v[3]); }
        s += __shfl_xor(s, 1); s += __shfl_xor(s, 2); s += __shfl_xor(s, 4); s += __shfl_xor(s, 8); s += __shfl_xor(s, 16);
        if (part == 0) rsl[row] = rsqrtf(s * (1.0f / DM) + EPS);
        if (tl < 240) rsl[16 + tl] = 0.f;
    }
    asm volatile("s_waitcnt lgkmcnt(0)" ::: "memory"); __builtin_amdgcn_s_barrier(); asm volatile("" ::: "memory");
    return rsl;
}
__device__ __forceinline__ void meta_rowgemm(const bf16* A, int lda, const bf16* Bt, int K, float* HM, bf16* HB, int G, int bx) {
    int tid_ = threadIdx.x; asm volatile("" : "+v"(tid_)); const int r = tid_ >> 5, kp = tid_ & 31;
    for (int cg = bx; cg < 256; cg += G) {
        float acc[4] = {0.f, 0.f, 0.f, 0.f};
        for (int k0 = kp * 8; k0 < K; k0 += 256) {
            const u32x4 av = *(const u32x4*)(A + (size_t)r * lda + k0);
#pragma unroll
            for (int j = 0; j < 4; ++j) {
                const u32x4 bv = *(const u32x4*)(Bt + (size_t)(4 * cg + j) * K + k0);
#pragma unroll
                for (int q = 0; q < 4; ++q) {
                    acc[j] += __uint_as_float(av[q] << 16) * __uint_as_float(bv[q] << 16);
                    acc[j] += __uint_as_float(av[q] & 0xffff0000u) * __uint_as_float(bv[q] & 0xffff0000u);
                }
            }
        }
#pragma unroll
        for (int j = 0; j < 4; ++j) { float s = acc[j]; s += __shfl_xor(s, 1); s += __shfl_xor(s, 2); s += __shfl_xor(s, 4); s += __shfl_xor(s, 8); s += __shfl_xor(s, 16); acc[j] = s; }
        if (kp == 0) {
            float* hp = HM + (size_t)r * DM + 4 * cg;
            const f32x4 h = *(const f32x4*)hp + (f32x4){acc[0], acc[1], acc[2], acc[3]};
            *(f32x4*)hp = h;
            u32x2 w; w.x = pk2(h[0], h[1]); w.y = pk2(h[2], h[3]);
            *(u32x2*)(HB + (size_t)(META0 + r) * DM + 4 * cg) = w;
        }
    }
}
__device__ __forceinline__ void meta_up(LAS unsigned char* lds, const bf16* HB, const bf16* Wup, const float* HM, const float* cw, const float* cb, bf16* A2, float* HL, int G, int bx) {
    int tid_ = threadIdx.x; asm volatile("" : "+v"(tid_)); const int tid = tid_, r = tid >> 5, kp = tid & 31;
    LAS float* hb = (LAS float*)lds;
    float rs;
    { const f32x4* hp = (const f32x4*)(HM + (size_t)r * DM) + kp; float s = 0.f;
#pragma unroll
      for (int j = 0; j < 8; ++j) { const f32x4 v = hp[32 * j]; s += (v[0] * v[0] + v[1] * v[1]) + (v[2] * v[2] + v[3] * v[3]); }
      s += __shfl_xor(s, 1); s += __shfl_xor(s, 2); s += __shfl_xor(s, 4); s += __shfl_xor(s, 8); s += __shfl_xor(s, 16);
      rs = rsqrtf(s * (1.0f / DM) + EPS); }
    u32x4 av[4];
#pragma unroll
    for (int i = 0; i < 4; ++i) av[i] = *(const u32x4*)(HB + (size_t)(META0 + r) * DM + kp * 8 + 256 * i);
    for (int cg = bx; cg < 256; cg += G) {
#pragma unroll 1
        for (int cb0 = 0; cb0 < 24; cb0 += 6) {
            u32x4 bv[6][4];
#pragma unroll
            for (int c6 = 0; c6 < 6; ++c6) {
                const int c = cb0 + c6 < 22 ? cb0 + c6 : 21, isg = c >= 11 ? 1 : 0, jj = c - 11 * isg;
                const int ch = 11 * cg + jj, wrow = (ch >> 7) * 256 + isg * 128 + (ch & 127);
#pragma unroll
                for (int i = 0; i < 4; ++i) bv[c6][i] = *(const u32x4*)(Wup + (size_t)wrow * DM + kp * 8 + 256 * i);
            }
#pragma unroll
            for (int c6 = 0; c6 < 6; ++c6) {
                float acc = 0.f;
#pragma unroll
                for (int i = 0; i < 4; ++i)
#pragma unroll
                    for (int q = 0; q < 4; ++q) {
                        acc += __uint_as_float(av[i][q] << 16) * __uint_as_float(bv[c6][i][q] << 16);
                        acc += __uint_as_float(av[i][q] & 0xffff0000u) * __uint_as_float(bv[c6][i][q] & 0xffff0000u);
                    }
                acc += __shfl_xor(acc, 1); acc += __shfl_xor(acc, 2); acc += __shfl_xor(acc, 4); acc += __shfl_xor(acc, 8); acc += __shfl_xor(acc, 16);
                if (kp == 0 && cb0 + c6 < 22) hb[r * 24 + cb0 + c6] = acc * rs;
            }
        }
        __syncthreads();
        if (tid < 16 * 11) {
            const int rr = tid / 11, jj = tid % 11, ch = 11 * cg + jj;
            float hc[2];
#pragma unroll
            for (int ug = 0; ug < 2; ++ug) {
                const int c = ug * DFF + ch;
                const float x0 = hb[rr * 24 + ug * 11 + jj], x1 = rr >= 1 ? hb[(rr - 1) * 24 + ug * 11 + jj] : 0.f, x2 = rr >= 2 ? hb[(rr - 2) * 24 + ug * 11 + jj] : 0.f;
                hc[ug] = cb[c] + cw[c] * x2 + cw[NUP + c] * x1 + cw[2 * NUP + c] * x0;
                if (rr >= 14) HL[(size_t)(256 + rr - 14) * NUP + c] = x0;
            }
            A2[(size_t)(META0 + rr) * DFF + ch] = f2bf(siluf(hc[1]) * hc[0]);
        }
        __syncthreads();
    }
}
__device__ __forceinline__ bool so_next_pm(int nM, int nN, int G, int c, int i, int& pm) {
    const int nwg = nM * nN; const long Lq = (long)i * G + c; if (Lq >= nwg) return false;
    int wgid = (int)Lq; { const int q = nwg / pg8::NXCD, r = nwg % pg8::NXCD, xcd = wgid % pg8::NXCD, off = wgid / pg8::NXCD; wgid = (xcd < r ? xcd * (q + 1) : r * (q + 1) + (xcd - r) * q) + off; }
    const int nig = pg8::WGM * nN, gid = wgid / nig, fm = gid * pg8::WGM, gsz = (nM - fm) < pg8::WGM ? (nM - fm) : pg8::WGM;
    pm = fm + ((wgid % nig) % gsz); return true;
}
struct EpiIn {
    static constexpr bool PERM = true, AFTER_DRAIN = false;
    int si;
    __device__ __forceinline__ void operator()(const pg8::f32x4 (&acc)[2][2][4][2], const pg8::Unit& u, int wr, int wc, int fr, int fq) const {
        asm volatile("" : "+v"(fr), "+v"(fq));
        unsigned char* wsb = gptr(kargs()->ws);
        bf16* Q = (bf16*)(wsb + WS_QKV); float* SM = (float*)(wsb + WS_SM); const LAS float* rsl = tile_rstd(wsb, si, u.pm, wr, wc, fr, fq);
#pragma unroll
        for (int ai = 0; ai < 2; ++ai)
#pragma unroll
            for (int m = 0; m < 4; ++m) {
                const int row = u.pm * 256 + ai * 128 + wr * 64 + m * 16 + fr;
                const float rs = rsl[ai * 128 + wr * 64 + m * 16 + fr];
                if (u.pn < 12) {
#pragma unroll
                    for (int bj = 0; bj < 2; ++bj) {
                        const pg8::f32x4 v0 = acc[ai][bj][m][0] * rs, v1 = acc[ai][bj][m][1] * rs;
                        u32x4 w; w.x = pk2(v0[0], v0[1]); w.y = pk2(v0[2], v0[3]); w.z = pk2(v1[0], v1[1]); w.w = pk2(v1[2], v1[3]);
                        *(u32x4*)(Q + (size_t)row * QP + u.pn * 256 + bj * 128 + wc * 32 + 8 * fq) = w;
                    }
                } else if (wc == 0) {
                    *(f32x4*)(SM + (size_t)row * 32 + 8 * fq) = acc[ai][0][m][0] * rs;
                    *(f32x4*)(SM + (size_t)row * 32 + 8 * fq + 4) = acc[ai][0][m][1] * rs;
                }
            }
    }
};
template <bool from_x, bool last> struct EpiRes {
    static constexpr bool PERM = false, AFTER_DRAIN = false;
    int si;
    __device__ __forceinline__ void operator()(const pg8::f32x4 (&acc)[2][2][4][2], const pg8::Unit& u, int wr, int wc, int fr, int fq) const {
        asm volatile("" : "+v"(fr), "+v"(fq));
        KArgs ka = kargs(); unsigned char* wsb = gptr(ka->ws);
        float* out = last ? gptr(ka->out) : nullptr; const float* xin = from_x ? gptr(ka->x) : nullptr; bf16* HB = (bf16*)(wsb + WS_HB); float* ssq_next = (float*)ssq_arr(wsb, si);
        extern __shared__ __attribute__((aligned(16))) unsigned char lds_dyn_[];
        LAS float* red = (LAS float*)((LAS unsigned char*)lds_dyn_ + HALO_OFF);
#pragma unroll
        for (int ai = 0; ai < 2; ++ai)
#pragma unroll
            for (int m = 0; m < 4; ++m) {
                const int row = u.pm * 256 + ai * 128 + wr * 64 + m * 16 + fr;
                float ss = 0.f;
#pragma unroll
                for (int bj = 0; bj < 2; ++bj)
#pragma unroll
                    for (int n = 0; n < 2; ++n) {
                        const int col = u.pn * 256 + bj * 128 + wc * 32 + 16 * n + 4 * fq;
                        f32x4 bs;
                        if constexpr (from_x) bs = *(const f32x4*)(xin + (size_t)row * DM + col);
                        else { const u32x2 t = *(const u32x2*)(HB + (size_t)row * DM + col);
                               bs = (f32x4){__uint_as_float(t.x << 16), __uint_as_float(t.x & 0xffff0000u), __uint_as_float(t.y << 16), __uint_as_float(t.y & 0xffff0000u)}; }
                        const f32x4 h = bs + acc[ai][bj][m][n];
                        ss += (h[0] * h[0] + h[1] * h[1]) + (h[2] * h[2] + h[3] * h[3]);
                        u32x2 w; w.x = pk2(h[0], h[1]); w.y = pk2(h[2], h[3]);
                        *(u32x2*)(HB + (size_t)row * DM + col) = w;
                        if constexpr (last) *(f32x4*)(out + (size_t)row * DM + col) = h;
                    }
                ss += __shfl_xor(ss, 16); ss += __shfl_xor(ss, 32);
                if (fq == 0) red[wc * 256 + ai * 128 + wr * 64 + m * 16 + fr] = ss;
            }
        asm volatile("s_waitcnt lgkmcnt(0)" ::: "memory"); __builtin_amdgcn_s_barrier(); asm volatile("" ::: "memory");
        {
            const int tl = (wr * 4 + wc) * 64 + fq * 16 + fr;
            if (tl < 256) ssq_next[(size_t)(u.pm * 256 + tl) * 4 + u.pn] = (red[tl] + red[256 + tl]) + (red[512 + tl] + red[768 + tl]);
        }
    }
};
struct EpiUp {
    static constexpr bool PERM = true, AFTER_DRAIN = false;
    int L;
    __device__ __forceinline__ void operator()(pg8::f32x4 (&acc)[2][2][4][2], const pg8::Unit& u, int wr, int wc, int fr, int fq) const {
        asm volatile("" : "+v"(fr), "+v"(fq));
        KArgs ka = kargs(); unsigned char* wsb = gptr(ka->ws);
        const LAS float* rsl = tile_rstd(wsb, 2 * L + 1, u.pm, wr, wc, fr, fq); const float* cw = gptr(ka->conv_w) + (size_t)L * 3 * NUP; const float* cb = gptr(ka->conv_b) + (size_t)L * NUP;
        extern __shared__ __attribute__((aligned(16))) unsigned char lds_dyn_[];
        LAS float* halo = (LAS float*)((LAS unsigned char*)lds_dyn_ + HALO_OFF);
        const int colw = wc * 32 + 8 * fq;
#pragma unroll
        for (int ai = 0; ai < 2; ++ai)
#pragma unroll
            for (int m = 0; m < 4; ++m) {
                const int row = u.pm * 256 + ai * 128 + wr * 64 + m * 16 + fr;
                const float rs = rsl[ai * 128 + wr * 64 + m * 16 + fr]; (void)row;
#pragma unroll
                for (int bj = 0; bj < 2; ++bj)
#pragma unroll
                    for (int n = 0; n < 2; ++n) acc[ai][bj][m][n] *= rs;
            }
#ifdef SIMPLE_UP
        {
            const int ch0s = u.pn * 128 + colw;
#pragma unroll
            for (int n = 0; n < 2; ++n)
#pragma unroll
                for (int ai = 0; ai < 2; ++ai)
#pragma unroll
                    for (int m = 0; m < 4; ++m) {
                        const int row = u.pm * 256 + ai * 128 + wr * 64 + m * 16 + fr;
                        const f32x4 hu = acc[ai][0][m][n], hg = acc[ai][1][m][n];
                        u32x2 w; w.x = pk2(hu[0] + hg[0], hu[1] + hg[1]); w.y = pk2(hu[2] + hg[2], hu[3] + hg[3]);
                        *(u32x2*)(wsb + (unsigned)(WS_QKV + (unsigned)((row * DFF + ch0s + 4 * n) * 2))) = w;
                    }
            return;
        }
#endif
        if (fr >= 14) {
#pragma unroll
            for (int ai = 0; ai < 2; ++ai)
#pragma unroll
                for (int bj = 0; bj < 2; ++bj)
#pragma unroll
                    for (int n = 0; n < 2; ++n)
                        *(LAS f32x4*)(halo + (((2 * ai + wr) * 2 + (fr - 14)) * 256 + bj * 128 + colw + 4 * n)) = acc[ai][bj][3][n];
        }
        asm volatile("s_waitcnt lgkmcnt(0)" ::: "memory"); __builtin_amdgcn_s_barrier(); asm volatile("" ::: "memory");
        const int ch0 = u.pn * 128 + colw;
        u32x2 wout[2][4][2];
#pragma unroll
        for (int n = 0; n < 2; ++n) {
            f32x4 w0[2], w1[2], w2[2], bb[2];
#pragma unroll
            for (int bj = 0; bj < 2; ++bj) {
                const int c = bj * DFF + ch0 + 4 * n;
                w0[bj] = *(const f32x4*)((const char*)cw + (unsigned)(c * 4)); w1[bj] = *(const f32x4*)((const char*)cw + (unsigned)((NUP + c) * 4)); w2[bj] = *(const f32x4*)((const char*)cw + (unsigned)((2 * NUP + c) * 4)); bb[bj] = *(const f32x4*)((const char*)cb + (unsigned)(c * 4));
            }
#pragma unroll
            for (int ai = 0; ai < 2; ++ai)
#pragma unroll
                for (int m = 0; m < 4; ++m) {
                    const int g = 2 * ai + wr;
                    f32x4 hc[2];
#pragma unroll
                    for (int bj = 0; bj < 2; ++bj) {
                        const int c = bj * DFF + ch0 + 4 * n;
                        const f32x4 cur = acc[ai][bj][m][n];
                        f32x4 pb;
                        if (m > 0) pb = acc[ai][bj][m - 1][n];
                        else pb = *(const LAS f32x4*)(halo + ((((g > 0 ? g - 1 : 0) * 2) + (fr & 1)) * 256 + bj * 128 + colw + 4 * n));
                        f32x4 p1, p2;
#pragma unroll
                        for (int j = 0; j < 4; ++j) {
                            const float t1 = DPP_MOV(0.f, pb[j], 0x121);
                            p1[j] = DPP_MOV(t1, cur[j], 0x111);
                            const float t2 = DPP_MOV(0.f, pb[j], 0x122);
                            p2[j] = DPP_MOV(t2, cur[j], 0x112);
                        }
                        hc[bj] = bb[bj] + w0[bj] * p2 + w1[bj] * p1 + w2[bj] * cur;
                        if (g == 0 && m == 0 && fr < 2) *(f32x4*)(wsb + (unsigned)(WS_UT + (unsigned)(((u.pm * 2 + fr) * NUP + c) * 4))) = cur;
                        if (u.pm == 128 ? (g == 0 && m == 0 && fr >= 14) : (g == 3 && m == 3 && fr >= 14))
                            *(f32x4*)(wsb + (unsigned)(WS_UT + HFL_SIZE + (unsigned)(((u.pm * 2 + fr - 14) * NUP + c) * 4))) = cur;
                    }
                    wout[ai][m][n].x = pk2(siluf(hc[1][0]) * hc[0][0], siluf(hc[1][1]) * hc[0][1]);
                    wout[ai][m][n].y = pk2(siluf(hc[1][2]) * hc[0][2], siluf(hc[1][3]) * hc[0][3]);
                }
        }
#pragma unroll
        for (int ai = 0; ai < 2; ++ai)
#pragma unroll
            for (int m = 0; m < 4; ++m) {
                const int row = u.pm * 256 + ai * 128 + wr * 64 + m * 16 + fr;
                u32x4 w; w.x = wout[ai][m][0].x; w.y = wout[ai][m][0].y; w.z = wout[ai][m][1].x; w.w = wout[ai][m][1].y;
                *(u32x4*)(wsb + (unsigned)(WS_QKV + (unsigned)((row * DFF + ch0) * 2))) = w;
            }
    }
};
#define XB_TMO      128
#define XB_XCNT(j)  (256  + 64 * (j))
#define XB_XSUB(j)  (1280 + 64 * (j))
#define XB_XGEN(j)  (2304 + 64 * (j))
#define XB_TOP      3328
#define XB_TOPGEN   3392
#define XCD_BAR_WORDS 3456
#define XB_SPIN_CAP (1u << 18)

__device__ __forceinline__ unsigned xb_ld(unsigned* p)              { return __hip_atomic_load(p, __ATOMIC_RELAXED, __HIP_MEMORY_SCOPE_AGENT); }
__device__ __forceinline__ unsigned xb_add(unsigned* p, unsigned v) { return __hip_atomic_fetch_add(p, v, __ATOMIC_RELAXED, __HIP_MEMORY_SCOPE_AGENT); }
__device__ __forceinline__ unsigned xb_xcc_id() { return (unsigned)__builtin_amdgcn_s_getreg((3 << 11) | 20) & 0xFu; }
#define XB_SPIN(cond, bar) do { unsigned _sp = 0; while (cond) { __builtin_amdgcn_s_sleep(1); \
    if ((++_sp & 255u) == 0u) { if (xb_ld(&(bar)[XB_TMO])) break; if (_sp > XB_SPIN_CAP) { atomicAdd(&(bar)[XB_TMO], 1u); break; } } } } while (0)

struct XcdBarrier {
    unsigned* bar; unsigned x;
    volatile LAS unsigned* st;
};

__device__ __forceinline__ XcdBarrier xcd_barrier_post(unsigned* bar, volatile LAS unsigned* st) {
    XcdBarrier b; b.bar = bar; b.x = xb_xcc_id(); b.st = st;
    if (threadIdx.x == 0) (void)xb_add(&bar[XB_XCNT(b.x)], 1u);
    return b;
}
__device__ __forceinline__ void xcd_barrier_complete(unsigned* bar, unsigned x, unsigned& nloc, unsigned& nx) {
    const unsigned G = gridDim.x * gridDim.y * gridDim.z;
    unsigned sum, cnt, mine, sp = 0u;
    for (;;) {
        sum = 0u; cnt = 0u; mine = 0u;
#pragma unroll
        for (unsigned j = 0; j < 16; ++j) { const unsigned c = xb_ld(&bar[XB_XCNT(j)]); sum += c; cnt += (c > 0u) ? 1u : 0u; mine = (j == x) ? c : mine; }
        if (sum == G) break;
        __builtin_amdgcn_s_sleep(1);
        if ((++sp & 255u) == 0u) { if (xb_ld(&bar[XB_TMO])) break; if (sp > XB_SPIN_CAP) { atomicAdd(&bar[XB_TMO], 1u); break; } }
    }
    nloc = mine > 0u ? mine : 1u; nx = cnt > 0u ? cnt : 1u;
}

__device__ __forceinline__ void xcd_barrier(const XcdBarrier& b) {
    asm volatile("s_waitcnt vmcnt(0)" ::: "memory");
    __syncthreads();
    if (threadIdx.x == 0) {
        unsigned* bar = b.bar;
        __builtin_amdgcn_s_waitcnt(0);
        unsigned nloc = b.st[0], nx = b.st[1];
        if (nloc == 0u) { xcd_barrier_complete(bar, b.x, nloc, nx); b.st[0] = nloc; b.st[1] = nx; }
        const unsigned old = xb_add(&bar[XB_XSUB(b.x)], 1u);
        const unsigned gen = old / nloc;
        if (old + 1u == (gen + 1u) * nloc) {
            __builtin_amdgcn_fence(__ATOMIC_RELEASE, "agent");
            asm volatile("s_waitcnt vmcnt(0)" ::: "memory");
            const unsigned og = xb_add(&bar[XB_TOP], 1u);
            const unsigned tg = og / nx;
            if (og + 1u == (tg + 1u) * nx) xb_add(&bar[XB_TOPGEN], 1u);
            else XB_SPIN(xb_ld(&bar[XB_TOPGEN]) == tg, bar);
            __builtin_amdgcn_fence(__ATOMIC_ACQUIRE, "agent");
            xb_add(&bar[XB_XGEN(b.x)], 1u);
            asm volatile("s_waitcnt vmcnt(0)" ::: "memory");
        } else {
            XB_SPIN(xb_ld(&bar[XB_XGEN(b.x)]) == gen, bar);
            __builtin_amdgcn_fence(__ATOMIC_ACQUIRE, "agent");
            asm volatile("s_waitcnt vmcnt(0)" ::: "memory");
        }
    }
    __syncthreads();
}
__device__ __forceinline__ int win_src(int n) {
    if (n < 512) return 1552 + n;
    if (n < 1024) return 2064 + (n - 512);
    if (n < 1536) return 2576 + (n - 1024);
    if (n < 1792) return n - 1536;
    if (n < 2048) return 256 + (n - 1792);
    if (n < 2560) return 512 + (n - 2048);
    if (n < 3072) return 1024 + (n - 2560);
    if (n < 3088) return 1536 + (n - 3072);
    if (n < 3096) return n;
    return -1;
}
__device__ __forceinline__ void tr_item(const float* W, int Nsrc, bf16* WT, int K, const float* gk, int mode, LAS float* scr, int k0, int n0, int lane) {
    const int n = n0 + lane;
    int src = n; float cs = 1.f;
    if (mode == 0) { src = win_src(n); cs = n < 512 ? C2 : ((n >= 1536 && n < 1792) ? 0.125f : 1.f); }
    else if (mode == 2) { const int pn = n >> 8, j = n & 255; src = j < 128 ? pn * 128 + j : DFF + pn * 128 + (j - 128); }
#pragma unroll 32
    for (int kk = 0; kk < 64; ++kk) {
        float v = 0.f;
        if (src >= 0) v = W[(size_t)(k0 + kk) * Nsrc + src] * cs;
        if (gk) v *= gk[k0 + kk];
        scr[kk * 65 + lane] = v;
    }
    LDS_WAIT(); asm volatile("" ::: "memory");
    const int c = lane & 7;
#pragma unroll
    for (int j = 0; j < 8; ++j) {
        const int nn = (lane >> 3) + 8 * j; const LAS float* s = scr + (8 * c) * 65 + nn;
        u32x4 o; o.x = pk2(s[0 * 65], s[1 * 65]); o.y = pk2(s[2 * 65], s[3 * 65]); o.z = pk2(s[4 * 65], s[5 * 65]); o.w = pk2(s[6 * 65], s[7 * 65]);
        *(u32x4*)(WT + (size_t)(n0 + nn) * K + k0 + 8 * c) = o;
    }
    LDS_WAIT(); asm volatile("" ::: "memory");
}
__device__ __forceinline__ void row_to_bf16(const float* xrow, bf16* orow, float* ssq_slot, float* copy_row, int lane) {
    const f32x4* xr = (const f32x4*)xrow + lane;
    f32x4 v[4]; float s = 0.f;
#pragma unroll
    for (int j = 0; j < 4; ++j) { v[j] = xr[64 * j]; s += (v[j][0] * v[j][0] + v[j][1] * v[j][1]) + (v[j][2] * v[j][2] + v[j][3] * v[j][3]); }
    s = wave_sum(s);
    if (lane == 0) *(f32x4*)ssq_slot = (f32x4){s, 0.f, 0.f, 0.f};
    u32x2* o8 = (u32x2*)orow + lane;
#pragma unroll
    for (int j = 0; j < 4; ++j) { u32x2 w; w.x = pk2(v[j][0], v[j][1]); w.y = pk2(v[j][2], v[j][3]); o8[64 * j] = w; }
    if (copy_row) {
#pragma unroll
        for (int j = 0; j < 4; ++j) ((f32x4*)copy_row + lane)[64 * j] = v[j];
    }
}

template <int NQ> __device__ __forceinline__ void gla_u_group(LAS unsigned char* lds, const bf16* QKV, const float* SM, const float* wau, const float* balpha, float* UT, float* DEC, int grp) {
    int tid_ = threadIdx.x; asm volatile("" : "+v"(tid_)); const int tid = tid_, lane = tid & 63, wid = __builtin_amdgcn_readfirstlane(tid >> 6), hi = lane >> 5, r32 = lane & 31;
    constexpr int SUB = 9216 + 17408 + 2048;
    const int dk = lane, sg = wid;
    int bhq[NQ], ccq[NQ], hq[NQ], row0q[NQ], tvq[NQ];
    float la[NQ][8], kf[NQ][8];
#pragma unroll
    for (int q = 0; q < NQ; ++q) {
        const int u = NQ * grp + q; bhq[q] = u / NCH; ccq[q] = u % NCH; hq[q] = bhq[q] & 3;
        row0q[q] = ccq[q] == 0 ? META0 : (bhq[q] >> 2) * SEQ + (ccq[q] - 1) * 64; tvq[q] = ccq[q] == 0 ? NMETA : 64;
        LAS unsigned char* VT = lds + q * SUB + 9216;
        LAS float* TOT = (LAS float*)(lds + q * SUB + 9216 + 17408);
#pragma unroll
        for (int i = 0; i < 2; ++i) {
            const int idx = tid + 512 * i, row = idx >> 4, ch = idx & 15;
            const u32x4 v = *(const u32x4*)(QKV + (size_t)(row0q[q] + row) * QP + C_GV + hq[q] * 128 + ch * 8);
            *(LAS u32x4*)(VT + row * 272 + ch * 16) = v;
        }
#pragma unroll
        for (int i = 0; i < 8; ++i) kf[q][i] = bf2f(QKV[(size_t)(row0q[q] + 8 * sg + i) * QP + C_GK + hq[q] * 64 + dk]);
        float w[16];
#pragma unroll
        for (int r = 0; r < 16; ++r) w[r] = wau[r * 256 + hq[q] * 64 + dk];
        const float bias = balpha[hq[q] * 64 + dk];
#pragma unroll
        for (int i = 0; i < 8; ++i) {
            const int s = 8 * sg + i;
            const f32x4* g4 = (const f32x4*)(SM + (size_t)(row0q[q] + s) * 32);
            float z = bias;
#pragma unroll
            for (int k = 0; k < 4; ++k) { const f32x4 gv = g4[k]; z += gv[0] * w[4 * k] + gv[1] * w[4 * k + 1] + gv[2] * w[4 * k + 2] + gv[3] * w[4 * k + 3]; }
            la[q][i] = (s < tvq[q]) ? logsigmoidf(z) * (1.0f / 16.0f) : 0.f;
        }
#pragma unroll
        for (int i = 1; i < 8; ++i) la[q][i] += la[q][i - 1];
        TOT[sg * 64 + dk] = la[q][7];
    }
    __syncthreads();
#pragma unroll
    for (int q = 0; q < NQ; ++q) {
        LAS unsigned char* KD = lds + q * SUB;
        const LAS float* TOT = (const LAS float*)(lds + q * SUB + 9216 + 17408);
        float pre = 0.f, tot = 0.f;
#pragma unroll
        for (int g2 = 0; g2 < 8; ++g2) { const float t = TOT[g2 * 64 + dk]; if (g2 < sg) pre += t; tot += t; }
        if (sg == 0) DEC[(size_t)(bhq[q] * NCH + ccq[q]) * 64 + dk] = __expf(tot);
#pragma unroll
        for (int i = 0; i < 8; ++i) {
            const int s = 8 * sg + i;
            const float kd = (s < tvq[q]) ? kf[q][i] * __expf(tot - (pre + la[q][i])) : 0.f;
            *(LAS bf16*)(KD + s * 144 + dk * 2) = f2bf(kd);
        }
    }
    __syncthreads();
    const int dvb = wid >> 1, dkb = wid & 1;
    const int qq = (lane & 15) >> 2, pp = lane & 3, half = (lane >> 4) & 1;
#pragma unroll
    for (int q = 0; q < NQ; ++q) {
        const LAS unsigned char* KD = lds + q * SUB; const LAS unsigned char* VT = lds + q * SUB + 9216;
        f32x16 acc = {};
#pragma unroll
        for (int j = 0; j < 4; ++j) {
            const LAS unsigned char* ap = VT + (16 * j + 4 * hi + qq) * 272 + (32 * dvb + 16 * half + 4 * pp) * 2;
            const LAS unsigned char* bp = KD + (16 * j + 4 * hi + qq) * 144 + (32 * dkb + 16 * half + 4 * pp) * 2;
            const bf16x8 af = cat8(vtr(ap), vtr(ap + 8 * 272));
            const bf16x8 bfr = cat8(vtr(bp), vtr(bp + 8 * 144));
            acc = __builtin_amdgcn_mfma_f32_32x32x16_bf16(af, bfr, acc, 0, 0, 0);
        }
        float* up = UT + ((size_t)(bhq[q] * NCH + ccq[q]) * 128 + 32 * dvb) * 64 + 32 * dkb + r32;
#pragma unroll
        for (int r = 0; r < 16; ++r) up[crow(r, hi) * 64] = acc[r];
    }
    __syncthreads();
}
__device__ __forceinline__ void fox_cumsum_unit(LAS unsigned char* lds, const float* SM, const float* bforget, float* CK, int bh) {
    int tid_ = threadIdx.x; asm volatile("" : "+v"(tid_)); const int tid = tid_, lane = tid & 63, wid = tid >> 6;
    const int b = bh >> 3, h = bh & 7;
    const float bf_ = bforget[h];
    LAS float* WT_ = (LAS float*)lds;
    float mtot = 0.f, mine = 0.f;
    for (int p = 0; p < NMETA; ++p) { mtot += logsigmoidf(SM[(size_t)(META0 + p) * 32 + 16 + h] + bf_); if (tid == p) mine = mtot; }
    if (tid < 64) CK[(size_t)bh * CKP + tid] = tid < NMETA ? -LOG2E * mine : -INFINITY;
    float v[8]; float run = 0.f;
#pragma unroll
    for (int i = 0; i < 8; ++i) { run += logsigmoidf(SM[(size_t)(b * SEQ + 8 * tid + i) * 32 + 16 + h] + bf_); v[i] = run; }
    float inc = run;
#pragma unroll
    for (int o = 1; o < 64; o <<= 1) { const float t = __shfl_up(inc, o); if (lane >= o) inc += t; }
    if (lane == 63) WT_[wid] = inc;
    __syncthreads();
    float off = mtot + (inc - run);
    for (int w2 = 0; w2 < wid; ++w2) off += WT_[w2];
#pragma unroll
    for (int i = 0; i < 8; ++i) CK[(size_t)bh * CKP + 64 + 8 * tid + i] = -LOG2E * (off + v[i]);
    __syncthreads();
}

__device__ __forceinline__ void attn_unit(LAS unsigned char* lds, const bf16* QKV, const float* CK, bf16* OB, const float* fnorm, int b, int h, int qb) {
    int tid_ = threadIdx.x; asm volatile("" : "+v"(tid_)); const int tid = tid_, lane = tid & 63, wid = __builtin_amdgcn_readfirstlane(tid >> 6), r32 = lane & 31, hi = lane >> 5;
    constexpr int KB = 9216, KOFF = 0, VOFF = 2 * KB, COFF = 4 * KB, WOFF = COFF + 512;
    LAS float* wsf = (LAS float*)(lds + WOFF) + wid * 64;
    const size_t rowb = (size_t)b * SEQ; const int q0 = qb * 256;
    const int NT = 1 + 4 * (qb + 1);
    const bf16* qp = QKV + (rowb + q0 + wid * 32 + r32) * QP + C_FQ + h * 64 + hi * 8;
    bf16x8 qr[4];
#pragma unroll
    for (int d0 = 0; d0 < 4; ++d0) qr[d0] = *(const bf16x8*)(qp + d0 * 16);
    const int srow = tid >> 3, sch = tid & 7;
    const float* ckp = CK + (size_t)(b * 8 + h) * CKP;
    u32x4 kreg, vreg; float creg = 0.f;
#define ATT_LOAD(t) do { const size_t r0_ = (t) == 0 ? (size_t)META0 : rowb + (size_t)((t) - 1) * 64; const bf16* p_ = QKV + (r0_ + srow) * QP + h * 64 + sch * 8; \
        kreg = *(const u32x4*)(p_ + C_FK); vreg = *(const u32x4*)(p_ + C_FV); if (tid < 64) creg = ckp[(t) * 64 + tid]; } while (0)
#define ATT_STORE(buf) do { *(LAS u32x4*)(lds + KOFF + (buf) * KB + srow * 144 + sch * 16) = kreg; *(LAS u32x4*)(lds + VOFF + (buf) * KB + srow * 144 + sch * 16) = vreg; \
        if (tid < 64) *(LAS float*)(lds + COFF + (buf) * 256 + tid * 4) = creg; } while (0)
    float m = -1e30f, l = 0.f; f32x16 o0 = {}, o1 = {};
    const int qrel = 32 * wid + r32;
    const int qq = (lane & 15) >> 2, pp = lane & 3, half = (lane >> 4) & 1;
    ATT_LOAD(0); ATT_STORE(0);
    for (int t = 0; t < NT; ++t) {
        const int buf = t & 1;
        if (t + 1 < NT) ATT_LOAD(t + 1);
        __syncthreads();
        const int jb = t - (NT - 4);
        const bool skip = (jb >= 0) && (64 * jb > 32 * wid + 31);
        if (!skip) {
            const LAS unsigned char* Kb = lds + KOFF + buf * KB; const LAS unsigned char* Vb = lds + VOFF + buf * KB; const LAS float* Cb = (const LAS float*)(lds + COFF + buf * 256);
            f32x16 p0, p1;
#pragma unroll
            for (int g = 0; g < 4; ++g) {
                const f32x4 c0 = *(const LAS f32x4*)(Cb + 8 * g + 4 * hi), c1 = *(const LAS f32x4*)(Cb + 32 + 8 * g + 4 * hi);
#pragma unroll
                for (int i = 0; i < 4; ++i) { p0[4 * g + i] = c0[i]; p1[4 * g + i] = c1[i]; }
            }
#pragma unroll
            for (int d0 = 0; d0 < 4; ++d0) {
                const bf16x8 a0 = *(const LAS bf16x8*)(Kb + r32 * 144 + (16 * d0 + 8 * hi) * 2);
                const bf16x8 a1 = *(const LAS bf16x8*)(Kb + (32 + r32) * 144 + (16 * d0 + 8 * hi) * 2);
                p0 = __builtin_amdgcn_mfma_f32_32x32x16_bf16(a0, qr[d0], p0, 0, 0, 0);
                p1 = __builtin_amdgcn_mfma_f32_32x32x16_bf16(a1, qr[d0], p1, 0, 0, 0);
            }
            if (jb >= 0 && 64 * jb + 63 > 32 * wid) {
#pragma unroll
                for (int r = 0; r < 16; ++r) { const int kv = 64 * jb + crow(r, hi); if (kv > qrel) p0[r] = -INFINITY; if (kv + 32 > qrel) p1[r] = -INFINITY; }
            }
            float mx = fmaxf(fmaxf(p0[0], p1[0]), fmaxf(p0[1], p1[1]));
#pragma unroll
            for (int r = 2; r < 16; r += 2) mx = fmaxf(fmaxf(mx, fmaxf(p0[r], p1[r])), fmaxf(p0[r + 1], p1[r + 1]));
            mx = fmaxf(mx, __shfl_xor(mx, 32));
            if (__any(mx > m + 8.0f)) {
                const float mn = fmaxf(m, mx);
                const float alpha = __builtin_amdgcn_exp2f(m - mn);
                m = mn; l *= alpha;
                if (hi == 0) wsf[r32] = alpha;
                LDS_WAIT();
#pragma unroll
                for (int g = 0; g < 4; ++g) {
                    const f32x4 a = *(const LAS f32x4*)(wsf + 8 * g + 4 * hi);
#pragma unroll
                    for (int i = 0; i < 4; ++i) { o0[4 * g + i] *= a[i]; o1[4 * g + i] *= a[i]; }
                }
            }
            float rsum = 0.f;
#pragma unroll
            for (int r = 0; r < 16; ++r) { p0[r] = __builtin_amdgcn_exp2f(p0[r] - m); p1[r] = __builtin_amdgcn_exp2f(p1[r] - m); rsum += p0[r] + p1[r]; }
            l += rsum;
            bf16x8 pa[4];
            { u32x4 w;
              w.x = pk2(p0[0], p0[1]); w.y = pk2(p0[2], p0[3]); w.z = pk2(p0[4], p0[5]); w.w = pk2(p0[6], p0[7]); pa[0] = __builtin_bit_cast(bf16x8, w);
              w.x = pk2(p0[8], p0[9]); w.y = pk2(p0[10], p0[11]); w.z = pk2(p0[12], p0[13]); w.w = pk2(p0[14], p0[15]); pa[1] = __builtin_bit_cast(bf16x8, w);
              w.x = pk2(p1[0], p1[1]); w.y = pk2(p1[2], p1[3]); w.z = pk2(p1[4], p1[5]); w.w = pk2(p1[6], p1[7]); pa[2] = __builtin_bit_cast(bf16x8, w);
              w.x = pk2(p1[8], p1[9]); w.y = pk2(p1[10], p1[11]); w.z = pk2(p1[12], p1[13]); w.w = pk2(p1[14], p1[15]); pa[3] = __builtin_bit_cast(bf16x8, w); }
#pragma unroll
            for (int j = 0; j < 4; ++j) {
                const LAS unsigned char* vp = Vb + (16 * j + 4 * hi + qq) * 144 + (16 * half + 4 * pp) * 2;
                const bf16x8 v0 = cat8(vtr(vp), vtr(vp + 8 * 144));
                const bf16x8 v1 = cat8(vtr(vp + 64), vtr(vp + 64 + 8 * 144));
                o0 = __builtin_amdgcn_mfma_f32_32x32x16_bf16(pa[j], v0, o0, 0, 0, 0);
                o1 = __builtin_amdgcn_mfma_f32_32x32x16_bf16(pa[j], v1, o1, 0, 0, 0);
            }
        }
        if (t + 1 < NT) ATT_STORE(buf ^ 1);
    }
#undef ATT_LOAD
#undef ATT_STORE
    l += __shfl_xor(l, 32);
    if (hi == 0) wsf[r32] = 1.0f / l;
    LDS_WAIT();
#pragma unroll
    for (int g = 0; g < 4; ++g) {
        const f32x4 a = *(const LAS f32x4*)(wsf + 8 * g + 4 * hi);
#pragma unroll
        for (int i = 0; i < 4; ++i) { o0[4 * g + i] *= a[i]; o1[4 * g + i] *= a[i]; }
    }
    const float w0 = fnorm[h * 64 + r32], w1 = fnorm[h * 64 + 32 + r32];
#pragma unroll
    for (int r = 0; r < 16; ++r) {
        float s = o0[r] * o0[r] + o1[r] * o1[r];
        s += __shfl_xor(s, 1); s += __shfl_xor(s, 2); s += __shfl_xor(s, 4); s += __shfl_xor(s, 8); s += __shfl_xor(s, 16);
        const float rs = rsqrtf(s * (1.0f / 64.0f) + EPS);
        bf16* op = OB + (rowb + q0 + wid * 32 + crow(r, hi)) * DM + 512 + h * 64 + r32;
        op[0] = f2bf(o0[r] * rs * w0); op[32] = f2bf(o1[r] * rs * w1);
    }
    __syncthreads();
}
__device__ __forceinline__ void meta_attn(const bf16* QKV, const float* CK, bf16* OB, const float* fnorm, int p) {
    int tid_ = threadIdx.x; asm volatile("" : "+v"(tid_)); const int lane = tid_ & 63, h = tid_ >> 6;
    const float q = bf2f(QKV[(size_t)(META0 + p) * QP + C_FQ + h * 64 + lane]);
    float sc[NMETA], vv[NMETA];
#pragma unroll
    for (int s = 0; s < NMETA; ++s) {
        sc[s] = q * bf2f(QKV[(size_t)(META0 + s) * QP + C_FK + h * 64 + lane]);
        vv[s] = bf2f(QKV[(size_t)(META0 + s) * QP + C_FV + h * 64 + lane]);
    }
    float m = -1e30f;
#pragma unroll
    for (int s = 0; s < NMETA; ++s) { sc[s] = (s <= p) ? wave_sum(sc[s]) + CK[(size_t)h * CKP + s] : -INFINITY; m = fmaxf(m, sc[s]); }
    float l = 0.f, o = 0.f;
#pragma unroll
    for (int s = 0; s < NMETA; ++s) { const float pw = __builtin_amdgcn_exp2f(sc[s] - m); l += pw; o += pw * vv[s]; }
    o /= l;
    const float ss = wave_sum(o * o);
    OB[(size_t)(META0 + p) * DM + 512 + h * 64 + lane] = f2bf(o * rsqrtf(ss * (1.0f / 64.0f) + EPS) * fnorm[h * 64 + lane]);
}
template <int NU> __device__ __forceinline__ void gla_readout_wave(const bf16* QKV, const float* UT, bf16* OB, const float* gnorm, const int* bhs, const int* ccs, const int* halfs, int lane) {
    asm volatile("" : "+v"(lane));
    const int r32 = lane & 31, hi = lane >> 5;
    int row0[NU], nvalid[NU], hq[NU]; const float* Sp[NU];
    f32x16 acc[NU][4];
#pragma unroll
    for (int u = 0; u < NU; ++u) {
        const int b = bhs[u] >> 2; hq[u] = bhs[u] & 3;
        row0[u] = ccs[u] == 0 ? META0 : b * SEQ + (ccs[u] - 1) * 64 + 32 * halfs[u]; nvalid[u] = ccs[u] == 0 ? NMETA : 32;
        Sp[u] = UT + (size_t)(bhs[u] * NCH + ccs[u]) * 8192;
#pragma unroll
        for (int blk = 0; blk < 4; ++blk) acc[u][blk] = (f32x16){};
    }
#pragma unroll
    for (int j = 0; j < 4; ++j)
#pragma unroll
        for (int u = 0; u < NU; ++u) {
            const bf16x8 bq = *(const bf16x8*)(QKV + (size_t)(row0[u] + r32) * QP + C_GQ + hq[u] * 64 + 16 * j + 8 * hi);
#pragma unroll
            for (int blk = 0; blk < 4; ++blk) {
                const float* sp = Sp[u] + (32 * blk + r32) * 64 + 16 * j + 8 * hi;
                const f32x4 s0 = *(const f32x4*)sp, s1 = *(const f32x4*)(sp + 4);
                u32x4 w; w.x = pk2(s0[0], s0[1]); w.y = pk2(s0[2], s0[3]); w.z = pk2(s1[0], s1[1]); w.w = pk2(s1[2], s1[3]);
                acc[u][blk] = __builtin_amdgcn_mfma_f32_32x32x16_bf16(__builtin_bit_cast(bf16x8, w), bq, acc[u][blk], 0, 0, 0);
            }
        }
#pragma unroll
    for (int u = 0; u < NU; ++u) {
        float ss = 0.f;
#pragma unroll
        for (int blk = 0; blk < 4; ++blk)
#pragma unroll
            for (int r = 0; r < 16; ++r) ss += acc[u][blk][r] * acc[u][blk][r];
        ss += __shfl_xor(ss, 32);
        const float rs = rsqrtf(ss * (1.0f / 128.0f) + EPS);
        if (r32 < nvalid[u]) {
            const size_t row = (size_t)row0[u] + r32; const int h = hq[u];
#pragma unroll
            for (int blk = 0; blk < 4; ++blk)
#pragma unroll
                for (int g = 0; g < 4; ++g) {
                    const int dv = 32 * blk + 8 * g + 4 * hi;
                    const u32x2 gt = *(const u32x2*)(QKV + row * QP + C_GR + h * 128 + dv);
                    const f32x4 wn = *(const f32x4*)(gnorm + h * 128 + dv);
                    const float g0 = __uint_as_float(gt.x << 16), g1 = __uint_as_float(gt.x & 0xffff0000u), g2 = __uint_as_float(gt.y << 16), g3 = __uint_as_float(gt.y & 0xffff0000u);
                    u32x2 w;
                    w.x = pk2(acc[u][blk][4 * g] * rs * wn[0] * siluf(g0), acc[u][blk][4 * g + 1] * rs * wn[1] * siluf(g1));
                    w.y = pk2(acc[u][blk][4 * g + 2] * rs * wn[2] * siluf(g2), acc[u][blk][4 * g + 3] * rs * wn[3] * siluf(g3));
                    *(u32x2*)(OB + row * DM + h * 128 + dv) = w;
                }
        }
    }
}

__device__ __forceinline__ void gla_readout_chunk(const bf16* QKV, const float* UT, bf16* OB, const float* gnorm, int bh, int cc, int lane) {
    asm volatile("" : "+v"(lane));
    const int r32 = lane & 31, hi = lane >> 5, b = bh >> 2, h = bh & 3;
    const int row0 = b * SEQ + (cc - 1) * 64;
    const float* Sp = UT + (size_t)(bh * NCH + cc) * 8192;
    f32x16 acc[2][4];
#pragma unroll
    for (int u = 0; u < 2; ++u)
#pragma unroll
        for (int blk = 0; blk < 4; ++blk) acc[u][blk] = (f32x16){};
#pragma unroll 1
    for (int j = 0; j < 4; ++j) {
        const bf16x8 bq0 = *(const bf16x8*)(QKV + (size_t)(row0 + r32) * QP + C_GQ + h * 64 + 16 * j + 8 * hi);
        const bf16x8 bq1 = *(const bf16x8*)(QKV + (size_t)(row0 + 32 + r32) * QP + C_GQ + h * 64 + 16 * j + 8 * hi);
#pragma unroll
        for (int blk = 0; blk < 4; ++blk) {
            const float* sp = Sp + (32 * blk + r32) * 64 + 16 * j + 8 * hi;
            const f32x4 s0 = *(const f32x4*)sp, s1 = *(const f32x4*)(sp + 4);
            u32x4 w; w.x = pk2(s0[0], s0[1]); w.y = pk2(s0[2], s0[3]); w.z = pk2(s1[0], s1[1]); w.w = pk2(s1[2], s1[3]);
            const bf16x8 sa = __builtin_bit_cast(bf16x8, w);
            acc[0][blk] = __builtin_amdgcn_mfma_f32_32x32x16_bf16(sa, bq0, acc[0][blk], 0, 0, 0);
            acc[1][blk] = __builtin_amdgcn_mfma_f32_32x32x16_bf16(sa, bq1, acc[1][blk], 0, 0, 0);
        }
    }
#pragma unroll
    for (int u = 0; u < 2; ++u) {
        float ss = 0.f;
#pragma unroll
        for (int blk = 0; blk < 4; ++blk)
#pragma unroll
            for (int r = 0; r < 16; ++r) ss += acc[u][blk][r] * acc[u][blk][r];
        ss += __shfl_xor(ss, 32);
        const float rs = rsqrtf(ss * (1.0f / 128.0f) + EPS);
        const size_t row = (size_t)row0 + 32 * u + r32;
#pragma unroll
        for (int blk = 0; blk < 4; ++blk)
#pragma unroll
            for (int g = 0; g < 4; ++g) {
                const int dv = 32 * blk + 8 * g + 4 * hi;
                const u32x2 gt = *(const u32x2*)(QKV + row * QP + C_GR + h * 128 + dv);
                const f32x4 wn = *(const f32x4*)(gnorm + h * 128 + dv);
                const float g0 = __uint_as_float(gt.x << 16), g1 = __uint_as_float(gt.x & 0xffff0000u), g2 = __uint_as_float(gt.y << 16), g3 = __uint_as_float(gt.y & 0xffff0000u);
                u32x2 w;
                w.x = pk2(acc[u][blk][4 * g] * rs * wn[0] * siluf(g0), acc[u][blk][4 * g + 1] * rs * wn[1] * siluf(g1));
                w.y = pk2(acc[u][blk][4 * g + 2] * rs * wn[2] * siluf(g2), acc[u][blk][4 * g + 3] * rs * wn[3] * siluf(g3));
                *(u32x2*)(OB + row * DM + h * 128 + dv) = w;
            }
    }
}

#define FRESH() KArgs ka_ = kargs(); Args a; a.x = gptr(ka_->x); a.meta = gptr(ka_->meta); a.attn_norm = gptr(ka_->attn_norm); a.w_in = gptr(ka_->w_in); a.w_au = gptr(ka_->w_au); a.b_alpha = gptr(ka_->b_alpha); a.b_forget = gptr(ka_->b_forget); a.gla_norm = gptr(ka_->gla_norm); a.fox_norm = gptr(ka_->fox_norm); a.w_out = gptr(ka_->w_out); a.ffn_norm = gptr(ka_->ffn_norm); a.w_up = gptr(ka_->w_up); a.conv_w = gptr(ka_->conv_w); a.conv_b = gptr(ka_->conv_b); a.w_down = gptr(ka_->w_down); a.final_norm = gptr(ka_->final_norm); a.out = gptr(ka_->out); a.ws = gptr(ka_->ws); unsigned char* ws = a.ws; \
    bf16* HB = (bf16*)(ws + WS_HB); bf16* OB = (bf16*)(ws + WS_OB); bf16* QKV = (bf16*)(ws + WS_QKV); bf16* A2 = (bf16*)(ws + WS_QKV); \
    float* UT = (float*)(ws + WS_UT); float* HF = (float*)(ws + WS_UT); float* HL = (float*)(ws + WS_UT + HFL_SIZE); \
    float* SM = (float*)(ws + WS_SM); float* CK = (float*)(ws + WS_CK); float* DEC = (float*)(ws + WS_DEC); float* HM = (float*)(ws + WS_HM); float* SSQ = (float*)(ws + WS_SSQ); \
    unsigned char* wl = ws + WS_W + (size_t)L * WL_SIZE; \
    (void)HB; (void)OB; (void)QKV; (void)A2; (void)UT; (void)HF; (void)HL; (void)SM; (void)CK; (void)DEC; (void)HM; (void)SSQ; (void)wl; \
    int G_ = gridDim.x, bx_ = blockIdx.x; asm volatile("" : "+s"(G_), "+s"(bx_)); const int G = G_, bx = bx_; (void)G; (void)bx; \
    int tid_ = threadIdx.x; asm volatile("" : "+v"(tid_)); const int tid = tid_, lane = tid & 63, wid = __builtin_amdgcn_readfirstlane(tid >> 6); \
    const int gw = bx * 8 + wid, NGW = G * 8, gt = bx * 512 + tid, NGT = G * 512; (void)lane; (void)gw; (void)NGW; (void)gt; (void)NGT;
#ifndef REP_A
#define REP_A 1
#endif
#ifndef REP_CA
#define REP_CA 1
#endif
#ifndef REP_F
#define REP_F 1
#endif
#ifndef REP_B
#define REP_B 1
#endif
#ifndef REP_D
#define REP_D 1
#endif
#define GSYNC_CG() do { asm volatile("s_waitcnt vmcnt(0) lgkmcnt(0)" ::: "memory"); grid.sync(); __builtin_amdgcn_fence(__ATOMIC_ACQUIRE, "agent"); asm volatile("s_waitcnt vmcnt(0)" ::: "memory"); } while (0)
#ifdef PROBE_PH
#define PH_END(id) do { const unsigned long long tn_ = __builtin_amdgcn_s_memrealtime(); if ((PROBE_PH >> (id)) & 1) tsync += tn_ - tlast; tlast = tn_; } while (0)
#else
#define PH_END(id) do {} while (0)
#endif
#ifdef PROBE_SYNC
#define GSYNC() do { const unsigned long long t0_ = __builtin_amdgcn_s_memrealtime(); xcd_barrier(xbar); tsync += __builtin_amdgcn_s_memrealtime() - t0_; } while (0)
#else
#define GSYNC() do { XcdBarrier xb_; xb_.bar = (unsigned*)(gptr(kargs()->ws) + WS_BAR); xb_.x = xb_xcc_id(); xb_.st = (volatile LAS unsigned*)(lds + HALO_OFF + 8192 + 1024); xcd_barrier(xb_); } while (0)
#endif
__global__ void __launch_bounds__(512, 2) fwd_kernel(Args a_unused) {
    extern __shared__ __attribute__((aligned(16))) unsigned char lds_raw[];
    LAS unsigned char* lds = (LAS unsigned char*)lds_raw;
    cg::grid_group grid = cg::this_grid();
#if defined(PROBE_SYNC) || defined(PROBE_PH)
    unsigned long long tsync = 0ull, tlast = __builtin_amdgcn_s_memrealtime(); (void)tlast;
#endif
    volatile LAS unsigned* xst = (volatile LAS unsigned*)(lds + HALO_OFF + 8192 + 1024);
    if (threadIdx.x < 2) xst[threadIdx.x] = 0u;
    __syncthreads();
    (void)xcd_barrier_post((unsigned*)(gptr(kargs()->ws) + WS_BAR), xst);
#ifndef REP_P
#define REP_P 1
#endif
    for (int rep = 0; rep < REP_P; ++rep) {
        const int L = 0; FRESH();
        LAS float* scr = (LAS float*)(lds + wid * 16640);
        constexpr int I_IN = 16 * (NINP / 64), I_OUT = 16 * 16, I_UP = 16 * (NUP / 64), I_DN = (DFF / 64) * 16, I_L = I_IN + I_OUT + I_UP + I_DN;
        for (int it = gw; it < DEPTH * I_L; it += NGW) {
            const int Lw = it / I_L; int r = it % I_L;
            unsigned char* wlw = ws + WS_W + (size_t)Lw * WL_SIZE;
            if (r < I_IN) { const int nb = NINP / 64; tr_item(a.w_in + (size_t)Lw * DM * 3096, 3096, (bf16*)(wlw + WL_IN), DM, a.attn_norm + Lw * DM, 0, scr, 64 * (r / nb), 64 * (r % nb), lane); continue; } r -= I_IN;
            if (r < I_OUT) { tr_item(a.w_out + (size_t)Lw * DM * DM, DM, (bf16*)(wlw + WL_OUT), DM, nullptr, 1, scr, 64 * (r / 16), 64 * (r % 16), lane); continue; } r -= I_OUT;
            if (r < I_UP) { const int nb = NUP / 64; tr_item(a.w_up + (size_t)Lw * DM * NUP, NUP, (bf16*)(wlw + WL_UP), DM, a.ffn_norm + Lw * DM, 2, scr, 64 * (r / nb), 64 * (r % nb), lane); continue; } r -= I_UP;
            tr_item(a.w_down + (size_t)Lw * DFF * DM, DM, (bf16*)(wlw + WL_DN), DFF, nullptr, 3, scr, 64 * (r / 16), 64 * (r % 16), lane);
        }
        for (int i = gt; i < (256 - NMETA) * 4; i += NGT) SSQ[(size_t)(META0 + NMETA) * 4 + i] = 0.f;
        for (int r = gw; r < MREAL + 256; r += NGW) {
            if (r < MREAL) row_to_bf16(a.x + (size_t)r * DM, HB + (size_t)r * DM, SSQ + (size_t)r * 4, nullptr, lane);
            else if (r < MREAL + NMETA) row_to_bf16(a.meta + (size_t)(r - MREAL) * DM, HB + (size_t)r * DM, SSQ + (size_t)r * 4, HM + (size_t)(r - MREAL) * DM, lane);
            else {
#pragma unroll
                for (int j = 0; j < 4; ++j) { ((f32x4*)(HM + (size_t)(r - MREAL) * DM) + lane)[64 * j] = (f32x4){0.f, 0.f, 0.f, 0.f};
                    ((u32x2*)(HB + (size_t)r * DM) + lane)[64 * j] = (u32x2){0u, 0u}; ((u32x2*)(OB + (size_t)r * DM) + lane)[64 * j] = (u32x2){0u, 0u}; }
            }
        }
    }
    GSYNC_CG(); PH_END(0);

    for (int L = 0; L < DEPTH; ++L) {
#ifndef SKIP_A
        {
            FRESH();
            pg8::Gemm g{HB, (const bf16*)(wl + WL_IN), MROWS, NINP, DM}; pg8::StaticOrder S; S.init(MROWS, NINP, G, bx);
            EpiIn E{2 * L};
            for (int rep = 0; rep < REP_A; ++rep) pg8::gemm_phase<EpiIn, pg8::StaticOrder, true, true>(lds, g, S, E);
        }
#endif
        GSYNC(); PH_END(1);
#ifndef SKIP_B
        { FRESH();
        for (int rep = 0; rep < REP_B; ++rep) {
        for (int gr = bx; gr < 16 * NCH; gr += G) gla_u_group<2>(lds, QKV, SM, a.w_au + (size_t)L * 16 * 256, a.b_alpha + L * 256, UT, DEC, gr);
        for (int u = bx - 64 + ((bx < 64) ? G : 0); u < 64; u += G) fox_cumsum_unit(lds, SM, a.b_forget + L * 8, CK, u);
        }
        }
#endif
        GSYNC(); PH_END(2);
#ifndef SKIP_CS
        { FRESH();
        for (int e = gt; e < 32 * 2048; e += NGT) {
            const int bh = e >> 11, rem = (e & 2047) * 4, dk = rem & 63;
            float* up = UT + (size_t)bh * NCH * 8192 + rem; const float* dp = DEC + (size_t)bh * NCH * 64 + dk;
            f32x4 Sv = *(const f32x4*)up;
            for (int c0 = 1; c0 <= 64; c0 += 8) {
                f32x4 uu[8], dd[8];
#pragma unroll
                for (int i = 0; i < 8; ++i) { uu[i] = *(const f32x4*)(up + (size_t)(c0 + i) * 8192); dd[i] = *(const f32x4*)(dp + (c0 + i) * 64); }
#pragma unroll
                for (int i = 0; i < 8; ++i) { Sv = dd[i] * Sv + uu[i]; *(f32x4*)(up + (size_t)(c0 + i) * 8192) = Sv; }
            }
        }
#ifdef REP_SCAN
        for (int e = gt; e < 32 * 2048; e += NGT) {
            const int bh = e >> 11, rem = (e & 2047) * 4, dk = rem & 63;
            float* up = UT + (size_t)bh * NCH * 8192 + rem; const float* dp = DEC + (size_t)bh * NCH * 64 + dk;
            for (int c0 = 1; c0 <= 64; c0 += 8) {
                f32x4 uu[8], dd[8];
#pragma unroll
                for (int i = 0; i < 8; ++i) { uu[i] = *(const f32x4*)(up + (size_t)(c0 + i) * 8192); dd[i] = *(const f32x4*)(dp + (c0 + i) * 64); }
#pragma unroll
                for (int i = 0; i < 8; ++i) { *(f32x4*)(up + (size_t)(c0 + i) * 8192) = uu[i] + dd[i] * 0.f; }
            }
        }
#endif
        }
        { FRESH();
        for (int rep = 0; rep < REP_CA; ++rep)
        for (int v0 = bx; v0 < 256; v0 += G) {
            const int v = (G == 256) ? (v0 & 7) * 32 + (v0 >> 3) : v0;
            const int bhh = v >> 2, s = v & 3;
#pragma unroll 1
            for (int i = 0; i < 4; ++i) {
                const int qb = (i == 0) ? s : (i == 1) ? 7 - s : (i == 2) ? 8 + s : 15 - s;
                attn_unit(lds, QKV, CK, OB, a.fox_norm + L * 512, bhh >> 3, bhh & 7, qb);
            }
        }
#endif
#ifndef SKIP_CM
        }
        { FRESH();
#ifndef REP_CM
#define REP_CM 1
#endif
        for (int rep = 0; rep < REP_CM; ++rep)
        if (bx < NMETA) meta_attn(QKV, CK, OB, a.fox_norm + L * 512, bx);
        if (bx >= NMETA && bx < NMETA + 4 && wid == 0) { const int bhs[1] = {bx - NMETA}, ccs[1] = {0}, hfs[1] = {0}; gla_readout_wave<1>(QKV, UT, OB, a.gla_norm + L * 512, bhs, ccs, hfs, lane); }
        }
#endif
        GSYNC(); PH_END(3);
#ifndef SKIP_D
        { FRESH();
        for (int rep = 0; rep < REP_D; ++rep)
        for (int wu = gw; wu < 32 * 64; wu += NGW) gla_readout_chunk(QKV, UT, OB, a.gla_norm + L * 512, wu >> 6, 1 + (wu & 63), lane);
        }
#endif
        GSYNC(); PH_END(4);
#ifndef SKIP_E
        {
            FRESH();
            meta_rowgemm(OB + (size_t)META0 * DM, DM, (const bf16*)(wl + WL_OUT), DM, HM, HB, G, bx);
            pg8::Gemm g{OB, (const bf16*)(wl + WL_OUT), MREAL, DM, DM}; pg8::StaticOrder S; S.init(MREAL, DM, G, bx);
            if (L == 0) { EpiRes<true, false> E{2 * L + 1}; pg8::gemm_phase<EpiRes<true, false>, pg8::StaticOrder, true, true>(lds, g, S, E); }
            else { EpiRes<false, false> E{2 * L + 1}; pg8::gemm_phase<EpiRes<false, false>, pg8::StaticOrder, true, true>(lds, g, S, E); }
        }
#endif
        GSYNC(); PH_END(5);
#ifndef SKIP_F
        {
            FRESH();
            meta_up(lds, HB, (const bf16*)(wl + WL_UP), HM, a.conv_w + (size_t)L * 3 * NUP, a.conv_b + (size_t)L * NUP, A2, HL, G, bx);
            pg8::Gemm g{HB, (const bf16*)(wl + WL_UP), MREAL, NUP, DM}; pg8::StaticOrder S; S.init(MREAL, NUP, G, bx);
            EpiUp E{L};
            for (int rep = 0; rep < REP_F; ++rep) pg8::gemm_phase<EpiUp, pg8::StaticOrder, true, true>(lds, g, S, E);
        }
#endif
        GSYNC(); PH_END(6);
#ifndef SKIP_H
        {
            FRESH();
            const float* cw = a.conv_w + (size_t)L * 3 * NUP; const float* cb = a.conv_b + (size_t)L * NUP;
            { int pm = 0;
              for (int ui = 0; so_next_pm(MREAL / 256, DM / 256, G, bx, ui, pm); ++ui) {
                for (int i = tid; i < 2 * (DFF / 4); i += 512) {
                    const int c4 = i % (DFF / 4), rr = i / (DFF / 4);
                    const int ch = 4 * c4;
                    f32x4 hc[2];
#pragma unroll
                    for (int bj = 0; bj < 2; ++bj) {
                        const int c = bj * DFF + ch;
                        f32x4 P0 = {0.f, 0.f, 0.f, 0.f}, P1 = P0;
                        if (pm != 128) { const int src = (pm % 16 == 0) ? 128 : pm - 1; P0 = *(const f32x4*)(HL + (size_t)(src * 2) * NUP + c); P1 = *(const f32x4*)(HL + (size_t)(src * 2 + 1) * NUP + c); }
                        const f32x4 H0 = *(const f32x4*)(HF + (size_t)(pm * 2) * NUP + c), H1 = *(const f32x4*)(HF + (size_t)(pm * 2 + 1) * NUP + c);
                        const f32x4 x2 = rr == 0 ? P0 : P1, x1 = rr == 0 ? P1 : H0, x0 = rr == 0 ? H0 : H1;
                        hc[bj] = *(const f32x4*)(cb + c) + *(const f32x4*)(cw + c) * x2 + *(const f32x4*)(cw + NUP + c) * x1 + *(const f32x4*)(cw + 2 * NUP + c) * x0;
                    }
                    u32x2 w;
                    w.x = pk2(siluf(hc[1][0]) * hc[0][0], siluf(hc[1][1]) * hc[0][1]);
                    w.y = pk2(siluf(hc[1][2]) * hc[0][2], siluf(hc[1][3]) * hc[0][3]);
                    *(u32x2*)(A2 + (size_t)(pm * 256 + rr) * DFF + ch) = w;
                }
              }
            }
            asm volatile("s_waitcnt vmcnt(0)" ::: "memory"); __syncthreads();
            meta_rowgemm(A2 + (size_t)META0 * DFF, DFF, (const bf16*)(wl + WL_DN), DFF, HM, HB, G, bx);
            pg8::Gemm g{A2, (const bf16*)(wl + WL_DN), MREAL, DM, DFF}; pg8::StaticOrder S; S.init(MREAL, DM, G, bx);
            if (L == DEPTH - 1) { EpiRes<false, true> E{2 * L + 2}; pg8::gemm_phase<EpiRes<false, true>, pg8::StaticOrder, true, true>(lds, g, S, E); }
            else { EpiRes<false, false> E{2 * L + 2}; pg8::gemm_phase<EpiRes<false, false>, pg8::StaticOrder, true, true>(lds, g, S, E); }
        }
#endif
        GSYNC(); PH_END(7);
    }
    {
        const int L = 0; FRESH();
        const float* ssq = ssq_arr(ws, 8);
        for (int r = gw; r < MREAL; r += NGW) {
            const float rs = row_rstd(ssq, r);
            f32x4* p = (f32x4*)(a.out + (size_t)r * DM) + lane; const f32x4* wn = (const f32x4*)a.final_norm + lane;
#pragma unroll
            for (int j = 0; j < 4; ++j) p[64 * j] = p[64 * j] * rs * wn[64 * j];
        }
#if defined(PROBE_SYNC) || defined(PROBE_PH)
        asm volatile("s_waitcnt vmcnt(0)" ::: "memory"); __syncthreads();
        if (bx == PROBE_BLOCK && tid == 0) a.out[(size_t)PROBE_BLOCK * 16 * DM * 0 + 5] += floorf((float)tsync * 0.0002f + 0.5f);
#endif
    }
}

extern "C" void kernel_launch(void* const* d_in, const int* in_sizes, int n_in, void* d_out, int out_size, void* d_ws, size_t ws_size, hipStream_t stream) {
    static int grid = 0;
    if (grid == 0) {
        if (n_in != 16 || out_size != MREAL * DM || ws_size < WS_END) { fprintf(stderr, "kernel_launch: unexpected problem (n_in %d out %d ws %zu, need %zu)\n", n_in, out_size, ws_size, (size_t)WS_END); grid = -1; return; }
        int dev = 0, cus = 0, per = 0;
        (void)hipGetDevice(&dev); (void)hipDeviceGetAttribute(&cus, hipDeviceAttributeMultiprocessorCount, dev);
        (void)hipFuncSetAttribute((const void*)fwd_kernel, hipFuncAttributeMaxDynamicSharedMemorySize, LDS_BYTES);
        (void)hipOccupancyMaxActiveBlocksPerMultiprocessor(&per, (const void*)fwd_kernel, 512, LDS_BYTES);
        if (per < 1) per = 1;
        grid = cus * per;
        fprintf(stderr, "kernel_launch: grid %d (cus %d x %d), ws %zu\n", grid, cus, per, ws_size);
    }
    if (grid < 0) return;
    Args a{};
    const float** f = (const float**)&a;
    for (int i = 0; i < 16; ++i) f[i] = (const float*)d_in[i];
    a.out = (float*)d_out; a.ws = (unsigned char*)d_ws;
    (void)hipMemsetAsync((unsigned char*)d_ws + WS_BAR, 0, BAR_BYTES, stream);
    void* args[] = {&a};
    hipError_t e = hipLaunchCooperativeKernel((const void*)fwd_kernel, dim3(grid), dim3(512), args, LDS_BYTES, stream);
    if (e != hipSuccess) fprintf(stderr, "cooperative launch failed: %s (grid %d)\n", hipGetErrorString(e), grid);
}
```

```cpp
#include <hip/hip_runtime.h>
#include <hip/hip_cooperative_groups.h>
#include <cstdio>
#include <cstdint>
namespace cg = cooperative_groups;
namespace pg8 {
#define PG8_LAS __attribute__((address_space(3)))
typedef unsigned short bf16_t;
typedef short bf16x8 __attribute__((ext_vector_type(8)));
typedef float f32x4 __attribute__((ext_vector_type(4)));
typedef unsigned u32x4 __attribute__((ext_vector_type(4)));
constexpr int BM = 256, BK = 64, HALF = 128, HTB = HALF * BK * 2  , STAGE_BYTES = 8 * HTB, NXCD = 8, WGM = 8;

__host__ __device__ __forceinline__ int lds_byte(int r, int c) { const int st = (r >> 4) * 2 + (c >> 5), rr = r & 15, cc = c & 31, ob = rr * 64 + cc * 2; return st * 1024 + (ob ^ (((ob >> 9) & 1) << 5)); }
__host__ __device__ __forceinline__ void stage_rc(int b, int& R, int& C) { const int st = b / 1024, sb = b % 1024, swz = sb ^ (((sb >> 9) & 1) << 5); R = (st >> 1) * 16 + swz / 64; C = (st & 1) * 32 + (swz % 64) / 2; }
__host__ __device__ __forceinline__ int perm32(int rho) { const int n = rho >> 4, i = rho & 15; return 8 * (i >> 2) + 4 * n + (i & 3); }

struct Unit { int pm, pn; };
struct Gemm { const bf16_t* A; const bf16_t* Bt; int M, N, K; };

struct StaticOrder {
    int nM, nN, nwg, G, c;
    __host__ __device__ void init(int M, int N, int G_, int c_) { nM = M / BM; nN = N / BM; nwg = nM * nN; G = G_; c = c_; }
    __host__ __device__ bool next(int i, Unit& u) const {
        const long L = (long)i * G + c; if (L >= nwg) return false;
        int wgid = (int)L; { const int q = nwg / NXCD, r = nwg % NXCD, xcd = wgid % NXCD, off = wgid / NXCD; wgid = (xcd < r ? xcd * (q + 1) : r * (q + 1) + (xcd - r) * q) + off; }
        const int nig = WGM * nN, gid = wgid / nig, fm = gid * WGM, gsz = (nM - fm) < WGM ? (nM - fm) : WGM;
        u.pm = fm + ((wgid % nig) % gsz); u.pn = (wgid % nig) / gsz; return true;
    }
    __device__ __forceinline__ void a_ready(const Unit&) const {}
    __device__ __forceinline__ void done(const Unit&) const {}
};

__device__ __forceinline__ unsigned cvt_pk_bf16(float lo, float hi) { unsigned r; asm volatile("v_cvt_pk_bf16_f32 %0, %1, %2" : "=v"(r) : "v"(lo), "v"(hi)); return r; }
typedef float f32x2 __attribute__((ext_vector_type(2)));
template <class Epi, class Sched, bool ALIGN_EPI = false, bool SP2 = false>
__device__ __forceinline__ void gemm_phase(PG8_LAS unsigned char* lds, const Gemm g, const Sched& S, const Epi& E) {
    int tid_ = threadIdx.x; asm volatile("" : "+v"(tid_)); const int tid = tid_, wid = __builtin_amdgcn_readfirstlane(tid >> 6), lane = tid & 63, wr = wid >> 2, wc = wid & 3, fr = lane & 15, fq = lane >> 4;
    const int K = g.K, nt = K / BK;
    unsigned voffA[2], voffB[2];
#pragma unroll
    for (int i = 0; i < 2; ++i) { int R, C; stage_rc(tid * 16 + i * 8192, R, C); const int Rb = Epi::PERM ? ((R & ~31) + perm32(R & 31)) : R;
        voffA[i] = (unsigned)(R * K + C) * 2u; voffB[i] = (unsigned)(Rb * K + C) * 2u; }
    const size_t kstep = (size_t)(BK * 2);
    const size_t hstep = (size_t)HALF * K * 2;
    const size_t tstep = 2 * hstep;
    const unsigned ldsw = (unsigned)wid * 1024u;
    const int aoff = lds_byte(wr * 64 + fr, fq * 8), boff = lds_byte(wc * 32 + fr, fq * 8);
#define PG8_SA(b, h) (((b) * 2 + (h)) * HTB)
#define PG8_SB(b, h) ((4 + (b) * 2 + (h)) * HTB)
#define PG8_STAGE(bufoff, gbase, voff) do { _Pragma("unroll") for (int _i = 0; _i < 2; ++_i) \
        __builtin_amdgcn_global_load_lds((const unsigned*)((const char*)(gbase) + (voff)[_i]), (PG8_LAS unsigned*)(lds + (bufoff) + ldsw + _i * 8192), 16, 0, 0); } while (0)
#define PG8_LDA(dst, b, h) do { _Pragma("unroll") for (int m = 0; m < 4; ++m) _Pragma("unroll") for (int k = 0; k < 2; ++k) dst[m][k] = *(const PG8_LAS bf16x8*)(lds + PG8_SA(b, h) + aoff + m * 2048 + k * 1024); } while (0)
#define PG8_LDB(dst, b, h) do { _Pragma("unroll") for (int n = 0; n < 2; ++n) _Pragma("unroll") for (int k = 0; k < 2; ++k) dst[n][k] = *(const PG8_LAS bf16x8*)(lds + PG8_SB(b, h) + boff + n * 2048 + k * 1024); } while (0)
#define PG8_MMA(ai, bj, At, Bt) do { __builtin_amdgcn_s_setprio(1); _Pragma("unroll") for (int m = 0; m < 4; ++m) _Pragma("unroll") for (int n = 0; n < 2; ++n) _Pragma("unroll") for (int k = 0; k < 2; ++k) \
        acc[ai][bj][m][n] = __builtin_amdgcn_mfma_f32_16x16x32_bf16(Bt[n][k], At[m][k], acc[ai][bj][m][n], 0, 0, 0); __builtin_amdgcn_s_setprio(0); } while (0)
#define PG8_WAIT_V(n) asm volatile("s_waitcnt vmcnt(" #n ")" ::: "memory")
#define PG8_WAIT_L(n) asm volatile("s_waitcnt lgkmcnt(" #n ")" ::: "memory")
#define PG8_BAR __builtin_amdgcn_s_barrier()
#define PG8_SCHED __builtin_amdgcn_sched_barrier(0)
    Unit cur, nxt; int ui = 0;
    if (!S.next(0, cur)) return;
    f32x4 acc[2][2][4][2];
#pragma unroll
    for (int a = 0; a < 2; ++a)
#pragma unroll
        for (int b = 0; b < 2; ++b)
#pragma unroll
            for (int m = 0; m < 4; ++m)
#pragma unroll
                for (int n = 0; n < 2; ++n) acc[a][b][m][n] = (f32x4){0.f, 0.f, 0.f, 0.f};
    bf16x8 At[4][2], B0[2][2], B1[2][2];
    const char* cA = (const char*)g.A + (size_t)cur.pm * tstep; const char* cB = (const char*)g.Bt + (size_t)cur.pn * tstep;
    S.a_ready(cur);
    if constexpr (SP2) {
        PG8_STAGE(PG8_SB(0, 0), cB, voffB); PG8_STAGE(PG8_SB(0, 1), cB + hstep, voffB); PG8_STAGE(PG8_SA(0, 0), cA, voffA); PG8_STAGE(PG8_SA(0, 1), cA + hstep, voffA);
        if (wr == 1) PG8_BAR;
        PG8_WAIT_V(2); PG8_BAR;
        PG8_STAGE(PG8_SB(1, 0), cB + kstep, voffB); PG8_STAGE(PG8_SA(1, 0), cA + kstep, voffA); PG8_STAGE(PG8_SB(1, 1), cB + hstep + kstep, voffB);
        PG8_WAIT_V(6); PG8_BAR;
    } else {
        PG8_STAGE(PG8_SB(0, 0), cB, voffB); PG8_STAGE(PG8_SA(0, 0), cA, voffA); PG8_STAGE(PG8_SB(0, 1), cB + hstep, voffB); PG8_STAGE(PG8_SA(0, 1), cA + hstep, voffA);
        if (wr == 1) PG8_BAR;
        PG8_WAIT_V(4); PG8_BAR;
        PG8_STAGE(PG8_SB(1, 0), cB + kstep, voffB); PG8_STAGE(PG8_SA(1, 0), cA + kstep, voffA); PG8_STAGE(PG8_SB(1, 1), cB + hstep + kstep, voffB);
        PG8_WAIT_V(6); PG8_BAR;
    }
    for (;;) {
        const bool has_next = S.next(ui + 1, nxt);
        const char* nA = has_next ? (const char*)g.A + (size_t)nxt.pm * tstep : cA; const char* nB = has_next ? (const char*)g.Bt + (size_t)nxt.pn * tstep : cB;
        for (int t = 0; t < nt; t += 2) {
            const bool last = (t == nt - 2);
            const char* a1 = cA + (size_t)(t + 1) * kstep;
            const char* a2 = last ? nA : cA + (size_t)(t + 2) * kstep; const char* b2 = last ? nB : cB + (size_t)(t + 2) * kstep;
            const char* a3 = a2 + kstep; const char* b3 = b2 + kstep;
            if (last && has_next) S.a_ready(nxt);
            if constexpr (SP2) {
            PG8_LDB(B0, 0, 0); PG8_LDB(B1, 0, 1); PG8_SCHED; PG8_LDA(At, 0, 0); PG8_STAGE(PG8_SA(1, 1), a1 + hstep, voffA);
            PG8_WAIT_V(8); PG8_WAIT_L(0); PG8_BAR; PG8_MMA(0, 0, At, B0); PG8_MMA(0, 1, At, B1); PG8_BAR; PG8_SCHED;
            PG8_LDA(At, 0, 1); PG8_STAGE(PG8_SB(0, 0), b2, voffB); PG8_STAGE(PG8_SB(0, 1), b2 + hstep, voffB); PG8_STAGE(PG8_SA(0, 0), a2, voffA);
            PG8_WAIT_V(8); PG8_WAIT_L(0); PG8_BAR; PG8_MMA(1, 0, At, B0); PG8_MMA(1, 1, At, B1); PG8_BAR; PG8_SCHED;
            PG8_LDB(B0, 1, 0); PG8_LDB(B1, 1, 1); PG8_SCHED; PG8_LDA(At, 1, 0); PG8_STAGE(PG8_SA(0, 1), a2 + hstep, voffA);
            PG8_WAIT_V(8); PG8_WAIT_L(0); PG8_BAR; PG8_MMA(0, 0, At, B0); PG8_MMA(0, 1, At, B1); PG8_BAR; PG8_SCHED;
            PG8_LDA(At, 1, 1); PG8_STAGE(PG8_SB(1, 0), b3, voffB); PG8_STAGE(PG8_SB(1, 1), b3 + hstep, voffB); PG8_STAGE(PG8_SA(1, 0), a3, voffA);
            PG8_WAIT_V(8); PG8_WAIT_L(0); PG8_BAR; PG8_MMA(1, 0, At, B0); PG8_MMA(1, 1, At, B1); PG8_BAR; PG8_SCHED;
            } else {
            PG8_LDB(B0, 0, 0); PG8_SCHED; PG8_LDA(At, 0, 0); PG8_STAGE(PG8_SA(1, 1), a1 + hstep, voffA);
            PG8_WAIT_L(8); PG8_BAR; PG8_WAIT_L(0); PG8_MMA(0, 0, At, B0); PG8_BAR; PG8_SCHED;
            PG8_LDB(B1, 0, 1); PG8_STAGE(PG8_SB(0, 0), b2, voffB);
            PG8_BAR; PG8_WAIT_L(0); PG8_MMA(0, 1, At, B1); PG8_BAR;
            PG8_LDA(At, 0, 1); PG8_STAGE(PG8_SA(0, 0), a2, voffA);
            PG8_BAR; PG8_WAIT_L(0); PG8_MMA(1, 0, At, B0); PG8_BAR; PG8_SCHED;
            PG8_STAGE(PG8_SB(0, 1), b2 + hstep, voffB);
            PG8_WAIT_V(6); PG8_BAR; PG8_MMA(1, 1, At, B1); PG8_BAR;
            PG8_LDB(B0, 1, 0); PG8_SCHED; PG8_LDA(At, 1, 0); PG8_STAGE(PG8_SA(0, 1), a2 + hstep, voffA);
            PG8_WAIT_L(8); PG8_BAR; PG8_WAIT_L(0); PG8_MMA(0, 0, At, B0); PG8_BAR; PG8_SCHED;
            PG8_LDB(B1, 1, 1); PG8_STAGE(PG8_SB(1, 0), b3, voffB);
            PG8_BAR; PG8_WAIT_L(0); PG8_MMA(0, 1, At, B1); PG8_BAR;
            PG8_LDA(At, 1, 1); PG8_STAGE(PG8_SA(1, 0), a3, voffA);
            PG8_BAR; PG8_WAIT_L(0); PG8_MMA(1, 0, At, B0); PG8_BAR; PG8_SCHED;
            PG8_STAGE(PG8_SB(1, 1), b3 + hstep, voffB);
            PG8_WAIT_V(6); PG8_BAR; PG8_MMA(1, 1, At, B1); PG8_BAR;
            }
        }
        if constexpr (ALIGN_EPI) { if (wr == 0) PG8_BAR; }
        if constexpr (!Epi::AFTER_DRAIN) { E(acc, cur, wr, wc, fr, fq); S.done(cur); }
        if (!has_next) break;
#pragma unroll
        for (int a = 0; a < 2; ++a)
#pragma unroll
            for (int b = 0; b < 2; ++b)
#pragma unroll
                for (int m = 0; m < 4; ++m)
#pragma unroll
                    for (int n = 0; n < 2; ++n) acc[a][b][m][n] = (f32x4){0.f, 0.f, 0.f, 0.f};
        cur = nxt; cA = nA; cB = nB; ++ui;
        if constexpr (ALIGN_EPI) { if (wr == 1) PG8_BAR; }
    }
    PG8_WAIT_V(0);
    if constexpr (!ALIGN_EPI) { if (wr == 0) PG8_BAR; }
    PG8_BAR;
    if constexpr (Epi::AFTER_DRAIN) { E.fused(acc, cur, wr, wc, fr, fq, lds, wid, lane); S.done(cur); }
#undef PG8_SA
#undef PG8_SB
#undef PG8_STAGE
#undef PG8_LDA
#undef PG8_LDB
#undef PG8_MMA
#undef PG8_WAIT_V
#undef PG8_WAIT_L
#undef PG8_BAR
#undef PG8_SCHED
}
}
#define LAS __attribute__((address_space(3)))
typedef unsigned short bf16;
typedef short bf16x8 __attribute__((ext_vector_type(8)));
typedef short s16x4 __attribute__((ext_vector_type(4)));
typedef float f32x4 __attribute__((ext_vector_type(4)));
typedef float f32x16 __attribute__((ext_vector_type(16)));
typedef unsigned u32x4 __attribute__((ext_vector_type(4)));
typedef unsigned u32x2 __attribute__((ext_vector_type(2)));

constexpr int NB = 8, SEQ = 4096, DM = 1024, DEPTH = 4, NMETA = 16;
constexpr int MREAL = NB * SEQ;
constexpr int META0 = MREAL;
constexpr int MROWS = 129 * 256;
constexpr int NINP = 3328, QP = 3072;
constexpr int C_FQ = 0, C_FK = 512, C_FV = 1024, C_GQ = 1536, C_GK = 1792, C_GV = 2048, C_GR = 2560;
constexpr int DFF = 2816, NUP = 5632;
constexpr float EPS = 1e-6f, LOG2E = 1.4426950408889634f, C2 = 0.125f * LOG2E;
constexpr int CKP = 4160;
constexpr int NCH = 65;

constexpr size_t MiB = 1u << 20;
constexpr size_t WL_IN = 0, WL_OUT = 6815744, WL_UP = 8912896, WL_DN = 20447232, WL_SIZE = 26214400;
constexpr size_t WS_W = 0, WS_HB = 100 * MiB, WS_OB = WS_HB + 67633152, WS_QKV = WS_OB + 67633152, WS_UT = WS_QKV + 202899456;
constexpr size_t WS_SM = WS_UT + 68157440, WS_CK = WS_SM + 4456448, WS_DEC = WS_CK + 1310720, WS_HM = WS_DEC + 786432, WS_SSQ = WS_HM + MiB, WS_BAR = WS_SSQ + 1835008, BAR_BYTES = 16384, WS_END = WS_BAR + BAR_BYTES;
static_assert(WS_END <= 512 * MiB, "workspace map");
constexpr size_t HFL_SIZE = (size_t)129 * 2 * NUP * 4;
static_assert(2 * HFL_SIZE <= 68157440, "halo overlay");

constexpr int LDS_BYTES = 147456, HALO_OFF = 131072;

struct Args {
    const float *x, *meta, *attn_norm, *w_in, *w_au, *b_alpha, *b_forget, *gla_norm, *fox_norm, *w_out, *ffn_norm, *w_up, *conv_w, *conv_b, *w_down, *final_norm;
    float* out; unsigned char* ws;
};

#define GAS __attribute__((address_space(1)))
#define CAS __attribute__((address_space(4)))
typedef const CAS Args* KArgs;
__device__ __forceinline__ KArgs kargs() { KArgs p = (KArgs)__builtin_amdgcn_kernarg_segment_ptr(); asm volatile("" : "+s"(p)); return p; }
template <class T> __device__ __forceinline__ T* gptr(T* p) { return (T*)(GAS T*)p; }
__device__ __forceinline__ float bf2f(bf16 v) { return __uint_as_float((unsigned)v << 16); }
__device__ __forceinline__ unsigned pk2(float lo, float hi) { return pg8::cvt_pk_bf16(lo, hi); }
__device__ __forceinline__ bf16 f2bf(float v) { return (bf16)(pk2(v, 0.f) & 0xffffu); }
__device__ __forceinline__ float wave_sum(float v) {
#pragma unroll
    for (int o = 1; o < 64; o <<= 1) v += __shfl_xor(v, o);
    return v;
}
__device__ __forceinline__ float logsigmoidf(float z) { return -(fmaxf(-z, 0.f) + log1pf(__expf(-fabsf(z)))); }
__device__ __forceinline__ float siluf(float v) { return v * __builtin_amdgcn_rcpf(1.f + __builtin_amdgcn_exp2f(-LOG2E * v)); }
__device__ __forceinline__ int crow(int r, int hi) { return (r & 3) + 8 * (r >> 2) + 4 * hi; }
__device__ __forceinline__ s16x4 vtr(const LAS unsigned char* p) { return __builtin_bit_cast(s16x4, __builtin_amdgcn_ds_read_tr16_b64_v4i16((LAS s16x4*)p)); }
__device__ __forceinline__ bf16x8 cat8(s16x4 a, s16x4 b) { return (bf16x8){a[0], a[1], a[2], a[3], b[0], b[1], b[2], b[3]}; }
__device__ __forceinline__ float dppf(float old, float src, int ctrl_unused);
#define DPP_MOV(old, src, ctrl) __builtin_bit_cast(float, __builtin_amdgcn_update_dpp(__builtin_bit_cast(int, (float)(old)), __builtin_bit_cast(int, (float)(src)), (ctrl), 0xf, 0xf, false))
#define LDS_WAIT() asm volatile("s_waitcnt lgkmcnt(0)" ::: "memory")

__device__ __forceinline__ const float* ssq_arr(unsigned char* wsb, int si) { return (const float*)(wsb + WS_SSQ) + (size_t)(si % 3) * MROWS * 4; }
__device__ __forceinline__ float row_rstd(const float* ssqp, int row) { const f32x4 s = *(const f32x4*)(ssqp + (size_t)row * 4); return rsqrtf(((s[0] + s[1]) + (s[2] + s[3])) * (1.0f / DM) + EPS); }
__device__ __forceinline__ LAS float* tile_rstd(unsigned char* wsb, int si, int pm, int wr, int wc, int fr, int fq) {
    extern __shared__ __attribute__((aligned(16))) unsigned char lds_dyn_[];
    LAS float* rsl = (LAS float*)((LAS unsigned char*)lds_dyn_ + HALO_OFF + 8192);
    const int tl = (wr * 4 + wc) * 64 + fq * 16 + fr;
    if (pm != 128) {
        if (tl < 256) rsl[tl] = row_rstd(ssq_arr(wsb, si), pm * 256 + tl);
    } else {
        const int row = tl >> 5, part = tl & 31;
        const f32x4* hp = (const f32x4*)((const float*)(wsb + WS_HM) + (size_t)row * DM) + part;
        float s = 0.f;
#pragma unroll
        for (int j = 0; j < 8; ++j) { const f32x4 v = hp[32 * j]; s += (v[0] * v[0] + v[1] * v[1]) + (v[2] * v[2] + v[3] * v[3]); }
        s += __shfl_xor(s, 1); s += __shfl_xor(s, 2); s += __shfl_xor(s, 4); s += __shfl_xor(s, 8); s += __shfl_xor(s, 16);
        if (part == 0) rsl[row] = rsqrtf(s * (1.0f / DM) + EPS);
        if (tl < 240) rsl[16 + tl] = 0.f;
    }
    asm volatile("s_waitcnt lgkmcnt(0)" ::: "memory"); __builtin_amdgcn_s_barrier(); asm volatile("" ::: "memory");
    return rsl;
}
__device__ __forceinline__ void meta_rowgemm(const bf16* A, int lda, const bf16* Bt, int K, float* HM, bf16* HB, int G, int bx) {
    int tid_ = threadIdx.x; asm volatile("" : "+v"(tid_)); const int r = tid_ >> 5, kp = tid_ & 31;
    for (int cg = bx; cg < 256; cg += G) {
        float acc[4] = {0.f, 0.f, 0.f, 0.f};
        for (int k0 = kp * 8; k0 < K; k0 += 256) {
            const u32x4 av = *(const u32x4*)(A + (size_t)r * lda + k0);
#pragma unroll
            for (int j = 0; j < 4; ++j) {
                const u32x4 bv = *(const u32x4*)(Bt + (size_t)(4 * cg + j) * K + k0);
#pragma unroll
                for (int q = 0; q < 4; ++q) {
                    acc[j] += __uint_as_float(av[q] << 16) * __uint_as_float(bv[q] << 16);
                    acc[j] += __uint_as_float(av[q] & 0xffff0000u) * __uint_as_float(bv[q] & 0xffff0000u);
                }
            }
        }
#pragma unroll
        for (int j = 0; j < 4; ++j) { float s = acc[j]; s += __shfl_xor(s, 1); s += __shfl_xor(s, 2); s += __shfl_xor(s, 4); s += __shfl_xor(s, 8); s += __shfl_xor(s, 16); acc[j] = s; }
        if (kp == 0) {
            float* hp = HM + (size_t)r * DM + 4 * cg;
            const f32x4 h = *(const f32x4*)hp + (f32x4){acc[0], acc[1], acc[2], acc[3]};
            *(f32x4*)hp = h;
            u32x2 w; w.x = pk2(h[0], h[1]); w.y = pk2(h[2], h[3]);
            *(u32x2*)(HB + (size_t)(META0 + r) * DM + 4 * cg) = w;
        }
    }
}
__device__ __forceinline__ void meta_up(LAS unsigned char* lds, const bf16* HB, const bf16* Wup, const float* HM, const float* cw, const float* cb, bf16* A2, float* HL, int G, int bx) {
    int tid_ = threadIdx.x; asm volatile("" : "+v"(tid_)); const int tid = tid_, r = tid >> 5, kp = tid & 31;
    LAS float* hb = (LAS float*)lds;
    float rs;
    { const f32x4* hp = (const f32x4*)(HM + (size_t)r * DM) + kp; float s = 0.f;
#pragma unroll
      for (int j = 0; j < 8; ++j) { const f32x4 v = hp[32 * j]; s += (v[0] * v[0] + v[1] * v[1]) + (v[2] * v[2] + v[3] * v[3]); }
      s += __shfl_xor(s, 1); s += __shfl_xor(s, 2); s += __shfl_xor(s, 4); s += __shfl_xor(s, 8); s += __shfl_xor(s, 16);
      rs = rsqrtf(s * (1.0f / DM) + EPS); }
    u32x4 av[4];
#pragma unroll
    for (int i = 0; i < 4; ++i) av[i] = *(const u32x4*)(HB + (size_t)(META0 + r) * DM + kp * 8 + 256 * i);
    for (int cg = bx; cg < 256; cg += G) {
#pragma unroll 1
        for (int cb0 = 0; cb0 < 24; cb0 += 6) {
            u32x4 bv[6][4];
#pragma unroll
            for (int c6 = 0; c6 < 6; ++c6) {
                const int c = cb0 + c6 < 22 ? cb0 + c6 : 21, isg = c >= 11 ? 1 : 0, jj = c - 11 * isg;
                const int ch = 11 * cg + jj, wrow = (ch >> 7) * 256 + isg * 128 + (ch & 127);
#pragma unroll
                for (int i = 0; i < 4; ++i) bv[c6][i] = *(const u32x4*)(Wup + (size_t)wrow * DM + kp * 8 + 256 * i);
            }
#pragma unroll
            for (int c6 = 0; c6 < 6; ++c6) {
                float acc = 0.f;
#pragma unroll
                for (int i = 0; i < 4; ++i)
#pragma unroll
                    for (int q = 0; q < 4; ++q) {
                        acc += __uint_as_float(av[i][q] << 16) * __uint_as_float(bv[c6][i][q] << 16);
                        acc += __uint_as_float(av[i][q] & 0xffff0000u) * __uint_as_float(bv[c6][i][q] & 0xffff0000u);
                    }
                acc += __shfl_xor(acc, 1); acc += __shfl_xor(acc, 2); acc += __shfl_xor(acc, 4); acc += __shfl_xor(acc, 8); acc += __shfl_xor(acc, 16);
                if (kp == 0 && cb0 + c6 < 22) hb[r * 24 + cb0 + c6] = acc * rs;
            }
        }
        __syncthreads();
        if (tid < 16 * 11) {
            const int rr = tid / 11, jj = tid % 11, ch = 11 * cg + jj;
            float hc[2];
#pragma unroll
            for (int ug = 0; ug < 2; ++ug) {
                const int c = ug * DFF + ch;
                const float x0 = hb[rr * 24 + ug * 11 + jj], x1 = rr >= 1 ? hb[(rr - 1) * 24 + ug * 11 + jj] : 0.f, x2 = rr >= 2 ? hb[(rr - 2) * 24 + ug * 11 + jj] : 0.f;
                hc[ug] = cb[c] + cw[c] * x2 + cw[NUP + c] * x1 + cw[2 * NUP + c] * x0;
                if (rr >= 14) HL[(size_t)(256 + rr - 14) * NUP + c] = x0;
            }
            A2[(size_t)(META0 + rr) * DFF + ch] = f2bf(siluf(hc[1]) * hc[0]);
        }
        __syncthreads();
    }
}
__device__ __forceinline__ bool so_next_pm(int nM, int nN, int G, int c, int i, int& pm) {
    const int nwg = nM * nN; const long Lq = (long)i * G + c; if (Lq >= nwg) return false;
    int wgid = (int)Lq; { const int q = nwg / pg8::NXCD, r = nwg % pg8::NXCD, xcd = wgid % pg8::NXCD, off = wgid / pg8::NXCD; wgid = (xcd < r ? xcd * (q + 1) : r * (q + 1) + (xcd - r) * q) + off; }
    const int nig = pg8::WGM * nN, gid = wgid / nig, fm = gid * pg8::WGM, gsz = (nM - fm) < pg8::WGM ? (nM - fm) : pg8::WGM;
    pm = fm + ((wgid % nig) % gsz); return true;
}
struct EpiIn {
    static constexpr bool PERM = true, AFTER_DRAIN = false;
    int si;
    __device__ __forceinline__ void operator()(const pg8::f32x4 (&acc)[2][2][4][2], const pg8::Unit& u, int wr, int wc, int fr, int fq) const {
        asm volatile("" : "+v"(fr), "+v"(fq));
        unsigned char* wsb = gptr(kargs()->ws);
        bf16* Q = (bf16*)(wsb + WS_QKV); float* SM = (float*)(wsb + WS_SM); const LAS float* rsl = tile_rstd(wsb, si, u.pm, wr, wc, fr, fq);
#pragma unroll
        for (int ai = 0; ai < 2; ++ai)
#pragma unroll
            for (int m = 0; m < 4; ++m) {
                const int row = u.pm * 256 + ai * 128 + wr * 64 + m * 16 + fr;
                const float rs = rsl[ai * 128 + wr * 64 + m * 16 + fr];
                if (u.pn < 12) {
#pragma unroll
                    for (int bj = 0; bj < 2; ++bj) {
                        const pg8::f32x4 v0 = acc[ai][bj][m][0] * rs, v1 = acc[ai][bj][m][1] * rs;
                        u32x4 w; w.x = pk2(v0[0], v0[1]); w.y = pk2(v0[2], v0[3]); w.z = pk2(v1[0], v1[1]); w.w = pk2(v1[2], v1[3]);
                        *(u32x4*)(Q + (size_t)row * QP + u.pn * 256 + bj * 128 + wc * 32 + 8 * fq) = w;
                    }
                } else if (wc == 0) {
                    *(f32x4*)(SM + (size_t)row * 32 + 8 * fq) = acc[ai][0][m][0] * rs;
                    *(f32x4*)(SM + (size_t)row * 32 + 8 * fq + 4) = acc[ai][0][m][1] * rs;
                }
            }
    }
};
template <bool from_x, bool last> struct EpiRes {
    static constexpr bool PERM = false, AFTER_DRAIN = false;
    int si;
    __device__ __forceinline__ void operator()(const pg8::f32x4 (&acc)[2][2][4][2], const pg8::Unit& u, int wr, int wc, int fr, int fq) const {
        asm volatile("" : "+v"(fr), "+v"(fq));
        KArgs ka = kargs(); unsigned char* wsb = gptr(ka->ws);
        float* out = last ? gptr(ka->out) : nullptr; const float* xin = from_x ? gptr(ka->x) : nullptr; bf16* HB = (bf16*)(wsb + WS_HB); float* ssq_next = (float*)ssq_arr(wsb, si);
        extern __shared__ __attribute__((aligned(16))) unsigned char lds_dyn_[];
        LAS float* red = (LAS float*)((LAS unsigned char*)lds_dyn_ + HALO_OFF);
#pragma unroll
        for (int ai = 0; ai < 2; ++ai)
#pragma unroll
            for (int m = 0; m < 4; ++m) {
                const int row = u.pm * 256 + ai * 128 + wr * 64 + m * 16 + fr;
                float ss = 0.f;
#pragma unroll
                for (int bj = 0; bj < 2; ++bj)
#pragma unroll
                    for (int n = 0; n < 2; ++n) {
                        const int col = u.pn * 256 + bj * 128 + wc * 32 + 16 * n + 4 * fq;
                        f32x4 bs;
                        if constexpr (from_x) bs = *(const f32x4*)(xin + (size_t)row * DM + col);
                        else { const u32x2 t = *(const u32x2*)(HB + (size_t)row * DM + col);
                               bs = (f32x4){__uint_as_float(t.x << 16), __uint_as_float(t.x & 0xffff0000u), __uint_as_float(t.y << 16), __uint_as_float(t.y & 0xffff0000u)}; }
                        const f32x4 h = bs + acc[ai][bj][m][n];
                        ss += (h[0] * h[0] + h[1] * h[1]) + (h[2] * h[2] + h[3] * h[3]);
                        u32x2 w; w.x = pk2(h[0], h[1]); w.y = pk2(h[2], h[3]);
                        *(u32x2*)(HB + (size_t)row * DM + col) = w;
                        if constexpr (last) *(f32x4*)(out + (size_t)row * DM + col) = h;
                    }
                ss += __shfl_xor(ss, 16); ss += __shfl_xor(ss, 32);
                if (fq == 0) red[wc * 256 + ai * 128 + wr * 64 + m * 16 + fr] = ss;
            }
        asm volatile("s_waitcnt lgkmcnt(0)" ::: "memory"); __builtin_amdgcn_s_barrier(); asm volatile("" ::: "memory");
        {
            const int tl = (wr * 4 + wc) * 64 + fq * 16 + fr;
            if (tl < 256) ssq_next[(size_t)(u.pm * 256 + tl) * 4 + u.pn] = (red[tl] + red[256 + tl]) + (red[512 + tl] + red[768 + tl]);
        }
    }
};
struct EpiUp {
    static constexpr bool PERM = true, AFTER_DRAIN = false;
    int L;
    __device__ __forceinline__ void operator()(pg8::f32x4 (&acc)[2][2][4][2], const pg8::Unit& u, int wr, int wc, int fr, int fq) const {
        asm volatile("" : "+v"(fr), "+v"(fq));
        KArgs ka = kargs(); unsigned char* wsb = gptr(ka->ws);
        const LAS float* rsl = tile_rstd(wsb, 2 * L + 1, u.pm, wr, wc, fr, fq); const float* cw = gptr(ka->conv_w) + (size_t)L * 3 * NUP; const float* cb = gptr(ka->conv_b) + (size_t)L * NUP;
        extern __shared__ __attribute__((aligned(16))) unsigned char lds_dyn_[];
        LAS float* halo = (LAS float*)((LAS unsigned char*)lds_dyn_ + HALO_OFF);
        const int colw = wc * 32 + 8 * fq;
#pragma unroll
        for (int ai = 0; ai < 2; ++ai)
#pragma unroll
            for (int m = 0; m < 4; ++m) {
                const int row = u.pm * 256 + ai * 128 + wr * 64 + m * 16 + fr;
                const float rs = rsl[ai * 128 + wr * 64 + m * 16 + fr]; (void)row;
#pragma unroll
                for (int bj = 0; bj < 2; ++bj)
#pragma unroll
                    for (int n = 0; n < 2; ++n) acc[ai][bj][m][n] *= rs;
            }
#ifdef SIMPLE_UP
        {
            const int ch0s = u.pn * 128 + colw;
#pragma unroll
            for (int n = 0; n < 2; ++n)
#pragma unroll
                for (int ai = 0; ai < 2; ++ai)
#pragma unroll
                    for (int m = 0; m < 4; ++m) {
                        const int row = u.pm * 256 + ai * 128 + wr * 64 + m * 16 + fr;
                        const f32x4 hu = acc[ai][0][m][n], hg = acc[ai][1][m][n];
                        u32x2 w; w.x = pk2(hu[0] + hg[0], hu[1] + hg[1]); w.y = pk2(hu[2] + hg[2], hu[3] + hg[3]);
                        *(u32x2*)(wsb + (unsigned)(WS_QKV + (unsigned)((row * DFF + ch0s + 4 * n) * 2))) = w;
                    }
            return;
        }
#endif
        if (fr >= 14) {
#pragma unroll
            for (int ai = 0; ai < 2; ++ai)
#pragma unroll
                for (int bj = 0; bj < 2; ++bj)
#pragma unroll
                    for (int n = 0; n < 2; ++n)
                        *(LAS f32x4*)(halo + (((2 * ai + wr) * 2 + (fr - 14)) * 256 + bj * 128 + colw + 4 * n)) = acc[ai][bj][3][n];
        }
        asm volatile("s_waitcnt lgkmcnt(0)" ::: "memory"); __builtin_amdgcn_s_barrier(); asm volatile("" ::: "memory");
        const int ch0 = u.pn * 128 + colw;
        u32x2 wout[2][4][2];
#pragma unroll
        for (int n = 0; n < 2; ++n) {
            f32x4 w0[2], w1[2], w2[2], bb[2];
#pragma unroll
            for (int bj = 0; bj < 2; ++bj) {
                const int c = bj * DFF + ch0 + 4 * n;
                w0[bj] = *(const f32x4*)((const char*)cw + (unsigned)(c * 4)); w1[bj] = *(const f32x4*)((const char*)cw + (unsigned)((NUP + c) * 4)); w2[bj] = *(const f32x4*)((const char*)cw + (unsigned)((2 * NUP + c) * 4)); bb[bj] = *(const f32x4*)((const char*)cb + (unsigned)(c * 4));
            }
#pragma unroll
            for (int ai = 0; ai < 2; ++ai)
#pragma unroll
                for (int m = 0; m < 4; ++m) {
                    const int g = 2 * ai + wr;
                    f32x4 hc[2];
#pragma unroll
                    for (int bj = 0; bj < 2; ++bj) {
                        const int c = bj * DFF + ch0 + 4 * n;
                        const f32x4 cur = acc[ai][bj][m][n];
                        f32x4 pb;
                        if (m > 0) pb = acc[ai][bj][m - 1][n];
                        else pb = *(const LAS f32x4*)(halo + ((((g > 0 ? g - 1 : 0) * 2) + (fr & 1)) * 256 + bj * 128 + colw + 4 * n));
                        f32x4 p1, p2;
#pragma unroll
                        for (int j = 0; j < 4; ++j) {
                            const float t1 = DPP_MOV(0.f, pb[j], 0x121);
                            p1[j] = DPP_MOV(t1, cur[j], 0x111);
                            const float t2 = DPP_MOV(0.f, pb[j], 0x122);
                            p2[j] = DPP_MOV(t2, cur[j], 0x112);
                        }
                        hc[bj] = bb[bj] + w0[bj] * p2 + w1[bj] * p1 + w2[bj] * cur;
                        if (g == 0 && m == 0 && fr < 2) *(f32x4*)(wsb + (unsigned)(WS_UT + (unsigned)(((u.pm * 2 + fr) * NUP + c) * 4))) = cur;
                        if (u.pm == 128 ? (g == 0 && m == 0 && fr >= 14) : (g == 3 && m == 3 && fr >= 14))
                            *(f32x4*)(wsb + (unsigned)(WS_UT + HFL_SIZE + (unsigned)(((u.pm * 2 + fr - 14) * NUP + c) * 4))) = cur;
                    }
                    wout[ai][m][n].x = pk2(siluf(hc[1][0]) * hc[0][0], siluf(hc[1][1]) * hc[0][1]);
                    wout[ai][m][n].y = pk2(siluf(hc[1][2]) * hc[0][2], siluf(hc[1][3]) * hc[0][3]);
                }
        }
#pragma unroll
        for (int ai = 0; ai < 2; ++ai)
#pragma unroll
            for (int m = 0; m < 4; ++m) {
                const int row = u.pm * 256 + ai * 128 + wr * 64 + m * 16 + fr;
                u32x4 w; w.x = wout[ai][m][0].x; w.y = wout[ai][m][0].y; w.z = wout[ai][m][1].x; w.w = wout[ai][m][1].y;
                *(u32x4*)(wsb + (unsigned)(WS_QKV + (unsigned)((row * DFF + ch0) * 2))) = w;
            }
    }
};
#define XB_TMO      128
#define XB_XCNT(j)  (256  + 64 * (j))
#define XB_XSUB(j)  (1280 + 64 * (j))
#define XB_XGEN(j)  (2304 + 64 * (j))
#define XB_TOP      3328
#define XB_TOPGEN   3392
#define XCD_BAR_WORDS 3456
#define XB_SPIN_CAP (1u << 18)

__device__ __forceinline__ unsigned xb_ld(unsigned* p)              { return __hip_atomic_load(p, __ATOMIC_RELAXED, __HIP_MEMORY_SCOPE_AGENT); }
__device__ __forceinline__ unsigned xb_add(unsigned* p, unsigned v) { return __hip_atomic_fetch_add(p, v, __ATOMIC_RELAXED, __HIP_MEMORY_SCOPE_AGENT); }
__device__ __forceinline__ unsigned xb_xcc_id() { return (unsigned)__builtin_amdgcn_s_getreg((3 << 11) | 20) & 0xFu; }
#define XB_SPIN(cond, bar) do { unsigned _sp = 0; while (cond) { __builtin_amdgcn_s_sleep(1); \
    if ((++_sp & 255u) == 0u) { if (xb_ld(&(bar)[XB_TMO])) break; if (_sp > XB_SPIN_CAP) { atomicAdd(&(bar)[XB_TMO], 1u); break; } } } } while (0)

struct XcdBarrier {
    unsigned* bar; unsigned x;
    volatile LAS unsigned* st;
};

__device__ __forceinline__ XcdBarrier xcd_barrier_post(unsigned* bar, volatile LAS unsigned* st) {
    XcdBarrier b; b.bar = bar; b.x = xb_xcc_id(); b.st = st;
    if (threadIdx.x == 0) (void)xb_add(&bar[XB_XCNT(b.x)], 1u);
    return b;
}
__device__ __forceinline__ void xcd_barrier_complete(unsigned* bar, unsigned x, unsigned& nloc, unsigned& nx) {
    const unsigned G = gridDim.x * gridDim.y * gridDim.z;
    unsigned sum, cnt, mine, sp = 0u;
    for (;;) {
        sum = 0u; cnt = 0u; mine = 0u;
#pragma unroll
        for (unsigned j = 0; j < 16; ++j) { const unsigned c = xb_ld(&bar[XB_XCNT(j)]); sum += c; cnt += (c > 0u) ? 1u : 0u; mine = (j == x) ? c : mine; }
        if (sum == G) break;
        __builtin_amdgcn_s_sleep(1);
        if ((++sp & 255u) == 0u) { if (xb_ld(&bar[XB_TMO])) break; if (sp > XB_SPIN_CAP) { atomicAdd(&bar[XB_TMO], 1u); break; } }
    }
    nloc = mine > 0u ? mine : 1u; nx = cnt > 0u ? cnt : 1u;
}

__device__ __forceinline__ void xcd_barrier(const XcdBarrier& b) {
    asm volatile("s_waitcnt vmcnt(0)" ::: "memory");
    __syncthreads();
    if (threadIdx.x == 0) {
        unsigned* bar = b.bar;
        __builtin_amdgcn_s_waitcnt(0);
        unsigned nloc = b.st[0], nx = b.st[1];
        if (nloc == 0u) { xcd_barrier_complete(bar, b.x, nloc, nx); b.st[0] = nloc; b.st[1] = nx; }
        const unsigned old = xb_add(&bar[XB_XSUB(b.x)], 1u);
        const unsigned gen = old / nloc;
        if (old + 1u == (gen + 1u) * nloc) {
            __builtin_amdgcn_fence(__ATOMIC_RELEASE, "agent");
            asm volatile("s_waitcnt vmcnt(0)" ::: "memory");
            const unsigned og = xb_add(&bar[XB_TOP], 1u);
            const unsigned tg = og / nx;
            if (og + 1u == (tg + 1u) * nx) xb_add(&bar[XB_TOPGEN], 1u);
            else XB_SPIN(xb_ld(&bar[XB_TOPGEN]) == tg, bar);
            __builtin_amdgcn_fence(__ATOMIC_ACQUIRE, "agent");
            xb_add(&bar[XB_XGEN(b.x)], 1u);
            asm volatile("s_waitcnt vmcnt(0)" ::: "memory");
        } else {
            XB_SPIN(xb_ld(&bar[XB_XGEN(b.x)]) == gen, bar);
            __builtin_amdgcn_fence(__ATOMIC_ACQUIRE, "agent");
            asm volatile("s_waitcnt vmcnt(0)" ::: "memory");
        }
    }
    __syncthreads();
}
__device__ __forceinline__ int win_src(int n) {
    if (n < 512) return 1552 + n;
    if (n < 1024) return 2064 + (n - 512);
    if (n < 1536) return 2576 + (n - 1024);
    if (n < 1792) return n - 1536;
    if (n < 2048) return 256 + (n - 1792);
    if (n < 2560) return 512 + (n - 2048);
    if (n < 3072) return 1024 + (n - 2560);
    if (n < 3088) return 1536 + (n - 3072);
    if (n < 3096) return n;
    return -1;
}
__device__ __forceinline__ void tr_item(const float* W, int Nsrc, bf16* WT, int K, const float* gk, int mode, LAS float* scr, int k0, int n0, int lane) {
    const int nl = lane & 31, n = n0 + nl;
    int src = n; float cs = 1.f;
    if (mode == 0) { src = win_src(n); cs = n < 512 ? C2 : ((n >= 1536 && n < 1792) ? 0.125f : 1.f); }
    else if (mode == 2) { const int pn = n >> 8, j = n & 255; src = j < 128 ? pn * 128 + j : DFF + pn * 128 + (j - 128); }
#pragma unroll
    for (int i = 0; i < 32; ++i) {
        const int kk = 2 * i + (lane >> 5);
        float v = 0.f;
        if (src >= 0) v = W[(size_t)(k0 + kk) * Nsrc + src] * cs;
        if (gk) v *= gk[k0 + kk];
        scr[kk * 33 + nl] = v;
    }
    LDS_WAIT(); asm volatile("" ::: "memory");
    const int c = lane & 7;
#pragma unroll
    for (int j = 0; j < 4; ++j) {
        const int nn = (lane >> 3) + 8 * j; const LAS float* s = scr + (8 * c) * 33 + nn;
        u32x4 o; o.x = pk2(s[0 * 33], s[1 * 33]); o.y = pk2(s[2 * 33], s[3 * 33]); o.z = pk2(s[4 * 33], s[5 * 33]); o.w = pk2(s[6 * 33], s[7 * 33]);
        *(u32x4*)(WT + (size_t)(n0 + nn) * K + k0 + 8 * c) = o;
    }
    LDS_WAIT(); asm volatile("" ::: "memory");
}
__device__ __forceinline__ void row_to_bf16(const float* xrow, bf16* orow, float* ssq_slot, float* copy_row, int lane) {
    const f32x4* xr = (const f32x4*)xrow + lane;
    f32x4 v[4]; float s = 0.f;
#pragma unroll
    for (int j = 0; j < 4; ++j) { v[j] = xr[64 * j]; s += (v[j][0] * v[j][0] + v[j][1] * v[j][1]) + (v[j][2] * v[j][2] + v[j][3] * v[j][3]); }
    s = wave_sum(s);
    if (lane == 0) *(f32x4*)ssq_slot = (f32x4){s, 0.f, 0.f, 0.f};
    u32x2* o8 = (u32x2*)orow + lane;
#pragma unroll
    for (int j = 0; j < 4; ++j) { u32x2 w; w.x = pk2(v[j][0], v[j][1]); w.y = pk2(v[j][2], v[j][3]); o8[64 * j] = w; }
    if (copy_row) {
#pragma unroll
        for (int j = 0; j < 4; ++j) ((f32x4*)copy_row + lane)[64 * j] = v[j];
    }
}

template <int NQ> __device__ __forceinline__ void gla_u_group(LAS unsigned char* lds, const bf16* QKV, const float* SM, const float* wau, const float* balpha, float* UT, float* DEC, int grp) {
    int tid_ = threadIdx.x; asm volatile("" : "+v"(tid_)); const int tid = tid_, lane = tid & 63, wid = __builtin_amdgcn_readfirstlane(tid >> 6), hi = lane >> 5, r32 = lane & 31;
    constexpr int SUB = 9216 + 17408 + 2048;
    const int dk = lane, sg = wid;
    int bhq[NQ], ccq[NQ], hq[NQ], row0q[NQ], tvq[NQ];
    float la[NQ][8], kf[NQ][8];
#pragma unroll
    for (int q = 0; q < NQ; ++q) {
        const int u = NQ * grp + q; bhq[q] = u / NCH; ccq[q] = u % NCH; hq[q] = bhq[q] & 3;
        row0q[q] = ccq[q] == 0 ? META0 : (bhq[q] >> 2) * SEQ + (ccq[q] - 1) * 64; tvq[q] = ccq[q] == 0 ? NMETA : 64;
        LAS unsigned char* VT = lds + q * SUB + 9216;
        LAS float* TOT = (LAS float*)(lds + q * SUB + 9216 + 17408);
#pragma unroll
        for (int i = 0; i < 2; ++i) {
            const int idx = tid + 512 * i, row = idx >> 4, ch = idx & 15;
            const u32x4 v = *(const u32x4*)(QKV + (size_t)(row0q[q] + row) * QP + C_GV + hq[q] * 128 + ch * 8);
            *(LAS u32x4*)(VT + row * 272 + ch * 16) = v;
        }
#pragma unroll
        for (int i = 0; i < 8; ++i) kf[q][i] = bf2f(QKV[(size_t)(row0q[q] + 8 * sg + i) * QP + C_GK + hq[q] * 64 + dk]);
        float w[16];
#pragma unroll
        for (int r = 0; r < 16; ++r) w[r] = wau[r * 256 + hq[q] * 64 + dk];
        const float bias = balpha[hq[q] * 64 + dk];
#pragma unroll
        for (int i = 0; i < 8; ++i) {
            const int s = 8 * sg + i;
            const f32x4* g4 = (const f32x4*)(SM + (size_t)(row0q[q] + s) * 32);
            float z = bias;
#pragma unroll
            for (int k = 0; k < 4; ++k) { const f32x4 gv = g4[k]; z += gv[0] * w[4 * k] + gv[1] * w[4 * k + 1] + gv[2] * w[4 * k + 2] + gv[3] * w[4 * k + 3]; }
            la[q][i] = (s < tvq[q]) ? logsigmoidf(z) * (1.0f / 16.0f) : 0.f;
        }
#pragma unroll
        for (int i = 1; i < 8; ++i) la[q][i] += la[q][i - 1];
        TOT[sg * 64 + dk] = la[q][7];
    }
    __syncthreads();
#pragma unroll
    for (int q = 0; q < NQ; ++q) {
        LAS unsigned char* KD = lds + q * SUB;
        const LAS float* TOT = (const LAS float*)(lds + q * SUB + 9216 + 17408);
        float pre = 0.f, tot = 0.f;
#pragma unroll
        for (int g2 = 0; g2 < 8; ++g2) { const float t = TOT[g2 * 64 + dk]; if (g2 < sg) pre += t; tot += t; }
        if (sg == 0) DEC[(size_t)(bhq[q] * NCH + ccq[q]) * 64 + dk] = __expf(tot);
#pragma unroll
        for (int i = 0; i < 8; ++i) {
            const int s = 8 * sg + i;
            const float kd = (s < tvq[q]) ? kf[q][i] * __expf(tot - (pre + la[q][i])) : 0.f;
            *(LAS bf16*)(KD + s * 144 + dk * 2) = f2bf(kd);
        }
    }
    __syncthreads();
    const int dvb = wid >> 1, dkb = wid & 1;
    const int qq = (lane & 15) >> 2, pp = lane & 3, half = (lane >> 4) & 1;
#pragma unroll
    for (int q = 0; q < NQ; ++q) {
        const LAS unsigned char* KD = lds + q * SUB; const LAS unsigned char* VT = lds + q * SUB + 9216;
        f32x16 acc = {};
#pragma unroll
        for (int j = 0; j < 4; ++j) {
            const LAS unsigned char* ap = VT + (16 * j + 4 * hi + qq) * 272 + (32 * dvb + 16 * half + 4 * pp) * 2;
            const LAS unsigned char* bp = KD + (16 * j + 4 * hi + qq) * 144 + (32 * dkb + 16 * half + 4 * pp) * 2;
            const bf16x8 af = cat8(vtr(ap), vtr(ap + 8 * 272));
            const bf16x8 bfr = cat8(vtr(bp), vtr(bp + 8 * 144));
            acc = __builtin_amdgcn_mfma_f32_32x32x16_bf16(af, bfr, acc, 0, 0, 0);
        }
        float* up = UT + ((size_t)(bhq[q] * NCH + ccq[q]) * 128 + 32 * dvb) * 64 + 32 * dkb + r32;
#pragma unroll
        for (int r = 0; r < 16; ++r) up[crow(r, hi) * 64] = acc[r];
    }
    __syncthreads();
}
__device__ __forceinline__ void fox_cumsum_unit(LAS unsigned char* lds, const float* SM, const float* bforget, float* CK, int bh) {
    int tid_ = threadIdx.x; asm volatile("" : "+v"(tid_)); const int tid = tid_, lane = tid & 63, wid = tid >> 6;
    const int b = bh >> 3, h = bh & 7;
    const float bf_ = bforget[h];
    LAS float* WT_ = (LAS float*)lds;
    float mtot = 0.f, mine = 0.f;
    for (int p = 0; p < NMETA; ++p) { mtot += logsigmoidf(SM[(size_t)(META0 + p) * 32 + 16 + h] + bf_); if (tid == p) mine = mtot; }
    if (tid < 64) CK[(size_t)bh * CKP + tid] = tid < NMETA ? -LOG2E * mine : -INFINITY;
    float v[8]; float run = 0.f;
#pragma unroll
    for (int i = 0; i < 8; ++i) { run += logsigmoidf(SM[(size_t)(b * SEQ + 8 * tid + i) * 32 + 16 + h] + bf_); v[i] = run; }
    float inc = run;
#pragma unroll
    for (int o = 1; o < 64; o <<= 1) { const float t = __shfl_up(inc, o); if (lane >= o) inc += t; }
    if (lane == 63) WT_[wid] = inc;
    __syncthreads();
    float off = mtot + (inc - run);
    for (int w2 = 0; w2 < wid; ++w2) off += WT_[w2];
#pragma unroll
    for (int i = 0; i < 8; ++i) CK[(size_t)bh * CKP + 64 + 8 * tid + i] = -LOG2E * (off + v[i]);
    __syncthreads();
}

__device__ __forceinline__ void attn_unit(LAS unsigned char* lds, const bf16* QKV, const float* CK, bf16* OB, const float* fnorm, int b, int h, int qb) {
    int tid_ = threadIdx.x; asm volatile("" : "+v"(tid_)); const int tid = tid_, lane = tid & 63, wid = __builtin_amdgcn_readfirstlane(tid >> 6), r32 = lane & 31, hi = lane >> 5;
    constexpr int KB = 9216, KOFF = 0, VOFF = 2 * KB, COFF = 4 * KB, WOFF = COFF + 512;
    LAS float* wsf = (LAS float*)(lds + WOFF) + wid * 64;
    const size_t rowb = (size_t)b * SEQ; const int q0 = qb * 256;
    const int NT = 1 + 4 * (qb + 1);
    const bf16* qp = QKV + (rowb + q0 + wid * 32 + r32) * QP + C_FQ + h * 64 + hi * 8;
    bf16x8 qr[4];
#pragma unroll
    for (int d0 = 0; d0 < 4; ++d0) qr[d0] = *(const bf16x8*)(qp + d0 * 16);
    const int srow = tid >> 3, sch = tid & 7;
    const float* ckp = CK + (size_t)(b * 8 + h) * CKP;
    u32x4 kreg, vreg; float creg = 0.f;
#define ATT_LOAD(t) do { const size_t r0_ = (t) == 0 ? (size_t)META0 : rowb + (size_t)((t) - 1) * 64; const bf16* p_ = QKV + (r0_ + srow) * QP + h * 64 + sch * 8; \
        kreg = *(const u32x4*)(p_ + C_FK); vreg = *(const u32x4*)(p_ + C_FV); if (tid < 64) creg = ckp[(t) * 64 + tid]; } while (0)
#define ATT_STORE(buf) do { *(LAS u32x4*)(lds + KOFF + (buf) * KB + srow * 144 + sch * 16) = kreg; *(LAS u32x4*)(lds + VOFF + (buf) * KB + srow * 144 + sch * 16) = vreg; \
        if (tid < 64) *(LAS float*)(lds + COFF + (buf) * 256 + tid * 4) = creg; } while (0)
    float m = -1e30f, l = 0.f; f32x16 o0 = {}, o1 = {};
    const int qrel = 32 * wid + r32;
    const int qq = (lane & 15) >> 2, pp = lane & 3, half = (lane >> 4) & 1;
    ATT_LOAD(0); ATT_STORE(0);
    for (int t = 0; t < NT; ++t) {
        const int buf = t & 1;
        if (t + 1 < NT) ATT_LOAD(t + 1);
        __syncthreads();
        const int jb = t - (NT - 4);
        const bool skip = (jb >= 0) && (64 * jb > 32 * wid + 31);
        if (!skip) {
            const LAS unsigned char* Kb = lds + KOFF + buf * KB; const LAS unsigned char* Vb = lds + VOFF + buf * KB; const LAS float* Cb = (const LAS float*)(lds + COFF + buf * 256);
            f32x16 p0, p1;
#pragma unroll
            for (int g = 0; g < 4; ++g) {
                const f32x4 c0 = *(const LAS f32x4*)(Cb + 8 * g + 4 * hi), c1 = *(const LAS f32x4*)(Cb + 32 + 8 * g + 4 * hi);
#pragma unroll
                for (int i = 0; i < 4; ++i) { p0[4 * g + i] = c0[i]; p1[4 * g + i] = c1[i]; }
            }
#pragma unroll
            for (int d0 = 0; d0 < 4; ++d0) {
                const bf16x8 a0 = *(const LAS bf16x8*)(Kb + r32 * 144 + (16 * d0 + 8 * hi) * 2);
                const bf16x8 a1 = *(const LAS bf16x8*)(Kb + (32 + r32) * 144 + (16 * d0 + 8 * hi) * 2);
                p0 = __builtin_amdgcn_mfma_f32_32x32x16_bf16(a0, qr[d0], p0, 0, 0, 0);
                p1 = __builtin_amdgcn_mfma_f32_32x32x16_bf16(a1, qr[d0], p1, 0, 0, 0);
            }
            if (jb >= 0 && 64 * jb + 63 > 32 * wid) {
#pragma unroll
                for (int r = 0; r < 16; ++r) { const int kv = 64 * jb + crow(r, hi); if (kv > qrel) p0[r] = -INFINITY; if (kv + 32 > qrel) p1[r] = -INFINITY; }
            }
            float mx = fmaxf(fmaxf(p0[0], p1[0]), fmaxf(p0[1], p1[1]));
#pragma unroll
            for (int r = 2; r < 16; r += 2) mx = fmaxf(fmaxf(mx, fmaxf(p0[r], p1[r])), fmaxf(p0[r + 1], p1[r + 1]));
            mx = fmaxf(mx, __shfl_xor(mx, 32));
            if (__any(mx > m + 8.0f)) {
                const float mn = fmaxf(m, mx);
                const float alpha = __builtin_amdgcn_exp2f(m - mn);
                m = mn; l *= alpha;
                if (hi == 0) wsf[r32] = alpha;
                LDS_WAIT();
#pragma unroll
                for (int g = 0; g < 4; ++g) {
                    const f32x4 a = *(const LAS f32x4*)(wsf + 8 * g + 4 * hi);
#pragma unroll
                    for (int i = 0; i < 4; ++i) { o0[4 * g + i] *= a[i]; o1[4 * g + i] *= a[i]; }
                }
            }
            float rsum = 0.f;
#pragma unroll
            for (int r = 0; r < 16; ++r) { p0[r] = __builtin_amdgcn_exp2f(p0[r] - m); p1[r] = __builtin_amdgcn_exp2f(p1[r] - m); rsum += p0[r] + p1[r]; }
            l += rsum;
            bf16x8 pa[4];
            { u32x4 w;
              w.x = pk2(p0[0], p0[1]); w.y = pk2(p0[2], p0[3]); w.z = pk2(p0[4], p0[5]); w.w = pk2(p0[6], p0[7]); pa[0] = __builtin_bit_cast(bf16x8, w);
              w.x = pk2(p0[8], p0[9]); w.y = pk2(p0[10], p0[11]); w.z = pk2(p0[12], p0[13]); w.w = pk2(p0[14], p0[15]); pa[1] = __builtin_bit_cast(bf16x8, w);
              w.x = pk2(p1[0], p1[1]); w.y = pk2(p1[2], p1[3]); w.z = pk2(p1[4], p1[5]); w.w = pk2(p1[6], p1[7]); pa[2] = __builtin_bit_cast(bf16x8, w);
              w.x = pk2(p1[8], p1[9]); w.y = pk2(p1[10], p1[11]); w.z = pk2(p1[12], p1[13]); w.w = pk2(p1[14], p1[15]); pa[3] = __builtin_bit_cast(bf16x8, w); }
#pragma unroll
            for (int j = 0; j < 4; ++j) {
                const LAS unsigned char* vp = Vb + (16 * j + 4 * hi + qq) * 144 + (16 * half + 4 * pp) * 2;
                const bf16x8 v0 = cat8(vtr(vp), vtr(vp + 8 * 144));
                const bf16x8 v1 = cat8(vtr(vp + 64), vtr(vp + 64 + 8 * 144));
                o0 = __builtin_amdgcn_mfma_f32_32x32x16_bf16(pa[j], v0, o0, 0, 0, 0);
                o1 = __builtin_amdgcn_mfma_f32_32x32x16_bf16(pa[j], v1, o1, 0, 0, 0);
            }
        }
        if (t + 1 < NT) ATT_STORE(buf ^ 1);
    }
#undef ATT_LOAD
#undef ATT_STORE
    l += __shfl_xor(l, 32);
    if (hi == 0) wsf[r32] = 1.0f / l;
    LDS_WAIT();
#pragma unroll
    for (int g = 0; g < 4; ++g) {
        const f32x4 a = *(const LAS f32x4*)(wsf + 8 * g + 4 * hi);
#pragma unroll
        for (int i = 0; i < 4; ++i) { o0[4 * g + i] *= a[i]; o1[4 * g + i] *= a[i]; }
    }
    const float w0 = fnorm[h * 64 + r32], w1 = fnorm[h * 64 + 32 + r32];
#pragma unroll
    for (int r = 0; r < 16; ++r) {
        float s = o0[r] * o0[r] + o1[r] * o1[r];
        s += __shfl_xor(s, 1); s += __shfl_xor(s, 2); s += __shfl_xor(s, 4); s += __shfl_xor(s, 8); s += __shfl_xor(s, 16);
        const float rs = rsqrtf(s * (1.0f / 64.0f) + EPS);
        bf16* op = OB + (rowb + q0 + wid * 32 + crow(r, hi)) * DM + 512 + h * 64 + r32;
        op[0] = f2bf(o0[r] * rs * w0); op[32] = f2bf(o1[r] * rs * w1);
    }
    __syncthreads();
}
__device__ __forceinline__ void meta_attn(const bf16* QKV, const float* CK, bf16* OB, const float* fnorm, int p) {
    int tid_ = threadIdx.x; asm volatile("" : "+v"(tid_)); const int lane = tid_ & 63, h = tid_ >> 6;
    const float q = bf2f(QKV[(size_t)(META0 + p) * QP + C_FQ + h * 64 + lane]);
    float sc[NMETA], vv[NMETA];
#pragma unroll
    for (int s = 0; s < NMETA; ++s) {
        sc[s] = q * bf2f(QKV[(size_t)(META0 + s) * QP + C_FK + h * 64 + lane]);
        vv[s] = bf2f(QKV[(size_t)(META0 + s) * QP + C_FV + h * 64 + lane]);
    }
    float m = -1e30f;
#pragma unroll
    for (int s = 0; s < NMETA; ++s) { sc[s] = (s <= p) ? wave_sum(sc[s]) + CK[(size_t)h * CKP + s] : -INFINITY; m = fmaxf(m, sc[s]); }
    float l = 0.f, o = 0.f;
#pragma unroll
    for (int s = 0; s < NMETA; ++s) { const float pw = __builtin_amdgcn_exp2f(sc[s] - m); l += pw; o += pw * vv[s]; }
    o /= l;
    const float ss = wave_sum(o * o);
    OB[(size_t)(META0 + p) * DM + 512 + h * 64 + lane] = f2bf(o * rsqrtf(ss * (1.0f / 64.0f) + EPS) * fnorm[h * 64 + lane]);
}
template <int NU> __device__ __forceinline__ void gla_readout_wave(const bf16* QKV, const float* UT, bf16* OB, const float* gnorm, const int* bhs, const int* ccs, const int* halfs, int lane) {
    asm volatile("" : "+v"(lane));
    const int r32 = lane & 31, hi = lane >> 5;
    int row0[NU], nvalid[NU], hq[NU]; const float* Sp[NU];
    f32x16 acc[NU][4];
#pragma unroll
    for (int u = 0; u < NU; ++u) {
        const int b = bhs[u] >> 2; hq[u] = bhs[u] & 3;
        row0[u] = ccs[u] == 0 ? META0 : b * SEQ + (ccs[u] - 1) * 64 + 32 * halfs[u]; nvalid[u] = ccs[u] == 0 ? NMETA : 32;
        Sp[u] = UT + (size_t)(bhs[u] * NCH + ccs[u]) * 8192;
#pragma unroll
        for (int blk = 0; blk < 4; ++blk) acc[u][blk] = (f32x16){};
    }
#pragma unroll
    for (int j = 0; j < 4; ++j)
#pragma unroll
        for (int u = 0; u < NU; ++u) {
            const bf16x8 bq = *(const bf16x8*)(QKV + (size_t)(row0[u] + r32) * QP + C_GQ + hq[u] * 64 + 16 * j + 8 * hi);
#pragma unroll
            for (int blk = 0; blk < 4; ++blk) {
                const float* sp = Sp[u] + (32 * blk + r32) * 64 + 16 * j + 8 * hi;
                const f32x4 s0 = *(const f32x4*)sp, s1 = *(const f32x4*)(sp + 4);
                u32x4 w; w.x = pk2(s0[0], s0[1]); w.y = pk2(s0[2], s0[3]); w.z = pk2(s1[0], s1[1]); w.w = pk2(s1[2], s1[3]);
                acc[u][blk] = __builtin_amdgcn_mfma_f32_32x32x16_bf16(__builtin_bit_cast(bf16x8, w), bq, acc[u][blk], 0, 0, 0);
            }
        }
#pragma unroll
    for (int u = 0; u < NU; ++u) {
        float ss = 0.f;
#pragma unroll
        for (int blk = 0; blk < 4; ++blk)
#pragma unroll
            for (int r = 0; r < 16; ++r) ss += acc[u][blk][r] * acc[u][blk][r];
        ss += __shfl_xor(ss, 32);
        const float rs = rsqrtf(ss * (1.0f / 128.0f) + EPS);
        if (r32 < nvalid[u]) {
            const size_t row = (size_t)row0[u] + r32; const int h = hq[u];
#pragma unroll
            for (int blk = 0; blk < 4; ++blk)
#pragma unroll
                for (int g = 0; g < 4; ++g) {
                    const int dv = 32 * blk + 8 * g + 4 * hi;
                    const u32x2 gt = *(const u32x2*)(QKV + row * QP + C_GR + h * 128 + dv);
                    const f32x4 wn = *(const f32x4*)(gnorm + h * 128 + dv);
                    const float g0 = __uint_as_float(gt.x << 16), g1 = __uint_as_float(gt.x & 0xffff0000u), g2 = __uint_as_float(gt.y << 16), g3 = __uint_as_float(gt.y & 0xffff0000u);
                    u32x2 w;
                    w.x = pk2(acc[u][blk][4 * g] * rs * wn[0] * siluf(g0), acc[u][blk][4 * g + 1] * rs * wn[1] * siluf(g1));
                    w.y = pk2(acc[u][blk][4 * g + 2] * rs * wn[2] * siluf(g2), acc[u][blk][4 * g + 3] * rs * wn[3] * siluf(g3));
                    *(u32x2*)(OB + row * DM + h * 128 + dv) = w;
                }
        }
    }
}

__device__ __forceinline__ void gla_readout_chunk(const bf16* QKV, const float* UT, bf16* OB, const float* gnorm, int bh, int cc, int lane) {
    asm volatile("" : "+v"(lane));
    const int r32 = lane & 31, hi = lane >> 5, b = bh >> 2, h = bh & 3;
    const int row0 = b * SEQ + (cc - 1) * 64;
    const float* Sp = UT + (size_t)(bh * NCH + cc) * 8192;
    f32x16 acc[2][4];
#pragma unroll
    for (int u = 0; u < 2; ++u)
#pragma unroll
        for (int blk = 0; blk < 4; ++blk) acc[u][blk] = (f32x16){};
#pragma unroll 1
    for (int j = 0; j < 4; ++j) {
        const bf16x8 bq0 = *(const bf16x8*)(QKV + (size_t)(row0 + r32) * QP + C_GQ + h * 64 + 16 * j + 8 * hi);
        const bf16x8 bq1 = *(const bf16x8*)(QKV + (size_t)(row0 + 32 + r32) * QP + C_GQ + h * 64 + 16 * j + 8 * hi);
#pragma unroll
        for (int blk = 0; blk < 4; ++blk) {
            const float* sp = Sp + (32 * blk + r32) * 64 + 16 * j + 8 * hi;
            const f32x4 s0 = *(const f32x4*)sp, s1 = *(const f32x4*)(sp + 4);
            u32x4 w; w.x = pk2(s0[0], s0[1]); w.y = pk2(s0[2], s0[3]); w.z = pk2(s1[0], s1[1]); w.w = pk2(s1[2], s1[3]);
            const bf16x8 sa = __builtin_bit_cast(bf16x8, w);
            acc[0][blk] = __builtin_amdgcn_mfma_f32_32x32x16_bf16(sa, bq0, acc[0][blk], 0, 0, 0);
            acc[1][blk] = __builtin_amdgcn_mfma_f32_32x32x16_bf16(sa, bq1, acc[1][blk], 0, 0, 0);
        }
    }
#pragma unroll
    for (int u = 0; u < 2; ++u) {
        float ss = 0.f;
#pragma unroll
        for (int blk = 0; blk < 4; ++blk)
#pragma unroll
            for (int r = 0; r < 16; ++r) ss += acc[u][blk][r] * acc[u][blk][r];
        ss += __shfl_xor(ss, 32);
        const float rs = rsqrtf(ss * (1.0f / 128.0f) + EPS);
        const size_t row = (size_t)row0 + 32 * u + r32;
#pragma unroll
        for (int blk = 0; blk < 4; ++blk)
#pragma unroll
            for (int g = 0; g < 4; ++g) {
                const int dv = 32 * blk + 8 * g + 4 * hi;
                const u32x2 gt = *(const u32x2*)(QKV + row * QP + C_GR + h * 128 + dv);
                const f32x4 wn = *(const f32x4*)(gnorm + h * 128 + dv);
                const float g0 = __uint_as_float(gt.x << 16), g1 = __uint_as_float(gt.x & 0xffff0000u), g2 = __uint_as_float(gt.y << 16), g3 = __uint_as_float(gt.y & 0xffff0000u);
                u32x2 w;
                w.x = pk2(acc[u][blk][4 * g] * rs * wn[0] * siluf(g0), acc[u][blk][4 * g + 1] * rs * wn[1] * siluf(g1));
                w.y = pk2(acc[u][blk][4 * g + 2] * rs * wn[2] * siluf(g2), acc[u][blk][4 * g + 3] * rs * wn[3] * siluf(g3));
                *(u32x2*)(OB + row * DM + h * 128 + dv) = w;
            }
    }
}

#define FRESH() KArgs ka_ = kargs(); Args a; a.x = gptr(ka_->x); a.meta = gptr(ka_->meta); a.attn_norm = gptr(ka_->attn_norm); a.w_in = gptr(ka_->w_in); a.w_au = gptr(ka_->w_au); a.b_alpha = gptr(ka_->b_alpha); a.b_forget = gptr(ka_->b_forget); a.gla_norm = gptr(ka_->gla_norm); a.fox_norm = gptr(ka_->fox_norm); a.w_out = gptr(ka_->w_out); a.ffn_norm = gptr(ka_->ffn_norm); a.w_up = gptr(ka_->w_up); a.conv_w = gptr(ka_->conv_w); a.conv_b = gptr(ka_->conv_b); a.w_down = gptr(ka_->w_down); a.final_norm = gptr(ka_->final_norm); a.out = gptr(ka_->out); a.ws = gptr(ka_->ws); unsigned char* ws = a.ws; \
    bf16* HB = (bf16*)(ws + WS_HB); bf16* OB = (bf16*)(ws + WS_OB); bf16* QKV = (bf16*)(ws + WS_QKV); bf16* A2 = (bf16*)(ws + WS_QKV); \
    float* UT = (float*)(ws + WS_UT); float* HF = (float*)(ws + WS_UT); float* HL = (float*)(ws + WS_UT + HFL_SIZE); \
    float* SM = (float*)(ws + WS_SM); float* CK = (float*)(ws + WS_CK); float* DEC = (float*)(ws + WS_DEC); float* HM = (float*)(ws + WS_HM); float* SSQ = (float*)(ws + WS_SSQ); \
    unsigned char* wl = ws + WS_W + (size_t)L * WL_SIZE; \
    (void)HB; (void)OB; (void)QKV; (void)A2; (void)UT; (void)HF; (void)HL; (void)SM; (void)CK; (void)DEC; (void)HM; (void)SSQ; (void)wl; \
    int G_ = gridDim.x, bx_ = blockIdx.x; asm volatile("" : "+s"(G_), "+s"(bx_)); const int G = G_, bx = bx_; (void)G; (void)bx; \
    int tid_ = threadIdx.x; asm volatile("" : "+v"(tid_)); const int tid = tid_, lane = tid & 63, wid = __builtin_amdgcn_readfirstlane(tid >> 6); \
    const int gw = bx * 8 + wid, NGW = G * 8, gt = bx * 512 + tid, NGT = G * 512; (void)lane; (void)gw; (void)NGW; (void)gt; (void)NGT;
#ifndef REP_A
#define REP_A 1
#endif
#ifndef REP_CA
#define REP_CA 1
#endif
#ifndef REP_F
#define REP_F 1
#endif
#ifndef REP_B
#define REP_B 1
#endif
#ifndef REP_D
#define REP_D 1
#endif
#define GSYNC_CG() do { asm volatile("s_waitcnt vmcnt(0) lgkmcnt(0)" ::: "memory"); grid.sync(); __builtin_amdgcn_fence(__ATOMIC_ACQUIRE, "agent"); asm volatile("s_waitcnt vmcnt(0)" ::: "memory"); } while (0)
#ifdef PROBE_PH
#define PH_END(id) do { const unsigned long long tn_ = __builtin_amdgcn_s_memrealtime(); if ((PROBE_PH >> (id)) & 1) tsync += tn_ - tlast; tlast = tn_; } while (0)
#else
#define PH_END(id) do {} while (0)
#endif
#ifdef PROBE_SYNC
#define GSYNC() do { const unsigned long long t0_ = __builtin_amdgcn_s_memrealtime(); xcd_barrier(xbar); tsync += __builtin_amdgcn_s_memrealtime() - t0_; } while (0)
#else
#define GSYNC() do { XcdBarrier xb_; xb_.bar = (unsigned*)(gptr(kargs()->ws) + WS_BAR); xb_.x = xb_xcc_id(); xb_.st = (volatile LAS unsigned*)(lds + HALO_OFF + 8192 + 1024); xcd_barrier(xb_); } while (0)
#endif
__global__ void __launch_bounds__(512, 2) fwd_kernel(Args a_unused) {
    extern __shared__ __attribute__((aligned(16))) unsigned char lds_raw[];
    LAS unsigned char* lds = (LAS unsigned char*)lds_raw;
    cg::grid_group grid = cg::this_grid();
#if defined(PROBE_SYNC) || defined(PROBE_PH)
    unsigned long long tsync = 0ull, tlast = __builtin_amdgcn_s_memrealtime(); (void)tlast;
#endif
    volatile LAS unsigned* xst = (volatile LAS unsigned*)(lds + HALO_OFF + 8192 + 1024);
    if (threadIdx.x < 2) xst[threadIdx.x] = 0u;
    __syncthreads();
    (void)xcd_barrier_post((unsigned*)(gptr(kargs()->ws) + WS_BAR), xst);
#ifndef REP_P
#define REP_P 1
#endif
    for (int rep = 0; rep < REP_P; ++rep) {
        const int L = 0; FRESH();
        LAS float* scr = (LAS float*)(lds + wid * 16384);
        constexpr int I_IN = 16 * (NINP / 32), I_OUT = 16 * 32, I_UP = 16 * (NUP / 32), I_DN = (DFF / 64) * 32, I_L = I_IN + I_OUT + I_UP + I_DN;
        for (int it = gw; it < DEPTH * I_L; it += NGW) {
            const int L = it / I_L; int r = it % I_L;
            unsigned char* wl = ws + WS_W + (size_t)L * WL_SIZE;
            if (r < I_IN) { const int nb = NINP / 32; tr_item(a.w_in + (size_t)L * DM * 3096, 3096, (bf16*)(wl + WL_IN), DM, a.attn_norm + L * DM, 0, scr, 64 * (r / nb), 32 * (r % nb), lane); continue; } r -= I_IN;
            if (r < I_OUT) { tr_item(a.w_out + (size_t)L * DM * DM, DM, (bf16*)(wl + WL_OUT), DM, nullptr, 1, scr, 64 * (r / 32), 32 * (r % 32), lane); continue; } r -= I_OUT;
            if (r < I_UP) { const int nb = NUP / 32; tr_item(a.w_up + (size_t)L * DM * NUP, NUP, (bf16*)(wl + WL_UP), DM, a.ffn_norm + L * DM, 2, scr, 64 * (r / nb), 32 * (r % nb), lane); continue; } r -= I_UP;
            tr_item(a.w_down + (size_t)L * DFF * DM, DM, (bf16*)(wl + WL_DN), DFF, nullptr, 3, scr, 64 * (r / 32), 32 * (r % 32), lane);
        }
        for (int i = gt; i < (256 - NMETA) * 4; i += NGT) SSQ[(size_t)(META0 + NMETA) * 4 + i] = 0.f;
        for (int r = gw; r < MREAL + 256; r += NGW) {
            if (r < MREAL) row_to_bf16(a.x + (size_t)r * DM, HB + (size_t)r * DM, SSQ + (size_t)r * 4, nullptr, lane);
            else if (r < MREAL + NMETA) row_to_bf16(a.meta + (size_t)(r - MREAL) * DM, HB + (size_t)r * DM, SSQ + (size_t)r * 4, HM + (size_t)(r - MREAL) * DM, lane);
            else {
#pragma unroll
                for (int j = 0; j < 4; ++j) { ((f32x4*)(HM + (size_t)(r - MREAL) * DM) + lane)[64 * j] = (f32x4){0.f, 0.f, 0.f, 0.f};
                    ((u32x2*)(HB + (size_t)r * DM) + lane)[64 * j] = (u32x2){0u, 0u}; ((u32x2*)(OB + (size_t)r * DM) + lane)[64 * j] = (u32x2){0u, 0u}; }
            }
        }
    }
    GSYNC_CG(); PH_END(0);

    for (int L = 0; L < DEPTH; ++L) {
#ifndef SKIP_A
        {
            FRESH();
            pg8::Gemm g{HB, (const bf16*)(wl + WL_IN), MROWS, NINP, DM}; pg8::StaticOrder S; S.init(MROWS, NINP, G, bx);
            EpiIn E{2 * L};
            for (int rep = 0; rep < REP_A; ++rep) pg8::gemm_phase<EpiIn, pg8::StaticOrder, true, true>(lds, g, S, E);
        }
#endif
        GSYNC(); PH_END(1);
#ifndef SKIP_B
        { FRESH();
        for (int rep = 0; rep < REP_B; ++rep) {
        for (int gr = bx; gr < 16 * NCH; gr += G) gla_u_group<2>(lds, QKV, SM, a.w_au + (size_t)L * 16 * 256, a.b_alpha + L * 256, UT, DEC, gr);
        for (int u = (G == 256) ? bx - 64 + ((bx < 64) ? 256 : 0) : bx; u < 64; u += G) fox_cumsum_unit(lds, SM, a.b_forget + L * 8, CK, u);
        }
        }
#endif
        GSYNC(); PH_END(2);
#ifndef SKIP_CS
        { FRESH();
        for (int e = gt; e < 32 * 2048; e += NGT) {
            const int bh = e >> 11, rem = (e & 2047) * 4, dk = rem & 63;
            float* up = UT + (size_t)bh * NCH * 8192 + rem; const float* dp = DEC + (size_t)bh * NCH * 64 + dk;
            f32x4 Sv = *(const f32x4*)up;
            for (int c0 = 1; c0 <= 64; c0 += 8) {
                f32x4 uu[8], dd[8];
#pragma unroll
                for (int i = 0; i < 8; ++i) { uu[i] = *(const f32x4*)(up + (size_t)(c0 + i) * 8192); dd[i] = *(const f32x4*)(dp + (c0 + i) * 64); }
#pragma unroll
                for (int i = 0; i < 8; ++i) { Sv = dd[i] * Sv + uu[i]; *(f32x4*)(up + (size_t)(c0 + i) * 8192) = Sv; }
            }
        }
#ifdef REP_SCAN
        for (int e = gt; e < 32 * 2048; e += NGT) {
            const int bh = e >> 11, rem = (e & 2047) * 4, dk = rem & 63;
            float* up = UT + (size_t)bh * NCH * 8192 + rem; const float* dp = DEC + (size_t)bh * NCH * 64 + dk;
            for (int c0 = 1; c0 <= 64; c0 += 8) {
                f32x4 uu[8], dd[8];
#pragma unroll
                for (int i = 0; i < 8; ++i) { uu[i] = *(const f32x4*)(up + (size_t)(c0 + i) * 8192); dd[i] = *(const f32x4*)(dp + (c0 + i) * 64); }
#pragma unroll
                for (int i = 0; i < 8; ++i) { *(f32x4*)(up + (size_t)(c0 + i) * 8192) = uu[i] + dd[i] * 0.f; }
            }
        }
#endif
        }
        { FRESH();
        for (int rep = 0; rep < REP_CA; ++rep)
        for (int v0 = bx; v0 < 256; v0 += G) {
            const int v = (G == 256) ? (v0 & 7) * 32 + (v0 >> 3) : v0;
            const int bhh = v >> 2, s = v & 3;
#pragma unroll 1
            for (int i = 0; i < 4; ++i) {
                const int qb = (i == 0) ? s : (i == 1) ? 7 - s : (i == 2) ? 8 + s : 15 - s;
                attn_unit(lds, QKV, CK, OB, a.fox_norm + L * 512, bhh >> 3, bhh & 7, qb);
            }
        }
#endif
#ifndef SKIP_CM
        }
        { FRESH();
#ifndef REP_CM
#define REP_CM 1
#endif
        for (int rep = 0; rep < REP_CM; ++rep)
        if (bx < NMETA) meta_attn(QKV, CK, OB, a.fox_norm + L * 512, bx);
        if (bx >= NMETA && bx < NMETA + 4 && wid == 0) { const int bhs[1] = {bx - NMETA}, ccs[1] = {0}, hfs[1] = {0}; gla_readout_wave<1>(QKV, UT, OB, a.gla_norm + L * 512, bhs, ccs, hfs, lane); }
        }
#endif
        GSYNC(); PH_END(3);
#ifndef SKIP_D
        { FRESH();
        for (int rep = 0; rep < REP_D; ++rep)
        for (int wu = gw; wu < 32 * 64; wu += NGW) gla_readout_chunk(QKV, UT, OB, a.gla_norm + L * 512, wu >> 6, 1 + (wu & 63), lane);
        }
#endif
        GSYNC(); PH_END(4);
#ifndef SKIP_E
        {
            FRESH();
            meta_rowgemm(OB + (size_t)META0 * DM, DM, (const bf16*)(wl + WL_OUT), DM, HM, HB, G, bx);
            pg8::Gemm g{OB, (const bf16*)(wl + WL_OUT), MREAL, DM, DM}; pg8::StaticOrder S; S.init(MREAL, DM, G, bx);
            if (L == 0) { EpiRes<true, false> E{2 * L + 1}; pg8::gemm_phase<EpiRes<true, false>, pg8::StaticOrder, true, true>(lds, g, S, E); }
            else { EpiRes<false, false> E{2 * L + 1}; pg8::gemm_phase<EpiRes<false, false>, pg8::StaticOrder, true, true>(lds, g, S, E); }
        }
#endif
        GSYNC(); PH_END(5);
#ifndef SKIP_F
        {
            FRESH();
            meta_up(lds, HB, (const bf16*)(wl + WL_UP), HM, a.conv_w + (size_t)L * 3 * NUP, a.conv_b + (size_t)L * NUP, A2, HL, G, bx);
            pg8::Gemm g{HB, (const bf16*)(wl + WL_UP), MREAL, NUP, DM}; pg8::StaticOrder S; S.init(MREAL, NUP, G, bx);
            EpiUp E{L};
            for (int rep = 0; rep < REP_F; ++rep) pg8::gemm_phase<EpiUp, pg8::StaticOrder, true, true>(lds, g, S, E);
        }
#endif
        GSYNC(); PH_END(6);
#ifndef SKIP_H
        {
            FRESH();
            const float* cw = a.conv_w + (size_t)L * 3 * NUP; const float* cb = a.conv_b + (size_t)L * NUP;
            { int pm = 0;
              for (int ui = 0; so_next_pm(MREAL / 256, DM / 256, G, bx, ui, pm); ++ui) {
                for (int i = tid; i < 2 * (DFF / 4); i += 512) {
                    const int c4 = i % (DFF / 4), rr = i / (DFF / 4);
                    const int ch = 4 * c4;
                    f32x4 hc[2];
#pragma unroll
                    for (int bj = 0; bj < 2; ++bj) {
                        const int c = bj * DFF + ch;
                        f32x4 P0 = {0.f, 0.f, 0.f, 0.f}, P1 = P0;
                        if (pm != 128) { const int src = (pm % 16 == 0) ? 128 : pm - 1; P0 = *(const f32x4*)(HL + (size_t)(src * 2) * NUP + c); P1 = *(const f32x4*)(HL + (size_t)(src * 2 + 1) * NUP + c); }
                        const f32x4 H0 = *(const f32x4*)(HF + (size_t)(pm * 2) * NUP + c), H1 = *(const f32x4*)(HF + (size_t)(pm * 2 + 1) * NUP + c);
                        const f32x4 x2 = rr == 0 ? P0 : P1, x1 = rr == 0 ? P1 : H0, x0 = rr == 0 ? H0 : H1;
                        hc[bj] = *(const f32x4*)(cb + c) + *(const f32x4*)(cw + c) * x2 + *(const f32x4*)(cw + NUP + c) * x1 + *(const f32x4*)(cw + 2 * NUP + c) * x0;
                    }
                    u32x2 w;
                    w.x = pk2(siluf(hc[1][0]) * hc[0][0], siluf(hc[1][1]) * hc[0][1]);
                    w.y = pk2(siluf(hc[1][2]) * hc[0][2], siluf(hc[1][3]) * hc[0][3]);
                    *(u32x2*)(A2 + (size_t)(pm * 256 + rr) * DFF + ch) = w;
                }
              }
            }
            asm volatile("s_waitcnt vmcnt(0)" ::: "memory"); __syncthreads();
            meta_rowgemm(A2 + (size_t)META0 * DFF, DFF, (const bf16*)(wl + WL_DN), DFF, HM, HB, G, bx);
            pg8::Gemm g{A2, (const bf16*)(wl + WL_DN), MREAL, DM, DFF}; pg8::StaticOrder S; S.init(MREAL, DM, G, bx);
            if (L == DEPTH - 1) { EpiRes<false, true> E{2 * L + 2}; pg8::gemm_phase<EpiRes<false, true>, pg8::StaticOrder, true, true>(lds, g, S, E); }
            else { EpiRes<false, false> E{2 * L + 2}; pg8::gemm_phase<EpiRes<false, false>, pg8::StaticOrder, true, true>(lds, g, S, E); }
        }
#endif
        GSYNC(); PH_END(7);
    }
    {
        const int L = 0; FRESH();
        const float* ssq = ssq_arr(ws, 8);
        for (int r = gw; r < MREAL; r += NGW) {
            const float rs = row_rstd(ssq, r);
            f32x4* p = (f32x4*)(a.out + (size_t)r * DM) + lane; const f32x4* wn = (const f32x4*)a.final_norm + lane;
#pragma unroll
            for (int j = 0; j < 4; ++j) p[64 * j] = p[64 * j] * rs * wn[64 * j];
        }
#if defined(PROBE_SYNC) || defined(PROBE_PH)
        asm volatile("s_waitcnt vmcnt(0)" ::: "memory"); __syncthreads();
        if (bx == PROBE_BLOCK && tid == 0) a.out[(size_t)PROBE_BLOCK * 16 * DM * 0 + 5] += floorf((float)tsync * 0.0002f + 0.5f);
#endif
    }
}

extern "C" void kernel_launch(void* const* d_in, const int* in_sizes, int n_in, void* d_out, int out_size, void* d_ws, size_t ws_size, hipStream_t stream) {
    static int grid = 0;
    if (grid == 0) {
        if (n_in != 16 || out_size != MREAL * DM || ws_size < WS_END) { fprintf(stderr, "kernel_launch: unexpected problem (n_in %d out %d ws %zu, need %zu)\n", n_in, out_size, ws_size, (size_t)WS_END); grid = -1; return; }
        int dev = 0, cus = 0, per = 0;
        (void)hipGetDevice(&dev); (void)hipDeviceGetAttribute(&cus, hipDeviceAttributeMultiprocessorCount, dev);
        (void)hipFuncSetAttribute((const void*)fwd_kernel, hipFuncAttributeMaxDynamicSharedMemorySize, LDS_BYTES);
        (void)hipOccupancyMaxActiveBlocksPerMultiprocessor(&per, (const void*)fwd_kernel, 512, LDS_BYTES);
        if (per < 1) per = 1;
        grid = cus * per;
        fprintf(stderr, "kernel_launch: grid %d (cus %d x %d), ws %zu\n", grid, cus, per, ws_size);
    }
    if (grid < 0) return;
    Args a{};
    const float** f = (const float**)&a;
    for (int i = 0; i < 16; ++i) f[i] = (const float*)d_in[i];
    a.out = (float*)d_out; a.ws = (unsigned char*)d_ws;
    (void)hipMemsetAsync((unsigned char*)d_ws + WS_BAR, 0, BAR_BYTES, stream);
    void* args[] = {&a};
    hipError_t e = hipLaunchCooperativeKernel((const void*)fwd_kernel, dim3(grid), dim3(512), args, LDS_BYTES, stream);
    if (e != hipSuccess) fprintf(stderr, "cooperative launch failed: %s (grid %d)\n", hipGetErrorString(e), grid);
}
```

```cpp
#include <hip/hip_runtime.h>
#include <hip/hip_cooperative_groups.h>
#include <cstdio>
#include <cstdint>
namespace cg = cooperative_groups;
namespace pg8 {
#define PG8_LAS __attribute__((address_space(3)))
typedef unsigned short bf16_t;
typedef short bf16x8 __attribute__((ext_vector_type(8)));
typedef float f32x4 __attribute__((ext_vector_type(4)));
typedef unsigned u32x4 __attribute__((ext_vector_type(4)));
constexpr int BM = 256, BK = 64, HALF = 128, HTB = HALF * BK * 2  , STAGE_BYTES = 8 * HTB, NXCD = 8, WGM = 8;

__host__ __device__ __forceinline__ int lds_byte(int r, int c) { const int st = (r >> 4) * 2 + (c >> 5), rr = r & 15, cc = c & 31, ob = rr * 64 + cc * 2; return st * 1024 + (ob ^ (((ob >> 9) & 1) << 5)); }
__host__ __device__ __forceinline__ void stage_rc(int b, int& R, int& C) { const int st = b / 1024, sb = b % 1024, swz = sb ^ (((sb >> 9) & 1) << 5); R = (st >> 1) * 16 + swz / 64; C = (st & 1) * 32 + (swz % 64) / 2; }
__host__ __device__ __forceinline__ int perm32(int rho) { const int n = rho >> 4, i = rho & 15; return 8 * (i >> 2) + 4 * n + (i & 3); }

struct Unit { int pm, pn; };
struct Gemm { const bf16_t* A; const bf16_t* Bt; int M, N, K; };

struct StaticOrder {
    int nM, nN, nwg, G, c;
    __host__ __device__ void init(int M, int N, int G_, int c_) { nM = M / BM; nN = N / BM; nwg = nM * nN; G = G_; c = c_; }
    __host__ __device__ bool next(int i, Unit& u) const {
        const long L = (long)i * G + c; if (L >= nwg) return false;
        int wgid = (int)L; { const int q = nwg / NXCD, r = nwg % NXCD, xcd = wgid % NXCD, off = wgid / NXCD; wgid = (xcd < r ? xcd * (q + 1) : r * (q + 1) + (xcd - r) * q) + off; }
        const int nig = WGM * nN, gid = wgid / nig, fm = gid * WGM, gsz = (nM - fm) < WGM ? (nM - fm) : WGM;
        u.pm = fm + ((wgid % nig) % gsz); u.pn = (wgid % nig) / gsz; return true;
    }
    __device__ __forceinline__ void a_ready(const Unit&) const {}
    __device__ __forceinline__ void done(const Unit&) const {}
};

__device__ __forceinline__ unsigned cvt_pk_bf16(float lo, float hi) { unsigned r; asm volatile("v_cvt_pk_bf16_f32 %0, %1, %2" : "=v"(r) : "v"(lo), "v"(hi)); return r; }
typedef float f32x2 __attribute__((ext_vector_type(2)));
template <class Epi, class Sched, bool ALIGN_EPI = false, bool SP2 = false>
__device__ __forceinline__ void gemm_phase(PG8_LAS unsigned char* lds, const Gemm g, const Sched& S, const Epi& E) {
    int tid_ = threadIdx.x; asm volatile("" : "+v"(tid_)); const int tid = tid_, wid = __builtin_amdgcn_readfirstlane(tid >> 6), lane = tid & 63, wr = wid >> 2, wc = wid & 3, fr = lane & 15, fq = lane >> 4;
    const int K = g.K, nt = K / BK;
    unsigned voffA[2], voffB[2];
#pragma unroll
    for (int i = 0; i < 2; ++i) { int R, C; stage_rc(tid * 16 + i * 8192, R, C); const int Rb = Epi::PERM ? ((R & ~31) + perm32(R & 31)) : R;
        voffA[i] = (unsigned)(R * K + C) * 2u; voffB[i] = (unsigned)(Rb * K + C) * 2u; }
    const size_t kstep = (size_t)(BK * 2);
    const size_t hstep = (size_t)HALF * K * 2;
    const size_t tstep = 2 * hstep;
    const unsigned ldsw = (unsigned)wid * 1024u;
    const int aoff = lds_byte(wr * 64 + fr, fq * 8), boff = lds_byte(wc * 32 + fr, fq * 8);
#define PG8_SA(b, h) (((b) * 2 + (h)) * HTB)
#define PG8_SB(b, h) ((4 + (b) * 2 + (h)) * HTB)
#define PG8_STAGE(bufoff, gbase, voff) do { _Pragma("unroll") for (int _i = 0; _i < 2; ++_i) \
        __builtin_amdgcn_global_load_lds((const unsigned*)((const char*)(gbase) + (voff)[_i]), (PG8_LAS unsigned*)(lds + (bufoff) + ldsw + _i * 8192), 16, 0, 0); } while (0)
#define PG8_LDA(dst, b, h) do { _Pragma("unroll") for (int m = 0; m < 4; ++m) _Pragma("unroll") for (int k = 0; k < 2; ++k) dst[m][k] = *(const PG8_LAS bf16x8*)(lds + PG8_SA(b, h) + aoff + m * 2048 + k * 1024); } while (0)
#define PG8_LDB(dst, b, h) do { _Pragma("unroll") for (int n = 0; n < 2; ++n) _Pragma("unroll") for (int k = 0; k < 2; ++k) dst[n][k] = *(const PG8_LAS bf16x8*)(lds + PG8_SB(b, h) + boff + n * 2048 + k * 1024); } while (0)
#define PG8_MMA(ai, bj, At, Bt) do { __builtin_amdgcn_s_setprio(1); _Pragma("unroll") for (int m = 0; m < 4; ++m) _Pragma("unroll") for (int n = 0; n < 2; ++n) _Pragma("unroll") for (int k = 0; k < 2; ++k) \
        acc[ai][bj][m][n] = __builtin_amdgcn_mfma_f32_16x16x32_bf16(Bt[n][k], At[m][k], acc[ai][bj][m][n], 0, 0, 0); __builtin_amdgcn_s_setprio(0); } while (0)
#define PG8_WAIT_V(n) asm volatile("s_waitcnt vmcnt(" #n ")" ::: "memory")
#define PG8_WAIT_L(n) asm volatile("s_waitcnt lgkmcnt(" #n ")" ::: "memory")
#define PG8_BAR __builtin_amdgcn_s_barrier()
#define PG8_SCHED __builtin_amdgcn_sched_barrier(0)
    Unit cur, nxt; int ui = 0;
    if (!S.next(0, cur)) return;
    f32x4 acc[2][2][4][2];
#pragma unroll
    for (int a = 0; a < 2; ++a)
#pragma unroll
        for (int b = 0; b < 2; ++b)
#pragma unroll
            for (int m = 0; m < 4; ++m)
#pragma unroll
                for (int n = 0; n < 2; ++n) acc[a][b][m][n] = (f32x4){0.f, 0.f, 0.f, 0.f};
    bf16x8 At[4][2], B0[2][2], B1[2][2];
    const char* cA = (const char*)g.A + (size_t)cur.pm * tstep; const char* cB = (const char*)g.Bt + (size_t)cur.pn * tstep;
    S.a_ready(cur);
    if constexpr (SP2) {
        PG8_STAGE(PG8_SB(0, 0), cB, voffB); PG8_STAGE(PG8_SB(0, 1), cB + hstep, voffB); PG8_STAGE(PG8_SA(0, 0), cA, voffA); PG8_STAGE(PG8_SA(0, 1), cA + hstep, voffA);
        if (wr == 1) PG8_BAR;
        PG8_WAIT_V(2); PG8_BAR;
        PG8_STAGE(PG8_SB(1, 0), cB + kstep, voffB); PG8_STAGE(PG8_SA(1, 0), cA + kstep, voffA); PG8_STAGE(PG8_SB(1, 1), cB + hstep + kstep, voffB);
        PG8_WAIT_V(6); PG8_BAR;
    } else {
        PG8_STAGE(PG8_SB(0, 0), cB, voffB); PG8_STAGE(PG8_SA(0, 0), cA, voffA); PG8_STAGE(PG8_SB(0, 1), cB + hstep, voffB); PG8_STAGE(PG8_SA(0, 1), cA + hstep, voffA);
        if (wr == 1) PG8_BAR;
        PG8_WAIT_V(4); PG8_BAR;
        PG8_STAGE(PG8_SB(1, 0), cB + kstep, voffB); PG8_STAGE(PG8_SA(1, 0), cA + kstep, voffA); PG8_STAGE(PG8_SB(1, 1), cB + hstep + kstep, voffB);
        PG8_WAIT_V(6); PG8_BAR;
    }
    for (;;) {
        const bool has_next = S.next(ui + 1, nxt);
        const char* nA = has_next ? (const char*)g.A + (size_t)nxt.pm * tstep : cA; const char* nB = has_next ? (const char*)g.Bt + (size_t)nxt.pn * tstep : cB;
        for (int t = 0; t < nt; t += 2) {
            const bool last = (t == nt - 2);
            const char* a1 = cA + (size_t)(t + 1) * kstep;
            const char* a2 = last ? nA : cA + (size_t)(t + 2) * kstep; const char* b2 = last ? nB : cB + (size_t)(t + 2) * kstep;
            const char* a3 = a2 + kstep; const char* b3 = b2 + kstep;
            if (last && has_next) S.a_ready(nxt);
            if constexpr (SP2) {
            PG8_LDB(B0, 0, 0); PG8_LDB(B1, 0, 1); PG8_SCHED; PG8_LDA(At, 0, 0); PG8_STAGE(PG8_SA(1, 1), a1 + hstep, voffA);
            PG8_WAIT_V(8); PG8_WAIT_L(0); PG8_BAR; PG8_MMA(0, 0, At, B0); PG8_MMA(0, 1, At, B1); PG8_BAR; PG8_SCHED;
            PG8_LDA(At, 0, 1); PG8_STAGE(PG8_SB(0, 0), b2, voffB); PG8_STAGE(PG8_SB(0, 1), b2 + hstep, voffB); PG8_STAGE(PG8_SA(0, 0), a2, voffA);
            PG8_WAIT_V(8); PG8_WAIT_L(0); PG8_BAR; PG8_MMA(1, 0, At, B0); PG8_MMA(1, 1, At, B1); PG8_BAR; PG8_SCHED;
            PG8_LDB(B0, 1, 0); PG8_LDB(B1, 1, 1); PG8_SCHED; PG8_LDA(At, 1, 0); PG8_STAGE(PG8_SA(0, 1), a2 + hstep, voffA);
            PG8_WAIT_V(8); PG8_WAIT_L(0); PG8_BAR; PG8_MMA(0, 0, At, B0); PG8_MMA(0, 1, At, B1); PG8_BAR; PG8_SCHED;
            PG8_LDA(At, 1, 1); PG8_STAGE(PG8_SB(1, 0), b3, voffB); PG8_STAGE(PG8_SB(1, 1), b3 + hstep, voffB); PG8_STAGE(PG8_SA(1, 0), a3, voffA);
            PG8_WAIT_V(8); PG8_WAIT_L(0); PG8_BAR; PG8_MMA(1, 0, At, B0); PG8_MMA(1, 1, At, B1); PG8_BAR; PG8_SCHED;
            } else {
            PG8_LDB(B0, 0, 0); PG8_SCHED; PG8_LDA(At, 0, 0); PG8_STAGE(PG8_SA(1, 1), a1 + hstep, voffA);
            PG8_WAIT_L(8); PG8_BAR; PG8_WAIT_L(0); PG8_MMA(0, 0, At, B0); PG8_BAR; PG8_SCHED;
            PG8_LDB(B1, 0, 1); PG8_STAGE(PG8_SB(0, 0), b2, voffB);
            PG8_BAR; PG8_WAIT_L(0); PG8_MMA(0, 1, At, B1); PG8_BAR;
            PG8_LDA(At, 0, 1); PG8_STAGE(PG8_SA(0, 0), a2, voffA);
            PG8_BAR; PG8_WAIT_L(0); PG8_MMA(1, 0, At, B0); PG8_BAR; PG8_SCHED;
            PG8_STAGE(PG8_SB(0, 1), b2 + hstep, voffB);
            PG8_WAIT_V(6); PG8_BAR; PG8_MMA(1, 1, At, B1); PG8_BAR;
            PG8_LDB(B0, 1, 0); PG8_SCHED; PG8_LDA(At, 1, 0); PG8_STAGE(PG8_SA(0, 1), a2 + hstep, voffA);
            PG8_WAIT_L(8); PG8_BAR; PG8_WAIT_L(0); PG8_MMA(0, 0, At, B0); PG8_BAR; PG8_SCHED;
            PG8_LDB(B1, 1, 1); PG8_STAGE(PG8_SB(1, 0), b3, voffB);
            PG8_BAR; PG8_WAIT_L(0); PG8_MMA(0, 1, At, B1); PG8_BAR;
            PG8_LDA(At, 1, 1); PG8_STAGE(PG8_SA(1, 0), a3, voffA);
            PG8_BAR; PG8_WAIT_L(0); PG8_MMA(1, 0, At, B0); PG8_BAR; PG8_SCHED;
            PG8_STAGE(PG8_SB(1, 1), b3 + hstep, voffB);
            PG8_WAIT_V(6); PG8_BAR; PG8_MMA(1, 1, At, B1); PG8_BAR;
            }
        }
        if constexpr (ALIGN_EPI) { if (wr == 0) PG8_BAR; }
        if constexpr (!Epi::AFTER_DRAIN) { E(acc, cur, wr, wc, fr, fq); S.done(cur); }
        if (!has_next) break;
#pragma unroll
        for (int a = 0; a < 2; ++a)
#pragma unroll
            for (int b = 0; b < 2; ++b)
#pragma unroll
                for (int m = 0; m < 4; ++m)
#pragma unroll
                    for (int n = 0; n < 2; ++n) acc[a][b][m][n] = (f32x4){0.f, 0.f, 0.f, 0.f};
        cur = nxt; cA = nA; cB = nB; ++ui;
        if constexpr (ALIGN_EPI) { if (wr == 1) PG8_BAR; }
    }
    PG8_WAIT_V(0);
    if constexpr (!ALIGN_EPI) { if (wr == 0) PG8_BAR; }
    PG8_BAR;
    if constexpr (Epi::AFTER_DRAIN) { E.fused(acc, cur, wr, wc, fr, fq, lds, wid, lane); S.done(cur); }
#undef PG8_SA
#undef PG8_SB
#undef PG8_STAGE
#undef PG8_LDA
#undef PG8_LDB
#undef PG8_MMA
#undef PG8_WAIT_V
#undef PG8_WAIT_L
#undef PG8_BAR
#undef PG8_SCHED
}
}
#define LAS __attribute__((address_space(3)))
typedef unsigned short bf16;
typedef short bf16x8 __attribute__((ext_vector_type(8)));
typedef short s16x4 __attribute__((ext_vector_type(4)));
typedef float f32x4 __attribute__((ext_vector_type(4)));
typedef float f32x16 __attribute__((ext_vector_type(16)));
typedef unsigned u32x4 __attribute__((ext_vector_type(4)));
typedef unsigned u32x2 __attribute__((ext_vector_type(2)));

constexpr int NB = 8, SEQ = 4096, DM = 1024, DEPTH = 4, NMETA = 16;
constexpr int MREAL = NB * SEQ;
constexpr int META0 = MREAL;
constexpr int MROWS = 129 * 256;
constexpr int NINP = 3328, QP = 3072;
constexpr int C_FQ = 0, C_FK = 512, C_FV = 1024, C_GQ = 1536, C_GK = 1792, C_GV = 2048, C_GR = 2560;
constexpr int DFF = 2816, NUP = 5632;
constexpr float EPS = 1e-6f, LOG2E = 1.4426950408889634f, C2 = 0.125f * LOG2E;
constexpr int CKP = 4160;
constexpr int NCH = 65;

constexpr size_t MiB = 1u << 20;
constexpr size_t WL_IN = 0, WL_OUT = 6815744, WL_UP = 8912896, WL_DN = 20447232, WL_SIZE = 26214400;
constexpr size_t WS_W = 0, WS_HB = 100 * MiB, WS_OB = WS_HB + 67633152, WS_QKV = WS_OB + 67633152, WS_UT = WS_QKV + 202899456;
constexpr size_t WS_SM = WS_UT + 68157440, WS_CK = WS_SM + 4456448, WS_DEC = WS_CK + 1310720, WS_HM = WS_DEC + 786432, WS_SSQ = WS_HM + MiB, WS_BAR = WS_SSQ + 1835008, BAR_BYTES = 16384, WS_END = WS_BAR + BAR_BYTES;
static_assert(WS_END <= 512 * MiB, "workspace map");
constexpr size_t HFL_SIZE = (size_t)129 * 2 * NUP * 4;
static_assert(2 * HFL_SIZE <= 68157440, "halo overlay");

constexpr int LDS_BYTES = 147456, HALO_OFF = 131072;

struct Args {
    const float *x, *meta, *attn_norm, *w_in, *w_au, *b_alpha, *b_forget, *gla_norm, *fox_norm, *w_out, *ffn_norm, *w_up, *conv_w, *conv_b, *w_down, *final_norm;
    float* out; unsigned char* ws;
};

#define GAS __attribute__((address_space(1)))
#define CAS __attribute__((address_space(4)))
typedef const CAS Args* KArgs;
__device__ __forceinline__ KArgs kargs() { KArgs p = (KArgs)__builtin_amdgcn_kernarg_segment_ptr(); asm volatile("" : "+s"(p)); return p; }
template <class T> __device__ __forceinline__ T* gptr(T* p) { return (T*)(GAS T*)p; }
__device__ __forceinline__ float bf2f(bf16 v) { return __uint_as_float((unsigned)v << 16); }
__device__ __forceinline__ unsigned pk2(float lo, float hi) { return pg8::cvt_pk_bf16(lo, hi); }
__device__ __forceinline__ bf16 f2bf(float v) { return (bf16)(pk2(v, 0.f) & 0xffffu); }
__device__ __forceinline__ float wave_sum(float v) {
#pragma unroll
    for (int o = 1; o < 64; o <<= 1) v += __shfl_xor(v, o);
    return v;
}
__device__ __forceinline__ float logsigmoidf(float z) { return -(fmaxf(-z, 0.f) + log1pf(__expf(-fabsf(z)))); }
__device__ __forceinline__ float siluf(float v) { return v * __builtin_amdgcn_rcpf(1.f + __builtin_amdgcn_exp2f(-LOG2E * v)); }
__device__ __forceinline__ int crow(int r, int hi) { return (r & 3) + 8 * (r >> 2) + 4 * hi; }
__device__ __forceinline__ s16x4 vtr(const LAS unsigned char* p) { return __builtin_bit_cast(s16x4, __builtin_amdgcn_ds_read_tr16_b64_v4i16((LAS s16x4*)p)); }
__device__ __forceinline__ bf16x8 cat8(s16x4 a, s16x4 b) { return (bf16x8){a[0], a[1], a[2], a[3], b[0], b[1], b[2], b[3]}; }
__device__ __forceinline__ float dppf(float old, float src, int ctrl_unused);
#define DPP_MOV(old, src, ctrl) __builtin_bit_cast(float, __builtin_amdgcn_update_dpp(__builtin_bit_cast(int, (float)(old)), __builtin_bit_cast(int, (float)(src)), (ctrl), 0xf, 0xf, false))
#define LDS_WAIT() asm volatile("s_waitcnt lgkmcnt(0)" ::: "memory")

__device__ __forceinline__ const float* ssq_arr(unsigned char* wsb, int si) { return (const float*)(wsb + WS_SSQ) + (size_t)(si % 3) * MROWS * 4; }
__device__ __forceinline__ float row_rstd(const float* ssqp, int row) { const f32x4 s = *(const f32x4*)(ssqp + (size_t)row * 4); return rsqrtf(((s[0] + s[1]) + (s[2] + s[3])) * (1.0f / DM) + EPS); }
__device__ __forceinline__ LAS float* tile_rstd(unsigned char* wsb, int si, int pm, int wr, int wc, int fr, int fq) {
    extern __shared__ __attribute__((aligned(16))) unsigned char lds_dyn_[];
    LAS float* rsl = (LAS float*)((LAS unsigned char*)lds_dyn_ + HALO_OFF + 8192);
    const int tl = (wr * 4 + wc) * 64 + fq * 16 + fr;
    if (pm != 128) {
        if (tl < 256) rsl[tl] = row_rstd(ssq_arr(wsb, si), pm * 256 + tl);
    } else {
        const int row = tl >> 5, part = tl & 31;
        const f32x4* hp = (const f32x4*)((const float*)(wsb + WS_HM) + (size_t)row * DM) + part;
        float s = 0.f;
#pragma unroll
        for (int j = 0; j < 8; ++j) { const f32x4 v = hp[32 * j]; s += (v[0] * v[0] + v[1] * v[1]) + (v[2] * v[2] + v[3] * v[3]); }
        s += __shfl_xor(s, 1); s += __shfl_xor(s, 2); s += __shfl_xor(s, 4); s += __shfl_xor(s, 8); s += __shfl_xor(s, 16);
        if (part == 0) rsl[row] = rsqrtf(s * (1.0f / DM) + EPS);
        if (tl < 240) rsl[16 + tl] = 0.f;
    }
    asm volatile("s_waitcnt lgkmcnt(0)" ::: "memory"); __builtin_amdgcn_s_barrier(); asm volatile("" ::: "memory");
    return rsl;
}
__device__ __forceinline__ void meta_rowgemm(const bf16* A, int lda, const bf16* Bt, int K, float* HM, bf16* HB, int G, int bx) {
    int tid_ = threadIdx.x; asm volatile("" : "+v"(tid_)); const int r = tid_ >> 5, kp = tid_ & 31;
    for (int cg = bx; cg < 256; cg += G) {
        float acc[4] = {0.f, 0.f, 0.f, 0.f};
        for (int k0 = kp * 8; k0 < K; k0 += 256) {
            const u32x4 av = *(const u32x4*)(A + (size_t)r * lda + k0);
#pragma unroll
            for (int j = 0; j < 4; ++j) {
                const u32x4 bv = *(const u32x4*)(Bt + (size_t)(4 * cg + j) * K + k0);
#pragma unroll
                for (int q = 0; q < 4; ++q) {
                    acc[j] += __uint_as_float(av[q] << 16) * __uint_as_float(bv[q] << 16);
                    acc[j] += __uint_as_float(av[q] & 0xffff0000u) * __uint_as_float(bv[q] & 0xffff0000u);
                }
            }
        }
#pragma unroll
        for (int j = 0; j < 4; ++j) { float s = acc[j]; s += __shfl_xor(s, 1); s += __shfl_xor(s, 2); s += __shfl_xor(s, 4); s += __shfl_xor(s, 8); s += __shfl_xor(s, 16); acc[j] = s; }
        if (kp == 0) {
            float* hp = HM + (size_t)r * DM + 4 * cg;
            const f32x4 h = *(const f32x4*)hp + (f32x4){acc[0], acc[1], acc[2], acc[3]};
            *(f32x4*)hp = h;
            u32x2 w; w.x = pk2(h[0], h[1]); w.y = pk2(h[2], h[3]);
            *(u32x2*)(HB + (size_t)(META0 + r) * DM + 4 * cg) = w;
        }
    }
}
__device__ __forceinline__ void meta_up(LAS unsigned char* lds, const bf16* HB, const bf16* Wup, const float* HM, const float* cw, const float* cb, bf16* A2, float* HL, int G, int bx) {
    int tid_ = threadIdx.x; asm volatile("" : "+v"(tid_)); const int tid = tid_, r = tid >> 5, kp = tid & 31;
    LAS float* hb = (LAS float*)lds;
    float rs;
    { const f32x4* hp = (const f32x4*)(HM + (size_t)r * DM) + kp; float s = 0.f;
#pragma unroll
      for (int j = 0; j < 8; ++j) { const f32x4 v = hp[32 * j]; s += (v[0] * v[0] + v[1] * v[1]) + (v[2] * v[2] + v[3] * v[3]); }
      s += __shfl_xor(s, 1); s += __shfl_xor(s, 2); s += __shfl_xor(s, 4); s += __shfl_xor(s, 8); s += __shfl_xor(s, 16);
      rs = rsqrtf(s * (1.0f / DM) + EPS); }
    u32x4 av[4];
#pragma unroll
    for (int i = 0; i < 4; ++i) av[i] = *(const u32x4*)(HB + (size_t)(META0 + r) * DM + kp * 8 + 256 * i);
    for (int cg = bx; cg < 256; cg += G) {
#pragma unroll 1
        for (int cb0 = 0; cb0 < 24; cb0 += 6) {
            u32x4 bv[6][4];
#pragma unroll
            for (int c6 = 0; c6 < 6; ++c6) {
                const int c = cb0 + c6 < 22 ? cb0 + c6 : 21, isg = c >= 11 ? 1 : 0, jj = c - 11 * isg;
                const int ch = 11 * cg + jj, wrow = (ch >> 7) * 256 + isg * 128 + (ch & 127);
#pragma unroll
                for (int i = 0; i < 4; ++i) bv[c6][i] = *(const u32x4*)(Wup + (size_t)wrow * DM + kp * 8 + 256 * i);
            }
#pragma unroll
            for (int c6 = 0; c6 < 6; ++c6) {
                float acc = 0.f;
#pragma unroll
                for (int i = 0; i < 4; ++i)
#pragma unroll
                    for (int q = 0; q < 4; ++q) {
                        acc += __uint_as_float(av[i][q] << 16) * __uint_as_float(bv[c6][i][q] << 16);
                        acc += __uint_as_float(av[i][q] & 0xffff0000u) * __uint_as_float(bv[c6][i][q] & 0xffff0000u);
                    }
                acc += __shfl_xor(acc, 1); acc += __shfl_xor(acc, 2); acc += __shfl_xor(acc, 4); acc += __shfl_xor(acc, 8); acc += __shfl_xor(acc, 16);
                if (kp == 0 && cb0 + c6 < 22) hb[r * 24 + cb0 + c6] = acc * rs;
            }
        }
        __syncthreads();
        if (tid < 16 * 11) {
            const int rr = tid / 11, jj = tid % 11, ch = 11 * cg + jj;
            float hc[2];
#pragma unroll
            for (int ug = 0; ug < 2; ++ug) {
                const int c = ug * DFF + ch;
                const float x0 = hb[rr * 24 + ug * 11 + jj], x1 = rr >= 1 ? hb[(rr - 1) * 24 + ug * 11 + jj] : 0.f, x2 = rr >= 2 ? hb[(rr - 2) * 24 + ug * 11 + jj] : 0.f;
                hc[ug] = cb[c] + cw[c] * x2 + cw[NUP + c] * x1 + cw[2 * NUP + c] * x0;
                if (rr >= 14) HL[(size_t)(256 + rr - 14) * NUP + c] = x0;
            }
            A2[(size_t)(META0 + rr) * DFF + ch] = f2bf(siluf(hc[1]) * hc[0]);
        }
        __syncthreads();
    }
}
__device__ __forceinline__ bool so_next_pm(int nM, int nN, int G, int c, int i, int& pm) {
    const int nwg = nM * nN; const long Lq = (long)i * G + c; if (Lq >= nwg) return false;
    int wgid = (int)Lq; { const int q = nwg / pg8::NXCD, r = nwg % pg8::NXCD, xcd = wgid % pg8::NXCD, off = wgid / pg8::NXCD; wgid = (xcd < r ? xcd * (q + 1) : r * (q + 1) + (xcd - r) * q) + off; }
    const int nig = pg8::WGM * nN, gid = wgid / nig, fm = gid * pg8::WGM, gsz = (nM - fm) < pg8::WGM ? (nM - fm) : pg8::WGM;
    pm = fm + ((wgid % nig) % gsz); return true;
}
struct EpiIn {
    static constexpr bool PERM = true, AFTER_DRAIN = false;
    int si;
    __device__ __forceinline__ void operator()(const pg8::f32x4 (&acc)[2][2][4][2], const pg8::Unit& u, int wr, int wc, int fr, int fq) const {
        asm volatile("" : "+v"(fr), "+v"(fq));
        unsigned char* wsb = gptr(kargs()->ws);
        bf16* Q = (bf16*)(wsb + WS_QKV); float* SM = (float*)(wsb + WS_SM); const LAS float* rsl = tile_rstd(wsb, si, u.pm, wr, wc, fr, fq);
#pragma unroll
        for (int ai = 0; ai < 2; ++ai)
#pragma unroll
            for (int m = 0; m < 4; ++m) {
                const int row = u.pm * 256 + ai * 128 + wr * 64 + m * 16 + fr;
                const float rs = rsl[ai * 128 + wr * 64 + m * 16 + fr];
                if (u.pn < 12) {
#pragma unroll
                    for (int bj = 0; bj < 2; ++bj) {
                        const pg8::f32x4 v0 = acc[ai][bj][m][0] * rs, v1 = acc[ai][bj][m][1] * rs;
                        u32x4 w; w.x = pk2(v0[0], v0[1]); w.y = pk2(v0[2], v0[3]); w.z = pk2(v1[0], v1[1]); w.w = pk2(v1[2], v1[3]);
                        *(u32x4*)(Q + (size_t)row * QP + u.pn * 256 + bj * 128 + wc * 32 + 8 * fq) = w;
                    }
                } else if (wc == 0) {
                    *(f32x4*)(SM + (size_t)row * 32 + 8 * fq) = acc[ai][0][m][0] * rs;
                    *(f32x4*)(SM + (size_t)row * 32 + 8 * fq + 4) = acc[ai][0][m][1] * rs;
                }
            }
    }
};
template <bool from_x, bool last> struct EpiRes {
    static constexpr bool PERM = false, AFTER_DRAIN = false;
    int si;
    __device__ __forceinline__ void operator()(const pg8::f32x4 (&acc)[2][2][4][2], const pg8::Unit& u, int wr, int wc, int fr, int fq) const {
        asm volatile("" : "+v"(fr), "+v"(fq));
        KArgs ka = kargs(); unsigned char* wsb = gptr(ka->ws);
        float* out = last ? gptr(ka->out) : nullptr; const float* xin = from_x ? gptr(ka->x) : nullptr; bf16* HB = (bf16*)(wsb + WS_HB); float* ssq_next = (float*)ssq_arr(wsb, si);
        extern __shared__ __attribute__((aligned(16))) unsigned char lds_dyn_[];
        LAS float* red = (LAS float*)((LAS unsigned char*)lds_dyn_ + HALO_OFF);
#pragma unroll
        for (int ai = 0; ai < 2; ++ai)
#pragma unroll
            for (int m = 0; m < 4; ++m) {
                const int row = u.pm * 256 + ai * 128 + wr * 64 + m * 16 + fr;
                float ss = 0.f;
#pragma unroll
                for (int bj = 0; bj < 2; ++bj)
#pragma unroll
                    for (int n = 0; n < 2; ++n) {
                        const int col = u.pn * 256 + bj * 128 + wc * 32 + 16 * n + 4 * fq;
                        f32x4 bs;
                        if constexpr (from_x) bs = *(const f32x4*)(xin + (size_t)row * DM + col);
                        else { const u32x2 t = *(const u32x2*)(HB + (size_t)row * DM + col);
                               bs = (f32x4){__uint_as_float(t.x << 16), __uint_as_float(t.x & 0xffff0000u), __uint_as_float(t.y << 16), __uint_as_float(t.y & 0xffff0000u)}; }
                        const f32x4 h = bs + acc[ai][bj][m][n];
                        ss += (h[0] * h[0] + h[1] * h[1]) + (h[2] * h[2] + h[3] * h[3]);
                        u32x2 w; w.x = pk2(h[0], h[1]); w.y = pk2(h[2], h[3]);
                        *(u32x2*)(HB + (size_t)row * DM + col) = w;
                        if constexpr (last) *(f32x4*)(out + (size_t)row * DM + col) = h;
                    }
                ss += __shfl_xor(ss, 16); ss += __shfl_xor(ss, 32);
                if (fq == 0) red[wc * 256 + ai * 128 + wr * 64 + m * 16 + fr] = ss;
            }
        asm volatile("s_waitcnt lgkmcnt(0)" ::: "memory"); __builtin_amdgcn_s_barrier(); asm volatile("" ::: "memory");
        {
            const int tl = (wr * 4 + wc) * 64 + fq * 16 + fr;
            if (tl < 256) ssq_next[(size_t)(u.pm * 256 + tl) * 4 + u.pn] = (red[tl] + red[256 + tl]) + (red[512 + tl] + red[768 + tl]);
        }
    }
};
struct EpiUp {
    static constexpr bool PERM = true, AFTER_DRAIN = false;
    int L;
    __device__ __forceinline__ void operator()(pg8::f32x4 (&acc)[2][2][4][2], const pg8::Unit& u, int wr, int wc, int fr, int fq) const {
        asm volatile("" : "+v"(fr), "+v"(fq));
        KArgs ka = kargs(); unsigned char* wsb = gptr(ka->ws);
        const LAS float* rsl = tile_rstd(wsb, 2 * L + 1, u.pm, wr, wc, fr, fq); const float* cw = gptr(ka->conv_w) + (size_t)L * 3 * NUP; const float* cb = gptr(ka->conv_b) + (size_t)L * NUP;
        extern __shared__ __attribute__((aligned(16))) unsigned char lds_dyn_[];
        LAS float* halo = (LAS float*)((LAS unsigned char*)lds_dyn_ + HALO_OFF);
        const int colw = wc * 32 + 8 * fq;
#pragma unroll
        for (int ai = 0; ai < 2; ++ai)
#pragma unroll
            for (int m = 0; m < 4; ++m) {
                const int row = u.pm * 256 + ai * 128 + wr * 64 + m * 16 + fr;
                const float rs = rsl[ai * 128 + wr * 64 + m * 16 + fr]; (void)row;
#pragma unroll
                for (int bj = 0; bj < 2; ++bj)
#pragma unroll
                    for (int n = 0; n < 2; ++n) acc[ai][bj][m][n] *= rs;
            }
#ifdef SIMPLE_UP
        {
            const int ch0s = u.pn * 128 + colw;
#pragma unroll
            for (int n = 0; n < 2; ++n)
#pragma unroll
                for (int ai = 0; ai < 2; ++ai)
#pragma unroll
                    for (int m = 0; m < 4; ++m) {
                        const int row = u.pm * 256 + ai * 128 + wr * 64 + m * 16 + fr;
                        const f32x4 hu = acc[ai][0][m][n], hg = acc[ai][1][m][n];
                        u32x2 w; w.x = pk2(hu[0] + hg[0], hu[1] + hg[1]); w.y = pk2(hu[2] + hg[2], hu[3] + hg[3]);
                        *(u32x2*)(wsb + (unsigned)(WS_QKV + (unsigned)((row * DFF + ch0s + 4 * n) * 2))) = w;
                    }
            return;
        }
#endif
        if (fr >= 14) {
#pragma unroll
            for (int ai = 0; ai < 2; ++ai)
#pragma unroll
                for (int bj = 0; bj < 2; ++bj)
#pragma unroll
                    for (int n = 0; n < 2; ++n)
                        *(LAS f32x4*)(halo + (((2 * ai + wr) * 2 + (fr - 14)) * 256 + bj * 128 + colw + 4 * n)) = acc[ai][bj][3][n];
        }
        asm volatile("s_waitcnt lgkmcnt(0)" ::: "memory"); __builtin_amdgcn_s_barrier(); asm volatile("" ::: "memory");
        const int ch0 = u.pn * 128 + colw;
        u32x2 wout[2][4][2];
#pragma unroll
        for (int n = 0; n < 2; ++n) {
            f32x4 w0[2], w1[2], w2[2], bb[2];
#pragma unroll
            for (int bj = 0; bj < 2; ++bj) {
                const int c = bj * DFF + ch0 + 4 * n;
                w0[bj] = *(const f32x4*)((const char*)cw + (unsigned)(c * 4)); w1[bj] = *(const f32x4*)((const char*)cw + (unsigned)((NUP + c) * 4)); w2[bj] = *(const f32x4*)((const char*)cw + (unsigned)((2 * NUP + c) * 4)); bb[bj] = *(const f32x4*)((const char*)cb + (unsigned)(c * 4));
            }
#pragma unroll
            for (int ai = 0; ai < 2; ++ai)
#pragma unroll
                for (int m = 0; m < 4; ++m) {
                    const int g = 2 * ai + wr;
                    f32x4 hc[2];
#pragma unroll
                    for (int bj = 0; bj < 2; ++bj) {
                        const int c = bj * DFF + ch0 + 4 * n;
                        const f32x4 cur = acc[ai][bj][m][n];
                        f32x4 pb;
                        if (m > 0) pb = acc[ai][bj][m - 1][n];
                        else pb = *(const LAS f32x4*)(halo + ((((g > 0 ? g - 1 : 0) * 2) + (fr & 1)) * 256 + bj * 128 + colw + 4 * n));
                        f32x4 p1, p2;
#pragma unroll
                        for (int j = 0; j < 4; ++j) {
                            const float t1 = DPP_MOV(0.f, pb[j], 0x121);
                            p1[j] = DPP_MOV(t1, cur[j], 0x111);
                            const float t2 = DPP_MOV(0.f, pb[j], 0x122);
                            p2[j] = DPP_MOV(t2, cur[j], 0x112);
                        }
                        hc[bj] = bb[bj] + w0[bj] * p2 + w1[bj] * p1 + w2[bj] * cur;
                        if (g == 0 && m == 0 && fr < 2) *(f32x4*)(wsb + (unsigned)(WS_UT + (unsigned)(((u.pm * 2 + fr) * NUP + c) * 4))) = cur;
                        if (u.pm == 128 ? (g == 0 && m == 0 && fr >= 14) : (g == 3 && m == 3 && fr >= 14))
                            *(f32x4*)(wsb + (unsigned)(WS_UT + HFL_SIZE + (unsigned)(((u.pm * 2 + fr - 14) * NUP + c) * 4))) = cur;
                    }
                    wout[ai][m][n].x = pk2(siluf(hc[1][0]) * hc[0][0], siluf(hc[1][1]) * hc[0][1]);
                    wout[ai][m][n].y = pk2(siluf(hc[1][2]) * hc[0][2], siluf(hc[1][3]) * hc[0][3]);
                }
        }
#pragma unroll
        for (int ai = 0; ai < 2; ++ai)
#pragma unroll
            for (int m = 0; m < 4; ++m) {
                const int row = u.pm * 256 + ai * 128 + wr * 64 + m * 16 + fr;
                u32x4 w; w.x = wout[ai][m][0].x; w.y = wout[ai][m][0].y; w.z = wout[ai][m][1].x; w.w = wout[ai][m][1].y;
                *(u32x4*)(wsb + (unsigned)(WS_QKV + (unsigned)((row * DFF + ch0) * 2))) = w;
            }
    }
};
#define XB_TMO      128
#define XB_XCNT(j)  (256  + 64 * (j))
#define XB_XSUB(j)  (1280 + 64 * (j))
#define XB_XGEN(j)  (2304 + 64 * (j))
#define XB_TOP      3328
#define XB_TOPGEN   3392
#define XCD_BAR_WORDS 3456
#define XB_SPIN_CAP (1u << 18)

__device__ __forceinline__ unsigned xb_ld(unsigned* p)              { return __hip_atomic_load(p, __ATOMIC_RELAXED, __HIP_MEMORY_SCOPE_AGENT); }
__device__ __forceinline__ unsigned xb_add(unsigned* p, unsigned v) { return __hip_atomic_fetch_add(p, v, __ATOMIC_RELAXED, __HIP_MEMORY_SCOPE_AGENT); }
__device__ __forceinline__ unsigned xb_xcc_id() { return (unsigned)__builtin_amdgcn_s_getreg((3 << 11) | 20) & 0xFu; }
#define XB_SPIN(cond, bar) do { unsigned _sp = 0; while (cond) { __builtin_amdgcn_s_sleep(1); \
    if ((++_sp & 255u) == 0u) { if (xb_ld(&(bar)[XB_TMO])) break; if (_sp > XB_SPIN_CAP) { atomicAdd(&(bar)[XB_TMO], 1u); break; } } } } while (0)

struct XcdBarrier {
    unsigned* bar; unsigned x;
    volatile LAS unsigned* st;
};

__device__ __forceinline__ XcdBarrier xcd_barrier_post(unsigned* bar, volatile LAS unsigned* st) {
    XcdBarrier b; b.bar = bar; b.x = xb_xcc_id(); b.st = st;
    if (threadIdx.x == 0) (void)xb_add(&bar[XB_XCNT(b.x)], 1u);
    return b;
}
__device__ __forceinline__ void xcd_barrier_complete(unsigned* bar, unsigned x, unsigned& nloc, unsigned& nx) {
    const unsigned G = gridDim.x * gridDim.y * gridDim.z;
    unsigned sum, cnt, mine, sp = 0u;
    for (;;) {
        sum = 0u; cnt = 0u; mine = 0u;
#pragma unroll
        for (unsigned j = 0; j < 16; ++j) { const unsigned c = xb_ld(&bar[XB_XCNT(j)]); sum += c; cnt += (c > 0u) ? 1u : 0u; mine = (j == x) ? c : mine; }
        if (sum == G) break;
        __builtin_amdgcn_s_sleep(1);
        if ((++sp & 255u) == 0u) { if (xb_ld(&bar[XB_TMO])) break; if (sp > XB_SPIN_CAP) { atomicAdd(&bar[XB_TMO], 1u); break; } }
    }
    nloc = mine > 0u ? mine : 1u; nx = cnt > 0u ? cnt : 1u;
}

__device__ __forceinline__ void xcd_barrier(const XcdBarrier& b) {
    asm volatile("s_waitcnt vmcnt(0)" ::: "memory");
    __syncthreads();
    if (threadIdx.x == 0) {
        unsigned* bar = b.bar;
        __builtin_amdgcn_s_waitcnt(0);
        unsigned nloc = b.st[0], nx = b.st[1];
        if (nloc == 0u) { xcd_barrier_complete(bar, b.x, nloc, nx); b.st[0] = nloc; b.st[1] = nx; }
        const unsigned old = xb_add(&bar[XB_XSUB(b.x)], 1u);
        const unsigned gen = old / nloc;
        if (old + 1u == (gen + 1u) * nloc) {
            __builtin_amdgcn_fence(__ATOMIC_RELEASE, "agent");
            asm volatile("s_waitcnt vmcnt(0)" ::: "memory");
            const unsigned og = xb_add(&bar[XB_TOP], 1u);
            const unsigned tg = og / nx;
            if (og + 1u == (tg + 1u) * nx) xb_add(&bar[XB_TOPGEN], 1u);
            else XB_SPIN(xb_ld(&bar[XB_TOPGEN]) == tg, bar);
            __builtin_amdgcn_fence(__ATOMIC_ACQUIRE, "agent");
            xb_add(&bar[XB_XGEN(b.x)], 1u);
            asm volatile("s_waitcnt vmcnt(0)" ::: "memory");
        } else {
            XB_SPIN(xb_ld(&bar[XB_XGEN(b.x)]) == gen, bar);
            __builtin_amdgcn_fence(__ATOMIC_ACQUIRE, "agent");
            asm volatile("s_waitcnt vmcnt(0)" ::: "memory");
        }
    }
    __syncthreads();
}
__device__ __forceinline__ int win_src(int n) {
    if (n < 512) return 1552 + n;
    if (n < 1024) return 2064 + (n - 512);
    if (n < 1536) return 2576 + (n - 1024);
    if (n < 1792) return n - 1536;
    if (n < 2048) return 256 + (n - 1792);
    if (n < 2560) return 512 + (n - 2048);
    if (n < 3072) return 1024 + (n - 2560);
    if (n < 3088) return 1536 + (n - 3072);
    if (n < 3096) return n;
    return -1;
}
__device__ __forceinline__ void tr_item(const float* W, int Nsrc, bf16* WT, int K, const float* gk, int mode, LAS float* scr, int k0, int n0, int lane) {
    const int nl = lane & 31, n = n0 + nl;
    int src = n; float cs = 1.f;
    if (mode == 0) { src = win_src(n); cs = n < 512 ? C2 : ((n >= 1536 && n < 1792) ? 0.125f : 1.f); }
    else if (mode == 2) { const int pn = n >> 8, j = n & 255; src = j < 128 ? pn * 128 + j : DFF + pn * 128 + (j - 128); }
#pragma unroll
    for (int i = 0; i < 32; ++i) {
        const int kk = 2 * i + (lane >> 5);
        float v = 0.f;
        if (src >= 0) v = W[(size_t)(k0 + kk) * Nsrc + src] * cs;
        if (gk) v *= gk[k0 + kk];
        scr[kk * 33 + nl] = v;
    }
    LDS_WAIT(); asm volatile("" ::: "memory");
    const int c = lane & 7;
#pragma unroll
    for (int j = 0; j < 4; ++j) {
        const int nn = (lane >> 3) + 8 * j; const LAS float* s = scr + (8 * c) * 33 + nn;
        u32x4 o; o.x = pk2(s[0 * 33], s[1 * 33]); o.y = pk2(s[2 * 33], s[3 * 33]); o.z = pk2(s[4 * 33], s[5 * 33]); o.w = pk2(s[6 * 33], s[7 * 33]);
        *(u32x4*)(WT + (size_t)(n0 + nn) * K + k0 + 8 * c) = o;
    }
    LDS_WAIT(); asm volatile("" ::: "memory");
}
__device__ __forceinline__ void row_to_bf16(const float* xrow, bf16* orow, float* ssq_slot, float* copy_row, int lane) {
    const f32x4* xr = (const f32x4*)xrow + lane;
    f32x4 v[4]; float s = 0.f;
#pragma unroll
    for (int j = 0; j < 4; ++j) { v[j] = xr[64 * j]; s += (v[j][0] * v[j][0] + v[j][1] * v[j][1]) + (v[j][2] * v[j][2] + v[j][3] * v[j][3]); }
    s = wave_sum(s);
    if (lane == 0) *(f32x4*)ssq_slot = (f32x4){s, 0.f, 0.f, 0.f};
    u32x2* o8 = (u32x2*)orow + lane;
#pragma unroll
    for (int j = 0; j < 4; ++j) { u32x2 w; w.x = pk2(v[j][0], v[j][1]); w.y = pk2(v[j][2], v[j][3]); o8[64 * j] = w; }
    if (copy_row) {
#pragma unroll
        for (int j = 0; j < 4; ++j) ((f32x4*)copy_row + lane)[64 * j] = v[j];
    }
}

template <int NQ> __device__ __forceinline__ void gla_u_group(LAS unsigned char* lds, const bf16* QKV, const float* SM, const float* wau, const float* balpha, float* UT, float* DEC, int grp) {
    int tid_ = threadIdx.x; asm volatile("" : "+v"(tid_)); const int tid = tid_, lane = tid & 63, wid = __builtin_amdgcn_readfirstlane(tid >> 6), hi = lane >> 5, r32 = lane & 31;
    constexpr int SUB = 9216 + 17408 + 2048;
    const int dk = lane, sg = wid;
    int bhq[NQ], ccq[NQ], hq[NQ], row0q[NQ], tvq[NQ];
    float la[NQ][8], kf[NQ][8];
#pragma unroll
    for (int q = 0; q < NQ; ++q) {
        const int u = NQ * grp + q; bhq[q] = u / NCH; ccq[q] = u % NCH; hq[q] = bhq[q] & 3;
        row0q[q] = ccq[q] == 0 ? META0 : (bhq[q] >> 2) * SEQ + (ccq[q] - 1) * 64; tvq[q] = ccq[q] == 0 ? NMETA : 64;
        LAS unsigned char* VT = lds + q * SUB + 9216;
        LAS float* TOT = (LAS float*)(lds + q * SUB + 9216 + 17408);
#pragma unroll
        for (int i = 0; i < 2; ++i) {
            const int idx = tid + 512 * i, row = idx >> 4, ch = idx & 15;
            const u32x4 v = *(const u32x4*)(QKV + (size_t)(row0q[q] + row) * QP + C_GV + hq[q] * 128 + ch * 8);
            *(LAS u32x4*)(VT + row * 272 + ch * 16) = v;
        }
#pragma unroll
        for (int i = 0; i < 8; ++i) kf[q][i] = bf2f(QKV[(size_t)(row0q[q] + 8 * sg + i) * QP + C_GK + hq[q] * 64 + dk]);
        float w[16];
#pragma unroll
        for (int r = 0; r < 16; ++r) w[r] = wau[r * 256 + hq[q] * 64 + dk];
        const float bias = balpha[hq[q] * 64 + dk];
#pragma unroll
        for (int i = 0; i < 8; ++i) {
            const int s = 8 * sg + i;
            const f32x4* g4 = (const f32x4*)(SM + (size_t)(row0q[q] + s) * 32);
            float z = bias;
#pragma unroll
            for (int k = 0; k < 4; ++k) { const f32x4 gv = g4[k]; z += gv[0] * w[4 * k] + gv[1] * w[4 * k + 1] + gv[2] * w[4 * k + 2] + gv[3] * w[4 * k + 3]; }
            la[q][i] = (s < tvq[q]) ? logsigmoidf(z) * (1.0f / 16.0f) : 0.f;
        }
#pragma unroll
        for (int i = 1; i < 8; ++i) la[q][i] += la[q][i - 1];
        TOT[sg * 64 + dk] = la[q][7];
    }
    __syncthreads();
#pragma unroll
    for (int q = 0; q < NQ; ++q) {
        LAS unsigned char* KD = lds + q * SUB;
        const LAS float* TOT = (const LAS float*)(lds + q * SUB + 9216 + 17408);
        float pre = 0.f, tot = 0.f;
#pragma unroll
        for (int g2 = 0; g2 < 8; ++g2) { const float t = TOT[g2 * 64 + dk]; if (g2 < sg) pre += t; tot += t; }
        if (sg == 0) DEC[(size_t)(bhq[q] * NCH + ccq[q]) * 64 + dk] = __expf(tot);
#pragma unroll
        for (int i = 0; i < 8; ++i) {
            const int s = 8 * sg + i;
            const float kd = (s < tvq[q]) ? kf[q][i] * __expf(tot - (pre + la[q][i])) : 0.f;
            *(LAS bf16*)(KD + s * 144 + dk * 2) = f2bf(kd);
        }
    }
    __syncthreads();
    const int dvb = wid >> 1, dkb = wid & 1;
    const int qq = (lane & 15) >> 2, pp = lane & 3, half = (lane >> 4) & 1;
#pragma unroll
    for (int q = 0; q < NQ; ++q) {
        const LAS unsigned char* KD = lds + q * SUB; const LAS unsigned char* VT = lds + q * SUB + 9216;
        f32x16 acc = {};
#pragma unroll
        for (int j = 0; j < 4; ++j) {
            const LAS unsigned char* ap = VT + (16 * j + 4 * hi + qq) * 272 + (32 * dvb + 16 * half + 4 * pp) * 2;
            const LAS unsigned char* bp = KD + (16 * j + 4 * hi + qq) * 144 + (32 * dkb + 16 * half + 4 * pp) * 2;
            const bf16x8 af = cat8(vtr(ap), vtr(ap + 8 * 272));
            const bf16x8 bfr = cat8(vtr(bp), vtr(bp + 8 * 144));
            acc = __builtin_amdgcn_mfma_f32_32x32x16_bf16(af, bfr, acc, 0, 0, 0);
        }
        float* up = UT + ((size_t)(bhq[q] * NCH + ccq[q]) * 128 + 32 * dvb) * 64 + 32 * dkb + r32;
#pragma unroll
        for (int r = 0; r < 16; ++r) up[crow(r, hi) * 64] = acc[r];
    }
    __syncthreads();
}
__device__ __forceinline__ void fox_cumsum_unit(LAS unsigned char* lds, const float* SM, const float* bforget, float* CK, int bh) {
    int tid_ = threadIdx.x; asm volatile("" : "+v"(tid_)); const int tid = tid_, lane = tid & 63, wid = tid >> 6;
    const int b = bh >> 3, h = bh & 7;
    const float bf_ = bforget[h];
    LAS float* WT_ = (LAS float*)lds;
    float mtot = 0.f, mine = 0.f;
    for (int p = 0; p < NMETA; ++p) { mtot += logsigmoidf(SM[(size_t)(META0 + p) * 32 + 16 + h] + bf_); if (tid == p) mine = mtot; }
    if (tid < 64) CK[(size_t)bh * CKP + tid] = tid < NMETA ? -LOG2E * mine : -INFINITY;
    float v[8]; float run = 0.f;
#pragma unroll
    for (int i = 0; i < 8; ++i) { run += logsigmoidf(SM[(size_t)(b * SEQ + 8 * tid + i) * 32 + 16 + h] + bf_); v[i] = run; }
    float inc = run;
#pragma unroll
    for (int o = 1; o < 64; o <<= 1) { const float t = __shfl_up(inc, o); if (lane >= o) inc += t; }
    if (lane == 63) WT_[wid] = inc;
    __syncthreads();
    float off = mtot + (inc - run);
    for (int w2 = 0; w2 < wid; ++w2) off += WT_[w2];
#pragma unroll
    for (int i = 0; i < 8; ++i) CK[(size_t)bh * CKP + 64 + 8 * tid + i] = -LOG2E * (off + v[i]);
    __syncthreads();
}

__device__ __forceinline__ void attn_unit(LAS unsigned char* lds, const bf16* QKV, const float* CK, bf16* OB, const float* fnorm, int b, int h, int qb) {
    int tid_ = threadIdx.x; asm volatile("" : "+v"(tid_)); const int tid = tid_, lane = tid & 63, wid = __builtin_amdgcn_readfirstlane(tid >> 6), r32 = lane & 31, hi = lane >> 5;
    constexpr int KB = 9216, KOFF = 0, VOFF = 2 * KB, COFF = 4 * KB, WOFF = COFF + 512;
    LAS float* wsf = (LAS float*)(lds + WOFF) + wid * 64;
    const size_t rowb = (size_t)b * SEQ; const int q0 = qb * 512;
    const int NT = 1 + 8 * (qb + 1);
    bf16x8 qr[2][4];
#pragma unroll
    for (int g = 0; g < 2; ++g) {
        const bf16* qp = QKV + (rowb + q0 + wid * 64 + g * 32 + r32) * QP + C_FQ + h * 64 + hi * 8;
#pragma unroll
        for (int d0 = 0; d0 < 4; ++d0) qr[g][d0] = *(const bf16x8*)(qp + d0 * 16);
    }
    const int srow = tid >> 3, sch = tid & 7;
    const float* ckp = CK + (size_t)(b * 8 + h) * CKP;
    u32x4 kreg, vreg; float creg = 0.f;
#define ATT_LOAD(t) do { const size_t r0_ = (t) == 0 ? (size_t)META0 : rowb + (size_t)((t) - 1) * 64; const bf16* p_ = QKV + (r0_ + srow) * QP + h * 64 + sch * 8; \
        kreg = *(const u32x4*)(p_ + C_FK); vreg = *(const u32x4*)(p_ + C_FV); if (tid < 64) creg = ckp[(t) * 64 + tid]; } while (0)
#define ATT_STORE(buf) do { *(LAS u32x4*)(lds + KOFF + (buf) * KB + srow * 144 + sch * 16) = kreg; *(LAS u32x4*)(lds + VOFF + (buf) * KB + srow * 144 + sch * 16) = vreg; \
        if (tid < 64) *(LAS float*)(lds + COFF + (buf) * 256 + tid * 4) = creg; } while (0)
    float m[2] = {-1e30f, -1e30f}, l[2] = {0.f, 0.f}; f32x16 o0[2], o1[2];
    o0[0] = (f32x16){}; o0[1] = (f32x16){}; o1[0] = (f32x16){}; o1[1] = (f32x16){};
    const int qq = (lane & 15) >> 2, pp = lane & 3, half = (lane >> 4) & 1;
    ATT_LOAD(0); ATT_STORE(0);
    for (int t = 0; t < NT; ++t) {
        const int buf = t & 1;
        if (t + 1 < NT) ATT_LOAD(t + 1);
        __syncthreads();
        const int jb = t - (NT - 8);
        const bool skip = (jb >= 0) && (jb > wid);
        if (!skip) {
            const LAS unsigned char* Kb = lds + KOFF + buf * KB; const LAS unsigned char* Vb = lds + VOFF + buf * KB; const LAS float* Cb = (const LAS float*)(lds + COFF + buf * 256);
            f32x16 p0[2], p1[2];
#pragma unroll
            for (int g4 = 0; g4 < 4; ++g4) {
                const f32x4 c0 = *(const LAS f32x4*)(Cb + 8 * g4 + 4 * hi), c1 = *(const LAS f32x4*)(Cb + 32 + 8 * g4 + 4 * hi);
#pragma unroll
                for (int i = 0; i < 4; ++i) { p0[0][4 * g4 + i] = c0[i]; p1[0][4 * g4 + i] = c1[i]; p0[1][4 * g4 + i] = c0[i]; p1[1][4 * g4 + i] = c1[i]; }
            }
#pragma unroll
            for (int d0 = 0; d0 < 4; ++d0) {
                const bf16x8 a0 = *(const LAS bf16x8*)(Kb + r32 * 144 + (16 * d0 + 8 * hi) * 2);
                const bf16x8 a1 = *(const LAS bf16x8*)(Kb + (32 + r32) * 144 + (16 * d0 + 8 * hi) * 2);
                p0[0] = __builtin_amdgcn_mfma_f32_32x32x16_bf16(a0, qr[0][d0], p0[0], 0, 0, 0);
                p0[1] = __builtin_amdgcn_mfma_f32_32x32x16_bf16(a0, qr[1][d0], p0[1], 0, 0, 0);
                p1[0] = __builtin_amdgcn_mfma_f32_32x32x16_bf16(a1, qr[0][d0], p1[0], 0, 0, 0);
                p1[1] = __builtin_amdgcn_mfma_f32_32x32x16_bf16(a1, qr[1][d0], p1[1], 0, 0, 0);
            }
            bf16x8 pa[2][4];
#pragma unroll
            for (int g = 0; g < 2; ++g) {
                if (jb == wid) {
                    const int qrel = 32 * g + r32;
#pragma unroll
                    for (int r = 0; r < 16; ++r) { const int kv = crow(r, hi); if (kv > qrel) p0[g][r] = -INFINITY; if (kv + 32 > qrel) p1[g][r] = -INFINITY; }
                }
                float mx = fmaxf(fmaxf(p0[g][0], p1[g][0]), fmaxf(p0[g][1], p1[g][1]));
#pragma unroll
                for (int r = 2; r < 16; r += 2) mx = fmaxf(fmaxf(mx, fmaxf(p0[g][r], p1[g][r])), fmaxf(p0[g][r + 1], p1[g][r + 1]));
                mx = fmaxf(mx, __shfl_xor(mx, 32));
                if (__any(mx > m[g] + 8.0f)) {
                    const float mn = fmaxf(m[g], mx);
                    const float alpha = __builtin_amdgcn_exp2f(m[g] - mn);
                    m[g] = mn; l[g] *= alpha;
                    if (hi == 0) wsf[g * 32 + r32] = alpha;
                    LDS_WAIT();
#pragma unroll
                    for (int g4 = 0; g4 < 4; ++g4) {
                        const f32x4 a = *(const LAS f32x4*)(wsf + g * 32 + 8 * g4 + 4 * hi);
#pragma unroll
                        for (int i = 0; i < 4; ++i) { o0[g][4 * g4 + i] *= a[i]; o1[g][4 * g4 + i] *= a[i]; }
                    }
                }
                float rsum = 0.f;
#pragma unroll
                for (int r = 0; r < 16; ++r) { p0[g][r] = __builtin_amdgcn_exp2f(p0[g][r] - m[g]); p1[g][r] = __builtin_amdgcn_exp2f(p1[g][r] - m[g]); rsum += p0[g][r] + p1[g][r]; }
                l[g] += rsum;
                { u32x4 w;
                  w.x = pk2(p0[g][0], p0[g][1]); w.y = pk2(p0[g][2], p0[g][3]); w.z = pk2(p0[g][4], p0[g][5]); w.w = pk2(p0[g][6], p0[g][7]); pa[g][0] = __builtin_bit_cast(bf16x8, w);
                  w.x = pk2(p0[g][8], p0[g][9]); w.y = pk2(p0[g][10], p0[g][11]); w.z = pk2(p0[g][12], p0[g][13]); w.w = pk2(p0[g][14], p0[g][15]); pa[g][1] = __builtin_bit_cast(bf16x8, w);
                  w.x = pk2(p1[g][0], p1[g][1]); w.y = pk2(p1[g][2], p1[g][3]); w.z = pk2(p1[g][4], p1[g][5]); w.w = pk2(p1[g][6], p1[g][7]); pa[g][2] = __builtin_bit_cast(bf16x8, w);
                  w.x = pk2(p1[g][8], p1[g][9]); w.y = pk2(p1[g][10], p1[g][11]); w.z = pk2(p1[g][12], p1[g][13]); w.w = pk2(p1[g][14], p1[g][15]); pa[g][3] = __builtin_bit_cast(bf16x8, w); }
            }
#pragma unroll
            for (int j = 0; j < 4; ++j) {
                const LAS unsigned char* vp = Vb + (16 * j + 4 * hi + qq) * 144 + (16 * half + 4 * pp) * 2;
                const bf16x8 v0 = cat8(vtr(vp), vtr(vp + 8 * 144));
                const bf16x8 v1 = cat8(vtr(vp + 64), vtr(vp + 64 + 8 * 144));
                o0[0] = __builtin_amdgcn_mfma_f32_32x32x16_bf16(pa[0][j], v0, o0[0], 0, 0, 0);
                o0[1] = __builtin_amdgcn_mfma_f32_32x32x16_bf16(pa[1][j], v0, o0[1], 0, 0, 0);
                o1[0] = __builtin_amdgcn_mfma_f32_32x32x16_bf16(pa[0][j], v1, o1[0], 0, 0, 0);
                o1[1] = __builtin_amdgcn_mfma_f32_32x32x16_bf16(pa[1][j], v1, o1[1], 0, 0, 0);
            }
        }
        if (t + 1 < NT) ATT_STORE(buf ^ 1);
    }
#undef ATT_LOAD
#undef ATT_STORE
    const float w0 = fnorm[h * 64 + r32], w1 = fnorm[h * 64 + 32 + r32];
#pragma unroll
    for (int g = 0; g < 2; ++g) {
        float lt = l[g]; lt += __shfl_xor(lt, 32);
        if (hi == 0) wsf[g * 32 + r32] = 1.0f / lt;
        LDS_WAIT();
#pragma unroll
        for (int g4 = 0; g4 < 4; ++g4) {
            const f32x4 a = *(const LAS f32x4*)(wsf + g * 32 + 8 * g4 + 4 * hi);
#pragma unroll
            for (int i = 0; i < 4; ++i) { o0[g][4 * g4 + i] *= a[i]; o1[g][4 * g4 + i] *= a[i]; }
        }
#pragma unroll
        for (int r = 0; r < 16; ++r) {
            float s = o0[g][r] * o0[g][r] + o1[g][r] * o1[g][r];
            s += __shfl_xor(s, 1); s += __shfl_xor(s, 2); s += __shfl_xor(s, 4); s += __shfl_xor(s, 8); s += __shfl_xor(s, 16);
            const float rs = rsqrtf(s * (1.0f / 64.0f) + EPS);
            bf16* op = OB + (rowb + q0 + wid * 64 + g * 32 + crow(r, hi)) * DM + 512 + h * 64 + r32;
            op[0] = f2bf(o0[g][r] * rs * w0); op[32] = f2bf(o1[g][r] * rs * w1);
        }
    }
    __syncthreads();
}
__device__ __forceinline__ void meta_attn(const bf16* QKV, const float* CK, bf16* OB, const float* fnorm, int p) {
    int tid_ = threadIdx.x; asm volatile("" : "+v"(tid_)); const int lane = tid_ & 63, h = tid_ >> 6;
    const float q = bf2f(QKV[(size_t)(META0 + p) * QP + C_FQ + h * 64 + lane]);
    float sc[NMETA], vv[NMETA];
#pragma unroll
    for (int s = 0; s < NMETA; ++s) {
        sc[s] = q * bf2f(QKV[(size_t)(META0 + s) * QP + C_FK + h * 64 + lane]);
        vv[s] = bf2f(QKV[(size_t)(META0 + s) * QP + C_FV + h * 64 + lane]);
    }
    float m = -1e30f;
#pragma unroll
    for (int s = 0; s < NMETA; ++s) { sc[s] = (s <= p) ? wave_sum(sc[s]) + CK[(size_t)h * CKP + s] : -INFINITY; m = fmaxf(m, sc[s]); }
    float l = 0.f, o = 0.f;
#pragma unroll
    for (int s = 0; s < NMETA; ++s) { const float pw = __builtin_amdgcn_exp2f(sc[s] - m); l += pw; o += pw * vv[s]; }
    o /= l;
    const float ss = wave_sum(o * o);
    OB[(size_t)(META0 + p) * DM + 512 + h * 64 + lane] = f2bf(o * rsqrtf(ss * (1.0f / 64.0f) + EPS) * fnorm[h * 64 + lane]);
}
template <int NU> __device__ __forceinline__ void gla_readout_wave(const bf16* QKV, const float* UT, bf16* OB, const float* gnorm, const int* bhs, const int* ccs, const int* halfs, int lane) {
    asm volatile("" : "+v"(lane));
    const int r32 = lane & 31, hi = lane >> 5;
    int row0[NU], nvalid[NU], hq[NU]; const float* Sp[NU];
    f32x16 acc[NU][4];
#pragma unroll
    for (int u = 0; u < NU; ++u) {
        const int b = bhs[u] >> 2; hq[u] = bhs[u] & 3;
        row0[u] = ccs[u] == 0 ? META0 : b * SEQ + (ccs[u] - 1) * 64 + 32 * halfs[u]; nvalid[u] = ccs[u] == 0 ? NMETA : 32;
        Sp[u] = UT + (size_t)(bhs[u] * NCH + ccs[u]) * 8192;
#pragma unroll
        for (int blk = 0; blk < 4; ++blk) acc[u][blk] = (f32x16){};
    }
#pragma unroll
    for (int j = 0; j < 4; ++j)
#pragma unroll
        for (int u = 0; u < NU; ++u) {
            const bf16x8 bq = *(const bf16x8*)(QKV + (size_t)(row0[u] + r32) * QP + C_GQ + hq[u] * 64 + 16 * j + 8 * hi);
#pragma unroll
            for (int blk = 0; blk < 4; ++blk) {
                const float* sp = Sp[u] + (32 * blk + r32) * 64 + 16 * j + 8 * hi;
                const f32x4 s0 = *(const f32x4*)sp, s1 = *(const f32x4*)(sp + 4);
                u32x4 w; w.x = pk2(s0[0], s0[1]); w.y = pk2(s0[2], s0[3]); w.z = pk2(s1[0], s1[1]); w.w = pk2(s1[2], s1[3]);
                acc[u][blk] = __builtin_amdgcn_mfma_f32_32x32x16_bf16(__builtin_bit_cast(bf16x8, w), bq, acc[u][blk], 0, 0, 0);
            }
        }
#pragma unroll
    for (int u = 0; u < NU; ++u) {
        float ss = 0.f;
#pragma unroll
        for (int blk = 0; blk < 4; ++blk)
#pragma unroll
            for (int r = 0; r < 16; ++r) ss += acc[u][blk][r] * acc[u][blk][r];
        ss += __shfl_xor(ss, 32);
        const float rs = rsqrtf(ss * (1.0f / 128.0f) + EPS);
        if (r32 < nvalid[u]) {
            const size_t row = (size_t)row0[u] + r32; const int h = hq[u];
#pragma unroll
            for (int blk = 0; blk < 4; ++blk)
#pragma unroll
                for (int g = 0; g < 4; ++g) {
                    const int dv = 32 * blk + 8 * g + 4 * hi;
                    const u32x2 gt = *(const u32x2*)(QKV + row * QP + C_GR + h * 128 + dv);
                    const f32x4 wn = *(const f32x4*)(gnorm + h * 128 + dv);
                    const float g0 = __uint_as_float(gt.x << 16), g1 = __uint_as_float(gt.x & 0xffff0000u), g2 = __uint_as_float(gt.y << 16), g3 = __uint_as_float(gt.y & 0xffff0000u);
                    u32x2 w;
                    w.x = pk2(acc[u][blk][4 * g] * rs * wn[0] * siluf(g0), acc[u][blk][4 * g + 1] * rs * wn[1] * siluf(g1));
                    w.y = pk2(acc[u][blk][4 * g + 2] * rs * wn[2] * siluf(g2), acc[u][blk][4 * g + 3] * rs * wn[3] * siluf(g3));
                    *(u32x2*)(OB + row * DM + h * 128 + dv) = w;
                }
        }
    }
}

__device__ __forceinline__ void gla_readout_chunk(const bf16* QKV, const float* UT, bf16* OB, const float* gnorm, int bh, int cc, int lane) {
    asm volatile("" : "+v"(lane));
    const int r32 = lane & 31, hi = lane >> 5, b = bh >> 2, h = bh & 3;
    const int row0 = b * SEQ + (cc - 1) * 64;
    const float* Sp = UT + (size_t)(bh * NCH + cc) * 8192;
    f32x16 acc[2][4];
#pragma unroll
    for (int u = 0; u < 2; ++u)
#pragma unroll
        for (int blk = 0; blk < 4; ++blk) acc[u][blk] = (f32x16){};
#pragma unroll 1
    for (int j = 0; j < 4; ++j) {
        const bf16x8 bq0 = *(const bf16x8*)(QKV + (size_t)(row0 + r32) * QP + C_GQ + h * 64 + 16 * j + 8 * hi);
        const bf16x8 bq1 = *(const bf16x8*)(QKV + (size_t)(row0 + 32 + r32) * QP + C_GQ + h * 64 + 16 * j + 8 * hi);
#pragma unroll
        for (int blk = 0; blk < 4; ++blk) {
            const float* sp = Sp + (32 * blk + r32) * 64 + 16 * j + 8 * hi;
            const f32x4 s0 = *(const f32x4*)sp, s1 = *(const f32x4*)(sp + 4);
            u32x4 w; w.x = pk2(s0[0], s0[1]); w.y = pk2(s0[2], s0[3]); w.z = pk2(s1[0], s1[1]); w.w = pk2(s1[2], s1[3]);
            const bf16x8 sa = __builtin_bit_cast(bf16x8, w);
            acc[0][blk] = __builtin_amdgcn_mfma_f32_32x32x16_bf16(sa, bq0, acc[0][blk], 0, 0, 0);
            acc[1][blk] = __builtin_amdgcn_mfma_f32_32x32x16_bf16(sa, bq1, acc[1][blk], 0, 0, 0);
        }
    }
#pragma unroll
    for (int u = 0; u < 2; ++u) {
        float ss = 0.f;
#pragma unroll
        for (int blk = 0; blk < 4; ++blk)
#pragma unroll
            for (int r = 0; r < 16; ++r) ss += acc[u][blk][r] * acc[u][blk][r];
        ss += __shfl_xor(ss, 32);
        const float rs = rsqrtf(ss * (1.0f / 128.0f) + EPS);
        const size_t row = (size_t)row0 + 32 * u + r32;
#pragma unroll
        for (int blk = 0; blk < 4; ++blk)
#pragma unroll
            for (int g = 0; g < 4; ++g) {
                const int dv = 32 * blk + 8 * g + 4 * hi;
                const u32x2 gt = *(const u32x2*)(QKV + row * QP + C_GR + h * 128 + dv);
                const f32x4 wn = *(const f32x4*)(gnorm + h * 128 + dv);
                const float g0 = __uint_as_float(gt.x << 16), g1 = __uint_as_float(gt.x & 0xffff0000u), g2 = __uint_as_float(gt.y << 16), g3 = __uint_as_float(gt.y & 0xffff0000u);
                u32x2 w;
                w.x = pk2(acc[u][blk][4 * g] * rs * wn[0] * siluf(g0), acc[u][blk][4 * g + 1] * rs * wn[1] * siluf(g1));
                w.y = pk2(acc[u][blk][4 * g + 2] * rs * wn[2] * siluf(g2), acc[u][blk][4 * g + 3] * rs * wn[3] * siluf(g3));
                *(u32x2*)(OB + row * DM + h * 128 + dv) = w;
            }
    }
}

#define FRESH() KArgs ka_ = kargs(); Args a; a.x = gptr(ka_->x); a.meta = gptr(ka_->meta); a.attn_norm = gptr(ka_->attn_norm); a.w_in = gptr(ka_->w_in); a.w_au = gptr(ka_->w_au); a.b_alpha = gptr(ka_->b_alpha); a.b_forget = gptr(ka_->b_forget); a.gla_norm = gptr(ka_->gla_norm); a.fox_norm = gptr(ka_->fox_norm); a.w_out = gptr(ka_->w_out); a.ffn_norm = gptr(ka_->ffn_norm); a.w_up = gptr(ka_->w_up); a.conv_w = gptr(ka_->conv_w); a.conv_b = gptr(ka_->conv_b); a.w_down = gptr(ka_->w_down); a.final_norm = gptr(ka_->final_norm); a.out = gptr(ka_->out); a.ws = gptr(ka_->ws); unsigned char* ws = a.ws; \
    bf16* HB = (bf16*)(ws + WS_HB); bf16* OB = (bf16*)(ws + WS_OB); bf16* QKV = (bf16*)(ws + WS_QKV); bf16* A2 = (bf16*)(ws + WS_QKV); \
    float* UT = (float*)(ws + WS_UT); float* HF = (float*)(ws + WS_UT); float* HL = (float*)(ws + WS_UT + HFL_SIZE); \
    float* SM = (float*)(ws + WS_SM); float* CK = (float*)(ws + WS_CK); float* DEC = (float*)(ws + WS_DEC); float* HM = (float*)(ws + WS_HM); float* SSQ = (float*)(ws + WS_SSQ); \
    unsigned char* wl = ws + WS_W + (size_t)L * WL_SIZE; \
    (void)HB; (void)OB; (void)QKV; (void)A2; (void)UT; (void)HF; (void)HL; (void)SM; (void)CK; (void)DEC; (void)HM; (void)SSQ; (void)wl; \
    int G_ = gridDim.x, bx_ = blockIdx.x; asm volatile("" : "+s"(G_), "+s"(bx_)); const int G = G_, bx = bx_; (void)G; (void)bx; \
    int tid_ = threadIdx.x; asm volatile("" : "+v"(tid_)); const int tid = tid_, lane = tid & 63, wid = __builtin_amdgcn_readfirstlane(tid >> 6); \
    const int gw = bx * 8 + wid, NGW = G * 8, gt = bx * 512 + tid, NGT = G * 512; (void)lane; (void)gw; (void)NGW; (void)gt; (void)NGT;
#ifndef REP_A
#define REP_A 1
#endif
#ifndef REP_CA
#define REP_CA 1
#endif
#ifndef REP_F
#define REP_F 1
#endif
#ifndef REP_B
#define REP_B 1
#endif
#ifndef REP_D
#define REP_D 1
#endif
#define GSYNC_CG() do { asm volatile("s_waitcnt vmcnt(0) lgkmcnt(0)" ::: "memory"); grid.sync(); __builtin_amdgcn_fence(__ATOMIC_ACQUIRE, "agent"); asm volatile("s_waitcnt vmcnt(0)" ::: "memory"); } while (0)
#ifdef PROBE_PH
#define PH_END(id) do { const unsigned long long tn_ = __builtin_amdgcn_s_memrealtime(); if ((PROBE_PH >> (id)) & 1) tsync += tn_ - tlast; tlast = tn_; } while (0)
#else
#define PH_END(id) do {} while (0)
#endif
#ifdef PROBE_SYNC
#define GSYNC() do { const unsigned long long t0_ = __builtin_amdgcn_s_memrealtime(); xcd_barrier(xbar); tsync += __builtin_amdgcn_s_memrealtime() - t0_; } while (0)
#else
#define GSYNC() do { XcdBarrier xb_; xb_.bar = (unsigned*)(gptr(kargs()->ws) + WS_BAR); xb_.x = xb_xcc_id(); xb_.st = (volatile LAS unsigned*)(lds + HALO_OFF + 8192 + 1024); xcd_barrier(xb_); } while (0)
#endif
__global__ void __launch_bounds__(512, 2) fwd_kernel(Args a_unused) {
    extern __shared__ __attribute__((aligned(16))) unsigned char lds_raw[];
    LAS unsigned char* lds = (LAS unsigned char*)lds_raw;
    cg::grid_group grid = cg::this_grid();
#if defined(PROBE_SYNC) || defined(PROBE_PH)
    unsigned long long tsync = 0ull, tlast = __builtin_amdgcn_s_memrealtime(); (void)tlast;
#endif
    volatile LAS unsigned* xst = (volatile LAS unsigned*)(lds + HALO_OFF + 8192 + 1024);
    if (threadIdx.x < 2) xst[threadIdx.x] = 0u;
    __syncthreads();
    (void)xcd_barrier_post((unsigned*)(gptr(kargs()->ws) + WS_BAR), xst);
#ifndef REP_P
#define REP_P 1
#endif
    for (int rep = 0; rep < REP_P; ++rep) {
        const int L = 0; FRESH();
        LAS float* scr = (LAS float*)(lds + wid * 16384);
        constexpr int I_IN = 16 * (NINP / 32), I_OUT = 16 * 32, I_UP = 16 * (NUP / 32), I_DN = (DFF / 64) * 32, I_L = I_IN + I_OUT + I_UP + I_DN;
        for (int it = gw; it < DEPTH * I_L; it += NGW) {
            const int L = it / I_L; int r = it % I_L;
            unsigned char* wl = ws + WS_W + (size_t)L * WL_SIZE;
            if (r < I_IN) { const int nb = NINP / 32; tr_item(a.w_in + (size_t)L * DM * 3096, 3096, (bf16*)(wl + WL_IN), DM, a.attn_norm + L * DM, 0, scr, 64 * (r / nb), 32 * (r % nb), lane); continue; } r -= I_IN;
            if (r < I_OUT) { tr_item(a.w_out + (size_t)L * DM * DM, DM, (bf16*)(wl + WL_OUT), DM, nullptr, 1, scr, 64 * (r / 32), 32 * (r % 32), lane); continue; } r -= I_OUT;
            if (r < I_UP) { const int nb = NUP / 32; tr_item(a.w_up + (size_t)L * DM * NUP, NUP, (bf16*)(wl + WL_UP), DM, a.ffn_norm + L * DM, 2, scr, 64 * (r / nb), 32 * (r % nb), lane); continue; } r -= I_UP;
            tr_item(a.w_down + (size_t)L * DFF * DM, DM, (bf16*)(wl + WL_DN), DFF, nullptr, 3, scr, 64 * (r / 32), 32 * (r % 32), lane);
        }
        for (int i = gt; i < (256 - NMETA) * 4; i += NGT) SSQ[(size_t)(META0 + NMETA) * 4 + i] = 0.f;
        for (int r = gw; r < MREAL + 256; r += NGW) {
            if (r < MREAL) row_to_bf16(a.x + (size_t)r * DM, HB + (size_t)r * DM, SSQ + (size_t)r * 4, nullptr, lane);
            else if (r < MREAL + NMETA) row_to_bf16(a.meta + (size_t)(r - MREAL) * DM, HB + (size_t)r * DM, SSQ + (size_t)r * 4, HM + (size_t)(r - MREAL) * DM, lane);
            else {
#pragma unroll
                for (int j = 0; j < 4; ++j) { ((f32x4*)(HM + (size_t)(r - MREAL) * DM) + lane)[64 * j] = (f32x4){0.f, 0.f, 0.f, 0.f};
                    ((u32x2*)(HB + (size_t)r * DM) + lane)[64 * j] = (u32x2){0u, 0u}; ((u32x2*)(OB + (size_t)r * DM) + lane)[64 * j] = (u32x2){0u, 0u}; }
            }
        }
    }
    GSYNC_CG(); PH_END(0);

    for (int L = 0; L < DEPTH; ++L) {
#ifndef SKIP_A
        {
            FRESH();
            pg8::Gemm g{HB, (const bf16*)(wl + WL_IN), MROWS, NINP, DM}; pg8::StaticOrder S; S.init(MROWS, NINP, G, bx);
            EpiIn E{2 * L};
            for (int rep = 0; rep < REP_A; ++rep) pg8::gemm_phase<EpiIn, pg8::StaticOrder, true, true>(lds, g, S, E);
        }
#endif
        GSYNC(); PH_END(1);
#ifndef SKIP_B
        { FRESH();
        for (int rep = 0; rep < REP_B; ++rep) {
        for (int gr = bx; gr < 16 * NCH; gr += G) gla_u_group<2>(lds, QKV, SM, a.w_au + (size_t)L * 16 * 256, a.b_alpha + L * 256, UT, DEC, gr);
        for (int u = (G == 256) ? bx - 64 + ((bx < 64) ? 256 : 0) : bx; u < 64; u += G) fox_cumsum_unit(lds, SM, a.b_forget + L * 8, CK, u);
        }
        }
#endif
        GSYNC(); PH_END(2);
#ifndef SKIP_CS
        { FRESH();
        for (int e = gt; e < 32 * 2048; e += NGT) {
            const int bh = e >> 11, rem = (e & 2047) * 4, dk = rem & 63;
            float* up = UT + (size_t)bh * NCH * 8192 + rem; const float* dp = DEC + (size_t)bh * NCH * 64 + dk;
            f32x4 Sv = *(const f32x4*)up;
            for (int c0 = 1; c0 <= 64; c0 += 8) {
                f32x4 uu[8], dd[8];
#pragma unroll
                for (int i = 0; i < 8; ++i) { uu[i] = *(const f32x4*)(up + (size_t)(c0 + i) * 8192); dd[i] = *(const f32x4*)(dp + (c0 + i) * 64); }
#pragma unroll
                for (int i = 0; i < 8; ++i) { Sv = dd[i] * Sv + uu[i]; *(f32x4*)(up + (size_t)(c0 + i) * 8192) = Sv; }
            }
        }
#ifdef REP_SCAN
        for (int e = gt; e < 32 * 2048; e += NGT) {
            const int bh = e >> 11, rem = (e & 2047) * 4, dk = rem & 63;
            float* up = UT + (size_t)bh * NCH * 8192 + rem; const float* dp = DEC + (size_t)bh * NCH * 64 + dk;
            for (int c0 = 1; c0 <= 64; c0 += 8) {
                f32x4 uu[8], dd[8];
#pragma unroll
                for (int i = 0; i < 8; ++i) { uu[i] = *(const f32x4*)(up + (size_t)(c0 + i) * 8192); dd[i] = *(const f32x4*)(dp + (c0 + i) * 64); }
#pragma unroll
                for (int i = 0; i < 8; ++i) { *(f32x4*)(up + (size_t)(c0 + i) * 8192) = uu[i] + dd[i] * 0.f; }
            }
        }
#endif
        }
        { FRESH();
        for (int rep = 0; rep < REP_CA; ++rep)
        for (int v0 = bx; v0 < 256; v0 += G) {
            const int v = (G == 256) ? (v0 & 7) * 32 + (v0 >> 3) : v0;
            const int bhh = v >> 2, s = v & 3;
#pragma unroll 1
            for (int i = 0; i < 2; ++i) {
                const int qb = (i == 0) ? s : 7 - s;
                attn_unit(lds, QKV, CK, OB, a.fox_norm + L * 512, bhh >> 3, bhh & 7, qb);
            }
        }
#endif
#ifndef SKIP_CM
        }
        { FRESH();
#ifndef REP_CM
#define REP_CM 1
#endif
        for (int rep = 0; rep < REP_CM; ++rep)
        if (bx < NMETA) meta_attn(QKV, CK, OB, a.fox_norm + L * 512, bx);
        if (bx >= NMETA && bx < NMETA + 4 && wid == 0) { const int bhs[1] = {bx - NMETA}, ccs[1] = {0}, hfs[1] = {0}; gla_readout_wave<1>(QKV, UT, OB, a.gla_norm + L * 512, bhs, ccs, hfs, lane); }
        }
#endif
        GSYNC(); PH_END(3);
#ifndef SKIP_D
        { FRESH();
        for (int rep = 0; rep < REP_D; ++rep)
        for (int wu = gw; wu < 32 * 64; wu += NGW) gla_readout_chunk(QKV, UT, OB, a.gla_norm + L * 512, wu >> 6, 1 + (wu & 63), lane);
        }
#endif
        GSYNC(); PH_END(4);
#ifndef SKIP_E
        {
            FRESH();
            meta_rowgemm(OB + (size_t)META0 * DM, DM, (const bf16*)(wl + WL_OUT), DM, HM, HB, G, bx);
            pg8::Gemm g{OB, (const bf16*)(wl + WL_OUT), MREAL, DM, DM}; pg8::StaticOrder S; S.init(MREAL, DM, G, bx);
            if (L == 0) { EpiRes<true, false> E{2 * L + 1}; pg8::gemm_phase<EpiRes<true, false>, pg8::StaticOrder, true, true>(lds, g, S, E); }
            else { EpiRes<false, false> E{2 * L + 1}; pg8::gemm_phase<EpiRes<false, false>, pg8::StaticOrder, true, true>(lds, g, S, E); }
        }
#endif
        GSYNC(); PH_END(5);
#ifndef SKIP_F
        {
            FRESH();
            meta_up(lds, HB, (const bf16*)(wl + WL_UP), HM, a.conv_w + (size_t)L * 3 * NUP, a.conv_b + (size_t)L * NUP, A2, HL, G, bx);
            pg8::Gemm g{HB, (const bf16*)(wl + WL_UP), MREAL, NUP, DM}; pg8::StaticOrder S; S.init(MREAL, NUP, G, bx);
            EpiUp E{L};
            for (int rep = 0; rep < REP_F; ++rep) pg8::gemm_phase<EpiUp, pg8::StaticOrder, true, true>(lds, g, S, E);
        }
#endif
        GSYNC(); PH_END(6);
#ifndef SKIP_H
        {
            FRESH();
            const float* cw = a.conv_w + (size_t)L * 3 * NUP; const float* cb = a.conv_b + (size_t)L * NUP;
            { int pm = 0;
              for (int ui = 0; so_next_pm(MREAL / 256, DM / 256, G, bx, ui, pm); ++ui) {
                for (int i = tid; i < 2 * (DFF / 4); i += 512) {
                    const int c4 = i % (DFF / 4), rr = i / (DFF / 4);
                    const int ch = 4 * c4;
                    f32x4 hc[2];
#pragma unroll
                    for (int bj = 0; bj < 2; ++bj) {
                        const int c = bj * DFF + ch;
                        f32x4 P0 = {0.f, 0.f, 0.f, 0.f}, P1 = P0;
                        if (pm != 128) { const int src = (pm % 16 == 0) ? 128 : pm - 1; P0 = *(const f32x4*)(HL + (size_t)(src * 2) * NUP + c); P1 = *(const f32x4*)(HL + (size_t)(src * 2 + 1) * NUP + c); }
                        const f32x4 H0 = *(const f32x4*)(HF + (size_t)(pm * 2) * NUP + c), H1 = *(const f32x4*)(HF + (size_t)(pm * 2 + 1) * NUP + c);
                        const f32x4 x2 = rr == 0 ? P0 : P1, x1 = rr == 0 ? P1 : H0, x0 = rr == 0 ? H0 : H1;
                        hc[bj] = *(const f32x4*)(cb + c) + *(const f32x4*)(cw + c) * x2 + *(const f32x4*)(cw + NUP + c) * x1 + *(const f32x4*)(cw + 2 * NUP + c) * x0;
                    }
                    u32x2 w;
                    w.x = pk2(siluf(hc[1][0]) * hc[0][0], siluf(hc[1][1]) * hc[0][1]);
                    w.y = pk2(siluf(hc[1][2]) * hc[0][2], siluf(hc[1][3]) * hc[0][3]);
                    *(u32x2*)(A2 + (size_t)(pm * 256 + rr) * DFF + ch) = w;
                }
              }
            }
            asm volatile("s_waitcnt vmcnt(0)" ::: "memory"); __syncthreads();
            meta_rowgemm(A2 + (size_t)META0 * DFF, DFF, (const bf16*)(wl + WL_DN), DFF, HM, HB, G, bx);
            pg8::Gemm g{A2, (const bf16*)(wl + WL_DN), MREAL, DM, DFF}; pg8::StaticOrder S; S.init(MREAL, DM, G, bx);
            if (L == DEPTH - 1) { EpiRes<false, true> E{2 * L + 2}; pg8::gemm_phase<EpiRes<false, true>, pg8::StaticOrder, true, true>(lds, g, S, E); }
            else { EpiRes<false, false> E{2 * L + 2}; pg8::gemm_phase<EpiRes<false, false>, pg8::StaticOrder, true, true>(lds, g, S, E); }
        }
#endif
        GSYNC(); PH_END(7);
    }
    {
        const int L = 0; FRESH();
        const float* ssq = ssq_arr(ws, 8);
        for (int r = gw; r < MREAL; r += NGW) {
            const float rs = row_rstd(ssq, r);
            f32x4* p = (f32x4*)(a.out + (size_t)r * DM) + lane; const f32x4* wn = (const f32x4*)a.final_norm + lane;
#pragma unroll
            for (int j = 0; j < 4; ++j) p[64 * j] = p[64 * j] * rs * wn[64 * j];
        }
#if defined(PROBE_SYNC) || defined(PROBE_PH)
        asm volatile("s_waitcnt vmcnt(0)" ::: "memory"); __syncthreads();
        if (bx == PROBE_BLOCK && tid == 0) a.out[(size_t)PROBE_BLOCK * 16 * DM * 0 + 5] += floorf((float)tsync * 0.0002f + 0.5f);
#endif
    }
}

extern "C" void kernel_launch(void* const* d_in, const int* in_sizes, int n_in, void* d_out, int out_size, void* d_ws, size_t ws_size, hipStream_t stream) {
    static int grid = 0;
    if (grid == 0) {
        if (n_in != 16 || out_size != MREAL * DM || ws_size < WS_END) { fprintf(stderr, "kernel_launch: unexpected problem (n_in %d out %d ws %zu, need %zu)\n", n_in, out_size, ws_size, (size_t)WS_END); grid = -1; return; }
        int dev = 0, cus = 0, per = 0;
        (void)hipGetDevice(&dev); (void)hipDeviceGetAttribute(&cus, hipDeviceAttributeMultiprocessorCount, dev);
        (void)hipFuncSetAttribute((const void*)fwd_kernel, hipFuncAttributeMaxDynamicSharedMemorySize, LDS_BYTES);
        (void)hipOccupancyMaxActiveBlocksPerMultiprocessor(&per, (const void*)fwd_kernel, 512, LDS_BYTES);
        if (per < 1) per = 1;
        grid = cus * per;
        fprintf(stderr, "kernel_launch: grid %d (cus %d x %d), ws %zu\n", grid, cus, per, ws_size);
    }
    if (grid < 0) return;
    Args a{};
    const float** f = (const float**)&a;
    for (int i = 0; i < 16; ++i) f[i] = (const float*)d_in[i];
    a.out = (float*)d_out; a.ws = (unsigned char*)d_ws;
    (void)hipMemsetAsync((unsigned char*)d_ws + WS_BAR, 0, BAR_BYTES, stream);
    void* args[] = {&a};
    hipError_t e = hipLaunchCooperativeKernel((const void*)fwd_kernel, dim3(grid), dim3(512), args, LDS_BYTES, stream);
    if (e != hipSuccess) fprintf(stderr, "cooperative launch failed: %s (grid %d)\n", hipGetErrorString(e), grid);
}
```

```cpp
#include <hip/hip_runtime.h>
#include <hip/hip_cooperative_groups.h>
#include <cstdio>
#include <cstdint>
namespace cg = cooperative_groups;
namespace pg8 {
#define PG8_LAS __attribute__((address_space(3)))
typedef unsigned short bf16_t;
typedef short bf16x8 __attribute__((ext_vector_type(8)));
typedef float f32x4 __attribute__((ext_vector_type(4)));
typedef unsigned u32x4 __attribute__((ext_vector_type(4)));
constexpr int BM = 256, BK = 64, HALF = 128, HTB = HALF * BK * 2  , STAGE_BYTES = 8 * HTB, NXCD = 8, WGM = 8;

__host__ __device__ __forceinline__ int lds_byte(int r, int c) { const int st = (r >> 4) * 2 + (c >> 5), rr = r & 15, cc = c & 31, ob = rr * 64 + cc * 2; return st * 1024 + (ob ^ (((ob >> 9) & 1) << 5)); }
__host__ __device__ __forceinline__ void stage_rc(int b, int& R, int& C) { const int st = b / 1024, sb = b % 1024, swz = sb ^ (((sb >> 9) & 1) << 5); R = (st >> 1) * 16 + swz / 64; C = (st & 1) * 32 + (swz % 64) / 2; }
__host__ __device__ __forceinline__ int perm32(int rho) { const int n = rho >> 4, i = rho & 15; return 8 * (i >> 2) + 4 * n + (i & 3); }

struct Unit { int pm, pn; };
struct Gemm { const bf16_t* A; const bf16_t* Bt; int M, N, K; };

struct StaticOrder {
    int nM, nN, nwg, G, c;
    __host__ __device__ void init(int M, int N, int G_, int c_) { nM = M / BM; nN = N / BM; nwg = nM * nN; G = G_; c = c_; }
    __host__ __device__ bool next(int i, Unit& u) const {
        const long L = (long)i * G + c; if (L >= nwg) return false;
        int wgid = (int)L; { const int q = nwg / NXCD, r = nwg % NXCD, xcd = wgid % NXCD, off = wgid / NXCD; wgid = (xcd < r ? xcd * (q + 1) : r * (q + 1) + (xcd - r) * q) + off; }
        const int nig = WGM * nN, gid = wgid / nig, fm = gid * WGM, gsz = (nM - fm) < WGM ? (nM - fm) : WGM;
        u.pm = fm + ((wgid % nig) % gsz); u.pn = (wgid % nig) / gsz; return true;
    }
    __device__ __forceinline__ void a_ready(const Unit&) const {}
    __device__ __forceinline__ void done(const Unit&) const {}
};

__device__ __forceinline__ unsigned cvt_pk_bf16(float lo, float hi) { unsigned r; asm volatile("v_cvt_pk_bf16_f32 %0, %1, %2" : "=v"(r) : "v"(lo), "v"(hi)); return r; }
typedef float f32x2 __attribute__((ext_vector_type(2)));
template <class Epi, class Sched, bool ALIGN_EPI = false, bool SP2 = false>
__device__ __forceinline__ void gemm_phase(PG8_LAS unsigned char* lds, const Gemm g, const Sched& S, const Epi& E) {
    int tid_ = threadIdx.x; asm volatile("" : "+v"(tid_)); const int tid = tid_, wid = __builtin_amdgcn_readfirstlane(tid >> 6), lane = tid & 63, wr = wid >> 2, wc = wid & 3, fr = lane & 15, fq = lane >> 4;
    const int K = g.K, nt = K / BK;
    unsigned voffA[2], voffB[2];
#pragma unroll
    for (int i = 0; i < 2; ++i) { int R, C; stage_rc(tid * 16 + i * 8192, R, C); const int Rb = Epi::PERM ? ((R & ~31) + perm32(R & 31)) : R;
        voffA[i] = (unsigned)(R * K + C) * 2u; voffB[i] = (unsigned)(Rb * K + C) * 2u; }
    const size_t kstep = (size_t)(BK * 2);
    const size_t hstep = (size_t)HALF * K * 2;
    const size_t tstep = 2 * hstep;
    const unsigned ldsw = (unsigned)wid * 1024u;
    const int aoff = lds_byte(wr * 64 + fr, fq * 8), boff = lds_byte(wc * 32 + fr, fq * 8);
#define PG8_SA(b, h) (((b) * 2 + (h)) * HTB)
#define PG8_SB(b, h) ((4 + (b) * 2 + (h)) * HTB)
#define PG8_STAGE(bufoff, gbase, voff) do { _Pragma("unroll") for (int _i = 0; _i < 2; ++_i) \
        __builtin_amdgcn_global_load_lds((const unsigned*)((const char*)(gbase) + (voff)[_i]), (PG8_LAS unsigned*)(lds + (bufoff) + ldsw + _i * 8192), 16, 0, 0); } while (0)
#define PG8_LDA(dst, b, h) do { _Pragma("unroll") for (int m = 0; m < 4; ++m) _Pragma("unroll") for (int k = 0; k < 2; ++k) dst[m][k] = *(const PG8_LAS bf16x8*)(lds + PG8_SA(b, h) + aoff + m * 2048 + k * 1024); } while (0)
#define PG8_LDB(dst, b, h) do { _Pragma("unroll") for (int n = 0; n < 2; ++n) _Pragma("unroll") for (int k = 0; k < 2; ++k) dst[n][k] = *(const PG8_LAS bf16x8*)(lds + PG8_SB(b, h) + boff + n * 2048 + k * 1024); } while (0)
#define PG8_MMA(ai, bj, At, Bt) do { __builtin_amdgcn_s_setprio(1); _Pragma("unroll") for (int m = 0; m < 4; ++m) _Pragma("unroll") for (int n = 0; n < 2; ++n) _Pragma("unroll") for (int k = 0; k < 2; ++k) \
        acc[ai][bj][m][n] = __builtin_amdgcn_mfma_f32_16x16x32_bf16(Bt[n][k], At[m][k], acc[ai][bj][m][n], 0, 0, 0); __builtin_amdgcn_s_setprio(0); } while (0)
#define PG8_WAIT_V(n) asm volatile("s_waitcnt vmcnt(" #n ")" ::: "memory")
#define PG8_WAIT_L(n) asm volatile("s_waitcnt lgkmcnt(" #n ")" ::: "memory")
#define PG8_BAR __builtin_amdgcn_s_barrier()
#define PG8_SCHED __builtin_amdgcn_sched_barrier(0)
    Unit cur, nxt; int ui = 0;
    if (!S.next(0, cur)) return;
    f32x4 acc[2][2][4][2];
#pragma unroll
    for (int a = 0; a < 2; ++a)
#pragma unroll
        for (int b = 0; b < 2; ++b)
#pragma unroll
            for (int m = 0; m < 4; ++m)
#pragma unroll
                for (int n = 0; n < 2; ++n) acc[a][b][m][n] = (f32x4){0.f, 0.f, 0.f, 0.f};
    bf16x8 At[4][2], B0[2][2], B1[2][2];
    const char* cA = (const char*)g.A + (size_t)cur.pm * tstep; const char* cB = (const char*)g.Bt + (size_t)cur.pn * tstep;
    S.a_ready(cur);
    if constexpr (SP2) {
        PG8_STAGE(PG8_SB(0, 0), cB, voffB); PG8_STAGE(PG8_SB(0, 1), cB + hstep, voffB); PG8_STAGE(PG8_SA(0, 0), cA, voffA); PG8_STAGE(PG8_SA(0, 1), cA + hstep, voffA);
        if (wr == 1) PG8_BAR;
        PG8_WAIT_V(2); PG8_BAR;
        PG8_STAGE(PG8_SB(1, 0), cB + kstep, voffB); PG8_STAGE(PG8_SA(1, 0), cA + kstep, voffA); PG8_STAGE(PG8_SB(1, 1), cB + hstep + kstep, voffB);
        PG8_WAIT_V(6); PG8_BAR;
    } else {
        PG8_STAGE(PG8_SB(0, 0), cB, voffB); PG8_STAGE(PG8_SA(0, 0), cA, voffA); PG8_STAGE(PG8_SB(0, 1), cB + hstep, voffB); PG8_STAGE(PG8_SA(0, 1), cA + hstep, voffA);
        if (wr == 1) PG8_BAR;
        PG8_WAIT_V(4); PG8_BAR;
        PG8_STAGE(PG8_SB(1, 0), cB + kstep, voffB); PG8_STAGE(PG8_SA(1, 0), cA + kstep, voffA); PG8_STAGE(PG8_SB(1, 1), cB + hstep + kstep, voffB);
        PG8_WAIT_V(6); PG8_BAR;
    }
    for (;;) {
        const bool has_next = S.next(ui + 1, nxt);
        const char* nA = has_next ? (const char*)g.A + (size_t)nxt.pm * tstep : cA; const char* nB = has_next ? (const char*)g.Bt + (size_t)nxt.pn * tstep : cB;
        for (int t = 0; t < nt; t += 2) {
            const bool last = (t == nt - 2);
            const char* a1 = cA + (size_t)(t + 1) * kstep;
            const char* a2 = last ? nA : cA + (size_t)(t + 2) * kstep; const char* b2 = last ? nB : cB + (size_t)(t + 2) * kstep;
            const char* a3 = a2 + kstep; const char* b3 = b2 + kstep;
            if (last && has_next) S.a_ready(nxt);
            if constexpr (SP2) {
            PG8_LDB(B0, 0, 0); PG8_LDB(B1, 0, 1); PG8_SCHED; PG8_LDA(At, 0, 0); PG8_STAGE(PG8_SA(1, 1), a1 + hstep, voffA);
            PG8_WAIT_V(8); PG8_WAIT_L(0); PG8_BAR; PG8_MMA(0, 0, At, B0); PG8_MMA(0, 1, At, B1); PG8_BAR; PG8_SCHED;
            PG8_LDA(At, 0, 1); PG8_STAGE(PG8_SB(0, 0), b2, voffB); PG8_STAGE(PG8_SB(0, 1), b2 + hstep, voffB); PG8_STAGE(PG8_SA(0, 0), a2, voffA);
            PG8_WAIT_V(8); PG8_WAIT_L(0); PG8_BAR; PG8_MMA(1, 0, At, B0); PG8_MMA(1, 1, At, B1); PG8_BAR; PG8_SCHED;
            PG8_LDB(B0, 1, 0); PG8_LDB(B1, 1, 1); PG8_SCHED; PG8_LDA(At, 1, 0); PG8_STAGE(PG8_SA(0, 1), a2 + hstep, voffA);
            PG8_WAIT_V(8); PG8_WAIT_L(0); PG8_BAR; PG8_MMA(0, 0, At, B0); PG8_MMA(0, 1, At, B1); PG8_BAR; PG8_SCHED;
            PG8_LDA(At, 1, 1); PG8_STAGE(PG8_SB(1, 0), b3, voffB); PG8_STAGE(PG8_SB(1, 1), b3 + hstep, voffB); PG8_STAGE(PG8_SA(1, 0), a3, voffA);
            PG8_WAIT_V(8); PG8_WAIT_L(0); PG8_BAR; PG8_MMA(1, 0, At, B0); PG8_MMA(1, 1, At, B1); PG8_BAR; PG8_SCHED;
            } else {
            PG8_LDB(B0, 0, 0); PG8_SCHED; PG8_LDA(At, 0, 0); PG8_STAGE(PG8_SA(1, 1), a1 + hstep, voffA);
            PG8_WAIT_L(8); PG8_BAR; PG8_WAIT_L(0); PG8_MMA(0, 0, At, B0); PG8_BAR; PG8_SCHED;
            PG8_LDB(B1, 0, 1); PG8_STAGE(PG8_SB(0, 0), b2, voffB);
            PG8_BAR; PG8_WAIT_L(0); PG8_MMA(0, 1, At, B1); PG8_BAR;
            PG8_LDA(At, 0, 1); PG8_STAGE(PG8_SA(0, 0), a2, voffA);
            PG8_BAR; PG8_WAIT_L(0); PG8_MMA(1, 0, At, B0); PG8_BAR; PG8_SCHED;
            PG8_STAGE(PG8_SB(0, 1), b2 + hstep, voffB);
            PG8_WAIT_V(6); PG8_BAR; PG8_MMA(1, 1, At, B1); PG8_BAR;
            PG8_LDB(B0, 1, 0); PG8_SCHED; PG8_LDA(At, 1, 0); PG8_STAGE(PG8_SA(0, 1), a2 + hstep, voffA);
            PG8_WAIT_L(8); PG8_BAR; PG8_WAIT_L(0); PG8_MMA(0, 0, At, B0); PG8_BAR; PG8_SCHED;
            PG8_LDB(B1, 1, 1); PG8_STAGE(PG8_SB(1, 0), b3, voffB);
            PG8_BAR; PG8_WAIT_L(0); PG8_MMA(0, 1, At, B1); PG8_BAR;
            PG8_LDA(At, 1, 1); PG8_STAGE(PG8_SA(1, 0), a3, voffA);
            PG8_BAR; PG8_WAIT_L(0); PG8_MMA(1, 0, At, B0); PG8_BAR; PG8_SCHED;
            PG8_STAGE(PG8_SB(1, 1), b3 + hstep, voffB);
            PG8_WAIT_V(6); PG8_BAR; PG8_MMA(1, 1, At, B1); PG8_BAR;
            }
        }
        if constexpr (ALIGN_EPI) { if (wr == 0) PG8_BAR; }
        if constexpr (!Epi::AFTER_DRAIN) { E(acc, cur, wr, wc, fr, fq); S.done(cur); }
        if (!has_next) break;
#pragma unroll
        for (int a = 0; a < 2; ++a)
#pragma unroll
            for (int b = 0; b < 2; ++b)
#pragma unroll
                for (int m = 0; m < 4; ++m)
#pragma unroll
                    for (int n = 0; n < 2; ++n) acc[a][b][m][n] = (f32x4){0.f, 0.f, 0.f, 0.f};
        cur = nxt; cA = nA; cB = nB; ++ui;
        if constexpr (ALIGN_EPI) { if (wr == 1) PG8_BAR; }
    }
    PG8_WAIT_V(0);
    if constexpr (!ALIGN_EPI) { if (wr == 0) PG8_BAR; }
    PG8_BAR;
    if constexpr (Epi::AFTER_DRAIN) { E.fused(acc, cur, wr, wc, fr, fq, lds, wid, lane); S.done(cur); }
#undef PG8_SA
#undef PG8_SB
#undef PG8_STAGE
#undef PG8_LDA
#undef PG8_LDB
#undef PG8_MMA
#undef PG8_WAIT_V
#undef PG8_WAIT_L
#undef PG8_BAR
#undef PG8_SCHED
}
}
#define LAS __attribute__((address_space(3)))
typedef unsigned short bf16;
typedef short bf16x8 __attribute__((ext_vector_type(8)));
typedef short s16x4 __attribute__((ext_vector_type(4)));
typedef float f32x4 __attribute__((ext_vector_type(4)));
typedef float f32x16 __attribute__((ext_vector_type(16)));
typedef unsigned u32x4 __attribute__((ext_vector_type(4)));
typedef unsigned u32x2 __attribute__((ext_vector_type(2)));

constexpr int NB = 8, SEQ = 4096, DM = 1024, DEPTH = 4, NMETA = 16;
constexpr int MREAL = NB * SEQ;
constexpr int META0 = MREAL;
constexpr int MROWS = 129 * 256;
constexpr int NINP = 3328, QP = 3072;
constexpr int C_FQ = 0, C_FK = 512, C_FV = 1024, C_GQ = 1536, C_GK = 1792, C_GV = 2048, C_GR = 2560;
constexpr int DFF = 2816, NUP = 5632;
constexpr float EPS = 1e-6f, LOG2E = 1.4426950408889634f, C2 = 0.125f * LOG2E;
constexpr int CKP = 4160;
constexpr int NCH = 65;

constexpr size_t MiB = 1u << 20;
constexpr size_t WL_IN = 0, WL_OUT = 6815744, WL_UP = 8912896, WL_DN = 20447232, WL_SIZE = 26214400;
constexpr size_t WS_W = 0, WS_HB = 100 * MiB, WS_OB = WS_HB + 67633152, WS_QKV = WS_OB + 67633152, WS_UT = WS_QKV + 202899456;
constexpr size_t WS_SM = WS_UT + 68157440, WS_CK = WS_SM + 4456448, WS_DEC = WS_CK + 1310720, WS_HM = WS_DEC + 786432, WS_SSQ = WS_HM + MiB, WS_BAR = WS_SSQ + 1835008, BAR_BYTES = 16384, WS_END = WS_BAR + BAR_BYTES;
static_assert(WS_END <= 512 * MiB, "workspace map");
constexpr size_t HFL_SIZE = (size_t)129 * 2 * NUP * 4;
static_assert(2 * HFL_SIZE <= 68157440, "halo overlay");

constexpr int LDS_BYTES = 147456, HALO_OFF = 131072;

struct Args {
    const float *x, *meta, *attn_norm, *w_in, *w_au, *b_alpha, *b_forget, *gla_norm, *fox_norm, *w_out, *ffn_norm, *w_up, *conv_w, *conv_b, *w_down, *final_norm;
    float* out; unsigned char* ws;
};

#define GAS __attribute__((address_space(1)))
#define CAS __attribute__((address_space(4)))
typedef const CAS Args* KArgs;
__device__ __forceinline__ KArgs kargs() { KArgs p = (KArgs)__builtin_amdgcn_kernarg_segment_ptr(); asm volatile("" : "+s"(p)); return p; }
template <class T> __device__ __forceinline__ T* gptr(T* p) { return (T*)(GAS T*)p; }
__device__ __forceinline__ float bf2f(bf16 v) { return __uint_as_float((unsigned)v << 16); }
__device__ __forceinline__ unsigned pk2(float lo, float hi) { return pg8::cvt_pk_bf16(lo, hi); }
__device__ __forceinline__ bf16 f2bf(float v) { return (bf16)(pk2(v, 0.f) & 0xffffu); }
__device__ __forceinline__ float wave_sum(float v) {
#pragma unroll
    for (int o = 1; o < 64; o <<= 1) v += __shfl_xor(v, o);
    return v;
}
__device__ __forceinline__ float logsigmoidf(float z) { return -(fmaxf(-z, 0.f) + log1pf(__expf(-fabsf(z)))); }
__device__ __forceinline__ float siluf(float v) { return v * __builtin_amdgcn_rcpf(1.f + __builtin_amdgcn_exp2f(-LOG2E * v)); }
__device__ __forceinline__ int crow(int r, int hi) { return (r & 3) + 8 * (r >> 2) + 4 * hi; }
__device__ __forceinline__ s16x4 vtr(const LAS unsigned char* p) { return __builtin_bit_cast(s16x4, __builtin_amdgcn_ds_read_tr16_b64_v4i16((LAS s16x4*)p)); }
__device__ __forceinline__ bf16x8 cat8(s16x4 a, s16x4 b) { return (bf16x8){a[0], a[1], a[2], a[3], b[0], b[1], b[2], b[3]}; }
__device__ __forceinline__ float dppf(float old, float src, int ctrl_unused);
#define DPP_MOV(old, src, ctrl) __builtin_bit_cast(float, __builtin_amdgcn_update_dpp(__builtin_bit_cast(int, (float)(old)), __builtin_bit_cast(int, (float)(src)), (ctrl), 0xf, 0xf, false))
#define LDS_WAIT() asm volatile("s_waitcnt lgkmcnt(0)" ::: "memory")

__device__ __forceinline__ const float* ssq_arr(unsigned char* wsb, int si) { return (const float*)(wsb + WS_SSQ) + (size_t)(si % 3) * MROWS * 4; }
__device__ __forceinline__ float row_rstd(const float* ssqp, int row) { const f32x4 s = *(const f32x4*)(ssqp + (size_t)row * 4); return rsqrtf(((s[0] + s[1]) + (s[2] + s[3])) * (1.0f / DM) + EPS); }
__device__ __forceinline__ LAS float* tile_rstd(unsigned char* wsb, int si, int pm, int wr, int wc, int fr, int fq) {
    extern __shared__ __attribute__((aligned(16))) unsigned char lds_dyn_[];
    LAS float* rsl = (LAS float*)((LAS unsigned char*)lds_dyn_ + HALO_OFF + 8192);
    const int tl = (wr * 4 + wc) * 64 + fq * 16 + fr;
    if (pm != 128) {
        if (tl < 256) rsl[tl] = row_rstd(ssq_arr(wsb, si), pm * 256 + tl);
    } else {
        const int row = tl >> 5, part = tl & 31;
        const f32x4* hp = (const f32x4*)((const float*)(wsb + WS_HM) + (size_t)row * DM) + part;
        float s = 0.f;
#pragma unroll
        for (int j = 0; j < 8; ++j) { const f32x4 v = hp[32 * j]; s += (v[0] * v[0] + v[1] * v[1]) + (v[2] * v[2] + v[3] * v[3]); }
        s += __shfl_xor(s, 1); s += __shfl_xor(s, 2); s += __shfl_xor(s, 4); s += __shfl_xor(s, 8); s += __shfl_xor(s, 16);
        if (part == 0) rsl[row] = rsqrtf(s * (1.0f / DM) + EPS);
        if (tl < 240) rsl[16 + tl] = 0.f;
    }
    asm volatile("s_waitcnt lgkmcnt(0)" ::: "memory"); __builtin_amdgcn_s_barrier(); asm volatile("" ::: "memory");
    return rsl;
}
__device__ __forceinline__ void meta_rowgemm(const bf16* A, int lda, const bf16* Bt, int K, float* HM, bf16* HB, int G, int bx) {
    int tid_ = threadIdx.x; asm volatile("" : "+v"(tid_)); const int r = tid_ >> 5, kp = tid_ & 31;
    for (int cg = bx; cg < 256; cg += G) {
        float acc[4] = {0.f, 0.f, 0.f, 0.f};
        for (int k0 = kp * 8; k0 < K; k0 += 256) {
            const u32x4 av = *(const u32x4*)(A + (size_t)r * lda + k0);
#pragma unroll
            for (int j = 0; j < 4; ++j) {
                const u32x4 bv = *(const u32x4*)(Bt + (size_t)(4 * cg + j) * K + k0);
#pragma unroll
                for (int q = 0; q < 4; ++q) {
                    acc[j] += __uint_as_float(av[q] << 16) * __uint_as_float(bv[q] << 16);
                    acc[j] += __uint_as_float(av[q] & 0xffff0000u) * __uint_as_float(bv[q] & 0xffff0000u);
                }
            }
        }
#pragma unroll
        for (int j = 0; j < 4; ++j) { float s = acc[j]; s += __shfl_xor(s, 1); s += __shfl_xor(s, 2); s += __shfl_xor(s, 4); s += __shfl_xor(s, 8); s += __shfl_xor(s, 16); acc[j] = s; }
        if (kp == 0) {
            float* hp = HM + (size_t)r * DM + 4 * cg;
            const f32x4 h = *(const f32x4*)hp + (f32x4){acc[0], acc[1], acc[2], acc[3]};
            *(f32x4*)hp = h;
            u32x2 w; w.x = pk2(h[0], h[1]); w.y = pk2(h[2], h[3]);
            *(u32x2*)(HB + (size_t)(META0 + r) * DM + 4 * cg) = w;
        }
    }
}
__device__ __forceinline__ void meta_up(LAS unsigned char* lds, const bf16* HB, const bf16* Wup, const float* HM, const float* cw, const float* cb, bf16* A2, float* HL, int G, int bx) {
    int tid_ = threadIdx.x; asm volatile("" : "+v"(tid_)); const int tid = tid_, r = tid >> 5, kp = tid & 31;
    LAS float* hb = (LAS float*)lds;
    float rs;
    { const f32x4* hp = (const f32x4*)(HM + (size_t)r * DM) + kp; float s = 0.f;
#pragma unroll
      for (int j = 0; j < 8; ++j) { const f32x4 v = hp[32 * j]; s += (v[0] * v[0] + v[1] * v[1]) + (v[2] * v[2] + v[3] * v[3]); }
      s += __shfl_xor(s, 1); s += __shfl_xor(s, 2); s += __shfl_xor(s, 4); s += __shfl_xor(s, 8); s += __shfl_xor(s, 16);
      rs = rsqrtf(s * (1.0f / DM) + EPS); }
    u32x4 av[4];
#pragma unroll
    for (int i = 0; i < 4; ++i) av[i] = *(const u32x4*)(HB + (size_t)(META0 + r) * DM + kp * 8 + 256 * i);
    for (int cg = bx; cg < 256; cg += G) {
#pragma unroll 1
        for (int cb0 = 0; cb0 < 24; cb0 += 6) {
            u32x4 bv[6][4];
#pragma unroll
            for (int c6 = 0; c6 < 6; ++c6) {
                const int c = cb0 + c6 < 22 ? cb0 + c6 : 21, isg = c >= 11 ? 1 : 0, jj = c - 11 * isg;
                const int ch = 11 * cg + jj, wrow = (ch >> 7) * 256 + isg * 128 + (ch & 127);
#pragma unroll
                for (int i = 0; i < 4; ++i) bv[c6][i] = *(const u32x4*)(Wup + (size_t)wrow * DM + kp * 8 + 256 * i);
            }
#pragma unroll
            for (int c6 = 0; c6 < 6; ++c6) {
                float acc = 0.f;
#pragma unroll
                for (int i = 0; i < 4; ++i)
#pragma unroll
                    for (int q = 0; q < 4; ++q) {
                        acc += __uint_as_float(av[i][q] << 16) * __uint_as_float(bv[c6][i][q] << 16);
                        acc += __uint_as_float(av[i][q] & 0xffff0000u) * __uint_as_float(bv[c6][i][q] & 0xffff0000u);
                    }
                acc += __shfl_xor(acc, 1); acc += __shfl_xor(acc, 2); acc += __shfl_xor(acc, 4); acc += __shfl_xor(acc, 8); acc += __shfl_xor(acc, 16);
                if (kp == 0 && cb0 + c6 < 22) hb[r * 24 + cb0 + c6] = acc * rs;
            }
        }
        __syncthreads();
        if (tid < 16 * 11) {
            const int rr = tid / 11, jj = tid % 11, ch = 11 * cg + jj;
            float hc[2];
#pragma unroll
            for (int ug = 0; ug < 2; ++ug) {
                const int c = ug * DFF + ch;
                const float x0 = hb[rr * 24 + ug * 11 + jj], x1 = rr >= 1 ? hb[(rr - 1) * 24 + ug * 11 + jj] : 0.f, x2 = rr >= 2 ? hb[(rr - 2) * 24 + ug * 11 + jj] : 0.f;
                hc[ug] = cb[c] + cw[c] * x2 + cw[NUP + c] * x1 + cw[2 * NUP + c] * x0;
                if (rr >= 14) HL[(size_t)(256 + rr - 14) * NUP + c] = x0;
            }
            A2[(size_t)(META0 + rr) * DFF + ch] = f2bf(siluf(hc[1]) * hc[0]);
        }
        __syncthreads();
    }
}
__device__ __forceinline__ bool so_next_pm(int nM, int nN, int G, int c, int i, int& pm) {
    const int nwg = nM * nN; const long Lq = (long)i * G + c; if (Lq >= nwg) return false;
    int wgid = (int)Lq; { const int q = nwg / pg8::NXCD, r = nwg % pg8::NXCD, xcd = wgid % pg8::NXCD, off = wgid / pg8::NXCD; wgid = (xcd < r ? xcd * (q + 1) : r * (q + 1) + (xcd - r) * q) + off; }
    const int nig = pg8::WGM * nN, gid = wgid / nig, fm = gid * pg8::WGM, gsz = (nM - fm) < pg8::WGM ? (nM - fm) : pg8::WGM;
    pm = fm + ((wgid % nig) % gsz); return true;
}
struct EpiIn {
    static constexpr bool PERM = true, AFTER_DRAIN = false;
    int si;
    __device__ __forceinline__ void operator()(const pg8::f32x4 (&acc)[2][2][4][2], const pg8::Unit& u, int wr, int wc, int fr, int fq) const {
        asm volatile("" : "+v"(fr), "+v"(fq));
        unsigned char* wsb = gptr(kargs()->ws);
        bf16* Q = (bf16*)(wsb + WS_QKV); float* SM = (float*)(wsb + WS_SM); const LAS float* rsl = tile_rstd(wsb, si, u.pm, wr, wc, fr, fq);
#pragma unroll
        for (int ai = 0; ai < 2; ++ai)
#pragma unroll
            for (int m = 0; m < 4; ++m) {
                const int row = u.pm * 256 + ai * 128 + wr * 64 + m * 16 + fr;
                const float rs = rsl[ai * 128 + wr * 64 + m * 16 + fr];
                if (u.pn < 12) {
#pragma unroll
                    for (int bj = 0; bj < 2; ++bj) {
                        const pg8::f32x4 v0 = acc[ai][bj][m][0] * rs, v1 = acc[ai][bj][m][1] * rs;
                        u32x4 w; w.x = pk2(v0[0], v0[1]); w.y = pk2(v0[2], v0[3]); w.z = pk2(v1[0], v1[1]); w.w = pk2(v1[2], v1[3]);
                        *(u32x4*)(Q + (size_t)row * QP + u.pn * 256 + bj * 128 + wc * 32 + 8 * fq) = w;
                    }
                } else if (wc == 0) {
                    *(f32x4*)(SM + (size_t)row * 32 + 8 * fq) = acc[ai][0][m][0] * rs;
                    *(f32x4*)(SM + (size_t)row * 32 + 8 * fq + 4) = acc[ai][0][m][1] * rs;
                }
            }
    }
};
template <bool from_x, bool last> struct EpiRes {
    static constexpr bool PERM = false, AFTER_DRAIN = false;
    int si;
    __device__ __forceinline__ void operator()(const pg8::f32x4 (&acc)[2][2][4][2], const pg8::Unit& u, int wr, int wc, int fr, int fq) const {
        asm volatile("" : "+v"(fr), "+v"(fq));
        KArgs ka = kargs(); unsigned char* wsb = gptr(ka->ws);
        float* out = last ? gptr(ka->out) : nullptr; const float* xin = from_x ? gptr(ka->x) : nullptr; bf16* HB = (bf16*)(wsb + WS_HB); float* ssq_next = (float*)ssq_arr(wsb, si);
        extern __shared__ __attribute__((aligned(16))) unsigned char lds_dyn_[];
        LAS float* red = (LAS float*)((LAS unsigned char*)lds_dyn_ + HALO_OFF);
#pragma unroll
        for (int ai = 0; ai < 2; ++ai)
#pragma unroll
            for (int m = 0; m < 4; ++m) {
                const int row = u.pm * 256 + ai * 128 + wr * 64 + m * 16 + fr;
                float ss = 0.f;
#pragma unroll
                for (int bj = 0; bj < 2; ++bj)
#pragma unroll
                    for (int n = 0; n < 2; ++n) {
                        const int col = u.pn * 256 + bj * 128 + wc * 32 + 16 * n + 4 * fq;
                        f32x4 bs;
                        if constexpr (from_x) bs = *(const f32x4*)(xin + (size_t)row * DM + col);
                        else { const u32x2 t = *(const u32x2*)(HB + (size_t)row * DM + col);
                               bs = (f32x4){__uint_as_float(t.x << 16), __uint_as_float(t.x & 0xffff0000u), __uint_as_float(t.y << 16), __uint_as_float(t.y & 0xffff0000u)}; }
                        const f32x4 h = bs + acc[ai][bj][m][n];
                        ss += (h[0] * h[0] + h[1] * h[1]) + (h[2] * h[2] + h[3] * h[3]);
                        u32x2 w; w.x = pk2(h[0], h[1]); w.y = pk2(h[2], h[3]);
                        *(u32x2*)(HB + (size_t)row * DM + col) = w;
                        if constexpr (last) *(f32x4*)(out + (size_t)row * DM + col) = h;
                    }
                ss += __shfl_xor(ss, 16); ss += __shfl_xor(ss, 32);
                if (fq == 0) red[wc * 256 + ai * 128 + wr * 64 + m * 16 + fr] = ss;
            }
        asm volatile("s_waitcnt lgkmcnt(0)" ::: "memory"); __builtin_amdgcn_s_barrier(); asm volatile("" ::: "memory");
        {
            const int tl = (wr * 4 + wc) * 64 + fq * 16 + fr;
            if (tl < 256) ssq_next[(size_t)(u.pm * 256 + tl) * 4 + u.pn] = (red[tl] + red[256 + tl]) + (red[512 + tl] + red[768 + tl]);
        }
    }
};
struct EpiUp {
    static constexpr bool PERM = true, AFTER_DRAIN = false;
    int L;
    __device__ __forceinline__ void operator()(pg8::f32x4 (&acc)[2][2][4][2], const pg8::Unit& u, int wr, int wc, int fr, int fq) const {
        asm volatile("" : "+v"(fr), "+v"(fq));
        KArgs ka = kargs(); unsigned char* wsb = gptr(ka->ws);
        const LAS float* rsl = tile_rstd(wsb, 2 * L + 1, u.pm, wr, wc, fr, fq); const float* cw = gptr(ka->conv_w) + (size_t)L * 3 * NUP; const float* cb = gptr(ka->conv_b) + (size_t)L * NUP;
        extern __shared__ __attribute__((aligned(16))) unsigned char lds_dyn_[];
        LAS float* halo = (LAS float*)((LAS unsigned char*)lds_dyn_ + HALO_OFF);
        const int colw = wc * 32 + 8 * fq;
#pragma unroll
        for (int ai = 0; ai < 2; ++ai)
#pragma unroll
            for (int m = 0; m < 4; ++m) {
                const int row = u.pm * 256 + ai * 128 + wr * 64 + m * 16 + fr;
                const float rs = rsl[ai * 128 + wr * 64 + m * 16 + fr]; (void)row;
#pragma unroll
                for (int bj = 0; bj < 2; ++bj)
#pragma unroll
                    for (int n = 0; n < 2; ++n) acc[ai][bj][m][n] *= rs;
            }
#ifdef SIMPLE_UP
        {
            const int ch0s = u.pn * 128 + colw;
#pragma unroll
            for (int n = 0; n < 2; ++n)
#pragma unroll
                for (int ai = 0; ai < 2; ++ai)
#pragma unroll
                    for (int m = 0; m < 4; ++m) {
                        const int row = u.pm * 256 + ai * 128 + wr * 64 + m * 16 + fr;
                        const f32x4 hu = acc[ai][0][m][n], hg = acc[ai][1][m][n];
                        u32x2 w; w.x = pk2(hu[0] + hg[0], hu[1] + hg[1]); w.y = pk2(hu[2] + hg[2], hu[3] + hg[3]);
                        *(u32x2*)(wsb + (unsigned)(WS_QKV + (unsigned)((row * DFF + ch0s + 4 * n) * 2))) = w;
                    }
            return;
        }
#endif
        if (fr >= 14) {
#pragma unroll
            for (int ai = 0; ai < 2; ++ai)
#pragma unroll
                for (int bj = 0; bj < 2; ++bj)
#pragma unroll
                    for (int n = 0; n < 2; ++n)
                        *(LAS f32x4*)(halo + (((2 * ai + wr) * 2 + (fr - 14)) * 256 + bj * 128 + colw + 4 * n)) = acc[ai][bj][3][n];
        }
        asm volatile("s_waitcnt lgkmcnt(0)" ::: "memory"); __builtin_amdgcn_s_barrier(); asm volatile("" ::: "memory");
        const int ch0 = u.pn * 128 + colw;
        u32x2 wout[2][4][2];
#pragma unroll
        for (int n = 0; n < 2; ++n) {
            f32x4 w0[2], w1[2], w2[2], bb[2];
#pragma unroll
            for (int bj = 0; bj < 2; ++bj) {
                const int c = bj * DFF + ch0 + 4 * n;
                w0[bj] = *(const f32x4*)((const char*)cw + (unsigned)(c * 4)); w1[bj] = *(const f32x4*)((const char*)cw + (unsigned)((NUP + c) * 4)); w2[bj] = *(const f32x4*)((const char*)cw + (unsigned)((2 * NUP + c) * 4)); bb[bj] = *(const f32x4*)((const char*)cb + (unsigned)(c * 4));
            }
#pragma unroll
            for (int ai = 0; ai < 2; ++ai)
#pragma unroll
                for (int m = 0; m < 4; ++m) {
                    const int g = 2 * ai + wr;
                    f32x4 hc[2];
#pragma unroll
                    for (int bj = 0; bj < 2; ++bj) {
                        const int c = bj * DFF + ch0 + 4 * n;
                        const f32x4 cur = acc[ai][bj][m][n];
                        f32x4 pb;
                        if (m > 0) pb = acc[ai][bj][m - 1][n];
                        else pb = *(const LAS f32x4*)(halo + ((((g > 0 ? g - 1 : 0) * 2) + (fr & 1)) * 256 + bj * 128 + colw + 4 * n));
                        f32x4 p1, p2;
#pragma unroll
                        for (int j = 0; j < 4; ++j) {
                            const float t1 = DPP_MOV(0.f, pb[j], 0x121);
                            p1[j] = DPP_MOV(t1, cur[j], 0x111);
                            const float t2 = DPP_MOV(0.f, pb[j], 0x122);
                            p2[j] = DPP_MOV(t2, cur[j], 0x112);
                        }
                        hc[bj] = bb[bj] + w0[bj] * p2 + w1[bj] * p1 + w2[bj] * cur;
                        if (g == 0 && m == 0 && fr < 2) *(f32x4*)(wsb + (unsigned)(WS_UT + (unsigned)(((u.pm * 2 + fr) * NUP + c) * 4))) = cur;
                        if (u.pm == 128 ? (g == 0 && m == 0 && fr >= 14) : (g == 3 && m == 3 && fr >= 14))
                            *(f32x4*)(wsb + (unsigned)(WS_UT + HFL_SIZE + (unsigned)(((u.pm * 2 + fr - 14) * NUP + c) * 4))) = cur;
                    }
                    wout[ai][m][n].x = pk2(siluf(hc[1][0]) * hc[0][0], siluf(hc[1][1]) * hc[0][1]);
                    wout[ai][m][n].y = pk2(siluf(hc[1][2]) * hc[0][2], siluf(hc[1][3]) * hc[0][3]);
                }
        }
#pragma unroll
        for (int ai = 0; ai < 2; ++ai)
#pragma unroll
            for (int m = 0; m < 4; ++m) {
                const int row = u.pm * 256 + ai * 128 + wr * 64 + m * 16 + fr;
                u32x4 w; w.x = wout[ai][m][0].x; w.y = wout[ai][m][0].y; w.z = wout[ai][m][1].x; w.w = wout[ai][m][1].y;
                *(u32x4*)(wsb + (unsigned)(WS_QKV + (unsigned)((row * DFF + ch0) * 2))) = w;
            }
    }
};
#define XB_TMO      128
#define XB_XCNT(j)  (256  + 64 * (j))
#define XB_XSUB(j)  (1280 + 64 * (j))
#define XB_XGEN(j)  (2304 + 64 * (j))
#define XB_TOP      3328
#define XB_TOPGEN   3392
#define XCD_BAR_WORDS 3456
#define XB_SPIN_CAP (1u << 18)

__device__ __forceinline__ unsigned xb_ld(unsigned* p)              { return __hip_atomic_load(p, __ATOMIC_RELAXED, __HIP_MEMORY_SCOPE_AGENT); }
__device__ __forceinline__ unsigned xb_add(unsigned* p, unsigned v) { return __hip_atomic_fetch_add(p, v, __ATOMIC_RELAXED, __HIP_MEMORY_SCOPE_AGENT); }
__device__ __forceinline__ unsigned xb_xcc_id() { return (unsigned)__builtin_amdgcn_s_getreg((3 << 11) | 20) & 0xFu; }
#define XB_SPIN(cond, bar) do { unsigned _sp = 0; while (cond) { __builtin_amdgcn_s_sleep(1); \
    if ((++_sp & 255u) == 0u) { if (xb_ld(&(bar)[XB_TMO])) break; if (_sp > XB_SPIN_CAP) { atomicAdd(&(bar)[XB_TMO], 1u); break; } } } } while (0)

struct XcdBarrier {
    unsigned* bar; unsigned x;
    volatile LAS unsigned* st;
};

__device__ __forceinline__ XcdBarrier xcd_barrier_post(unsigned* bar, volatile LAS unsigned* st) {
    XcdBarrier b; b.bar = bar; b.x = xb_xcc_id(); b.st = st;
    if (threadIdx.x == 0) (void)xb_add(&bar[XB_XCNT(b.x)], 1u);
    return b;
}
__device__ __forceinline__ void xcd_barrier_complete(unsigned* bar, unsigned x, unsigned& nloc, unsigned& nx) {
    const unsigned G = gridDim.x * gridDim.y * gridDim.z;
    unsigned sum, cnt, mine, sp = 0u;
    for (;;) {
        sum = 0u; cnt = 0u; mine = 0u;
#pragma unroll
        for (unsigned j = 0; j < 16; ++j) { const unsigned c = xb_ld(&bar[XB_XCNT(j)]); sum += c; cnt += (c > 0u) ? 1u : 0u; mine = (j == x) ? c : mine; }
        if (sum == G) break;
        __builtin_amdgcn_s_sleep(1);
        if ((++sp & 255u) == 0u) { if (xb_ld(&bar[XB_TMO])) break; if (sp > XB_SPIN_CAP) { atomicAdd(&bar[XB_TMO], 1u); break; } }
    }
    nloc = mine > 0u ? mine : 1u; nx = cnt > 0u ? cnt : 1u;
}

__device__ __forceinline__ void xcd_barrier(const XcdBarrier& b) {
    asm volatile("s_waitcnt vmcnt(0)" ::: "memory");
    __syncthreads();
    if (threadIdx.x == 0) {
        unsigned* bar = b.bar;
        __builtin_amdgcn_s_waitcnt(0);
        unsigned nloc = b.st[0], nx = b.st[1];
        if (nloc == 0u) { xcd_barrier_complete(bar, b.x, nloc, nx); b.st[0] = nloc; b.st[1] = nx; }
        const unsigned old = xb_add(&bar[XB_XSUB(b.x)], 1u);
        const unsigned gen = old / nloc;
        if (old + 1u == (gen + 1u) * nloc) {
            __builtin_amdgcn_fence(__ATOMIC_RELEASE, "agent");
            asm volatile("s_waitcnt vmcnt(0)" ::: "memory");
            const unsigned og = xb_add(&bar[XB_TOP], 1u);
            const unsigned tg = og / nx;
            if (og + 1u == (tg + 1u) * nx) xb_add(&bar[XB_TOPGEN], 1u);
            else XB_SPIN(xb_ld(&bar[XB_TOPGEN]) == tg, bar);
            __builtin_amdgcn_fence(__ATOMIC_ACQUIRE, "agent");
            xb_add(&bar[XB_XGEN(b.x)], 1u);
            asm volatile("s_waitcnt vmcnt(0)" ::: "memory");
        } else {
            XB_SPIN(xb_ld(&bar[XB_XGEN(b.x)]) == gen, bar);
            __builtin_amdgcn_fence(__ATOMIC_ACQUIRE, "agent");
            asm volatile("s_waitcnt vmcnt(0)" ::: "memory");
        }
    }
    __syncthreads();
}
__device__ __forceinline__ int win_src(int n) {
    if (n < 512) return 1552 + n;
    if (n < 1024) return 2064 + (n - 512);
    if (n < 1536) return 2576 + (n - 1024);
    if (n < 1792) return n - 1536;
    if (n < 2048) return 256 + (n - 1792);
    if (n < 2560) return 512 + (n - 2048);
    if (n < 3072) return 1024 + (n - 2560);
    if (n < 3088) return 1536 + (n - 3072);
    if (n < 3096) return n;
    return -1;
}
__device__ __forceinline__ void tr_item(const float* W, int Nsrc, bf16* WT, int K, const float* gk, int mode, LAS float* scr, int k0, int n0, int lane) {
    const int nl = lane & 31, n = n0 + nl;
    int src = n; float cs = 1.f;
    if (mode == 0) { src = win_src(n); cs = n < 512 ? C2 : ((n >= 1536 && n < 1792) ? 0.125f : 1.f); }
    else if (mode == 2) { const int pn = n >> 8, j = n & 255; src = j < 128 ? pn * 128 + j : DFF + pn * 128 + (j - 128); }
#pragma unroll
    for (int i = 0; i < 32; ++i) {
        const int kk = 2 * i + (lane >> 5);
        float v = 0.f;
        if (src >= 0) v = W[(size_t)(k0 + kk) * Nsrc + src] * cs;
        if (gk) v *= gk[k0 + kk];
        scr[kk * 33 + nl] = v;
    }
    LDS_WAIT(); asm volatile("" ::: "memory");
    const int c = lane & 7;
#pragma unroll
    for (int j = 0; j < 4; ++j) {
        const int nn = (lane >> 3) + 8 * j; const LAS float* s = scr + (8 * c) * 33 + nn;
        u32x4 o; o.x = pk2(s[0 * 33], s[1 * 33]); o.y = pk2(s[2 * 33], s[3 * 33]); o.z = pk2(s[4 * 33], s[5 * 33]); o.w = pk2(s[6 * 33], s[7 * 33]);
        *(u32x4*)(WT + (size_t)(n0 + nn) * K + k0 + 8 * c) = o;
    }
    LDS_WAIT(); asm volatile("" ::: "memory");
}
__device__ __forceinline__ void row_to_bf16(const float* xrow, bf16* orow, float* ssq_slot, float* copy_row, int lane) {
    const f32x4* xr = (const f32x4*)xrow + lane;
    f32x4 v[4]; float s = 0.f;
#pragma unroll
    for (int j = 0; j < 4; ++j) { v[j] = xr[64 * j]; s += (v[j][0] * v[j][0] + v[j][1] * v[j][1]) + (v[j][2] * v[j][2] + v[j][3] * v[j][3]); }
    s = wave_sum(s);
    if (lane == 0) *(f32x4*)ssq_slot = (f32x4){s, 0.f, 0.f, 0.f};
    u32x2* o8 = (u32x2*)orow + lane;
#pragma unroll
    for (int j = 0; j < 4; ++j) { u32x2 w; w.x = pk2(v[j][0], v[j][1]); w.y = pk2(v[j][2], v[j][3]); o8[64 * j] = w; }
    if (copy_row) {
#pragma unroll
        for (int j = 0; j < 4; ++j) ((f32x4*)copy_row + lane)[64 * j] = v[j];
    }
}

template <int NQ> __device__ __forceinline__ void gla_u_group(LAS unsigned char* lds, const bf16* QKV, const float* SM, const float* wau, const float* balpha, float* UT, float* DEC, int grp) {
    int tid_ = threadIdx.x; asm volatile("" : "+v"(tid_)); const int tid = tid_, lane = tid & 63, wid = __builtin_amdgcn_readfirstlane(tid >> 6), hi = lane >> 5, r32 = lane & 31;
    constexpr int SUB = 9216 + 17408 + 2048;
    const int dk = lane, sg = wid;
    int bhq[NQ], ccq[NQ], hq[NQ], row0q[NQ], tvq[NQ];
    float la[NQ][8], kf[NQ][8];
#pragma unroll
    for (int q = 0; q < NQ; ++q) {
        const int u = NQ * grp + q; bhq[q] = u / NCH; ccq[q] = u % NCH; hq[q] = bhq[q] & 3;
        row0q[q] = ccq[q] == 0 ? META0 : (bhq[q] >> 2) * SEQ + (ccq[q] - 1) * 64; tvq[q] = ccq[q] == 0 ? NMETA : 64;
        LAS unsigned char* VT = lds + q * SUB + 9216;
        LAS float* TOT = (LAS float*)(lds + q * SUB + 9216 + 17408);
#pragma unroll
        for (int i = 0; i < 2; ++i) {
            const int idx = tid + 512 * i, row = idx >> 4, ch = idx & 15;
            const u32x4 v = *(const u32x4*)(QKV + (size_t)(row0q[q] + row) * QP + C_GV + hq[q] * 128 + ch * 8);
            *(LAS u32x4*)(VT + row * 272 + ch * 16) = v;
        }
#pragma unroll
        for (int i = 0; i < 8; ++i) kf[q][i] = bf2f(QKV[(size_t)(row0q[q] + 8 * sg + i) * QP + C_GK + hq[q] * 64 + dk]);
        float w[16];
#pragma unroll
        for (int r = 0; r < 16; ++r) w[r] = wau[r * 256 + hq[q] * 64 + dk];
        const float bias = balpha[hq[q] * 64 + dk];
#pragma unroll
        for (int i = 0; i < 8; ++i) {
            const int s = 8 * sg + i;
            const f32x4* g4 = (const f32x4*)(SM + (size_t)(row0q[q] + s) * 32);
            float z = bias;
#pragma unroll
            for (int k = 0; k < 4; ++k) { const f32x4 gv = g4[k]; z += gv[0] * w[4 * k] + gv[1] * w[4 * k + 1] + gv[2] * w[4 * k + 2] + gv[3] * w[4 * k + 3]; }
            la[q][i] = (s < tvq[q]) ? logsigmoidf(z) * (1.0f / 16.0f) : 0.f;
        }
#pragma unroll
        for (int i = 1; i < 8; ++i) la[q][i] += la[q][i - 1];
        TOT[sg * 64 + dk] = la[q][7];
    }
    __syncthreads();
#pragma unroll
    for (int q = 0; q < NQ; ++q) {
        LAS unsigned char* KD = lds + q * SUB;
        const LAS float* TOT = (const LAS float*)(lds + q * SUB + 9216 + 17408);
        float pre = 0.f, tot = 0.f;
#pragma unroll
        for (int g2 = 0; g2 < 8; ++g2) { const float t = TOT[g2 * 64 + dk]; if (g2 < sg) pre += t; tot += t; }
        if (sg == 0) DEC[(size_t)(bhq[q] * NCH + ccq[q]) * 64 + dk] = __expf(tot);
#pragma unroll
        for (int i = 0; i < 8; ++i) {
            const int s = 8 * sg + i;
            const float kd = (s < tvq[q]) ? kf[q][i] * __expf(tot - (pre + la[q][i])) : 0.f;
            *(LAS bf16*)(KD + s * 144 + dk * 2) = f2bf(kd);
        }
    }
    __syncthreads();
    const int dvb = wid >> 1, dkb = wid & 1;
    const int qq = (lane & 15) >> 2, pp = lane & 3, half = (lane >> 4) & 1;
#pragma unroll
    for (int q = 0; q < NQ; ++q) {
        const LAS unsigned char* KD = lds + q * SUB; const LAS unsigned char* VT = lds + q * SUB + 9216;
        f32x16 acc = {};
#pragma unroll
        for (int j = 0; j < 4; ++j) {
            const LAS unsigned char* ap = VT + (16 * j + 4 * hi + qq) * 272 + (32 * dvb + 16 * half + 4 * pp) * 2;
            const LAS unsigned char* bp = KD + (16 * j + 4 * hi + qq) * 144 + (32 * dkb + 16 * half + 4 * pp) * 2;
            const bf16x8 af = cat8(vtr(ap), vtr(ap + 8 * 272));
            const bf16x8 bfr = cat8(vtr(bp), vtr(bp + 8 * 144));
            acc = __builtin_amdgcn_mfma_f32_32x32x16_bf16(af, bfr, acc, 0, 0, 0);
        }
        float* up = UT + ((size_t)(bhq[q] * NCH + ccq[q]) * 128 + 32 * dvb) * 64 + 32 * dkb + r32;
#pragma unroll
        for (int r = 0; r < 16; ++r) up[crow(r, hi) * 64] = acc[r];
    }
    __syncthreads();
}
__device__ __forceinline__ void fox_cumsum_unit(LAS unsigned char* lds, const float* SM, const float* bforget, float* CK, int bh) {
    int tid_ = threadIdx.x; asm volatile("" : "+v"(tid_)); const int tid = tid_, lane = tid & 63, wid = tid >> 6;
    const int b = bh >> 3, h = bh & 7;
    const float bf_ = bforget[h];
    LAS float* WT_ = (LAS float*)lds;
    float mtot = 0.f, mine = 0.f;
    for (int p = 0; p < NMETA; ++p) { mtot += logsigmoidf(SM[(size_t)(META0 + p) * 32 + 16 + h] + bf_); if (tid == p) mine = mtot; }
    if (tid < 64) CK[(size_t)bh * CKP + tid] = tid < NMETA ? -LOG2E * mine : -INFINITY;
    float v[8]; float run = 0.f;
#pragma unroll
    for (int i = 0; i < 8; ++i) { run += logsigmoidf(SM[(size_t)(b * SEQ + 8 * tid + i) * 32 + 16 + h] + bf_); v[i] = run; }
    float inc = run;
#pragma unroll
    for (int o = 1; o < 64; o <<= 1) { const float t = __shfl_up(inc, o); if (lane >= o) inc += t; }
    if (lane == 63) WT_[wid] = inc;
    __syncthreads();
    float off = mtot + (inc - run);
    for (int w2 = 0; w2 < wid; ++w2) off += WT_[w2];
#pragma unroll
    for (int i = 0; i < 8; ++i) CK[(size_t)bh * CKP + 64 + 8 * tid + i] = -LOG2E * (off + v[i]);
    __syncthreads();
}

__device__ __forceinline__ void attn_unit(LAS unsigned char* lds, const bf16* QKV, const float* CK, bf16* OB, const float* fnorm, int b, int h, int qb) {
    int tid_ = threadIdx.x; asm volatile("" : "+v"(tid_)); const int tid = tid_, lane = tid & 63, wid = __builtin_amdgcn_readfirstlane(tid >> 6), r32 = lane & 31, hi = lane >> 5;
    constexpr int KB = 9216, KOFF = 0, VOFF = 2 * KB, COFF = 4 * KB, WOFF = COFF + 512;
    LAS float* wsf = (LAS float*)(lds + WOFF) + wid * 64;
    const size_t rowb = (size_t)b * SEQ; const int q0 = qb * 512;
    const int NT = 1 + 8 * (qb + 1);
    bf16x8 qr[2][4];
#pragma unroll
    for (int g = 0; g < 2; ++g) {
        const bf16* qp = QKV + (rowb + q0 + wid * 64 + g * 32 + r32) * QP + C_FQ + h * 64 + hi * 8;
#pragma unroll
        for (int d0 = 0; d0 < 4; ++d0) qr[g][d0] = *(const bf16x8*)(qp + d0 * 16);
    }
    const int srow = tid >> 3, sch = tid & 7;
    const float* ckp = CK + (size_t)(b * 8 + h) * CKP;
    u32x4 kreg, vreg; float creg = 0.f;
#define ATT_LOAD(t) do { const size_t r0_ = (t) == 0 ? (size_t)META0 : rowb + (size_t)((t) - 1) * 64; const bf16* p_ = QKV + (r0_ + srow) * QP + h * 64 + sch * 8; \
        kreg = *(const u32x4*)(p_ + C_FK); vreg = *(const u32x4*)(p_ + C_FV); if (tid < 64) creg = ckp[(t) * 64 + tid]; } while (0)
#define ATT_STORE(buf) do { *(LAS u32x4*)(lds + KOFF + (buf) * KB + srow * 144 + sch * 16) = kreg; *(LAS u32x4*)(lds + VOFF + (buf) * KB + srow * 144 + sch * 16) = vreg; \
        if (tid < 64) *(LAS float*)(lds + COFF + (buf) * 256 + tid * 4) = creg; } while (0)
    float m[2] = {-1e30f, -1e30f}, l[2] = {0.f, 0.f}; f32x16 o0[2], o1[2];
    o0[0] = (f32x16){}; o0[1] = (f32x16){}; o1[0] = (f32x16){}; o1[1] = (f32x16){};
    const int qq = (lane & 15) >> 2, pp = lane & 3, half = (lane >> 4) & 1;
    ATT_LOAD(0); ATT_STORE(0);
    for (int t = 0; t < NT; ++t) {
        const int buf = t & 1;
        if (t + 1 < NT) ATT_LOAD(t + 1);
        __syncthreads();
        const int jb = t - (NT - 8);
        const bool skip = (jb >= 0) && (jb > wid);
        if (!skip) {
            const LAS unsigned char* Kb = lds + KOFF + buf * KB; const LAS unsigned char* Vb = lds + VOFF + buf * KB; const LAS float* Cb = (const LAS float*)(lds + COFF + buf * 256);
            f32x16 p0[2], p1[2];
#pragma unroll
            for (int g4 = 0; g4 < 4; ++g4) {
                const f32x4 c0 = *(const LAS f32x4*)(Cb + 8 * g4 + 4 * hi), c1 = *(const LAS f32x4*)(Cb + 32 + 8 * g4 + 4 * hi);
#pragma unroll
                for (int i = 0; i < 4; ++i) { p0[0][4 * g4 + i] = c0[i]; p1[0][4 * g4 + i] = c1[i]; p0[1][4 * g4 + i] = c0[i]; p1[1][4 * g4 + i] = c1[i]; }
            }
#pragma unroll
            for (int d0 = 0; d0 < 4; ++d0) {
                const bf16x8 a0 = *(const LAS bf16x8*)(Kb + r32 * 144 + (16 * d0 + 8 * hi) * 2);
                const bf16x8 a1 = *(const LAS bf16x8*)(Kb + (32 + r32) * 144 + (16 * d0 + 8 * hi) * 2);
                p0[0] = __builtin_amdgcn_mfma_f32_32x32x16_bf16(a0, qr[0][d0], p0[0], 0, 0, 0);
                p0[1] = __builtin_amdgcn_mfma_f32_32x32x16_bf16(a0, qr[1][d0], p0[1], 0, 0, 0);
                p1[0] = __builtin_amdgcn_mfma_f32_32x32x16_bf16(a1, qr[0][d0], p1[0], 0, 0, 0);
                p1[1] = __builtin_amdgcn_mfma_f32_32x32x16_bf16(a1, qr[1][d0], p1[1], 0, 0, 0);
            }
            bf16x8 pa[2][4];
#pragma unroll
            for (int g = 0; g < 2; ++g) {
                if (jb == wid) {
                    const int qrel = 32 * g + r32;
#pragma unroll
                    for (int r = 0; r < 16; ++r) { const int kv = crow(r, hi); if (kv > qrel) p0[g][r] = -INFINITY; if (kv + 32 > qrel) p1[g][r] = -INFINITY; }
                }
                float mxa = fmaxf(p0[g][0], p1[g][0]), mxb = fmaxf(p0[g][1], p1[g][1]);
#pragma unroll
                for (int r = 2; r < 16; r += 2) { mxa = fmaxf(fmaxf(mxa, p0[g][r]), p1[g][r]); mxb = fmaxf(fmaxf(mxb, p0[g][r + 1]), p1[g][r + 1]); }
                float mx = fmaxf(mxa, mxb);
                mx = fmaxf(mx, __shfl_xor(mx, 32));
                if (__any(mx > m[g] + 8.0f)) {
                    const float mn = fmaxf(m[g], mx);
                    const float alpha = __builtin_amdgcn_exp2f(m[g] - mn);
                    m[g] = mn; l[g] *= alpha;
                    if (hi == 0) wsf[g * 32 + r32] = alpha;
                    LDS_WAIT();
#pragma unroll
                    for (int g4 = 0; g4 < 4; ++g4) {
                        const f32x4 a = *(const LAS f32x4*)(wsf + g * 32 + 8 * g4 + 4 * hi);
#pragma unroll
                        for (int i = 0; i < 4; ++i) { o0[g][4 * g4 + i] *= a[i]; o1[g][4 * g4 + i] *= a[i]; }
                    }
                }
                float rsum = 0.f;
#pragma unroll
                for (int r = 0; r < 16; ++r) { p0[g][r] = __builtin_amdgcn_exp2f(p0[g][r] - m[g]); p1[g][r] = __builtin_amdgcn_exp2f(p1[g][r] - m[g]); rsum += p0[g][r] + p1[g][r]; }
                l[g] += rsum;
                { u32x4 w;
                  w.x = pk2(p0[g][0], p0[g][1]); w.y = pk2(p0[g][2], p0[g][3]); w.z = pk2(p0[g][4], p0[g][5]); w.w = pk2(p0[g][6], p0[g][7]); pa[g][0] = __builtin_bit_cast(bf16x8, w);
                  w.x = pk2(p0[g][8], p0[g][9]); w.y = pk2(p0[g][10], p0[g][11]); w.z = pk2(p0[g][12], p0[g][13]); w.w = pk2(p0[g][14], p0[g][15]); pa[g][1] = __builtin_bit_cast(bf16x8, w);
                  w.x = pk2(p1[g][0], p1[g][1]); w.y = pk2(p1[g][2], p1[g][3]); w.z = pk2(p1[g][4], p1[g][5]); w.w = pk2(p1[g][6], p1[g][7]); pa[g][2] = __builtin_bit_cast(bf16x8, w);
                  w.x = pk2(p1[g][8], p1[g][9]); w.y = pk2(p1[g][10], p1[g][11]); w.z = pk2(p1[g][12], p1[g][13]); w.w = pk2(p1[g][14], p1[g][15]); pa[g][3] = __builtin_bit_cast(bf16x8, w); }
            }
#pragma unroll
            for (int j = 0; j < 4; ++j) {
                const LAS unsigned char* vp = Vb + (16 * j + 4 * hi + qq) * 144 + (16 * half + 4 * pp) * 2;
                const bf16x8 v0 = cat8(vtr(vp), vtr(vp + 8 * 144));
                const bf16x8 v1 = cat8(vtr(vp + 64), vtr(vp + 64 + 8 * 144));
                o0[0] = __builtin_amdgcn_mfma_f32_32x32x16_bf16(pa[0][j], v0, o0[0], 0, 0, 0);
                o0[1] = __builtin_amdgcn_mfma_f32_32x32x16_bf16(pa[1][j], v0, o0[1], 0, 0, 0);
                o1[0] = __builtin_amdgcn_mfma_f32_32x32x16_bf16(pa[0][j], v1, o1[0], 0, 0, 0);
                o1[1] = __builtin_amdgcn_mfma_f32_32x32x16_bf16(pa[1][j], v1, o1[1], 0, 0, 0);
            }
        }
        if (t + 1 < NT) ATT_STORE(buf ^ 1);
    }
#undef ATT_LOAD
#undef ATT_STORE
    const float w0 = fnorm[h * 64 + r32], w1 = fnorm[h * 64 + 32 + r32];
#pragma unroll
    for (int g = 0; g < 2; ++g) {
        float lt = l[g]; lt += __shfl_xor(lt, 32);
        if (hi == 0) wsf[g * 32 + r32] = 1.0f / lt;
        LDS_WAIT();
#pragma unroll
        for (int g4 = 0; g4 < 4; ++g4) {
            const f32x4 a = *(const LAS f32x4*)(wsf + g * 32 + 8 * g4 + 4 * hi);
#pragma unroll
            for (int i = 0; i < 4; ++i) { o0[g][4 * g4 + i] *= a[i]; o1[g][4 * g4 + i] *= a[i]; }
        }
#pragma unroll
        for (int r = 0; r < 16; ++r) {
            float s = o0[g][r] * o0[g][r] + o1[g][r] * o1[g][r];
            s += __shfl_xor(s, 1); s += __shfl_xor(s, 2); s += __shfl_xor(s, 4); s += __shfl_xor(s, 8); s += __shfl_xor(s, 16);
            const float rs = rsqrtf(s * (1.0f / 64.0f) + EPS);
            bf16* op = OB + (rowb + q0 + wid * 64 + g * 32 + crow(r, hi)) * DM + 512 + h * 64 + r32;
            op[0] = f2bf(o0[g][r] * rs * w0); op[32] = f2bf(o1[g][r] * rs * w1);
        }
    }
    __syncthreads();
}
__device__ __forceinline__ void meta_attn(const bf16* QKV, const float* CK, bf16* OB, const float* fnorm, int p) {
    int tid_ = threadIdx.x; asm volatile("" : "+v"(tid_)); const int lane = tid_ & 63, h = tid_ >> 6;
    const float q = bf2f(QKV[(size_t)(META0 + p) * QP + C_FQ + h * 64 + lane]);
    float sc[NMETA], vv[NMETA];
#pragma unroll
    for (int s = 0; s < NMETA; ++s) {
        sc[s] = q * bf2f(QKV[(size_t)(META0 + s) * QP + C_FK + h * 64 + lane]);
        vv[s] = bf2f(QKV[(size_t)(META0 + s) * QP + C_FV + h * 64 + lane]);
    }
    float m = -1e30f;
#pragma unroll
    for (int s = 0; s < NMETA; ++s) { sc[s] = (s <= p) ? wave_sum(sc[s]) + CK[(size_t)h * CKP + s] : -INFINITY; m = fmaxf(m, sc[s]); }
    float l = 0.f, o = 0.f;
#pragma unroll
    for (int s = 0; s < NMETA; ++s) { const float pw = __builtin_amdgcn_exp2f(sc[s] - m); l += pw; o += pw * vv[s]; }
    o /= l;
    const float ss = wave_sum(o * o);
    OB[(size_t)(META0 + p) * DM + 512 + h * 64 + lane] = f2bf(o * rsqrtf(ss * (1.0f / 64.0f) + EPS) * fnorm[h * 64 + lane]);
}
template <int NU> __device__ __forceinline__ void gla_readout_wave(const bf16* QKV, const float* UT, bf16* OB, const float* gnorm, const int* bhs, const int* ccs, const int* halfs, int lane) {
    asm volatile("" : "+v"(lane));
    const int r32 = lane & 31, hi = lane >> 5;
    int row0[NU], nvalid[NU], hq[NU]; const float* Sp[NU];
    f32x16 acc[NU][4];
#pragma unroll
    for (int u = 0; u < NU; ++u) {
        const int b = bhs[u] >> 2; hq[u] = bhs[u] & 3;
        row0[u] = ccs[u] == 0 ? META0 : b * SEQ + (ccs[u] - 1) * 64 + 32 * halfs[u]; nvalid[u] = ccs[u] == 0 ? NMETA : 32;
        Sp[u] = UT + (size_t)(bhs[u] * NCH + ccs[u]) * 8192;
#pragma unroll
        for (int blk = 0; blk < 4; ++blk) acc[u][blk] = (f32x16){};
    }
#pragma unroll
    for (int j = 0; j < 4; ++j)
#pragma unroll
        for (int u = 0; u < NU; ++u) {
            const bf16x8 bq = *(const bf16x8*)(QKV + (size_t)(row0[u] + r32) * QP + C_GQ + hq[u] * 64 + 16 * j + 8 * hi);
#pragma unroll
            for (int blk = 0; blk < 4; ++blk) {
                const float* sp = Sp[u] + (32 * blk + r32) * 64 + 16 * j + 8 * hi;
                const f32x4 s0 = *(const f32x4*)sp, s1 = *(const f32x4*)(sp + 4);
                u32x4 w; w.x = pk2(s0[0], s0[1]); w.y = pk2(s0[2], s0[3]); w.z = pk2(s1[0], s1[1]); w.w = pk2(s1[2], s1[3]);
                acc[u][blk] = __builtin_amdgcn_mfma_f32_32x32x16_bf16(__builtin_bit_cast(bf16x8, w), bq, acc[u][blk], 0, 0, 0);
            }
        }
#pragma unroll
    for (int u = 0; u < NU; ++u) {
        float ss = 0.f;
#pragma unroll
        for (int blk = 0; blk < 4; ++blk)
#pragma unroll
            for (int r = 0; r < 16; ++r) ss += acc[u][blk][r] * acc[u][blk][r];
        ss += __shfl_xor(ss, 32);
        const float rs = rsqrtf(ss * (1.0f / 128.0f) + EPS);
        if (r32 < nvalid[u]) {
            const size_t row = (size_t)row0[u] + r32; const int h = hq[u];
#pragma unroll
            for (int blk = 0; blk < 4; ++blk)
#pragma unroll
                for (int g = 0; g < 4; ++g) {
                    const int dv = 32 * blk + 8 * g + 4 * hi;
                    const u32x2 gt = *(const u32x2*)(QKV + row * QP + C_GR + h * 128 + dv);
                    const f32x4 wn = *(const f32x4*)(gnorm + h * 128 + dv);
                    const float g0 = __uint_as_float(gt.x << 16), g1 = __uint_as_float(gt.x & 0xffff0000u), g2 = __uint_as_float(gt.y << 16), g3 = __uint_as_float(gt.y & 0xffff0000u);
                    u32x2 w;
                    w.x = pk2(acc[u][blk][4 * g] * rs * wn[0] * siluf(g0), acc[u][blk][4 * g + 1] * rs * wn[1] * siluf(g1));
                    w.y = pk2(acc[u][blk][4 * g + 2] * rs * wn[2] * siluf(g2), acc[u][blk][4 * g + 3] * rs * wn[3] * siluf(g3));
                    *(u32x2*)(OB + row * DM + h * 128 + dv) = w;
                }
        }
    }
}

__device__ __forceinline__ void gla_readout_chunk(const bf16* QKV, const float* UT, bf16* OB, const float* gnorm, int bh, int cc, int lane) {
    asm volatile("" : "+v"(lane));
    const int r32 = lane & 31, hi = lane >> 5, b = bh >> 2, h = bh & 3;
    const int row0 = b * SEQ + (cc - 1) * 64;
    const float* Sp = UT + (size_t)(bh * NCH + cc) * 8192;
    f32x16 acc[2][4];
#pragma unroll
    for (int u = 0; u < 2; ++u)
#pragma unroll
        for (int blk = 0; blk < 4; ++blk) acc[u][blk] = (f32x16){};
#pragma unroll 1
    for (int j = 0; j < 4; ++j) {
        const bf16x8 bq0 = *(const bf16x8*)(QKV + (size_t)(row0 + r32) * QP + C_GQ + h * 64 + 16 * j + 8 * hi);
        const bf16x8 bq1 = *(const bf16x8*)(QKV + (size_t)(row0 + 32 + r32) * QP + C_GQ + h * 64 + 16 * j + 8 * hi);
#pragma unroll
        for (int blk = 0; blk < 4; ++blk) {
            const float* sp = Sp + (32 * blk + r32) * 64 + 16 * j + 8 * hi;
            const f32x4 s0 = *(const f32x4*)sp, s1 = *(const f32x4*)(sp + 4);
            u32x4 w; w.x = pk2(s0[0], s0[1]); w.y = pk2(s0[2], s0[3]); w.z = pk2(s1[0], s1[1]); w.w = pk2(s1[2], s1[3]);
            const bf16x8 sa = __builtin_bit_cast(bf16x8, w);
            acc[0][blk] = __builtin_amdgcn_mfma_f32_32x32x16_bf16(sa, bq0, acc[0][blk], 0, 0, 0);
            acc[1][blk] = __builtin_amdgcn_mfma_f32_32x32x16_bf16(sa, bq1, acc[1][blk], 0, 0, 0);
        }
    }
#pragma unroll
    for (int u = 0; u < 2; ++u) {
        float ss = 0.f;
#pragma unroll
        for (int blk = 0; blk < 4; ++blk)
#pragma unroll
            for (int r = 0; r < 16; ++r) ss += acc[u][blk][r] * acc[u][blk][r];
        ss += __shfl_xor(ss, 32);
        const float rs = rsqrtf(ss * (1.0f / 128.0f) + EPS);
        const size_t row = (size_t)row0 + 32 * u + r32;
#pragma unroll
        for (int blk = 0; blk < 4; ++blk)
#pragma unroll
            for (int g = 0; g < 4; ++g) {
                const int dv = 32 * blk + 8 * g + 4 * hi;
                const u32x2 gt = *(const u32x2*)(QKV + row * QP + C_GR + h * 128 + dv);
                const f32x4 wn = *(const f32x4*)(gnorm + h * 128 + dv);
                const float g0 = __uint_as_float(gt.x << 16), g1 = __uint_as_float(gt.x & 0xffff0000u), g2 = __uint_as_float(gt.y << 16), g3 = __uint_as_float(gt.y & 0xffff0000u);
                u32x2 w;
                w.x = pk2(acc[u][blk][4 * g] * rs * wn[0] * siluf(g0), acc[u][blk][4 * g + 1] * rs * wn[1] * siluf(g1));
                w.y = pk2(acc[u][blk][4 * g + 2] * rs * wn[2] * siluf(g2), acc[u][blk][4 * g + 3] * rs * wn[3] * siluf(g3));
                *(u32x2*)(OB + row * DM + h * 128 + dv) = w;
            }
    }
}

#define FRESH() KArgs ka_ = kargs(); Args a; a.x = gptr(ka_->x); a.meta = gptr(ka_->meta); a.attn_norm = gptr(ka_->attn_norm); a.w_in = gptr(ka_->w_in); a.w_au = gptr(ka_->w_au); a.b_alpha = gptr(ka_->b_alpha); a.b_forget = gptr(ka_->b_forget); a.gla_norm = gptr(ka_->gla_norm); a.fox_norm = gptr(ka_->fox_norm); a.w_out = gptr(ka_->w_out); a.ffn_norm = gptr(ka_->ffn_norm); a.w_up = gptr(ka_->w_up); a.conv_w = gptr(ka_->conv_w); a.conv_b = gptr(ka_->conv_b); a.w_down = gptr(ka_->w_down); a.final_norm = gptr(ka_->final_norm); a.out = gptr(ka_->out); a.ws = gptr(ka_->ws); unsigned char* ws = a.ws; \
    bf16* HB = (bf16*)(ws + WS_HB); bf16* OB = (bf16*)(ws + WS_OB); bf16* QKV = (bf16*)(ws + WS_QKV); bf16* A2 = (bf16*)(ws + WS_QKV); \
    float* UT = (float*)(ws + WS_UT); float* HF = (float*)(ws + WS_UT); float* HL = (float*)(ws + WS_UT + HFL_SIZE); \
    float* SM = (float*)(ws + WS_SM); float* CK = (float*)(ws + WS_CK); float* DEC = (float*)(ws + WS_DEC); float* HM = (float*)(ws + WS_HM); float* SSQ = (float*)(ws + WS_SSQ); \
    unsigned char* wl = ws + WS_W + (size_t)L * WL_SIZE; \
    (void)HB; (void)OB; (void)QKV; (void)A2; (void)UT; (void)HF; (void)HL; (void)SM; (void)CK; (void)DEC; (void)HM; (void)SSQ; (void)wl; \
    int G_ = gridDim.x, bx_ = blockIdx.x; asm volatile("" : "+s"(G_), "+s"(bx_)); const int G = G_, bx = bx_; (void)G; (void)bx; \
    int tid_ = threadIdx.x; asm volatile("" : "+v"(tid_)); const int tid = tid_, lane = tid & 63, wid = __builtin_amdgcn_readfirstlane(tid >> 6); \
    const int gw = bx * 8 + wid, NGW = G * 8, gt = bx * 512 + tid, NGT = G * 512; (void)lane; (void)gw; (void)NGW; (void)gt; (void)NGT;
#ifndef REP_A
#define REP_A 1
#endif
#ifndef REP_CA
#define REP_CA 1
#endif
#ifndef REP_F
#define REP_F 1
#endif
#ifndef REP_B
#define REP_B 1
#endif
#ifndef REP_D
#define REP_D 1
#endif
#define GSYNC_CG() do { asm volatile("s_waitcnt vmcnt(0) lgkmcnt(0)" ::: "memory"); grid.sync(); __builtin_amdgcn_fence(__ATOMIC_ACQUIRE, "agent"); asm volatile("s_waitcnt vmcnt(0)" ::: "memory"); } while (0)
#ifdef PROBE_PH
#define PH_END(id) do { const unsigned long long tn_ = __builtin_amdgcn_s_memrealtime(); if ((PROBE_PH >> (id)) & 1) tsync += tn_ - tlast; tlast = tn_; } while (0)
#else
#define PH_END(id) do {} while (0)
#endif
#ifdef PROBE_SYNC
#define GSYNC() do { const unsigned long long t0_ = __builtin_amdgcn_s_memrealtime(); xcd_barrier(xbar); tsync += __builtin_amdgcn_s_memrealtime() - t0_; } while (0)
#else
#define GSYNC() do { XcdBarrier xb_; xb_.bar = (unsigned*)(gptr(kargs()->ws) + WS_BAR); xb_.x = xb_xcc_id(); xb_.st = (volatile LAS unsigned*)(lds + HALO_OFF + 8192 + 1024); xcd_barrier(xb_); } while (0)
#endif
__global__ void __launch_bounds__(512, 2) fwd_kernel(Args a_unused) {
    extern __shared__ __attribute__((aligned(16))) unsigned char lds_raw[];
    LAS unsigned char* lds = (LAS unsigned char*)lds_raw;
    cg::grid_group grid = cg::this_grid();
#if defined(PROBE_SYNC) || defined(PROBE_PH)
    unsigned long long tsync = 0ull, tlast = __builtin_amdgcn_s_memrealtime(); (void)tlast;
#endif
    volatile LAS unsigned* xst = (volatile LAS unsigned*)(lds + HALO_OFF + 8192 + 1024);
    if (threadIdx.x < 2) xst[threadIdx.x] = 0u;
    __syncthreads();
    (void)xcd_barrier_post((unsigned*)(gptr(kargs()->ws) + WS_BAR), xst);
#ifndef REP_P
#define REP_P 1
#endif
    for (int rep = 0; rep < REP_P; ++rep) {
        const int L = 0; FRESH();
        LAS float* scr = (LAS float*)(lds + wid * 16384);
        constexpr int I_IN = 16 * (NINP / 32), I_OUT = 16 * 32, I_UP = 16 * (NUP / 32), I_DN = (DFF / 64) * 32, I_L = I_IN + I_OUT + I_UP + I_DN;
        for (int it = gw; it < DEPTH * I_L; it += NGW) {
            const int L = it / I_L; int r = it % I_L;
            unsigned char* wl = ws + WS_W + (size_t)L * WL_SIZE;
            if (r < I_IN) { const int nb = NINP / 32; tr_item(a.w_in + (size_t)L * DM * 3096, 3096, (bf16*)(wl + WL_IN), DM, a.attn_norm + L * DM, 0, scr, 64 * (r / nb), 32 * (r % nb), lane); continue; } r -= I_IN;
            if (r < I_OUT) { tr_item(a.w_out + (size_t)L * DM * DM, DM, (bf16*)(wl + WL_OUT), DM, nullptr, 1, scr, 64 * (r / 32), 32 * (r % 32), lane); continue; } r -= I_OUT;
            if (r < I_UP) { const int nb = NUP / 32; tr_item(a.w_up + (size_t)L * DM * NUP, NUP, (bf16*)(wl + WL_UP), DM, a.ffn_norm + L * DM, 2, scr, 64 * (r / nb), 32 * (r % nb), lane); continue; } r -= I_UP;
            tr_item(a.w_down + (size_t)L * DFF * DM, DM, (bf16*)(wl + WL_DN), DFF, nullptr, 3, scr, 64 * (r / 32), 32 * (r % 32), lane);
        }
        for (int i = gt; i < (256 - NMETA) * 4; i += NGT) SSQ[(size_t)(META0 + NMETA) * 4 + i] = 0.f;
        for (int r = gw; r < MREAL + 256; r += NGW) {
            if (r < MREAL) row_to_bf16(a.x + (size_t)r * DM, HB + (size_t)r * DM, SSQ + (size_t)r * 4, nullptr, lane);
            else if (r < MREAL + NMETA) row_to_bf16(a.meta + (size_t)(r - MREAL) * DM, HB + (size_t)r * DM, SSQ + (size_t)r * 4, HM + (size_t)(r - MREAL) * DM, lane);
            else {
#pragma unroll
                for (int j = 0; j < 4; ++j) { ((f32x4*)(HM + (size_t)(r - MREAL) * DM) + lane)[64 * j] = (f32x4){0.f, 0.f, 0.f, 0.f};
                    ((u32x2*)(HB + (size_t)r * DM) + lane)[64 * j] = (u32x2){0u, 0u}; ((u32x2*)(OB + (size_t)r * DM) + lane)[64 * j] = (u32x2){0u, 0u}; }
            }
        }
    }
    GSYNC_CG(); PH_END(0);

    for (int L = 0; L < DEPTH; ++L) {
#ifndef SKIP_A
        {
            FRESH();
            pg8::Gemm g{HB, (const bf16*)(wl + WL_IN), MROWS, NINP, DM}; pg8::StaticOrder S; S.init(MROWS, NINP, G, bx);
            EpiIn E{2 * L};
            for (int rep = 0; rep < REP_A; ++rep) pg8::gemm_phase<EpiIn, pg8::StaticOrder, true, true>(lds, g, S, E);
        }
#endif
        GSYNC(); PH_END(1);
#ifndef SKIP_B
        { FRESH();
        for (int rep = 0; rep < REP_B; ++rep) {
        for (int gr = bx; gr < 16 * NCH; gr += G) gla_u_group<2>(lds, QKV, SM, a.w_au + (size_t)L * 16 * 256, a.b_alpha + L * 256, UT, DEC, gr);
        for (int u = (G == 256) ? bx - 64 + ((bx < 64) ? 256 : 0) : bx; u < 64; u += G) fox_cumsum_unit(lds, SM, a.b_forget + L * 8, CK, u);
        }
        }
#endif
        GSYNC(); PH_END(2);
#ifndef SKIP_CS
        { FRESH();
        for (int e = gt; e < 32 * 2048; e += NGT) {
            const int bh = e >> 11, rem = (e & 2047) * 4, dk = rem & 63;
            float* up = UT + (size_t)bh * NCH * 8192 + rem; const float* dp = DEC + (size_t)bh * NCH * 64 + dk;
            f32x4 Sv = *(const f32x4*)up;
            for (int c0 = 1; c0 <= 64; c0 += 8) {
                f32x4 uu[8], dd[8];
#pragma unroll
                for (int i = 0; i < 8; ++i) { uu[i] = *(const f32x4*)(up + (size_t)(c0 + i) * 8192); dd[i] = *(const f32x4*)(dp + (c0 + i) * 64); }
#pragma unroll
                for (int i = 0; i < 8; ++i) { Sv = dd[i] * Sv + uu[i]; *(f32x4*)(up + (size_t)(c0 + i) * 8192) = Sv; }
            }
        }
#ifdef REP_SCAN
        for (int e = gt; e < 32 * 2048; e += NGT) {
            const int bh = e >> 11, rem = (e & 2047) * 4, dk = rem & 63;
            float* up = UT + (size_t)bh * NCH * 8192 + rem; const float* dp = DEC + (size_t)bh * NCH * 64 + dk;
            for (int c0 = 1; c0 <= 64; c0 += 8) {
                f32x4 uu[8], dd[8];
#pragma unroll
                for (int i = 0; i < 8; ++i) { uu[i] = *(const f32x4*)(up + (size_t)(c0 + i) * 8192); dd[i] = *(const f32x4*)(dp + (c0 + i) * 64); }
#pragma unroll
                for (int i = 0; i < 8; ++i) { *(f32x4*)(up + (size_t)(c0 + i) * 8192) = uu[i] + dd[i] * 0.f; }
            }
        }
#endif
        }
        { FRESH();
        for (int rep = 0; rep < REP_CA; ++rep)
        for (int v0 = bx; v0 < 256; v0 += G) {
            const int v = (G == 256) ? (v0 & 7) * 32 + (v0 >> 3) : v0;
            const int bhh = v >> 2, s = v & 3;
#pragma unroll 1
            for (int i = 0; i < 2; ++i) {
                const int qb = (i == 0) ? s : 7 - s;
                attn_unit(lds, QKV, CK, OB, a.fox_norm + L * 512, bhh >> 3, bhh & 7, qb);
            }
        }
#endif
#ifndef SKIP_CM
        }
        { FRESH();
#ifndef REP_CM
#define REP_CM 1
#endif
        for (int rep = 0; rep < REP_CM; ++rep)
        if (bx < NMETA) meta_attn(QKV, CK, OB, a.fox_norm + L * 512, bx);
        if (bx >= NMETA && bx < NMETA + 4 && wid == 0) { const int bhs[1] = {bx - NMETA}, ccs[1] = {0}, hfs[1] = {0}; gla_readout_wave<1>(QKV, UT, OB, a.gla_norm + L * 512, bhs, ccs, hfs, lane); }
        }
#endif
        GSYNC(); PH_END(3);
#ifndef SKIP_D
        { FRESH();
        for (int rep = 0; rep < REP_D; ++rep)
        for (int wu = gw; wu < 32 * 64; wu += NGW) gla_readout_chunk(QKV, UT, OB, a.gla_norm + L * 512, wu >> 6, 1 + (wu & 63), lane);
        }
#endif
        GSYNC(); PH_END(4);
#ifndef SKIP_E
        {
            FRESH();
            meta_rowgemm(OB + (size_t)META0 * DM, DM, (const bf16*)(wl + WL_OUT), DM, HM, HB, G, bx);
            pg8::Gemm g{OB, (const bf16*)(wl + WL_OUT), MREAL, DM, DM}; pg8::StaticOrder S; S.init(MREAL, DM, G, bx);
            if (L == 0) { EpiRes<true, false> E{2 * L + 1}; pg8::gemm_phase<EpiRes<true, false>, pg8::StaticOrder, true, true>(lds, g, S, E); }
            else { EpiRes<false, false> E{2 * L + 1}; pg8::gemm_phase<EpiRes<false, false>, pg8::StaticOrder, true, true>(lds, g, S, E); }
        }
#endif
        GSYNC(); PH_END(5);
#ifndef SKIP_F
        {
            FRESH();
            meta_up(lds, HB, (const bf16*)(wl + WL_UP), HM, a.conv_w + (size_t)L * 3 * NUP, a.conv_b + (size_t)L * NUP, A2, HL, G, bx);
            pg8::Gemm g{HB, (const bf16*)(wl + WL_UP), MREAL, NUP, DM}; pg8::StaticOrder S; S.init(MREAL, NUP, G, bx);
            EpiUp E{L};
            for (int rep = 0; rep < REP_F; ++rep) pg8::gemm_phase<EpiUp, pg8::StaticOrder, true, true>(lds, g, S, E);
        }
#endif
        GSYNC(); PH_END(6);
#ifndef SKIP_H
        {
            FRESH();
            const float* cw = a.conv_w + (size_t)L * 3 * NUP; const float* cb = a.conv_b + (size_t)L * NUP;
            { int pm = 0;
              for (int ui = 0; so_next_pm(MREAL / 256, DM / 256, G, bx, ui, pm); ++ui) {
                for (int i = tid; i < 2 * (DFF / 4); i += 512) {
                    const int c4 = i % (DFF / 4), rr = i / (DFF / 4);
                    const int ch = 4 * c4;
                    f32x4 hc[2];
#pragma unroll
                    for (int bj = 0; bj < 2; ++bj) {
                        const int c = bj * DFF + ch;
                        f32x4 P0 = {0.f, 0.f, 0.f, 0.f}, P1 = P0;
                        if (pm != 128) { const int src = (pm % 16 == 0) ? 128 : pm - 1; P0 = *(const f32x4*)(HL + (size_t)(src * 2) * NUP + c); P1 = *(const f32x4*)(HL + (size_t)(src * 2 + 1) * NUP + c); }
                        const f32x4 H0 = *(const f32x4*)(HF + (size_t)(pm * 2) * NUP + c), H1 = *(const f32x4*)(HF + (size_t)(pm * 2 + 1) * NUP + c);
                        const f32x4 x2 = rr == 0 ? P0 : P1, x1 = rr == 0 ? P1 : H0, x0 = rr == 0 ? H0 : H1;
                        hc[bj] = *(const f32x4*)(cb + c) + *(const f32x4*)(cw + c) * x2 + *(const f32x4*)(cw + NUP + c) * x1 + *(const f32x4*)(cw + 2 * NUP + c) * x0;
                    }
                    u32x2 w;
                    w.x = pk2(siluf(hc[1][0]) * hc[0][0], siluf(hc[1][1]) * hc[0][1]);
                    w.y = pk2(siluf(hc[1][2]) * hc[0][2], siluf(hc[1][3]) * hc[0][3]);
                    *(u32x2*)(A2 + (size_t)(pm * 256 + rr) * DFF + ch) = w;
                }
              }
            }
            asm volatile("s_waitcnt vmcnt(0)" ::: "memory"); __syncthreads();
            meta_rowgemm(A2 + (size_t)META0 * DFF, DFF, (const bf16*)(wl + WL_DN), DFF, HM, HB, G, bx);
            pg8::Gemm g{A2, (const bf16*)(wl + WL_DN), MREAL, DM, DFF}; pg8::StaticOrder S; S.init(MREAL, DM, G, bx);
            if (L == DEPTH - 1) { EpiRes<false, true> E{2 * L + 2}; pg8::gemm_phase<EpiRes<false, true>, pg8::StaticOrder, true, true>(lds, g, S, E); }
            else { EpiRes<false, false> E{2 * L + 2}; pg8::gemm_phase<EpiRes<false, false>, pg8::StaticOrder, true, true>(lds, g, S, E); }
        }
#endif
        GSYNC(); PH_END(7);
    }
    {
        const int L = 0; FRESH();
        const float* ssq = ssq_arr(ws, 8);
        for (int r = gw; r < MREAL; r += NGW) {
            const float rs = row_rstd(ssq, r);
            f32x4* p = (f32x4*)(a.out + (size_t)r * DM) + lane; const f32x4* wn = (const f32x4*)a.final_norm + lane;
#pragma unroll
            for (int j = 0; j < 4; ++j) p[64 * j] = p[64 * j] * rs * wn[64 * j];
        }
#if defined(PROBE_SYNC) || defined(PROBE_PH)
        asm volatile("s_waitcnt vmcnt(0)" ::: "memory"); __syncthreads();
        if (bx == PROBE_BLOCK && tid == 0) a.out[(size_t)PROBE_BLOCK * 16 * DM * 0 + 5] += floorf((float)tsync * 0.0002f + 0.5f);
#endif
    }
}

extern "C" void kernel_launch(void* const* d_in, const int* in_sizes, int n_in, void* d_out, int out_size, void* d_ws, size_t ws_size, hipStream_t stream) {
    static int grid = 0;
    if (grid == 0) {
        if (n_in != 16 || out_size != MREAL * DM || ws_size < WS_END) { fprintf(stderr, "kernel_launch: unexpected problem (n_in %d out %d ws %zu, need %zu)\n", n_in, out_size, ws_size, (size_t)WS_END); grid = -1; return; }
        int dev = 0, cus = 0, per = 0;
        (void)hipGetDevice(&dev); (void)hipDeviceGetAttribute(&cus, hipDeviceAttributeMultiprocessorCount, dev);
        (void)hipFuncSetAttribute((const void*)fwd_kernel, hipFuncAttributeMaxDynamicSharedMemorySize, LDS_BYTES);
        (void)hipOccupancyMaxActiveBlocksPerMultiprocessor(&per, (const void*)fwd_kernel, 512, LDS_BYTES);
        if (per < 1) per = 1;
        grid = cus * per;
        fprintf(stderr, "kernel_launch: grid %d (cus %d x %d), ws %zu\n", grid, cus, per, ws_size);
    }
    if (grid < 0) return;
    Args a{};
    const float** f = (const float**)&a;
    for (int i = 0; i < 16; ++i) f[i] = (const float*)d_in[i];
    a.out = (float*)d_out; a.ws = (unsigned char*)d_ws;
    (void)hipMemsetAsync((unsigned char*)d_ws + WS_BAR, 0, BAR_BYTES, stream);
    void* args[] = {&a};
    hipError_t e = hipLaunchCooperativeKernel((const void*)fwd_kernel, dim3(grid), dim3(512), args, LDS_BYTES, stream);
    if (e != hipSuccess) fprintf(stderr, "cooperative launch failed: %s (grid %d)\n", hipGetErrorString(e), grid);
}
```

```cpp
#include <hip/hip_runtime.h>
#include <hip/hip_cooperative_groups.h>
#include <cstdio>
#include <cstdint>
namespace cg = cooperative_groups;
namespace pg8 {
#define PG8_LAS __attribute__((address_space(3)))
typedef unsigned short bf16_t;
typedef short bf16x8 __attribute__((ext_vector_type(8)));
typedef float f32x4 __attribute__((ext_vector_type(4)));
typedef unsigned u32x4 __attribute__((ext_vector_type(4)));
constexpr int BM = 256, BK = 64, HALF = 128, HTB = HALF * BK * 2  , STAGE_BYTES = 8 * HTB, NXCD = 8, WGM = 8;

__host__ __device__ __forceinline__ int lds_byte(int r, int c) { const int st = (r >> 4) * 2 + (c >> 5), rr = r & 15, cc = c & 31, ob = rr * 64 + cc * 2; return st * 1024 + (ob ^ (((ob >> 9) & 1) << 5)); }
__host__ __device__ __forceinline__ void stage_rc(int b, int& R, int& C) { const int st = b / 1024, sb = b % 1024, swz = sb ^ (((sb >> 9) & 1) << 5); R = (st >> 1) * 16 + swz / 64; C = (st & 1) * 32 + (swz % 64) / 2; }
__host__ __device__ __forceinline__ int perm32(int rho) { const int n = rho >> 4, i = rho & 15; return 8 * (i >> 2) + 4 * n + (i & 3); }

struct Unit { int pm, pn; };
struct Gemm { const bf16_t* A; const bf16_t* Bt; int M, N, K; };

struct StaticOrder {
    int nM, nN, nwg, G, c;
    __host__ __device__ void init(int M, int N, int G_, int c_) { nM = M / BM; nN = N / BM; nwg = nM * nN; G = G_; c = c_; }
    __host__ __device__ bool next(int i, Unit& u) const {
        const long L = (long)i * G + c; if (L >= nwg) return false;
        int wgid = (int)L; { const int q = nwg / NXCD, r = nwg % NXCD, xcd = wgid % NXCD, off = wgid / NXCD; wgid = (xcd < r ? xcd * (q + 1) : r * (q + 1) + (xcd - r) * q) + off; }
        const int nig = WGM * nN, gid = wgid / nig, fm = gid * WGM, gsz = (nM - fm) < WGM ? (nM - fm) : WGM;
        u.pm = fm + ((wgid % nig) % gsz); u.pn = (wgid % nig) / gsz; return true;
    }
    __device__ __forceinline__ void a_ready(const Unit&) const {}
    __device__ __forceinline__ void done(const Unit&) const {}
};

__device__ __forceinline__ unsigned cvt_pk_bf16(float lo, float hi) { unsigned r; asm volatile("v_cvt_pk_bf16_f32 %0, %1, %2" : "=v"(r) : "v"(lo), "v"(hi)); return r; }
typedef float f32x2 __attribute__((ext_vector_type(2)));
template <class Epi, class Sched, bool ALIGN_EPI = false, bool SP2 = false>
__device__ __forceinline__ void gemm_phase(PG8_LAS unsigned char* lds, const Gemm g, const Sched& S, const Epi& E) {
    int tid_ = threadIdx.x; asm volatile("" : "+v"(tid_)); const int tid = tid_, wid = __builtin_amdgcn_readfirstlane(tid >> 6), lane = tid & 63, wr = wid >> 2, wc = wid & 3, fr = lane & 15, fq = lane >> 4;
    const int K = g.K, nt = K / BK;
    unsigned voffA[2], voffB[2];
#pragma unroll
    for (int i = 0; i < 2; ++i) { int R, C; stage_rc(tid * 16 + i * 8192, R, C); const int Rb = Epi::PERM ? ((R & ~31) + perm32(R & 31)) : R;
        voffA[i] = (unsigned)(R * K + C) * 2u; voffB[i] = (unsigned)(Rb * K + C) * 2u; }
    const size_t kstep = (size_t)(BK * 2);
    const size_t hstep = (size_t)HALF * K * 2;
    const size_t tstep = 2 * hstep;
    const unsigned ldsw = (unsigned)wid * 1024u;
    const int aoff = lds_byte(wr * 64 + fr, fq * 8), boff = lds_byte(wc * 32 + fr, fq * 8);
#define PG8_SA(b, h) (((b) * 2 + (h)) * HTB)
#define PG8_SB(b, h) ((4 + (b) * 2 + (h)) * HTB)
#define PG8_STAGE(bufoff, gbase, voff) do { _Pragma("unroll") for (int _i = 0; _i < 2; ++_i) \
        __builtin_amdgcn_global_load_lds((const unsigned*)((const char*)(gbase) + (voff)[_i]), (PG8_LAS unsigned*)(lds + (bufoff) + ldsw + _i * 8192), 16, 0, 0); } while (0)
#define PG8_LDA(dst, b, h) do { _Pragma("unroll") for (int m = 0; m < 4; ++m) _Pragma("unroll") for (int k = 0; k < 2; ++k) dst[m][k] = *(const PG8_LAS bf16x8*)(lds + PG8_SA(b, h) + aoff + m * 2048 + k * 1024); } while (0)
#define PG8_LDB(dst, b, h) do { _Pragma("unroll") for (int n = 0; n < 2; ++n) _Pragma("unroll") for (int k = 0; k < 2; ++k) dst[n][k] = *(const PG8_LAS bf16x8*)(lds + PG8_SB(b, h) + boff + n * 2048 + k * 1024); } while (0)
#define PG8_MMA(ai, bj, At, Bt) do { __builtin_amdgcn_s_setprio(1); _Pragma("unroll") for (int m = 0; m < 4; ++m) _Pragma("unroll") for (int n = 0; n < 2; ++n) _Pragma("unroll") for (int k = 0; k < 2; ++k) \
        acc[ai][bj][m][n] = __builtin_amdgcn_mfma_f32_16x16x32_bf16(Bt[n][k], At[m][k], acc[ai][bj][m][n], 0, 0, 0); __builtin_amdgcn_s_setprio(0); } while (0)
#define PG8_WAIT_V(n) asm volatile("s_waitcnt vmcnt(" #n ")" ::: "memory")
#define PG8_WAIT_L(n) asm volatile("s_waitcnt lgkmcnt(" #n ")" ::: "memory")
#define PG8_BAR __builtin_amdgcn_s_barrier()
#define PG8_SCHED __builtin_amdgcn_sched_barrier(0)
    Unit cur, nxt; int ui = 0;
    if (!S.next(0, cur)) return;
    f32x4 acc[2][2][4][2];
#pragma unroll
    for (int a = 0; a < 2; ++a)
#pragma unroll
        for (int b = 0; b < 2; ++b)
#pragma unroll
            for (int m = 0; m < 4; ++m)
#pragma unroll
                for (int n = 0; n < 2; ++n) acc[a][b][m][n] = (f32x4){0.f, 0.f, 0.f, 0.f};
    bf16x8 At[4][2], B0[2][2], B1[2][2];
    const char* cA = (const char*)g.A + (size_t)cur.pm * tstep; const char* cB = (const char*)g.Bt + (size_t)cur.pn * tstep;
    S.a_ready(cur);
    if constexpr (SP2) {
        PG8_STAGE(PG8_SB(0, 0), cB, voffB); PG8_STAGE(PG8_SB(0, 1), cB + hstep, voffB); PG8_STAGE(PG8_SA(0, 0), cA, voffA); PG8_STAGE(PG8_SA(0, 1), cA + hstep, voffA);
        if (wr == 1) PG8_BAR;
        PG8_WAIT_V(2); PG8_BAR;
        PG8_STAGE(PG8_SB(1, 0), cB + kstep, voffB); PG8_STAGE(PG8_SA(1, 0), cA + kstep, voffA); PG8_STAGE(PG8_SB(1, 1), cB + hstep + kstep, voffB);
        PG8_WAIT_V(6); PG8_BAR;
    } else {
        PG8_STAGE(PG8_SB(0, 0), cB, voffB); PG8_STAGE(PG8_SA(0, 0), cA, voffA); PG8_STAGE(PG8_SB(0, 1), cB + hstep, voffB); PG8_STAGE(PG8_SA(0, 1), cA + hstep, voffA);
        if (wr == 1) PG8_BAR;
        PG8_WAIT_V(4); PG8_BAR;
        PG8_STAGE(PG8_SB(1, 0), cB + kstep, voffB); PG8_STAGE(PG8_SA(1, 0), cA + kstep, voffA); PG8_STAGE(PG8_SB(1, 1), cB + hstep + kstep, voffB);
        PG8_WAIT_V(6); PG8_BAR;
    }
    for (;;) {
        const bool has_next = S.next(ui + 1, nxt);
        const char* nA = has_next ? (const char*)g.A + (size_t)nxt.pm * tstep : cA; const char* nB = has_next ? (const char*)g.Bt + (size_t)nxt.pn * tstep : cB;
        for (int t = 0; t < nt; t += 2) {
            const bool last = (t == nt - 2);
            const char* a1 = cA + (size_t)(t + 1) * kstep;
            const char* a2 = last ? nA : cA + (size_t)(t + 2) * kstep; const char* b2 = last ? nB : cB + (size_t)(t + 2) * kstep;
            const char* a3 = a2 + kstep; const char* b3 = b2 + kstep;
            if (last && has_next) S.a_ready(nxt);
            if constexpr (SP2) {
            PG8_LDB(B0, 0, 0); PG8_LDB(B1, 0, 1); PG8_SCHED; PG8_LDA(At, 0, 0); PG8_STAGE(PG8_SA(1, 1), a1 + hstep, voffA);
            PG8_WAIT_V(8); PG8_WAIT_L(0); PG8_BAR; PG8_MMA(0, 0, At, B0); PG8_MMA(0, 1, At, B1); PG8_BAR; PG8_SCHED;
            PG8_LDA(At, 0, 1); PG8_STAGE(PG8_SB(0, 0), b2, voffB); PG8_STAGE(PG8_SB(0, 1), b2 + hstep, voffB); PG8_STAGE(PG8_SA(0, 0), a2, voffA);
            PG8_WAIT_V(8); PG8_WAIT_L(0); PG8_BAR; PG8_MMA(1, 0, At, B0); PG8_MMA(1, 1, At, B1); PG8_BAR; PG8_SCHED;
            PG8_LDB(B0, 1, 0); PG8_LDB(B1, 1, 1); PG8_SCHED; PG8_LDA(At, 1, 0); PG8_STAGE(PG8_SA(0, 1), a2 + hstep, voffA);
            PG8_WAIT_V(8); PG8_WAIT_L(0); PG8_BAR; PG8_MMA(0, 0, At, B0); PG8_MMA(0, 1, At, B1); PG8_BAR; PG8_SCHED;
            PG8_LDA(At, 1, 1); PG8_STAGE(PG8_SB(1, 0), b3, voffB); PG8_STAGE(PG8_SB(1, 1), b3 + hstep, voffB); PG8_STAGE(PG8_SA(1, 0), a3, voffA);
            PG8_WAIT_V(8); PG8_WAIT_L(0); PG8_BAR; PG8_MMA(1, 0, At, B0); PG8_MMA(1, 1, At, B1); PG8_BAR; PG8_SCHED;
            } else {
            PG8_LDB(B0, 0, 0); PG8_SCHED; PG8_LDA(At, 0, 0); PG8_STAGE(PG8_SA(1, 1), a1 + hstep, voffA);
            PG8_WAIT_L(8); PG8_BAR; PG8_WAIT_L(0); PG8_MMA(0, 0, At, B0); PG8_BAR; PG8_SCHED;
            PG8_LDB(B1, 0, 1); PG8_STAGE(PG8_SB(0, 0), b2, voffB);
            PG8_BAR; PG8_WAIT_L(0); PG8_MMA(0, 1, At, B1); PG8_BAR;
            PG8_LDA(At, 0, 1); PG8_STAGE(PG8_SA(0, 0), a2, voffA);
            PG8_BAR; PG8_WAIT_L(0); PG8_MMA(1, 0, At, B0); PG8_BAR; PG8_SCHED;
            PG8_STAGE(PG8_SB(0, 1), b2 + hstep, voffB);
            PG8_WAIT_V(6); PG8_BAR; PG8_MMA(1, 1, At, B1); PG8_BAR;
            PG8_LDB(B0, 1, 0); PG8_SCHED; PG8_LDA(At, 1, 0); PG8_STAGE(PG8_SA(0, 1), a2 + hstep, voffA);
            PG8_WAIT_L(8); PG8_BAR; PG8_WAIT_L(0); PG8_MMA(0, 0, At, B0); PG8_BAR; PG8_SCHED;
            PG8_LDB(B1, 1, 1); PG8_STAGE(PG8_SB(1, 0), b3, voffB);
            PG8_BAR; PG8_WAIT_L(0); PG8_MMA(0, 1, At, B1); PG8_BAR;
            PG8_LDA(At, 1, 1); PG8_STAGE(PG8_SA(1, 0), a3, voffA);
            PG8_BAR; PG8_WAIT_L(0); PG8_MMA(1, 0, At, B0); PG8_BAR; PG8_SCHED;
            PG8_STAGE(PG8_SB(1, 1), b3 + hstep, voffB);
            PG8_WAIT_V(6); PG8_BAR; PG8_MMA(1, 1, At, B1); PG8_BAR;
            }
        }
        if constexpr (ALIGN_EPI) { if (wr == 0) PG8_BAR; }
        if constexpr (!Epi::AFTER_DRAIN) { E(acc, cur, wr, wc, fr, fq); S.done(cur); }
        if (!has_next) break;
#pragma unroll
        for (int a = 0; a < 2; ++a)
#pragma unroll
            for (int b = 0; b < 2; ++b)
#pragma unroll
                for (int m = 0; m < 4; ++m)
#pragma unroll
                    for (int n = 0; n < 2; ++n) acc[a][b][m][n] = (f32x4){0.f, 0.f, 0.f, 0.f};
        cur = nxt; cA = nA; cB = nB; ++ui;
        if constexpr (ALIGN_EPI) { if (wr == 1) PG8_BAR; }
    }
    PG8_WAIT_V(0);
    if constexpr (!ALIGN_EPI) { if (wr == 0) PG8_BAR; }
    PG8_BAR;
    if constexpr (Epi::AFTER_DRAIN) { E.fused(acc, cur, wr, wc, fr, fq, lds, wid, lane); S.done(cur); }
#undef PG8_SA
#undef PG8_SB
#undef PG8_STAGE
#undef PG8_LDA
#undef PG8_LDB
#undef PG8_MMA
#undef PG8_WAIT_V
#undef PG8_WAIT_L
#undef PG8_BAR
#undef PG8_SCHED
}
}
#define LAS __attribute__((address_space(3)))
typedef unsigned short bf16;
typedef short bf16x8 __attribute__((ext_vector_type(8)));
typedef short s16x4 __attribute__((ext_vector_type(4)));
typedef float f32x4 __attribute__((ext_vector_type(4)));
typedef float f32x16 __attribute__((ext_vector_type(16)));
typedef unsigned u32x4 __attribute__((ext_vector_type(4)));
typedef unsigned u32x2 __attribute__((ext_vector_type(2)));

constexpr int NB = 8, SEQ = 4096, DM = 1024, DEPTH = 4, NMETA = 16;
constexpr int MREAL = NB * SEQ;
constexpr int META0 = MREAL;
constexpr int MROWS = 129 * 256;
constexpr int NINP = 3328, QP = 3072;
constexpr int C_FQ = 0, C_FK = 512, C_FV = 1024, C_GQ = 1536, C_GK = 1792, C_GV = 2048, C_GR = 2560;
constexpr int DFF = 2816, NUP = 5632;
constexpr float EPS = 1e-6f, LOG2E = 1.4426950408889634f, C2 = 0.125f * LOG2E;
constexpr int CKP = 4160;
constexpr int NCH = 65;

constexpr size_t MiB = 1u << 20;
constexpr size_t WL_IN = 0, WL_OUT = 6815744, WL_UP = 8912896, WL_DN = 20447232, WL_SIZE = 26214400;
constexpr size_t WS_W = 0, WS_HB = 100 * MiB, WS_OB = WS_HB + 67633152, WS_QKV = WS_OB + 67633152, WS_UT = WS_QKV + 202899456;
constexpr size_t WS_SM = WS_UT + 68157440, WS_CK = WS_SM + 4456448, WS_DEC = WS_CK + 1310720, WS_HM = WS_DEC + 786432, WS_SSQ = WS_HM + MiB, WS_BAR = WS_SSQ + 1835008, BAR_BYTES = 16384, WS_END = WS_BAR + BAR_BYTES;
static_assert(WS_END <= 512 * MiB, "workspace map");
constexpr size_t HFL_SIZE = (size_t)129 * 2 * NUP * 4;
static_assert(2 * HFL_SIZE <= 68157440, "halo overlay");

constexpr int LDS_BYTES = 147456, HALO_OFF = 131072;

struct Args {
    const float *x, *meta, *attn_norm, *w_in, *w_au, *b_alpha, *b_forget, *gla_norm, *fox_norm, *w_out, *ffn_norm, *w_up, *conv_w, *conv_b, *w_down, *final_norm;
    float* out; unsigned char* ws;
};

#define GAS __attribute__((address_space(1)))
#define CAS __attribute__((address_space(4)))
typedef const CAS Args* KArgs;
__device__ __forceinline__ KArgs kargs() { KArgs p = (KArgs)__builtin_amdgcn_kernarg_segment_ptr(); asm volatile("" : "+s"(p)); return p; }
template <class T> __device__ __forceinline__ T* gptr(T* p) { return (T*)(GAS T*)p; }
__device__ __forceinline__ float bf2f(bf16 v) { return __uint_as_float((unsigned)v << 16); }
__device__ __forceinline__ unsigned pk2(float lo, float hi) { return pg8::cvt_pk_bf16(lo, hi); }
__device__ __forceinline__ bf16 f2bf(float v) { return (bf16)(pk2(v, 0.f) & 0xffffu); }
__device__ __forceinline__ float wave_sum(float v) {
#pragma unroll
    for (int o = 1; o < 64; o <<= 1) v += __shfl_xor(v, o);
    return v;
}
__device__ __forceinline__ float logsigmoidf(float z) { return -(fmaxf(-z, 0.f) + log1pf(__expf(-fabsf(z)))); }
__device__ __forceinline__ float siluf(float v) { return v * __builtin_amdgcn_rcpf(1.f + __builtin_amdgcn_exp2f(-LOG2E * v)); }
__device__ __forceinline__ int crow(int r, int hi) { return (r & 3) + 8 * (r >> 2) + 4 * hi; }
__device__ __forceinline__ s16x4 vtr(const LAS unsigned char* p) { return __builtin_bit_cast(s16x4, __builtin_amdgcn_ds_read_tr16_b64_v4i16((LAS s16x4*)p)); }
__device__ __forceinline__ bf16x8 cat8(s16x4 a, s16x4 b) { return (bf16x8){a[0], a[1], a[2], a[3], b[0], b[1], b[2], b[3]}; }
__device__ __forceinline__ float dppf(float old, float src, int ctrl_unused);
#define DPP_MOV(old, src, ctrl) __builtin_bit_cast(float, __builtin_amdgcn_update_dpp(__builtin_bit_cast(int, (float)(old)), __builtin_bit_cast(int, (float)(src)), (ctrl), 0xf, 0xf, false))
#define LDS_WAIT() asm volatile("s_waitcnt lgkmcnt(0)" ::: "memory")

__device__ __forceinline__ const float* ssq_arr(unsigned char* wsb, int si) { return (const float*)(wsb + WS_SSQ) + (size_t)(si % 3) * MROWS * 4; }
__device__ __forceinline__ float row_rstd(const float* ssqp, int row) { const f32x4 s = *(const f32x4*)(ssqp + (size_t)row * 4); return rsqrtf(((s[0] + s[1]) + (s[2] + s[3])) * (1.0f / DM) + EPS); }
__device__ __forceinline__ LAS float* tile_rstd(unsigned char* wsb, int si, int pm, int wr, int wc, int fr, int fq) {
    extern __shared__ __attribute__((aligned(16))) unsigned char lds_dyn_[];
    LAS float* rsl = (LAS float*)((LAS unsigned char*)lds_dyn_ + HALO_OFF + 8192);
    const int tl = (wr * 4 + wc) * 64 + fq * 16 + fr;
    if (pm != 128) {
        if (tl < 256) rsl[tl] = row_rstd(ssq_arr(wsb, si), pm * 256 + tl);
    } else {
        const int row = tl >> 5, part = tl & 31;
        const f32x4* hp = (const f32x4*)((const float*)(wsb + WS_HM) + (size_t)row * DM) + part;
        float s = 0.f;
#pragma unroll
        for (int j = 0; j < 8; ++j) { const f32x4 v = hp[32 * j]; s += (v[0] * v[0] + v[1] * v[1]) + (v[2] * v[2] + v[3] * v[3]); }
        s += __shfl_xor(s, 1); s += __shfl_xor(s, 2); s += __shfl_xor(s, 4); s += __shfl_xor(s, 8); s += __shfl_xor(s, 16);
        if (part == 0) rsl[row] = rsqrtf(s * (1.0f / DM) + EPS);
        if (tl < 240) rsl[16 + tl] = 0.f;
    }
    asm volatile("s_waitcnt lgkmcnt(0)" ::: "memory"); __builtin_amdgcn_s_barrier(); asm volatile("" ::: "memory");
    return rsl;
}
__device__ __forceinline__ void meta_rowgemm(const bf16* A, int lda, const bf16* Bt, int K, float* HM, bf16* HB, int G, int bx) {
    int tid_ = threadIdx.x; asm volatile("" : "+v"(tid_)); const int r = tid_ >> 5, kp = tid_ & 31;
    for (int cg = bx; cg < 256; cg += G) {
        float acc[4] = {0.f, 0.f, 0.f, 0.f};
        for (int k0 = kp * 8; k0 < K; k0 += 256) {
            const u32x4 av = *(const u32x4*)(A + (size_t)r * lda + k0);
#pragma unroll
            for (int j = 0; j < 4; ++j) {
                const u32x4 bv = *(const u32x4*)(Bt + (size_t)(4 * cg + j) * K + k0);
#pragma unroll
                for (int q = 0; q < 4; ++q) {
                    acc[j] += __uint_as_float(av[q] << 16) * __uint_as_float(bv[q] << 16);
                    acc[j] += __uint_as_float(av[q] & 0xffff0000u) * __uint_as_float(bv[q] & 0xffff0000u);
                }
            }
        }
#pragma unroll
        for (int j = 0; j < 4; ++j) { float s = acc[j]; s += __shfl_xor(s, 1); s += __shfl_xor(s, 2); s += __shfl_xor(s, 4); s += __shfl_xor(s, 8); s += __shfl_xor(s, 16); acc[j] = s; }
        if (kp == 0) {
            float* hp = HM + (size_t)r * DM + 4 * cg;
            const f32x4 h = *(const f32x4*)hp + (f32x4){acc[0], acc[1], acc[2], acc[3]};
            *(f32x4*)hp = h;
            u32x2 w; w.x = pk2(h[0], h[1]); w.y = pk2(h[2], h[3]);
            *(u32x2*)(HB + (size_t)(META0 + r) * DM + 4 * cg) = w;
        }
    }
}
__device__ __forceinline__ void meta_up(LAS unsigned char* lds, const bf16* HB, const bf16* Wup, const float* HM, const float* cw, const float* cb, bf16* A2, float* HL, int G, int bx) {
    int tid_ = threadIdx.x; asm volatile("" : "+v"(tid_)); const int tid = tid_, r = tid >> 5, kp = tid & 31;
    LAS float* hb = (LAS float*)lds;
    float rs;
    { const f32x4* hp = (const f32x4*)(HM + (size_t)r * DM) + kp; float s = 0.f;
#pragma unroll
      for (int j = 0; j < 8; ++j) { const f32x4 v = hp[32 * j]; s += (v[0] * v[0] + v[1] * v[1]) + (v[2] * v[2] + v[3] * v[3]); }
      s += __shfl_xor(s, 1); s += __shfl_xor(s, 2); s += __shfl_xor(s, 4); s += __shfl_xor(s, 8); s += __shfl_xor(s, 16);
      rs = rsqrtf(s * (1.0f / DM) + EPS); }
    u32x4 av[4];
#pragma unroll
    for (int i = 0; i < 4; ++i) av[i] = *(const u32x4*)(HB + (size_t)(META0 + r) * DM + kp * 8 + 256 * i);
    for (int cg = bx; cg < 256; cg += G) {
#pragma unroll 1
        for (int cb0 = 0; cb0 < 24; cb0 += 6) {
            u32x4 bv[6][4];
#pragma unroll
            for (int c6 = 0; c6 < 6; ++c6) {
                const int c = cb0 + c6 < 22 ? cb0 + c6 : 21, isg = c >= 11 ? 1 : 0, jj = c - 11 * isg;
                const int ch = 11 * cg + jj, wrow = (ch >> 7) * 256 + isg * 128 + (ch & 127);
#pragma unroll
                for (int i = 0; i < 4; ++i) bv[c6][i] = *(const u32x4*)(Wup + (size_t)wrow * DM + kp * 8 + 256 * i);
            }
#pragma unroll
            for (int c6 = 0; c6 < 6; ++c6) {
                float acc = 0.f;
#pragma unroll
                for (int i = 0; i < 4; ++i)
#pragma unroll
                    for (int q = 0; q < 4; ++q) {
                        acc += __uint_as_float(av[i][q] << 16) * __uint_as_float(bv[c6][i][q] << 16);
                        acc += __uint_as_float(av[i][q] & 0xffff0000u) * __uint_as_float(bv[c6][i][q] & 0xffff0000u);
                    }
                acc += __shfl_xor(acc, 1); acc += __shfl_xor(acc, 2); acc += __shfl_xor(acc, 4); acc += __shfl_xor(acc, 8); acc += __shfl_xor(acc, 16);
                if (kp == 0 && cb0 + c6 < 22) hb[r * 24 + cb0 + c6] = acc * rs;
            }
        }
        __syncthreads();
        if (tid < 16 * 11) {
            const int rr = tid / 11, jj = tid % 11, ch = 11 * cg + jj;
            float hc[2];
#pragma unroll
            for (int ug = 0; ug < 2; ++ug) {
                const int c = ug * DFF + ch;
                const float x0 = hb[rr * 24 + ug * 11 + jj], x1 = rr >= 1 ? hb[(rr - 1) * 24 + ug * 11 + jj] : 0.f, x2 = rr >= 2 ? hb[(rr - 2) * 24 + ug * 11 + jj] : 0.f;
                hc[ug] = cb[c] + cw[c] * x2 + cw[NUP + c] * x1 + cw[2 * NUP + c] * x0;
                if (rr >= 14) HL[(size_t)(256 + rr - 14) * NUP + c] = x0;
            }
            A2[(size_t)(META0 + rr) * DFF + ch] = f2bf(siluf(hc[1]) * hc[0]);
        }
        __syncthreads();
    }
}
__device__ __forceinline__ bool so_next_pm(int nM, int nN, int G, int c, int i, int& pm) {
    const int nwg = nM * nN; const long Lq = (long)i * G + c; if (Lq >= nwg) return false;
    int wgid = (int)Lq; { const int q = nwg / pg8::NXCD, r = nwg % pg8::NXCD, xcd = wgid % pg8::NXCD, off = wgid / pg8::NXCD; wgid = (xcd < r ? xcd * (q + 1) : r * (q + 1) + (xcd - r) * q) + off; }
    const int nig = pg8::WGM * nN, gid = wgid / nig, fm = gid * pg8::WGM, gsz = (nM - fm) < pg8::WGM ? (nM - fm) : pg8::WGM;
    pm = fm + ((wgid % nig) % gsz); return true;
}
struct EpiIn {
    static constexpr bool PERM = true, AFTER_DRAIN = false;
    int si;
    __device__ __forceinline__ void operator()(const pg8::f32x4 (&acc)[2][2][4][2], const pg8::Unit& u, int wr, int wc, int fr, int fq) const {
        asm volatile("" : "+v"(fr), "+v"(fq));
        unsigned char* wsb = gptr(kargs()->ws);
        bf16* Q = (bf16*)(wsb + WS_QKV); float* SM = (float*)(wsb + WS_SM); const LAS float* rsl = tile_rstd(wsb, si, u.pm, wr, wc, fr, fq);
#pragma unroll
        for (int ai = 0; ai < 2; ++ai)
#pragma unroll
            for (int m = 0; m < 4; ++m) {
                const int row = u.pm * 256 + ai * 128 + wr * 64 + m * 16 + fr;
                const float rs = rsl[ai * 128 + wr * 64 + m * 16 + fr];
                if (u.pn < 12) {
#pragma unroll
                    for (int bj = 0; bj < 2; ++bj) {
                        const pg8::f32x4 v0 = acc[ai][bj][m][0] * rs, v1 = acc[ai][bj][m][1] * rs;
                        u32x4 w; w.x = pk2(v0[0], v0[1]); w.y = pk2(v0[2], v0[3]); w.z = pk2(v1[0], v1[1]); w.w = pk2(v1[2], v1[3]);
                        *(u32x4*)(Q + (size_t)row * QP + u.pn * 256 + bj * 128 + wc * 32 + 8 * fq) = w;
                    }
                } else if (wc == 0) {
                    *(f32x4*)(SM + (size_t)row * 32 + 8 * fq) = acc[ai][0][m][0] * rs;
                    *(f32x4*)(SM + (size_t)row * 32 + 8 * fq + 4) = acc[ai][0][m][1] * rs;
                }
            }
    }
};
template <bool from_x, bool last> struct EpiRes {
    static constexpr bool PERM = false, AFTER_DRAIN = false;
    int si;
    __device__ __forceinline__ void operator()(const pg8::f32x4 (&acc)[2][2][4][2], const pg8::Unit& u, int wr, int wc, int fr, int fq) const {
        asm volatile("" : "+v"(fr), "+v"(fq));
        KArgs ka = kargs(); unsigned char* wsb = gptr(ka->ws);
        float* out = last ? gptr(ka->out) : nullptr; const float* xin = from_x ? gptr(ka->x) : nullptr; bf16* HB = (bf16*)(wsb + WS_HB); float* ssq_next = (float*)ssq_arr(wsb, si);
        extern __shared__ __attribute__((aligned(16))) unsigned char lds_dyn_[];
        LAS float* red = (LAS float*)((LAS unsigned char*)lds_dyn_ + HALO_OFF);
#pragma unroll
        for (int ai = 0; ai < 2; ++ai)
#pragma unroll
            for (int m = 0; m < 4; ++m) {
                const int row = u.pm * 256 + ai * 128 + wr * 64 + m * 16 + fr;
                float ss = 0.f;
#pragma unroll
                for (int bj = 0; bj < 2; ++bj)
#pragma unroll
                    for (int n = 0; n < 2; ++n) {
                        const int col = u.pn * 256 + bj * 128 + wc * 32 + 16 * n + 4 * fq;
                        f32x4 bs;
                        if constexpr (from_x) bs = *(const f32x4*)(xin + (size_t)row * DM + col);
                        else { const u32x2 t = *(const u32x2*)(HB + (size_t)row * DM + col);
                               bs = (f32x4){__uint_as_float(t.x << 16), __uint_as_float(t.x & 0xffff0000u), __uint_as_float(t.y << 16), __uint_as_float(t.y & 0xffff0000u)}; }
                        const f32x4 h = bs + acc[ai][bj][m][n];
                        ss += (h[0] * h[0] + h[1] * h[1]) + (h[2] * h[2] + h[3] * h[3]);
                        u32x2 w; w.x = pk2(h[0], h[1]); w.y = pk2(h[2], h[3]);
                        *(u32x2*)(HB + (size_t)row * DM + col) = w;
                        if constexpr (last) *(f32x4*)(out + (size_t)row * DM + col) = h;
                    }
                ss += __shfl_xor(ss, 16); ss += __shfl_xor(ss, 32);
                if (fq == 0) red[wc * 256 + ai * 128 + wr * 64 + m * 16 + fr] = ss;
            }
        asm volatile("s_waitcnt lgkmcnt(0)" ::: "memory"); __builtin_amdgcn_s_barrier(); asm volatile("" ::: "memory");
        {
            const int tl = (wr * 4 + wc) * 64 + fq * 16 + fr;
            if (tl < 256) ssq_next[(size_t)(u.pm * 256 + tl) * 4 + u.pn] = (red[tl] + red[256 + tl]) + (red[512 + tl] + red[768 + tl]);
        }
    }
};
struct EpiUp {
    static constexpr bool PERM = true, AFTER_DRAIN = false;
    int L;
    __device__ __forceinline__ void operator()(pg8::f32x4 (&acc)[2][2][4][2], const pg8::Unit& u, int wr, int wc, int fr, int fq) const {
        asm volatile("" : "+v"(fr), "+v"(fq));
        KArgs ka = kargs(); unsigned char* wsb = gptr(ka->ws);
        const LAS float* rsl = tile_rstd(wsb, 2 * L + 1, u.pm, wr, wc, fr, fq); const float* cw = gptr(ka->conv_w) + (size_t)L * 3 * NUP; const float* cb = gptr(ka->conv_b) + (size_t)L * NUP;
        extern __shared__ __attribute__((aligned(16))) unsigned char lds_dyn_[];
        LAS float* halo = (LAS float*)((LAS unsigned char*)lds_dyn_ + HALO_OFF);
        const int colw = wc * 32 + 8 * fq;
#pragma unroll
        for (int ai = 0; ai < 2; ++ai)
#pragma unroll
            for (int m = 0; m < 4; ++m) {
                const int row = u.pm * 256 + ai * 128 + wr * 64 + m * 16 + fr;
                const float rs = rsl[ai * 128 + wr * 64 + m * 16 + fr]; (void)row;
#pragma unroll
                for (int bj = 0; bj < 2; ++bj)
#pragma unroll
                    for (int n = 0; n < 2; ++n) acc[ai][bj][m][n] *= rs;
            }
#ifdef SIMPLE_UP
        {
            const int ch0s = u.pn * 128 + colw;
#pragma unroll
            for (int n = 0; n < 2; ++n)
#pragma unroll
                for (int ai = 0; ai < 2; ++ai)
#pragma unroll
                    for (int m = 0; m < 4; ++m) {
                        const int row = u.pm * 256 + ai * 128 + wr * 64 + m * 16 + fr;
                        const f32x4 hu = acc[ai][0][m][n], hg = acc[ai][1][m][n];
                        u32x2 w; w.x = pk2(hu[0] + hg[0], hu[1] + hg[1]); w.y = pk2(hu[2] + hg[2], hu[3] + hg[3]);
                        *(u32x2*)(wsb + (unsigned)(WS_QKV + (unsigned)((row * DFF + ch0s + 4 * n) * 2))) = w;
                    }
            return;
        }
#endif
        if (fr >= 14) {
#pragma unroll
            for (int ai = 0; ai < 2; ++ai)
#pragma unroll
                for (int bj = 0; bj < 2; ++bj)
#pragma unroll
                    for (int n = 0; n < 2; ++n)
                        *(LAS f32x4*)(halo + (((2 * ai + wr) * 2 + (fr - 14)) * 256 + bj * 128 + colw + 4 * n)) = acc[ai][bj][3][n];
        }
        asm volatile("s_waitcnt lgkmcnt(0)" ::: "memory"); __builtin_amdgcn_s_barrier(); asm volatile("" ::: "memory");
        const int ch0 = u.pn * 128 + colw;
        u32x2 wout[2][4][2];
#pragma unroll
        for (int n = 0; n < 2; ++n) {
            f32x4 w0[2], w1[2], w2[2], bb[2];
#pragma unroll
            for (int bj = 0; bj < 2; ++bj) {
                const int c = bj * DFF + ch0 + 4 * n;
                w0[bj] = *(const f32x4*)((const char*)cw + (unsigned)(c * 4)); w1[bj] = *(const f32x4*)((const char*)cw + (unsigned)((NUP + c) * 4)); w2[bj] = *(const f32x4*)((const char*)cw + (unsigned)((2 * NUP + c) * 4)); bb[bj] = *(const f32x4*)((const char*)cb + (unsigned)(c * 4));
            }
#pragma unroll
            for (int ai = 0; ai < 2; ++ai)
#pragma unroll
                for (int m = 0; m < 4; ++m) {
                    const int g = 2 * ai + wr;
                    f32x4 hc[2];
#pragma unroll
                    for (int bj = 0; bj < 2; ++bj) {
                        const int c = bj * DFF + ch0 + 4 * n;
                        const f32x4 cur = acc[ai][bj][m][n];
                        f32x4 pb;
                        if (m > 0) pb = acc[ai][bj][m - 1][n];
                        else pb = *(const LAS f32x4*)(halo + ((((g > 0 ? g - 1 : 0) * 2) + (fr & 1)) * 256 + bj * 128 + colw + 4 * n));
                        f32x4 p1, p2;
#pragma unroll
                        for (int j = 0; j < 4; ++j) {
                            const float t1 = DPP_MOV(0.f, pb[j], 0x121);
                            p1[j] = DPP_MOV(t1, cur[j], 0x111);
                            const float t2 = DPP_MOV(0.f, pb[j], 0x122);
                            p2[j] = DPP_MOV(t2, cur[j], 0x112);
                        }
                        hc[bj] = bb[bj] + w0[bj] * p2 + w1[bj] * p1 + w2[bj] * cur;
                        if (g == 0 && m == 0 && fr < 2) *(f32x4*)(wsb + (unsigned)(WS_UT + (unsigned)(((u.pm * 2 + fr) * NUP + c) * 4))) = cur;
                        if (u.pm == 128 ? (g == 0 && m == 0 && fr >= 14) : (g == 3 && m == 3 && fr >= 14))
                            *(f32x4*)(wsb + (unsigned)(WS_UT + HFL_SIZE + (unsigned)(((u.pm * 2 + fr - 14) * NUP + c) * 4))) = cur;
                    }
                    wout[ai][m][n].x = pk2(siluf(hc[1][0]) * hc[0][0], siluf(hc[1][1]) * hc[0][1]);
                    wout[ai][m][n].y = pk2(siluf(hc[1][2]) * hc[0][2], siluf(hc[1][3]) * hc[0][3]);
                }
        }
#pragma unroll
        for (int ai = 0; ai < 2; ++ai)
#pragma unroll
            for (int m = 0; m < 4; ++m) {
                const int row = u.pm * 256 + ai * 128 + wr * 64 + m * 16 + fr;
                u32x4 w; w.x = wout[ai][m][0].x; w.y = wout[ai][m][0].y; w.z = wout[ai][m][1].x; w.w = wout[ai][m][1].y;
                *(u32x4*)(wsb + (unsigned)(WS_QKV + (unsigned)((row * DFF + ch0) * 2))) = w;
            }
    }
};
#define XB_TMO      128
#define XB_XCNT(j)  (256  + 64 * (j))
#define XB_XSUB(j)  (1280 + 64 * (j))
#define XB_XGEN(j)  (2304 + 64 * (j))
#define XB_TOP      3328
#define XB_TOPGEN   3392
#define XCD_BAR_WORDS 3456
#define XB_SPIN_CAP (1u << 18)

__device__ __forceinline__ unsigned xb_ld(unsigned* p)              { return __hip_atomic_load(p, __ATOMIC_RELAXED, __HIP_MEMORY_SCOPE_AGENT); }
__device__ __forceinline__ unsigned xb_add(unsigned* p, unsigned v) { return __hip_atomic_fetch_add(p, v, __ATOMIC_RELAXED, __HIP_MEMORY_SCOPE_AGENT); }
__device__ __forceinline__ unsigned xb_xcc_id() { return (unsigned)__builtin_amdgcn_s_getreg((3 << 11) | 20) & 0xFu; }
#define XB_SPIN(cond, bar) do { unsigned _sp = 0; while (cond) { __builtin_amdgcn_s_sleep(1); \
    if ((++_sp & 255u) == 0u) { if (xb_ld(&(bar)[XB_TMO])) break; if (_sp > XB_SPIN_CAP) { atomicAdd(&(bar)[XB_TMO], 1u); break; } } } } while (0)

struct XcdBarrier {
    unsigned* bar; unsigned x;
    volatile LAS unsigned* st;
};

__device__ __forceinline__ XcdBarrier xcd_barrier_post(unsigned* bar, volatile LAS unsigned* st) {
    XcdBarrier b; b.bar = bar; b.x = xb_xcc_id(); b.st = st;
    if (threadIdx.x == 0) (void)xb_add(&bar[XB_XCNT(b.x)], 1u);
    return b;
}
__device__ __forceinline__ void xcd_barrier_complete(unsigned* bar, unsigned x, unsigned& nloc, unsigned& nx) {
    const unsigned G = gridDim.x * gridDim.y * gridDim.z;
    unsigned sum, cnt, mine, sp = 0u;
    for (;;) {
        sum = 0u; cnt = 0u; mine = 0u;
#pragma unroll
        for (unsigned j = 0; j < 16; ++j) { const unsigned c = xb_ld(&bar[XB_XCNT(j)]); sum += c; cnt += (c > 0u) ? 1u : 0u; mine = (j == x) ? c : mine; }
        if (sum == G) break;
        __builtin_amdgcn_s_sleep(1);
        if ((++sp & 255u) == 0u) { if (xb_ld(&bar[XB_TMO])) break; if (sp > XB_SPIN_CAP) { atomicAdd(&bar[XB_TMO], 1u); break; } }
    }
    nloc = mine > 0u ? mine : 1u; nx = cnt > 0u ? cnt : 1u;
}

__device__ __forceinline__ void xcd_barrier(const XcdBarrier& b) {
    asm volatile("s_waitcnt vmcnt(0)" ::: "memory");
    __syncthreads();
    if (threadIdx.x == 0) {
        unsigned* bar = b.bar;
        __builtin_amdgcn_s_waitcnt(0);
        unsigned nloc = b.st[0], nx = b.st[1];
        if (nloc == 0u) { xcd_barrier_complete(bar, b.x, nloc, nx); b.st[0] = nloc; b.st[1] = nx; }
        const unsigned old = xb_add(&bar[XB_XSUB(b.x)], 1u);
        const unsigned gen = old / nloc;
        if (old + 1u == (gen + 1u) * nloc) {
            __builtin_amdgcn_fence(__ATOMIC_RELEASE, "agent");
            asm volatile("s_waitcnt vmcnt(0)" ::: "memory");
            const unsigned og = xb_add(&bar[XB_TOP], 1u);
            const unsigned tg = og / nx;
            if (og + 1u == (tg + 1u) * nx) xb_add(&bar[XB_TOPGEN], 1u);
            else XB_SPIN(xb_ld(&bar[XB_TOPGEN]) == tg, bar);
            __builtin_amdgcn_fence(__ATOMIC_ACQUIRE, "agent");
            xb_add(&bar[XB_XGEN(b.x)], 1u);
            asm volatile("s_waitcnt vmcnt(0)" ::: "memory");
        } else {
            XB_SPIN(xb_ld(&bar[XB_XGEN(b.x)]) == gen, bar);
            __builtin_amdgcn_fence(__ATOMIC_ACQUIRE, "agent");
            asm volatile("s_waitcnt vmcnt(0)" ::: "memory");
        }
    }
    __syncthreads();
}
__device__ __forceinline__ int win_src(int n) {
    if (n < 512) return 1552 + n;
    if (n < 1024) return 2064 + (n - 512);
    if (n < 1536) return 2576 + (n - 1024);
    if (n < 1792) return n - 1536;
    if (n < 2048) return 256 + (n - 1792);
    if (n < 2560) return 512 + (n - 2048);
    if (n < 3072) return 1024 + (n - 2560);
    if (n < 3088) return 1536 + (n - 3072);
    if (n < 3096) return n;
    return -1;
}
__device__ __forceinline__ void tr_item(const float* W, int Nsrc, bf16* WT, int K, const float* gk, int mode, LAS float* scr, int k0, int n0, int lane) {
    const int nl = lane & 31, n = n0 + nl;
    int src = n; float cs = 1.f;
    if (mode == 0) { src = win_src(n); cs = n < 512 ? C2 : ((n >= 1536 && n < 1792) ? 0.125f : 1.f); }
    else if (mode == 2) { const int pn = n >> 8, j = n & 255; src = j < 128 ? pn * 128 + j : DFF + pn * 128 + (j - 128); }
#pragma unroll
    for (int i = 0; i < 32; ++i) {
        const int kk = 2 * i + (lane >> 5);
        float v = 0.f;
        if (src >= 0) v = W[(size_t)(k0 + kk) * Nsrc + src] * cs;
        if (gk) v *= gk[k0 + kk];
        scr[kk * 33 + nl] = v;
    }
    LDS_WAIT(); asm volatile("" ::: "memory");
    const int c = lane & 7;
#pragma unroll
    for (int j = 0; j < 4; ++j) {
        const int nn = (lane >> 3) + 8 * j; const LAS float* s = scr + (8 * c) * 33 + nn;
        u32x4 o; o.x = pk2(s[0 * 33], s[1 * 33]); o.y = pk2(s[2 * 33], s[3 * 33]); o.z = pk2(s[4 * 33], s[5 * 33]); o.w = pk2(s[6 * 33], s[7 * 33]);
        *(u32x4*)(WT + (size_t)(n0 + nn) * K + k0 + 8 * c) = o;
    }
    LDS_WAIT(); asm volatile("" ::: "memory");
}
__device__ __forceinline__ void row_to_bf16(const float* xrow, bf16* orow, float* ssq_slot, float* copy_row, int lane) {
    const f32x4* xr = (const f32x4*)xrow + lane;
    f32x4 v[4]; float s = 0.f;
#pragma unroll
    for (int j = 0; j < 4; ++j) { v[j] = xr[64 * j]; s += (v[j][0] * v[j][0] + v[j][1] * v[j][1]) + (v[j][2] * v[j][2] + v[j][3] * v[j][3]); }
    s = wave_sum(s);
    if (lane == 0) *(f32x4*)ssq_slot = (f32x4){s, 0.f, 0.f, 0.f};
    u32x2* o8 = (u32x2*)orow + lane;
#pragma unroll
    for (int j = 0; j < 4; ++j) { u32x2 w; w.x = pk2(v[j][0], v[j][1]); w.y = pk2(v[j][2], v[j][3]); o8[64 * j] = w; }
    if (copy_row) {
#pragma unroll
        for (int j = 0; j < 4; ++j) ((f32x4*)copy_row + lane)[64 * j] = v[j];
    }
}

template <int NQ> __device__ __forceinline__ void gla_u_group(LAS unsigned char* lds, const bf16* QKV, const float* SM, const float* wau, const float* balpha, float* UT, float* DEC, int grp) {
    int tid_ = threadIdx.x; asm volatile("" : "+v"(tid_)); const int tid = tid_, lane = tid & 63, wid = __builtin_amdgcn_readfirstlane(tid >> 6), hi = lane >> 5, r32 = lane & 31;
    constexpr int SUB = 9216 + 17408 + 2048;
    const int dk = lane, sg = wid;
    int bhq[NQ], ccq[NQ], hq[NQ], row0q[NQ], tvq[NQ];
    float la[NQ][8], kf[NQ][8];
#pragma unroll
    for (int q = 0; q < NQ; ++q) {
        const int u = NQ * grp + q; bhq[q] = u / NCH; ccq[q] = u % NCH; hq[q] = bhq[q] & 3;
        row0q[q] = ccq[q] == 0 ? META0 : (bhq[q] >> 2) * SEQ + (ccq[q] - 1) * 64; tvq[q] = ccq[q] == 0 ? NMETA : 64;
        LAS unsigned char* VT = lds + q * SUB + 9216;
        LAS float* TOT = (LAS float*)(lds + q * SUB + 9216 + 17408);
#pragma unroll
        for (int i = 0; i < 2; ++i) {
            const int idx = tid + 512 * i, row = idx >> 4, ch = idx & 15;
            const u32x4 v = *(const u32x4*)(QKV + (size_t)(row0q[q] + row) * QP + C_GV + hq[q] * 128 + ch * 8);
            *(LAS u32x4*)(VT + row * 272 + ch * 16) = v;
        }
#pragma unroll
        for (int i = 0; i < 8; ++i) kf[q][i] = bf2f(QKV[(size_t)(row0q[q] + 8 * sg + i) * QP + C_GK + hq[q] * 64 + dk]);
        float w[16];
#pragma unroll
        for (int r = 0; r < 16; ++r) w[r] = wau[r * 256 + hq[q] * 64 + dk];
        const float bias = balpha[hq[q] * 64 + dk];
#pragma unroll
        for (int i = 0; i < 8; ++i) {
            const int s = 8 * sg + i;
            const f32x4* g4 = (const f32x4*)(SM + (size_t)(row0q[q] + s) * 32);
            float z = bias;
#pragma unroll
            for (int k = 0; k < 4; ++k) { const f32x4 gv = g4[k]; z += gv[0] * w[4 * k] + gv[1] * w[4 * k + 1] + gv[2] * w[4 * k + 2] + gv[3] * w[4 * k + 3]; }
            la[q][i] = (s < tvq[q]) ? logsigmoidf(z) * (1.0f / 16.0f) : 0.f;
        }
#pragma unroll
        for (int i = 1; i < 8; ++i) la[q][i] += la[q][i - 1];
        TOT[sg * 64 + dk] = la[q][7];
    }
    __syncthreads();
#pragma unroll
    for (int q = 0; q < NQ; ++q) {
        LAS unsigned char* KD = lds + q * SUB;
        const LAS float* TOT = (const LAS float*)(lds + q * SUB + 9216 + 17408);
        float pre = 0.f, tot = 0.f;
#pragma unroll
        for (int g2 = 0; g2 < 8; ++g2) { const float t = TOT[g2 * 64 + dk]; if (g2 < sg) pre += t; tot += t; }
        if (sg == 0) DEC[(size_t)(bhq[q] * NCH + ccq[q]) * 64 + dk] = __expf(tot);
#pragma unroll
        for (int i = 0; i < 8; ++i) {
            const int s = 8 * sg + i;
            const float kd = (s < tvq[q]) ? kf[q][i] * __expf(tot - (pre + la[q][i])) : 0.f;
            *(LAS bf16*)(KD + s * 144 + dk * 2) = f2bf(kd);
        }
    }
    __syncthreads();
    const int dvb = wid >> 1, dkb = wid & 1;
    const int qq = (lane & 15) >> 2, pp = lane & 3, half = (lane >> 4) & 1;
#pragma unroll
    for (int q = 0; q < NQ; ++q) {
        const LAS unsigned char* KD = lds + q * SUB; const LAS unsigned char* VT = lds + q * SUB + 9216;
        f32x16 acc = {};
#pragma unroll
        for (int j = 0; j < 4; ++j) {
            const LAS unsigned char* ap = VT + (16 * j + 4 * hi + qq) * 272 + (32 * dvb + 16 * half + 4 * pp) * 2;
            const LAS unsigned char* bp = KD + (16 * j + 4 * hi + qq) * 144 + (32 * dkb + 16 * half + 4 * pp) * 2;
            const bf16x8 af = cat8(vtr(ap), vtr(ap + 8 * 272));
            const bf16x8 bfr = cat8(vtr(bp), vtr(bp + 8 * 144));
            acc = __builtin_amdgcn_mfma_f32_32x32x16_bf16(af, bfr, acc, 0, 0, 0);
        }
        float* up = UT + ((size_t)(bhq[q] * NCH + ccq[q]) * 128 + 32 * dvb) * 64 + 32 * dkb + r32;
#pragma unroll
        for (int r = 0; r < 16; ++r) up[crow(r, hi) * 64] = acc[r];
    }
    __syncthreads();
}
__device__ __forceinline__ void fox_cumsum_unit(LAS unsigned char* lds, const float* SM, const float* bforget, float* CK, int bh) {
    int tid_ = threadIdx.x; asm volatile("" : "+v"(tid_)); const int tid = tid_, lane = tid & 63, wid = tid >> 6;
    const int b = bh >> 3, h = bh & 7;
    const float bf_ = bforget[h];
    LAS float* WT_ = (LAS float*)lds;
    float mtot = 0.f, mine = 0.f;
    for (int p = 0; p < NMETA; ++p) { mtot += logsigmoidf(SM[(size_t)(META0 + p) * 32 + 16 + h] + bf_); if (tid == p) mine = mtot; }
    if (tid < 64) CK[(size_t)bh * CKP + tid] = tid < NMETA ? -LOG2E * mine : -INFINITY;
    float v[8]; float run = 0.f;
#pragma unroll
    for (int i = 0; i < 8; ++i) { run += logsigmoidf(SM[(size_t)(b * SEQ + 8 * tid + i) * 32 + 16 + h] + bf_); v[i] = run; }
    float inc = run;
#pragma unroll
    for (int o = 1; o < 64; o <<= 1) { const float t = __shfl_up(inc, o); if (lane >= o) inc += t; }
    if (lane == 63) WT_[wid] = inc;
    __syncthreads();
    float off = mtot + (inc - run);
    for (int w2 = 0; w2 < wid; ++w2) off += WT_[w2];
#pragma unroll
    for (int i = 0; i < 8; ++i) CK[(size_t)bh * CKP + 64 + 8 * tid + i] = -LOG2E * (off + v[i]);
    __syncthreads();
}

__device__ __forceinline__ void attn_unit(LAS unsigned char* lds, const bf16* QKV, const float* CK, bf16* OB, const float* fnorm, int b, int h, int qb) {
    int tid_ = threadIdx.x; asm volatile("" : "+v"(tid_)); const int tid = tid_, lane = tid & 63, wid = __builtin_amdgcn_readfirstlane(tid >> 6), r32 = lane & 31, hi = lane >> 5;
    constexpr int KB = 9216, KOFF = 0, VOFF = 2 * KB, COFF = 4 * KB, WOFF = COFF + 512;
    LAS float* wsf = (LAS float*)(lds + WOFF) + wid * 64;
    const size_t rowb = (size_t)b * SEQ; const int q0 = qb * 512;
    const int NT = 1 + 8 * (qb + 1);
    bf16x8 qr[2][4];
#pragma unroll
    for (int g = 0; g < 2; ++g) {
        const bf16* qp = QKV + (rowb + q0 + wid * 64 + g * 32 + r32) * QP + C_FQ + h * 64 + hi * 8;
#pragma unroll
        for (int d0 = 0; d0 < 4; ++d0) qr[g][d0] = *(const bf16x8*)(qp + d0 * 16);
    }
    const int srow = tid >> 3, sch = tid & 7;
    const float* ckp = CK + (size_t)(b * 8 + h) * CKP;
    u32x4 kreg, vreg; float creg = 0.f;
#define ATT_LOAD(t) do { const size_t r0_ = (t) == 0 ? (size_t)META0 : rowb + (size_t)((t) - 1) * 64; const bf16* p_ = QKV + (r0_ + srow) * QP + h * 64 + sch * 8; \
        kreg = *(const u32x4*)(p_ + C_FK); vreg = *(const u32x4*)(p_ + C_FV); if (tid < 64) creg = ckp[(t) * 64 + tid]; } while (0)
#define ATT_STORE(buf) do { *(LAS u32x4*)(lds + KOFF + (buf) * KB + srow * 144 + sch * 16) = kreg; *(LAS u32x4*)(lds + VOFF + (buf) * KB + srow * 144 + sch * 16) = vreg; \
        if (tid < 64) *(LAS float*)(lds + COFF + (buf) * 256 + tid * 4) = creg; } while (0)
    float m[2] = {-1e30f, -1e30f}, l[2] = {0.f, 0.f}; f32x16 o0[2], o1[2];
    o0[0] = (f32x16){}; o0[1] = (f32x16){}; o1[0] = (f32x16){}; o1[1] = (f32x16){};
    const int qq = (lane & 15) >> 2, pp = lane & 3, half = (lane >> 4) & 1;
    ATT_LOAD(0); ATT_STORE(0);
    for (int t = 0; t < NT; ++t) {
        const int buf = t & 1;
        if (t + 1 < NT) ATT_LOAD(t + 1);
        __syncthreads();
        const int jb = t - (NT - 8);
        const bool skip = (jb >= 0) && (jb > wid);
        if (!skip) {
            const LAS unsigned char* Kb = lds + KOFF + buf * KB; const LAS unsigned char* Vb = lds + VOFF + buf * KB; const LAS float* Cb = (const LAS float*)(lds + COFF + buf * 256);
            f32x16 p0[2], p1[2], c0v, c1v;
#pragma unroll
            for (int g4 = 0; g4 < 4; ++g4) {
                const f32x4 c0 = *(const LAS f32x4*)(Cb + 8 * g4 + 4 * hi), c1 = *(const LAS f32x4*)(Cb + 32 + 8 * g4 + 4 * hi);
#pragma unroll
                for (int i = 0; i < 4; ++i) { c0v[4 * g4 + i] = c0[i]; c1v[4 * g4 + i] = c1[i]; }
            }
#pragma unroll
            for (int d0 = 0; d0 < 4; ++d0) {
                const bf16x8 a0 = *(const LAS bf16x8*)(Kb + r32 * 144 + (16 * d0 + 8 * hi) * 2);
                const bf16x8 a1 = *(const LAS bf16x8*)(Kb + (32 + r32) * 144 + (16 * d0 + 8 * hi) * 2);
                p0[0] = __builtin_amdgcn_mfma_f32_32x32x16_bf16(a0, qr[0][d0], d0 == 0 ? c0v : p0[0], 0, 0, 0);
                p0[1] = __builtin_amdgcn_mfma_f32_32x32x16_bf16(a0, qr[1][d0], d0 == 0 ? c0v : p0[1], 0, 0, 0);
                p1[0] = __builtin_amdgcn_mfma_f32_32x32x16_bf16(a1, qr[0][d0], d0 == 0 ? c1v : p1[0], 0, 0, 0);
                p1[1] = __builtin_amdgcn_mfma_f32_32x32x16_bf16(a1, qr[1][d0], d0 == 0 ? c1v : p1[1], 0, 0, 0);
            }
            bf16x8 pa[2][4];
#pragma unroll
            for (int g = 0; g < 2; ++g) {
                if (jb == wid) {
                    const int qrel = 32 * g + r32;
#pragma unroll
                    for (int r = 0; r < 16; ++r) { const int kv = crow(r, hi); if (kv > qrel) p0[g][r] = -INFINITY; if (kv + 32 > qrel) p1[g][r] = -INFINITY; }
                }
                float mxa = fmaxf(p0[g][0], p1[g][0]), mxb = fmaxf(p0[g][1], p1[g][1]);
#pragma unroll
                for (int r = 2; r < 16; r += 2) { mxa = fmaxf(fmaxf(mxa, p0[g][r]), p1[g][r]); mxb = fmaxf(fmaxf(mxb, p0[g][r + 1]), p1[g][r + 1]); }
                float mx = fmaxf(mxa, mxb);
                mx = fmaxf(mx, __shfl_xor(mx, 32));
                if (__any(mx > m[g] + 8.0f)) {
                    const float mn = fmaxf(m[g], mx);
                    const float alpha = __builtin_amdgcn_exp2f(m[g] - mn);
                    m[g] = mn; l[g] *= alpha;
                    if (hi == 0) wsf[g * 32 + r32] = alpha;
                    LDS_WAIT();
#pragma unroll
                    for (int g4 = 0; g4 < 4; ++g4) {
                        const f32x4 a = *(const LAS f32x4*)(wsf + g * 32 + 8 * g4 + 4 * hi);
#pragma unroll
                        for (int i = 0; i < 4; ++i) { o0[g][4 * g4 + i] *= a[i]; o1[g][4 * g4 + i] *= a[i]; }
                    }
                }
                float rsa = 0.f, rsb = 0.f, rsc = 0.f, rsd = 0.f;
#pragma unroll
                for (int r = 0; r < 16; r += 2) {
                    p0[g][r] = __builtin_amdgcn_exp2f(p0[g][r] - m[g]); p1[g][r] = __builtin_amdgcn_exp2f(p1[g][r] - m[g]);
                    p0[g][r + 1] = __builtin_amdgcn_exp2f(p0[g][r + 1] - m[g]); p1[g][r + 1] = __builtin_amdgcn_exp2f(p1[g][r + 1] - m[g]);
                    rsa += p0[g][r]; rsb += p1[g][r]; rsc += p0[g][r + 1]; rsd += p1[g][r + 1];
                }
                l[g] += (rsa + rsb) + (rsc + rsd);
                { u32x4 w;
                  w.x = pk2(p0[g][0], p0[g][1]); w.y = pk2(p0[g][2], p0[g][3]); w.z = pk2(p0[g][4], p0[g][5]); w.w = pk2(p0[g][6], p0[g][7]); pa[g][0] = __builtin_bit_cast(bf16x8, w);
                  w.x = pk2(p0[g][8], p0[g][9]); w.y = pk2(p0[g][10], p0[g][11]); w.z = pk2(p0[g][12], p0[g][13]); w.w = pk2(p0[g][14], p0[g][15]); pa[g][1] = __builtin_bit_cast(bf16x8, w);
                  w.x = pk2(p1[g][0], p1[g][1]); w.y = pk2(p1[g][2], p1[g][3]); w.z = pk2(p1[g][4], p1[g][5]); w.w = pk2(p1[g][6], p1[g][7]); pa[g][2] = __builtin_bit_cast(bf16x8, w);
                  w.x = pk2(p1[g][8], p1[g][9]); w.y = pk2(p1[g][10], p1[g][11]); w.z = pk2(p1[g][12], p1[g][13]); w.w = pk2(p1[g][14], p1[g][15]); pa[g][3] = __builtin_bit_cast(bf16x8, w); }
            }
#pragma unroll
            for (int j = 0; j < 4; ++j) {
                const LAS unsigned char* vp = Vb + (16 * j + 4 * hi + qq) * 144 + (16 * half + 4 * pp) * 2;
                const bf16x8 v0 = cat8(vtr(vp), vtr(vp + 8 * 144));
                const bf16x8 v1 = cat8(vtr(vp + 64), vtr(vp + 64 + 8 * 144));
                o0[0] = __builtin_amdgcn_mfma_f32_32x32x16_bf16(pa[0][j], v0, o0[0], 0, 0, 0);
                o0[1] = __builtin_amdgcn_mfma_f32_32x32x16_bf16(pa[1][j], v0, o0[1], 0, 0, 0);
                o1[0] = __builtin_amdgcn_mfma_f32_32x32x16_bf16(pa[0][j], v1, o1[0], 0, 0, 0);
                o1[1] = __builtin_amdgcn_mfma_f32_32x32x16_bf16(pa[1][j], v1, o1[1], 0, 0, 0);
            }
        }
        if (t + 1 < NT) ATT_STORE(buf ^ 1);
    }
#undef ATT_LOAD
#undef ATT_STORE
    const float w0 = fnorm[h * 64 + r32], w1 = fnorm[h * 64 + 32 + r32];
#pragma unroll
    for (int g = 0; g < 2; ++g) {
        float lt = l[g]; lt += __shfl_xor(lt, 32);
        if (hi == 0) wsf[g * 32 + r32] = 1.0f / lt;
        LDS_WAIT();
#pragma unroll
        for (int g4 = 0; g4 < 4; ++g4) {
            const f32x4 a = *(const LAS f32x4*)(wsf + g * 32 + 8 * g4 + 4 * hi);
#pragma unroll
            for (int i = 0; i < 4; ++i) { o0[g][4 * g4 + i] *= a[i]; o1[g][4 * g4 + i] *= a[i]; }
        }
#pragma unroll
        for (int r = 0; r < 16; ++r) {
            float s = o0[g][r] * o0[g][r] + o1[g][r] * o1[g][r];
            s += __shfl_xor(s, 1); s += __shfl_xor(s, 2); s += __shfl_xor(s, 4); s += __shfl_xor(s, 8); s += __shfl_xor(s, 16);
            const float rs = rsqrtf(s * (1.0f / 64.0f) + EPS);
            bf16* op = OB + (rowb + q0 + wid * 64 + g * 32 + crow(r, hi)) * DM + 512 + h * 64 + r32;
            op[0] = f2bf(o0[g][r] * rs * w0); op[32] = f2bf(o1[g][r] * rs * w1);
        }
    }
    __syncthreads();
}
__device__ __forceinline__ void meta_attn(const bf16* QKV, const float* CK, bf16* OB, const float* fnorm, int p) {
    int tid_ = threadIdx.x; asm volatile("" : "+v"(tid_)); const int lane = tid_ & 63, h = tid_ >> 6;
    const float q = bf2f(QKV[(size_t)(META0 + p) * QP + C_FQ + h * 64 + lane]);
    float sc[NMETA], vv[NMETA];
#pragma unroll
    for (int s = 0; s < NMETA; ++s) {
        sc[s] = q * bf2f(QKV[(size_t)(META0 + s) * QP + C_FK + h * 64 + lane]);
        vv[s] = bf2f(QKV[(size_t)(META0 + s) * QP + C_FV + h * 64 + lane]);
    }
    float m = -1e30f;
#pragma unroll
    for (int s = 0; s < NMETA; ++s) { sc[s] = (s <= p) ? wave_sum(sc[s]) + CK[(size_t)h * CKP + s] : -INFINITY; m = fmaxf(m, sc[s]); }
    float l = 0.f, o = 0.f;
#pragma unroll
    for (int s = 0; s < NMETA; ++s) { const float pw = __builtin_amdgcn_exp2f(sc[s] - m); l += pw; o += pw * vv[s]; }
    o /= l;
    const float ss = wave_sum(o * o);
    OB[(size_t)(META0 + p) * DM + 512 + h * 64 + lane] = f2bf(o * rsqrtf(ss * (1.0f / 64.0f) + EPS) * fnorm[h * 64 + lane]);
}
template <int NU> __device__ __forceinline__ void gla_readout_wave(const bf16* QKV, const float* UT, bf16* OB, const float* gnorm, const int* bhs, const int* ccs, const int* halfs, int lane) {
    asm volatile("" : "+v"(lane));
    const int r32 = lane & 31, hi = lane >> 5;
    int row0[NU], nvalid[NU], hq[NU]; const float* Sp[NU];
    f32x16 acc[NU][4];
#pragma unroll
    for (int u = 0; u < NU; ++u) {
        const int b = bhs[u] >> 2; hq[u] = bhs[u] & 3;
        row0[u] = ccs[u] == 0 ? META0 : b * SEQ + (ccs[u] - 1) * 64 + 32 * halfs[u]; nvalid[u] = ccs[u] == 0 ? NMETA : 32;
        Sp[u] = UT + (size_t)(bhs[u] * NCH + ccs[u]) * 8192;
#pragma unroll
        for (int blk = 0; blk < 4; ++blk) acc[u][blk] = (f32x16){};
    }
#pragma unroll
    for (int j = 0; j < 4; ++j)
#pragma unroll
        for (int u = 0; u < NU; ++u) {
            const bf16x8 bq = *(const bf16x8*)(QKV + (size_t)(row0[u] + r32) * QP + C_GQ + hq[u] * 64 + 16 * j + 8 * hi);
#pragma unroll
            for (int blk = 0; blk < 4; ++blk) {
                const float* sp = Sp[u] + (32 * blk + r32) * 64 + 16 * j + 8 * hi;
                const f32x4 s0 = *(const f32x4*)sp, s1 = *(const f32x4*)(sp + 4);
                u32x4 w; w.x = pk2(s0[0], s0[1]); w.y = pk2(s0[2], s0[3]); w.z = pk2(s1[0], s1[1]); w.w = pk2(s1[2], s1[3]);
                acc[u][blk] = __builtin_amdgcn_mfma_f32_32x32x16_bf16(__builtin_bit_cast(bf16x8, w), bq, acc[u][blk], 0, 0, 0);
            }
        }
#pragma unroll
    for (int u = 0; u < NU; ++u) {
        float ss = 0.f;
#pragma unroll
        for (int blk = 0; blk < 4; ++blk)
#pragma unroll
            for (int r = 0; r < 16; ++r) ss += acc[u][blk][r] * acc[u][blk][r];
        ss += __shfl_xor(ss, 32);
        const float rs = rsqrtf(ss * (1.0f / 128.0f) + EPS);
        if (r32 < nvalid[u]) {
            const size_t row = (size_t)row0[u] + r32; const int h = hq[u];
#pragma unroll
            for (int blk = 0; blk < 4; ++blk)
#pragma unroll
                for (int g = 0; g < 4; ++g) {
                    const int dv = 32 * blk + 8 * g + 4 * hi;
                    const u32x2 gt = *(const u32x2*)(QKV + row * QP + C_GR + h * 128 + dv);
                    const f32x4 wn = *(const f32x4*)(gnorm + h * 128 + dv);
                    const float g0 = __uint_as_float(gt.x << 16), g1 = __uint_as_float(gt.x & 0xffff0000u), g2 = __uint_as_float(gt.y << 16), g3 = __uint_as_float(gt.y & 0xffff0000u);
                    u32x2 w;
                    w.x = pk2(acc[u][blk][4 * g] * rs * wn[0] * siluf(g0), acc[u][blk][4 * g + 1] * rs * wn[1] * siluf(g1));
                    w.y = pk2(acc[u][blk][4 * g + 2] * rs * wn[2] * siluf(g2), acc[u][blk][4 * g + 3] * rs * wn[3] * siluf(g3));
                    *(u32x2*)(OB + row * DM + h * 128 + dv) = w;
                }
        }
    }
}

__device__ __forceinline__ void gla_readout_chunk(const bf16* QKV, const float* UT, bf16* OB, const float* gnorm, int bh, int cc, int lane) {
    asm volatile("" : "+v"(lane));
    const int r32 = lane & 31, hi = lane >> 5, b = bh >> 2, h = bh & 3;
    const int row0 = b * SEQ + (cc - 1) * 64;
    const float* Sp = UT + (size_t)(bh * NCH + cc) * 8192;
    f32x16 acc[2][4];
#pragma unroll
    for (int u = 0; u < 2; ++u)
#pragma unroll
        for (int blk = 0; blk < 4; ++blk) acc[u][blk] = (f32x16){};
#pragma unroll 1
    for (int j = 0; j < 4; ++j) {
        const bf16x8 bq0 = *(const bf16x8*)(QKV + (size_t)(row0 + r32) * QP + C_GQ + h * 64 + 16 * j + 8 * hi);
        const bf16x8 bq1 = *(const bf16x8*)(QKV + (size_t)(row0 + 32 + r32) * QP + C_GQ + h * 64 + 16 * j + 8 * hi);
#pragma unroll
        for (int blk = 0; blk < 4; ++blk) {
            const float* sp = Sp + (32 * blk + r32) * 64 + 16 * j + 8 * hi;
            const f32x4 s0 = *(const f32x4*)sp, s1 = *(const f32x4*)(sp + 4);
            u32x4 w; w.x = pk2(s0[0], s0[1]); w.y = pk2(s0[2], s0[3]); w.z = pk2(s1[0], s1[1]); w.w = pk2(s1[2], s1[3]);
            const bf16x8 sa = __builtin_bit_cast(bf16x8, w);
            acc[0][blk] = __builtin_amdgcn_mfma_f32_32x32x16_bf16(sa, bq0, acc[0][blk], 0, 0, 0);
            acc[1][blk] = __builtin_amdgcn_mfma_f32_32x32x16_bf16(sa, bq1, acc[1][blk], 0, 0, 0);
        }
    }
#pragma unroll
    for (int u = 0; u < 2; ++u) {
        float ss = 0.f;
#pragma unroll
        for (int blk = 0; blk < 4; ++blk)
#pragma unroll
            for (int r = 0; r < 16; ++r) ss += acc[u][blk][r] * acc[u][blk][r];
        ss += __shfl_xor(ss, 32);
        const float rs = rsqrtf(ss * (1.0f / 128.0f) + EPS);
        const size_t row = (size_t)row0 + 32 * u + r32;
#pragma unroll
        for (int blk = 0; blk < 4; ++blk)
#pragma unroll
            for (int g = 0; g < 4; ++g) {
                const int dv = 32 * blk + 8 * g + 4 * hi;
                const u32x2 gt = *(const u32x2*)(QKV + row * QP + C_GR + h * 128 + dv);
                const f32x4 wn = *(const f32x4*)(gnorm + h * 128 + dv);
                const float g0 = __uint_as_float(gt.x << 16), g1 = __uint_as_float(gt.x & 0xffff0000u), g2 = __uint_as_float(gt.y << 16), g3 = __uint_as_float(gt.y & 0xffff0000u);
                u32x2 w;
                w.x = pk2(acc[u][blk][4 * g] * rs * wn[0] * siluf(g0), acc[u][blk][4 * g + 1] * rs * wn[1] * siluf(g1));
                w.y = pk2(acc[u][blk][4 * g + 2] * rs * wn[2] * siluf(g2), acc[u][blk][4 * g + 3] * rs * wn[3] * siluf(g3));
                *(u32x2*)(OB + row * DM + h * 128 + dv) = w;
            }
    }
}

#define FRESH() KArgs ka_ = kargs(); Args a; a.x = gptr(ka_->x); a.meta = gptr(ka_->meta); a.attn_norm = gptr(ka_->attn_norm); a.w_in = gptr(ka_->w_in); a.w_au = gptr(ka_->w_au); a.b_alpha = gptr(ka_->b_alpha); a.b_forget = gptr(ka_->b_forget); a.gla_norm = gptr(ka_->gla_norm); a.fox_norm = gptr(ka_->fox_norm); a.w_out = gptr(ka_->w_out); a.ffn_norm = gptr(ka_->ffn_norm); a.w_up = gptr(ka_->w_up); a.conv_w = gptr(ka_->conv_w); a.conv_b = gptr(ka_->conv_b); a.w_down = gptr(ka_->w_down); a.final_norm = gptr(ka_->final_norm); a.out = gptr(ka_->out); a.ws = gptr(ka_->ws); unsigned char* ws = a.ws; \
    bf16* HB = (bf16*)(ws + WS_HB); bf16* OB = (bf16*)(ws + WS_OB); bf16* QKV = (bf16*)(ws + WS_QKV); bf16* A2 = (bf16*)(ws + WS_QKV); \
    float* UT = (float*)(ws + WS_UT); float* HF = (float*)(ws + WS_UT); float* HL = (float*)(ws + WS_UT + HFL_SIZE); \
    float* SM = (float*)(ws + WS_SM); float* CK = (float*)(ws + WS_CK); float* DEC = (float*)(ws + WS_DEC); float* HM = (float*)(ws + WS_HM); float* SSQ = (float*)(ws + WS_SSQ); \
    unsigned char* wl = ws + WS_W + (size_t)L * WL_SIZE; \
    (void)HB; (void)OB; (void)QKV; (void)A2; (void)UT; (void)HF; (void)HL; (void)SM; (void)CK; (void)DEC; (void)HM; (void)SSQ; (void)wl; \
    int G_ = gridDim.x, bx_ = blockIdx.x; asm volatile("" : "+s"(G_), "+s"(bx_)); const int G = G_, bx = bx_; (void)G; (void)bx; \
    int tid_ = threadIdx.x; asm volatile("" : "+v"(tid_)); const int tid = tid_, lane = tid & 63, wid = __builtin_amdgcn_readfirstlane(tid >> 6); \
    const int gw = bx * 8 + wid, NGW = G * 8, gt = bx * 512 + tid, NGT = G * 512; (void)lane; (void)gw; (void)NGW; (void)gt; (void)NGT;
#ifndef REP_A
#define REP_A 1
#endif
#ifndef REP_CA
#define REP_CA 1
#endif
#ifndef REP_F
#define REP_F 1
#endif
#ifndef REP_B
#define REP_B 1
#endif
#ifndef REP_D
#define REP_D 1
#endif
#define GSYNC_CG() do { asm volatile("s_waitcnt vmcnt(0) lgkmcnt(0)" ::: "memory"); grid.sync(); __builtin_amdgcn_fence(__ATOMIC_ACQUIRE, "agent"); asm volatile("s_waitcnt vmcnt(0)" ::: "memory"); } while (0)
#ifdef PROBE_PH
#define PH_END(id) do { const unsigned long long tn_ = __builtin_amdgcn_s_memrealtime(); if ((PROBE_PH >> (id)) & 1) tsync += tn_ - tlast; tlast = tn_; } while (0)
#else
#define PH_END(id) do {} while (0)
#endif
#ifdef PROBE_SYNC
#define GSYNC() do { const unsigned long long t0_ = __builtin_amdgcn_s_memrealtime(); xcd_barrier(xbar); tsync += __builtin_amdgcn_s_memrealtime() - t0_; } while (0)
#else
#define GSYNC() do { XcdBarrier xb_; xb_.bar = (unsigned*)(gptr(kargs()->ws) + WS_BAR); xb_.x = xb_xcc_id(); xb_.st = (volatile LAS unsigned*)(lds + HALO_OFF + 8192 + 1024); xcd_barrier(xb_); } while (0)
#endif
__global__ void __launch_bounds__(512, 2) fwd_kernel(Args a_unused) {
    extern __shared__ __attribute__((aligned(16))) unsigned char lds_raw[];
    LAS unsigned char* lds = (LAS unsigned char*)lds_raw;
    cg::grid_group grid = cg::this_grid();
#if defined(PROBE_SYNC) || defined(PROBE_PH)
    unsigned long long tsync = 0ull, tlast = __builtin_amdgcn_s_memrealtime(); (void)tlast;
#endif
    volatile LAS unsigned* xst = (volatile LAS unsigned*)(lds + HALO_OFF + 8192 + 1024);
    if (threadIdx.x < 2) xst[threadIdx.x] = 0u;
    __syncthreads();
    (void)xcd_barrier_post((unsigned*)(gptr(kargs()->ws) + WS_BAR), xst);
#ifndef REP_P
#define REP_P 1
#endif
    for (int rep = 0; rep < REP_P; ++rep) {
        const int L = 0; FRESH();
        LAS float* scr = (LAS float*)(lds + wid * 16384);
        constexpr int I_IN = 16 * (NINP / 32), I_OUT = 16 * 32, I_UP = 16 * (NUP / 32), I_DN = (DFF / 64) * 32, I_L = I_IN + I_OUT + I_UP + I_DN;
        for (int it = gw; it < DEPTH * I_L; it += NGW) {
            const int L = it / I_L; int r = it % I_L;
            unsigned char* wl = ws + WS_W + (size_t)L * WL_SIZE;
            if (r < I_IN) { const int nb = NINP / 32; tr_item(a.w_in + (size_t)L * DM * 3096, 3096, (bf16*)(wl + WL_IN), DM, a.attn_norm + L * DM, 0, scr, 64 * (r / nb), 32 * (r % nb), lane); continue; } r -= I_IN;
            if (r < I_OUT) { tr_item(a.w_out + (size_t)L * DM * DM, DM, (bf16*)(wl + WL_OUT), DM, nullptr, 1, scr, 64 * (r / 32), 32 * (r % 32), lane); continue; } r -= I_OUT;
            if (r < I_UP) { const int nb = NUP / 32; tr_item(a.w_up + (size_t)L * DM * NUP, NUP, (bf16*)(wl + WL_UP), DM, a.ffn_norm + L * DM, 2, scr, 64 * (r / nb), 32 * (r % nb), lane); continue; } r -= I_UP;
            tr_item(a.w_down + (size_t)L * DFF * DM, DM, (bf16*)(wl + WL_DN), DFF, nullptr, 3, scr, 64 * (r / 32), 32 * (r % 32), lane);
        }
        for (int i = gt; i < (256 - NMETA) * 4; i += NGT) SSQ[(size_t)(META0 + NMETA) * 4 + i] = 0.f;
        for (int r = gw; r < MREAL + 256; r += NGW) {
            if (r < MREAL) row_to_bf16(a.x + (size_t)r * DM, HB + (size_t)r * DM, SSQ + (size_t)r * 4, nullptr, lane);
            else if (r < MREAL + NMETA) row_to_bf16(a.meta + (size_t)(r - MREAL) * DM, HB + (size_t)r * DM, SSQ + (size_t)r * 4, HM + (size_t)(r - MREAL) * DM, lane);
            else {
#pragma unroll
                for (int j = 0; j < 4; ++j) { ((f32x4*)(HM + (size_t)(r - MREAL) * DM) + lane)[64 * j] = (f32x4){0.f, 0.f, 0.f, 0.f};
                    ((u32x2*)(HB + (size_t)r * DM) + lane)[64 * j] = (u32x2){0u, 0u}; ((u32x2*)(OB + (size_t)r * DM) + lane)[64 * j] = (u32x2){0u, 0u}; }
            }
        }
    }
    GSYNC_CG(); PH_END(0);

    for (int L = 0; L < DEPTH; ++L) {
#ifndef SKIP_A
        {
            FRESH();
            pg8::Gemm g{HB, (const bf16*)(wl + WL_IN), MROWS, NINP, DM}; pg8::StaticOrder S; S.init(MROWS, NINP, G, bx);
            EpiIn E{2 * L};
            for (int rep = 0; rep < REP_A; ++rep) pg8::gemm_phase<EpiIn, pg8::StaticOrder, true, true>(lds, g, S, E);
        }
#endif
        GSYNC(); PH_END(1);
#ifndef SKIP_B
        { FRESH();
        for (int rep = 0; rep < REP_B; ++rep) {
        for (int gr = bx; gr < 16 * NCH; gr += G) gla_u_group<2>(lds, QKV, SM, a.w_au + (size_t)L * 16 * 256, a.b_alpha + L * 256, UT, DEC, gr);
        for (int u = (G == 256) ? bx - 64 + ((bx < 64) ? 256 : 0) : bx; u < 64; u += G) fox_cumsum_unit(lds, SM, a.b_forget + L * 8, CK, u);
        }
        }
#endif
        GSYNC(); PH_END(2);
#ifndef SKIP_CS
        { FRESH();
        for (int e = gt; e < 32 * 2048; e += NGT) {
            const int bh = e >> 11, rem = (e & 2047) * 4, dk = rem & 63;
            float* up = UT + (size_t)bh * NCH * 8192 + rem; const float* dp = DEC + (size_t)bh * NCH * 64 + dk;
            f32x4 Sv = *(const f32x4*)up;
            for (int c0 = 1; c0 <= 64; c0 += 8) {
                f32x4 uu[8], dd[8];
#pragma unroll
                for (int i = 0; i < 8; ++i) { uu[i] = *(const f32x4*)(up + (size_t)(c0 + i) * 8192); dd[i] = *(const f32x4*)(dp + (c0 + i) * 64); }
#pragma unroll
                for (int i = 0; i < 8; ++i) { Sv = dd[i] * Sv + uu[i]; *(f32x4*)(up + (size_t)(c0 + i) * 8192) = Sv; }
            }
        }
#ifdef REP_SCAN
        for (int e = gt; e < 32 * 2048; e += NGT) {
            const int bh = e >> 11, rem = (e & 2047) * 4, dk = rem & 63;
            float* up = UT + (size_t)bh * NCH * 8192 + rem; const float* dp = DEC + (size_t)bh * NCH * 64 + dk;
            for (int c0 = 1; c0 <= 64; c0 += 8) {
                f32x4 uu[8], dd[8];
#pragma unroll
                for (int i = 0; i < 8; ++i) { uu[i] = *(const f32x4*)(up + (size_t)(c0 + i) * 8192); dd[i] = *(const f32x4*)(dp + (c0 + i) * 64); }
#pragma unroll
                for (int i = 0; i < 8; ++i) { *(f32x4*)(up + (size_t)(c0 + i) * 8192) = uu[i] + dd[i] * 0.f; }
            }
        }
#endif
        }
        { FRESH();
        for (int rep = 0; rep < REP_CA; ++rep)
        for (int v0 = bx; v0 < 256; v0 += G) {
            const int v = (G == 256) ? (v0 & 7) * 32 + (v0 >> 3) : v0;
            const int bhh = v >> 2, s = v & 3;
#pragma unroll 1
            for (int i = 0; i < 2; ++i) {
                const int qb = (i == 0) ? s : 7 - s;
                attn_unit(lds, QKV, CK, OB, a.fox_norm + L * 512, bhh >> 3, bhh & 7, qb);
            }
        }
#endif
#ifndef SKIP_CM
        }
        { FRESH();
#ifndef REP_CM
#define REP_CM 1
#endif
        for (int rep = 0; rep < REP_CM; ++rep)
        if (bx < NMETA) meta_attn(QKV, CK, OB, a.fox_norm + L * 512, bx);
        if (bx >= NMETA && bx < NMETA + 4 && wid == 0) { const int bhs[1] = {bx - NMETA}, ccs[1] = {0}, hfs[1] = {0}; gla_readout_wave<1>(QKV, UT, OB, a.gla_norm + L * 512, bhs, ccs, hfs, lane); }
        }
#endif
        GSYNC(); PH_END(3);
#ifndef SKIP_D
        { FRESH();
        for (int rep = 0; rep < REP_D; ++rep)
        for (int wu = gw; wu < 32 * 64; wu += NGW) gla_readout_chunk(QKV, UT, OB, a.gla_norm + L * 512, wu >> 6, 1 + (wu & 63), lane);
        }
#endif
        GSYNC(); PH_END(4);
#ifndef SKIP_E
        {
            FRESH();
            meta_rowgemm(OB + (size_t)META0 * DM, DM, (const bf16*)(wl + WL_OUT), DM, HM, HB, G, bx);
            pg8::Gemm g{OB, (const bf16*)(wl + WL_OUT), MREAL, DM, DM}; pg8::StaticOrder S; S.init(MREAL, DM, G, bx);
            if (L == 0) { EpiRes<true, false> E{2 * L + 1}; pg8::gemm_phase<EpiRes<true, false>, pg8::StaticOrder, true, true>(lds, g, S, E); }
            else { EpiRes<false, false> E{2 * L + 1}; pg8::gemm_phase<EpiRes<false, false>, pg8::StaticOrder, true, true>(lds, g, S, E); }
        }
#endif
        GSYNC(); PH_END(5);
#ifndef SKIP_F
        {
            FRESH();
            meta_up(lds, HB, (const bf16*)(wl + WL_UP), HM, a.conv_w + (size_t)L * 3 * NUP, a.conv_b + (size_t)L * NUP, A2, HL, G, bx);
            pg8::Gemm g{HB, (const bf16*)(wl + WL_UP), MREAL, NUP, DM}; pg8::StaticOrder S; S.init(MREAL, NUP, G, bx);
            EpiUp E{L};
            for (int rep = 0; rep < REP_F; ++rep) pg8::gemm_phase<EpiUp, pg8::StaticOrder, true, true>(lds, g, S, E);
        }
#endif
        GSYNC(); PH_END(6);
#ifndef SKIP_H
        {
            FRESH();
            const float* cw = a.conv_w + (size_t)L * 3 * NUP; const float* cb = a.conv_b + (size_t)L * NUP;
            { int pm = 0;
              for (int ui = 0; so_next_pm(MREAL / 256, DM / 256, G, bx, ui, pm); ++ui) {
                for (int i = tid; i < 2 * (DFF / 4); i += 512) {
                    const int c4 = i % (DFF / 4), rr = i / (DFF / 4);
                    const int ch = 4 * c4;
                    f32x4 hc[2];
#pragma unroll
                    for (int bj = 0; bj < 2; ++bj) {
                        const int c = bj * DFF + ch;
                        f32x4 P0 = {0.f, 0.f, 0.f, 0.f}, P1 = P0;
                        if (pm != 128) { const int src = (pm % 16 == 0) ? 128 : pm - 1; P0 = *(const f32x4*)(HL + (size_t)(src * 2) * NUP + c); P1 = *(const f32x4*)(HL + (size_t)(src * 2 + 1) * NUP + c); }
                        const f32x4 H0 = *(const f32x4*)(HF + (size_t)(pm * 2) * NUP + c), H1 = *(const f32x4*)(HF + (size_t)(pm * 2 + 1) * NUP + c);
                        const f32x4 x2 = rr == 0 ? P0 : P1, x1 = rr == 0 ? P1 : H0, x0 = rr == 0 ? H0 : H1;
                        hc[bj] = *(const f32x4*)(cb + c) + *(const f32x4*)(cw + c) * x2 + *(const f32x4*)(cw + NUP + c) * x1 + *(const f32x4*)(cw + 2 * NUP + c) * x0;
                    }
                    u32x2 w;
                    w.x = pk2(siluf(hc[1][0]) * hc[0][0], siluf(hc[1][1]) * hc[0][1]);
                    w.y = pk2(siluf(hc[1][2]) * hc[0][2], siluf(hc[1][3]) * hc[0][3]);
                    *(u32x2*)(A2 + (size_t)(pm * 256 + rr) * DFF + ch) = w;
                }
              }
            }
            asm volatile("s_waitcnt vmcnt(0)" ::: "memory"); __syncthreads();
            meta_rowgemm(A2 + (size_t)META0 * DFF, DFF, (const bf16*)(wl + WL_DN), DFF, HM, HB, G, bx);
            pg8::Gemm g{A2, (const bf16*)(wl + WL_DN), MREAL, DM, DFF}; pg8::StaticOrder S; S.init(MREAL, DM, G, bx);
            if (L == DEPTH - 1) { EpiRes<false, true> E{2 * L + 2}; pg8::gemm_phase<EpiRes<false, true>, pg8::StaticOrder, true, true>(lds, g, S, E); }
            else { EpiRes<false, false> E{2 * L + 2}; pg8::gemm_phase<EpiRes<false, false>, pg8::StaticOrder, true, true>(lds, g, S, E); }
        }
#endif
        GSYNC(); PH_END(7);
    }
    {
        const int L = 0; FRESH();
        const float* ssq = ssq_arr(ws, 8);
        for (int r = gw; r < MREAL; r += NGW) {
            const float rs = row_rstd(ssq, r);
            f32x4* p = (f32x4*)(a.out + (size_t)r * DM) + lane; const f32x4* wn = (const f32x4*)a.final_norm + lane;
#pragma unroll
            for (int j = 0; j < 4; ++j) p[64 * j] = p[64 * j] * rs * wn[64 * j];
        }
#if defined(PROBE_SYNC) || defined(PROBE_PH)
        asm volatile("s_waitcnt vmcnt(0)" ::: "memory"); __syncthreads();
        if (bx == PROBE_BLOCK && tid == 0) a.out[(size_t)PROBE_BLOCK * 16 * DM * 0 + 5] += floorf((float)tsync * 0.0002f + 0.5f);
#endif
    }
}

extern "C" void kernel_launch(void* const* d_in, const int* in_sizes, int n_in, void* d_out, int out_size, void* d_ws, size_t ws_size, hipStream_t stream) {
    static int grid = 0;
    if (grid == 0) {
        if (n_in != 16 || out_size != MREAL * DM || ws_size < WS_END) { fprintf(stderr, "kernel_launch: unexpected problem (n_in %d out %d ws %zu, need %zu)\n", n_in, out_size, ws_size, (size_t)WS_END); grid = -1; return; }
        int dev = 0, cus = 0, per = 0;
        (void)hipGetDevice(&dev); (void)hipDeviceGetAttribute(&cus, hipDeviceAttributeMultiprocessorCount, dev);
        (void)hipFuncSetAttribute((const void*)fwd_kernel, hipFuncAttributeMaxDynamicSharedMemorySize, LDS_BYTES);
        (void)hipOccupancyMaxActiveBlocksPerMultiprocessor(&per, (const void*)fwd_kernel, 512, LDS_BYTES);
        if (per < 1) per = 1;
        grid = cus * per;
        fprintf(stderr, "kernel_launch: grid %d (cus %d x %d), ws %zu\n", grid, cus, per, ws_size);
    }
    if (grid < 0) return;
    Args a{};
    const float** f = (const float**)&a;
    for (int i = 0; i < 16; ++i) f[i] = (const float*)d_in[i];
    a.out = (float*)d_out; a.ws = (unsigned char*)d_ws;
    (void)hipMemsetAsync((unsigned char*)d_ws + WS_BAR, 0, BAR_BYTES, stream);
    void* args[] = {&a};
    hipError_t e = hipLaunchCooperativeKernel((const void*)fwd_kernel, dim3(grid), dim3(512), args, LDS_BYTES, stream);
    if (e != hipSuccess) fprintf(stderr, "cooperative launch failed: %s (grid %d)\n", hipGetErrorString(e), grid);
}
```

```cpp
#include <hip/hip_runtime.h>
#include <hip/hip_cooperative_groups.h>
#include <cstdio>
#include <cstdint>
namespace cg = cooperative_groups;
namespace pg8 {
#define PG8_LAS __attribute__((address_space(3)))
typedef unsigned short bf16_t;
typedef short bf16x8 __attribute__((ext_vector_type(8)));
typedef float f32x4 __attribute__((ext_vector_type(4)));
typedef unsigned u32x4 __attribute__((ext_vector_type(4)));
constexpr int BM = 256, BK = 64, HALF = 128, HTB = HALF * BK * 2  , STAGE_BYTES = 8 * HTB, NXCD = 8, WGM = 8;

__host__ __device__ __forceinline__ int lds_byte(int r, int c) { const int st = (r >> 4) * 2 + (c >> 5), rr = r & 15, cc = c & 31, ob = rr * 64 + cc * 2; return st * 1024 + (ob ^ (((ob >> 9) & 1) << 5)); }
__host__ __device__ __forceinline__ void stage_rc(int b, int& R, int& C) { const int st = b / 1024, sb = b % 1024, swz = sb ^ (((sb >> 9) & 1) << 5); R = (st >> 1) * 16 + swz / 64; C = (st & 1) * 32 + (swz % 64) / 2; }
__host__ __device__ __forceinline__ int perm32(int rho) { const int n = rho >> 4, i = rho & 15; return 8 * (i >> 2) + 4 * n + (i & 3); }

struct Unit { int pm, pn; };
struct Gemm { const bf16_t* A; const bf16_t* Bt; int M, N, K; };

struct StaticOrder {
    int nM, nN, nwg, G, c;
    __host__ __device__ void init(int M, int N, int G_, int c_) { nM = M / BM; nN = N / BM; nwg = nM * nN; G = G_; c = c_; }
    __host__ __device__ bool next(int i, Unit& u) const {
        const long L = (long)i * G + c; if (L >= nwg) return false;
        int wgid = (int)L; { const int q = nwg / NXCD, r = nwg % NXCD, xcd = wgid % NXCD, off = wgid / NXCD; wgid = (xcd < r ? xcd * (q + 1) : r * (q + 1) + (xcd - r) * q) + off; }
        const int nig = WGM * nN, gid = wgid / nig, fm = gid * WGM, gsz = (nM - fm) < WGM ? (nM - fm) : WGM;
        u.pm = fm + ((wgid % nig) % gsz); u.pn = (wgid % nig) / gsz; return true;
    }
    __device__ __forceinline__ void a_ready(const Unit&) const {}
    __device__ __forceinline__ void done(const Unit&) const {}
};

__device__ __forceinline__ unsigned cvt_pk_bf16(float lo, float hi) { unsigned r; asm volatile("v_cvt_pk_bf16_f32 %0, %1, %2" : "=v"(r) : "v"(lo), "v"(hi)); return r; }
typedef float f32x2 __attribute__((ext_vector_type(2)));
template <class Epi, class Sched, bool ALIGN_EPI = false, bool SP2 = false>
__device__ __forceinline__ void gemm_phase(PG8_LAS unsigned char* lds, const Gemm g, const Sched& S, const Epi& E) {
    int tid_ = threadIdx.x; asm volatile("" : "+v"(tid_)); const int tid = tid_, wid = __builtin_amdgcn_readfirstlane(tid >> 6), lane = tid & 63, wr = wid >> 2, wc = wid & 3, fr = lane & 15, fq = lane >> 4;
    const int K = g.K, nt = K / BK;
    unsigned voffA[2], voffB[2];
#pragma unroll
    for (int i = 0; i < 2; ++i) { int R, C; stage_rc(tid * 16 + i * 8192, R, C); const int Rb = Epi::PERM ? ((R & ~31) + perm32(R & 31)) : R;
        voffA[i] = (unsigned)(R * K + C) * 2u; voffB[i] = (unsigned)(Rb * K + C) * 2u; }
    const size_t kstep = (size_t)(BK * 2);
    const size_t hstep = (size_t)HALF * K * 2;
    const size_t tstep = 2 * hstep;
    const unsigned ldsw = (unsigned)wid * 1024u;
    const int aoff = lds_byte(wr * 64 + fr, fq * 8), boff = lds_byte(wc * 32 + fr, fq * 8);
#define PG8_SA(b, h) (((b) * 2 + (h)) * HTB)
#define PG8_SB(b, h) ((4 + (b) * 2 + (h)) * HTB)
#define PG8_STAGE(bufoff, gbase, voff) do { _Pragma("unroll") for (int _i = 0; _i < 2; ++_i) \
        __builtin_amdgcn_global_load_lds((const unsigned*)((const char*)(gbase) + (voff)[_i]), (PG8_LAS unsigned*)(lds + (bufoff) + ldsw + _i * 8192), 16, 0, 0); } while (0)
#define PG8_LDA(dst, b, h) do { _Pragma("unroll") for (int m = 0; m < 4; ++m) _Pragma("unroll") for (int k = 0; k < 2; ++k) dst[m][k] = *(const PG8_LAS bf16x8*)(lds + PG8_SA(b, h) + aoff + m * 2048 + k * 1024); } while (0)
#define PG8_LDB(dst, b, h) do { _Pragma("unroll") for (int n = 0; n < 2; ++n) _Pragma("unroll") for (int k = 0; k < 2; ++k) dst[n][k] = *(const PG8_LAS bf16x8*)(lds + PG8_SB(b, h) + boff + n * 2048 + k * 1024); } while (0)
#define PG8_MMA(ai, bj, At, Bt) do { __builtin_amdgcn_s_setprio(1); _Pragma("unroll") for (int m = 0; m < 4; ++m) _Pragma("unroll") for (int n = 0; n < 2; ++n) _Pragma("unroll") for (int k = 0; k < 2; ++k) \
        acc[ai][bj][m][n] = __builtin_amdgcn_mfma_f32_16x16x32_bf16(Bt[n][k], At[m][k], acc[ai][bj][m][n], 0, 0, 0); __builtin_amdgcn_s_setprio(0); } while (0)
#define PG8_WAIT_V(n) asm volatile("s_waitcnt vmcnt(" #n ")" ::: "memory")
#define PG8_WAIT_L(n) asm volatile("s_waitcnt lgkmcnt(" #n ")" ::: "memory")
#define PG8_BAR __builtin_amdgcn_s_barrier()
#define PG8_SCHED __builtin_amdgcn_sched_barrier(0)
    Unit cur, nxt; int ui = 0;
    if (!S.next(0, cur)) return;
    f32x4 acc[2][2][4][2];
#pragma unroll
    for (int a = 0; a < 2; ++a)
#pragma unroll
        for (int b = 0; b < 2; ++b)
#pragma unroll
            for (int m = 0; m < 4; ++m)
#pragma unroll
                for (int n = 0; n < 2; ++n) acc[a][b][m][n] = (f32x4){0.f, 0.f, 0.f, 0.f};
    bf16x8 At[4][2], B0[2][2], B1[2][2];
    const char* cA = (const char*)g.A + (size_t)cur.pm * tstep; const char* cB = (const char*)g.Bt + (size_t)cur.pn * tstep;
    S.a_ready(cur);
    if constexpr (SP2) {
        PG8_STAGE(PG8_SB(0, 0), cB, voffB); PG8_STAGE(PG8_SB(0, 1), cB + hstep, voffB); PG8_STAGE(PG8_SA(0, 0), cA, voffA); PG8_STAGE(PG8_SA(0, 1), cA + hstep, voffA);
        if (wr == 1) PG8_BAR;
        PG8_WAIT_V(2); PG8_BAR;
        PG8_STAGE(PG8_SB(1, 0), cB + kstep, voffB); PG8_STAGE(PG8_SA(1, 0), cA + kstep, voffA); PG8_STAGE(PG8_SB(1, 1), cB + hstep + kstep, voffB);
        PG8_WAIT_V(6); PG8_BAR;
    } else {
        PG8_STAGE(PG8_SB(0, 0), cB, voffB); PG8_STAGE(PG8_SA(0, 0), cA, voffA); PG8_STAGE(PG8_SB(0, 1), cB + hstep, voffB); PG8_STAGE(PG8_SA(0, 1), cA + hstep, voffA);
        if (wr == 1) PG8_BAR;
        PG8_WAIT_V(4); PG8_BAR;
        PG8_STAGE(PG8_SB(1, 0), cB + kstep, voffB); PG8_STAGE(PG8_SA(1, 0), cA + kstep, voffA); PG8_STAGE(PG8_SB(1, 1), cB + hstep + kstep, voffB);
        PG8_WAIT_V(6); PG8_BAR;
    }
    for (;;) {
        const bool has_next = S.next(ui + 1, nxt);
        const char* nA = has_next ? (const char*)g.A + (size_t)nxt.pm * tstep : cA; const char* nB = has_next ? (const char*)g.Bt + (size_t)nxt.pn * tstep : cB;
        for (int t = 0; t < nt; t += 2) {
            const bool last = (t == nt - 2);
            const char* a1 = cA + (size_t)(t + 1) * kstep;
            const char* a2 = last ? nA : cA + (size_t)(t + 2) * kstep; const char* b2 = last ? nB : cB + (size_t)(t + 2) * kstep;
            const char* a3 = a2 + kstep; const char* b3 = b2 + kstep;
            if (last && has_next) S.a_ready(nxt);
            if constexpr (SP2) {
            PG8_LDB(B0, 0, 0); PG8_LDB(B1, 0, 1); PG8_SCHED; PG8_LDA(At, 0, 0); PG8_STAGE(PG8_SA(1, 1), a1 + hstep, voffA);
            PG8_WAIT_V(8); PG8_WAIT_L(0); PG8_BAR; PG8_MMA(0, 0, At, B0); PG8_MMA(0, 1, At, B1); PG8_BAR; PG8_SCHED;
            PG8_LDA(At, 0, 1); PG8_STAGE(PG8_SB(0, 0), b2, voffB); PG8_STAGE(PG8_SB(0, 1), b2 + hstep, voffB); PG8_STAGE(PG8_SA(0, 0), a2, voffA);
            PG8_WAIT_V(8); PG8_WAIT_L(0); PG8_BAR; PG8_MMA(1, 0, At, B0); PG8_MMA(1, 1, At, B1); PG8_BAR; PG8_SCHED;
            PG8_LDB(B0, 1, 0); PG8_LDB(B1, 1, 1); PG8_SCHED; PG8_LDA(At, 1, 0); PG8_STAGE(PG8_SA(0, 1), a2 + hstep, voffA);
            PG8_WAIT_V(8); PG8_WAIT_L(0); PG8_BAR; PG8_MMA(0, 0, At, B0); PG8_MMA(0, 1, At, B1); PG8_BAR; PG8_SCHED;
            PG8_LDA(At, 1, 1); PG8_STAGE(PG8_SB(1, 0), b3, voffB); PG8_STAGE(PG8_SB(1, 1), b3 + hstep, voffB); PG8_STAGE(PG8_SA(1, 0), a3, voffA);
            PG8_WAIT_V(8); PG8_WAIT_L(0); PG8_BAR; PG8_MMA(1, 0, At, B0); PG8_MMA(1, 1, At, B1); PG8_BAR; PG8_SCHED;
            } else {
            PG8_LDB(B0, 0, 0); PG8_SCHED; PG8_LDA(At, 0, 0); PG8_STAGE(PG8_SA(1, 1), a1 + hstep, voffA);
            PG8_WAIT_L(8); PG8_BAR; PG8_WAIT_L(0); PG8_MMA(0, 0, At, B0); PG8_BAR; PG8_SCHED;
            PG8_LDB(B1, 0, 1); PG8_STAGE(PG8_SB(0, 0), b2, voffB);
            PG8_BAR; PG8_WAIT_L(0); PG8_MMA(0, 1, At, B1); PG8_BAR;
            PG8_LDA(At, 0, 1); PG8_STAGE(PG8_SA(0, 0), a2, voffA);
            PG8_BAR; PG8_WAIT_L(0); PG8_MMA(1, 0, At, B0); PG8_BAR; PG8_SCHED;
            PG8_STAGE(PG8_SB(0, 1), b2 + hstep, voffB);
            PG8_WAIT_V(6); PG8_BAR; PG8_MMA(1, 1, At, B1); PG8_BAR;
            PG8_LDB(B0, 1, 0); PG8_SCHED; PG8_LDA(At, 1, 0); PG8_STAGE(PG8_SA(0, 1), a2 + hstep, voffA);
            PG8_WAIT_L(8); PG8_BAR; PG8_WAIT_L(0); PG8_MMA(0, 0, At, B0); PG8_BAR; PG8_SCHED;
            PG8_LDB(B1, 1, 1); PG8_STAGE(PG8_SB(1, 0), b3, voffB);
            PG8_BAR; PG8_WAIT_L(0); PG8_MMA(0, 1, At, B1); PG8_BAR;
            PG8_LDA(At, 1, 1); PG8_STAGE(PG8_SA(1, 0), a3, voffA);
            PG8_BAR; PG8_WAIT_L(0); PG8_MMA(1, 0, At, B0); PG8_BAR; PG8_SCHED;
            PG8_STAGE(PG8_SB(1, 1), b3 + hstep, voffB);
            PG8_WAIT_V(6); PG8_BAR; PG8_MMA(1, 1, At, B1); PG8_BAR;
            }
        }
        if constexpr (ALIGN_EPI) { if (wr == 0) PG8_BAR; }
        if constexpr (!Epi::AFTER_DRAIN) { E(acc, cur, wr, wc, fr, fq); S.done(cur); }
        if (!has_next) break;
#pragma unroll
        for (int a = 0; a < 2; ++a)
#pragma unroll
            for (int b = 0; b < 2; ++b)
#pragma unroll
                for (int m = 0; m < 4; ++m)
#pragma unroll
                    for (int n = 0; n < 2; ++n) acc[a][b][m][n] = (f32x4){0.f, 0.f, 0.f, 0.f};
        cur = nxt; cA = nA; cB = nB; ++ui;
        if constexpr (ALIGN_EPI) { if (wr == 1) PG8_BAR; }
    }
    PG8_WAIT_V(0);
    if constexpr (!ALIGN_EPI) { if (wr == 0) PG8_BAR; }
    PG8_BAR;
    if constexpr (Epi::AFTER_DRAIN) { E.fused(acc, cur, wr, wc, fr, fq, lds, wid, lane); S.done(cur); }
#undef PG8_SA
#undef PG8_SB
#undef PG8_STAGE
#undef PG8_LDA
#undef PG8_LDB
#undef PG8_MMA
#undef PG8_WAIT_V
#undef PG8_WAIT_L
#undef PG8_BAR
#undef PG8_SCHED
}
}
#define LAS __attribute__((address_space(3)))
typedef unsigned short bf16;
typedef short bf16x8 __attribute__((ext_vector_type(8)));
typedef short s16x4 __attribute__((ext_vector_type(4)));
typedef float f32x4 __attribute__((ext_vector_type(4)));
typedef float f32x16 __attribute__((ext_vector_type(16)));
typedef unsigned u32x4 __attribute__((ext_vector_type(4)));
typedef unsigned u32x2 __attribute__((ext_vector_type(2)));

constexpr int NB = 8, SEQ = 4096, DM = 1024, DEPTH = 4, NMETA = 16;
constexpr int MREAL = NB * SEQ;
constexpr int META0 = MREAL;
constexpr int MROWS = 129 * 256;
constexpr int NINP = 3328, QP = 3072;
constexpr int C_FQ = 0, C_FK = 512, C_FV = 1024, C_GQ = 1536, C_GK = 1792, C_GV = 2048, C_GR = 2560;
constexpr int DFF = 2816, NUP = 5632;
constexpr float EPS = 1e-6f, LOG2E = 1.4426950408889634f, C2 = 0.125f * LOG2E;
constexpr int CKP = 4160;
constexpr int NCH = 65;

constexpr size_t MiB = 1u << 20;
constexpr size_t WL_IN = 0, WL_OUT = 6815744, WL_UP = 8912896, WL_DN = 20447232, WL_SIZE = 26214400;
constexpr size_t WS_W = 0, WS_HB = 100 * MiB, WS_OB = WS_HB + 67633152, WS_QKV = WS_OB + 67633152, WS_UT = WS_QKV + 202899456;
constexpr size_t WS_SM = WS_UT + 68157440, WS_CK = WS_SM + 4456448, WS_DEC = WS_CK + 1310720, WS_HM = WS_DEC + 786432, WS_SSQ = WS_HM + MiB, WS_BAR = WS_SSQ + 1835008, BAR_BYTES = 16384, WS_END = WS_BAR + BAR_BYTES;
static_assert(WS_END <= 512 * MiB, "workspace map");
constexpr size_t HFL_SIZE = (size_t)129 * 2 * NUP * 4;
static_assert(2 * HFL_SIZE <= 68157440, "halo overlay");

constexpr int LDS_BYTES = 147456, HALO_OFF = 131072;

struct Args {
    const float *x, *meta, *attn_norm, *w_in, *w_au, *b_alpha, *b_forget, *gla_norm, *fox_norm, *w_out, *ffn_norm, *w_up, *conv_w, *conv_b, *w_down, *final_norm;
    float* out; unsigned char* ws;
};

#define GAS __attribute__((address_space(1)))
#define CAS __attribute__((address_space(4)))
typedef const CAS Args* KArgs;
__device__ __forceinline__ KArgs kargs() { KArgs p = (KArgs)__builtin_amdgcn_kernarg_segment_ptr(); asm volatile("" : "+s"(p)); return p; }
template <class T> __device__ __forceinline__ T* gptr(T* p) { return (T*)(GAS T*)p; }
__device__ __forceinline__ float bf2f(bf16 v) { return __uint_as_float((unsigned)v << 16); }
__device__ __forceinline__ unsigned pk2(float lo, float hi) { return pg8::cvt_pk_bf16(lo, hi); }
__device__ __forceinline__ bf16 f2bf(float v) { return (bf16)(pk2(v, 0.f) & 0xffffu); }
__device__ __forceinline__ float wave_sum(float v) {
#pragma unroll
    for (int o = 1; o < 64; o <<= 1) v += __shfl_xor(v, o);
    return v;
}
__device__ __forceinline__ float logsigmoidf(float z) { return -(fmaxf(-z, 0.f) + log1pf(__expf(-fabsf(z)))); }
__device__ __forceinline__ float siluf(float v) { return v * __builtin_amdgcn_rcpf(1.f + __builtin_amdgcn_exp2f(-LOG2E * v)); }
__device__ __forceinline__ int crow(int r, int hi) { return (r & 3) + 8 * (r >> 2) + 4 * hi; }
__device__ __forceinline__ s16x4 vtr(const LAS unsigned char* p) { return __builtin_bit_cast(s16x4, __builtin_amdgcn_ds_read_tr16_b64_v4i16((LAS s16x4*)p)); }
__device__ __forceinline__ bf16x8 cat8(s16x4 a, s16x4 b) { return (bf16x8){a[0], a[1], a[2], a[3], b[0], b[1], b[2], b[3]}; }
__device__ __forceinline__ float dppf(float old, float src, int ctrl_unused);
#define DPP_MOV(old, src, ctrl) __builtin_bit_cast(float, __builtin_amdgcn_update_dpp(__builtin_bit_cast(int, (float)(old)), __builtin_bit_cast(int, (float)(src)), (ctrl), 0xf, 0xf, false))
#define LDS_WAIT() asm volatile("s_waitcnt lgkmcnt(0)" ::: "memory")

__device__ __forceinline__ const float* ssq_arr(unsigned char* wsb, int si) { return (const float*)(wsb + WS_SSQ) + (size_t)(si % 3) * MROWS * 4; }
__device__ __forceinline__ float row_rstd(const float* ssqp, int row) { const f32x4 s = *(const f32x4*)(ssqp + (size_t)row * 4); return rsqrtf(((s[0] + s[1]) + (s[2] + s[3])) * (1.0f / DM) + EPS); }
__device__ __forceinline__ LAS float* tile_rstd(unsigned char* wsb, int si, int pm, int wr, int wc, int fr, int fq) {
    extern __shared__ __attribute__((aligned(16))) unsigned char lds_dyn_[];
    LAS float* rsl = (LAS float*)((LAS unsigned char*)lds_dyn_ + HALO_OFF + 8192);
    const int tl = (wr * 4 + wc) * 64 + fq * 16 + fr;
    if (pm != 128) {
        if (tl < 256) rsl[tl] = row_rstd(ssq_arr(wsb, si), pm * 256 + tl);
    } else {
        const int row = tl >> 5, part = tl & 31;
        const f32x4* hp = (const f32x4*)((const float*)(wsb + WS_HM) + (size_t)row * DM) + part;
        float s = 0.f;
#pragma unroll
        for (int j = 0; j < 8; ++j) { const f32x4 v = hp[32 * j]; s += (v[0] * v[0] + v[1] * v[1]) + (v[2] * v[2] + v[3] * v[3]); }
        s += __shfl_xor(s, 1); s += __shfl_xor(s, 2); s += __shfl_xor(s, 4); s += __shfl_xor(s, 8); s += __shfl_xor(s, 16);
        if (part == 0) rsl[row] = rsqrtf(s * (1.0f / DM) + EPS);
        if (tl < 240) rsl[16 + tl] = 0.f;
    }
    asm volatile("s_waitcnt lgkmcnt(0)" ::: "memory"); __builtin_amdgcn_s_barrier(); asm volatile("" ::: "memory");
    return rsl;
}
__device__ __forceinline__ void meta_rowgemm(const bf16* A, int lda, const bf16* Bt, int K, float* HM, bf16* HB, int G, int bx) {
    int tid_ = threadIdx.x; asm volatile("" : "+v"(tid_)); const int r = tid_ >> 5, kp = tid_ & 31;
    for (int cg = bx; cg < 256; cg += G) {
        float acc[4] = {0.f, 0.f, 0.f, 0.f};
        for (int k0 = kp * 8; k0 < K; k0 += 256) {
            const u32x4 av = *(const u32x4*)(A + (size_t)r * lda + k0);
#pragma unroll
            for (int j = 0; j < 4; ++j) {
                const u32x4 bv = *(const u32x4*)(Bt + (size_t)(4 * cg + j) * K + k0);
#pragma unroll
                for (int q = 0; q < 4; ++q) {
                    acc[j] += __uint_as_float(av[q] << 16) * __uint_as_float(bv[q] << 16);
                    acc[j] += __uint_as_float(av[q] & 0xffff0000u) * __uint_as_float(bv[q] & 0xffff0000u);
                }
            }
        }
#pragma unroll
        for (int j = 0; j < 4; ++j) { float s = acc[j]; s += __shfl_xor(s, 1); s += __shfl_xor(s, 2); s += __shfl_xor(s, 4); s += __shfl_xor(s, 8); s += __shfl_xor(s, 16); acc[j] = s; }
        if (kp == 0) {
            float* hp = HM + (size_t)r * DM + 4 * cg;
            const f32x4 h = *(const f32x4*)hp + (f32x4){acc[0], acc[1], acc[2], acc[3]};
            *(f32x4*)hp = h;
            u32x2 w; w.x = pk2(h[0], h[1]); w.y = pk2(h[2], h[3]);
            *(u32x2*)(HB + (size_t)(META0 + r) * DM + 4 * cg) = w;
        }
    }
}
__device__ __forceinline__ void meta_up(LAS unsigned char* lds, const bf16* HB, const bf16* Wup, const float* HM, const float* cw, const float* cb, bf16* A2, float* HL, int G, int bx) {
    int tid_ = threadIdx.x; asm volatile("" : "+v"(tid_)); const int tid = tid_, r = tid >> 5, kp = tid & 31;
    LAS float* hb = (LAS float*)lds;
    float rs;
    { const f32x4* hp = (const f32x4*)(HM + (size_t)r * DM) + kp; float s = 0.f;
#pragma unroll
      for (int j = 0; j < 8; ++j) { const f32x4 v = hp[32 * j]; s += (v[0] * v[0] + v[1] * v[1]) + (v[2] * v[2] + v[3] * v[3]); }
      s += __shfl_xor(s, 1); s += __shfl_xor(s, 2); s += __shfl_xor(s, 4); s += __shfl_xor(s, 8); s += __shfl_xor(s, 16);
      rs = rsqrtf(s * (1.0f / DM) + EPS); }
    u32x4 av[4];
#pragma unroll
    for (int i = 0; i < 4; ++i) av[i] = *(const u32x4*)(HB + (size_t)(META0 + r) * DM + kp * 8 + 256 * i);
    for (int cg = bx; cg < 256; cg += G) {
#pragma unroll 1
        for (int cb0 = 0; cb0 < 24; cb0 += 6) {
            u32x4 bv[6][4];
#pragma unroll
            for (int c6 = 0; c6 < 6; ++c6) {
                const int c = cb0 + c6 < 22 ? cb0 + c6 : 21, isg = c >= 11 ? 1 : 0, jj = c - 11 * isg;
                const int ch = 11 * cg + jj, wrow = (ch >> 7) * 256 + isg * 128 + (ch & 127);
#pragma unroll
                for (int i = 0; i < 4; ++i) bv[c6][i] = *(const u32x4*)(Wup + (size_t)wrow * DM + kp * 8 + 256 * i);
            }
#pragma unroll
            for (int c6 = 0; c6 < 6; ++c6) {
                float acc = 0.f;
#pragma unroll
                for (int i = 0; i < 4; ++i)
#pragma unroll
                    for (int q = 0; q < 4; ++q) {
                        acc += __uint_as_float(av[i][q] << 16) * __uint_as_float(bv[c6][i][q] << 16);
                        acc += __uint_as_float(av[i][q] & 0xffff0000u) * __uint_as_float(bv[c6][i][q] & 0xffff0000u);
                    }
                acc += __shfl_xor(acc, 1); acc += __shfl_xor(acc, 2); acc += __shfl_xor(acc, 4); acc += __shfl_xor(acc, 8); acc += __shfl_xor(acc, 16);
                if (kp == 0 && cb0 + c6 < 22) hb[r * 24 + cb0 + c6] = acc * rs;
            }
        }
        __syncthreads();
        if (tid < 16 * 11) {
            const int rr = tid / 11, jj = tid % 11, ch = 11 * cg + jj;
            float hc[2];
#pragma unroll
            for (int ug = 0; ug < 2; ++ug) {
                const int c = ug * DFF + ch;
                const float x0 = hb[rr * 24 + ug * 11 + jj], x1 = rr >= 1 ? hb[(rr - 1) * 24 + ug * 11 + jj] : 0.f, x2 = rr >= 2 ? hb[(rr - 2) * 24 + ug * 11 + jj] : 0.f;
                hc[ug] = cb[c] + cw[c] * x2 + cw[NUP + c] * x1 + cw[2 * NUP + c] * x0;
                if (rr >= 14) HL[(size_t)(256 + rr - 14) * NUP + c] = x0;
            }
            A2[(size_t)(META0 + rr) * DFF + ch] = f2bf(siluf(hc[1]) * hc[0]);
        }
        __syncthreads();
    }
}
__device__ __forceinline__ bool so_next_pm(int nM, int nN, int G, int c, int i, int& pm) {
    const int nwg = nM * nN; const long Lq = (long)i * G + c; if (Lq >= nwg) return false;
    int wgid = (int)Lq; { const int q = nwg / pg8::NXCD, r = nwg % pg8::NXCD, xcd = wgid % pg8::NXCD, off = wgid / pg8::NXCD; wgid = (xcd < r ? xcd * (q + 1) : r * (q + 1) + (xcd - r) * q) + off; }
    const int nig = pg8::WGM * nN, gid = wgid / nig, fm = gid * pg8::WGM, gsz = (nM - fm) < pg8::WGM ? (nM - fm) : pg8::WGM;
    pm = fm + ((wgid % nig) % gsz); return true;
}
struct EpiIn {
    static constexpr bool PERM = true, AFTER_DRAIN = false;
    int si;
    __device__ __forceinline__ void operator()(const pg8::f32x4 (&acc)[2][2][4][2], const pg8::Unit& u, int wr, int wc, int fr, int fq) const {
        asm volatile("" : "+v"(fr), "+v"(fq));
        unsigned char* wsb = gptr(kargs()->ws);
        bf16* Q = (bf16*)(wsb + WS_QKV); float* SM = (float*)(wsb + WS_SM); const LAS float* rsl = tile_rstd(wsb, si, u.pm, wr, wc, fr, fq);
#pragma unroll
        for (int ai = 0; ai < 2; ++ai)
#pragma unroll
            for (int m = 0; m < 4; ++m) {
                const int row = u.pm * 256 + ai * 128 + wr * 64 + m * 16 + fr;
                const float rs = rsl[ai * 128 + wr * 64 + m * 16 + fr];
                if (u.pn < 12) {
#pragma unroll
                    for (int bj = 0; bj < 2; ++bj) {
                        const pg8::f32x4 v0 = acc[ai][bj][m][0] * rs, v1 = acc[ai][bj][m][1] * rs;
                        u32x4 w; w.x = pk2(v0[0], v0[1]); w.y = pk2(v0[2], v0[3]); w.z = pk2(v1[0], v1[1]); w.w = pk2(v1[2], v1[3]);
                        *(u32x4*)(Q + (size_t)row * QP + u.pn * 256 + bj * 128 + wc * 32 + 8 * fq) = w;
                    }
                } else if (wc == 0) {
                    *(f32x4*)(SM + (size_t)row * 32 + 8 * fq) = acc[ai][0][m][0] * rs;
                    *(f32x4*)(SM + (size_t)row * 32 + 8 * fq + 4) = acc[ai][0][m][1] * rs;
                }
            }
    }
};
template <bool from_x, bool last> struct EpiRes {
    static constexpr bool PERM = false, AFTER_DRAIN = false;
    int si;
    __device__ __forceinline__ void operator()(const pg8::f32x4 (&acc)[2][2][4][2], const pg8::Unit& u, int wr, int wc, int fr, int fq) const {
        asm volatile("" : "+v"(fr), "+v"(fq));
        KArgs ka = kargs(); unsigned char* wsb = gptr(ka->ws);
        float* out = last ? gptr(ka->out) : nullptr; const float* xin = from_x ? gptr(ka->x) : nullptr; bf16* HB = (bf16*)(wsb + WS_HB); float* ssq_next = (float*)ssq_arr(wsb, si);
        extern __shared__ __attribute__((aligned(16))) unsigned char lds_dyn_[];
        LAS float* red = (LAS float*)((LAS unsigned char*)lds_dyn_ + HALO_OFF);
#pragma unroll
        for (int ai = 0; ai < 2; ++ai)
#pragma unroll
            for (int m = 0; m < 4; ++m) {
                const int row = u.pm * 256 + ai * 128 + wr * 64 + m * 16 + fr;
                float ss = 0.f;
#pragma unroll
                for (int bj = 0; bj < 2; ++bj)
#pragma unroll
                    for (int n = 0; n < 2; ++n) {
                        const int col = u.pn * 256 + bj * 128 + wc * 32 + 16 * n + 4 * fq;
                        f32x4 bs;
                        if constexpr (from_x) bs = *(const f32x4*)(xin + (size_t)row * DM + col);
                        else { const u32x2 t = *(const u32x2*)(HB + (size_t)row * DM + col);
                               bs = (f32x4){__uint_as_float(t.x << 16), __uint_as_float(t.x & 0xffff0000u), __uint_as_float(t.y << 16), __uint_as_float(t.y & 0xffff0000u)}; }
                        const f32x4 h = bs + acc[ai][bj][m][n];
                        ss += (h[0] * h[0] + h[1] * h[1]) + (h[2] * h[2] + h[3] * h[3]);
                        u32x2 w; w.x = pk2(h[0], h[1]); w.y = pk2(h[2], h[3]);
                        *(u32x2*)(HB + (size_t)row * DM + col) = w;
                        if constexpr (last) *(f32x4*)(out + (size_t)row * DM + col) = h;
                    }
                ss += __shfl_xor(ss, 16); ss += __shfl_xor(ss, 32);
                if (fq == 0) red[wc * 256 + ai * 128 + wr * 64 + m * 16 + fr] = ss;
            }
        asm volatile("s_waitcnt lgkmcnt(0)" ::: "memory"); __builtin_amdgcn_s_barrier(); asm volatile("" ::: "memory");
        {
            const int tl = (wr * 4 + wc) * 64 + fq * 16 + fr;
            if (tl < 256) ssq_next[(size_t)(u.pm * 256 + tl) * 4 + u.pn] = (red[tl] + red[256 + tl]) + (red[512 + tl] + red[768 + tl]);
        }
    }
};
struct EpiUp {
    static constexpr bool PERM = true, AFTER_DRAIN = false;
    int L;
    __device__ __forceinline__ void operator()(pg8::f32x4 (&acc)[2][2][4][2], const pg8::Unit& u, int wr, int wc, int fr, int fq) const {
        asm volatile("" : "+v"(fr), "+v"(fq));
        KArgs ka = kargs(); unsigned char* wsb = gptr(ka->ws);
        const LAS float* rsl = tile_rstd(wsb, 2 * L + 1, u.pm, wr, wc, fr, fq); const float* cw = gptr(ka->conv_w) + (size_t)L * 3 * NUP; const float* cb = gptr(ka->conv_b) + (size_t)L * NUP;
        extern __shared__ __attribute__((aligned(16))) unsigned char lds_dyn_[];
        LAS float* halo = (LAS float*)((LAS unsigned char*)lds_dyn_ + HALO_OFF);
        const int colw = wc * 32 + 8 * fq;
#pragma unroll
        for (int ai = 0; ai < 2; ++ai)
#pragma unroll
            for (int m = 0; m < 4; ++m) {
                const int row = u.pm * 256 + ai * 128 + wr * 64 + m * 16 + fr;
                const float rs = rsl[ai * 128 + wr * 64 + m * 16 + fr]; (void)row;
#pragma unroll
                for (int bj = 0; bj < 2; ++bj)
#pragma unroll
                    for (int n = 0; n < 2; ++n) acc[ai][bj][m][n] *= rs;
            }
#ifdef SIMPLE_UP
        {
            const int ch0s = u.pn * 128 + colw;
#pragma unroll
            for (int n = 0; n < 2; ++n)
#pragma unroll
                for (int ai = 0; ai < 2; ++ai)
#pragma unroll
                    for (int m = 0; m < 4; ++m) {
                        const int row = u.pm * 256 + ai * 128 + wr * 64 + m * 16 + fr;
                        const f32x4 hu = acc[ai][0][m][n], hg = acc[ai][1][m][n];
                        u32x2 w; w.x = pk2(hu[0] + hg[0], hu[1] + hg[1]); w.y = pk2(hu[2] + hg[2], hu[3] + hg[3]);
                        *(u32x2*)(wsb + (unsigned)(WS_QKV + (unsigned)((row * DFF + ch0s + 4 * n) * 2))) = w;
                    }
            return;
        }
#endif
        if (fr >= 14) {
#pragma unroll
            for (int ai = 0; ai < 2; ++ai)
#pragma unroll
                for (int bj = 0; bj < 2; ++bj)
#pragma unroll
                    for (int n = 0; n < 2; ++n)
                        *(LAS f32x4*)(halo + (((2 * ai + wr) * 2 + (fr - 14)) * 256 + bj * 128 + colw + 4 * n)) = acc[ai][bj][3][n];
        }
        asm volatile("s_waitcnt lgkmcnt(0)" ::: "memory"); __builtin_amdgcn_s_barrier(); asm volatile("" ::: "memory");
        const int ch0 = u.pn * 128 + colw;
        u32x2 wout[2][4][2];
#pragma unroll
        for (int n = 0; n < 2; ++n) {
            f32x4 w0[2], w1[2], w2[2], bb[2];
#pragma unroll
            for (int bj = 0; bj < 2; ++bj) {
                const int c = bj * DFF + ch0 + 4 * n;
                w0[bj] = *(const f32x4*)((const char*)cw + (unsigned)(c * 4)); w1[bj] = *(const f32x4*)((const char*)cw + (unsigned)((NUP + c) * 4)); w2[bj] = *(const f32x4*)((const char*)cw + (unsigned)((2 * NUP + c) * 4)); bb[bj] = *(const f32x4*)((const char*)cb + (unsigned)(c * 4));
            }
#pragma unroll
            for (int ai = 0; ai < 2; ++ai)
#pragma unroll
                for (int m = 0; m < 4; ++m) {
                    const int g = 2 * ai + wr;
                    f32x4 hc[2];
#pragma unroll
                    for (int bj = 0; bj < 2; ++bj) {
                        const int c = bj * DFF + ch0 + 4 * n;
                        const f32x4 cur = acc[ai][bj][m][n];
                        f32x4 pb;
                        if (m > 0) pb = acc[ai][bj][m - 1][n];
                        else pb = *(const LAS f32x4*)(halo + ((((g > 0 ? g - 1 : 0) * 2) + (fr & 1)) * 256 + bj * 128 + colw + 4 * n));
                        f32x4 p1, p2;
#pragma unroll
                        for (int j = 0; j < 4; ++j) {
                            const float t1 = DPP_MOV(0.f, pb[j], 0x121);
                            p1[j] = DPP_MOV(t1, cur[j], 0x111);
                            const float t2 = DPP_MOV(0.f, pb[j], 0x122);
                            p2[j] = DPP_MOV(t2, cur[j], 0x112);
                        }
                        hc[bj] = bb[bj] + w0[bj] * p2 + w1[bj] * p1 + w2[bj] * cur;
                        if (g == 0 && m == 0 && fr < 2) *(f32x4*)(wsb + (unsigned)(WS_UT + (unsigned)(((u.pm * 2 + fr) * NUP + c) * 4))) = cur;
                        if (u.pm == 128 ? (g == 0 && m == 0 && fr >= 14) : (g == 3 && m == 3 && fr >= 14))
                            *(f32x4*)(wsb + (unsigned)(WS_UT + HFL_SIZE + (unsigned)(((u.pm * 2 + fr - 14) * NUP + c) * 4))) = cur;
                    }
                    wout[ai][m][n].x = pk2(siluf(hc[1][0]) * hc[0][0], siluf(hc[1][1]) * hc[0][1]);
                    wout[ai][m][n].y = pk2(siluf(hc[1][2]) * hc[0][2], siluf(hc[1][3]) * hc[0][3]);
                }
        }
#pragma unroll
        for (int ai = 0; ai < 2; ++ai)
#pragma unroll
            for (int m = 0; m < 4; ++m) {
                const int row = u.pm * 256 + ai * 128 + wr * 64 + m * 16 + fr;
                u32x4 w; w.x = wout[ai][m][0].x; w.y = wout[ai][m][0].y; w.z = wout[ai][m][1].x; w.w = wout[ai][m][1].y;
                *(u32x4*)(wsb + (unsigned)(WS_QKV + (unsigned)((row * DFF + ch0) * 2))) = w;
            }
    }
};
#define XB_TMO      128
#define XB_XCNT(j)  (256  + 64 * (j))
#define XB_XSUB(j)  (1280 + 64 * (j))
#define XB_XGEN(j)  (2304 + 64 * (j))
#define XB_TOP      3328
#define XB_TOPGEN   3392
#define XCD_BAR_WORDS 3456
#define XB_SPIN_CAP (1u << 18)

__device__ __forceinline__ unsigned xb_ld(unsigned* p)              { return __hip_atomic_load(p, __ATOMIC_RELAXED, __HIP_MEMORY_SCOPE_AGENT); }
__device__ __forceinline__ unsigned xb_add(unsigned* p, unsigned v) { return __hip_atomic_fetch_add(p, v, __ATOMIC_RELAXED, __HIP_MEMORY_SCOPE_AGENT); }
__device__ __forceinline__ unsigned xb_xcc_id() { return (unsigned)__builtin_amdgcn_s_getreg((3 << 11) | 20) & 0xFu; }
#define XB_SPIN(cond, bar) do { unsigned _sp = 0; while (cond) { __builtin_amdgcn_s_sleep(1); \
    if ((++_sp & 255u) == 0u) { if (xb_ld(&(bar)[XB_TMO])) break; if (_sp > XB_SPIN_CAP) { atomicAdd(&(bar)[XB_TMO], 1u); break; } } } } while (0)

struct XcdBarrier {
    unsigned* bar; unsigned x;
    volatile LAS unsigned* st;
};

__device__ __forceinline__ XcdBarrier xcd_barrier_post(unsigned* bar, volatile LAS unsigned* st) {
    XcdBarrier b; b.bar = bar; b.x = xb_xcc_id(); b.st = st;
    if (threadIdx.x == 0) (void)xb_add(&bar[XB_XCNT(b.x)], 1u);
    return b;
}
__device__ __forceinline__ void xcd_barrier_complete(unsigned* bar, unsigned x, unsigned& nloc, unsigned& nx) {
    const unsigned G = gridDim.x * gridDim.y * gridDim.z;
    unsigned sum, cnt, mine, sp = 0u;
    for (;;) {
        sum = 0u; cnt = 0u; mine = 0u;
#pragma unroll
        for (unsigned j = 0; j < 16; ++j) { const unsigned c = xb_ld(&bar[XB_XCNT(j)]); sum += c; cnt += (c > 0u) ? 1u : 0u; mine = (j == x) ? c : mine; }
        if (sum == G) break;
        __builtin_amdgcn_s_sleep(1);
        if ((++sp & 255u) == 0u) { if (xb_ld(&bar[XB_TMO])) break; if (sp > XB_SPIN_CAP) { atomicAdd(&bar[XB_TMO], 1u); break; } }
    }
    nloc = mine > 0u ? mine : 1u; nx = cnt > 0u ? cnt : 1u;
}

__device__ __forceinline__ void xcd_barrier(const XcdBarrier& b) {
    asm volatile("s_waitcnt vmcnt(0)" ::: "memory");
    __syncthreads();
    if (threadIdx.x == 0) {
        unsigned* bar = b.bar;
        __builtin_amdgcn_s_waitcnt(0);
        unsigned nloc = b.st[0], nx = b.st[1];
        if (nloc == 0u) { xcd_barrier_complete(bar, b.x, nloc, nx); b.st[0] = nloc; b.st[1] = nx; }
        const unsigned old = xb_add(&bar[XB_XSUB(b.x)], 1u);
        const unsigned gen = old / nloc;
        if (old + 1u == (gen + 1u) * nloc) {
            __builtin_amdgcn_fence(__ATOMIC_RELEASE, "agent");
            asm volatile("s_waitcnt vmcnt(0)" ::: "memory");
            const unsigned og = xb_add(&bar[XB_TOP], 1u);
            const unsigned tg = og / nx;
            if (og + 1u == (tg + 1u) * nx) xb_add(&bar[XB_TOPGEN], 1u);
            else XB_SPIN(xb_ld(&bar[XB_TOPGEN]) == tg, bar);
            __builtin_amdgcn_fence(__ATOMIC_ACQUIRE, "agent");
            xb_add(&bar[XB_XGEN(b.x)], 1u);
            asm volatile("s_waitcnt vmcnt(0)" ::: "memory");
        } else {
            XB_SPIN(xb_ld(&bar[XB_XGEN(b.x)]) == gen, bar);
            __builtin_amdgcn_fence(__ATOMIC_ACQUIRE, "agent");
            asm volatile("s_waitcnt vmcnt(0)" ::: "memory");
        }
    }
    __syncthreads();
}
__device__ __forceinline__ int win_src(int n) {
    if (n < 512) return 1552 + n;
    if (n < 1024) return 2064 + (n - 512);
    if (n < 1536) return 2576 + (n - 1024);
    if (n < 1792) return n - 1536;
    if (n < 2048) return 256 + (n - 1792);
    if (n < 2560) return 512 + (n - 2048);
    if (n < 3072) return 1024 + (n - 2560);
    if (n < 3088) return 1536 + (n - 3072);
    if (n < 3096) return n;
    return -1;
}
__device__ __forceinline__ void tr_item(const float* W, int Nsrc, bf16* WT, int K, const float* gk, int mode, LAS float* scr, int k0, int n0, int lane) {
    const int nl = lane & 31, n = n0 + nl;
    int src = n; float cs = 1.f;
    if (mode == 0) { src = win_src(n); cs = n < 512 ? C2 : ((n >= 1536 && n < 1792) ? 0.125f : 1.f); }
    else if (mode == 2) { const int pn = n >> 8, j = n & 255; src = j < 128 ? pn * 128 + j : DFF + pn * 128 + (j - 128); }
#pragma unroll
    for (int i = 0; i < 32; ++i) {
        const int kk = 2 * i + (lane >> 5);
        float v = 0.f;
        if (src >= 0) v = W[(size_t)(k0 + kk) * Nsrc + src] * cs;
        if (gk) v *= gk[k0 + kk];
        scr[kk * 33 + nl] = v;
    }
    LDS_WAIT(); asm volatile("" ::: "memory");
    const int c = lane & 7;
#pragma unroll
    for (int j = 0; j < 4; ++j) {
        const int nn = (lane >> 3) + 8 * j; const LAS float* s = scr + (8 * c) * 33 + nn;
        u32x4 o; o.x = pk2(s[0 * 33], s[1 * 33]); o.y = pk2(s[2 * 33], s[3 * 33]); o.z = pk2(s[4 * 33], s[5 * 33]); o.w = pk2(s[6 * 33], s[7 * 33]);
        *(u32x4*)(WT + (size_t)(n0 + nn) * K + k0 + 8 * c) = o;
    }
    LDS_WAIT(); asm volatile("" ::: "memory");
}
__device__ __forceinline__ void row_to_bf16(const float* xrow, bf16* orow, float* ssq_slot, float* copy_row, int lane) {
    const f32x4* xr = (const f32x4*)xrow + lane;
    f32x4 v[4]; float s = 0.f;
#pragma unroll
    for (int j = 0; j < 4; ++j) { v[j] = xr[64 * j]; s += (v[j][0] * v[j][0] + v[j][1] * v[j][1]) + (v[j][2] * v[j][2] + v[j][3] * v[j][3]); }
    s = wave_sum(s);
    if (lane == 0) *(f32x4*)ssq_slot = (f32x4){s, 0.f, 0.f, 0.f};
    u32x2* o8 = (u32x2*)orow + lane;
#pragma unroll
    for (int j = 0; j < 4; ++j) { u32x2 w; w.x = pk2(v[j][0], v[j][1]); w.y = pk2(v[j][2], v[j][3]); o8[64 * j] = w; }
    if (copy_row) {
#pragma unroll
        for (int j = 0; j < 4; ++j) ((f32x4*)copy_row + lane)[64 * j] = v[j];
    }
}

template <int NQ> __device__ __forceinline__ void gla_u_group(LAS unsigned char* lds, const bf16* QKV, const float* SM, const float* wau, const float* balpha, float* UT, float* DEC, int grp) {
    int tid_ = threadIdx.x; asm volatile("" : "+v"(tid_)); const int tid = tid_, lane = tid & 63, wid = __builtin_amdgcn_readfirstlane(tid >> 6), hi = lane >> 5, r32 = lane & 31;
    constexpr int SUB = 9216 + 17408 + 2048;
    const int dk = lane, sg = wid;
    int bhq[NQ], ccq[NQ], hq[NQ], row0q[NQ], tvq[NQ];
    float la[NQ][8], kf[NQ][8];
#pragma unroll
    for (int q = 0; q < NQ; ++q) {
        const int u = NQ * grp + q; bhq[q] = u / NCH; ccq[q] = u % NCH; hq[q] = bhq[q] & 3;
        row0q[q] = ccq[q] == 0 ? META0 : (bhq[q] >> 2) * SEQ + (ccq[q] - 1) * 64; tvq[q] = ccq[q] == 0 ? NMETA : 64;
        LAS unsigned char* VT = lds + q * SUB + 9216;
        LAS float* TOT = (LAS float*)(lds + q * SUB + 9216 + 17408);
#pragma unroll
        for (int i = 0; i < 2; ++i) {
            const int idx = tid + 512 * i, row = idx >> 4, ch = idx & 15;
            const u32x4 v = *(const u32x4*)(QKV + (size_t)(row0q[q] + row) * QP + C_GV + hq[q] * 128 + ch * 8);
            *(LAS u32x4*)(VT + row * 272 + ch * 16) = v;
        }
#pragma unroll
        for (int i = 0; i < 8; ++i) kf[q][i] = bf2f(QKV[(size_t)(row0q[q] + 8 * sg + i) * QP + C_GK + hq[q] * 64 + dk]);
        float w[16];
#pragma unroll
        for (int r = 0; r < 16; ++r) w[r] = wau[r * 256 + hq[q] * 64 + dk];
        const float bias = balpha[hq[q] * 64 + dk];
#pragma unroll
        for (int i = 0; i < 8; ++i) {
            const int s = 8 * sg + i;
            const f32x4* g4 = (const f32x4*)(SM + (size_t)(row0q[q] + s) * 32);
            float z = bias;
#pragma unroll
            for (int k = 0; k < 4; ++k) { const f32x4 gv = g4[k]; z += gv[0] * w[4 * k] + gv[1] * w[4 * k + 1] + gv[2] * w[4 * k + 2] + gv[3] * w[4 * k + 3]; }
            la[q][i] = (s < tvq[q]) ? logsigmoidf(z) * (1.0f / 16.0f) : 0.f;
        }
#pragma unroll
        for (int i = 1; i < 8; ++i) la[q][i] += la[q][i - 1];
        TOT[sg * 64 + dk] = la[q][7];
    }
    __syncthreads();
#pragma unroll
    for (int q = 0; q < NQ; ++q) {
        LAS unsigned char* KD = lds + q * SUB;
        const LAS float* TOT = (const LAS float*)(lds + q * SUB + 9216 + 17408);
        float pre = 0.f, tot = 0.f;
#pragma unroll
        for (int g2 = 0; g2 < 8; ++g2) { const float t = TOT[g2 * 64 + dk]; if (g2 < sg) pre += t; tot += t; }
        if (sg == 0) DEC[(size_t)(bhq[q] * NCH + ccq[q]) * 64 + dk] = __expf(tot);
#pragma unroll
        for (int i = 0; i < 8; ++i) {
            const int s = 8 * sg + i;
            const float kd = (s < tvq[q]) ? kf[q][i] * __expf(tot - (pre + la[q][i])) : 0.f;
            *(LAS bf16*)(KD + s * 144 + dk * 2) = f2bf(kd);
        }
    }
    __syncthreads();
    const int dvb = wid >> 1, dkb = wid & 1;
    const int qq = (lane & 15) >> 2, pp = lane & 3, half = (lane >> 4) & 1;
#pragma unroll
    for (int q = 0; q < NQ; ++q) {
        const LAS unsigned char* KD = lds + q * SUB; const LAS unsigned char* VT = lds + q * SUB + 9216;
        f32x16 acc = {};
#pragma unroll
        for (int j = 0; j < 4; ++j) {
            const LAS unsigned char* ap = VT + (16 * j + 4 * hi + qq) * 272 + (32 * dvb + 16 * half + 4 * pp) * 2;
            const LAS unsigned char* bp = KD + (16 * j + 4 * hi + qq) * 144 + (32 * dkb + 16 * half + 4 * pp) * 2;
            const bf16x8 af = cat8(vtr(ap), vtr(ap + 8 * 272));
            const bf16x8 bfr = cat8(vtr(bp), vtr(bp + 8 * 144));
            acc = __builtin_amdgcn_mfma_f32_32x32x16_bf16(af, bfr, acc, 0, 0, 0);
        }
        float* up = UT + ((size_t)(bhq[q] * NCH + ccq[q]) * 128 + 32 * dvb) * 64 + 32 * dkb + r32;
#pragma unroll
        for (int r = 0; r < 16; ++r) up[crow(r, hi) * 64] = acc[r];
    }
    __syncthreads();
}
__device__ __forceinline__ void fox_cumsum_unit(LAS unsigned char* lds, const float* SM, const float* bforget, float* CK, int bh) {
    int tid_ = threadIdx.x; asm volatile("" : "+v"(tid_)); const int tid = tid_, lane = tid & 63, wid = tid >> 6;
    const int b = bh >> 3, h = bh & 7;
    const float bf_ = bforget[h];
    LAS float* WT_ = (LAS float*)lds;
    float mtot = 0.f, mine = 0.f;
    for (int p = 0; p < NMETA; ++p) { mtot += logsigmoidf(SM[(size_t)(META0 + p) * 32 + 16 + h] + bf_); if (tid == p) mine = mtot; }
    if (tid < 64) CK[(size_t)bh * CKP + tid] = tid < NMETA ? -LOG2E * mine : -INFINITY;
    float v[8]; float run = 0.f;
#pragma unroll
    for (int i = 0; i < 8; ++i) { run += logsigmoidf(SM[(size_t)(b * SEQ + 8 * tid + i) * 32 + 16 + h] + bf_); v[i] = run; }
    float inc = run;
#pragma unroll
    for (int o = 1; o < 64; o <<= 1) { const float t = __shfl_up(inc, o); if (lane >= o) inc += t; }
    if (lane == 63) WT_[wid] = inc;
    __syncthreads();
    float off = mtot + (inc - run);
    for (int w2 = 0; w2 < wid; ++w2) off += WT_[w2];
#pragma unroll
    for (int i = 0; i < 8; ++i) CK[(size_t)bh * CKP + 64 + 8 * tid + i] = -LOG2E * (off + v[i]);
    __syncthreads();
}

__device__ __forceinline__ void attn_unit(LAS unsigned char* lds, const bf16* QKV, const float* CK, bf16* OB, const float* fnorm, int b, int h, int qb) {
    int tid_ = threadIdx.x; asm volatile("" : "+v"(tid_)); const int tid = tid_, lane = tid & 63, wid = __builtin_amdgcn_readfirstlane(tid >> 6), r32 = lane & 31, hi = lane >> 5;
    constexpr int KB = 9216, KOFF = 0, VOFF = 2 * KB, COFF = 4 * KB, WOFF = COFF + 512;
    LAS float* wsf = (LAS float*)(lds + WOFF) + wid * 64;
    const size_t rowb = (size_t)b * SEQ; const int q0 = qb * 512;
    const int NT = 1 + 8 * (qb + 1);
    bf16x8 qr[2][4];
#pragma unroll
    for (int g = 0; g < 2; ++g) {
        const bf16* qp = QKV + (rowb + q0 + wid * 64 + g * 32 + r32) * QP + C_FQ + h * 64 + hi * 8;
#pragma unroll
        for (int d0 = 0; d0 < 4; ++d0) qr[g][d0] = *(const bf16x8*)(qp + d0 * 16);
    }
    const int srow = tid >> 3, sch = tid & 7;
    const float* ckp = CK + (size_t)(b * 8 + h) * CKP;
    u32x4 kreg, vreg; float creg = 0.f;
#define ATT_LOAD(t) do { const size_t r0_ = (t) == 0 ? (size_t)META0 : rowb + (size_t)((t) - 1) * 64; const bf16* p_ = QKV + (r0_ + srow) * QP + h * 64 + sch * 8; \
        kreg = *(const u32x4*)(p_ + C_FK); vreg = *(const u32x4*)(p_ + C_FV); if (tid < 64) creg = ckp[(t) * 64 + tid]; } while (0)
#define ATT_STORE(buf) do { *(LAS u32x4*)(lds + KOFF + (buf) * KB + srow * 144 + sch * 16) = kreg; *(LAS u32x4*)(lds + VOFF + (buf) * KB + (sch >> 2) * 4096 + (srow >> 3) * 512 + (srow & 7) * 64 + (sch & 3) * 16) = vreg; \
        if (tid < 64) *(LAS float*)(lds + COFF + (buf) * 256 + tid * 4) = creg; } while (0)
    float m[2] = {-1e30f, -1e30f}, l[2] = {0.f, 0.f}; f32x16 o0[2], o1[2];
    o0[0] = (f32x16){}; o0[1] = (f32x16){}; o1[0] = (f32x16){}; o1[1] = (f32x16){};
    const int qq = (lane & 15) >> 2, pp = lane & 3, half = (lane >> 4) & 1;
    ATT_LOAD(0); ATT_STORE(0);
    for (int t = 0; t < NT; ++t) {
        const int buf = t & 1;
        if (t + 1 < NT) ATT_LOAD(t + 1);
        __syncthreads();
        const int jb = t - (NT - 8);
        const bool skip = (jb >= 0) && (jb > wid);
        if (!skip) {
            const LAS unsigned char* Kb = lds + KOFF + buf * KB; const LAS unsigned char* Vb = lds + VOFF + buf * KB; const LAS float* Cb = (const LAS float*)(lds + COFF + buf * 256);
            f32x16 p0[2], p1[2], c0v, c1v;
#pragma unroll
            for (int g4 = 0; g4 < 4; ++g4) {
                const f32x4 c0 = *(const LAS f32x4*)(Cb + 8 * g4 + 4 * hi), c1 = *(const LAS f32x4*)(Cb + 32 + 8 * g4 + 4 * hi);
#pragma unroll
                for (int i = 0; i < 4; ++i) { c0v[4 * g4 + i] = c0[i]; c1v[4 * g4 + i] = c1[i]; }
            }
#pragma unroll
            for (int d0 = 0; d0 < 4; ++d0) {
                const bf16x8 a0 = *(const LAS bf16x8*)(Kb + r32 * 144 + (16 * d0 + 8 * hi) * 2);
                const bf16x8 a1 = *(const LAS bf16x8*)(Kb + (32 + r32) * 144 + (16 * d0 + 8 * hi) * 2);
                p0[0] = __builtin_amdgcn_mfma_f32_32x32x16_bf16(a0, qr[0][d0], d0 == 0 ? c0v : p0[0], 0, 0, 0);
                p0[1] = __builtin_amdgcn_mfma_f32_32x32x16_bf16(a0, qr[1][d0], d0 == 0 ? c0v : p0[1], 0, 0, 0);
                p1[0] = __builtin_amdgcn_mfma_f32_32x32x16_bf16(a1, qr[0][d0], d0 == 0 ? c1v : p1[0], 0, 0, 0);
                p1[1] = __builtin_amdgcn_mfma_f32_32x32x16_bf16(a1, qr[1][d0], d0 == 0 ? c1v : p1[1], 0, 0, 0);
            }
            bf16x8 pa[2][4];
#pragma unroll
            for (int g = 0; g < 2; ++g) {
                if (jb == wid) {
                    const int qrel = 32 * g + r32;
#pragma unroll
                    for (int r = 0; r < 16; ++r) { const int kv = crow(r, hi); if (kv > qrel) p0[g][r] = -INFINITY; if (kv + 32 > qrel) p1[g][r] = -INFINITY; }
                }
                float mxa = fmaxf(p0[g][0], p1[g][0]), mxb = fmaxf(p0[g][1], p1[g][1]);
#pragma unroll
                for (int r = 2; r < 16; r += 2) { mxa = fmaxf(fmaxf(mxa, p0[g][r]), p1[g][r]); mxb = fmaxf(fmaxf(mxb, p0[g][r + 1]), p1[g][r + 1]); }
                float mx = fmaxf(mxa, mxb);
                mx = fmaxf(mx, __shfl_xor(mx, 32));
                if (__any(mx > m[g] + 8.0f)) {
                    const float mn = fmaxf(m[g], mx);
                    const float alpha = __builtin_amdgcn_exp2f(m[g] - mn);
                    m[g] = mn; l[g] *= alpha;
                    if (hi == 0) wsf[g * 32 + r32] = alpha;
                    LDS_WAIT();
#pragma unroll
                    for (int g4 = 0; g4 < 4; ++g4) {
                        const f32x4 a = *(const LAS f32x4*)(wsf + g * 32 + 8 * g4 + 4 * hi);
#pragma unroll
                        for (int i = 0; i < 4; ++i) { o0[g][4 * g4 + i] *= a[i]; o1[g][4 * g4 + i] *= a[i]; }
                    }
                }
                float rsa = 0.f, rsb = 0.f, rsc = 0.f, rsd = 0.f;
#pragma unroll
                for (int r = 0; r < 16; r += 2) {
                    p0[g][r] = __builtin_amdgcn_exp2f(p0[g][r] - m[g]); p1[g][r] = __builtin_amdgcn_exp2f(p1[g][r] - m[g]);
                    p0[g][r + 1] = __builtin_amdgcn_exp2f(p0[g][r + 1] - m[g]); p1[g][r + 1] = __builtin_amdgcn_exp2f(p1[g][r + 1] - m[g]);
                    rsa += p0[g][r]; rsb += p1[g][r]; rsc += p0[g][r + 1]; rsd += p1[g][r + 1];
                }
                l[g] += (rsa + rsb) + (rsc + rsd);
                { u32x4 w;
                  w.x = pk2(p0[g][0], p0[g][1]); w.y = pk2(p0[g][2], p0[g][3]); w.z = pk2(p0[g][4], p0[g][5]); w.w = pk2(p0[g][6], p0[g][7]); pa[g][0] = __builtin_bit_cast(bf16x8, w);
                  w.x = pk2(p0[g][8], p0[g][9]); w.y = pk2(p0[g][10], p0[g][11]); w.z = pk2(p0[g][12], p0[g][13]); w.w = pk2(p0[g][14], p0[g][15]); pa[g][1] = __builtin_bit_cast(bf16x8, w);
                  w.x = pk2(p1[g][0], p1[g][1]); w.y = pk2(p1[g][2], p1[g][3]); w.z = pk2(p1[g][4], p1[g][5]); w.w = pk2(p1[g][6], p1[g][7]); pa[g][2] = __builtin_bit_cast(bf16x8, w);
                  w.x = pk2(p1[g][8], p1[g][9]); w.y = pk2(p1[g][10], p1[g][11]); w.z = pk2(p1[g][12], p1[g][13]); w.w = pk2(p1[g][14], p1[g][15]); pa[g][3] = __builtin_bit_cast(bf16x8, w); }
            }
#pragma unroll
            for (int j = 0; j < 4; ++j) {
                const LAS unsigned char* vp = Vb + (2 * j) * 512 + (4 * hi + qq) * 64 + 32 * half + 8 * pp;
                const bf16x8 v0 = cat8(vtr(vp), vtr(vp + 512));
                const bf16x8 v1 = cat8(vtr(vp + 4096), vtr(vp + 4096 + 512));
                o0[0] = __builtin_amdgcn_mfma_f32_32x32x16_bf16(pa[0][j], v0, o0[0], 0, 0, 0);
                o0[1] = __builtin_amdgcn_mfma_f32_32x32x16_bf16(pa[1][j], v0, o0[1], 0, 0, 0);
                o1[0] = __builtin_amdgcn_mfma_f32_32x32x16_bf16(pa[0][j], v1, o1[0], 0, 0, 0);
                o1[1] = __builtin_amdgcn_mfma_f32_32x32x16_bf16(pa[1][j], v1, o1[1], 0, 0, 0);
            }
        }
        if (t + 1 < NT) ATT_STORE(buf ^ 1);
    }
#undef ATT_LOAD
#undef ATT_STORE
    const float w0 = fnorm[h * 64 + r32], w1 = fnorm[h * 64 + 32 + r32];
#pragma unroll
    for (int g = 0; g < 2; ++g) {
        float lt = l[g]; lt += __shfl_xor(lt, 32);
        if (hi == 0) wsf[g * 32 + r32] = 1.0f / lt;
        LDS_WAIT();
#pragma unroll
        for (int g4 = 0; g4 < 4; ++g4) {
            const f32x4 a = *(const LAS f32x4*)(wsf + g * 32 + 8 * g4 + 4 * hi);
#pragma unroll
            for (int i = 0; i < 4; ++i) { o0[g][4 * g4 + i] *= a[i]; o1[g][4 * g4 + i] *= a[i]; }
        }
#pragma unroll
        for (int r = 0; r < 16; ++r) {
            float s = o0[g][r] * o0[g][r] + o1[g][r] * o1[g][r];
            s += __shfl_xor(s, 1); s += __shfl_xor(s, 2); s += __shfl_xor(s, 4); s += __shfl_xor(s, 8); s += __shfl_xor(s, 16);
            const float rs = rsqrtf(s * (1.0f / 64.0f) + EPS);
            bf16* op = OB + (rowb + q0 + wid * 64 + g * 32 + crow(r, hi)) * DM + 512 + h * 64 + r32;
            op[0] = f2bf(o0[g][r] * rs * w0); op[32] = f2bf(o1[g][r] * rs * w1);
        }
    }
    __syncthreads();
}
__device__ __forceinline__ void meta_attn(const bf16* QKV, const float* CK, bf16* OB, const float* fnorm, int p) {
    int tid_ = threadIdx.x; asm volatile("" : "+v"(tid_)); const int lane = tid_ & 63, h = tid_ >> 6;
    const float q = bf2f(QKV[(size_t)(META0 + p) * QP + C_FQ + h * 64 + lane]);
    float sc[NMETA], vv[NMETA];
#pragma unroll
    for (int s = 0; s < NMETA; ++s) {
        sc[s] = q * bf2f(QKV[(size_t)(META0 + s) * QP + C_FK + h * 64 + lane]);
        vv[s] = bf2f(QKV[(size_t)(META0 + s) * QP + C_FV + h * 64 + lane]);
    }
    float m = -1e30f;
#pragma unroll
    for (int s = 0; s < NMETA; ++s) { sc[s] = (s <= p) ? wave_sum(sc[s]) + CK[(size_t)h * CKP + s] : -INFINITY; m = fmaxf(m, sc[s]); }
    float l = 0.f, o = 0.f;
#pragma unroll
    for (int s = 0; s < NMETA; ++s) { const float pw = __builtin_amdgcn_exp2f(sc[s] - m); l += pw; o += pw * vv[s]; }
    o /= l;
    const float ss = wave_sum(o * o);
    OB[(size_t)(META0 + p) * DM + 512 + h * 64 + lane] = f2bf(o * rsqrtf(ss * (1.0f / 64.0f) + EPS) * fnorm[h * 64 + lane]);
}
template <int NU> __device__ __forceinline__ void gla_readout_wave(const bf16* QKV, const float* UT, bf16* OB, const float* gnorm, const int* bhs, const int* ccs, const int* halfs, int lane) {
    asm volatile("" : "+v"(lane));
    const int r32 = lane & 31, hi = lane >> 5;
    int row0[NU], nvalid[NU], hq[NU]; const float* Sp[NU];
    f32x16 acc[NU][4];
#pragma unroll
    for (int u = 0; u < NU; ++u) {
        const int b = bhs[u] >> 2; hq[u] = bhs[u] & 3;
        row0[u] = ccs[u] == 0 ? META0 : b * SEQ + (ccs[u] - 1) * 64 + 32 * halfs[u]; nvalid[u] = ccs[u] == 0 ? NMETA : 32;
        Sp[u] = UT + (size_t)(bhs[u] * NCH + ccs[u]) * 8192;
#pragma unroll
        for (int blk = 0; blk < 4; ++blk) acc[u][blk] = (f32x16){};
    }
#pragma unroll
    for (int j = 0; j < 4; ++j)
#pragma unroll
        for (int u = 0; u < NU; ++u) {
            const bf16x8 bq = *(const bf16x8*)(QKV + (size_t)(row0[u] + r32) * QP + C_GQ + hq[u] * 64 + 16 * j + 8 * hi);
#pragma unroll
            for (int blk = 0; blk < 4; ++blk) {
                const float* sp = Sp[u] + (32 * blk + r32) * 64 + 16 * j + 8 * hi;
                const f32x4 s0 = *(const f32x4*)sp, s1 = *(const f32x4*)(sp + 4);
                u32x4 w; w.x = pk2(s0[0], s0[1]); w.y = pk2(s0[2], s0[3]); w.z = pk2(s1[0], s1[1]); w.w = pk2(s1[2], s1[3]);
                acc[u][blk] = __builtin_amdgcn_mfma_f32_32x32x16_bf16(__builtin_bit_cast(bf16x8, w), bq, acc[u][blk], 0, 0, 0);
            }
        }
#pragma unroll
    for (int u = 0; u < NU; ++u) {
        float ss = 0.f;
#pragma unroll
        for (int blk = 0; blk < 4; ++blk)
#pragma unroll
            for (int r = 0; r < 16; ++r) ss += acc[u][blk][r] * acc[u][blk][r];
        ss += __shfl_xor(ss, 32);
        const float rs = rsqrtf(ss * (1.0f / 128.0f) + EPS);
        if (r32 < nvalid[u]) {
            const size_t row = (size_t)row0[u] + r32; const int h = hq[u];
#pragma unroll
            for (int blk = 0; blk < 4; ++blk)
#pragma unroll
                for (int g = 0; g < 4; ++g) {
                    const int dv = 32 * blk + 8 * g + 4 * hi;
                    const u32x2 gt = *(const u32x2*)(QKV + row * QP + C_GR + h * 128 + dv);
                    const f32x4 wn = *(const f32x4*)(gnorm + h * 128 + dv);
                    const float g0 = __uint_as_float(gt.x << 16), g1 = __uint_as_float(gt.x & 0xffff0000u), g2 = __uint_as_float(gt.y << 16), g3 = __uint_as_float(gt.y & 0xffff0000u);
                    u32x2 w;
                    w.x = pk2(acc[u][blk][4 * g] * rs * wn[0] * siluf(g0), acc[u][blk][4 * g + 1] * rs * wn[1] * siluf(g1));
                    w.y = pk2(acc[u][blk][4 * g + 2] * rs * wn[2] * siluf(g2), acc[u][blk][4 * g + 3] * rs * wn[3] * siluf(g3));
                    *(u32x2*)(OB + row * DM + h * 128 + dv) = w;
                }
        }
    }
}

__device__ __forceinline__ void gla_readout_chunk(const bf16* QKV, const float* UT, bf16* OB, const float* gnorm, int bh, int cc, int lane) {
    asm volatile("" : "+v"(lane));
    const int r32 = lane & 31, hi = lane >> 5, b = bh >> 2, h = bh & 3;
    const int row0 = b * SEQ + (cc - 1) * 64;
    const float* Sp = UT + (size_t)(bh * NCH + cc) * 8192;
    f32x16 acc[2][4];
#pragma unroll
    for (int u = 0; u < 2; ++u)
#pragma unroll
        for (int blk = 0; blk < 4; ++blk) acc[u][blk] = (f32x16){};
#pragma unroll 1
    for (int j = 0; j < 4; ++j) {
        const bf16x8 bq0 = *(const bf16x8*)(QKV + (size_t)(row0 + r32) * QP + C_GQ + h * 64 + 16 * j + 8 * hi);
        const bf16x8 bq1 = *(const bf16x8*)(QKV + (size_t)(row0 + 32 + r32) * QP + C_GQ + h * 64 + 16 * j + 8 * hi);
#pragma unroll
        for (int blk = 0; blk < 4; ++blk) {
            const float* sp = Sp + (32 * blk + r32) * 64 + 16 * j + 8 * hi;
            const f32x4 s0 = *(const f32x4*)sp, s1 = *(const f32x4*)(sp + 4);
            u32x4 w; w.x = pk2(s0[0], s0[1]); w.y = pk2(s0[2], s0[3]); w.z = pk2(s1[0], s1[1]); w.w = pk2(s1[2], s1[3]);
            const bf16x8 sa = __builtin_bit_cast(bf16x8, w);
            acc[0][blk] = __builtin_amdgcn_mfma_f32_32x32x16_bf16(sa, bq0, acc[0][blk], 0, 0, 0);
            acc[1][blk] = __builtin_amdgcn_mfma_f32_32x32x16_bf16(sa, bq1, acc[1][blk], 0, 0, 0);
        }
    }
#pragma unroll
    for (int u = 0; u < 2; ++u) {
        float ss = 0.f;
#pragma unroll
        for (int blk = 0; blk < 4; ++blk)
#pragma unroll
            for (int r = 0; r < 16; ++r) ss += acc[u][blk][r] * acc[u][blk][r];
        ss += __shfl_xor(ss, 32);
        const float rs = rsqrtf(ss * (1.0f / 128.0f) + EPS);
        const size_t row = (size_t)row0 + 32 * u + r32;
#pragma unroll
        for (int blk = 0; blk < 4; ++blk)
#pragma unroll
            for (int g = 0; g < 4; ++g) {
                const int dv = 32 * blk + 8 * g + 4 * hi;
                const u32x2 gt = *(const u32x2*)(QKV + row * QP + C_GR + h * 128 + dv);
                const f32x4 wn = *(const f32x4*)(gnorm + h * 128 + dv);
                const float g0 = __uint_as_float(gt.x << 16), g1 = __uint_as_float(gt.x & 0xffff0000u), g2 = __uint_as_float(gt.y << 16), g3 = __uint_as_float(gt.y & 0xffff0000u);
                u32x2 w;
                w.x = pk2(acc[u][blk][4 * g] * rs * wn[0] * siluf(g0), acc[u][blk][4 * g + 1] * rs * wn[1] * siluf(g1));
                w.y = pk2(acc[u][blk][4 * g + 2] * rs * wn[2] * siluf(g2), acc[u][blk][4 * g + 3] * rs * wn[3] * siluf(g3));
                *(u32x2*)(OB + row * DM + h * 128 + dv) = w;
            }
    }
}

#define FRESH() KArgs ka_ = kargs(); Args a; a.x = gptr(ka_->x); a.meta = gptr(ka_->meta); a.attn_norm = gptr(ka_->attn_norm); a.w_in = gptr(ka_->w_in); a.w_au = gptr(ka_->w_au); a.b_alpha = gptr(ka_->b_alpha); a.b_forget = gptr(ka_->b_forget); a.gla_norm = gptr(ka_->gla_norm); a.fox_norm = gptr(ka_->fox_norm); a.w_out = gptr(ka_->w_out); a.ffn_norm = gptr(ka_->ffn_norm); a.w_up = gptr(ka_->w_up); a.conv_w = gptr(ka_->conv_w); a.conv_b = gptr(ka_->conv_b); a.w_down = gptr(ka_->w_down); a.final_norm = gptr(ka_->final_norm); a.out = gptr(ka_->out); a.ws = gptr(ka_->ws); unsigned char* ws = a.ws; \
    bf16* HB = (bf16*)(ws + WS_HB); bf16* OB = (bf16*)(ws + WS_OB); bf16* QKV = (bf16*)(ws + WS_QKV); bf16* A2 = (bf16*)(ws + WS_QKV); \
    float* UT = (float*)(ws + WS_UT); float* HF = (float*)(ws + WS_UT); float* HL = (float*)(ws + WS_UT + HFL_SIZE); \
    float* SM = (float*)(ws + WS_SM); float* CK = (float*)(ws + WS_CK); float* DEC = (float*)(ws + WS_DEC); float* HM = (float*)(ws + WS_HM); float* SSQ = (float*)(ws + WS_SSQ); \
    unsigned char* wl = ws + WS_W + (size_t)L * WL_SIZE; \
    (void)HB; (void)OB; (void)QKV; (void)A2; (void)UT; (void)HF; (void)HL; (void)SM; (void)CK; (void)DEC; (void)HM; (void)SSQ; (void)wl; \
    int G_ = gridDim.x, bx_ = blockIdx.x; asm volatile("" : "+s"(G_), "+s"(bx_)); const int G = G_, bx = bx_; (void)G; (void)bx; \
    int tid_ = threadIdx.x; asm volatile("" : "+v"(tid_)); const int tid = tid_, lane = tid & 63, wid = __builtin_amdgcn_readfirstlane(tid >> 6); \
    const int gw = bx * 8 + wid, NGW = G * 8, gt = bx * 512 + tid, NGT = G * 512; (void)lane; (void)gw; (void)NGW; (void)gt; (void)NGT;
#ifndef REP_A
#define REP_A 1
#endif
#ifndef REP_CA
#define REP_CA 1
#endif
#ifndef REP_F
#define REP_F 1
#endif
#ifndef REP_B
#define REP_B 1
#endif
#ifndef REP_D
#define REP_D 1
#endif
#define GSYNC_CG() do { asm volatile("s_waitcnt vmcnt(0) lgkmcnt(0)" ::: "memory"); grid.sync(); __builtin_amdgcn_fence(__ATOMIC_ACQUIRE, "agent"); asm volatile("s_waitcnt vmcnt(0)" ::: "memory"); } while (0)
#ifdef PROBE_PH
#define PH_END(id) do { const unsigned long long tn_ = __builtin_amdgcn_s_memrealtime(); if ((PROBE_PH >> (id)) & 1) tsync += tn_ - tlast; tlast = tn_; } while (0)
#else
#define PH_END(id) do {} while (0)
#endif
#ifdef PROBE_SYNC
#define GSYNC() do { const unsigned long long t0_ = __builtin_amdgcn_s_memrealtime(); xcd_barrier(xbar); tsync += __builtin_amdgcn_s_memrealtime() - t0_; } while (0)
#else
#define GSYNC() do { XcdBarrier xb_; xb_.bar = (unsigned*)(gptr(kargs()->ws) + WS_BAR); xb_.x = xb_xcc_id(); xb_.st = (volatile LAS unsigned*)(lds + HALO_OFF + 8192 + 1024); xcd_barrier(xb_); } while (0)
#endif
__global__ void __launch_bounds__(512, 2) fwd_kernel(Args a_unused) {
    extern __shared__ __attribute__((aligned(16))) unsigned char lds_raw[];
    LAS unsigned char* lds = (LAS unsigned char*)lds_raw;
    cg::grid_group grid = cg::this_grid();
#if defined(PROBE_SYNC) || defined(PROBE_PH)
    unsigned long long tsync = 0ull, tlast = __builtin_amdgcn_s_memrealtime(); (void)tlast;
#endif
    volatile LAS unsigned* xst = (volatile LAS unsigned*)(lds + HALO_OFF + 8192 + 1024);
    if (threadIdx.x < 2) xst[threadIdx.x] = 0u;
    __syncthreads();
    (void)xcd_barrier_post((unsigned*)(gptr(kargs()->ws) + WS_BAR), xst);
#ifndef REP_P
#define REP_P 1
#endif
    for (int rep = 0; rep < REP_P; ++rep) {
        const int L = 0; FRESH();
        LAS float* scr = (LAS float*)(lds + wid * 16384);
        constexpr int I_IN = 16 * (NINP / 32), I_OUT = 16 * 32, I_UP = 16 * (NUP / 32), I_DN = (DFF / 64) * 32, I_L = I_IN + I_OUT + I_UP + I_DN;
        for (int it = gw; it < DEPTH * I_L; it += NGW) {
            const int L = it / I_L; int r = it % I_L;
            unsigned char* wl = ws + WS_W + (size_t)L * WL_SIZE;
            if (r < I_IN) { const int nb = NINP / 32; tr_item(a.w_in + (size_t)L * DM * 3096, 3096, (bf16*)(wl + WL_IN), DM, a.attn_norm + L * DM, 0, scr, 64 * (r / nb), 32 * (r % nb), lane); continue; } r -= I_IN;
            if (r < I_OUT) { tr_item(a.w_out + (size_t)L * DM * DM, DM, (bf16*)(wl + WL_OUT), DM, nullptr, 1, scr, 64 * (r / 32), 32 * (r % 32), lane); continue; } r -= I_OUT;
            if (r < I_UP) { const int nb = NUP / 32; tr_item(a.w_up + (size_t)L * DM * NUP, NUP, (bf16*)(wl + WL_UP), DM, a.ffn_norm + L * DM, 2, scr, 64 * (r / nb), 32 * (r % nb), lane); continue; } r -= I_UP;
            tr_item(a.w_down + (size_t)L * DFF * DM, DM, (bf16*)(wl + WL_DN), DFF, nullptr, 3, scr, 64 * (r / 32), 32 * (r % 32), lane);
        }
        for (int i = gt; i < (256 - NMETA) * 4; i += NGT) SSQ[(size_t)(META0 + NMETA) * 4 + i] = 0.f;
        for (int r = gw; r < MREAL + 256; r += NGW) {
            if (r < MREAL) row_to_bf16(a.x + (size_t)r * DM, HB + (size_t)r * DM, SSQ + (size_t)r * 4, nullptr, lane);
            else if (r < MREAL + NMETA) row_to_bf16(a.meta + (size_t)(r - MREAL) * DM, HB + (size_t)r * DM, SSQ + (size_t)r * 4, HM + (size_t)(r - MREAL) * DM, lane);
            else {
#pragma unroll
                for (int j = 0; j < 4; ++j) { ((f32x4*)(HM + (size_t)(r - MREAL) * DM) + lane)[64 * j] = (f32x4){0.f, 0.f, 0.f, 0.f};
                    ((u32x2*)(HB + (size_t)r * DM) + lane)[64 * j] = (u32x2){0u, 0u}; ((u32x2*)(OB + (size_t)r * DM) + lane)[64 * j] = (u32x2){0u, 0u}; }
            }
        }
    }
    GSYNC_CG(); PH_END(0);

    for (int L = 0; L < DEPTH; ++L) {
#ifndef SKIP_A
        {
            FRESH();
            pg8::Gemm g{HB, (const bf16*)(wl + WL_IN), MROWS, NINP, DM}; pg8::StaticOrder S; S.init(MROWS, NINP, G, bx);
            EpiIn E{2 * L};
            for (int rep = 0; rep < REP_A; ++rep) pg8::gemm_phase<EpiIn, pg8::StaticOrder, true, true>(lds, g, S, E);
        }
#endif
        GSYNC(); PH_END(1);
#ifndef SKIP_B
        { FRESH();
        for (int rep = 0; rep < REP_B; ++rep) {
        for (int gr = bx; gr < 16 * NCH; gr += G) gla_u_group<2>(lds, QKV, SM, a.w_au + (size_t)L * 16 * 256, a.b_alpha + L * 256, UT, DEC, gr);
        for (int u = (G == 256) ? bx - 64 + ((bx < 64) ? 256 : 0) : bx; u < 64; u += G) fox_cumsum_unit(lds, SM, a.b_forget + L * 8, CK, u);
        }
        }
#endif
        GSYNC(); PH_END(2);
#ifndef SKIP_CS
        { FRESH();
        for (int e = gt; e < 32 * 2048; e += NGT) {
            const int bh = e >> 11, rem = (e & 2047) * 4, dk = rem & 63;
            float* up = UT + (size_t)bh * NCH * 8192 + rem; const float* dp = DEC + (size_t)bh * NCH * 64 + dk;
            f32x4 Sv = *(const f32x4*)up;
            for (int c0 = 1; c0 <= 64; c0 += 8) {
                f32x4 uu[8], dd[8];
#pragma unroll
                for (int i = 0; i < 8; ++i) { uu[i] = *(const f32x4*)(up + (size_t)(c0 + i) * 8192); dd[i] = *(const f32x4*)(dp + (c0 + i) * 64); }
#pragma unroll
                for (int i = 0; i < 8; ++i) { Sv = dd[i] * Sv + uu[i]; *(f32x4*)(up + (size_t)(c0 + i) * 8192) = Sv; }
            }
        }
#ifdef REP_SCAN
        for (int e = gt; e < 32 * 2048; e += NGT) {
            const int bh = e >> 11, rem = (e & 2047) * 4, dk = rem & 63;
            float* up = UT + (size_t)bh * NCH * 8192 + rem; const float* dp = DEC + (size_t)bh * NCH * 64 + dk;
            for (int c0 = 1; c0 <= 64; c0 += 8) {
                f32x4 uu[8], dd[8];
#pragma unroll
                for (int i = 0; i < 8; ++i) { uu[i] = *(const f32x4*)(up + (size_t)(c0 + i) * 8192); dd[i] = *(const f32x4*)(dp + (c0 + i) * 64); }
#pragma unroll
                for (int i = 0; i < 8; ++i) { *(f32x4*)(up + (size_t)(c0 + i) * 8192) = uu[i] + dd[i] * 0.f; }
            }
        }
#endif
        }
        { FRESH();
        for (int rep = 0; rep < REP_CA; ++rep)
        for (int v0 = bx; v0 < 256; v0 += G) {
            const int v = (G == 256) ? (v0 & 7) * 32 + (v0 >> 3) : v0;
            const int bhh = v >> 2, s = v & 3;
#pragma unroll 1
            for (int i = 0; i < 2; ++i) {
                const int qb = (i == 0) ? s : 7 - s;
                attn_unit(lds, QKV, CK, OB, a.fox_norm + L * 512, bhh >> 3, bhh & 7, qb);
            }
        }
#endif
#ifndef SKIP_CM
        }
        { FRESH();
#ifndef REP_CM
#define REP_CM 1
#endif
        for (int rep = 0; rep < REP_CM; ++rep)
        if (bx < NMETA) meta_attn(QKV, CK, OB, a.fox_norm + L * 512, bx);
        if (bx >= NMETA && bx < NMETA + 4 && wid == 0) { const int bhs[1] = {bx - NMETA}, ccs[1] = {0}, hfs[1] = {0}; gla_readout_wave<1>(QKV, UT, OB, a.gla_norm + L * 512, bhs, ccs, hfs, lane); }
        }
#endif
        GSYNC(); PH_END(3);
#ifndef SKIP_D
        { FRESH();
        for (int rep = 0; rep < REP_D; ++rep)
        for (int wu = gw; wu < 32 * 64; wu += NGW) gla_readout_chunk(QKV, UT, OB, a.gla_norm + L * 512, wu >> 6, 1 + (wu & 63), lane);
        }
#endif
        GSYNC(); PH_END(4);
#ifndef SKIP_E
        {
            FRESH();
            meta_rowgemm(OB + (size_t)META0 * DM, DM, (const bf16*)(wl + WL_OUT), DM, HM, HB, G, bx);
            pg8::Gemm g{OB, (const bf16*)(wl + WL_OUT), MREAL, DM, DM}; pg8::StaticOrder S; S.init(MREAL, DM, G, bx);
            if (L == 0) { EpiRes<true, false> E{2 * L + 1}; pg8::gemm_phase<EpiRes<true, false>, pg8::StaticOrder, true, true>(lds, g, S, E); }
            else { EpiRes<false, false> E{2 * L + 1}; pg8::gemm_phase<EpiRes<false, false>, pg8::StaticOrder, true, true>(lds, g, S, E); }
        }
#endif
        GSYNC(); PH_END(5);
#ifndef SKIP_F
        {
            FRESH();
            meta_up(lds, HB, (const bf16*)(wl + WL_UP), HM, a.conv_w + (size_t)L * 3 * NUP, a.conv_b + (size_t)L * NUP, A2, HL, G, bx);
            pg8::Gemm g{HB, (const bf16*)(wl + WL_UP), MREAL, NUP, DM}; pg8::StaticOrder S; S.init(MREAL, NUP, G, bx);
            EpiUp E{L};
            for (int rep = 0; rep < REP_F; ++rep) pg8::gemm_phase<EpiUp, pg8::StaticOrder, true, true>(lds, g, S, E);
        }
#endif
        GSYNC(); PH_END(6);
#ifndef SKIP_H
        {
            FRESH();
            const float* cw = a.conv_w + (size_t)L * 3 * NUP; const float* cb = a.conv_b + (size_t)L * NUP;
            { int pm = 0;
              for (int ui = 0; so_next_pm(MREAL / 256, DM / 256, G, bx, ui, pm); ++ui) {
                for (int i = tid; i < 2 * (DFF / 4); i += 512) {
                    const int c4 = i % (DFF / 4), rr = i / (DFF / 4);
                    const int ch = 4 * c4;
                    f32x4 hc[2];
#pragma unroll
                    for (int bj = 0; bj < 2; ++bj) {
                        const int c = bj * DFF + ch;
                        f32x4 P0 = {0.f, 0.f, 0.f, 0.f}, P1 = P0;
                        if (pm != 128) { const int src = (pm % 16 == 0) ? 128 : pm - 1; P0 = *(const f32x4*)(HL + (size_t)(src * 2) * NUP + c); P1 = *(const f32x4*)(HL + (size_t)(src * 2 + 1) * NUP + c); }
                        const f32x4 H0 = *(const f32x4*)(HF + (size_t)(pm * 2) * NUP + c), H1 = *(const f32x4*)(HF + (size_t)(pm * 2 + 1) * NUP + c);
                        const f32x4 x2 = rr == 0 ? P0 : P1, x1 = rr == 0 ? P1 : H0, x0 = rr == 0 ? H0 : H1;
                        hc[bj] = *(const f32x4*)(cb + c) + *(const f32x4*)(cw + c) * x2 + *(const f32x4*)(cw + NUP + c) * x1 + *(const f32x4*)(cw + 2 * NUP + c) * x0;
                    }
                    u32x2 w;
                    w.x = pk2(siluf(hc[1][0]) * hc[0][0], siluf(hc[1][1]) * hc[0][1]);
                    w.y = pk2(siluf(hc[1][2]) * hc[0][2], siluf(hc[1][3]) * hc[0][3]);
                    *(u32x2*)(A2 + (size_t)(pm * 256 + rr) * DFF + ch) = w;
                }
              }
            }
            asm volatile("s_waitcnt vmcnt(0)" ::: "memory"); __syncthreads();
            meta_rowgemm(A2 + (size_t)META0 * DFF, DFF, (const bf16*)(wl + WL_DN), DFF, HM, HB, G, bx);
            pg8::Gemm g{A2, (const bf16*)(wl + WL_DN), MREAL, DM, DFF}; pg8::StaticOrder S; S.init(MREAL, DM, G, bx);
            if (L == DEPTH - 1) { EpiRes<false, true> E{2 * L + 2}; pg8::gemm_phase<EpiRes<false, true>, pg8::StaticOrder, true, true>(lds, g, S, E); }
            else { EpiRes<false, false> E{2 * L + 2}; pg8::gemm_phase<EpiRes<false, false>, pg8::StaticOrder, true, true>(lds, g, S, E); }
        }
#endif
        GSYNC(); PH_END(7);
    }
    {
        const int L = 0; FRESH();
        const float* ssq = ssq_arr(ws, 8);
        for (int r = gw; r < MREAL; r += NGW) {
            const float rs = row_rstd(ssq, r);
            f32x4* p = (f32x4*)(a.out + (size_t)r * DM) + lane; const f32x4* wn = (const f32x4*)a.final_norm + lane;
#pragma unroll
            for (int j = 0; j < 4; ++j) p[64 * j] = p[64 * j] * rs * wn[64 * j];
        }
#if defined(PROBE_SYNC) || defined(PROBE_PH)
        asm volatile("s_waitcnt vmcnt(0)" ::: "memory"); __syncthreads();
        if (bx == PROBE_BLOCK && tid == 0) a.out[(size_t)PROBE_BLOCK * 16 * DM * 0 + 5] += floorf((float)tsync * 0.0002f + 0.5f);
#endif
    }
}

extern "C" void kernel_launch(void* const* d_in, const int* in_sizes, int n_in, void* d_out, int out_size, void* d_ws, size_t ws_size, hipStream_t stream) {
    static int grid = 0;
    if (grid == 0) {
        if (n_in != 16 || out_size != MREAL * DM || ws_size < WS_END) { fprintf(stderr, "kernel_launch: unexpected problem (n_in %d out %d ws %zu, need %zu)\n", n_in, out_size, ws_size, (size_t)WS_END); grid = -1; return; }
        int dev = 0, cus = 0, per = 0;
        (void)hipGetDevice(&dev); (void)hipDeviceGetAttribute(&cus, hipDeviceAttributeMultiprocessorCount, dev);
        (void)hipFuncSetAttribute((const void*)fwd_kernel, hipFuncAttributeMaxDynamicSharedMemorySize, LDS_BYTES);
        (void)hipOccupancyMaxActiveBlocksPerMultiprocessor(&per, (const void*)fwd_kernel, 512, LDS_BYTES);
        if (per < 1) per = 1;
        grid = cus * per;
        fprintf(stderr, "kernel_launch: grid %d (cus %d x %d), ws %zu\n", grid, cus, per, ws_size);
    }
    if (grid < 0) return;
    Args a{};
    const float** f = (const float**)&a;
    for (int i = 0; i < 16; ++i) f[i] = (const float*)d_in[i];
    a.out = (float*)d_out; a.ws = (unsigned char*)d_ws;
    (void)hipMemsetAsync((unsigned char*)d_ws + WS_BAR, 0, BAR_BYTES, stream);
    void* args[] = {&a};
    hipError_t e = hipLaunchCooperativeKernel((const void*)fwd_kernel, dim3(grid), dim3(512), args, LDS_BYTES, stream);
    if (e != hipSuccess) fprintf(stderr, "cooperative launch failed: %s (grid %d)\n", hipGetErrorString(e), grid);
}
```

```cpp
#include <hip/hip_runtime.h>
#include <hip/hip_cooperative_groups.h>
#include <cstdio>
#include <cstdint>
namespace cg = cooperative_groups;
namespace pg8 {
#define PG8_LAS __attribute__((address_space(3)))
typedef unsigned short bf16_t;
typedef short bf16x8 __attribute__((ext_vector_type(8)));
typedef float f32x4 __attribute__((ext_vector_type(4)));
typedef unsigned u32x4 __attribute__((ext_vector_type(4)));
constexpr int BM = 256, BK = 64, HALF = 128, HTB = HALF * BK * 2  , STAGE_BYTES = 8 * HTB, NXCD = 8, WGM = 8;

__host__ __device__ __forceinline__ int lds_byte(int r, int c) { const int st = (r >> 4) * 2 + (c >> 5), rr = r & 15, cc = c & 31, ob = rr * 64 + cc * 2; return st * 1024 + (ob ^ (((ob >> 9) & 1) << 5)); }
__host__ __device__ __forceinline__ void stage_rc(int b, int& R, int& C) { const int st = b / 1024, sb = b % 1024, swz = sb ^ (((sb >> 9) & 1) << 5); R = (st >> 1) * 16 + swz / 64; C = (st & 1) * 32 + (swz % 64) / 2; }
__host__ __device__ __forceinline__ int perm32(int rho) { const int n = rho >> 4, i = rho & 15; return 8 * (i >> 2) + 4 * n + (i & 3); }

struct Unit { int pm, pn; };
struct Gemm { const bf16_t* A; const bf16_t* Bt; int M, N, K; };

struct StaticOrder {
    int nM, nN, nwg, G, c;
    __host__ __device__ void init(int M, int N, int G_, int c_) { nM = M / BM; nN = N / BM; nwg = nM * nN; G = G_; c = c_; }
    __host__ __device__ bool next(int i, Unit& u) const {
        const long L = (long)i * G + c; if (L >= nwg) return false;
        int wgid = (int)L; { const int q = nwg / NXCD, r = nwg % NXCD, xcd = wgid % NXCD, off = wgid / NXCD; wgid = (xcd < r ? xcd * (q + 1) : r * (q + 1) + (xcd - r) * q) + off; }
        const int nig = WGM * nN, gid = wgid / nig, fm = gid * WGM, gsz = (nM - fm) < WGM ? (nM - fm) : WGM;
        u.pm = fm + ((wgid % nig) % gsz); u.pn = (wgid % nig) / gsz; return true;
    }
    __device__ __forceinline__ void a_ready(const Unit&) const {}
    __device__ __forceinline__ void done(const Unit&) const {}
};

__device__ __forceinline__ unsigned cvt_pk_bf16(float lo, float hi) { unsigned r; asm volatile("v_cvt_pk_bf16_f32 %0, %1, %2" : "=v"(r) : "v"(lo), "v"(hi)); return r; }
typedef float f32x2 __attribute__((ext_vector_type(2)));
template <class Epi, class Sched, bool ALIGN_EPI = false, bool SP2 = false>
__device__ __forceinline__ void gemm_phase(PG8_LAS unsigned char* lds, const Gemm g, const Sched& S, const Epi& E) {
    int tid_ = threadIdx.x; asm volatile("" : "+v"(tid_)); const int tid = tid_, wid = __builtin_amdgcn_readfirstlane(tid >> 6), lane = tid & 63, wr = wid >> 2, wc = wid & 3, fr = lane & 15, fq = lane >> 4;
    const int K = g.K, nt = K / BK;
    unsigned voffA[2], voffB[2];
#pragma unroll
    for (int i = 0; i < 2; ++i) { int R, C; stage_rc(tid * 16 + i * 8192, R, C); const int Rb = Epi::PERM ? ((R & ~31) + perm32(R & 31)) : R;
        voffA[i] = (unsigned)(R * K + C) * 2u; voffB[i] = (unsigned)(Rb * K + C) * 2u; }
    const size_t kstep = (size_t)(BK * 2);
    const size_t hstep = (size_t)HALF * K * 2;
    const size_t tstep = 2 * hstep;
    const unsigned ldsw = (unsigned)wid * 1024u;
    const int aoff = lds_byte(wr * 64 + fr, fq * 8), boff = lds_byte(wc * 32 + fr, fq * 8);
#define PG8_SA(b, h) (((b) * 2 + (h)) * HTB)
#define PG8_SB(b, h) ((4 + (b) * 2 + (h)) * HTB)
#define PG8_STAGE(bufoff, gbase, voff) do { _Pragma("unroll") for (int _i = 0; _i < 2; ++_i) \
        __builtin_amdgcn_global_load_lds((const unsigned*)((const char*)(gbase) + (voff)[_i]), (PG8_LAS unsigned*)(lds + (bufoff) + ldsw + _i * 8192), 16, 0, 0); } while (0)
#define PG8_LDA(dst, b, h) do { _Pragma("unroll") for (int m = 0; m < 4; ++m) _Pragma("unroll") for (int k = 0; k < 2; ++k) dst[m][k] = *(const PG8_LAS bf16x8*)(lds + PG8_SA(b, h) + aoff + m * 2048 + k * 1024); } while (0)
#define PG8_LDB(dst, b, h) do { _Pragma("unroll") for (int n = 0; n < 2; ++n) _Pragma("unroll") for (int k = 0; k < 2; ++k) dst[n][k] = *(const PG8_LAS bf16x8*)(lds + PG8_SB(b, h) + boff + n * 2048 + k * 1024); } while (0)
#define PG8_MMA(ai, bj, At, Bt) do { __builtin_amdgcn_s_setprio(1); _Pragma("unroll") for (int m = 0; m < 4; ++m) _Pragma("unroll") for (int n = 0; n < 2; ++n) _Pragma("unroll") for (int k = 0; k < 2; ++k) \
        acc[ai][bj][m][n] = __builtin_amdgcn_mfma_f32_16x16x32_bf16(Bt[n][k], At[m][k], acc[ai][bj][m][n], 0, 0, 0); __builtin_amdgcn_s_setprio(0); } while (0)
#define PG8_WAIT_V(n) asm volatile("s_waitcnt vmcnt(" #n ")" ::: "memory")
#define PG8_WAIT_L(n) asm volatile("s_waitcnt lgkmcnt(" #n ")" ::: "memory")
#define PG8_BAR __builtin_amdgcn_s_barrier()
#define PG8_SCHED __builtin_amdgcn_sched_barrier(0)
    Unit cur, nxt; int ui = 0;
    if (!S.next(0, cur)) return;
    f32x4 acc[2][2][4][2];
#pragma unroll
    for (int a = 0; a < 2; ++a)
#pragma unroll
        for (int b = 0; b < 2; ++b)
#pragma unroll
            for (int m = 0; m < 4; ++m)
#pragma unroll
                for (int n = 0; n < 2; ++n) acc[a][b][m][n] = (f32x4){0.f, 0.f, 0.f, 0.f};
    bf16x8 At[4][2], B0[2][2], B1[2][2];
    const char* cA = (const char*)g.A + (size_t)cur.pm * tstep; const char* cB = (const char*)g.Bt + (size_t)cur.pn * tstep;
    S.a_ready(cur);
    if constexpr (SP2) {
        PG8_STAGE(PG8_SB(0, 0), cB, voffB); PG8_STAGE(PG8_SB(0, 1), cB + hstep, voffB); PG8_STAGE(PG8_SA(0, 0), cA, voffA); PG8_STAGE(PG8_SA(0, 1), cA + hstep, voffA);
        if (wr == 1) PG8_BAR;
        PG8_WAIT_V(2); PG8_BAR;
        PG8_STAGE(PG8_SB(1, 0), cB + kstep, voffB); PG8_STAGE(PG8_SA(1, 0), cA + kstep, voffA); PG8_STAGE(PG8_SB(1, 1), cB + hstep + kstep, voffB);
        PG8_WAIT_V(6); PG8_BAR;
    } else {
        PG8_STAGE(PG8_SB(0, 0), cB, voffB); PG8_STAGE(PG8_SA(0, 0), cA, voffA); PG8_STAGE(PG8_SB(0, 1), cB + hstep, voffB); PG8_STAGE(PG8_SA(0, 1), cA + hstep, voffA);
        if (wr == 1) PG8_BAR;
        PG8_WAIT_V(4); PG8_BAR;
        PG8_STAGE(PG8_SB(1, 0), cB + kstep, voffB); PG8_STAGE(PG8_SA(1, 0), cA + kstep, voffA); PG8_STAGE(PG8_SB(1, 1), cB + hstep + kstep, voffB);
        PG8_WAIT_V(6); PG8_BAR;
    }
    for (;;) {
        const bool has_next = S.next(ui + 1, nxt);
        const char* nA = has_next ? (const char*)g.A + (size_t)nxt.pm * tstep : cA; const char* nB = has_next ? (const char*)g.Bt + (size_t)nxt.pn * tstep : cB;
        for (int t = 0; t < nt; t += 2) {
            const bool last = (t == nt - 2);
            const char* a1 = cA + (size_t)(t + 1) * kstep;
            const char* a2 = last ? nA : cA + (size_t)(t + 2) * kstep; const char* b2 = last ? nB : cB + (size_t)(t + 2) * kstep;
            const char* a3 = a2 + kstep; const char* b3 = b2 + kstep;
            if (last && has_next) S.a_ready(nxt);
            if constexpr (SP2) {
            PG8_LDB(B0, 0, 0); PG8_LDB(B1, 0, 1); PG8_SCHED; PG8_LDA(At, 0, 0); PG8_STAGE(PG8_SA(1, 1), a1 + hstep, voffA);
            PG8_WAIT_V(8); PG8_WAIT_L(0); PG8_BAR; PG8_MMA(0, 0, At, B0); PG8_MMA(0, 1, At, B1); PG8_BAR; PG8_SCHED;
            PG8_LDA(At, 0, 1); PG8_STAGE(PG8_SB(0, 0), b2, voffB); PG8_STAGE(PG8_SB(0, 1), b2 + hstep, voffB); PG8_STAGE(PG8_SA(0, 0), a2, voffA);
            PG8_WAIT_V(8); PG8_WAIT_L(0); PG8_BAR; PG8_MMA(1, 0, At, B0); PG8_MMA(1, 1, At, B1); PG8_BAR; PG8_SCHED;
            PG8_LDB(B0, 1, 0); PG8_LDB(B1, 1, 1); PG8_SCHED; PG8_LDA(At, 1, 0); PG8_STAGE(PG8_SA(0, 1), a2 + hstep, voffA);
            PG8_WAIT_V(8); PG8_WAIT_L(0); PG8_BAR; PG8_MMA(0, 0, At, B0); PG8_MMA(0, 1, At, B1); PG8_BAR; PG8_SCHED;
            PG8_LDA(At, 1, 1); PG8_STAGE(PG8_SB(1, 0), b3, voffB); PG8_STAGE(PG8_SB(1, 1), b3 + hstep, voffB); PG8_STAGE(PG8_SA(1, 0), a3, voffA);
            PG8_WAIT_V(8); PG8_WAIT_L(0); PG8_BAR; PG8_MMA(1, 0, At, B0); PG8_MMA(1, 1, At, B1); PG8_BAR; PG8_SCHED;
            } else {
            PG8_LDB(B0, 0, 0); PG8_SCHED; PG8_LDA(At, 0, 0); PG8_STAGE(PG8_SA(1, 1), a1 + hstep, voffA);
            PG8_WAIT_L(8); PG8_BAR; PG8_WAIT_L(0); PG8_MMA(0, 0, At, B0); PG8_BAR; PG8_SCHED;
            PG8_LDB(B1, 0, 1); PG8_STAGE(PG8_SB(0, 0), b2, voffB);
            PG8_BAR; PG8_WAIT_L(0); PG8_MMA(0, 1, At, B1); PG8_BAR;
            PG8_LDA(At, 0, 1); PG8_STAGE(PG8_SA(0, 0), a2, voffA);
            PG8_BAR; PG8_WAIT_L(0); PG8_MMA(1, 0, At, B0); PG8_BAR; PG8_SCHED;
            PG8_STAGE(PG8_SB(0, 1), b2 + hstep, voffB);
            PG8_WAIT_V(6); PG8_BAR; PG8_MMA(1, 1, At, B1); PG8_BAR;
            PG8_LDB(B0, 1, 0); PG8_SCHED; PG8_LDA(At, 1, 0); PG8_STAGE(PG8_SA(0, 1), a2 + hstep, voffA);
            PG8_WAIT_L(8); PG8_BAR; PG8_WAIT_L(0); PG8_MMA(0, 0, At, B0); PG8_BAR; PG8_SCHED;
            PG8_LDB(B1, 1, 1); PG8_STAGE(PG8_SB(1, 0), b3, voffB);
            PG8_BAR; PG8_WAIT_L(0); PG8_MMA(0, 1, At, B1); PG8_BAR;
            PG8_LDA(At, 1, 1); PG8_STAGE(PG8_SA(1, 0), a3, voffA);
            PG8_BAR; PG8_WAIT_L(0); PG8_MMA(1, 0, At, B0); PG8_BAR; PG8_SCHED;
            PG8_STAGE(PG8_SB(1, 1), b3 + hstep, voffB);
            PG8_WAIT_V(6); PG8_BAR; PG8_MMA(1, 1, At, B1); PG8_BAR;
            }
        }
        if constexpr (ALIGN_EPI) { if (wr == 0) PG8_BAR; }
        if constexpr (!Epi::AFTER_DRAIN) { E(acc, cur, wr, wc, fr, fq); S.done(cur); }
        if (!has_next) break;
#pragma unroll
        for (int a = 0; a < 2; ++a)
#pragma unroll
            for (int b = 0; b < 2; ++b)
#pragma unroll
                for (int m = 0; m < 4; ++m)
#pragma unroll
                    for (int n = 0; n < 2; ++n) acc[a][b][m][n] = (f32x4){0.f, 0.f, 0.f, 0.f};
        cur = nxt; cA = nA; cB = nB; ++ui;
        if constexpr (ALIGN_EPI) { if (wr == 1) PG8_BAR; }
    }
    PG8_WAIT_V(0);
    if constexpr (!ALIGN_EPI) { if (wr == 0) PG8_BAR; }
    PG8_BAR;
    if constexpr (Epi::AFTER_DRAIN) { E.fused(acc, cur, wr, wc, fr, fq, lds, wid, lane); S.done(cur); }
#undef PG8_SA
#undef PG8_SB
#undef PG8_STAGE
#undef PG8_LDA
#undef PG8_LDB
#undef PG8_MMA
#undef PG8_WAIT_V
#undef PG8_WAIT_L
#undef PG8_BAR
#undef PG8_SCHED
}
}
#define LAS __attribute__((address_space(3)))
typedef unsigned short bf16;
typedef short bf16x8 __attribute__((ext_vector_type(8)));
typedef short s16x4 __attribute__((ext_vector_type(4)));
typedef float f32x4 __attribute__((ext_vector_type(4)));
typedef float f32x16 __attribute__((ext_vector_type(16)));
typedef unsigned u32x4 __attribute__((ext_vector_type(4)));
typedef unsigned u32x2 __attribute__((ext_vector_type(2)));

constexpr int NB = 8, SEQ = 4096, DM = 1024, DEPTH = 4, NMETA = 16;
constexpr int MREAL = NB * SEQ;
constexpr int META0 = MREAL;
constexpr int MROWS = 129 * 256;
constexpr int NINP = 3328, QP = 3072;
constexpr int C_FQ = 0, C_FK = 512, C_FV = 1024, C_GQ = 1536, C_GK = 1792, C_GV = 2048, C_GR = 2560;
constexpr int DFF = 2816, NUP = 5632;
constexpr float EPS = 1e-6f, LOG2E = 1.4426950408889634f, C2 = 0.125f * LOG2E;
constexpr int CKP = 4160;
constexpr int NCH = 65;

constexpr size_t MiB = 1u << 20;
constexpr size_t WL_IN = 0, WL_OUT = 6815744, WL_UP = 8912896, WL_DN = 20447232, WL_SIZE = 26214400;
constexpr size_t WS_W = 0, WS_HB = 100 * MiB, WS_OB = WS_HB + 67633152, WS_QKV = WS_OB + 67633152, WS_UT = WS_QKV + 202899456;
constexpr size_t WS_SM = WS_UT + 68157440, WS_CK = WS_SM + 4456448, WS_DEC = WS_CK + 1310720, WS_HM = WS_DEC + 786432, WS_SSQ = WS_HM + MiB, WS_BAR = WS_SSQ + 1835008, BAR_BYTES = 16384, WS_END = WS_BAR + BAR_BYTES;
static_assert(WS_END <= 512 * MiB, "workspace map");
constexpr size_t HFL_SIZE = (size_t)129 * 2 * NUP * 4;
static_assert(2 * HFL_SIZE <= 68157440, "halo overlay");

constexpr int LDS_BYTES = 147456, HALO_OFF = 131072;

struct Args {
    const float *x, *meta, *attn_norm, *w_in, *w_au, *b_alpha, *b_forget, *gla_norm, *fox_norm, *w_out, *ffn_norm, *w_up, *conv_w, *conv_b, *w_down, *final_norm;
    float* out; unsigned char* ws;
};

#define GAS __attribute__((address_space(1)))
#define CAS __attribute__((address_space(4)))
typedef const CAS Args* KArgs;
__device__ __forceinline__ KArgs kargs() { KArgs p = (KArgs)__builtin_amdgcn_kernarg_segment_ptr(); asm volatile("" : "+s"(p)); return p; }
template <class T> __device__ __forceinline__ T* gptr(T* p) { return (T*)(GAS T*)p; }
__device__ __forceinline__ float bf2f(bf16 v) { return __uint_as_float((unsigned)v << 16); }
__device__ __forceinline__ unsigned pk2(float lo, float hi) { return pg8::cvt_pk_bf16(lo, hi); }
__device__ __forceinline__ bf16 f2bf(float v) { return (bf16)(pk2(v, 0.f) & 0xffffu); }
__device__ __forceinline__ float wave_sum(float v) {
#pragma unroll
    for (int o = 1; o < 64; o <<= 1) v += __shfl_xor(v, o);
    return v;
}
__device__ __forceinline__ float logsigmoidf(float z) { return -(fmaxf(-z, 0.f) + log1pf(__expf(-fabsf(z)))); }
__device__ __forceinline__ float siluf(float v) { return v * __builtin_amdgcn_rcpf(1.f + __builtin_amdgcn_exp2f(-LOG2E * v)); }
__device__ __forceinline__ int crow(int r, int hi) { return (r & 3) + 8 * (r >> 2) + 4 * hi; }
__device__ __forceinline__ s16x4 vtr(const LAS unsigned char* p) { return __builtin_bit_cast(s16x4, __builtin_amdgcn_ds_read_tr16_b64_v4i16((LAS s16x4*)p)); }
__device__ __forceinline__ bf16x8 cat8(s16x4 a, s16x4 b) { return (bf16x8){a[0], a[1], a[2], a[3], b[0], b[1], b[2], b[3]}; }
__device__ __forceinline__ float dppf(float old, float src, int ctrl_unused);
#define DPP_MOV(old, src, ctrl) __builtin_bit_cast(float, __builtin_amdgcn_update_dpp(__builtin_bit_cast(int, (float)(old)), __builtin_bit_cast(int, (float)(src)), (ctrl), 0xf, 0xf, false))
#define LDS_WAIT() asm volatile("s_waitcnt lgkmcnt(0)" ::: "memory")

__device__ __forceinline__ const float* ssq_arr(unsigned char* wsb, int si) { return (const float*)(wsb + WS_SSQ) + (size_t)(si % 3) * MROWS * 4; }
__device__ __forceinline__ float row_rstd(const float* ssqp, int row) { const f32x4 s = *(const f32x4*)(ssqp + (size_t)row * 4); return rsqrtf(((s[0] + s[1]) + (s[2] + s[3])) * (1.0f / DM) + EPS); }
__device__ __forceinline__ LAS float* tile_rstd(unsigned char* wsb, int si, int pm, int wr, int wc, int fr, int fq) {
    extern __shared__ __attribute__((aligned(16))) unsigned char lds_dyn_[];
    LAS float* rsl = (LAS float*)((LAS unsigned char*)lds_dyn_ + HALO_OFF + 8192);
    const int tl = (wr * 4 + wc) * 64 + fq * 16 + fr;
    if (pm != 128) {
        if (tl < 256) rsl[tl] = row_rstd(ssq_arr(wsb, si), pm * 256 + tl);
    } else {
        const int row = tl >> 5, part = tl & 31;
        const f32x4* hp = (const f32x4*)((const float*)(wsb + WS_HM) + (size_t)row * DM) + part;
        float s = 0.f;
#pragma unroll
        for (int j = 0; j < 8; ++j) { const f32x4 v = hp[32 * j]; s += (v[0] * v[0] + v[1] * v[1]) + (v[2] * v[2] + v[3] * v[3]); }
        s += __shfl_xor(s, 1); s += __shfl_xor(s, 2); s += __shfl_xor(s, 4); s += __shfl_xor(s, 8); s += __shfl_xor(s, 16);
        if (part == 0) rsl[row] = rsqrtf(s * (1.0f / DM) + EPS);
        if (tl < 240) rsl[16 + tl] = 0.f;
    }
    asm volatile("s_waitcnt lgkmcnt(0)" ::: "memory"); __builtin_amdgcn_s_barrier(); asm volatile("" ::: "memory");
    return rsl;
}
__device__ __forceinline__ void meta_rowgemm(const bf16* A, int lda, const bf16* Bt, int K, float* HM, bf16* HB, int G, int bx) {
    int tid_ = threadIdx.x; asm volatile("" : "+v"(tid_)); const int r = tid_ >> 5, kp = tid_ & 31;
    for (int cg = bx; cg < 256; cg += G) {
        float acc[4] = {0.f, 0.f, 0.f, 0.f};
        for (int k0 = kp * 8; k0 < K; k0 += 256) {
            const u32x4 av = *(const u32x4*)(A + (size_t)r * lda + k0);
#pragma unroll
            for (int j = 0; j < 4; ++j) {
                const u32x4 bv = *(const u32x4*)(Bt + (size_t)(4 * cg + j) * K + k0);
#pragma unroll
                for (int q = 0; q < 4; ++q) {
                    acc[j] += __uint_as_float(av[q] << 16) * __uint_as_float(bv[q] << 16);
                    acc[j] += __uint_as_float(av[q] & 0xffff0000u) * __uint_as_float(bv[q] & 0xffff0000u);
                }
            }
        }
#pragma unroll
        for (int j = 0; j < 4; ++j) { float s = acc[j]; s += __shfl_xor(s, 1); s += __shfl_xor(s, 2); s += __shfl_xor(s, 4); s += __shfl_xor(s, 8); s += __shfl_xor(s, 16); acc[j] = s; }
        if (kp == 0) {
            float* hp = HM + (size_t)r * DM + 4 * cg;
            const f32x4 h = *(const f32x4*)hp + (f32x4){acc[0], acc[1], acc[2], acc[3]};
            *(f32x4*)hp = h;
            u32x2 w; w.x = pk2(h[0], h[1]); w.y = pk2(h[2], h[3]);
            *(u32x2*)(HB + (size_t)(META0 + r) * DM + 4 * cg) = w;
        }
    }
}
__device__ __forceinline__ void meta_up(LAS unsigned char* lds, const bf16* HB, const bf16* Wup, const float* HM, const float* cw, const float* cb, bf16* A2, float* HL, int G, int bx) {
    int tid_ = threadIdx.x; asm volatile("" : "+v"(tid_)); const int tid = tid_, r = tid >> 5, kp = tid & 31;
    LAS float* hb = (LAS float*)lds;
    float rs;
    { const f32x4* hp = (const f32x4*)(HM + (size_t)r * DM) + kp; float s = 0.f;
#pragma unroll
      for (int j = 0; j < 8; ++j) { const f32x4 v = hp[32 * j]; s += (v[0] * v[0] + v[1] * v[1]) + (v[2] * v[2] + v[3] * v[3]); }
      s += __shfl_xor(s, 1); s += __shfl_xor(s, 2); s += __shfl_xor(s, 4); s += __shfl_xor(s, 8); s += __shfl_xor(s, 16);
      rs = rsqrtf(s * (1.0f / DM) + EPS); }
    u32x4 av[4];
#pragma unroll
    for (int i = 0; i < 4; ++i) av[i] = *(const u32x4*)(HB + (size_t)(META0 + r) * DM + kp * 8 + 256 * i);
    for (int cg = bx; cg < 256; cg += G) {
#pragma unroll 1
        for (int cb0 = 0; cb0 < 24; cb0 += 6) {
            u32x4 bv[6][4];
#pragma unroll
            for (int c6 = 0; c6 < 6; ++c6) {
                const int c = cb0 + c6 < 22 ? cb0 + c6 : 21, isg = c >= 11 ? 1 : 0, jj = c - 11 * isg;
                const int ch = 11 * cg + jj, wrow = (ch >> 7) * 256 + isg * 128 + (ch & 127);
#pragma unroll
                for (int i = 0; i < 4; ++i) bv[c6][i] = *(const u32x4*)(Wup + (size_t)wrow * DM + kp * 8 + 256 * i);
            }
#pragma unroll
            for (int c6 = 0; c6 < 6; ++c6) {
                float acc = 0.f;
#pragma unroll
                for (int i = 0; i < 4; ++i)
#pragma unroll
                    for (int q = 0; q < 4; ++q) {
                        acc += __uint_as_float(av[i][q] << 16) * __uint_as_float(bv[c6][i][q] << 16);
                        acc += __uint_as_float(av[i][q] & 0xffff0000u) * __uint_as_float(bv[c6][i][q] & 0xffff0000u);
                    }
                acc += __shfl_xor(acc, 1); acc += __shfl_xor(acc, 2); acc += __shfl_xor(acc, 4); acc += __shfl_xor(acc, 8); acc += __shfl_xor(acc, 16);
                if (kp == 0 && cb0 + c6 < 22) hb[r * 24 + cb0 + c6] = acc * rs;
            }
        }
        __syncthreads();
        if (tid < 16 * 11) {
            const int rr = tid / 11, jj = tid % 11, ch = 11 * cg + jj;
            float hc[2];
#pragma unroll
            for (int ug = 0; ug < 2; ++ug) {
                const int c = ug * DFF + ch;
                const float x0 = hb[rr * 24 + ug * 11 + jj], x1 = rr >= 1 ? hb[(rr - 1) * 24 + ug * 11 + jj] : 0.f, x2 = rr >= 2 ? hb[(rr - 2) * 24 + ug * 11 + jj] : 0.f;
                hc[ug] = cb[c] + cw[c] * x2 + cw[NUP + c] * x1 + cw[2 * NUP + c] * x0;
                if (rr >= 14) HL[(size_t)(256 + rr - 14) * NUP + c] = x0;
            }
            A2[(size_t)(META0 + rr) * DFF + ch] = f2bf(siluf(hc[1]) * hc[0]);
        }
        __syncthreads();
    }
}
__device__ __forceinline__ bool so_next_pm(int nM, int nN, int G, int c, int i, int& pm) {
    const int nwg = nM * nN; const long Lq = (long)i * G + c; if (Lq >= nwg) return false;
    int wgid = (int)Lq; { const int q = nwg / pg8::NXCD, r = nwg % pg8::NXCD, xcd = wgid % pg8::NXCD, off = wgid / pg8::NXCD; wgid = (xcd < r ? xcd * (q + 1) : r * (q + 1) + (xcd - r) * q) + off; }
    const int nig = pg8::WGM * nN, gid = wgid / nig, fm = gid * pg8::WGM, gsz = (nM - fm) < pg8::WGM ? (nM - fm) : pg8::WGM;
    pm = fm + ((wgid % nig) % gsz); return true;
}
struct EpiIn {
    static constexpr bool PERM = true, AFTER_DRAIN = false;
    int si;
    __device__ __forceinline__ void operator()(const pg8::f32x4 (&acc)[2][2][4][2], const pg8::Unit& u, int wr, int wc, int fr, int fq) const {
        asm volatile("" : "+v"(fr), "+v"(fq));
        unsigned char* wsb = gptr(kargs()->ws);
        bf16* Q = (bf16*)(wsb + WS_QKV); float* SM = (float*)(wsb + WS_SM); const LAS float* rsl = tile_rstd(wsb, si, u.pm, wr, wc, fr, fq);
#pragma unroll
        for (int ai = 0; ai < 2; ++ai)
#pragma unroll
            for (int m = 0; m < 4; ++m) {
                const int row = u.pm * 256 + ai * 128 + wr * 64 + m * 16 + fr;
                const float rs = rsl[ai * 128 + wr * 64 + m * 16 + fr];
                if (u.pn < 12) {
#pragma unroll
                    for (int bj = 0; bj < 2; ++bj) {
                        const pg8::f32x4 v0 = acc[ai][bj][m][0] * rs, v1 = acc[ai][bj][m][1] * rs;
                        u32x4 w; w.x = pk2(v0[0], v0[1]); w.y = pk2(v0[2], v0[3]); w.z = pk2(v1[0], v1[1]); w.w = pk2(v1[2], v1[3]);
                        *(u32x4*)(Q + (size_t)row * QP + u.pn * 256 + bj * 128 + wc * 32 + 8 * fq) = w;
                    }
                } else if (wc == 0) {
                    *(f32x4*)(SM + (size_t)row * 32 + 8 * fq) = acc[ai][0][m][0] * rs;
                    *(f32x4*)(SM + (size_t)row * 32 + 8 * fq + 4) = acc[ai][0][m][1] * rs;
                }
            }
    }
};
template <bool from_x, bool last> struct EpiRes {
    static constexpr bool PERM = false, AFTER_DRAIN = false;
    int si;
    __device__ __forceinline__ void operator()(const pg8::f32x4 (&acc)[2][2][4][2], const pg8::Unit& u, int wr, int wc, int fr, int fq) const {
        asm volatile("" : "+v"(fr), "+v"(fq));
        KArgs ka = kargs(); unsigned char* wsb = gptr(ka->ws);
        float* out = last ? gptr(ka->out) : nullptr; const float* xin = from_x ? gptr(ka->x) : nullptr; bf16* HB = (bf16*)(wsb + WS_HB); float* ssq_next = (float*)ssq_arr(wsb, si);
        extern __shared__ __attribute__((aligned(16))) unsigned char lds_dyn_[];
        LAS float* red = (LAS float*)((LAS unsigned char*)lds_dyn_ + HALO_OFF);
#pragma unroll
        for (int ai = 0; ai < 2; ++ai)
#pragma unroll
            for (int m = 0; m < 4; ++m) {
                const int row = u.pm * 256 + ai * 128 + wr * 64 + m * 16 + fr;
                float ss = 0.f;
#pragma unroll
                for (int bj = 0; bj < 2; ++bj)
#pragma unroll
                    for (int n = 0; n < 2; ++n) {
                        const int col = u.pn * 256 + bj * 128 + wc * 32 + 16 * n + 4 * fq;
                        f32x4 bs;
                        if constexpr (from_x) bs = *(const f32x4*)(xin + (size_t)row * DM + col);
                        else { const u32x2 t = *(const u32x2*)(HB + (size_t)row * DM + col);
                               bs = (f32x4){__uint_as_float(t.x << 16), __uint_as_float(t.x & 0xffff0000u), __uint_as_float(t.y << 16), __uint_as_float(t.y & 0xffff0000u)}; }
                        const f32x4 h = bs + acc[ai][bj][m][n];
                        ss += (h[0] * h[0] + h[1] * h[1]) + (h[2] * h[2] + h[3] * h[3]);
                        u32x2 w; w.x = pk2(h[0], h[1]); w.y = pk2(h[2], h[3]);
                        *(u32x2*)(HB + (size_t)row * DM + col) = w;
                        if constexpr (last) *(f32x4*)(out + (size_t)row * DM + col) = h;
                    }
                ss += __shfl_xor(ss, 16); ss += __shfl_xor(ss, 32);
                if (fq == 0) red[wc * 256 + ai * 128 + wr * 64 + m * 16 + fr] = ss;
            }
        asm volatile("s_waitcnt lgkmcnt(0)" ::: "memory"); __builtin_amdgcn_s_barrier(); asm volatile("" ::: "memory");
        {
            const int tl = (wr * 4 + wc) * 64 + fq * 16 + fr;
            if (tl < 256) ssq_next[(size_t)(u.pm * 256 + tl) * 4 + u.pn] = (red[tl] + red[256 + tl]) + (red[512 + tl] + red[768 + tl]);
        }
    }
};
struct EpiUp {
    static constexpr bool PERM = true, AFTER_DRAIN = false;
    int L;
    __device__ __forceinline__ void operator()(pg8::f32x4 (&acc)[2][2][4][2], const pg8::Unit& u, int wr, int wc, int fr, int fq) const {
        asm volatile("" : "+v"(fr), "+v"(fq));
        KArgs ka = kargs(); unsigned char* wsb = gptr(ka->ws);
        const LAS float* rsl = tile_rstd(wsb, 2 * L + 1, u.pm, wr, wc, fr, fq); const float* cw = gptr(ka->conv_w) + (size_t)L * 3 * NUP; const float* cb = gptr(ka->conv_b) + (size_t)L * NUP;
        extern __shared__ __attribute__((aligned(16))) unsigned char lds_dyn_[];
        LAS float* halo = (LAS float*)((LAS unsigned char*)lds_dyn_ + HALO_OFF);
        const int colw = wc * 32 + 8 * fq;
#pragma unroll
        for (int ai = 0; ai < 2; ++ai)
#pragma unroll
            for (int m = 0; m < 4; ++m) {
                const int row = u.pm * 256 + ai * 128 + wr * 64 + m * 16 + fr;
                const float rs = rsl[ai * 128 + wr * 64 + m * 16 + fr]; (void)row;
#pragma unroll
                for (int bj = 0; bj < 2; ++bj)
#pragma unroll
                    for (int n = 0; n < 2; ++n) acc[ai][bj][m][n] *= rs;
            }
#ifdef SIMPLE_UP
        {
            const int ch0s = u.pn * 128 + colw;
#pragma unroll
            for (int n = 0; n < 2; ++n)
#pragma unroll
                for (int ai = 0; ai < 2; ++ai)
#pragma unroll
                    for (int m = 0; m < 4; ++m) {
                        const int row = u.pm * 256 + ai * 128 + wr * 64 + m * 16 + fr;
                        const f32x4 hu = acc[ai][0][m][n], hg = acc[ai][1][m][n];
                        u32x2 w; w.x = pk2(hu[0] + hg[0], hu[1] + hg[1]); w.y = pk2(hu[2] + hg[2], hu[3] + hg[3]);
                        *(u32x2*)(wsb + (unsigned)(WS_QKV + (unsigned)((row * DFF + ch0s + 4 * n) * 2))) = w;
                    }
            return;
        }
#endif
        if (fr >= 14) {
#pragma unroll
            for (int ai = 0; ai < 2; ++ai)
#pragma unroll
                for (int bj = 0; bj < 2; ++bj)
#pragma unroll
                    for (int n = 0; n < 2; ++n)
                        *(LAS f32x4*)(halo + (((2 * ai + wr) * 2 + (fr - 14)) * 256 + bj * 128 + colw + 4 * n)) = acc[ai][bj][3][n];
        }
        asm volatile("s_waitcnt lgkmcnt(0)" ::: "memory"); __builtin_amdgcn_s_barrier(); asm volatile("" ::: "memory");
        const int ch0 = u.pn * 128 + colw;
        u32x2 wout[2][4][2];
#pragma unroll
        for (int n = 0; n < 2; ++n) {
            f32x4 w0[2], w1[2], w2[2], bb[2];
#pragma unroll
            for (int bj = 0; bj < 2; ++bj) {
                const int c = bj * DFF + ch0 + 4 * n;
                w0[bj] = *(const f32x4*)((const char*)cw + (unsigned)(c * 4)); w1[bj] = *(const f32x4*)((const char*)cw + (unsigned)((NUP + c) * 4)); w2[bj] = *(const f32x4*)((const char*)cw + (unsigned)((2 * NUP + c) * 4)); bb[bj] = *(const f32x4*)((const char*)cb + (unsigned)(c * 4));
            }
#pragma unroll
            for (int ai = 0; ai < 2; ++ai)
#pragma unroll
                for (int m = 0; m < 4; ++m) {
                    const int g = 2 * ai + wr;
                    f32x4 hc[2];
#pragma unroll
                    for (int bj = 0; bj < 2; ++bj) {
                        const int c = bj * DFF + ch0 + 4 * n;
                        const f32x4 cur = acc[ai][bj][m][n];
                        f32x4 pb;
                        if (m > 0) pb = acc[ai][bj][m - 1][n];
                        else pb = *(const LAS f32x4*)(halo + ((((g > 0 ? g - 1 : 0) * 2) + (fr & 1)) * 256 + bj * 128 + colw + 4 * n));
                        f32x4 p1, p2;
#pragma unroll
                        for (int j = 0; j < 4; ++j) {
                            const float t1 = DPP_MOV(0.f, pb[j], 0x121);
                            p1[j] = DPP_MOV(t1, cur[j], 0x111);
                            const float t2 = DPP_MOV(0.f, pb[j], 0x122);
                            p2[j] = DPP_MOV(t2, cur[j], 0x112);
                        }
                        hc[bj] = bb[bj] + w0[bj] * p2 + w1[bj] * p1 + w2[bj] * cur;
                        if (g == 0 && m == 0 && fr < 2) *(f32x4*)(wsb + (unsigned)(WS_UT + (unsigned)(((u.pm * 2 + fr) * NUP + c) * 4))) = cur;
                        if (u.pm == 128 ? (g == 0 && m == 0 && fr >= 14) : (g == 3 && m == 3 && fr >= 14))
                            *(f32x4*)(wsb + (unsigned)(WS_UT + HFL_SIZE + (unsigned)(((u.pm * 2 + fr - 14) * NUP + c) * 4))) = cur;
                    }
                    wout[ai][m][n].x = pk2(siluf(hc[1][0]) * hc[0][0], siluf(hc[1][1]) * hc[0][1]);
                    wout[ai][m][n].y = pk2(siluf(hc[1][2]) * hc[0][2], siluf(hc[1][3]) * hc[0][3]);
                }
        }
#pragma unroll
        for (int ai = 0; ai < 2; ++ai)
#pragma unroll
            for (int m = 0; m < 4; ++m) {
                const int row = u.pm * 256 + ai * 128 + wr * 64 + m * 16 + fr;
                u32x4 w; w.x = wout[ai][m][0].x; w.y = wout[ai][m][0].y; w.z = wout[ai][m][1].x; w.w = wout[ai][m][1].y;
                *(u32x4*)(wsb + (unsigned)(WS_QKV + (unsigned)((row * DFF + ch0) * 2))) = w;
            }
    }
};
#define XB_TMO      128
#define XB_XCNT(j)  (256  + 64 * (j))
#define XB_XSUB(j)  (1280 + 64 * (j))
#define XB_XGEN(j)  (2304 + 64 * (j))
#define XB_TOP      3328
#define XB_TOPGEN   3392
#define XCD_BAR_WORDS 3456
#define XB_SPIN_CAP (1u << 18)

__device__ __forceinline__ unsigned xb_ld(unsigned* p)              { return __hip_atomic_load(p, __ATOMIC_RELAXED, __HIP_MEMORY_SCOPE_AGENT); }
__device__ __forceinline__ unsigned xb_add(unsigned* p, unsigned v) { return __hip_atomic_fetch_add(p, v, __ATOMIC_RELAXED, __HIP_MEMORY_SCOPE_AGENT); }
__device__ __forceinline__ unsigned xb_xcc_id() { return (unsigned)__builtin_amdgcn_s_getreg((3 << 11) | 20) & 0xFu; }
#define XB_SPIN(cond, bar) do { unsigned _sp = 0; while (cond) { __builtin_amdgcn_s_sleep(1); \
    if ((++_sp & 255u) == 0u) { if (xb_ld(&(bar)[XB_TMO])) break; if (_sp > XB_SPIN_CAP) { atomicAdd(&(bar)[XB_TMO], 1u); break; } } } } while (0)

struct XcdBarrier {
    unsigned* bar; unsigned x;
    volatile LAS unsigned* st;
};

__device__ __forceinline__ XcdBarrier xcd_barrier_post(unsigned* bar, volatile LAS unsigned* st) {
    XcdBarrier b; b.bar = bar; b.x = xb_xcc_id(); b.st = st;
    if (threadIdx.x == 0) (void)xb_add(&bar[XB_XCNT(b.x)], 1u);
    return b;
}
__device__ __forceinline__ void xcd_barrier_complete(unsigned* bar, unsigned x, unsigned& nloc, unsigned& nx) {
    const unsigned G = gridDim.x * gridDim.y * gridDim.z;
    unsigned sum, cnt, mine, sp = 0u;
    for (;;) {
        sum = 0u; cnt = 0u; mine = 0u;
#pragma unroll
        for (unsigned j = 0; j < 16; ++j) { const unsigned c = xb_ld(&bar[XB_XCNT(j)]); sum += c; cnt += (c > 0u) ? 1u : 0u; mine = (j == x) ? c : mine; }
        if (sum == G) break;
        __builtin_amdgcn_s_sleep(1);
        if ((++sp & 255u) == 0u) { if (xb_ld(&bar[XB_TMO])) break; if (sp > XB_SPIN_CAP) { atomicAdd(&bar[XB_TMO], 1u); break; } }
    }
    nloc = mine > 0u ? mine : 1u; nx = cnt > 0u ? cnt : 1u;
}

__device__ __forceinline__ void xcd_barrier(const XcdBarrier& b) {
    asm volatile("s_waitcnt vmcnt(0)" ::: "memory");
    __syncthreads();
    if (threadIdx.x == 0) {
        unsigned* bar = b.bar;
        __builtin_amdgcn_s_waitcnt(0);
        unsigned nloc = b.st[0], nx = b.st[1];
        if (nloc == 0u) { xcd_barrier_complete(bar, b.x, nloc, nx); b.st[0] = nloc; b.st[1] = nx; }
        const unsigned old = xb_add(&bar[XB_XSUB(b.x)], 1u);
        const unsigned gen = old / nloc;
        if (old + 1u == (gen + 1u) * nloc) {
            __builtin_amdgcn_fence(__ATOMIC_RELEASE, "agent");
            asm volatile("s_waitcnt vmcnt(0)" ::: "memory");
            const unsigned og = xb_add(&bar[XB_TOP], 1u);
            const unsigned tg = og / nx;
            if (og + 1u == (tg + 1u) * nx) xb_add(&bar[XB_TOPGEN], 1u);
            else XB_SPIN(xb_ld(&bar[XB_TOPGEN]) == tg, bar);
            __builtin_amdgcn_fence(__ATOMIC_ACQUIRE, "agent");
            xb_add(&bar[XB_XGEN(b.x)], 1u);
            asm volatile("s_waitcnt vmcnt(0)" ::: "memory");
        } else {
            XB_SPIN(xb_ld(&bar[XB_XGEN(b.x)]) == gen, bar);
            __builtin_amdgcn_fence(__ATOMIC_ACQUIRE, "agent");
            asm volatile("s_waitcnt vmcnt(0)" ::: "memory");
        }
    }
    __syncthreads();
}
__device__ __forceinline__ int win_src(int n) {
    if (n < 512) return 1552 + n;
    if (n < 1024) return 2064 + (n - 512);
    if (n < 1536) return 2576 + (n - 1024);
    if (n < 1792) return n - 1536;
    if (n < 2048) return 256 + (n - 1792);
    if (n < 2560) return 512 + (n - 2048);
    if (n < 3072) return 1024 + (n - 2560);
    if (n < 3088) return 1536 + (n - 3072);
    if (n < 3096) return n;
    return -1;
}
__device__ __forceinline__ void tr_item(const float* W, int Nsrc, bf16* WT, int K, const float* gk, int mode, LAS float* scr, int k0, int n0, int lane) {
    const int nl = lane & 31, n = n0 + nl;
    int src = n; float cs = 1.f;
    if (mode == 0) { src = win_src(n); cs = n < 512 ? C2 : ((n >= 1536 && n < 1792) ? 0.125f : 1.f); }
    else if (mode == 2) { const int pn = n >> 8, j = n & 255; src = j < 128 ? pn * 128 + j : DFF + pn * 128 + (j - 128); }
#pragma unroll
    for (int i = 0; i < 32; ++i) {
        const int kk = 2 * i + (lane >> 5);
        float v = 0.f;
        if (src >= 0) v = W[(size_t)(k0 + kk) * Nsrc + src] * cs;
        if (gk) v *= gk[k0 + kk];
        scr[kk * 33 + nl] = v;
    }
    LDS_WAIT(); asm volatile("" ::: "memory");
    const int c = lane & 7;
#pragma unroll
    for (int j = 0; j < 4; ++j) {
        const int nn = (lane >> 3) + 8 * j; const LAS float* s = scr + (8 * c) * 33 + nn;
        u32x4 o; o.x = pk2(s[0 * 33], s[1 * 33]); o.y = pk2(s[2 * 33], s[3 * 33]); o.z = pk2(s[4 * 33], s[5 * 33]); o.w = pk2(s[6 * 33], s[7 * 33]);
        *(u32x4*)(WT + (size_t)(n0 + nn) * K + k0 + 8 * c) = o;
    }
    LDS_WAIT(); asm volatile("" ::: "memory");
}
__device__ __forceinline__ void row_to_bf16(const float* xrow, bf16* orow, float* ssq_slot, float* copy_row, int lane) {
    const f32x4* xr = (const f32x4*)xrow + lane;
    f32x4 v[4]; float s = 0.f;
#pragma unroll
    for (int j = 0; j < 4; ++j) { v[j] = xr[64 * j]; s += (v[j][0] * v[j][0] + v[j][1] * v[j][1]) + (v[j][2] * v[j][2] + v[j][3] * v[j][3]); }
    s = wave_sum(s);
    if (lane == 0) *(f32x4*)ssq_slot = (f32x4){s, 0.f, 0.f, 0.f};
    u32x2* o8 = (u32x2*)orow + lane;
#pragma unroll
    for (int j = 0; j < 4; ++j) { u32x2 w; w.x = pk2(v[j][0], v[j][1]); w.y = pk2(v[j][2], v[j][3]); o8[64 * j] = w; }
    if (copy_row) {
#pragma unroll
        for (int j = 0; j < 4; ++j) ((f32x4*)copy_row + lane)[64 * j] = v[j];
    }
}

template <int NQ> __device__ __forceinline__ void gla_u_group(LAS unsigned char* lds, const bf16* QKV, const float* SM, const float* wau, const float* balpha, float* UT, float* DEC, int grp) {
    int tid_ = threadIdx.x; asm volatile("" : "+v"(tid_)); const int tid = tid_, lane = tid & 63, wid = __builtin_amdgcn_readfirstlane(tid >> 6), hi = lane >> 5, r32 = lane & 31;
    constexpr int SUB = 9216 + 17408 + 2048;
    const int dk = lane, sg = wid;
    int bhq[NQ], ccq[NQ], hq[NQ], row0q[NQ], tvq[NQ];
    float la[NQ][8], kf[NQ][8];
#pragma unroll
    for (int q = 0; q < NQ; ++q) {
        const int u = NQ * grp + q; bhq[q] = u / NCH; ccq[q] = u % NCH; hq[q] = bhq[q] & 3;
        row0q[q] = ccq[q] == 0 ? META0 : (bhq[q] >> 2) * SEQ + (ccq[q] - 1) * 64; tvq[q] = ccq[q] == 0 ? NMETA : 64;
        LAS unsigned char* VT = lds + q * SUB + 9216;
        LAS float* TOT = (LAS float*)(lds + q * SUB + 9216 + 17408);
#pragma unroll
        for (int i = 0; i < 2; ++i) {
            const int idx = tid + 512 * i, row = idx >> 4, ch = idx & 15;
            const u32x4 v = *(const u32x4*)(QKV + (size_t)(row0q[q] + row) * QP + C_GV + hq[q] * 128 + ch * 8);
            *(LAS u32x4*)(VT + row * 272 + ch * 16) = v;
        }
#pragma unroll
        for (int i = 0; i < 8; ++i) kf[q][i] = bf2f(QKV[(size_t)(row0q[q] + 8 * sg + i) * QP + C_GK + hq[q] * 64 + dk]);
        float w[16];
#pragma unroll
        for (int r = 0; r < 16; ++r) w[r] = wau[r * 256 + hq[q] * 64 + dk];
        const float bias = balpha[hq[q] * 64 + dk];
#pragma unroll
        for (int i = 0; i < 8; ++i) {
            const int s = 8 * sg + i;
            const f32x4* g4 = (const f32x4*)(SM + (size_t)(row0q[q] + s) * 32);
            float z = bias;
#pragma unroll
            for (int k = 0; k < 4; ++k) { const f32x4 gv = g4[k]; z += gv[0] * w[4 * k] + gv[1] * w[4 * k + 1] + gv[2] * w[4 * k + 2] + gv[3] * w[4 * k + 3]; }
            la[q][i] = (s < tvq[q]) ? logsigmoidf(z) * (1.0f / 16.0f) : 0.f;
        }
#pragma unroll
        for (int i = 1; i < 8; ++i) la[q][i] += la[q][i - 1];
        TOT[sg * 64 + dk] = la[q][7];
    }
    __syncthreads();
#pragma unroll
    for (int q = 0; q < NQ; ++q) {
        LAS unsigned char* KD = lds + q * SUB;
        const LAS float* TOT = (const LAS float*)(lds + q * SUB + 9216 + 17408);
        float pre = 0.f, tot = 0.f;
#pragma unroll
        for (int g2 = 0; g2 < 8; ++g2) { const float t = TOT[g2 * 64 + dk]; if (g2 < sg) pre += t; tot += t; }
        if (sg == 0) DEC[(size_t)(bhq[q] * NCH + ccq[q]) * 64 + dk] = __expf(tot);
#pragma unroll
        for (int i = 0; i < 8; ++i) {
            const int s = 8 * sg + i;
            const float kd = (s < tvq[q]) ? kf[q][i] * __expf(tot - (pre + la[q][i])) : 0.f;
            *(LAS bf16*)(KD + s * 144 + dk * 2) = f2bf(kd);
        }
    }
    __syncthreads();
    const int dvb = wid >> 1, dkb = wid & 1;
    const int qq = (lane & 15) >> 2, pp = lane & 3, half = (lane >> 4) & 1;
#pragma unroll
    for (int q = 0; q < NQ; ++q) {
        const LAS unsigned char* KD = lds + q * SUB; const LAS unsigned char* VT = lds + q * SUB + 9216;
        f32x16 acc = {};
#pragma unroll
        for (int j = 0; j < 4; ++j) {
            const LAS unsigned char* ap = VT + (16 * j + 4 * hi + qq) * 272 + (32 * dvb + 16 * half + 4 * pp) * 2;
            const LAS unsigned char* bp = KD + (16 * j + 4 * hi + qq) * 144 + (32 * dkb + 16 * half + 4 * pp) * 2;
            const bf16x8 af = cat8(vtr(ap), vtr(ap + 8 * 272));
            const bf16x8 bfr = cat8(vtr(bp), vtr(bp + 8 * 144));
            acc = __builtin_amdgcn_mfma_f32_32x32x16_bf16(af, bfr, acc, 0, 0, 0);
        }
        float* up = UT + ((size_t)(bhq[q] * NCH + ccq[q]) * 128 + 32 * dvb) * 64 + 32 * dkb + r32;
#pragma unroll
        for (int r = 0; r < 16; ++r) up[crow(r, hi) * 64] = acc[r];
    }
    __syncthreads();
}
__device__ __forceinline__ void fox_cumsum_unit(LAS unsigned char* lds, const float* SM, const float* bforget, float* CK, int bh) {
    int tid_ = threadIdx.x; asm volatile("" : "+v"(tid_)); const int tid = tid_, lane = tid & 63, wid = tid >> 6;
    const int b = bh >> 3, h = bh & 7;
    const float bf_ = bforget[h];
    LAS float* WT_ = (LAS float*)lds;
    float mtot = 0.f, mine = 0.f;
    for (int p = 0; p < NMETA; ++p) { mtot += logsigmoidf(SM[(size_t)(META0 + p) * 32 + 16 + h] + bf_); if (tid == p) mine = mtot; }
    if (tid < 64) CK[(size_t)bh * CKP + tid] = tid < NMETA ? -LOG2E * mine : -INFINITY;
    float v[8]; float run = 0.f;
#pragma unroll
    for (int i = 0; i < 8; ++i) { run += logsigmoidf(SM[(size_t)(b * SEQ + 8 * tid + i) * 32 + 16 + h] + bf_); v[i] = run; }
    float inc = run;
#pragma unroll
    for (int o = 1; o < 64; o <<= 1) { const float t = __shfl_up(inc, o); if (lane >= o) inc += t; }
    if (lane == 63) WT_[wid] = inc;
    __syncthreads();
    float off = mtot + (inc - run);
    for (int w2 = 0; w2 < wid; ++w2) off += WT_[w2];
#pragma unroll
    for (int i = 0; i < 8; ++i) CK[(size_t)bh * CKP + 64 + 8 * tid + i] = -LOG2E * (off + v[i]);
    __syncthreads();
}

__device__ __forceinline__ void attn_unit(LAS unsigned char* lds, const bf16* QKV, const float* CK, bf16* OB, const float* fnorm, int b, int h, int qb) {
    int tid_ = threadIdx.x; asm volatile("" : "+v"(tid_)); const int tid = tid_, lane = tid & 63, wid = __builtin_amdgcn_readfirstlane(tid >> 6), r32 = lane & 31, hi = lane >> 5;
    constexpr int KB = 9216, KOFF = 0, VOFF = 2 * KB, COFF = 4 * KB, WOFF = COFF + 512;
    LAS float* wsf = (LAS float*)(lds + WOFF) + wid * 64;
    const size_t rowb = (size_t)b * SEQ; const int q0 = qb * 512;
    const int NT = 1 + 8 * (qb + 1);
    bf16x8 qr[2][4];
#pragma unroll
    for (int g = 0; g < 2; ++g) {
        const bf16* qp = QKV + (rowb + q0 + wid * 64 + g * 32 + r32) * QP + C_FQ + h * 64 + hi * 8;
#pragma unroll
        for (int d0 = 0; d0 < 4; ++d0) qr[g][d0] = *(const bf16x8*)(qp + d0 * 16);
    }
    const int srow = tid >> 3, sch = tid & 7;
    const float* ckp = CK + (size_t)(b * 8 + h) * CKP;
    u32x4 kreg, vreg; float creg = 0.f;
#define ATT_LOAD(t) do { const size_t r0_ = (t) == 0 ? (size_t)META0 : rowb + (size_t)((t) - 1) * 64; const bf16* p_ = QKV + (r0_ + srow) * QP + h * 64 + sch * 8; \
        kreg = *(const u32x4*)(p_ + C_FK); vreg = *(const u32x4*)(p_ + C_FV); if (tid < 64) creg = ckp[(t) * 64 + tid]; } while (0)
#define ATT_STORE(buf) do { *(LAS u32x4*)(lds + KOFF + (buf) * KB + srow * 144 + sch * 16) = kreg; *(LAS u32x4*)(lds + VOFF + (buf) * KB + (sch >> 2) * 4096 + (srow >> 3) * 512 + (srow & 7) * 64 + (sch & 3) * 16) = vreg; \
        if (tid < 64) *(LAS float*)(lds + COFF + (buf) * 256 + tid * 4) = creg; } while (0)
    float m[2] = {-1e30f, -1e30f}, l[2] = {0.f, 0.f}; f32x16 o0[2], o1[2];
    o0[0] = (f32x16){}; o0[1] = (f32x16){}; o1[0] = (f32x16){}; o1[1] = (f32x16){};
    const int qq = (lane & 15) >> 2, pp = lane & 3, half = (lane >> 4) & 1;
    ATT_LOAD(0); ATT_STORE(0);
    for (int t = 0; t < NT; ++t) {
        const int buf = t & 1;
        if (t + 1 < NT) ATT_LOAD(t + 1);
        __syncthreads();
        const int jb = t - (NT - 8);
        const bool skip = (jb >= 0) && (jb > wid);
        if (!skip) {
            const LAS unsigned char* Kb = lds + KOFF + buf * KB; const LAS unsigned char* Vb = lds + VOFF + buf * KB; const LAS float* Cb = (const LAS float*)(lds + COFF + buf * 256);
            f32x16 p0[2], p1[2], c0v, c1v;
#pragma unroll
            for (int g4 = 0; g4 < 4; ++g4) {
                const f32x4 c0 = *(const LAS f32x4*)(Cb + 8 * g4 + 4 * hi), c1 = *(const LAS f32x4*)(Cb + 32 + 8 * g4 + 4 * hi);
#pragma unroll
                for (int i = 0; i < 4; ++i) { c0v[4 * g4 + i] = c0[i]; c1v[4 * g4 + i] = c1[i]; }
            }
#pragma unroll
            for (int d0 = 0; d0 < 4; ++d0) {
                const bf16x8 a0 = *(const LAS bf16x8*)(Kb + r32 * 144 + (16 * d0 + 8 * hi) * 2);
                const bf16x8 a1 = *(const LAS bf16x8*)(Kb + (32 + r32) * 144 + (16 * d0 + 8 * hi) * 2);
                p0[0] = __builtin_amdgcn_mfma_f32_32x32x16_bf16(a0, qr[0][d0], d0 == 0 ? c0v : p0[0], 0, 0, 0);
                p0[1] = __builtin_amdgcn_mfma_f32_32x32x16_bf16(a0, qr[1][d0], d0 == 0 ? c0v : p0[1], 0, 0, 0);
                p1[0] = __builtin_amdgcn_mfma_f32_32x32x16_bf16(a1, qr[0][d0], d0 == 0 ? c1v : p1[0], 0, 0, 0);
                p1[1] = __builtin_amdgcn_mfma_f32_32x32x16_bf16(a1, qr[1][d0], d0 == 0 ? c1v : p1[1], 0, 0, 0);
            }
            bf16x8 pa[2][4];
#pragma unroll
            for (int g = 0; g < 2; ++g) {
                if (jb == wid) {
                    const int qrel = 32 * g + r32;
#pragma unroll
                    for (int r = 0; r < 16; ++r) { const int kv = crow(r, hi); if (kv > qrel) p0[g][r] = -INFINITY; if (kv + 32 > qrel) p1[g][r] = -INFINITY; }
                }
                float mxa = fmaxf(p0[g][0], p1[g][0]), mxb = fmaxf(p0[g][1], p1[g][1]);
#pragma unroll
                for (int r = 2; r < 16; r += 2) { mxa = fmaxf(fmaxf(mxa, p0[g][r]), p1[g][r]); mxb = fmaxf(fmaxf(mxb, p0[g][r + 1]), p1[g][r + 1]); }
                float mx = fmaxf(mxa, mxb);
                mx = fmaxf(mx, __shfl_xor(mx, 32));
                if (__any(mx > m[g] + 16.0f)) {
                    const float mn = fmaxf(m[g], mx);
                    const float alpha = __builtin_amdgcn_exp2f(m[g] - mn);
                    m[g] = mn; l[g] *= alpha;
                    if (hi == 0) wsf[g * 32 + r32] = alpha;
                    LDS_WAIT();
#pragma unroll
                    for (int g4 = 0; g4 < 4; ++g4) {
                        const f32x4 a = *(const LAS f32x4*)(wsf + g * 32 + 8 * g4 + 4 * hi);
#pragma unroll
                        for (int i = 0; i < 4; ++i) { o0[g][4 * g4 + i] *= a[i]; o1[g][4 * g4 + i] *= a[i]; }
                    }
                }
                float rsa = 0.f, rsb = 0.f, rsc = 0.f, rsd = 0.f;
#pragma unroll
                for (int r = 0; r < 16; r += 2) {
                    p0[g][r] = __builtin_amdgcn_exp2f(p0[g][r] - m[g]); p1[g][r] = __builtin_amdgcn_exp2f(p1[g][r] - m[g]);
                    p0[g][r + 1] = __builtin_amdgcn_exp2f(p0[g][r + 1] - m[g]); p1[g][r + 1] = __builtin_amdgcn_exp2f(p1[g][r + 1] - m[g]);
                    rsa += p0[g][r]; rsb += p1[g][r]; rsc += p0[g][r + 1]; rsd += p1[g][r + 1];
                }
                l[g] += (rsa + rsb) + (rsc + rsd);
                { u32x4 w;
                  w.x = pk2(p0[g][0], p0[g][1]); w.y = pk2(p0[g][2], p0[g][3]); w.z = pk2(p0[g][4], p0[g][5]); w.w = pk2(p0[g][6], p0[g][7]); pa[g][0] = __builtin_bit_cast(bf16x8, w);
                  w.x = pk2(p0[g][8], p0[g][9]); w.y = pk2(p0[g][10], p0[g][11]); w.z = pk2(p0[g][12], p0[g][13]); w.w = pk2(p0[g][14], p0[g][15]); pa[g][1] = __builtin_bit_cast(bf16x8, w);
                  w.x = pk2(p1[g][0], p1[g][1]); w.y = pk2(p1[g][2], p1[g][3]); w.z = pk2(p1[g][4], p1[g][5]); w.w = pk2(p1[g][6], p1[g][7]); pa[g][2] = __builtin_bit_cast(bf16x8, w);
                  w.x = pk2(p1[g][8], p1[g][9]); w.y = pk2(p1[g][10], p1[g][11]); w.z = pk2(p1[g][12], p1[g][13]); w.w = pk2(p1[g][14], p1[g][15]); pa[g][3] = __builtin_bit_cast(bf16x8, w); }
            }
#pragma unroll
            for (int j = 0; j < 4; ++j) {
                const LAS unsigned char* vp = Vb + (2 * j) * 512 + (4 * hi + qq) * 64 + 32 * half + 8 * pp;
                const bf16x8 v0 = cat8(vtr(vp), vtr(vp + 512));
                const bf16x8 v1 = cat8(vtr(vp + 4096), vtr(vp + 4096 + 512));
                o0[0] = __builtin_amdgcn_mfma_f32_32x32x16_bf16(pa[0][j], v0, o0[0], 0, 0, 0);
                o0[1] = __builtin_amdgcn_mfma_f32_32x32x16_bf16(pa[1][j], v0, o0[1], 0, 0, 0);
                o1[0] = __builtin_amdgcn_mfma_f32_32x32x16_bf16(pa[0][j], v1, o1[0], 0, 0, 0);
                o1[1] = __builtin_amdgcn_mfma_f32_32x32x16_bf16(pa[1][j], v1, o1[1], 0, 0, 0);
            }
        }
        if (t + 1 < NT) ATT_STORE(buf ^ 1);
    }
#undef ATT_LOAD
#undef ATT_STORE
    const float w0 = fnorm[h * 64 + r32], w1 = fnorm[h * 64 + 32 + r32];
#pragma unroll
    for (int g = 0; g < 2; ++g) {
        float lt = l[g]; lt += __shfl_xor(lt, 32);
        if (hi == 0) wsf[g * 32 + r32] = 1.0f / lt;
        LDS_WAIT();
#pragma unroll
        for (int g4 = 0; g4 < 4; ++g4) {
            const f32x4 a = *(const LAS f32x4*)(wsf + g * 32 + 8 * g4 + 4 * hi);
#pragma unroll
            for (int i = 0; i < 4; ++i) { o0[g][4 * g4 + i] *= a[i]; o1[g][4 * g4 + i] *= a[i]; }
        }
#pragma unroll
        for (int r = 0; r < 16; ++r) {
            float s = o0[g][r] * o0[g][r] + o1[g][r] * o1[g][r];
            s += __shfl_xor(s, 1); s += __shfl_xor(s, 2); s += __shfl_xor(s, 4); s += __shfl_xor(s, 8); s += __shfl_xor(s, 16);
            const float rs = rsqrtf(s * (1.0f / 64.0f) + EPS);
            bf16* op = OB + (rowb + q0 + wid * 64 + g * 32 + crow(r, hi)) * DM + 512 + h * 64 + r32;
            op[0] = f2bf(o0[g][r] * rs * w0); op[32] = f2bf(o1[g][r] * rs * w1);
        }
    }
    __syncthreads();
}
__device__ __forceinline__ void meta_attn(const bf16* QKV, const float* CK, bf16* OB, const float* fnorm, int p) {
    int tid_ = threadIdx.x; asm volatile("" : "+v"(tid_)); const int lane = tid_ & 63, h = tid_ >> 6;
    const float q = bf2f(QKV[(size_t)(META0 + p) * QP + C_FQ + h * 64 + lane]);
    float sc[NMETA], vv[NMETA];
#pragma unroll
    for (int s = 0; s < NMETA; ++s) {
        sc[s] = q * bf2f(QKV[(size_t)(META0 + s) * QP + C_FK + h * 64 + lane]);
        vv[s] = bf2f(QKV[(size_t)(META0 + s) * QP + C_FV + h * 64 + lane]);
    }
    float m = -1e30f;
#pragma unroll
    for (int s = 0; s < NMETA; ++s) { sc[s] = (s <= p) ? wave_sum(sc[s]) + CK[(size_t)h * CKP + s] : -INFINITY; m = fmaxf(m, sc[s]); }
    float l = 0.f, o = 0.f;
#pragma unroll
    for (int s = 0; s < NMETA; ++s) { const float pw = __builtin_amdgcn_exp2f(sc[s] - m); l += pw; o += pw * vv[s]; }
    o /= l;
    const float ss = wave_sum(o * o);
    OB[(size_t)(META0 + p) * DM + 512 + h * 64 + lane] = f2bf(o * rsqrtf(ss * (1.0f / 64.0f) + EPS) * fnorm[h * 64 + lane]);
}
template <int NU> __device__ __forceinline__ void gla_readout_wave(const bf16* QKV, const float* UT, bf16* OB, const float* gnorm, const int* bhs, const int* ccs, const int* halfs, int lane) {
    asm volatile("" : "+v"(lane));
    const int r32 = lane & 31, hi = lane >> 5;
    int row0[NU], nvalid[NU], hq[NU]; const float* Sp[NU];
    f32x16 acc[NU][4];
#pragma unroll
    for (int u = 0; u < NU; ++u) {
        const int b = bhs[u] >> 2; hq[u] = bhs[u] & 3;
        row0[u] = ccs[u] == 0 ? META0 : b * SEQ + (ccs[u] - 1) * 64 + 32 * halfs[u]; nvalid[u] = ccs[u] == 0 ? NMETA : 32;
        Sp[u] = UT + (size_t)(bhs[u] * NCH + ccs[u]) * 8192;
#pragma unroll
        for (int blk = 0; blk < 4; ++blk) acc[u][blk] = (f32x16){};
    }
#pragma unroll
    for (int j = 0; j < 4; ++j)
#pragma unroll
        for (int u = 0; u < NU; ++u) {
            const bf16x8 bq = *(const bf16x8*)(QKV + (size_t)(row0[u] + r32) * QP + C_GQ + hq[u] * 64 + 16 * j + 8 * hi);
#pragma unroll
            for (int blk = 0; blk < 4; ++blk) {
                const float* sp = Sp[u] + (32 * blk + r32) * 64 + 16 * j + 8 * hi;
                const f32x4 s0 = *(const f32x4*)sp, s1 = *(const f32x4*)(sp + 4);
                u32x4 w; w.x = pk2(s0[0], s0[1]); w.y = pk2(s0[2], s0[3]); w.z = pk2(s1[0], s1[1]); w.w = pk2(s1[2], s1[3]);
                acc[u][blk] = __builtin_amdgcn_mfma_f32_32x32x16_bf16(__builtin_bit_cast(bf16x8, w), bq, acc[u][blk], 0, 0, 0);
            }
        }
#pragma unroll
    for (int u = 0; u < NU; ++u) {
        float ss = 0.f;
#pragma unroll
        for (int blk = 0; blk < 4; ++blk)
#pragma unroll
            for (int r = 0; r < 16; ++r) ss += acc[u][blk][r] * acc[u][blk][r];
        ss += __shfl_xor(ss, 32);
        const float rs = rsqrtf(ss * (1.0f / 128.0f) + EPS);
        if (r32 < nvalid[u]) {
            const size_t row = (size_t)row0[u] + r32; const int h = hq[u];
#pragma unroll
            for (int blk = 0; blk < 4; ++blk)
#pragma unroll
                for (int g = 0; g < 4; ++g) {
                    const int dv = 32 * blk + 8 * g + 4 * hi;
                    const u32x2 gt = *(const u32x2*)(QKV + row * QP + C_GR + h * 128 + dv);
                    const f32x4 wn = *(const f32x4*)(gnorm + h * 128 + dv);
                    const float g0 = __uint_as_float(gt.x << 16), g1 = __uint_as_float(gt.x & 0xffff0000u), g2 = __uint_as_float(gt.y << 16), g3 = __uint_as_float(gt.y & 0xffff0000u);
                    u32x2 w;
                    w.x = pk2(acc[u][blk][4 * g] * rs * wn[0] * siluf(g0), acc[u][blk][4 * g + 1] * rs * wn[1] * siluf(g1));
                    w.y = pk2(acc[u][blk][4 * g + 2] * rs * wn[2] * siluf(g2), acc[u][blk][4 * g + 3] * rs * wn[3] * siluf(g3));
                    *(u32x2*)(OB + row * DM + h * 128 + dv) = w;
                }
        }
    }
}

__device__ __forceinline__ void gla_readout_chunk(const bf16* QKV, const float* UT, bf16* OB, const float* gnorm, int bh, int cc, int lane) {
    asm volatile("" : "+v"(lane));
    const int r32 = lane & 31, hi = lane >> 5, b = bh >> 2, h = bh & 3;
    const int row0 = b * SEQ + (cc - 1) * 64;
    const float* Sp = UT + (size_t)(bh * NCH + cc) * 8192;
    f32x16 acc[2][4];
#pragma unroll
    for (int u = 0; u < 2; ++u)
#pragma unroll
        for (int blk = 0; blk < 4; ++blk) acc[u][blk] = (f32x16){};
#pragma unroll 1
    for (int j = 0; j < 4; ++j) {
        const bf16x8 bq0 = *(const bf16x8*)(QKV + (size_t)(row0 + r32) * QP + C_GQ + h * 64 + 16 * j + 8 * hi);
        const bf16x8 bq1 = *(const bf16x8*)(QKV + (size_t)(row0 + 32 + r32) * QP + C_GQ + h * 64 + 16 * j + 8 * hi);
#pragma unroll
        for (int blk = 0; blk < 4; ++blk) {
            const float* sp = Sp + (32 * blk + r32) * 64 + 16 * j + 8 * hi;
            const f32x4 s0 = *(const f32x4*)sp, s1 = *(const f32x4*)(sp + 4);
            u32x4 w; w.x = pk2(s0[0], s0[1]); w.y = pk2(s0[2], s0[3]); w.z = pk2(s1[0], s1[1]); w.w = pk2(s1[2], s1[3]);
            const bf16x8 sa = __builtin_bit_cast(bf16x8, w);
            acc[0][blk] = __builtin_amdgcn_mfma_f32_32x32x16_bf16(sa, bq0, acc[0][blk], 0, 0, 0);
            acc[1][blk] = __builtin_amdgcn_mfma_f32_32x32x16_bf16(sa, bq1, acc[1][blk], 0, 0, 0);
        }
    }
#pragma unroll
    for (int u = 0; u < 2; ++u) {
        float ss = 0.f;
#pragma unroll
        for (int blk = 0; blk < 4; ++blk)
#pragma unroll
            for (int r = 0; r < 16; ++r) ss += acc[u][blk][r] * acc[u][blk][r];
        ss += __shfl_xor(ss, 32);
        const float rs = rsqrtf(ss * (1.0f / 128.0f) + EPS);
        const size_t row = (size_t)row0 + 32 * u + r32;
#pragma unroll
        for (int blk = 0; blk < 4; ++blk)
#pragma unroll
            for (int g = 0; g < 4; ++g) {
                const int dv = 32 * blk + 8 * g + 4 * hi;
                const u32x2 gt = *(const u32x2*)(QKV + row * QP + C_GR + h * 128 + dv);
                const f32x4 wn = *(const f32x4*)(gnorm + h * 128 + dv);
                const float g0 = __uint_as_float(gt.x << 16), g1 = __uint_as_float(gt.x & 0xffff0000u), g2 = __uint_as_float(gt.y << 16), g3 = __uint_as_float(gt.y & 0xffff0000u);
                u32x2 w;
                w.x = pk2(acc[u][blk][4 * g] * rs * wn[0] * siluf(g0), acc[u][blk][4 * g + 1] * rs * wn[1] * siluf(g1));
                w.y = pk2(acc[u][blk][4 * g + 2] * rs * wn[2] * siluf(g2), acc[u][blk][4 * g + 3] * rs * wn[3] * siluf(g3));
                *(u32x2*)(OB + row * DM + h * 128 + dv) = w;
            }
    }
}

#define FRESH() KArgs ka_ = kargs(); Args a; a.x = gptr(ka_->x); a.meta = gptr(ka_->meta); a.attn_norm = gptr(ka_->attn_norm); a.w_in = gptr(ka_->w_in); a.w_au = gptr(ka_->w_au); a.b_alpha = gptr(ka_->b_alpha); a.b_forget = gptr(ka_->b_forget); a.gla_norm = gptr(ka_->gla_norm); a.fox_norm = gptr(ka_->fox_norm); a.w_out = gptr(ka_->w_out); a.ffn_norm = gptr(ka_->ffn_norm); a.w_up = gptr(ka_->w_up); a.conv_w = gptr(ka_->conv_w); a.conv_b = gptr(ka_->conv_b); a.w_down = gptr(ka_->w_down); a.final_norm = gptr(ka_->final_norm); a.out = gptr(ka_->out); a.ws = gptr(ka_->ws); unsigned char* ws = a.ws; \
    bf16* HB = (bf16*)(ws + WS_HB); bf16* OB = (bf16*)(ws + WS_OB); bf16* QKV = (bf16*)(ws + WS_QKV); bf16* A2 = (bf16*)(ws + WS_QKV); \
    float* UT = (float*)(ws + WS_UT); float* HF = (float*)(ws + WS_UT); float* HL = (float*)(ws + WS_UT + HFL_SIZE); \
    float* SM = (float*)(ws + WS_SM); float* CK = (float*)(ws + WS_CK); float* DEC = (float*)(ws + WS_DEC); float* HM = (float*)(ws + WS_HM); float* SSQ = (float*)(ws + WS_SSQ); \
    unsigned char* wl = ws + WS_W + (size_t)L * WL_SIZE; \
    (void)HB; (void)OB; (void)QKV; (void)A2; (void)UT; (void)HF; (void)HL; (void)SM; (void)CK; (void)DEC; (void)HM; (void)SSQ; (void)wl; \
    int G_ = gridDim.x, bx_ = blockIdx.x; asm volatile("" : "+s"(G_), "+s"(bx_)); const int G = G_, bx = bx_; (void)G; (void)bx; \
    int tid_ = threadIdx.x; asm volatile("" : "+v"(tid_)); const int tid = tid_, lane = tid & 63, wid = __builtin_amdgcn_readfirstlane(tid >> 6); \
    const int gw = bx * 8 + wid, NGW = G * 8, gt = bx * 512 + tid, NGT = G * 512; (void)lane; (void)gw; (void)NGW; (void)gt; (void)NGT;
#ifndef REP_A
#define REP_A 1
#endif
#ifndef REP_CA
#define REP_CA 1
#endif
#ifndef REP_F
#define REP_F 1
#endif
#ifndef REP_B
#define REP_B 1
#endif
#ifndef REP_D
#define REP_D 1
#endif
#define GSYNC_CG() do { asm volatile("s_waitcnt vmcnt(0) lgkmcnt(0)" ::: "memory"); grid.sync(); __builtin_amdgcn_fence(__ATOMIC_ACQUIRE, "agent"); asm volatile("s_waitcnt vmcnt(0)" ::: "memory"); } while (0)
#ifdef PROBE_PH
#define PH_END(id) do { const unsigned long long tn_ = __builtin_amdgcn_s_memrealtime(); if ((PROBE_PH >> (id)) & 1) tsync += tn_ - tlast; tlast = tn_; } while (0)
#else
#define PH_END(id) do {} while (0)
#endif
#ifdef PROBE_SYNC
#define GSYNC() do { const unsigned long long t0_ = __builtin_amdgcn_s_memrealtime(); xcd_barrier(xbar); tsync += __builtin_amdgcn_s_memrealtime() - t0_; } while (0)
#else
#define GSYNC() do { XcdBarrier xb_; xb_.bar = (unsigned*)(gptr(kargs()->ws) + WS_BAR); xb_.x = xb_xcc_id(); xb_.st = (volatile LAS unsigned*)(lds + HALO_OFF + 8192 + 1024); xcd_barrier(xb_); } while (0)
#endif
__global__ void __launch_bounds__(512, 2) fwd_kernel(Args a_unused) {
    extern __shared__ __attribute__((aligned(16))) unsigned char lds_raw[];
    LAS unsigned char* lds = (LAS unsigned char*)lds_raw;
    cg::grid_group grid = cg::this_grid();
#if defined(PROBE_SYNC) || defined(PROBE_PH)
    unsigned long long tsync = 0ull, tlast = __builtin_amdgcn_s_memrealtime(); (void)tlast;
#endif
    volatile LAS unsigned* xst = (volatile LAS unsigned*)(lds + HALO_OFF + 8192 + 1024);
    if (threadIdx.x < 2) xst[threadIdx.x] = 0u;
    __syncthreads();
    (void)xcd_barrier_post((unsigned*)(gptr(kargs()->ws) + WS_BAR), xst);
#ifndef REP_P
#define REP_P 1
#endif
    for (int rep = 0; rep < REP_P; ++rep) {
        const int L = 0; FRESH();
        LAS float* scr = (LAS float*)(lds + wid * 16384);
        constexpr int I_IN = 16 * (NINP / 32), I_OUT = 16 * 32, I_UP = 16 * (NUP / 32), I_DN = (DFF / 64) * 32, I_L = I_IN + I_OUT + I_UP + I_DN;
        for (int it = gw; it < DEPTH * I_L; it += NGW) {
            const int L = it / I_L; int r = it % I_L;
            unsigned char* wl = ws + WS_W + (size_t)L * WL_SIZE;
            if (r < I_IN) { const int nb = NINP / 32; tr_item(a.w_in + (size_t)L * DM * 3096, 3096, (bf16*)(wl + WL_IN), DM, a.attn_norm + L * DM, 0, scr, 64 * (r / nb), 32 * (r % nb), lane); continue; } r -= I_IN;
            if (r < I_OUT) { tr_item(a.w_out + (size_t)L * DM * DM, DM, (bf16*)(wl + WL_OUT), DM, nullptr, 1, scr, 64 * (r / 32), 32 * (r % 32), lane); continue; } r -= I_OUT;
            if (r < I_UP) { const int nb = NUP / 32; tr_item(a.w_up + (size_t)L * DM * NUP, NUP, (bf16*)(wl + WL_UP), DM, a.ffn_norm + L * DM, 2, scr, 64 * (r / nb), 32 * (r % nb), lane); continue; } r -= I_UP;
            tr_item(a.w_down + (size_t)L * DFF * DM, DM, (bf16*)(wl + WL_DN), DFF, nullptr, 3, scr, 64 * (r / 32), 32 * (r % 32), lane);
        }
        for (int i = gt; i < (256 - NMETA) * 4; i += NGT) SSQ[(size_t)(META0 + NMETA) * 4 + i] = 0.f;
        for (int r = gw; r < MREAL + 256; r += NGW) {
            if (r < MREAL) row_to_bf16(a.x + (size_t)r * DM, HB + (size_t)r * DM, SSQ + (size_t)r * 4, nullptr, lane);
            else if (r < MREAL + NMETA) row_to_bf16(a.meta + (size_t)(r - MREAL) * DM, HB + (size_t)r * DM, SSQ + (size_t)r * 4, HM + (size_t)(r - MREAL) * DM, lane);
            else {
#pragma unroll
                for (int j = 0; j < 4; ++j) { ((f32x4*)(HM + (size_t)(r - MREAL) * DM) + lane)[64 * j] = (f32x4){0.f, 0.f, 0.f, 0.f};
                    ((u32x2*)(HB + (size_t)r * DM) + lane)[64 * j] = (u32x2){0u, 0u}; ((u32x2*)(OB + (size_t)r * DM) + lane)[64 * j] = (u32x2){0u, 0u}; }
            }
        }
    }
    GSYNC_CG(); PH_END(0);

    for (int L = 0; L < DEPTH; ++L) {
#ifndef SKIP_A
        {
            FRESH();
            pg8::Gemm g{HB, (const bf16*)(wl + WL_IN), MROWS, NINP, DM}; pg8::StaticOrder S; S.init(MROWS, NINP, G, bx);
            EpiIn E{2 * L};
            for (int rep = 0; rep < REP_A; ++rep) pg8::gemm_phase<EpiIn, pg8::StaticOrder, true, true>(lds, g, S, E);
        }
#endif
        GSYNC(); PH_END(1);
#ifndef SKIP_B
        { FRESH();
        for (int rep = 0; rep < REP_B; ++rep) {
        for (int gr = bx; gr < 16 * NCH; gr += G) gla_u_group<2>(lds, QKV, SM, a.w_au + (size_t)L * 16 * 256, a.b_alpha + L * 256, UT, DEC, gr);
        for (int u = (G == 256) ? bx - 64 + ((bx < 64) ? 256 : 0) : bx; u < 64; u += G) fox_cumsum_unit(lds, SM, a.b_forget + L * 8, CK, u);
        }
        }
#endif
        GSYNC(); PH_END(2);
#ifndef SKIP_CS
        { FRESH();
        for (int e = gt; e < 32 * 2048; e += NGT) {
            const int bh = e >> 11, rem = (e & 2047) * 4, dk = rem & 63;
            float* up = UT + (size_t)bh * NCH * 8192 + rem; const float* dp = DEC + (size_t)bh * NCH * 64 + dk;
            f32x4 Sv = *(const f32x4*)up;
            for (int c0 = 1; c0 <= 64; c0 += 8) {
                f32x4 uu[8], dd[8];
#pragma unroll
                for (int i = 0; i < 8; ++i) { uu[i] = *(const f32x4*)(up + (size_t)(c0 + i) * 8192); dd[i] = *(const f32x4*)(dp + (c0 + i) * 64); }
#pragma unroll
                for (int i = 0; i < 8; ++i) { Sv = dd[i] * Sv + uu[i]; *(f32x4*)(up + (size_t)(c0 + i) * 8192) = Sv; }
            }
        }
#ifdef REP_SCAN
        for (int e = gt; e < 32 * 2048; e += NGT) {
            const int bh = e >> 11, rem = (e & 2047) * 4, dk = rem & 63;
            float* up = UT + (size_t)bh * NCH * 8192 + rem; const float* dp = DEC + (size_t)bh * NCH * 64 + dk;
            for (int c0 = 1; c0 <= 64; c0 += 8) {
                f32x4 uu[8], dd[8];
#pragma unroll
                for (int i = 0; i < 8; ++i) { uu[i] = *(const f32x4*)(up + (size_t)(c0 + i) * 8192); dd[i] = *(const f32x4*)(dp + (c0 + i) * 64); }
#pragma unroll
                for (int i = 0; i < 8; ++i) { *(f32x4*)(up + (size_t)(c0 + i) * 8192) = uu[i] + dd[i] * 0.f; }
            }
        }
#endif
        }
        { FRESH();
        for (int rep = 0; rep < REP_CA; ++rep)
        for (int v0 = bx; v0 < 256; v0 += G) {
            const int v = (G == 256) ? (v0 & 7) * 32 + (v0 >> 3) : v0;
            const int bhh = v >> 2, s = v & 3;
#pragma unroll 1
            for (int i = 0; i < 2; ++i) {
                const int qb = (i == 0) ? s : 7 - s;
                attn_unit(lds, QKV, CK, OB, a.fox_norm + L * 512, bhh >> 3, bhh & 7, qb);
            }
        }
#endif
#ifndef SKIP_CM
        }
        { FRESH();
#ifndef REP_CM
#define REP_CM 1
#endif
        for (int rep = 0; rep < REP_CM; ++rep)
        if (bx < NMETA) meta_attn(QKV, CK, OB, a.fox_norm + L * 512, bx);
        if (bx >= NMETA && bx < NMETA + 4 && wid == 0) { const int bhs[1] = {bx - NMETA}, ccs[1] = {0}, hfs[1] = {0}; gla_readout_wave<1>(QKV, UT, OB, a.gla_norm + L * 512, bhs, ccs, hfs, lane); }
        }
#endif
        GSYNC(); PH_END(3);
#ifndef SKIP_D
        { FRESH();
        for (int rep = 0; rep < REP_D; ++rep)
        for (int wu = gw; wu < 32 * 64; wu += NGW) gla_readout_chunk(QKV, UT, OB, a.gla_norm + L * 512, wu >> 6, 1 + (wu & 63), lane);
        }
#endif
        GSYNC(); PH_END(4);
#ifndef SKIP_E
        {
            FRESH();
            meta_rowgemm(OB + (size_t)META0 * DM, DM, (const bf16*)(wl + WL_OUT), DM, HM, HB, G, bx);
            pg8::Gemm g{OB, (const bf16*)(wl + WL_OUT), MREAL, DM, DM}; pg8::StaticOrder S; S.init(MREAL, DM, G, bx);
            if (L == 0) { EpiRes<true, false> E{2 * L + 1}; pg8::gemm_phase<EpiRes<true, false>, pg8::StaticOrder, true, true>(lds, g, S, E); }
            else { EpiRes<false, false> E{2 * L + 1}; pg8::gemm_phase<EpiRes<false, false>, pg8::StaticOrder, true, true>(lds, g, S, E); }
        }
#endif
        GSYNC(); PH_END(5);
#ifndef SKIP_F
        {
            FRESH();
            meta_up(lds, HB, (const bf16*)(wl + WL_UP), HM, a.conv_w + (size_t)L * 3 * NUP, a.conv_b + (size_t)L * NUP, A2, HL, G, bx);
            pg8::Gemm g{HB, (const bf16*)(wl + WL_UP), MREAL, NUP, DM}; pg8::StaticOrder S; S.init(MREAL, NUP, G, bx);
            EpiUp E{L};
            for (int rep = 0; rep < REP_F; ++rep) pg8::gemm_phase<EpiUp, pg8::StaticOrder, true, true>(lds, g, S, E);
        }
#endif
        GSYNC(); PH_END(6);
#ifndef SKIP_H
        {
            FRESH();
            const float* cw = a.conv_w + (size_t)L * 3 * NUP; const float* cb = a.conv_b + (size_t)L * NUP;
            { int pm = 0;
              for (int ui = 0; so_next_pm(MREAL / 256, DM / 256, G, bx, ui, pm); ++ui) {
                for (int i = tid; i < 2 * (DFF / 4); i += 512) {
                    const int c4 = i % (DFF / 4), rr = i / (DFF / 4);
                    const int ch = 4 * c4;
                    f32x4 hc[2];
#pragma unroll
                    for (int bj = 0; bj < 2; ++bj) {
                        const int c = bj * DFF + ch;
                        f32x4 P0 = {0.f, 0.f, 0.f, 0.f}, P1 = P0;
                        if (pm != 128) { const int src = (pm % 16 == 0) ? 128 : pm - 1; P0 = *(const f32x4*)(HL + (size_t)(src * 2) * NUP + c); P1 = *(const f32x4*)(HL + (size_t)(src * 2 + 1) * NUP + c); }
                        const f32x4 H0 = *(const f32x4*)(HF + (size_t)(pm * 2) * NUP + c), H1 = *(const f32x4*)(HF + (size_t)(pm * 2 + 1) * NUP + c);
                        const f32x4 x2 = rr == 0 ? P0 : P1, x1 = rr == 0 ? P1 : H0, x0 = rr == 0 ? H0 : H1;
                        hc[bj] = *(const f32x4*)(cb + c) + *(const f32x4*)(cw + c) * x2 + *(const f32x4*)(cw + NUP + c) * x1 + *(const f32x4*)(cw + 2 * NUP + c) * x0;
                    }
                    u32x2 w;
                    w.x = pk2(siluf(hc[1][0]) * hc[0][0], siluf(hc[1][1]) * hc[0][1]);
                    w.y = pk2(siluf(hc[1][2]) * hc[0][2], siluf(hc[1][3]) * hc[0][3]);
                    *(u32x2*)(A2 + (size_t)(pm * 256 + rr) * DFF + ch) = w;
                }
              }
            }
            asm volatile("s_waitcnt vmcnt(0)" ::: "memory"); __syncthreads();
            meta_rowgemm(A2 + (size_t)META0 * DFF, DFF, (const bf16*)(wl + WL_DN), DFF, HM, HB, G, bx);
            pg8::Gemm g{A2, (const bf16*)(wl + WL_DN), MREAL, DM, DFF}; pg8::StaticOrder S; S.init(MREAL, DM, G, bx);
            if (L == DEPTH - 1) { EpiRes<false, true> E{2 * L + 2}; pg8::gemm_phase<EpiRes<false, true>, pg8::StaticOrder, true, true>(lds, g, S, E); }
            else { EpiRes<false, false> E{2 * L + 2}; pg8::gemm_phase<EpiRes<false, false>, pg8::StaticOrder, true, true>(lds, g, S, E); }
        }
#endif
        GSYNC(); PH_END(7);
    }
    {
        const int L = 0; FRESH();
        const float* ssq = ssq_arr(ws, 8);
        for (int r = gw; r < MREAL; r += NGW) {
            const float rs = row_rstd(ssq, r);
            f32x4* p = (f32x4*)(a.out + (size_t)r * DM) + lane; const f32x4* wn = (const f32x4*)a.final_norm + lane;
#pragma unroll
            for (int j = 0; j < 4; ++j) p[64 * j] = p[64 * j] * rs * wn[64 * j];
        }
#if defined(PROBE_SYNC) || defined(PROBE_PH)
        asm volatile("s_waitcnt vmcnt(0)" ::: "memory"); __syncthreads();
        if (bx == PROBE_BLOCK && tid == 0) a.out[(size_t)PROBE_BLOCK * 16 * DM * 0 + 5] += floorf((float)tsync * 0.0002f + 0.5f);
#endif
    }
}

extern "C" void kernel_launch(void* const* d_in, const int* in_sizes, int n_in, void* d_out, int out_size, void* d_ws, size_t ws_size, hipStream_t stream) {
    static int grid = 0;
    if (grid == 0) {
        if (n_in != 16 || out_size != MREAL * DM || ws_size < WS_END) { fprintf(stderr, "kernel_launch: unexpected problem (n_in %d out %d ws %zu, need %zu)\n", n_in, out_size, ws_size, (size_t)WS_END); grid = -1; return; }
        int dev = 0, cus = 0, per = 0;
        (void)hipGetDevice(&dev); (void)hipDeviceGetAttribute(&cus, hipDeviceAttributeMultiprocessorCount, dev);
        (void)hipFuncSetAttribute((const void*)fwd_kernel, hipFuncAttributeMaxDynamicSharedMemorySize, LDS_BYTES);
        (void)hipOccupancyMaxActiveBlocksPerMultiprocessor(&per, (const void*)fwd_kernel, 512, LDS_BYTES);
        if (per < 1) per = 1;
        grid = cus * per;
        fprintf(stderr, "kernel_launch: grid %d (cus %d x %d), ws %zu\n", grid, cus, per, ws_size);
    }
    if (grid < 0) return;
    Args a{};
    const float** f = (const float**)&a;
    for (int i = 0; i < 16; ++i) f[i] = (const float*)d_in[i];
    a.out = (float*)d_out; a.ws = (unsigned char*)d_ws;
    (void)hipMemsetAsync((unsigned char*)d_ws + WS_BAR, 0, BAR_BYTES, stream);
    void* args[] = {&a};
    hipError_t e = hipLaunchCooperativeKernel((const void*)fwd_kernel, dim3(grid), dim3(512), args, LDS_BYTES, stream);
    if (e != hipSuccess) fprintf(stderr, "cooperative launch failed: %s (grid %d)\n", hipGetErrorString(e), grid);
}
```

```cpp
#include <hip/hip_runtime.h>
#include <hip/hip_cooperative_groups.h>
#include <cstdio>
#include <cstdint>
namespace cg = cooperative_groups;
namespace pg8 {
#define PG8_LAS __attribute__((address_space(3)))
typedef unsigned short bf16_t;
typedef short bf16x8 __attribute__((ext_vector_type(8)));
typedef float f32x4 __attribute__((ext_vector_type(4)));
typedef unsigned u32x4 __attribute__((ext_vector_type(4)));
constexpr int BM = 256, BK = 64, HALF = 128, HTB = HALF * BK * 2  , STAGE_BYTES = 8 * HTB, NXCD = 8, WGM = 8;

__host__ __device__ __forceinline__ int lds_byte(int r, int c) { const int st = (r >> 4) * 2 + (c >> 5), rr = r & 15, cc = c & 31, ob = rr * 64 + cc * 2; return st * 1024 + (ob ^ (((ob >> 9) & 1) << 5)); }
__host__ __device__ __forceinline__ void stage_rc(int b, int& R, int& C) { const int st = b / 1024, sb = b % 1024, swz = sb ^ (((sb >> 9) & 1) << 5); R = (st >> 1) * 16 + swz / 64; C = (st & 1) * 32 + (swz % 64) / 2; }
__host__ __device__ __forceinline__ int perm32(int rho) { const int n = rho >> 4, i = rho & 15; return 8 * (i >> 2) + 4 * n + (i & 3); }

struct Unit { int pm, pn; };
struct Gemm { const bf16_t* A; const bf16_t* Bt; int M, N, K; };

struct StaticOrder {
    int nM, nN, nwg, G, c;
    __host__ __device__ void init(int M, int N, int G_, int c_) { nM = M / BM; nN = N / BM; nwg = nM * nN; G = G_; c = c_; }
    __host__ __device__ bool next(int i, Unit& u) const {
        const long L = (long)i * G + c; if (L >= nwg) return false;
        int wgid = (int)L; { const int q = nwg / NXCD, r = nwg % NXCD, xcd = wgid % NXCD, off = wgid / NXCD; wgid = (xcd < r ? xcd * (q + 1) : r * (q + 1) + (xcd - r) * q) + off; }
        const int nig = WGM * nN, gid = wgid / nig, fm = gid * WGM, gsz = (nM - fm) < WGM ? (nM - fm) : WGM;
        u.pm = fm + ((wgid % nig) % gsz); u.pn = (wgid % nig) / gsz; return true;
    }
    __device__ __forceinline__ void a_ready(const Unit&) const {}
    __device__ __forceinline__ void done(const Unit&) const {}
};

__device__ __forceinline__ unsigned cvt_pk_bf16(float lo, float hi) { unsigned r; asm volatile("v_cvt_pk_bf16_f32 %0, %1, %2" : "=v"(r) : "v"(lo), "v"(hi)); return r; }
typedef float f32x2 __attribute__((ext_vector_type(2)));
template <class Epi, class Sched, bool ALIGN_EPI = false, bool SP2 = false>
__device__ __forceinline__ void gemm_phase(PG8_LAS unsigned char* lds, const Gemm g, const Sched& S, const Epi& E) {
    int tid_ = threadIdx.x; asm volatile("" : "+v"(tid_)); const int tid = tid_, wid = __builtin_amdgcn_readfirstlane(tid >> 6), lane = tid & 63, wr = wid >> 2, wc = wid & 3, fr = lane & 15, fq = lane >> 4;
    const int K = g.K, nt = K / BK;
    unsigned voffA[2], voffB[2];
#pragma unroll
    for (int i = 0; i < 2; ++i) { int R, C; stage_rc(tid * 16 + i * 8192, R, C); const int Rb = Epi::PERM ? ((R & ~31) + perm32(R & 31)) : R;
        voffA[i] = (unsigned)(R * K + C) * 2u; voffB[i] = (unsigned)(Rb * K + C) * 2u; }
    const size_t kstep = (size_t)(BK * 2);
    const size_t hstep = (size_t)HALF * K * 2;
    const size_t tstep = 2 * hstep;
    const unsigned ldsw = (unsigned)wid * 1024u;
    const int aoff = lds_byte(wr * 64 + fr, fq * 8), boff = lds_byte(wc * 32 + fr, fq * 8);
#define PG8_SA(b, h) (((b) * 2 + (h)) * HTB)
#define PG8_SB(b, h) ((4 + (b) * 2 + (h)) * HTB)
#define PG8_STAGE(bufoff, gbase, voff) do { _Pragma("unroll") for (int _i = 0; _i < 2; ++_i) \
        __builtin_amdgcn_global_load_lds((const unsigned*)((const char*)(gbase) + (voff)[_i]), (PG8_LAS unsigned*)(lds + (bufoff) + ldsw + _i * 8192), 16, 0, 0); } while (0)
#define PG8_LDA(dst, b, h) do { _Pragma("unroll") for (int m = 0; m < 4; ++m) _Pragma("unroll") for (int k = 0; k < 2; ++k) dst[m][k] = *(const PG8_LAS bf16x8*)(lds + PG8_SA(b, h) + aoff + m * 2048 + k * 1024); } while (0)
#define PG8_LDB(dst, b, h) do { _Pragma("unroll") for (int n = 0; n < 2; ++n) _Pragma("unroll") for (int k = 0; k < 2; ++k) dst[n][k] = *(const PG8_LAS bf16x8*)(lds + PG8_SB(b, h) + boff + n * 2048 + k * 1024); } while (0)
#define PG8_MMA(ai, bj, At, Bt) do { __builtin_amdgcn_s_setprio(1); _Pragma("unroll") for (int m = 0; m < 4; ++m) _Pragma("unroll") for (int n = 0; n < 2; ++n) _Pragma("unroll") for (int k = 0; k < 2; ++k) \
        acc[ai][bj][m][n] = __builtin_amdgcn_mfma_f32_16x16x32_bf16(Bt[n][k], At[m][k], acc[ai][bj][m][n], 0, 0, 0); __builtin_amdgcn_s_setprio(0); } while (0)
#define PG8_WAIT_V(n) asm volatile("s_waitcnt vmcnt(" #n ")" ::: "memory")
#define PG8_WAIT_L(n) asm volatile("s_waitcnt lgkmcnt(" #n ")" ::: "memory")
#define PG8_BAR __builtin_amdgcn_s_barrier()
#define PG8_SCHED __builtin_amdgcn_sched_barrier(0)
    Unit cur, nxt; int ui = 0;
    if (!S.next(0, cur)) return;
    f32x4 acc[2][2][4][2];
#pragma unroll
    for (int a = 0; a < 2; ++a)
#pragma unroll
        for (int b = 0; b < 2; ++b)
#pragma unroll
            for (int m = 0; m < 4; ++m)
#pragma unroll
                for (int n = 0; n < 2; ++n) acc[a][b][m][n] = (f32x4){0.f, 0.f, 0.f, 0.f};
    bf16x8 At[4][2], B0[2][2], B1[2][2];
    const char* cA = (const char*)g.A + (size_t)cur.pm * tstep; const char* cB = (const char*)g.Bt + (size_t)cur.pn * tstep;
    S.a_ready(cur);
    if constexpr (SP2) {
        PG8_STAGE(PG8_SB(0, 0), cB, voffB); PG8_STAGE(PG8_SB(0, 1), cB + hstep, voffB); PG8_STAGE(PG8_SA(0, 0), cA, voffA); PG8_STAGE(PG8_SA(0, 1), cA + hstep, voffA);
        if (wr == 1) PG8_BAR;
        PG8_WAIT_V(2); PG8_BAR;
        PG8_STAGE(PG8_SB(1, 0), cB + kstep, voffB); PG8_STAGE(PG8_SA(1, 0), cA + kstep, voffA); PG8_STAGE(PG8_SB(1, 1), cB + hstep + kstep, voffB);
        PG8_WAIT_V(6); PG8_BAR;
    } else {
        PG8_STAGE(PG8_SB(0, 0), cB, voffB); PG8_STAGE(PG8_SA(0, 0), cA, voffA); PG8_STAGE(PG8_SB(0, 1), cB + hstep, voffB); PG8_STAGE(PG8_SA(0, 1), cA + hstep, voffA);
        if (wr == 1) PG8_BAR;
        PG8_WAIT_V(4); PG8_BAR;
        PG8_STAGE(PG8_SB(1, 0), cB + kstep, voffB); PG8_STAGE(PG8_SA(1, 0), cA + kstep, voffA); PG8_STAGE(PG8_SB(1, 1), cB + hstep + kstep, voffB);
        PG8_WAIT_V(6); PG8_BAR;
    }
    for (;;) {
        const bool has_next = S.next(ui + 1, nxt);
        const char* nA = has_next ? (const char*)g.A + (size_t)nxt.pm * tstep : cA; const char* nB = has_next ? (const char*)g.Bt + (size_t)nxt.pn * tstep : cB;
        for (int t = 0; t < nt; t += 2) {
            const bool last = (t == nt - 2);
            const char* a1 = cA + (size_t)(t + 1) * kstep;
            const char* a2 = last ? nA : cA + (size_t)(t + 2) * kstep; const char* b2 = last ? nB : cB + (size_t)(t + 2) * kstep;
            const char* a3 = a2 + kstep; const char* b3 = b2 + kstep;
            if (last && has_next) S.a_ready(nxt);
            if constexpr (SP2) {
            PG8_LDB(B0, 0, 0); PG8_LDB(B1, 0, 1); PG8_SCHED; PG8_LDA(At, 0, 0); PG8_STAGE(PG8_SA(1, 1), a1 + hstep, voffA);
            PG8_WAIT_V(8); PG8_WAIT_L(0); PG8_BAR; PG8_MMA(0, 0, At, B0); PG8_MMA(0, 1, At, B1); PG8_BAR; PG8_SCHED;
            PG8_LDA(At, 0, 1); PG8_STAGE(PG8_SB(0, 0), b2, voffB); PG8_STAGE(PG8_SB(0, 1), b2 + hstep, voffB); PG8_STAGE(PG8_SA(0, 0), a2, voffA);
            PG8_WAIT_V(8); PG8_WAIT_L(0); PG8_BAR; PG8_MMA(1, 0, At, B0); PG8_MMA(1, 1, At, B1); PG8_BAR; PG8_SCHED;
            PG8_LDB(B0, 1, 0); PG8_LDB(B1, 1, 1); PG8_SCHED; PG8_LDA(At, 1, 0); PG8_STAGE(PG8_SA(0, 1), a2 + hstep, voffA);
            PG8_WAIT_V(8); PG8_WAIT_L(0); PG8_BAR; PG8_MMA(0, 0, At, B0); PG8_MMA(0, 1, At, B1); PG8_BAR; PG8_SCHED;
            PG8_LDA(At, 1, 1); PG8_STAGE(PG8_SB(1, 0), b3, voffB); PG8_STAGE(PG8_SB(1, 1), b3 + hstep, voffB); PG8_STAGE(PG8_SA(1, 0), a3, voffA);
            PG8_WAIT_V(8); PG8_WAIT_L(0); PG8_BAR; PG8_MMA(1, 0, At, B0); PG8_MMA(1, 1, At, B1); PG8_BAR; PG8_SCHED;
            } else {
            PG8_LDB(B0, 0, 0); PG8_SCHED; PG8_LDA(At, 0, 0); PG8_STAGE(PG8_SA(1, 1), a1 + hstep, voffA);
            PG8_WAIT_L(8); PG8_BAR; PG8_WAIT_L(0); PG8_MMA(0, 0, At, B0); PG8_BAR; PG8_SCHED;
            PG8_LDB(B1, 0, 1); PG8_STAGE(PG8_SB(0, 0), b2, voffB);
            PG8_BAR; PG8_WAIT_L(0); PG8_MMA(0, 1, At, B1); PG8_BAR;
            PG8_LDA(At, 0, 1); PG8_STAGE(PG8_SA(0, 0), a2, voffA);
            PG8_BAR; PG8_WAIT_L(0); PG8_MMA(1, 0, At, B0); PG8_BAR; PG8_SCHED;
            PG8_STAGE(PG8_SB(0, 1), b2 + hstep, voffB);
            PG8_WAIT_V(6); PG8_BAR; PG8_MMA(1, 1, At, B1); PG8_BAR;
            PG8_LDB(B0, 1, 0); PG8_SCHED; PG8_LDA(At, 1, 0); PG8_STAGE(PG8_SA(0, 1), a2 + hstep, voffA);
            PG8_WAIT_L(8); PG8_BAR; PG8_WAIT_L(0); PG8_MMA(0, 0, At, B0); PG8_BAR; PG8_SCHED;
            PG8_LDB(B1, 1, 1); PG8_STAGE(PG8_SB(1, 0), b3, voffB);
            PG8_BAR; PG8_WAIT_L(0); PG8_MMA(0, 1, At, B1); PG8_BAR;
            PG8_LDA(At, 1, 1); PG8_STAGE(PG8_SA(1, 0), a3, voffA);
            PG8_BAR; PG8_WAIT_L(0); PG8_MMA(1, 0, At, B0); PG8_BAR; PG8_SCHED;
            PG8_STAGE(PG8_SB(1, 1), b3 + hstep, voffB);
            PG8_WAIT_V(6); PG8_BAR; PG8_MMA(1, 1, At, B1); PG8_BAR;
            }
        }
        if constexpr (ALIGN_EPI) { if (wr == 0) PG8_BAR; }
        if constexpr (!Epi::AFTER_DRAIN) { E(acc, cur, wr, wc, fr, fq); S.done(cur); }
        if (!has_next) break;
#pragma unroll
        for (int a = 0; a < 2; ++a)
#pragma unroll
            for (int b = 0; b < 2; ++b)
#pragma unroll
                for (int m = 0; m < 4; ++m)
#pragma unroll
                    for (int n = 0; n < 2; ++n) acc[a][b][m][n] = (f32x4){0.f, 0.f, 0.f, 0.f};
        cur = nxt; cA = nA; cB = nB; ++ui;
        if constexpr (ALIGN_EPI) { if (wr == 1) PG8_BAR; }
    }
    PG8_WAIT_V(0);
    if constexpr (!ALIGN_EPI) { if (wr == 0) PG8_BAR; }
    PG8_BAR;
    if constexpr (Epi::AFTER_DRAIN) { E.fused(acc, cur, wr, wc, fr, fq, lds, wid, lane); S.done(cur); }
#undef PG8_SA
#undef PG8_SB
#undef PG8_STAGE
#undef PG8_LDA
#undef PG8_LDB
#undef PG8_MMA
#undef PG8_WAIT_V
#undef PG8_WAIT_L
#undef PG8_BAR
#undef PG8_SCHED
}
}
#define LAS __attribute__((address_space(3)))
typedef unsigned short bf16;
typedef short bf16x8 __attribute__((ext_vector_type(8)));
typedef short s16x4 __attribute__((ext_vector_type(4)));
typedef float f32x4 __attribute__((ext_vector_type(4)));
typedef float f32x16 __attribute__((ext_vector_type(16)));
typedef unsigned u32x4 __attribute__((ext_vector_type(4)));
typedef unsigned u32x2 __attribute__((ext_vector_type(2)));

constexpr int NB = 8, SEQ = 4096, DM = 1024, DEPTH = 4, NMETA = 16;
constexpr int MREAL = NB * SEQ;
constexpr int META0 = MREAL;
constexpr int MROWS = 129 * 256;
constexpr int NINP = 3328, QP = 3072;
constexpr int C_FQ = 0, C_FK = 512, C_FV = 1024, C_GQ = 1536, C_GK = 1792, C_GV = 2048, C_GR = 2560;
constexpr int DFF = 2816, NUP = 5632;
constexpr float EPS = 1e-6f, LOG2E = 1.4426950408889634f, C2 = 0.125f * LOG2E;
constexpr int CKP = 4160;
constexpr int NCH = 65;

constexpr size_t MiB = 1u << 20;
constexpr size_t WL_IN = 0, WL_OUT = 6815744, WL_UP = 8912896, WL_DN = 20447232, WL_SIZE = 26214400;
constexpr size_t WS_W = 0, WS_HB = 100 * MiB, WS_OB = WS_HB + 67633152, WS_QKV = WS_OB + 67633152, WS_UT = WS_QKV + 202899456;
constexpr size_t WS_SM = WS_UT + 68157440, WS_CK = WS_SM + 4456448, WS_DEC = WS_CK + 1310720, WS_HM = WS_DEC + 786432, WS_SSQ = WS_HM + MiB, WS_BAR = WS_SSQ + 1835008, BAR_BYTES = 16384, WS_END = WS_BAR + BAR_BYTES;
static_assert(WS_END <= 512 * MiB, "workspace map");
constexpr size_t HFL_SIZE = (size_t)129 * 2 * NUP * 4;
static_assert(2 * HFL_SIZE <= 68157440, "halo overlay");

constexpr int LDS_BYTES = 147456, HALO_OFF = 131072;

struct Args {
    const float *x, *meta, *attn_norm, *w_in, *w_au, *b_alpha, *b_forget, *gla_norm, *fox_norm, *w_out, *ffn_norm, *w_up, *conv_w, *conv_b, *w_down, *final_norm;
    float* out; unsigned char* ws;
};

#define GAS __attribute__((address_space(1)))
#define CAS __attribute__((address_space(4)))
typedef const CAS Args* KArgs;
__device__ __forceinline__ KArgs kargs() { KArgs p = (KArgs)__builtin_amdgcn_kernarg_segment_ptr(); asm volatile("" : "+s"(p)); return p; }
template <class T> __device__ __forceinline__ T* gptr(T* p) { return (T*)(GAS T*)p; }
__device__ __forceinline__ float bf2f(bf16 v) { return __uint_as_float((unsigned)v << 16); }
__device__ __forceinline__ unsigned pk2(float lo, float hi) { return pg8::cvt_pk_bf16(lo, hi); }
__device__ __forceinline__ bf16 f2bf(float v) { return (bf16)(pk2(v, 0.f) & 0xffffu); }
__device__ __forceinline__ float wave_sum(float v) {
#pragma unroll
    for (int o = 1; o < 64; o <<= 1) v += __shfl_xor(v, o);
    return v;
}
__device__ __forceinline__ float logsigmoidf(float z) { return -(fmaxf(-z, 0.f) + log1pf(__expf(-fabsf(z)))); }
__device__ __forceinline__ float siluf(float v) { return v * __builtin_amdgcn_rcpf(1.f + __builtin_amdgcn_exp2f(-LOG2E * v)); }
__device__ __forceinline__ int crow(int r, int hi) { return (r & 3) + 8 * (r >> 2) + 4 * hi; }
__device__ __forceinline__ s16x4 vtr(const LAS unsigned char* p) { return __builtin_bit_cast(s16x4, __builtin_amdgcn_ds_read_tr16_b64_v4i16((LAS s16x4*)p)); }
__device__ __forceinline__ bf16x8 cat8(s16x4 a, s16x4 b) { return (bf16x8){a[0], a[1], a[2], a[3], b[0], b[1], b[2], b[3]}; }
__device__ __forceinline__ float dppf(float old, float src, int ctrl_unused);
#define DPP_MOV(old, src, ctrl) __builtin_bit_cast(float, __builtin_amdgcn_update_dpp(__builtin_bit_cast(int, (float)(old)), __builtin_bit_cast(int, (float)(src)), (ctrl), 0xf, 0xf, false))
#define LDS_WAIT() asm volatile("s_waitcnt lgkmcnt(0)" ::: "memory")

__device__ __forceinline__ const float* ssq_arr(unsigned char* wsb, int si) { return (const float*)(wsb + WS_SSQ) + (size_t)(si % 3) * MROWS * 4; }
__device__ __forceinline__ float row_rstd(const float* ssqp, int row) { const f32x4 s = *(const f32x4*)(ssqp + (size_t)row * 4); return rsqrtf(((s[0] + s[1]) + (s[2] + s[3])) * (1.0f / DM) + EPS); }
__device__ __forceinline__ LAS float* tile_rstd(unsigned char* wsb, int si, int pm, int wr, int wc, int fr, int fq) {
    extern __shared__ __attribute__((aligned(16))) unsigned char lds_dyn_[];
    LAS float* rsl = (LAS float*)((LAS unsigned char*)lds_dyn_ + HALO_OFF + 8192);
    const int tl = (wr * 4 + wc) * 64 + fq * 16 + fr;
    if (pm != 128) {
        if (tl < 256) rsl[tl] = row_rstd(ssq_arr(wsb, si), pm * 256 + tl);
    } else {
        const int row = tl >> 5, part = tl & 31;
        const f32x4* hp = (const f32x4*)((const float*)(wsb + WS_HM) + (size_t)row * DM) + part;
        float s = 0.f;
#pragma unroll
        for (int j = 0; j < 8; ++j) { const f32x4 v = hp[32 * j]; s += (v[0] * v[0] + v[1] * v[1]) + (v[2] * v[2] + v[3] * v[3]); }
        s += __shfl_xor(s, 1); s += __shfl_xor(s, 2); s += __shfl_xor(s, 4); s += __shfl_xor(s, 8); s += __shfl_xor(s, 16);
        if (part == 0) rsl[row] = rsqrtf(s * (1.0f / DM) + EPS);
        if (tl < 240) rsl[16 + tl] = 0.f;
    }
    asm volatile("s_waitcnt lgkmcnt(0)" ::: "memory"); __builtin_amdgcn_s_barrier(); asm volatile("" ::: "memory");
    return rsl;
}
__device__ __forceinline__ void meta_rowgemm(const bf16* A, int lda, const bf16* Bt, int K, float* HM, bf16* HB, int G, int bx) {
    int tid_ = threadIdx.x; asm volatile("" : "+v"(tid_)); const int r = tid_ >> 5, kp = tid_ & 31;
    for (int cg = bx; cg < 256; cg += G) {
        float acc[4] = {0.f, 0.f, 0.f, 0.f};
        for (int k0 = kp * 8; k0 < K; k0 += 256) {
            const u32x4 av = *(const u32x4*)(A + (size_t)r * lda + k0);
#pragma unroll
            for (int j = 0; j < 4; ++j) {
                const u32x4 bv = *(const u32x4*)(Bt + (size_t)(4 * cg + j) * K + k0);
#pragma unroll
                for (int q = 0; q < 4; ++q) {
                    acc[j] += __uint_as_float(av[q] << 16) * __uint_as_float(bv[q] << 16);
                    acc[j] += __uint_as_float(av[q] & 0xffff0000u) * __uint_as_float(bv[q] & 0xffff0000u);
                }
            }
        }
#pragma unroll
        for (int j = 0; j < 4; ++j) { float s = acc[j]; s += __shfl_xor(s, 1); s += __shfl_xor(s, 2); s += __shfl_xor(s, 4); s += __shfl_xor(s, 8); s += __shfl_xor(s, 16); acc[j] = s; }
        if (kp == 0) {
            float* hp = HM + (size_t)r * DM + 4 * cg;
            const f32x4 h = *(const f32x4*)hp + (f32x4){acc[0], acc[1], acc[2], acc[3]};
            *(f32x4*)hp = h;
            u32x2 w; w.x = pk2(h[0], h[1]); w.y = pk2(h[2], h[3]);
            *(u32x2*)(HB + (size_t)(META0 + r) * DM + 4 * cg) = w;
        }
    }
}
__device__ __forceinline__ void meta_up(LAS unsigned char* lds, const bf16* HB, const bf16* Wup, const float* HM, const float* cw, const float* cb, bf16* A2, float* HL, int G, int bx) {
    int tid_ = threadIdx.x; asm volatile("" : "+v"(tid_)); const int tid = tid_, r = tid >> 5, kp = tid & 31;
    LAS float* hb = (LAS float*)lds;
    float rs;
    { const f32x4* hp = (const f32x4*)(HM + (size_t)r * DM) + kp; float s = 0.f;
#pragma unroll
      for (int j = 0; j < 8; ++j) { const f32x4 v = hp[32 * j]; s += (v[0] * v[0] + v[1] * v[1]) + (v[2] * v[2] + v[3] * v[3]); }
      s += __shfl_xor(s, 1); s += __shfl_xor(s, 2); s += __shfl_xor(s, 4); s += __shfl_xor(s, 8); s += __shfl_xor(s, 16);
      rs = rsqrtf(s * (1.0f / DM) + EPS); }
    u32x4 av[4];
#pragma unroll
    for (int i = 0; i < 4; ++i) av[i] = *(const u32x4*)(HB + (size_t)(META0 + r) * DM + kp * 8 + 256 * i);
    for (int cg = bx; cg < 256; cg += G) {
#pragma unroll 1
        for (int cb0 = 0; cb0 < 24; cb0 += 6) {
            u32x4 bv[6][4];
#pragma unroll
            for (int c6 = 0; c6 < 6; ++c6) {
                const int c = cb0 + c6 < 22 ? cb0 + c6 : 21, isg = c >= 11 ? 1 : 0, jj = c - 11 * isg;
                const int ch = 11 * cg + jj, wrow = (ch >> 7) * 256 + isg * 128 + (ch & 127);
#pragma unroll
                for (int i = 0; i < 4; ++i) bv[c6][i] = *(const u32x4*)(Wup + (size_t)wrow * DM + kp * 8 + 256 * i);
            }
#pragma unroll
            for (int c6 = 0; c6 < 6; ++c6) {
                float acc = 0.f;
#pragma unroll
                for (int i = 0; i < 4; ++i)
#pragma unroll
                    for (int q = 0; q < 4; ++q) {
                        acc += __uint_as_float(av[i][q] << 16) * __uint_as_float(bv[c6][i][q] << 16);
                        acc += __uint_as_float(av[i][q] & 0xffff0000u) * __uint_as_float(bv[c6][i][q] & 0xffff0000u);
                    }
                acc += __shfl_xor(acc, 1); acc += __shfl_xor(acc, 2); acc += __shfl_xor(acc, 4); acc += __shfl_xor(acc, 8); acc += __shfl_xor(acc, 16);
                if (kp == 0 && cb0 + c6 < 22) hb[r * 24 + cb0 + c6] = acc * rs;
            }
        }
        __syncthreads();
        if (tid < 16 * 11) {
            const int rr = tid / 11, jj = tid % 11, ch = 11 * cg + jj;
            float hc[2];
#pragma unroll
            for (int ug = 0; ug < 2; ++ug) {
                const int c = ug * DFF + ch;
                const float x0 = hb[rr * 24 + ug * 11 + jj], x1 = rr >= 1 ? hb[(rr - 1) * 24 + ug * 11 + jj] : 0.f, x2 = rr >= 2 ? hb[(rr - 2) * 24 + ug * 11 + jj] : 0.f;
                hc[ug] = cb[c] + cw[c] * x2 + cw[NUP + c] * x1 + cw[2 * NUP + c] * x0;
                if (rr >= 14) HL[(size_t)(256 + rr - 14) * NUP + c] = x0;
            }
            A2[(size_t)(META0 + rr) * DFF + ch] = f2bf(siluf(hc[1]) * hc[0]);
        }
        __syncthreads();
    }
}
__device__ __forceinline__ bool so_next_pm(int nM, int nN, int G, int c, int i, int& pm) {
    const int nwg = nM * nN; const long Lq = (long)i * G + c; if (Lq >= nwg) return false;
    int wgid = (int)Lq; { const int q = nwg / pg8::NXCD, r = nwg % pg8::NXCD, xcd = wgid % pg8::NXCD, off = wgid / pg8::NXCD; wgid = (xcd < r ? xcd * (q + 1) : r * (q + 1) + (xcd - r) * q) + off; }
    const int nig = pg8::WGM * nN, gid = wgid / nig, fm = gid * pg8::WGM, gsz = (nM - fm) < pg8::WGM ? (nM - fm) : pg8::WGM;
    pm = fm + ((wgid % nig) % gsz); return true;
}
struct EpiIn {
    static constexpr bool PERM = true, AFTER_DRAIN = false;
    int si;
    __device__ __forceinline__ void operator()(const pg8::f32x4 (&acc)[2][2][4][2], const pg8::Unit& u, int wr, int wc, int fr, int fq) const {
        asm volatile("" : "+v"(fr), "+v"(fq));
        unsigned char* wsb = gptr(kargs()->ws);
        bf16* Q = (bf16*)(wsb + WS_QKV); float* SM = (float*)(wsb + WS_SM); const LAS float* rsl = tile_rstd(wsb, si, u.pm, wr, wc, fr, fq);
#pragma unroll
        for (int ai = 0; ai < 2; ++ai)
#pragma unroll
            for (int m = 0; m < 4; ++m) {
                const int row = u.pm * 256 + ai * 128 + wr * 64 + m * 16 + fr;
                const float rs = rsl[ai * 128 + wr * 64 + m * 16 + fr];
                if (u.pn < 12) {
#pragma unroll
                    for (int bj = 0; bj < 2; ++bj) {
                        const pg8::f32x4 v0 = acc[ai][bj][m][0] * rs, v1 = acc[ai][bj][m][1] * rs;
                        u32x4 w; w.x = pk2(v0[0], v0[1]); w.y = pk2(v0[2], v0[3]); w.z = pk2(v1[0], v1[1]); w.w = pk2(v1[2], v1[3]);
                        *(u32x4*)(Q + (size_t)row * QP + u.pn * 256 + bj * 128 + wc * 32 + 8 * fq) = w;
                    }
                } else if (wc == 0) {
                    *(f32x4*)(SM + (size_t)row * 32 + 8 * fq) = acc[ai][0][m][0] * rs;
                    *(f32x4*)(SM + (size_t)row * 32 + 8 * fq + 4) = acc[ai][0][m][1] * rs;
                }
            }
    }
};
template <bool from_x, bool last> struct EpiRes {
    static constexpr bool PERM = false, AFTER_DRAIN = false;
    int si;
    __device__ __forceinline__ void operator()(const pg8::f32x4 (&acc)[2][2][4][2], const pg8::Unit& u, int wr, int wc, int fr, int fq) const {
        asm volatile("" : "+v"(fr), "+v"(fq));
        KArgs ka = kargs(); unsigned char* wsb = gptr(ka->ws);
        float* out = last ? gptr(ka->out) : nullptr; const float* xin = from_x ? gptr(ka->x) : nullptr; bf16* HB = (bf16*)(wsb + WS_HB); float* ssq_next = (float*)ssq_arr(wsb, si);
        extern __shared__ __attribute__((aligned(16))) unsigned char lds_dyn_[];
        LAS float* red = (LAS float*)((LAS unsigned char*)lds_dyn_ + HALO_OFF);
#pragma unroll
        for (int ai = 0; ai < 2; ++ai)
#pragma unroll
            for (int m = 0; m < 4; ++m) {
                const int row = u.pm * 256 + ai * 128 + wr * 64 + m * 16 + fr;
                float ss = 0.f;
#pragma unroll
                for (int bj = 0; bj < 2; ++bj)
#pragma unroll
                    for (int n = 0; n < 2; ++n) {
                        const int col = u.pn * 256 + bj * 128 + wc * 32 + 16 * n + 4 * fq;
                        f32x4 bs;
                        if constexpr (from_x) bs = *(const f32x4*)(xin + (size_t)row * DM + col);
                        else { const u32x2 t = *(const u32x2*)(HB + (size_t)row * DM + col);
                               bs = (f32x4){__uint_as_float(t.x << 16), __uint_as_float(t.x & 0xffff0000u), __uint_as_float(t.y << 16), __uint_as_float(t.y & 0xffff0000u)}; }
                        const f32x4 h = bs + acc[ai][bj][m][n];
                        ss += (h[0] * h[0] + h[1] * h[1]) + (h[2] * h[2] + h[3] * h[3]);
                        u32x2 w; w.x = pk2(h[0], h[1]); w.y = pk2(h[2], h[3]);
                        *(u32x2*)(HB + (size_t)row * DM + col) = w;
                        if constexpr (last) *(f32x4*)(out + (size_t)row * DM + col) = h;
                    }
                ss += __shfl_xor(ss, 16); ss += __shfl_xor(ss, 32);
                if (fq == 0) red[wc * 256 + ai * 128 + wr * 64 + m * 16 + fr] = ss;
            }
        asm volatile("s_waitcnt lgkmcnt(0)" ::: "memory"); __builtin_amdgcn_s_barrier(); asm volatile("" ::: "memory");
        {
            const int tl = (wr * 4 + wc) * 64 + fq * 16 + fr;
            if (tl < 256) ssq_next[(size_t)(u.pm * 256 + tl) * 4 + u.pn] = (red[tl] + red[256 + tl]) + (red[512 + tl] + red[768 + tl]);
        }
    }
};
struct EpiUp {
    static constexpr bool PERM = true, AFTER_DRAIN = false;
    int L;
    __device__ __forceinline__ void operator()(pg8::f32x4 (&acc)[2][2][4][2], const pg8::Unit& u, int wr, int wc, int fr, int fq) const {
        asm volatile("" : "+v"(fr), "+v"(fq));
        KArgs ka = kargs(); unsigned char* wsb = gptr(ka->ws);
        const LAS float* rsl = tile_rstd(wsb, 2 * L + 1, u.pm, wr, wc, fr, fq); const float* cw = gptr(ka->conv_w) + (size_t)L * 3 * NUP; const float* cb = gptr(ka->conv_b) + (size_t)L * NUP;
        extern __shared__ __attribute__((aligned(16))) unsigned char lds_dyn_[];
        LAS float* halo = (LAS float*)((LAS unsigned char*)lds_dyn_ + HALO_OFF);
        const int colw = wc * 32 + 8 * fq;
#pragma unroll
        for (int ai = 0; ai < 2; ++ai)
#pragma unroll
            for (int m = 0; m < 4; ++m) {
                const int row = u.pm * 256 + ai * 128 + wr * 64 + m * 16 + fr;
                const float rs = rsl[ai * 128 + wr * 64 + m * 16 + fr]; (void)row;
#pragma unroll
                for (int bj = 0; bj < 2; ++bj)
#pragma unroll
                    for (int n = 0; n < 2; ++n) acc[ai][bj][m][n] *= rs;
            }
#ifdef SIMPLE_UP
        {
            const int ch0s = u.pn * 128 + colw;
#pragma unroll
            for (int n = 0; n < 2; ++n)
#pragma unroll
                for (int ai = 0; ai < 2; ++ai)
#pragma unroll
                    for (int m = 0; m < 4; ++m) {
                        const int row = u.pm * 256 + ai * 128 + wr * 64 + m * 16 + fr;
                        const f32x4 hu = acc[ai][0][m][n], hg = acc[ai][1][m][n];
                        u32x2 w; w.x = pk2(hu[0] + hg[0], hu[1] + hg[1]); w.y = pk2(hu[2] + hg[2], hu[3] + hg[3]);
                        *(u32x2*)(wsb + (unsigned)(WS_QKV + (unsigned)((row * DFF + ch0s + 4 * n) * 2))) = w;
                    }
            return;
        }
#endif
        if (fr >= 14) {
#pragma unroll
            for (int ai = 0; ai < 2; ++ai)
#pragma unroll
                for (int bj = 0; bj < 2; ++bj)
#pragma unroll
                    for (int n = 0; n < 2; ++n)
                        *(LAS f32x4*)(halo + (((2 * ai + wr) * 2 + (fr - 14)) * 256 + bj * 128 + colw + 4 * n)) = acc[ai][bj][3][n];
        }
        asm volatile("s_waitcnt lgkmcnt(0)" ::: "memory"); __builtin_amdgcn_s_barrier(); asm volatile("" ::: "memory");
        const int ch0 = u.pn * 128 + colw;
        u32x2 wout[2][4][2];
#pragma unroll
        for (int n = 0; n < 2; ++n) {
            f32x4 w0[2], w1[2], w2[2], bb[2];
#pragma unroll
            for (int bj = 0; bj < 2; ++bj) {
                const int c = bj * DFF + ch0 + 4 * n;
                w0[bj] = *(const f32x4*)((const char*)cw + (unsigned)(c * 4)); w1[bj] = *(const f32x4*)((const char*)cw + (unsigned)((NUP + c) * 4)); w2[bj] = *(const f32x4*)((const char*)cw + (unsigned)((2 * NUP + c) * 4)); bb[bj] = *(const f32x4*)((const char*)cb + (unsigned)(c * 4));
            }
#pragma unroll
            for (int ai = 0; ai < 2; ++ai)
#pragma unroll
                for (int m = 0; m < 4; ++m) {
                    const int g = 2 * ai + wr;
                    f32x4 hc[2];
#pragma unroll
                    for (int bj = 0; bj < 2; ++bj) {
                        const int c = bj * DFF + ch0 + 4 * n;
                        const f32x4 cur = acc[ai][bj][m][n];
                        f32x4 pb;
                        if (m > 0) pb = acc[ai][bj][m - 1][n];
                        else pb = *(const LAS f32x4*)(halo + ((((g > 0 ? g - 1 : 0) * 2) + (fr & 1)) * 256 + bj * 128 + colw + 4 * n));
                        f32x4 p1, p2;
#pragma unroll
                        for (int j = 0; j < 4; ++j) {
                            const float t1 = DPP_MOV(0.f, pb[j], 0x121);
                            p1[j] = DPP_MOV(t1, cur[j], 0x111);
                            const float t2 = DPP_MOV(0.f, pb[j], 0x122);
                            p2[j] = DPP_MOV(t2, cur[j], 0x112);
                        }
                        hc[bj] = bb[bj] + w0[bj] * p2 + w1[bj] * p1 + w2[bj] * cur;
                        if (g == 0 && m == 0 && fr < 2) *(f32x4*)(wsb + (unsigned)(WS_UT + (unsigned)(((u.pm * 2 + fr) * NUP + c) * 4))) = cur;
                        if (u.pm == 128 ? (g == 0 && m == 0 && fr >= 14) : (g == 3 && m == 3 && fr >= 14))
                            *(f32x4*)(wsb + (unsigned)(WS_UT + HFL_SIZE + (unsigned)(((u.pm * 2 + fr - 14) * NUP + c) * 4))) = cur;
                    }
                    wout[ai][m][n].x = pk2(siluf(hc[1][0]) * hc[0][0], siluf(hc[1][1]) * hc[0][1]);
                    wout[ai][m][n].y = pk2(siluf(hc[1][2]) * hc[0][2], siluf(hc[1][3]) * hc[0][3]);
                }
        }
#pragma unroll
        for (int ai = 0; ai < 2; ++ai)
#pragma unroll
            for (int m = 0; m < 4; ++m) {
                const int row = u.pm * 256 + ai * 128 + wr * 64 + m * 16 + fr;
                u32x4 w; w.x = wout[ai][m][0].x; w.y = wout[ai][m][0].y; w.z = wout[ai][m][1].x; w.w = wout[ai][m][1].y;
                *(u32x4*)(wsb + (unsigned)(WS_QKV + (unsigned)((row * DFF + ch0) * 2))) = w;
            }
    }
};
#define XB_TMO      128
#define XB_XCNT(j)  (256  + 64 * (j))
#define XB_XSUB(j)  (1280 + 64 * (j))
#define XB_XGEN(j)  (2304 + 64 * (j))
#define XB_TOP      3328
#define XB_TOPGEN   3392
#define XCD_BAR_WORDS 3456
#define XB_SPIN_CAP (1u << 18)

__device__ __forceinline__ unsigned xb_ld(unsigned* p)              { return __hip_atomic_load(p, __ATOMIC_RELAXED, __HIP_MEMORY_SCOPE_AGENT); }
__device__ __forceinline__ unsigned xb_add(unsigned* p, unsigned v) { return __hip_atomic_fetch_add(p, v, __ATOMIC_RELAXED, __HIP_MEMORY_SCOPE_AGENT); }
__device__ __forceinline__ unsigned xb_xcc_id() { return (unsigned)__builtin_amdgcn_s_getreg((3 << 11) | 20) & 0xFu; }
#define XB_SPIN(cond, bar) do { unsigned _sp = 0; while (cond) { __builtin_amdgcn_s_sleep(1); \
    if ((++_sp & 255u) == 0u) { if (xb_ld(&(bar)[XB_TMO])) break; if (_sp > XB_SPIN_CAP) { atomicAdd(&(bar)[XB_TMO], 1u); break; } } } } while (0)

struct XcdBarrier {
    unsigned* bar; unsigned x;
    volatile LAS unsigned* st;
};

__device__ __forceinline__ XcdBarrier xcd_barrier_post(unsigned* bar, volatile LAS unsigned* st) {
    XcdBarrier b; b.bar = bar; b.x = xb_xcc_id(); b.st = st;
    if (threadIdx.x == 0) (void)xb_add(&bar[XB_XCNT(b.x)], 1u);
    return b;
}
__device__ __forceinline__ void xcd_barrier_complete(unsigned* bar, unsigned x, unsigned& nloc, unsigned& nx) {
    const unsigned G = gridDim.x * gridDim.y * gridDim.z;
    unsigned sum, cnt, mine, sp = 0u;
    for (;;) {
        sum = 0u; cnt = 0u; mine = 0u;
#pragma unroll
        for (unsigned j = 0; j < 16; ++j) { const unsigned c = xb_ld(&bar[XB_XCNT(j)]); sum += c; cnt += (c > 0u) ? 1u : 0u; mine = (j == x) ? c : mine; }
        if (sum == G) break;
        __builtin_amdgcn_s_sleep(1);
        if ((++sp & 255u) == 0u) { if (xb_ld(&bar[XB_TMO])) break; if (sp > XB_SPIN_CAP) { atomicAdd(&bar[XB_TMO], 1u); break; } }
    }
    nloc = mine > 0u ? mine : 1u; nx = cnt > 0u ? cnt : 1u;
}

__device__ __forceinline__ void xcd_barrier(const XcdBarrier& b) {
    asm volatile("s_waitcnt vmcnt(0)" ::: "memory");
    __syncthreads();
    if (threadIdx.x == 0) {
        unsigned* bar = b.bar;
        __builtin_amdgcn_s_waitcnt(0);
        unsigned nloc = b.st[0], nx = b.st[1];
        if (nloc == 0u) { xcd_barrier_complete(bar, b.x, nloc, nx); b.st[0] = nloc; b.st[1] = nx; }
        const unsigned old = xb_add(&bar[XB_XSUB(b.x)], 1u);
        const unsigned gen = old / nloc;
        if (old + 1u == (gen + 1u) * nloc) {
            __builtin_amdgcn_fence(__ATOMIC_RELEASE, "agent");
            asm volatile("s_waitcnt vmcnt(0)" ::: "memory");
            const unsigned og = xb_add(&bar[XB_TOP], 1u);
            const unsigned tg = og / nx;
            if (og + 1u == (tg + 1u) * nx) xb_add(&bar[XB_TOPGEN], 1u);
            else XB_SPIN(xb_ld(&bar[XB_TOPGEN]) == tg, bar);
            __builtin_amdgcn_fence(__ATOMIC_ACQUIRE, "agent");
            xb_add(&bar[XB_XGEN(b.x)], 1u);
            asm volatile("s_waitcnt vmcnt(0)" ::: "memory");
        } else {
            XB_SPIN(xb_ld(&bar[XB_XGEN(b.x)]) == gen, bar);
            __builtin_amdgcn_fence(__ATOMIC_ACQUIRE, "agent");
            asm volatile("s_waitcnt vmcnt(0)" ::: "memory");
        }
    }
    __syncthreads();
}
__device__ __forceinline__ int win_src(int n) {
    if (n < 512) return 1552 + n;
    if (n < 1024) return 2064 + (n - 512);
    if (n < 1536) return 2576 + (n - 1024);
    if (n < 1792) return n - 1536;
    if (n < 2048) return 256 + (n - 1792);
    if (n < 2560) return 512 + (n - 2048);
    if (n < 3072) return 1024 + (n - 2560);
    if (n < 3088) return 1536 + (n - 3072);
    if (n < 3096) return n;
    return -1;
}
__device__ __forceinline__ void tr_item(const float* W, int Nsrc, bf16* WT, int K, const float* gk, int mode, LAS float* scr, int k0, int n0, int lane) {
    const int nl = lane & 31, n = n0 + nl;
    int src = n; float cs = 1.f;
    if (mode == 0) { src = win_src(n); cs = n < 512 ? C2 : ((n >= 1536 && n < 1792) ? 0.125f : 1.f); }
    else if (mode == 2) { const int pn = n >> 8, j = n & 255; src = j < 128 ? pn * 128 + j : DFF + pn * 128 + (j - 128); }
#pragma unroll
    for (int i = 0; i < 32; ++i) {
        const int kk = 2 * i + (lane >> 5);
        float v = 0.f;
        if (src >= 0) v = W[(size_t)(k0 + kk) * Nsrc + src] * cs;
        if (gk) v *= gk[k0 + kk];
        scr[kk * 33 + nl] = v;
    }
    LDS_WAIT(); asm volatile("" ::: "memory");
    const int c = lane & 7;
#pragma unroll
    for (int j = 0; j < 4; ++j) {
        const int nn = (lane >> 3) + 8 * j; const LAS float* s = scr + (8 * c) * 33 + nn;
        u32x4 o; o.x = pk2(s[0 * 33], s[1 * 33]); o.y = pk2(s[2 * 33], s[3 * 33]); o.z = pk2(s[4 * 33], s[5 * 33]); o.w = pk2(s[6 * 33], s[7 * 33]);
        *(u32x4*)(WT + (size_t)(n0 + nn) * K + k0 + 8 * c) = o;
    }
    LDS_WAIT(); asm volatile("" ::: "memory");
}
__device__ __forceinline__ void row_to_bf16(const float* xrow, bf16* orow, float* ssq_slot, float* copy_row, int lane) {
    const f32x4* xr = (const f32x4*)xrow + lane;
    f32x4 v[4]; float s = 0.f;
#pragma unroll
    for (int j = 0; j < 4; ++j) { v[j] = xr[64 * j]; s += (v[j][0] * v[j][0] + v[j][1] * v[j][1]) + (v[j][2] * v[j][2] + v[j][3] * v[j][3]); }
    s = wave_sum(s);
    if (lane == 0) *(f32x4*)ssq_slot = (f32x4){s, 0.f, 0.f, 0.f};
    u32x2* o8 = (u32x2*)orow + lane;
#pragma unroll
    for (int j = 0; j < 4; ++j) { u32x2 w; w.x = pk2(v[j][0], v[j][1]); w.y = pk2(v[j][2], v[j][3]); o8[64 * j] = w; }
    if (copy_row) {
#pragma unroll
        for (int j = 0; j < 4; ++j) ((f32x4*)copy_row + lane)[64 * j] = v[j];
    }
}

template <int NQ> __device__ __forceinline__ void gla_u_group(LAS unsigned char* lds, const bf16* QKV, const float* SM, const float* wau, const float* balpha, float* UT, float* DEC, int grp) {
    int tid_ = threadIdx.x; asm volatile("" : "+v"(tid_)); const int tid = tid_, lane = tid & 63, wid = __builtin_amdgcn_readfirstlane(tid >> 6), hi = lane >> 5, r32 = lane & 31;
    constexpr int SUB = 9216 + 17408 + 2048;
    const int dk = lane, sg = wid;
    int bhq[NQ], ccq[NQ], hq[NQ], row0q[NQ], tvq[NQ];
    float la[NQ][8], kf[NQ][8];
#pragma unroll
    for (int q = 0; q < NQ; ++q) {
        const int u = NQ * grp + q; bhq[q] = u / NCH; ccq[q] = u % NCH; hq[q] = bhq[q] & 3;
        row0q[q] = ccq[q] == 0 ? META0 : (bhq[q] >> 2) * SEQ + (ccq[q] - 1) * 64; tvq[q] = ccq[q] == 0 ? NMETA : 64;
        LAS unsigned char* VT = lds + q * SUB + 9216;
        LAS float* TOT = (LAS float*)(lds + q * SUB + 9216 + 17408);
#pragma unroll
        for (int i = 0; i < 2; ++i) {
            const int idx = tid + 512 * i, row = idx >> 4, ch = idx & 15;
            const u32x4 v = *(const u32x4*)(QKV + (size_t)(row0q[q] + row) * QP + C_GV + hq[q] * 128 + ch * 8);
            *(LAS u32x4*)(VT + row * 272 + ch * 16) = v;
        }
#pragma unroll
        for (int i = 0; i < 8; ++i) kf[q][i] = bf2f(QKV[(size_t)(row0q[q] + 8 * sg + i) * QP + C_GK + hq[q] * 64 + dk]);
        float w[16];
#pragma unroll
        for (int r = 0; r < 16; ++r) w[r] = wau[r * 256 + hq[q] * 64 + dk];
        const float bias = balpha[hq[q] * 64 + dk];
#pragma unroll
        for (int i = 0; i < 8; ++i) {
            const int s = 8 * sg + i;
            const f32x4* g4 = (const f32x4*)(SM + (size_t)(row0q[q] + s) * 32);
            float z = bias;
#pragma unroll
            for (int k = 0; k < 4; ++k) { const f32x4 gv = g4[k]; z += gv[0] * w[4 * k] + gv[1] * w[4 * k + 1] + gv[2] * w[4 * k + 2] + gv[3] * w[4 * k + 3]; }
            la[q][i] = (s < tvq[q]) ? logsigmoidf(z) * (1.0f / 16.0f) : 0.f;
        }
#pragma unroll
        for (int i = 1; i < 8; ++i) la[q][i] += la[q][i - 1];
        TOT[sg * 64 + dk] = la[q][7];
    }
    __syncthreads();
#pragma unroll
    for (int q = 0; q < NQ; ++q) {
        LAS unsigned char* KD = lds + q * SUB;
        const LAS float* TOT = (const LAS float*)(lds + q * SUB + 9216 + 17408);
        float pre = 0.f, tot = 0.f;
#pragma unroll
        for (int g2 = 0; g2 < 8; ++g2) { const float t = TOT[g2 * 64 + dk]; if (g2 < sg) pre += t; tot += t; }
        if (sg == 0) DEC[(size_t)(bhq[q] * NCH + ccq[q]) * 64 + dk] = __expf(tot);
#pragma unroll
        for (int i = 0; i < 8; ++i) {
            const int s = 8 * sg + i;
            const float kd = (s < tvq[q]) ? kf[q][i] * __expf(tot - (pre + la[q][i])) : 0.f;
            *(LAS bf16*)(KD + s * 144 + dk * 2) = f2bf(kd);
        }
    }
    __syncthreads();
    const int dvb = wid >> 1, dkb = wid & 1;
    const int qq = (lane & 15) >> 2, pp = lane & 3, half = (lane >> 4) & 1;
#pragma unroll
    for (int q = 0; q < NQ; ++q) {
        const LAS unsigned char* KD = lds + q * SUB; const LAS unsigned char* VT = lds + q * SUB + 9216;
        f32x16 acc = {};
#pragma unroll
        for (int j = 0; j < 4; ++j) {
            const LAS unsigned char* ap = VT + (16 * j + 4 * hi + qq) * 272 + (32 * dvb + 16 * half + 4 * pp) * 2;
            const LAS unsigned char* bp = KD + (16 * j + 4 * hi + qq) * 144 + (32 * dkb + 16 * half + 4 * pp) * 2;
            const bf16x8 af = cat8(vtr(ap), vtr(ap + 8 * 272));
            const bf16x8 bfr = cat8(vtr(bp), vtr(bp + 8 * 144));
            acc = __builtin_amdgcn_mfma_f32_32x32x16_bf16(af, bfr, acc, 0, 0, 0);
        }
        float* up = UT + ((size_t)(bhq[q] * NCH + ccq[q]) * 128 + 32 * dvb) * 64 + 32 * dkb + r32;
#pragma unroll
        for (int r = 0; r < 16; ++r) up[crow(r, hi) * 64] = acc[r];
    }
    __syncthreads();
}
__device__ __forceinline__ void fox_cumsum_unit(LAS unsigned char* lds, const float* SM, const float* bforget, float* CK, int bh) {
    int tid_ = threadIdx.x; asm volatile("" : "+v"(tid_)); const int tid = tid_, lane = tid & 63, wid = tid >> 6;
    const int b = bh >> 3, h = bh & 7;
    const float bf_ = bforget[h];
    LAS float* WT_ = (LAS float*)lds;
    float mtot = 0.f, mine = 0.f;
    for (int p = 0; p < NMETA; ++p) { mtot += logsigmoidf(SM[(size_t)(META0 + p) * 32 + 16 + h] + bf_); if (tid == p) mine = mtot; }
    if (tid < 64) CK[(size_t)bh * CKP + tid] = tid < NMETA ? -LOG2E * mine : -INFINITY;
    float v[8]; float run = 0.f;
#pragma unroll
    for (int i = 0; i < 8; ++i) { run += logsigmoidf(SM[(size_t)(b * SEQ + 8 * tid + i) * 32 + 16 + h] + bf_); v[i] = run; }
    float inc = run;
#pragma unroll
    for (int o = 1; o < 64; o <<= 1) { const float t = __shfl_up(inc, o); if (lane >= o) inc += t; }
    if (lane == 63) WT_[wid] = inc;
    __syncthreads();
    float off = mtot + (inc - run);
    for (int w2 = 0; w2 < wid; ++w2) off += WT_[w2];
#pragma unroll
    for (int i = 0; i < 8; ++i) CK[(size_t)bh * CKP + 64 + 8 * tid + i] = -LOG2E * (off + v[i]);
    __syncthreads();
}

__device__ __forceinline__ void attn_unit(LAS unsigned char* lds, const bf16* QKV, const float* CK, bf16* OB, const float* fnorm, int b, int h, int qb) {
    int tid_ = threadIdx.x; asm volatile("" : "+v"(tid_)); const int tid = tid_, lane = tid & 63, wid = __builtin_amdgcn_readfirstlane(tid >> 6), r32 = lane & 31, hi = lane >> 5;
    constexpr int KB = 9216, KOFF = 0, VOFF = 2 * KB, COFF = 4 * KB, WOFF = COFF + 512;
    LAS float* wsf = (LAS float*)(lds + WOFF) + wid * 64;
    const size_t rowb = (size_t)b * SEQ; const int q0 = qb * 512;
    const int NT = 1 + 8 * (qb + 1);
    bf16x8 qr[2][4];
#pragma unroll
    for (int g = 0; g < 2; ++g) {
        const bf16* qp = QKV + (rowb + q0 + wid * 64 + g * 32 + r32) * QP + C_FQ + h * 64 + hi * 8;
#pragma unroll
        for (int d0 = 0; d0 < 4; ++d0) qr[g][d0] = *(const bf16x8*)(qp + d0 * 16);
    }
    const int srow = tid >> 3, sch = tid & 7;
    const float* ckp = CK + (size_t)(b * 8 + h) * CKP;
    u32x4 kreg, vreg; float creg = 0.f;
#define ATT_LOAD(t) do { const size_t r0_ = (t) == 0 ? (size_t)META0 : rowb + (size_t)((t) - 1) * 64; const bf16* p_ = QKV + (r0_ + srow) * QP + h * 64 + sch * 8; \
        kreg = *(const u32x4*)(p_ + C_FK); vreg = *(const u32x4*)(p_ + C_FV); if (tid < 64) creg = ckp[(t) * 64 + tid]; } while (0)
#define ATT_STORE(buf) do { *(LAS u32x4*)(lds + KOFF + (buf) * KB + srow * 144 + sch * 16) = kreg; *(LAS u32x4*)(lds + VOFF + (buf) * KB + (sch >> 2) * 4096 + (srow >> 3) * 512 + (srow & 7) * 64 + (sch & 3) * 16) = vreg; \
        if (tid < 64) *(LAS float*)(lds + COFF + (buf) * 256 + tid * 4) = creg; } while (0)
    float m[2] = {-1e30f, -1e30f}, l[2] = {0.f, 0.f}; f32x16 o0[2], o1[2];
    o0[0] = (f32x16){}; o0[1] = (f32x16){}; o1[0] = (f32x16){}; o1[1] = (f32x16){};
    const int qq = (lane & 15) >> 2, pp = lane & 3, half = (lane >> 4) & 1;
    ATT_LOAD(0); ATT_STORE(0);
    for (int t = 0; t < NT; ++t) {
        const int buf = t & 1;
        if (t + 1 < NT) ATT_LOAD(t + 1);
        __syncthreads();
        const int jb = t - (NT - 8);
        const bool skip = (jb >= 0) && (jb > wid);
        if (!skip) {
            const LAS unsigned char* Kb = lds + KOFF + buf * KB; const LAS unsigned char* Vb = lds + VOFF + buf * KB; const LAS float* Cb = (const LAS float*)(lds + COFF + buf * 256);
            f32x16 p0[2], p1[2], c0v, c1v;
#pragma unroll
            for (int g4 = 0; g4 < 4; ++g4) {
                const f32x4 c0 = *(const LAS f32x4*)(Cb + 8 * g4 + 4 * hi), c1 = *(const LAS f32x4*)(Cb + 32 + 8 * g4 + 4 * hi);
#pragma unroll
                for (int i = 0; i < 4; ++i) { c0v[4 * g4 + i] = c0[i]; c1v[4 * g4 + i] = c1[i]; }
            }
#pragma unroll
            for (int d0 = 0; d0 < 4; ++d0) {
                const bf16x8 a0 = *(const LAS bf16x8*)(Kb + r32 * 144 + (16 * d0 + 8 * hi) * 2);
                const bf16x8 a1 = *(const LAS bf16x8*)(Kb + (32 + r32) * 144 + (16 * d0 + 8 * hi) * 2);
                p0[0] = __builtin_amdgcn_mfma_f32_32x32x16_bf16(a0, qr[0][d0], d0 == 0 ? c0v : p0[0], 0, 0, 0);
                p0[1] = __builtin_amdgcn_mfma_f32_32x32x16_bf16(a0, qr[1][d0], d0 == 0 ? c0v : p0[1], 0, 0, 0);
                p1[0] = __builtin_amdgcn_mfma_f32_32x32x16_bf16(a1, qr[0][d0], d0 == 0 ? c1v : p1[0], 0, 0, 0);
                p1[1] = __builtin_amdgcn_mfma_f32_32x32x16_bf16(a1, qr[1][d0], d0 == 0 ? c1v : p1[1], 0, 0, 0);
            }
            bf16x8 pa[2][4];
#pragma unroll
            for (int g = 0; g < 2; ++g) {
                if (jb == wid) {
                    const int qrel = 32 * g + r32;
#pragma unroll
                    for (int r = 0; r < 16; ++r) { const int kv = crow(r, hi); if (kv > qrel) p0[g][r] = -INFINITY; if (kv + 32 > qrel) p1[g][r] = -INFINITY; }
                }
                float mxa = fmaxf(p0[g][0], p1[g][0]), mxb = fmaxf(p0[g][1], p1[g][1]);
#pragma unroll
                for (int r = 2; r < 16; r += 2) { mxa = fmaxf(fmaxf(mxa, p0[g][r]), p1[g][r]); mxb = fmaxf(fmaxf(mxb, p0[g][r + 1]), p1[g][r + 1]); }
                float mx = fmaxf(mxa, mxb);
                mx = fmaxf(mx, __shfl_xor(mx, 32));
                if (__any(mx > m[g] + 32.0f)) {
                    const float mn = fmaxf(m[g], mx);
                    const float alpha = __builtin_amdgcn_exp2f(m[g] - mn);
                    m[g] = mn; l[g] *= alpha;
                    if (hi == 0) wsf[g * 32 + r32] = alpha;
                    LDS_WAIT();
#pragma unroll
                    for (int g4 = 0; g4 < 4; ++g4) {
                        const f32x4 a = *(const LAS f32x4*)(wsf + g * 32 + 8 * g4 + 4 * hi);
#pragma unroll
                        for (int i = 0; i < 4; ++i) { o0[g][4 * g4 + i] *= a[i]; o1[g][4 * g4 + i] *= a[i]; }
                    }
                }
                float rsa = 0.f, rsb = 0.f, rsc = 0.f, rsd = 0.f;
#pragma unroll
                for (int r = 0; r < 16; r += 2) {
                    p0[g][r] = __builtin_amdgcn_exp2f(p0[g][r] - m[g]); p1[g][r] = __builtin_amdgcn_exp2f(p1[g][r] - m[g]);
                    p0[g][r + 1] = __builtin_amdgcn_exp2f(p0[g][r + 1] - m[g]); p1[g][r + 1] = __builtin_amdgcn_exp2f(p1[g][r + 1] - m[g]);
                    rsa += p0[g][r]; rsb += p1[g][r]; rsc += p0[g][r + 1]; rsd += p1[g][r + 1];
                }
                l[g] += (rsa + rsb) + (rsc + rsd);
                { u32x4 w;
                  w.x = pk2(p0[g][0], p0[g][1]); w.y = pk2(p0[g][2], p0[g][3]); w.z = pk2(p0[g][4], p0[g][5]); w.w = pk2(p0[g][6], p0[g][7]); pa[g][0] = __builtin_bit_cast(bf16x8, w);
                  w.x = pk2(p0[g][8], p0[g][9]); w.y = pk2(p0[g][10], p0[g][11]); w.z = pk2(p0[g][12], p0[g][13]); w.w = pk2(p0[g][14], p0[g][15]); pa[g][1] = __builtin_bit_cast(bf16x8, w);
                  w.x = pk2(p1[g][0], p1[g][1]); w.y = pk2(p1[g][2], p1[g][3]); w.z = pk2(p1[g][4], p1[g][5]); w.w = pk2(p1[g][6], p1[g][7]); pa[g][2] = __builtin_bit_cast(bf16x8, w);
                  w.x = pk2(p1[g][8], p1[g][9]); w.y = pk2(p1[g][10], p1[g][11]); w.z = pk2(p1[g][12], p1[g][13]); w.w = pk2(p1[g][14], p1[g][15]); pa[g][3] = __builtin_bit_cast(bf16x8, w); }
            }
#pragma unroll
            for (int j = 0; j < 4; ++j) {
                const LAS unsigned char* vp = Vb + (2 * j) * 512 + (4 * hi + qq) * 64 + 32 * half + 8 * pp;
                const bf16x8 v0 = cat8(vtr(vp), vtr(vp + 512));
                const bf16x8 v1 = cat8(vtr(vp + 4096), vtr(vp + 4096 + 512));
                o0[0] = __builtin_amdgcn_mfma_f32_32x32x16_bf16(pa[0][j], v0, o0[0], 0, 0, 0);
                o0[1] = __builtin_amdgcn_mfma_f32_32x32x16_bf16(pa[1][j], v0, o0[1], 0, 0, 0);
                o1[0] = __builtin_amdgcn_mfma_f32_32x32x16_bf16(pa[0][j], v1, o1[0], 0, 0, 0);
                o1[1] = __builtin_amdgcn_mfma_f32_32x32x16_bf16(pa[1][j], v1, o1[1], 0, 0, 0);
            }
        }
        if (t + 1 < NT) ATT_STORE(buf ^ 1);
    }
#undef ATT_LOAD
#undef ATT_STORE
    const float w0 = fnorm[h * 64 + r32], w1 = fnorm[h * 64 + 32 + r32];
#pragma unroll
    for (int g = 0; g < 2; ++g) {
        float lt = l[g]; lt += __shfl_xor(lt, 32);
        if (hi == 0) wsf[g * 32 + r32] = 1.0f / lt;
        LDS_WAIT();
#pragma unroll
        for (int g4 = 0; g4 < 4; ++g4) {
            const f32x4 a = *(const LAS f32x4*)(wsf + g * 32 + 8 * g4 + 4 * hi);
#pragma unroll
            for (int i = 0; i < 4; ++i) { o0[g][4 * g4 + i] *= a[i]; o1[g][4 * g4 + i] *= a[i]; }
        }
#pragma unroll
        for (int r = 0; r < 16; ++r) {
            float s = o0[g][r] * o0[g][r] + o1[g][r] * o1[g][r];
            s += __shfl_xor(s, 1); s += __shfl_xor(s, 2); s += __shfl_xor(s, 4); s += __shfl_xor(s, 8); s += __shfl_xor(s, 16);
            const float rs = rsqrtf(s * (1.0f / 64.0f) + EPS);
            bf16* op = OB + (rowb + q0 + wid * 64 + g * 32 + crow(r, hi)) * DM + 512 + h * 64 + r32;
            op[0] = f2bf(o0[g][r] * rs * w0); op[32] = f2bf(o1[g][r] * rs * w1);
        }
    }
    __syncthreads();
}
__device__ __forceinline__ void meta_attn(const bf16* QKV, const float* CK, bf16* OB, const float* fnorm, int p) {
    int tid_ = threadIdx.x; asm volatile("" : "+v"(tid_)); const int lane = tid_ & 63, h = tid_ >> 6;
    const float q = bf2f(QKV[(size_t)(META0 + p) * QP + C_FQ + h * 64 + lane]);
    float sc[NMETA], vv[NMETA];
#pragma unroll
    for (int s = 0; s < NMETA; ++s) {
        sc[s] = q * bf2f(QKV[(size_t)(META0 + s) * QP + C_FK + h * 64 + lane]);
        vv[s] = bf2f(QKV[(size_t)(META0 + s) * QP + C_FV + h * 64 + lane]);
    }
    float m = -1e30f;
#pragma unroll
    for (int s = 0; s < NMETA; ++s) { sc[s] = (s <= p) ? wave_sum(sc[s]) + CK[(size_t)h * CKP + s] : -INFINITY; m = fmaxf(m, sc[s]); }
    float l = 0.f, o = 0.f;
#pragma unroll
    for (int s = 0; s < NMETA; ++s) { const float pw = __builtin_amdgcn_exp2f(sc[s] - m); l += pw; o += pw * vv[s]; }
    o /= l;
    const float ss = wave_sum(o * o);
    OB[(size_t)(META0 + p) * DM + 512 + h * 64 + lane] = f2bf(o * rsqrtf(ss * (1.0f / 64.0f) + EPS) * fnorm[h * 64 + lane]);
}
template <int NU> __device__ __forceinline__ void gla_readout_wave(const bf16* QKV, const float* UT, bf16* OB, const float* gnorm, const int* bhs, const int* ccs, const int* halfs, int lane) {
    asm volatile("" : "+v"(lane));
    const int r32 = lane & 31, hi = lane >> 5;
    int row0[NU], nvalid[NU], hq[NU]; const float* Sp[NU];
    f32x16 acc[NU][4];
#pragma unroll
    for (int u = 0; u < NU; ++u) {
        const int b = bhs[u] >> 2; hq[u] = bhs[u] & 3;
        row0[u] = ccs[u] == 0 ? META0 : b * SEQ + (ccs[u] - 1) * 64 + 32 * halfs[u]; nvalid[u] = ccs[u] == 0 ? NMETA : 32;
        Sp[u] = UT + (size_t)(bhs[u] * NCH + ccs[u]) * 8192;
#pragma unroll
        for (int blk = 0; blk < 4; ++blk) acc[u][blk] = (f32x16){};
    }
#pragma unroll
    for (int j = 0; j < 4; ++j)
#pragma unroll
        for (int u = 0; u < NU; ++u) {
            const bf16x8 bq = *(const bf16x8*)(QKV + (size_t)(row0[u] + r32) * QP + C_GQ + hq[u] * 64 + 16 * j + 8 * hi);
#pragma unroll
            for (int blk = 0; blk < 4; ++blk) {
                const float* sp = Sp[u] + (32 * blk + r32) * 64 + 16 * j + 8 * hi;
                const f32x4 s0 = *(const f32x4*)sp, s1 = *(const f32x4*)(sp + 4);
                u32x4 w; w.x = pk2(s0[0], s0[1]); w.y = pk2(s0[2], s0[3]); w.z = pk2(s1[0], s1[1]); w.w = pk2(s1[2], s1[3]);
                acc[u][blk] = __builtin_amdgcn_mfma_f32_32x32x16_bf16(__builtin_bit_cast(bf16x8, w), bq, acc[u][blk], 0, 0, 0);
            }
        }
#pragma unroll
    for (int u = 0; u < NU; ++u) {
        float ss = 0.f;
#pragma unroll
        for (int blk = 0; blk < 4; ++blk)
#pragma unroll
            for (int r = 0; r < 16; ++r) ss += acc[u][blk][r] * acc[u][blk][r];
        ss += __shfl_xor(ss, 32);
        const float rs = rsqrtf(ss * (1.0f / 128.0f) + EPS);
        if (r32 < nvalid[u]) {
            const size_t row = (size_t)row0[u] + r32; const int h = hq[u];
#pragma unroll
            for (int blk = 0; blk < 4; ++blk)
#pragma unroll
                for (int g = 0; g < 4; ++g) {
                    const int dv = 32 * blk + 8 * g + 4 * hi;
                    const u32x2 gt = *(const u32x2*)(QKV + row * QP + C_GR + h * 128 + dv);
                    const f32x4 wn = *(const f32x4*)(gnorm + h * 128 + dv);
                    const float g0 = __uint_as_float(gt.x << 16), g1 = __uint_as_float(gt.x & 0xffff0000u), g2 = __uint_as_float(gt.y << 16), g3 = __uint_as_float(gt.y & 0xffff0000u);
                    u32x2 w;
                    w.x = pk2(acc[u][blk][4 * g] * rs * wn[0] * siluf(g0), acc[u][blk][4 * g + 1] * rs * wn[1] * siluf(g1));
                    w.y = pk2(acc[u][blk][4 * g + 2] * rs * wn[2] * siluf(g2), acc[u][blk][4 * g + 3] * rs * wn[3] * siluf(g3));
                    *(u32x2*)(OB + row * DM + h * 128 + dv) = w;
                }
        }
    }
}

__device__ __forceinline__ void gla_readout_chunk(const bf16* QKV, const float* UT, bf16* OB, const float* gnorm, int bh, int cc, int lane) {
    asm volatile("" : "+v"(lane));
    const int r32 = lane & 31, hi = lane >> 5, b = bh >> 2, h = bh & 3;
    const int row0 = b * SEQ + (cc - 1) * 64;
    const float* Sp = UT + (size_t)(bh * NCH + cc) * 8192;
    f32x16 acc[2][4];
#pragma unroll
    for (int u = 0; u < 2; ++u)
#pragma unroll
        for (int blk = 0; blk < 4; ++blk) acc[u][blk] = (f32x16){};
#pragma unroll 1
    for (int j = 0; j < 4; ++j) {
        const bf16x8 bq0 = *(const bf16x8*)(QKV + (size_t)(row0 + r32) * QP + C_GQ + h * 64 + 16 * j + 8 * hi);
        const bf16x8 bq1 = *(const bf16x8*)(QKV + (size_t)(row0 + 32 + r32) * QP + C_GQ + h * 64 + 16 * j + 8 * hi);
#pragma unroll
        for (int blk = 0; blk < 4; ++blk) {
            const float* sp = Sp + (32 * blk + r32) * 64 + 16 * j + 8 * hi;
            const f32x4 s0 = *(const f32x4*)sp, s1 = *(const f32x4*)(sp + 4);
            u32x4 w; w.x = pk2(s0[0], s0[1]); w.y = pk2(s0[2], s0[3]); w.z = pk2(s1[0], s1[1]); w.w = pk2(s1[2], s1[3]);
            const bf16x8 sa = __builtin_bit_cast(bf16x8, w);
            acc[0][blk] = __builtin_amdgcn_mfma_f32_32x32x16_bf16(sa, bq0, acc[0][blk], 0, 0, 0);
            acc[1][blk] = __builtin_amdgcn_mfma_f32_32x32x16_bf16(sa, bq1, acc[1][blk], 0, 0, 0);
        }
    }
#pragma unroll
    for (int u = 0; u < 2; ++u) {
        float ss = 0.f;
#pragma unroll
        for (int blk = 0; blk < 4; ++blk)
#pragma unroll
            for (int r = 0; r < 16; ++r) ss += acc[u][blk][r] * acc[u][blk][r];
        ss += __shfl_xor(ss, 32);
        const float rs = rsqrtf(ss * (1.0f / 128.0f) + EPS);
        const size_t row = (size_t)row0 + 32 * u + r32;
#pragma unroll
        for (int blk = 0; blk < 4; ++blk)
#pragma unroll
            for (int g = 0; g < 4; ++g) {
                const int dv = 32 * blk + 8 * g + 4 * hi;
                const u32x2 gt = *(const u32x2*)(QKV + row * QP + C_GR + h * 128 + dv);
                const f32x4 wn = *(const f32x4*)(gnorm + h * 128 + dv);
                const float g0 = __uint_as_float(gt.x << 16), g1 = __uint_as_float(gt.x & 0xffff0000u), g2 = __uint_as_float(gt.y << 16), g3 = __uint_as_float(gt.y & 0xffff0000u);
                u32x2 w;
                w.x = pk2(acc[u][blk][4 * g] * rs * wn[0] * siluf(g0), acc[u][blk][4 * g + 1] * rs * wn[1] * siluf(g1));
                w.y = pk2(acc[u][blk][4 * g + 2] * rs * wn[2] * siluf(g2), acc[u][blk][4 * g + 3] * rs * wn[3] * siluf(g3));
                *(u32x2*)(OB + row * DM + h * 128 + dv) = w;
            }
    }
}

#define FRESH() KArgs ka_ = kargs(); Args a; a.x = gptr(ka_->x); a.meta = gptr(ka_->meta); a.attn_norm = gptr(ka_->attn_norm); a.w_in = gptr(ka_->w_in); a.w_au = gptr(ka_->w_au); a.b_alpha = gptr(ka_->b_alpha); a.b_forget = gptr(ka_->b_forget); a.gla_norm = gptr(ka_->gla_norm); a.fox_norm = gptr(ka_->fox_norm); a.w_out = gptr(ka_->w_out); a.ffn_norm = gptr(ka_->ffn_norm); a.w_up = gptr(ka_->w_up); a.conv_w = gptr(ka_->conv_w); a.conv_b = gptr(ka_->conv_b); a.w_down = gptr(ka_->w_down); a.final_norm = gptr(ka_->final_norm); a.out = gptr(ka_->out); a.ws = gptr(ka_->ws); unsigned char* ws = a.ws; \
    bf16* HB = (bf16*)(ws + WS_HB); bf16* OB = (bf16*)(ws + WS_OB); bf16* QKV = (bf16*)(ws + WS_QKV); bf16* A2 = (bf16*)(ws + WS_QKV); \
    float* UT = (float*)(ws + WS_UT); float* HF = (float*)(ws + WS_UT); float* HL = (float*)(ws + WS_UT + HFL_SIZE); \
    float* SM = (float*)(ws + WS_SM); float* CK = (float*)(ws + WS_CK); float* DEC = (float*)(ws + WS_DEC); float* HM = (float*)(ws + WS_HM); float* SSQ = (float*)(ws + WS_SSQ); \
    unsigned char* wl = ws + WS_W + (size_t)L * WL_SIZE; \
    (void)HB; (void)OB; (void)QKV; (void)A2; (void)UT; (void)HF; (void)HL; (void)SM; (void)CK; (void)DEC; (void)HM; (void)SSQ; (void)wl; \
    int G_ = gridDim.x, bx_ = blockIdx.x; asm volatile("" : "+s"(G_), "+s"(bx_)); const int G = G_, bx = bx_; (void)G; (void)bx; \
    int tid_ = threadIdx.x; asm volatile("" : "+v"(tid_)); const int tid = tid_, lane = tid & 63, wid = __builtin_amdgcn_readfirstlane(tid >> 6); \
    const int gw = bx * 8 + wid, NGW = G * 8, gt = bx * 512 + tid, NGT = G * 512; (void)lane; (void)gw; (void)NGW; (void)gt; (void)NGT;
#ifndef REP_A
#define REP_A 1
#endif
#ifndef REP_CA
#define REP_CA 1
#endif
#ifndef REP_F
#define REP_F 1
#endif
#ifndef REP_B
#define REP_B 1
#endif
#ifndef REP_D
#define REP_D 1
#endif
#define GSYNC_CG() do { asm volatile("s_waitcnt vmcnt(0) lgkmcnt(0)" ::: "memory"); grid.sync(); __builtin_amdgcn_fence(__ATOMIC_ACQUIRE, "agent"); asm volatile("s_waitcnt vmcnt(0)" ::: "memory"); } while (0)
#ifdef PROBE_PH
#define PH_END(id) do { const unsigned long long tn_ = __builtin_amdgcn_s_memrealtime(); if ((PROBE_PH >> (id)) & 1) tsync += tn_ - tlast; tlast = tn_; } while (0)
#else
#define PH_END(id) do {} while (0)
#endif
#ifdef PROBE_SYNC
#define GSYNC() do { const unsigned long long t0_ = __builtin_amdgcn_s_memrealtime(); xcd_barrier(xbar); tsync += __builtin_amdgcn_s_memrealtime() - t0_; } while (0)
#else
#define GSYNC() do { XcdBarrier xb_; xb_.bar = (unsigned*)(gptr(kargs()->ws) + WS_BAR); xb_.x = xb_xcc_id(); xb_.st = (volatile LAS unsigned*)(lds + HALO_OFF + 8192 + 1024); xcd_barrier(xb_); } while (0)
#endif
__global__ void __launch_bounds__(512, 2) fwd_kernel(Args a_unused) {
    extern __shared__ __attribute__((aligned(16))) unsigned char lds_raw[];
    LAS unsigned char* lds = (LAS unsigned char*)lds_raw;
    cg::grid_group grid = cg::this_grid();
#if defined(PROBE_SYNC) || defined(PROBE_PH)
    unsigned long long tsync = 0ull, tlast = __builtin_amdgcn_s_memrealtime(); (void)tlast;
#endif
    volatile LAS unsigned* xst = (volatile LAS unsigned*)(lds + HALO_OFF + 8192 + 1024);
    if (threadIdx.x < 2) xst[threadIdx.x] = 0u;
    __syncthreads();
    (void)xcd_barrier_post((unsigned*)(gptr(kargs()->ws) + WS_BAR), xst);
#ifndef REP_P
#define REP_P 1
#endif
    for (int rep = 0; rep < REP_P; ++rep) {
        const int L = 0; FRESH();
        LAS float* scr = (LAS float*)(lds + wid * 16384);
        constexpr int I_IN = 16 * (NINP / 32), I_OUT = 16 * 32, I_UP = 16 * (NUP / 32), I_DN = (DFF / 64) * 32, I_L = I_IN + I_OUT + I_UP + I_DN;
        for (int it = gw; it < DEPTH * I_L; it += NGW) {
            const int L = it / I_L; int r = it % I_L;
            unsigned char* wl = ws + WS_W + (size_t)L * WL_SIZE;
            if (r < I_IN) { const int nb = NINP / 32; tr_item(a.w_in + (size_t)L * DM * 3096, 3096, (bf16*)(wl + WL_IN), DM, a.attn_norm + L * DM, 0, scr, 64 * (r / nb), 32 * (r % nb), lane); continue; } r -= I_IN;
            if (r < I_OUT) { tr_item(a.w_out + (size_t)L * DM * DM, DM, (bf16*)(wl + WL_OUT), DM, nullptr, 1, scr, 64 * (r / 32), 32 * (r % 32), lane); continue; } r -= I_OUT;
            if (r < I_UP) { const int nb = NUP / 32; tr_item(a.w_up + (size_t)L * DM * NUP, NUP, (bf16*)(wl + WL_UP), DM, a.ffn_norm + L * DM, 2, scr, 64 * (r / nb), 32 * (r % nb), lane); continue; } r -= I_UP;
            tr_item(a.w_down + (size_t)L * DFF * DM, DM, (bf16*)(wl + WL_DN), DFF, nullptr, 3, scr, 64 * (r / 32), 32 * (r % 32), lane);
        }
        for (int i = gt; i < (256 - NMETA) * 4; i += NGT) SSQ[(size_t)(META0 + NMETA) * 4 + i] = 0.f;
        for (int r = gw; r < MREAL + 256; r += NGW) {
            if (r < MREAL) row_to_bf16(a.x + (size_t)r * DM, HB + (size_t)r * DM, SSQ + (size_t)r * 4, nullptr, lane);
            else if (r < MREAL + NMETA) row_to_bf16(a.meta + (size_t)(r - MREAL) * DM, HB + (size_t)r * DM, SSQ + (size_t)r * 4, HM + (size_t)(r - MREAL) * DM, lane);
            else {
#pragma unroll
                for (int j = 0; j < 4; ++j) { ((f32x4*)(HM + (size_t)(r - MREAL) * DM) + lane)[64 * j] = (f32x4){0.f, 0.f, 0.f, 0.f};
                    ((u32x2*)(HB + (size_t)r * DM) + lane)[64 * j] = (u32x2){0u, 0u}; ((u32x2*)(OB + (size_t)r * DM) + lane)[64 * j] = (u32x2){0u, 0u}; }
            }
        }
    }
    GSYNC_CG(); PH_END(0);

    for (int L = 0; L < DEPTH; ++L) {
#ifndef SKIP_A
        {
            FRESH();
            pg8::Gemm g{HB, (const bf16*)(wl + WL_IN), MROWS, NINP, DM}; pg8::StaticOrder S; S.init(MROWS, NINP, G, bx);
            EpiIn E{2 * L};
            for (int rep = 0; rep < REP_A; ++rep) pg8::gemm_phase<EpiIn, pg8::StaticOrder, true, true>(lds, g, S, E);
        }
#endif
        GSYNC(); PH_END(1);
#ifndef SKIP_B
        { FRESH();
        for (int rep = 0; rep < REP_B; ++rep) {
        for (int gr = bx; gr < 16 * NCH; gr += G) gla_u_group<2>(lds, QKV, SM, a.w_au + (size_t)L * 16 * 256, a.b_alpha + L * 256, UT, DEC, gr);
        for (int u = (G == 256) ? bx - 64 + ((bx < 64) ? 256 : 0) : bx; u < 64; u += G) fox_cumsum_unit(lds, SM, a.b_forget + L * 8, CK, u);
        }
        }
#endif
        GSYNC(); PH_END(2);
#ifndef SKIP_CS
        { FRESH();
        for (int e = gt; e < 32 * 2048; e += NGT) {
            const int bh = e >> 11, rem = (e & 2047) * 4, dk = rem & 63;
            float* up = UT + (size_t)bh * NCH * 8192 + rem; const float* dp = DEC + (size_t)bh * NCH * 64 + dk;
            f32x4 Sv = *(const f32x4*)up;
            for (int c0 = 1; c0 <= 64; c0 += 8) {
                f32x4 uu[8], dd[8];
#pragma unroll
                for (int i = 0; i < 8; ++i) { uu[i] = *(const f32x4*)(up + (size_t)(c0 + i) * 8192); dd[i] = *(const f32x4*)(dp + (c0 + i) * 64); }
#pragma unroll
                for (int i = 0; i < 8; ++i) { Sv = dd[i] * Sv + uu[i]; *(f32x4*)(up + (size_t)(c0 + i) * 8192) = Sv; }
            }
        }
#ifdef REP_SCAN
        for (int e = gt; e < 32 * 2048; e += NGT) {
            const int bh = e >> 11, rem = (e & 2047) * 4, dk = rem & 63;
            float* up = UT + (size_t)bh * NCH * 8192 + rem; const float* dp = DEC + (size_t)bh * NCH * 64 + dk;
            for (int c0 = 1; c0 <= 64; c0 += 8) {
                f32x4 uu[8], dd[8];
#pragma unroll
                for (int i = 0; i < 8; ++i) { uu[i] = *(const f32x4*)(up + (size_t)(c0 + i) * 8192); dd[i] = *(const f32x4*)(dp + (c0 + i) * 64); }
#pragma unroll
                for (int i = 0; i < 8; ++i) { *(f32x4*)(up + (size_t)(c0 + i) * 8192) = uu[i] + dd[i] * 0.f; }
            }
        }
#endif
        }
        { FRESH();
        for (int rep = 0; rep < REP_CA; ++rep)
        for (int v0 = bx; v0 < 256; v0 += G) {
            const int v = (G == 256) ? (v0 & 7) * 32 + (v0 >> 3) : v0;
            const int bhh = v >> 2, s = v & 3;
#pragma unroll 1
            for (int i = 0; i < 2; ++i) {
                const int qb = (i == 0) ? s : 7 - s;
                attn_unit(lds, QKV, CK, OB, a.fox_norm + L * 512, bhh >> 3, bhh & 7, qb);
            }
        }
#endif
#ifndef SKIP_CM
        }
        { FRESH();
#ifndef REP_CM
#define REP_CM 1
#endif
        for (int rep = 0; rep < REP_CM; ++rep)
        if (bx < NMETA) meta_attn(QKV, CK, OB, a.fox_norm + L * 512, bx);
        if (bx >= NMETA && bx < NMETA + 4 && wid == 0) { const int bhs[1] = {bx - NMETA}, ccs[1] = {0}, hfs[1] = {0}; gla_readout_wave<1>(QKV, UT, OB, a.gla_norm + L * 512, bhs, ccs, hfs, lane); }
        }
#endif
        GSYNC(); PH_END(3);
#ifndef SKIP_D
        { FRESH();
        for (int rep = 0; rep < REP_D; ++rep)
        for (int wu = gw; wu < 32 * 64; wu += NGW) gla_readout_chunk(QKV, UT, OB, a.gla_norm + L * 512, wu >> 6, 1 + (wu & 63), lane);
        }
#endif
        GSYNC(); PH_END(4);
#ifndef SKIP_E
        {
            FRESH();
            meta_rowgemm(OB + (size_t)META0 * DM, DM, (const bf16*)(wl + WL_OUT), DM, HM, HB, G, bx);
            pg8::Gemm g{OB, (const bf16*)(wl + WL_OUT), MREAL, DM, DM}; pg8::StaticOrder S; S.init(MREAL, DM, G, bx);
            if (L == 0) { EpiRes<true, false> E{2 * L + 1}; pg8::gemm_phase<EpiRes<true, false>, pg8::StaticOrder, true, true>(lds, g, S, E); }
            else { EpiRes<false, false> E{2 * L + 1}; pg8::gemm_phase<EpiRes<false, false>, pg8::StaticOrder, true, true>(lds, g, S, E); }
        }
#endif
        GSYNC(); PH_END(5);
#ifndef SKIP_F
        {
            FRESH();
            meta_up(lds, HB, (const bf16*)(wl + WL_UP), HM, a.conv_w + (size_t)L * 3 * NUP, a.conv_b + (size_t)L * NUP, A2, HL, G, bx);
            pg8::Gemm g{HB, (const bf16*)(wl + WL_UP), MREAL, NUP, DM}; pg8::StaticOrder S; S.init(MREAL, NUP, G, bx);
            EpiUp E{L};
            for (int rep = 0; rep < REP_F; ++rep) pg8::gemm_phase<EpiUp, pg8::StaticOrder, true, true>(lds, g, S, E);
        }
#endif
        GSYNC(); PH_END(6);
#ifndef SKIP_H
        {
            FRESH();
            const float* cw = a.conv_w + (size_t)L * 3 * NUP; const float* cb = a.conv_b + (size_t)L * NUP;
            { int pm = 0;
              for (int ui = 0; so_next_pm(MREAL / 256, DM / 256, G, bx, ui, pm); ++ui) {
                for (int i = tid; i < 2 * (DFF / 4); i += 512) {
                    const int c4 = i % (DFF / 4), rr = i / (DFF / 4);
                    const int ch = 4 * c4;
                    f32x4 hc[2];
#pragma unroll
                    for (int bj = 0; bj < 2; ++bj) {
                        const int c = bj * DFF + ch;
                        f32x4 P0 = {0.f, 0.f, 0.f, 0.f}, P1 = P0;
                        if (pm != 128) { const int src = (pm % 16 == 0) ? 128 : pm - 1; P0 = *(const f32x4*)(HL + (size_t)(src * 2) * NUP + c); P1 = *(const f32x4*)(HL + (size_t)(src * 2 + 1) * NUP + c); }
                        const f32x4 H0 = *(const f32x4*)(HF + (size_t)(pm * 2) * NUP + c), H1 = *(const f32x4*)(HF + (size_t)(pm * 2 + 1) * NUP + c);
                        const f32x4 x2 = rr == 0 ? P0 : P1, x1 = rr == 0 ? P1 : H0, x0 = rr == 0 ? H0 : H1;
                        hc[bj] = *(const f32x4*)(cb + c) + *(const f32x4*)(cw + c) * x2 + *(const f32x4*)(cw + NUP + c) * x1 + *(const f32x4*)(cw + 2 * NUP + c) * x0;
                    }
                    u32x2 w;
                    w.x = pk2(siluf(hc[1][0]) * hc[0][0], siluf(hc[1][1]) * hc[0][1]);
                    w.y = pk2(siluf(hc[1][2]) * hc[0][2], siluf(hc[1][3]) * hc[0][3]);
                    *(u32x2*)(A2 + (size_t)(pm * 256 + rr) * DFF + ch) = w;
                }
              }
            }
            asm volatile("s_waitcnt vmcnt(0)" ::: "memory"); __syncthreads();
            meta_rowgemm(A2 + (size_t)META0 * DFF, DFF, (const bf16*)(wl + WL_DN), DFF, HM, HB, G, bx);
            pg8::Gemm g{A2, (const bf16*)(wl + WL_DN), MREAL, DM, DFF}; pg8::StaticOrder S; S.init(MREAL, DM, G, bx);
            if (L == DEPTH - 1) { EpiRes<false, true> E{2 * L + 2}; pg8::gemm_phase<EpiRes<false, true>, pg8::StaticOrder, true, true>(lds, g, S, E); }
            else { EpiRes<false, false> E{2 * L + 2}; pg8::gemm_phase<EpiRes<false, false>, pg8::StaticOrder, true, true>(lds, g, S, E); }
        }
#endif
        GSYNC(); PH_END(7);
    }
    {
        const int L = 0; FRESH();
        const float* ssq = ssq_arr(ws, 8);
        for (int r = gw; r < MREAL; r += NGW) {
            const float rs = row_rstd(ssq, r);
            f32x4* p = (f32x4*)(a.out + (size_t)r * DM) + lane; const f32x4* wn = (const f32x4*)a.final_norm + lane;
#pragma unroll
            for (int j = 0; j < 4; ++j) p[64 * j] = p[64 * j] * rs * wn[64 * j];
        }
#if defined(PROBE_SYNC) || defined(PROBE_PH)
        asm volatile("s_waitcnt vmcnt(0)" ::: "memory"); __syncthreads();
        if (bx == PROBE_BLOCK && tid == 0) a.out[(size_t)PROBE_BLOCK * 16 * DM * 0 + 5] += floorf((float)tsync * 0.0002f + 0.5f);
#endif
    }
}

extern "C" void kernel_launch(void* const* d_in, const int* in_sizes, int n_in, void* d_out, int out_size, void* d_ws, size_t ws_size, hipStream_t stream) {
    static int grid = 0;
    if (grid == 0) {
        if (n_in != 16 || out_size != MREAL * DM || ws_size < WS_END) { fprintf(stderr, "kernel_launch: unexpected problem (n_in %d out %d ws %zu, need %zu)\n", n_in, out_size, ws_size, (size_t)WS_END); grid = -1; return; }
        int dev = 0, cus = 0, per = 0;
        (void)hipGetDevice(&dev); (void)hipDeviceGetAttribute(&cus, hipDeviceAttributeMultiprocessorCount, dev);
        (void)hipFuncSetAttribute((const void*)fwd_kernel, hipFuncAttributeMaxDynamicSharedMemorySize, LDS_BYTES);
        (void)hipOccupancyMaxActiveBlocksPerMultiprocessor(&per, (const void*)fwd_kernel, 512, LDS_BYTES);
        if (per < 1) per = 1;
        grid = cus * per;
        fprintf(stderr, "kernel_launch: grid %d (cus %d x %d), ws %zu\n", grid, cus, per, ws_size);
    }
    if (grid < 0) return;
    Args a{};
    const float** f = (const float**)&a;
    for (int i = 0; i < 16; ++i) f[i] = (const float*)d_in[i];
    a.out = (float*)d_out; a.ws = (unsigned char*)d_ws;
    (void)hipMemsetAsync((unsigned char*)d_ws + WS_BAR, 0, BAR_BYTES, stream);
    void* args[] = {&a};
    hipError_t e = hipLaunchCooperativeKernel((const void*)fwd_kernel, dim3(grid), dim3(512), args, LDS_BYTES, stream);
    if (e != hipSuccess) fprintf(stderr, "cooperative launch failed: %s (grid %d)\n", hipGetErrorString(e), grid);
}
```

```cpp
#include <hip/hip_runtime.h>
#include <hip/hip_cooperative_groups.h>
#include <cstdio>
#include <cstdint>
namespace cg = cooperative_groups;
namespace pg8 {
#define PG8_LAS __attribute__((address_space(3)))
typedef unsigned short bf16_t;
typedef short bf16x8 __attribute__((ext_vector_type(8)));
typedef float f32x4 __attribute__((ext_vector_type(4)));
typedef unsigned u32x4 __attribute__((ext_vector_type(4)));
constexpr int BM = 256, BK = 64, HALF = 128, HTB = HALF * BK * 2  , STAGE_BYTES = 8 * HTB, NXCD = 8, WGM = 8;

__host__ __device__ __forceinline__ int lds_byte(int r, int c) { const int st = (r >> 4) * 2 + (c >> 5), rr = r & 15, cc = c & 31, ob = rr * 64 + cc * 2; return st * 1024 + (ob ^ (((ob >> 9) & 1) << 5)); }
__host__ __device__ __forceinline__ void stage_rc(int b, int& R, int& C) { const int st = b / 1024, sb = b % 1024, swz = sb ^ (((sb >> 9) & 1) << 5); R = (st >> 1) * 16 + swz / 64; C = (st & 1) * 32 + (swz % 64) / 2; }
__host__ __device__ __forceinline__ int perm32(int rho) { const int n = rho >> 4, i = rho & 15; return 8 * (i >> 2) + 4 * n + (i & 3); }

struct Unit { int pm, pn; };
struct Gemm { const bf16_t* A; const bf16_t* Bt; int M, N, K; };

struct StaticOrder {
    int nM, nN, nwg, G, c;
    __host__ __device__ void init(int M, int N, int G_, int c_) { nM = M / BM; nN = N / BM; nwg = nM * nN; G = G_; c = c_; }
    __host__ __device__ bool next(int i, Unit& u) const {
        const long L = (long)i * G + c; if (L >= nwg) return false;
        int wgid = (int)L; { const int q = nwg / NXCD, r = nwg % NXCD, xcd = wgid % NXCD, off = wgid / NXCD; wgid = (xcd < r ? xcd * (q + 1) : r * (q + 1) + (xcd - r) * q) + off; }
        const int nig = WGM * nN, gid = wgid / nig, fm = gid * WGM, gsz = (nM - fm) < WGM ? (nM - fm) : WGM;
        u.pm = fm + ((wgid % nig) % gsz); u.pn = (wgid % nig) / gsz; return true;
    }
    __device__ __forceinline__ void a_ready(const Unit&) const {}
    __device__ __forceinline__ void done(const Unit&) const {}
};

__device__ __forceinline__ unsigned cvt_pk_bf16(float lo, float hi) { unsigned r; asm volatile("v_cvt_pk_bf16_f32 %0, %1, %2" : "=v"(r) : "v"(lo), "v"(hi)); return r; }
typedef float f32x2 __attribute__((ext_vector_type(2)));
template <class Epi, class Sched, bool ALIGN_EPI = false, bool SP2 = false>
__device__ __forceinline__ void gemm_phase(PG8_LAS unsigned char* lds, const Gemm g, const Sched& S, const Epi& E) {
    int tid_ = threadIdx.x; asm volatile("" : "+v"(tid_)); const int tid = tid_, wid = __builtin_amdgcn_readfirstlane(tid >> 6), lane = tid & 63, wr = wid >> 2, wc = wid & 3, fr = lane & 15, fq = lane >> 4;
    const int K = g.K, nt = K / BK;
    unsigned voffA[2], voffB[2];
#pragma unroll
    for (int i = 0; i < 2; ++i) { int R, C; stage_rc(tid * 16 + i * 8192, R, C); const int Rb = Epi::PERM ? ((R & ~31) + perm32(R & 31)) : R;
        voffA[i] = (unsigned)(R * K + C) * 2u; voffB[i] = (unsigned)(Rb * K + C) * 2u; }
    const size_t kstep = (size_t)(BK * 2);
    const size_t hstep = (size_t)HALF * K * 2;
    const size_t tstep = 2 * hstep;
    const unsigned ldsw = (unsigned)wid * 1024u;
    const int aoff = lds_byte(wr * 64 + fr, fq * 8), boff = lds_byte(wc * 32 + fr, fq * 8);
#define PG8_SA(b, h) (((b) * 2 + (h)) * HTB)
#define PG8_SB(b, h) ((4 + (b) * 2 + (h)) * HTB)
#define PG8_STAGE(bufoff, gbase, voff) do { _Pragma("unroll") for (int _i = 0; _i < 2; ++_i) \
        __builtin_amdgcn_global_load_lds((const unsigned*)((const char*)(gbase) + (voff)[_i]), (PG8_LAS unsigned*)(lds + (bufoff) + ldsw + _i * 8192), 16, 0, 0); } while (0)
#define PG8_LDA(dst, b, h) do { _Pragma("unroll") for (int m = 0; m < 4; ++m) _Pragma("unroll") for (int k = 0; k < 2; ++k) dst[m][k] = *(const PG8_LAS bf16x8*)(lds + PG8_SA(b, h) + aoff + m * 2048 + k * 1024); } while (0)
#define PG8_LDB(dst, b, h) do { _Pragma("unroll") for (int n = 0; n < 2; ++n) _Pragma("unroll") for (int k = 0; k < 2; ++k) dst[n][k] = *(const PG8_LAS bf16x8*)(lds + PG8_SB(b, h) + boff + n * 2048 + k * 1024); } while (0)
#define PG8_MMA(ai, bj, At, Bt) do { __builtin_amdgcn_s_setprio(1); _Pragma("unroll") for (int m = 0; m < 4; ++m) _Pragma("unroll") for (int n = 0; n < 2; ++n) _Pragma("unroll") for (int k = 0; k < 2; ++k) \
        acc[ai][bj][m][n] = __builtin_amdgcn_mfma_f32_16x16x32_bf16(Bt[n][k], At[m][k], acc[ai][bj][m][n], 0, 0, 0); __builtin_amdgcn_s_setprio(0); } while (0)
#define PG8_WAIT_V(n) asm volatile("s_waitcnt vmcnt(" #n ")" ::: "memory")
#define PG8_WAIT_L(n) asm volatile("s_waitcnt lgkmcnt(" #n ")" ::: "memory")
#define PG8_BAR __builtin_amdgcn_s_barrier()
#define PG8_SCHED __builtin_amdgcn_sched_barrier(0)
    Unit cur, nxt; int ui = 0;
    if (!S.next(0, cur)) return;
    f32x4 acc[2][2][4][2];
#pragma unroll
    for (int a = 0; a < 2; ++a)
#pragma unroll
        for (int b = 0; b < 2; ++b)
#pragma unroll
            for (int m = 0; m < 4; ++m)
#pragma unroll
                for (int n = 0; n < 2; ++n) acc[a][b][m][n] = (f32x4){0.f, 0.f, 0.f, 0.f};
    bf16x8 At[4][2], B0[2][2], B1[2][2];
    const char* cA = (const char*)g.A + (size_t)cur.pm * tstep; const char* cB = (const char*)g.Bt + (size_t)cur.pn * tstep;
    S.a_ready(cur);
    if constexpr (SP2) {
        PG8_STAGE(PG8_SB(0, 0), cB, voffB); PG8_STAGE(PG8_SB(0, 1), cB + hstep, voffB); PG8_STAGE(PG8_SA(0, 0), cA, voffA); PG8_STAGE(PG8_SA(0, 1), cA + hstep, voffA);
        if (wr == 1) PG8_BAR;
        PG8_WAIT_V(2); PG8_BAR;
        PG8_STAGE(PG8_SB(1, 0), cB + kstep, voffB); PG8_STAGE(PG8_SA(1, 0), cA + kstep, voffA); PG8_STAGE(PG8_SB(1, 1), cB + hstep + kstep, voffB);
        PG8_WAIT_V(6); PG8_BAR;
    } else {
        PG8_STAGE(PG8_SB(0, 0), cB, voffB); PG8_STAGE(PG8_SA(0, 0), cA, voffA); PG8_STAGE(PG8_SB(0, 1), cB + hstep, voffB); PG8_STAGE(PG8_SA(0, 1), cA + hstep, voffA);
        if (wr == 1) PG8_BAR;
        PG8_WAIT_V(4); PG8_BAR;
        PG8_STAGE(PG8_SB(1, 0), cB + kstep, voffB); PG8_STAGE(PG8_SA(1, 0), cA + kstep, voffA); PG8_STAGE(PG8_SB(1, 1), cB + hstep + kstep, voffB);
        PG8_WAIT_V(6); PG8_BAR;
    }
    for (;;) {
        const bool has_next = S.next(ui + 1, nxt);
        const char* nA = has_next ? (const char*)g.A + (size_t)nxt.pm * tstep : cA; const char* nB = has_next ? (const char*)g.Bt + (size_t)nxt.pn * tstep : cB;
        for (int t = 0; t < nt; t += 2) {
            const bool last = (t == nt - 2);
            const char* a1 = cA + (size_t)(t + 1) * kstep;
            const char* a2 = last ? nA : cA + (size_t)(t + 2) * kstep; const char* b2 = last ? nB : cB + (size_t)(t + 2) * kstep;
            const char* a3 = a2 + kstep; const char* b3 = b2 + kstep;
            if (last && has_next) S.a_ready(nxt);
            if constexpr (SP2) {
            PG8_LDB(B0, 0, 0); PG8_LDB(B1, 0, 1); PG8_SCHED; PG8_LDA(At, 0, 0); PG8_STAGE(PG8_SA(1, 1), a1 + hstep, voffA);
            PG8_WAIT_V(8); PG8_WAIT_L(0); PG8_BAR; PG8_MMA(0, 0, At, B0); PG8_MMA(0, 1, At, B1); PG8_BAR; PG8_SCHED;
            PG8_LDA(At, 0, 1); PG8_STAGE(PG8_SB(0, 0), b2, voffB); PG8_STAGE(PG8_SB(0, 1), b2 + hstep, voffB); PG8_STAGE(PG8_SA(0, 0), a2, voffA);
            PG8_WAIT_V(8); PG8_WAIT_L(0); PG8_BAR; PG8_MMA(1, 0, At, B0); PG8_MMA(1, 1, At, B1); PG8_BAR; PG8_SCHED;
            PG8_LDB(B0, 1, 0); PG8_LDB(B1, 1, 1); PG8_SCHED; PG8_LDA(At, 1, 0); PG8_STAGE(PG8_SA(0, 1), a2 + hstep, voffA);
            PG8_WAIT_V(8); PG8_WAIT_L(0); PG8_BAR; PG8_MMA(0, 0, At, B0); PG8_MMA(0, 1, At, B1); PG8_BAR; PG8_SCHED;
            PG8_LDA(At, 1, 1); PG8_STAGE(PG8_SB(1, 0), b3, voffB); PG8_STAGE(PG8_SB(1, 1), b3 + hstep, voffB); PG8_STAGE(PG8_SA(1, 0), a3, voffA);
            PG8_WAIT_V(8); PG8_WAIT_L(0); PG8_BAR; PG8_MMA(1, 0, At, B0); PG8_MMA(1, 1, At, B1); PG8_BAR; PG8_SCHED;
            } else {
            PG8_LDB(B0, 0, 0); PG8_SCHED; PG8_LDA(At, 0, 0); PG8_STAGE(PG8_SA(1, 1), a1 + hstep, voffA);
            PG8_WAIT_L(8); PG8_BAR; PG8_WAIT_L(0); PG8_MMA(0, 0, At, B0); PG8_BAR; PG8_SCHED;
            PG8_LDB(B1, 0, 1); PG8_STAGE(PG8_SB(0, 0), b2, voffB);
            PG8_BAR; PG8_WAIT_L(0); PG8_MMA(0, 1, At, B1); PG8_BAR;
            PG8_LDA(At, 0, 1); PG8_STAGE(PG8_SA(0, 0), a2, voffA);
            PG8_BAR; PG8_WAIT_L(0); PG8_MMA(1, 0, At, B0); PG8_BAR; PG8_SCHED;
            PG8_STAGE(PG8_SB(0, 1), b2 + hstep, voffB);
            PG8_WAIT_V(6); PG8_BAR; PG8_MMA(1, 1, At, B1); PG8_BAR;
            PG8_LDB(B0, 1, 0); PG8_SCHED; PG8_LDA(At, 1, 0); PG8_STAGE(PG8_SA(0, 1), a2 + hstep, voffA);
            PG8_WAIT_L(8); PG8_BAR; PG8_WAIT_L(0); PG8_MMA(0, 0, At, B0); PG8_BAR; PG8_SCHED;
            PG8_LDB(B1, 1, 1); PG8_STAGE(PG8_SB(1, 0), b3, voffB);
            PG8_BAR; PG8_WAIT_L(0); PG8_MMA(0, 1, At, B1); PG8_BAR;
            PG8_LDA(At, 1, 1); PG8_STAGE(PG8_SA(1, 0), a3, voffA);
            PG8_BAR; PG8_WAIT_L(0); PG8_MMA(1, 0, At, B0); PG8_BAR; PG8_SCHED;
            PG8_STAGE(PG8_SB(1, 1), b3 + hstep, voffB);
            PG8_WAIT_V(6); PG8_BAR; PG8_MMA(1, 1, At, B1); PG8_BAR;
            }
        }
        if constexpr (ALIGN_EPI) { if (wr == 0) PG8_BAR; }
        if constexpr (!Epi::AFTER_DRAIN) { E(acc, cur, wr, wc, fr, fq); S.done(cur); }
        if (!has_next) break;
#pragma unroll
        for (int a = 0; a < 2; ++a)
#pragma unroll
            for (int b = 0; b < 2; ++b)
#pragma unroll
                for (int m = 0; m < 4; ++m)
#pragma unroll
                    for (int n = 0; n < 2; ++n) acc[a][b][m][n] = (f32x4){0.f, 0.f, 0.f, 0.f};
        cur = nxt; cA = nA; cB = nB; ++ui;
        if constexpr (ALIGN_EPI) { if (wr == 1) PG8_BAR; }
    }
    PG8_WAIT_V(0);
    if constexpr (!ALIGN_EPI) { if (wr == 0) PG8_BAR; }
    PG8_BAR;
    if constexpr (Epi::AFTER_DRAIN) { E.fused(acc, cur, wr, wc, fr, fq, lds, wid, lane); S.done(cur); }
#undef PG8_SA
#undef PG8_SB
#undef PG8_STAGE
#undef PG8_LDA
#undef PG8_LDB
#undef PG8_MMA
#undef PG8_WAIT_V
#undef PG8_WAIT_L
#undef PG8_BAR
#undef PG8_SCHED
}
}
#define LAS __attribute__((address_space(3)))
typedef unsigned short bf16;
typedef short bf16x8 __attribute__((ext_vector_type(8)));
typedef short s16x4 __attribute__((ext_vector_type(4)));
typedef float f32x4 __attribute__((ext_vector_type(4)));
typedef float f32x16 __attribute__((ext_vector_type(16)));
typedef unsigned u32x4 __attribute__((ext_vector_type(4)));
typedef unsigned u32x2 __attribute__((ext_vector_type(2)));

constexpr int NB = 8, SEQ = 4096, DM = 1024, DEPTH = 4, NMETA = 16;
constexpr int MREAL = NB * SEQ;
constexpr int META0 = MREAL;
constexpr int MROWS = 129 * 256;
constexpr int NINP = 3328, QP = 3072;
constexpr int C_FQ = 0, C_FK = 512, C_FV = 1024, C_GQ = 1536, C_GK = 1792, C_GV = 2048, C_GR = 2560;
constexpr int DFF = 2816, NUP = 5632;
constexpr float EPS = 1e-6f, LOG2E = 1.4426950408889634f, C2 = 0.125f * LOG2E;
constexpr int CKP = 4160;
constexpr int NCH = 65;

constexpr size_t MiB = 1u << 20;
constexpr size_t WL_IN = 0, WL_OUT = 6815744, WL_UP = 8912896, WL_DN = 20447232, WL_SIZE = 26214400;
constexpr size_t WS_W = 0, WS_HB = 100 * MiB, WS_OB = WS_HB + 67633152, WS_QKV = WS_OB + 67633152, WS_UT = WS_QKV + 202899456;
constexpr size_t WS_SM = WS_UT + 68157440, WS_CK = WS_SM + 4456448, WS_DEC = WS_CK + 1310720, WS_HM = WS_DEC + 786432, WS_SSQ = WS_HM + MiB, WS_BAR = WS_SSQ + 1835008, BAR_BYTES = 16384, WS_END = WS_BAR + BAR_BYTES;
static_assert(WS_END <= 512 * MiB, "workspace map");
constexpr size_t HFL_SIZE = (size_t)129 * 2 * NUP * 4;
static_assert(2 * HFL_SIZE <= 68157440, "halo overlay");

constexpr int LDS_BYTES = 147456, HALO_OFF = 131072;

struct Args {
    const float *x, *meta, *attn_norm, *w_in, *w_au, *b_alpha, *b_forget, *gla_norm, *fox_norm, *w_out, *ffn_norm, *w_up, *conv_w, *conv_b, *w_down, *final_norm;
    float* out; unsigned char* ws;
};

#define GAS __attribute__((address_space(1)))
#define CAS __attribute__((address_space(4)))
typedef const CAS Args* KArgs;
__device__ __forceinline__ KArgs kargs() { KArgs p = (KArgs)__builtin_amdgcn_kernarg_segment_ptr(); asm volatile("" : "+s"(p)); return p; }
template <class T> __device__ __forceinline__ T* gptr(T* p) { return (T*)(GAS T*)p; }
__device__ __forceinline__ float bf2f(bf16 v) { return __uint_as_float((unsigned)v << 16); }
__device__ __forceinline__ unsigned pk2(float lo, float hi) { return pg8::cvt_pk_bf16(lo, hi); }
__device__ __forceinline__ bf16 f2bf(float v) { return (bf16)(pk2(v, 0.f) & 0xffffu); }
__device__ __forceinline__ float wave_sum(float v) {
#pragma unroll
    for (int o = 1; o < 64; o <<= 1) v += __shfl_xor(v, o);
    return v;
}
__device__ __forceinline__ float logsigmoidf(float z) { return -(fmaxf(-z, 0.f) + log1pf(__expf(-fabsf(z)))); }
__device__ __forceinline__ float siluf(float v) { return v * __builtin_amdgcn_rcpf(1.f + __builtin_amdgcn_exp2f(-LOG2E * v)); }
__device__ __forceinline__ int crow(int r, int hi) { return (r & 3) + 8 * (r >> 2) + 4 * hi; }
__device__ __forceinline__ s16x4 vtr(const LAS unsigned char* p) { return __builtin_bit_cast(s16x4, __builtin_amdgcn_ds_read_tr16_b64_v4i16((LAS s16x4*)p)); }
__device__ __forceinline__ bf16x8 cat8(s16x4 a, s16x4 b) { return (bf16x8){a[0], a[1], a[2], a[3], b[0], b[1], b[2], b[3]}; }
__device__ __forceinline__ float dppf(float old, float src, int ctrl_unused);
#define DPP_MOV(old, src, ctrl) __builtin_bit_cast(float, __builtin_amdgcn_update_dpp(__builtin_bit_cast(int, (float)(old)), __builtin_bit_cast(int, (float)(src)), (ctrl), 0xf, 0xf, false))
#define LDS_WAIT() asm volatile("s_waitcnt lgkmcnt(0)" ::: "memory")

__device__ __forceinline__ const float* ssq_arr(unsigned char* wsb, int si) { return (const float*)(wsb + WS_SSQ) + (size_t)(si % 3) * MROWS * 4; }
__device__ __forceinline__ float row_rstd(const float* ssqp, int row) { const f32x4 s = *(const f32x4*)(ssqp + (size_t)row * 4); return rsqrtf(((s[0] + s[1]) + (s[2] + s[3])) * (1.0f / DM) + EPS); }
__device__ __forceinline__ LAS float* tile_rstd(unsigned char* wsb, int si, int pm, int wr, int wc, int fr, int fq) {
    extern __shared__ __attribute__((aligned(16))) unsigned char lds_dyn_[];
    LAS float* rsl = (LAS float*)((LAS unsigned char*)lds_dyn_ + HALO_OFF + 8192);
    const int tl = (wr * 4 + wc) * 64 + fq * 16 + fr;
    if (pm != 128) {
        if (tl < 256) rsl[tl] = row_rstd(ssq_arr(wsb, si), pm * 256 + tl);
    } else {
        const int row = tl >> 5, part = tl & 31;
        const f32x4* hp = (const f32x4*)((const float*)(wsb + WS_HM) + (size_t)row * DM) + part;
        float s = 0.f;
#pragma unroll
        for (int j = 0; j < 8; ++j) { const f32x4 v = hp[32 * j]; s += (v[0] * v[0] + v[1] * v[1]) + (v[2] * v[2] + v[3] * v[3]); }
        s += __shfl_xor(s, 1); s += __shfl_xor(s, 2); s += __shfl_xor(s, 4); s += __shfl_xor(s, 8); s += __shfl_xor(s, 16);
        if (part == 0) rsl[row] = rsqrtf(s * (1.0f / DM) + EPS);
        if (tl < 240) rsl[16 + tl] = 0.f;
    }
    asm volatile("s_waitcnt lgkmcnt(0)" ::: "memory"); __builtin_amdgcn_s_barrier(); asm volatile("" ::: "memory");
    return rsl;
}
__device__ __forceinline__ void meta_rowgemm(const bf16* A, int lda, const bf16* Bt, int K, float* HM, bf16* HB, int G, int bx) {
    int tid_ = threadIdx.x; asm volatile("" : "+v"(tid_)); const int r = tid_ >> 5, kp = tid_ & 31;
    for (int cg = bx; cg < 256; cg += G) {
        float acc[4] = {0.f, 0.f, 0.f, 0.f};
        for (int k0 = kp * 8; k0 < K; k0 += 256) {
            const u32x4 av = *(const u32x4*)(A + (size_t)r * lda + k0);
#pragma unroll
            for (int j = 0; j < 4; ++j) {
                const u32x4 bv = *(const u32x4*)(Bt + (size_t)(4 * cg + j) * K + k0);
#pragma unroll
                for (int q = 0; q < 4; ++q) {
                    acc[j] += __uint_as_float(av[q] << 16) * __uint_as_float(bv[q] << 16);
                    acc[j] += __uint_as_float(av[q] & 0xffff0000u) * __uint_as_float(bv[q] & 0xffff0000u);
                }
            }
        }
#pragma unroll
        for (int j = 0; j < 4; ++j) { float s = acc[j]; s += __shfl_xor(s, 1); s += __shfl_xor(s, 2); s += __shfl_xor(s, 4); s += __shfl_xor(s, 8); s += __shfl_xor(s, 16); acc[j] = s; }
        if (kp == 0) {
            float* hp = HM + (size_t)r * DM + 4 * cg;
            const f32x4 h = *(const f32x4*)hp + (f32x4){acc[0], acc[1], acc[2], acc[3]};
            *(f32x4*)hp = h;
            u32x2 w; w.x = pk2(h[0], h[1]); w.y = pk2(h[2], h[3]);
            *(u32x2*)(HB + (size_t)(META0 + r) * DM + 4 * cg) = w;
        }
    }
}
__device__ __forceinline__ void meta_up(LAS unsigned char* lds, const bf16* HB, const bf16* Wup, const float* HM, const float* cw, const float* cb, bf16* A2, float* HL, int G, int bx) {
    int tid_ = threadIdx.x; asm volatile("" : "+v"(tid_)); const int tid = tid_, r = tid >> 5, kp = tid & 31;
    LAS float* hb = (LAS float*)lds;
    float rs;
    { const f32x4* hp = (const f32x4*)(HM + (size_t)r * DM) + kp; float s = 0.f;
#pragma unroll
      for (int j = 0; j < 8; ++j) { const f32x4 v = hp[32 * j]; s += (v[0] * v[0] + v[1] * v[1]) + (v[2] * v[2] + v[3] * v[3]); }
      s += __shfl_xor(s, 1); s += __shfl_xor(s, 2); s += __shfl_xor(s, 4); s += __shfl_xor(s, 8); s += __shfl_xor(s, 16);
      rs = rsqrtf(s * (1.0f / DM) + EPS); }
    u32x4 av[4];
#pragma unroll
    for (int i = 0; i < 4; ++i) av[i] = *(const u32x4*)(HB + (size_t)(META0 + r) * DM + kp * 8 + 256 * i);
    for (int cg = bx; cg < 256; cg += G) {
#pragma unroll 1
        for (int cb0 = 0; cb0 < 24; cb0 += 6) {
            u32x4 bv[6][4];
#pragma unroll
            for (int c6 = 0; c6 < 6; ++c6) {
                const int c = cb0 + c6 < 22 ? cb0 + c6 : 21, isg = c >= 11 ? 1 : 0, jj = c - 11 * isg;
                const int ch = 11 * cg + jj, wrow = (ch >> 7) * 256 + isg * 128 + (ch & 127);
#pragma unroll
                for (int i = 0; i < 4; ++i) bv[c6][i] = *(const u32x4*)(Wup + (size_t)wrow * DM + kp * 8 + 256 * i);
            }
#pragma unroll
            for (int c6 = 0; c6 < 6; ++c6) {
                float acc = 0.f;
#pragma unroll
                for (int i = 0; i < 4; ++i)
#pragma unroll
                    for (int q = 0; q < 4; ++q) {
                        acc += __uint_as_float(av[i][q] << 16) * __uint_as_float(bv[c6][i][q] << 16);
                        acc += __uint_as_float(av[i][q] & 0xffff0000u) * __uint_as_float(bv[c6][i][q] & 0xffff0000u);
                    }
                acc += __shfl_xor(acc, 1); acc += __shfl_xor(acc, 2); acc += __shfl_xor(acc, 4); acc += __shfl_xor(acc, 8); acc += __shfl_xor(acc, 16);
                if (kp == 0 && cb0 + c6 < 22) hb[r * 24 + cb0 + c6] = acc * rs;
            }
        }
        __syncthreads();
        if (tid < 16 * 11) {
            const int rr = tid / 11, jj = tid % 11, ch = 11 * cg + jj;
            float hc[2];
#pragma unroll
            for (int ug = 0; ug < 2; ++ug) {
                const int c = ug * DFF + ch;
                const float x0 = hb[rr * 24 + ug * 11 + jj], x1 = rr >= 1 ? hb[(rr - 1) * 24 + ug * 11 + jj] : 0.f, x2 = rr >= 2 ? hb[(rr - 2) * 24 + ug * 11 + jj] : 0.f;
                hc[ug] = cb[c] + cw[c] * x2 + cw[NUP + c] * x1 + cw[2 * NUP + c] * x0;
                if (rr >= 14) HL[(size_t)(256 + rr - 14) * NUP + c] = x0;
            }
            A2[(size_t)(META0 + rr) * DFF + ch] = f2bf(siluf(hc[1]) * hc[0]);
        }
        __syncthreads();
    }
}
__device__ __forceinline__ bool so_next_pm(int nM, int nN, int G, int c, int i, int& pm) {
    const int nwg = nM * nN; const long Lq = (long)i * G + c; if (Lq >= nwg) return false;
    int wgid = (int)Lq; { const int q = nwg / pg8::NXCD, r = nwg % pg8::NXCD, xcd = wgid % pg8::NXCD, off = wgid / pg8::NXCD; wgid = (xcd < r ? xcd * (q + 1) : r * (q + 1) + (xcd - r) * q) + off; }
    const int nig = pg8::WGM * nN, gid = wgid / nig, fm = gid * pg8::WGM, gsz = (nM - fm) < pg8::WGM ? (nM - fm) : pg8::WGM;
    pm = fm + ((wgid % nig) % gsz); return true;
}
struct EpiIn {
    static constexpr bool PERM = true, AFTER_DRAIN = false;
    int si;
    __device__ __forceinline__ void operator()(const pg8::f32x4 (&acc)[2][2][4][2], const pg8::Unit& u, int wr, int wc, int fr, int fq) const {
        asm volatile("" : "+v"(fr), "+v"(fq));
        unsigned char* wsb = gptr(kargs()->ws);
        bf16* Q = (bf16*)(wsb + WS_QKV); float* SM = (float*)(wsb + WS_SM); const LAS float* rsl = tile_rstd(wsb, si, u.pm, wr, wc, fr, fq);
#pragma unroll
        for (int ai = 0; ai < 2; ++ai)
#pragma unroll
            for (int m = 0; m < 4; ++m) {
                const int row = u.pm * 256 + ai * 128 + wr * 64 + m * 16 + fr;
                const float rs = rsl[ai * 128 + wr * 64 + m * 16 + fr];
                if (u.pn < 12) {
#pragma unroll
                    for (int bj = 0; bj < 2; ++bj) {
                        const pg8::f32x4 v0 = acc[ai][bj][m][0] * rs, v1 = acc[ai][bj][m][1] * rs;
                        u32x4 w; w.x = pk2(v0[0], v0[1]); w.y = pk2(v0[2], v0[3]); w.z = pk2(v1[0], v1[1]); w.w = pk2(v1[2], v1[3]);
                        *(u32x4*)(Q + (size_t)row * QP + u.pn * 256 + bj * 128 + wc * 32 + 8 * fq) = w;
                    }
                } else if (wc == 0) {
                    *(f32x4*)(SM + (size_t)row * 32 + 8 * fq) = acc[ai][0][m][0] * rs;
                    *(f32x4*)(SM + (size_t)row * 32 + 8 * fq + 4) = acc[ai][0][m][1] * rs;
                }
            }
    }
};
template <bool from_x, bool last> struct EpiRes {
    static constexpr bool PERM = false, AFTER_DRAIN = false;
    int si;
    __device__ __forceinline__ void operator()(const pg8::f32x4 (&acc)[2][2][4][2], const pg8::Unit& u, int wr, int wc, int fr, int fq) const {
        asm volatile("" : "+v"(fr), "+v"(fq));
        KArgs ka = kargs(); unsigned char* wsb = gptr(ka->ws);
        float* out = last ? gptr(ka->out) : nullptr; const float* xin = from_x ? gptr(ka->x) : nullptr; bf16* HB = (bf16*)(wsb + WS_HB); float* ssq_next = (float*)ssq_arr(wsb, si);
        extern __shared__ __attribute__((aligned(16))) unsigned char lds_dyn_[];
        LAS float* red = (LAS float*)((LAS unsigned char*)lds_dyn_ + HALO_OFF);
#pragma unroll
        for (int ai = 0; ai < 2; ++ai)
#pragma unroll
            for (int m = 0; m < 4; ++m) {
                const int row = u.pm * 256 + ai * 128 + wr * 64 + m * 16 + fr;
                float ss = 0.f;
#pragma unroll
                for (int bj = 0; bj < 2; ++bj)
#pragma unroll
                    for (int n = 0; n < 2; ++n) {
                        const int col = u.pn * 256 + bj * 128 + wc * 32 + 16 * n + 4 * fq;
                        f32x4 bs;
                        if constexpr (from_x) bs = *(const f32x4*)(xin + (size_t)row * DM + col);
                        else { const u32x2 t = *(const u32x2*)(HB + (size_t)row * DM + col);
                               bs = (f32x4){__uint_as_float(t.x << 16), __uint_as_float(t.x & 0xffff0000u), __uint_as_float(t.y << 16), __uint_as_float(t.y & 0xffff0000u)}; }
                        const f32x4 h = bs + acc[ai][bj][m][n];
                        ss += (h[0] * h[0] + h[1] * h[1]) + (h[2] * h[2] + h[3] * h[3]);
                        u32x2 w; w.x = pk2(h[0], h[1]); w.y = pk2(h[2], h[3]);
                        *(u32x2*)(HB + (size_t)row * DM + col) = w;
                        if constexpr (last) *(f32x4*)(out + (size_t)row * DM + col) = h;
                    }
                ss += __shfl_xor(ss, 16); ss += __shfl_xor(ss, 32);
                if (fq == 0) red[wc * 256 + ai * 128 + wr * 64 + m * 16 + fr] = ss;
            }
        asm volatile("s_waitcnt lgkmcnt(0)" ::: "memory"); __builtin_amdgcn_s_barrier(); asm volatile("" ::: "memory");
        {
            const int tl = (wr * 4 + wc) * 64 + fq * 16 + fr;
            if (tl < 256) ssq_next[(size_t)(u.pm * 256 + tl) * 4 + u.pn] = (red[tl] + red[256 + tl]) + (red[512 + tl] + red[768 + tl]);
        }
    }
};
struct EpiUp {
    static constexpr bool PERM = true, AFTER_DRAIN = false;
    int L;
    __device__ __forceinline__ void operator()(pg8::f32x4 (&acc)[2][2][4][2], const pg8::Unit& u, int wr, int wc, int fr, int fq) const {
        asm volatile("" : "+v"(fr), "+v"(fq));
        KArgs ka = kargs(); unsigned char* wsb = gptr(ka->ws);
        const LAS float* rsl = tile_rstd(wsb, 2 * L + 1, u.pm, wr, wc, fr, fq); const float* cw = gptr(ka->conv_w) + (size_t)L * 3 * NUP; const float* cb = gptr(ka->conv_b) + (size_t)L * NUP;
        extern __shared__ __attribute__((aligned(16))) unsigned char lds_dyn_[];
        LAS float* halo = (LAS float*)((LAS unsigned char*)lds_dyn_ + HALO_OFF);
        const int colw = wc * 32 + 8 * fq;
#pragma unroll
        for (int ai = 0; ai < 2; ++ai)
#pragma unroll
            for (int m = 0; m < 4; ++m) {
                const int row = u.pm * 256 + ai * 128 + wr * 64 + m * 16 + fr;
                const float rs = rsl[ai * 128 + wr * 64 + m * 16 + fr]; (void)row;
#pragma unroll
                for (int bj = 0; bj < 2; ++bj)
#pragma unroll
                    for (int n = 0; n < 2; ++n) acc[ai][bj][m][n] *= rs;
            }
#ifdef SIMPLE_UP
        {
            const int ch0s = u.pn * 128 + colw;
#pragma unroll
            for (int n = 0; n < 2; ++n)
#pragma unroll
                for (int ai = 0; ai < 2; ++ai)
#pragma unroll
                    for (int m = 0; m < 4; ++m) {
                        const int row = u.pm * 256 + ai * 128 + wr * 64 + m * 16 + fr;
                        const f32x4 hu = acc[ai][0][m][n], hg = acc[ai][1][m][n];
                        u32x2 w; w.x = pk2(hu[0] + hg[0], hu[1] + hg[1]); w.y = pk2(hu[2] + hg[2], hu[3] + hg[3]);
                        *(u32x2*)(wsb + (unsigned)(WS_QKV + (unsigned)((row * DFF + ch0s + 4 * n) * 2))) = w;
                    }
            return;
        }
#endif
        if (fr >= 14) {
#pragma unroll
            for (int ai = 0; ai < 2; ++ai)
#pragma unroll
                for (int bj = 0; bj < 2; ++bj)
#pragma unroll
                    for (int n = 0; n < 2; ++n)
                        *(LAS f32x4*)(halo + (((2 * ai + wr) * 2 + (fr - 14)) * 256 + bj * 128 + colw + 4 * n)) = acc[ai][bj][3][n];
        }
        asm volatile("s_waitcnt lgkmcnt(0)" ::: "memory"); __builtin_amdgcn_s_barrier(); asm volatile("" ::: "memory");
        const int ch0 = u.pn * 128 + colw;
        u32x2 wout[2][4][2];
#pragma unroll
        for (int n = 0; n < 2; ++n) {
            f32x4 w0[2], w1[2], w2[2], bb[2];
#pragma unroll
            for (int bj = 0; bj < 2; ++bj) {
                const int c = bj * DFF + ch0 + 4 * n;
                w0[bj] = *(const f32x4*)((const char*)cw + (unsigned)(c * 4)); w1[bj] = *(const f32x4*)((const char*)cw + (unsigned)((NUP + c) * 4)); w2[bj] = *(const f32x4*)((const char*)cw + (unsigned)((2 * NUP + c) * 4)); bb[bj] = *(const f32x4*)((const char*)cb + (unsigned)(c * 4));
            }
#pragma unroll
            for (int ai = 0; ai < 2; ++ai)
#pragma unroll
                for (int m = 0; m < 4; ++m) {
                    const int g = 2 * ai + wr;
                    f32x4 hc[2];
#pragma unroll
                    for (int bj = 0; bj < 2; ++bj) {
                        const int c = bj * DFF + ch0 + 4 * n;
                        const f32x4 cur = acc[ai][bj][m][n];
                        f32x4 pb;
                        if (m > 0) pb = acc[ai][bj][m - 1][n];
                        else pb = *(const LAS f32x4*)(halo + ((((g > 0 ? g - 1 : 0) * 2) + (fr & 1)) * 256 + bj * 128 + colw + 4 * n));
                        f32x4 p1, p2;
#pragma unroll
                        for (int j = 0; j < 4; ++j) {
                            const float t1 = DPP_MOV(0.f, pb[j], 0x121);
                            p1[j] = DPP_MOV(t1, cur[j], 0x111);
                            const float t2 = DPP_MOV(0.f, pb[j], 0x122);
                            p2[j] = DPP_MOV(t2, cur[j], 0x112);
                        }
                        hc[bj] = bb[bj] + w0[bj] * p2 + w1[bj] * p1 + w2[bj] * cur;
                        if (g == 0 && m == 0 && fr < 2) *(f32x4*)(wsb + (unsigned)(WS_UT + (unsigned)(((u.pm * 2 + fr) * NUP + c) * 4))) = cur;
                        if (u.pm == 128 ? (g == 0 && m == 0 && fr >= 14) : (g == 3 && m == 3 && fr >= 14))
                            *(f32x4*)(wsb + (unsigned)(WS_UT + HFL_SIZE + (unsigned)(((u.pm * 2 + fr - 14) * NUP + c) * 4))) = cur;
                    }
                    wout[ai][m][n].x = pk2(siluf(hc[1][0]) * hc[0][0], siluf(hc[1][1]) * hc[0][1]);
                    wout[ai][m][n].y = pk2(siluf(hc[1][2]) * hc[0][2], siluf(hc[1][3]) * hc[0][3]);
                }
        }
#pragma unroll
        for (int ai = 0; ai < 2; ++ai)
#pragma unroll
            for (int m = 0; m < 4; ++m) {
                const int row = u.pm * 256 + ai * 128 + wr * 64 + m * 16 + fr;
                u32x4 w; w.x = wout[ai][m][0].x; w.y = wout[ai][m][0].y; w.z = wout[ai][m][1].x; w.w = wout[ai][m][1].y;
                *(u32x4*)(wsb + (unsigned)(WS_QKV + (unsigned)((row * DFF + ch0) * 2))) = w;
            }
    }
};
#define XB_TMO      128
#define XB_XCNT(j)  (256  + 64 * (j))
#define XB_XSUB(j)  (1280 + 64 * (j))
#define XB_XGEN(j)  (2304 + 64 * (j))
#define XB_TOP      3328
#define XB_TOPGEN   3392
#define XCD_BAR_WORDS 3456
#define XB_SPIN_CAP (1u << 18)

__device__ __forceinline__ unsigned xb_ld(unsigned* p)              { return __hip_atomic_load(p, __ATOMIC_RELAXED, __HIP_MEMORY_SCOPE_AGENT); }
__device__ __forceinline__ unsigned xb_add(unsigned* p, unsigned v) { return __hip_atomic_fetch_add(p, v, __ATOMIC_RELAXED, __HIP_MEMORY_SCOPE_AGENT); }
__device__ __forceinline__ unsigned xb_xcc_id() { return (unsigned)__builtin_amdgcn_s_getreg((3 << 11) | 20) & 0xFu; }
#define XB_SPIN(cond, bar) do { unsigned _sp = 0; while (cond) { __builtin_amdgcn_s_sleep(1); \
    if ((++_sp & 255u) == 0u) { if (xb_ld(&(bar)[XB_TMO])) break; if (_sp > XB_SPIN_CAP) { atomicAdd(&(bar)[XB_TMO], 1u); break; } } } } while (0)

struct XcdBarrier {
    unsigned* bar; unsigned x;
    volatile LAS unsigned* st;
};

__device__ __forceinline__ XcdBarrier xcd_barrier_post(unsigned* bar, volatile LAS unsigned* st) {
    XcdBarrier b; b.bar = bar; b.x = xb_xcc_id(); b.st = st;
    if (threadIdx.x == 0) (void)xb_add(&bar[XB_XCNT(b.x)], 1u);
    return b;
}
__device__ __forceinline__ void xcd_barrier_complete(unsigned* bar, unsigned x, unsigned& nloc, unsigned& nx) {
    const unsigned G = gridDim.x * gridDim.y * gridDim.z;
    unsigned sum, cnt, mine, sp = 0u;
    for (;;) {
        sum = 0u; cnt = 0u; mine = 0u;
#pragma unroll
        for (unsigned j = 0; j < 16; ++j) { const unsigned c = xb_ld(&bar[XB_XCNT(j)]); sum += c; cnt += (c > 0u) ? 1u : 0u; mine = (j == x) ? c : mine; }
        if (sum == G) break;
        __builtin_amdgcn_s_sleep(1);
        if ((++sp & 255u) == 0u) { if (xb_ld(&bar[XB_TMO])) break; if (sp > XB_SPIN_CAP) { atomicAdd(&bar[XB_TMO], 1u); break; } }
    }
    nloc = mine > 0u ? mine : 1u; nx = cnt > 0u ? cnt : 1u;
}

__device__ __forceinline__ void xcd_barrier(const XcdBarrier& b) {
    asm volatile("s_waitcnt vmcnt(0)" ::: "memory");
    __syncthreads();
    if (threadIdx.x == 0) {
        unsigned* bar = b.bar;
        __builtin_amdgcn_s_waitcnt(0);
        unsigned nloc = b.st[0], nx = b.st[1];
        if (nloc == 0u) { xcd_barrier_complete(bar, b.x, nloc, nx); b.st[0] = nloc; b.st[1] = nx; }
        const unsigned old = xb_add(&bar[XB_XSUB(b.x)], 1u);
        const unsigned gen = old / nloc;
        if (old + 1u == (gen + 1u) * nloc) {
            __builtin_amdgcn_fence(__ATOMIC_RELEASE, "agent");
            asm volatile("s_waitcnt vmcnt(0)" ::: "memory");
            const unsigned og = xb_add(&bar[XB_TOP], 1u);
            const unsigned tg = og / nx;
            if (og + 1u == (tg + 1u) * nx) xb_add(&bar[XB_TOPGEN], 1u);
            else XB_SPIN(xb_ld(&bar[XB_TOPGEN]) == tg, bar);
            __builtin_amdgcn_fence(__ATOMIC_ACQUIRE, "agent");
            xb_add(&bar[XB_XGEN(b.x)], 1u);
            asm volatile("s_waitcnt vmcnt(0)" ::: "memory");
        } else {
            XB_SPIN(xb_ld(&bar[XB_XGEN(b.x)]) == gen, bar);
            __builtin_amdgcn_fence(__ATOMIC_ACQUIRE, "agent");
            asm volatile("s_waitcnt vmcnt(0)" ::: "memory");
        }
    }
    __syncthreads();
}
__device__ __forceinline__ int win_src(int n) {
    if (n < 512) return 1552 + n;
    if (n < 1024) return 2064 + (n - 512);
    if (n < 1536) return 2576 + (n - 1024);
    if (n < 1792) return n - 1536;
    if (n < 2048) return 256 + (n - 1792);
    if (n < 2560) return 512 + (n - 2048);
    if (n < 3072) return 1024 + (n - 2560);
    if (n < 3088) return 1536 + (n - 3072);
    if (n < 3096) return n;
    return -1;
}
__device__ __forceinline__ void tr_item(const float* W, int Nsrc, bf16* WT, int K, const float* gk, int mode, LAS float* scr, int k0, int n0, int lane) {
    const int nl = lane & 31, n = n0 + nl;
    int src = n; float cs = 1.f;
    if (mode == 0) { src = win_src(n); cs = n < 512 ? C2 : ((n >= 1536 && n < 1792) ? 0.125f : 1.f); }
    else if (mode == 2) { const int pn = n >> 8, j = n & 255; src = j < 128 ? pn * 128 + j : DFF + pn * 128 + (j - 128); }
#pragma unroll
    for (int i = 0; i < 32; ++i) {
        const int kk = 2 * i + (lane >> 5);
        float v = 0.f;
        if (src >= 0) v = W[(size_t)(k0 + kk) * Nsrc + src] * cs;
        if (gk) v *= gk[k0 + kk];
        scr[kk * 33 + nl] = v;
    }
    LDS_WAIT(); asm volatile("" ::: "memory");
    const int c = lane & 7;
#pragma unroll
    for (int j = 0; j < 4; ++j) {
        const int nn = (lane >> 3) + 8 * j; const LAS float* s = scr + (8 * c) * 33 + nn;
        u32x4 o; o.x = pk2(s[0 * 33], s[1 * 33]); o.y = pk2(s[2 * 33], s[3 * 33]); o.z = pk2(s[4 * 33], s[5 * 33]); o.w = pk2(s[6 * 33], s[7 * 33]);
        *(u32x4*)(WT + (size_t)(n0 + nn) * K + k0 + 8 * c) = o;
    }
    LDS_WAIT(); asm volatile("" ::: "memory");
}
__device__ __forceinline__ void row_to_bf16(const float* xrow, bf16* orow, float* ssq_slot, float* copy_row, int lane) {
    const f32x4* xr = (const f32x4*)xrow + lane;
    f32x4 v[4]; float s = 0.f;
#pragma unroll
    for (int j = 0; j < 4; ++j) { v[j] = xr[64 * j]; s += (v[j][0] * v[j][0] + v[j][1] * v[j][1]) + (v[j][2] * v[j][2] + v[j][3] * v[j][3]); }
    s = wave_sum(s);
    if (lane == 0) *(f32x4*)ssq_slot = (f32x4){s, 0.f, 0.f, 0.f};
    u32x2* o8 = (u32x2*)orow + lane;
#pragma unroll
    for (int j = 0; j < 4; ++j) { u32x2 w; w.x = pk2(v[j][0], v[j][1]); w.y = pk2(v[j][2], v[j][3]); o8[64 * j] = w; }
    if (copy_row) {
#pragma unroll
        for (int j = 0; j < 4; ++j) ((f32x4*)copy_row + lane)[64 * j] = v[j];
    }
}

template <int NQ> __device__ __forceinline__ void gla_u_group(LAS unsigned char* lds, const bf16* QKV, const float* SM, const float* wau, const float* balpha, float* UT, float* DEC, int grp) {
    int tid_ = threadIdx.x; asm volatile("" : "+v"(tid_)); const int tid = tid_, lane = tid & 63, wid = __builtin_amdgcn_readfirstlane(tid >> 6), hi = lane >> 5, r32 = lane & 31;
    constexpr int SUB = 9216 + 17408 + 2048;
    const int dk = lane, sg = wid;
    int bhq[NQ], ccq[NQ], hq[NQ], row0q[NQ], tvq[NQ];
    float la[NQ][8], kf[NQ][8];
#pragma unroll
    for (int q = 0; q < NQ; ++q) {
        const int u = NQ * grp + q; bhq[q] = u / NCH; ccq[q] = u % NCH; hq[q] = bhq[q] & 3;
        row0q[q] = ccq[q] == 0 ? META0 : (bhq[q] >> 2) * SEQ + (ccq[q] - 1) * 64; tvq[q] = ccq[q] == 0 ? NMETA : 64;
        LAS unsigned char* VT = lds + q * SUB + 9216;
        LAS float* TOT = (LAS float*)(lds + q * SUB + 9216 + 17408);
#pragma unroll
        for (int i = 0; i < 2; ++i) {
            const int idx = tid + 512 * i, row = idx >> 4, ch = idx & 15;
            const u32x4 v = *(const u32x4*)(QKV + (size_t)(row0q[q] + row) * QP + C_GV + hq[q] * 128 + ch * 8);
            *(LAS u32x4*)(VT + row * 272 + ch * 16) = v;
        }
#pragma unroll
        for (int i = 0; i < 8; ++i) kf[q][i] = bf2f(QKV[(size_t)(row0q[q] + 8 * sg + i) * QP + C_GK + hq[q] * 64 + dk]);
        float w[16];
#pragma unroll
        for (int r = 0; r < 16; ++r) w[r] = wau[r * 256 + hq[q] * 64 + dk];
        const float bias = balpha[hq[q] * 64 + dk];
#pragma unroll
        for (int i = 0; i < 8; ++i) {
            const int s = 8 * sg + i;
            const f32x4* g4 = (const f32x4*)(SM + (size_t)(row0q[q] + s) * 32);
            float z = bias;
#pragma unroll
            for (int k = 0; k < 4; ++k) { const f32x4 gv = g4[k]; z += gv[0] * w[4 * k] + gv[1] * w[4 * k + 1] + gv[2] * w[4 * k + 2] + gv[3] * w[4 * k + 3]; }
            la[q][i] = (s < tvq[q]) ? logsigmoidf(z) * (1.0f / 16.0f) : 0.f;
        }
#pragma unroll
        for (int i = 1; i < 8; ++i) la[q][i] += la[q][i - 1];
        TOT[sg * 64 + dk] = la[q][7];
    }
    __syncthreads();
#pragma unroll
    for (int q = 0; q < NQ; ++q) {
        LAS unsigned char* KD = lds + q * SUB;
        const LAS float* TOT = (const LAS float*)(lds + q * SUB + 9216 + 17408);
        float pre = 0.f, tot = 0.f;
#pragma unroll
        for (int g2 = 0; g2 < 8; ++g2) { const float t = TOT[g2 * 64 + dk]; if (g2 < sg) pre += t; tot += t; }
        if (sg == 0) DEC[(size_t)(bhq[q] * NCH + ccq[q]) * 64 + dk] = __expf(tot);
#pragma unroll
        for (int i = 0; i < 8; ++i) {
            const int s = 8 * sg + i;
            const float kd = (s < tvq[q]) ? kf[q][i] * __expf(tot - (pre + la[q][i])) : 0.f;
            *(LAS bf16*)(KD + s * 144 + dk * 2) = f2bf(kd);
        }
    }
    __syncthreads();
    const int dvb = wid >> 1, dkb = wid & 1;
    const int qq = (lane & 15) >> 2, pp = lane & 3, half = (lane >> 4) & 1;
#pragma unroll
    for (int q = 0; q < NQ; ++q) {
        const LAS unsigned char* KD = lds + q * SUB; const LAS unsigned char* VT = lds + q * SUB + 9216;
        f32x16 acc = {};
#pragma unroll
        for (int j = 0; j < 4; ++j) {
            const LAS unsigned char* ap = VT + (16 * j + 4 * hi + qq) * 272 + (32 * dvb + 16 * half + 4 * pp) * 2;
            const LAS unsigned char* bp = KD + (16 * j + 4 * hi + qq) * 144 + (32 * dkb + 16 * half + 4 * pp) * 2;
            const bf16x8 af = cat8(vtr(ap), vtr(ap + 8 * 272));
            const bf16x8 bfr = cat8(vtr(bp), vtr(bp + 8 * 144));
            acc = __builtin_amdgcn_mfma_f32_32x32x16_bf16(af, bfr, acc, 0, 0, 0);
        }
        float* up = UT + ((size_t)(bhq[q] * NCH + ccq[q]) * 128 + 32 * dvb) * 64 + 32 * dkb + r32;
#pragma unroll
        for (int r = 0; r < 16; ++r) up[crow(r, hi) * 64] = acc[r];
    }
    __syncthreads();
}
__device__ __forceinline__ void fox_cumsum_unit(LAS unsigned char* lds, const float* SM, const float* bforget, float* CK, int bh) {
    int tid_ = threadIdx.x; asm volatile("" : "+v"(tid_)); const int tid = tid_, lane = tid & 63, wid = tid >> 6;
    const int b = bh >> 3, h = bh & 7;
    const float bf_ = bforget[h];
    LAS float* WT_ = (LAS float*)lds;
    float mtot = 0.f, mine = 0.f;
    for (int p = 0; p < NMETA; ++p) { mtot += logsigmoidf(SM[(size_t)(META0 + p) * 32 + 16 + h] + bf_); if (tid == p) mine = mtot; }
    if (tid < 64) CK[(size_t)bh * CKP + tid] = tid < NMETA ? -LOG2E * mine : -INFINITY;
    float v[8]; float run = 0.f;
#pragma unroll
    for (int i = 0; i < 8; ++i) { run += logsigmoidf(SM[(size_t)(b * SEQ + 8 * tid + i) * 32 + 16 + h] + bf_); v[i] = run; }
    float inc = run;
#pragma unroll
    for (int o = 1; o < 64; o <<= 1) { const float t = __shfl_up(inc, o); if (lane >= o) inc += t; }
    if (lane == 63) WT_[wid] = inc;
    __syncthreads();
    float off = mtot + (inc - run);
    for (int w2 = 0; w2 < wid; ++w2) off += WT_[w2];
#pragma unroll
    for (int i = 0; i < 8; ++i) CK[(size_t)bh * CKP + 64 + 8 * tid + i] = -LOG2E * (off + v[i]);
    __syncthreads();
}

__device__ __forceinline__ void attn_unit(LAS unsigned char* lds, const bf16* QKV, const float* CK, bf16* OB, const float* fnorm, int b, int h, int qb) {
    int tid_ = threadIdx.x; asm volatile("" : "+v"(tid_)); const int tid = tid_, lane = tid & 63, wid = __builtin_amdgcn_readfirstlane(tid >> 6), r32 = lane & 31, hi = lane >> 5;
    constexpr int KB = 9216, KOFF = 0, VOFF = 2 * KB, COFF = 4 * KB, WOFF = COFF + 512;
    LAS float* wsf = (LAS float*)(lds + WOFF) + wid * 64;
    const size_t rowb = (size_t)b * SEQ; const int q0 = qb * 512;
    const int NT = 1 + 8 * (qb + 1);
    bf16x8 qr[2][4];
#pragma unroll
    for (int g = 0; g < 2; ++g) {
        const bf16* qp = QKV + (rowb + q0 + wid * 64 + g * 32 + r32) * QP + C_FQ + h * 64 + hi * 8;
#pragma unroll
        for (int d0 = 0; d0 < 4; ++d0) qr[g][d0] = *(const bf16x8*)(qp + d0 * 16);
    }
    const int srow = tid >> 3, sch = tid & 7;
    const float* ckp = CK + (size_t)(b * 8 + h) * CKP;
    u32x4 kreg, vreg; float creg = 0.f;
#define ATT_LOAD(t) do { const size_t r0_ = (t) == 0 ? (size_t)META0 : rowb + (size_t)((t) - 1) * 64; const bf16* p_ = QKV + (r0_ + srow) * QP + h * 64 + sch * 8; \
        kreg = *(const u32x4*)(p_ + C_FK); vreg = *(const u32x4*)(p_ + C_FV); if (tid < 64) creg = ckp[(t) * 64 + tid]; } while (0)
#define ATT_STORE(buf) do { *(LAS u32x4*)(lds + KOFF + (buf) * KB + srow * 144 + sch * 16) = kreg; *(LAS u32x4*)(lds + VOFF + (buf) * KB + (sch >> 2) * 4096 + (srow >> 3) * 512 + (srow & 7) * 64 + (sch & 3) * 16) = vreg; \
        if (tid < 64) *(LAS float*)(lds + COFF + (buf) * 256 + tid * 4) = creg; } while (0)
    float m[2] = {-1e30f, -1e30f}, l[2] = {0.f, 0.f}; f32x16 o0[2], o1[2];
    o0[0] = (f32x16){}; o0[1] = (f32x16){}; o1[0] = (f32x16){}; o1[1] = (f32x16){};
    const int qq = (lane & 15) >> 2, pp = lane & 3, half = (lane >> 4) & 1;
    ATT_LOAD(0); ATT_STORE(0);
    for (int t = 0; t < NT; ++t) {
        const int buf = t & 1;
        if (t + 1 < NT) ATT_LOAD(t + 1);
        __syncthreads();
        const int jb = t - (NT - 8);
        const bool skip = (jb >= 0) && (jb > wid);
        if (!skip) {
            const LAS unsigned char* Kb = lds + KOFF + buf * KB; const LAS unsigned char* Vb = lds + VOFF + buf * KB; const LAS float* Cb = (const LAS float*)(lds + COFF + buf * 256);
            f32x16 p0[2], p1[2], c0v, c1v;
#pragma unroll
            for (int g4 = 0; g4 < 4; ++g4) {
                const f32x4 c0 = *(const LAS f32x4*)(Cb + 8 * g4 + 4 * hi), c1 = *(const LAS f32x4*)(Cb + 32 + 8 * g4 + 4 * hi);
#pragma unroll
                for (int i = 0; i < 4; ++i) { c0v[4 * g4 + i] = c0[i]; c1v[4 * g4 + i] = c1[i]; }
            }
#pragma unroll
            for (int d0 = 0; d0 < 4; ++d0) {
                const bf16x8 a0 = *(const LAS bf16x8*)(Kb + r32 * 144 + (16 * d0 + 8 * hi) * 2);
                const bf16x8 a1 = *(const LAS bf16x8*)(Kb + (32 + r32) * 144 + (16 * d0 + 8 * hi) * 2);
                p0[0] = __builtin_amdgcn_mfma_f32_32x32x16_bf16(a0, qr[0][d0], d0 == 0 ? c0v : p0[0], 0, 0, 0);
                p0[1] = __builtin_amdgcn_mfma_f32_32x32x16_bf16(a0, qr[1][d0], d0 == 0 ? c0v : p0[1], 0, 0, 0);
                p1[0] = __builtin_amdgcn_mfma_f32_32x32x16_bf16(a1, qr[0][d0], d0 == 0 ? c1v : p1[0], 0, 0, 0);
                p1[1] = __builtin_amdgcn_mfma_f32_32x32x16_bf16(a1, qr[1][d0], d0 == 0 ? c1v : p1[1], 0, 0, 0);
            }
            bf16x8 pa[2][4];
#pragma unroll
            for (int g = 0; g < 2; ++g) {
                if (jb == wid) {
                    const int qrel = 32 * g + r32;
#pragma unroll
                    for (int r = 0; r < 16; ++r) { const int kv = crow(r, hi); if (kv > qrel) p0[g][r] = -INFINITY; if (kv + 32 > qrel) p1[g][r] = -INFINITY; }
                }
                float mxa = fmaxf(p0[g][0], p1[g][0]), mxb = fmaxf(p0[g][1], p1[g][1]);
#pragma unroll
                for (int r = 2; r < 16; r += 2) { mxa = fmaxf(fmaxf(mxa, p0[g][r]), p1[g][r]); mxb = fmaxf(fmaxf(mxb, p0[g][r + 1]), p1[g][r + 1]); }
                float mx = fmaxf(mxa, mxb);
                mx = fmaxf(mx, __shfl_xor(mx, 32));
                if (__any(mx > m[g] + 64.0f)) {
                    const float mn = fmaxf(m[g], mx);
                    const float alpha = __builtin_amdgcn_exp2f(m[g] - mn);
                    m[g] = mn; l[g] *= alpha;
                    if (hi == 0) wsf[g * 32 + r32] = alpha;
                    LDS_WAIT();
#pragma unroll
                    for (int g4 = 0; g4 < 4; ++g4) {
                        const f32x4 a = *(const LAS f32x4*)(wsf + g * 32 + 8 * g4 + 4 * hi);
#pragma unroll
                        for (int i = 0; i < 4; ++i) { o0[g][4 * g4 + i] *= a[i]; o1[g][4 * g4 + i] *= a[i]; }
                    }
                }
                float rsa = 0.f, rsb = 0.f, rsc = 0.f, rsd = 0.f;
#pragma unroll
                for (int r = 0; r < 16; r += 2) {
                    p0[g][r] = __builtin_amdgcn_exp2f(p0[g][r] - m[g]); p1[g][r] = __builtin_amdgcn_exp2f(p1[g][r] - m[g]);
                    p0[g][r + 1] = __builtin_amdgcn_exp2f(p0[g][r + 1] - m[g]); p1[g][r + 1] = __builtin_amdgcn_exp2f(p1[g][r + 1] - m[g]);
                    rsa += p0[g][r]; rsb += p1[g][r]; rsc += p0[g][r + 1]; rsd += p1[g][r + 1];
                }
                l[g] += (rsa + rsb) + (rsc + rsd);
                { u32x4 w;
                  w.x = pk2(p0[g][0], p0[g][1]); w.y = pk2(p0[g][2], p0[g][3]); w.z = pk2(p0[g][4], p0[g][5]); w.w = pk2(p0[g][6], p0[g][7]); pa[g][0] = __builtin_bit_cast(bf16x8, w);
                  w.x = pk2(p0[g][8], p0[g][9]); w.y = pk2(p0[g][10], p0[g][11]); w.z = pk2(p0[g][12], p0[g][13]); w.w = pk2(p0[g][14], p0[g][15]); pa[g][1] = __builtin_bit_cast(bf16x8, w);
                  w.x = pk2(p1[g][0], p1[g][1]); w.y = pk2(p1[g][2], p1[g][3]); w.z = pk2(p1[g][4], p1[g][5]); w.w = pk2(p1[g][6], p1[g][7]); pa[g][2] = __builtin_bit_cast(bf16x8, w);
                  w.x = pk2(p1[g][8], p1[g][9]); w.y = pk2(p1[g][10], p1[g][11]); w.z = pk2(p1[g][12], p1[g][13]); w.w = pk2(p1[g][14], p1[g][15]); pa[g][3] = __builtin_bit_cast(bf16x8, w); }
            }
#pragma unroll
            for (int j = 0; j < 4; ++j) {
                const LAS unsigned char* vp = Vb + (2 * j) * 512 + (4 * hi + qq) * 64 + 32 * half + 8 * pp;
                const bf16x8 v0 = cat8(vtr(vp), vtr(vp + 512));
                const bf16x8 v1 = cat8(vtr(vp + 4096), vtr(vp + 4096 + 512));
                o0[0] = __builtin_amdgcn_mfma_f32_32x32x16_bf16(pa[0][j], v0, o0[0], 0, 0, 0);
                o0[1] = __builtin_amdgcn_mfma_f32_32x32x16_bf16(pa[1][j], v0, o0[1], 0, 0, 0);
                o1[0] = __builtin_amdgcn_mfma_f32_32x32x16_bf16(pa[0][j], v1, o1[0], 0, 0, 0);
                o1[1] = __builtin_amdgcn_mfma_f32_32x32x16_bf16(pa[1][j], v1, o1[1], 0, 0, 0);
            }
        }
        if (t + 1 < NT) ATT_STORE(buf ^ 1);
    }
#undef ATT_LOAD
#undef ATT_STORE
    const float w0 = fnorm[h * 64 + r32], w1 = fnorm[h * 64 + 32 + r32];
#pragma unroll
    for (int g = 0; g < 2; ++g) {
        float lt = l[g]; lt += __shfl_xor(lt, 32);
        if (hi == 0) wsf[g * 32 + r32] = 1.0f / lt;
        LDS_WAIT();
#pragma unroll
        for (int g4 = 0; g4 < 4; ++g4) {
            const f32x4 a = *(const LAS f32x4*)(wsf + g * 32 + 8 * g4 + 4 * hi);
#pragma unroll
            for (int i = 0; i < 4; ++i) { o0[g][4 * g4 + i] *= a[i]; o1[g][4 * g4 + i] *= a[i]; }
        }
#pragma unroll
        for (int r = 0; r < 16; ++r) {
            float s = o0[g][r] * o0[g][r] + o1[g][r] * o1[g][r];
            s += __shfl_xor(s, 1); s += __shfl_xor(s, 2); s += __shfl_xor(s, 4); s += __shfl_xor(s, 8); s += __shfl_xor(s, 16);
            const float rs = rsqrtf(s * (1.0f / 64.0f) + EPS);
            bf16* op = OB + (rowb + q0 + wid * 64 + g * 32 + crow(r, hi)) * DM + 512 + h * 64 + r32;
            op[0] = f2bf(o0[g][r] * rs * w0); op[32] = f2bf(o1[g][r] * rs * w1);
        }
    }
    __syncthreads();
}
__device__ __forceinline__ void meta_attn(const bf16* QKV, const float* CK, bf16* OB, const float* fnorm, int p) {
    int tid_ = threadIdx.x; asm volatile("" : "+v"(tid_)); const int lane = tid_ & 63, h = tid_ >> 6;
    const float q = bf2f(QKV[(size_t)(META0 + p) * QP + C_FQ + h * 64 + lane]);
    float sc[NMETA], vv[NMETA];
#pragma unroll
    for (int s = 0; s < NMETA; ++s) {
        sc[s] = q * bf2f(QKV[(size_t)(META0 + s) * QP + C_FK + h * 64 + lane]);
        vv[s] = bf2f(QKV[(size_t)(META0 + s) * QP + C_FV + h * 64 + lane]);
    }
    float m = -1e30f;
#pragma unroll
    for (int s = 0; s < NMETA; ++s) { sc[s] = (s <= p) ? wave_sum(sc[s]) + CK[(size_t)h * CKP + s] : -INFINITY; m = fmaxf(m, sc[s]); }
    float l = 0.f, o = 0.f;
#pragma unroll
    for (int s = 0; s < NMETA; ++s) { const float pw = __builtin_amdgcn_exp2f(sc[s] - m); l += pw; o += pw * vv[s]; }
    o /= l;
    const float ss = wave_sum(o * o);
    OB[(size_t)(META0 + p) * DM + 512 + h * 64 + lane] = f2bf(o * rsqrtf(ss * (1.0f / 64.0f) + EPS) * fnorm[h * 64 + lane]);
}
template <int NU> __device__ __forceinline__ void gla_readout_wave(const bf16* QKV, const float* UT, bf16* OB, const float* gnorm, const int* bhs, const int* ccs, const int* halfs, int lane) {
    asm volatile("" : "+v"(lane));
    const int r32 = lane & 31, hi = lane >> 5;
    int row0[NU], nvalid[NU], hq[NU]; const float* Sp[NU];
    f32x16 acc[NU][4];
#pragma unroll
    for (int u = 0; u < NU; ++u) {
        const int b = bhs[u] >> 2; hq[u] = bhs[u] & 3;
        row0[u] = ccs[u] == 0 ? META0 : b * SEQ + (ccs[u] - 1) * 64 + 32 * halfs[u]; nvalid[u] = ccs[u] == 0 ? NMETA : 32;
        Sp[u] = UT + (size_t)(bhs[u] * NCH + ccs[u]) * 8192;
#pragma unroll
        for (int blk = 0; blk < 4; ++blk) acc[u][blk] = (f32x16){};
    }
#pragma unroll
    for (int j = 0; j < 4; ++j)
#pragma unroll
        for (int u = 0; u < NU; ++u) {
            const bf16x8 bq = *(const bf16x8*)(QKV + (size_t)(row0[u] + r32) * QP + C_GQ + hq[u] * 64 + 16 * j + 8 * hi);
#pragma unroll
            for (int blk = 0; blk < 4; ++blk) {
                const float* sp = Sp[u] + (32 * blk + r32) * 64 + 16 * j + 8 * hi;
                const f32x4 s0 = *(const f32x4*)sp, s1 = *(const f32x4*)(sp + 4);
                u32x4 w; w.x = pk2(s0[0], s0[1]); w.y = pk2(s0[2], s0[3]); w.z = pk2(s1[0], s1[1]); w.w = pk2(s1[2], s1[3]);
                acc[u][blk] = __builtin_amdgcn_mfma_f32_32x32x16_bf16(__builtin_bit_cast(bf16x8, w), bq, acc[u][blk], 0, 0, 0);
            }
        }
#pragma unroll
    for (int u = 0; u < NU; ++u) {
        float ss = 0.f;
#pragma unroll
        for (int blk = 0; blk < 4; ++blk)
#pragma unroll
            for (int r = 0; r < 16; ++r) ss += acc[u][blk][r] * acc[u][blk][r];
        ss += __shfl_xor(ss, 32);
        const float rs = rsqrtf(ss * (1.0f / 128.0f) + EPS);
        if (r32 < nvalid[u]) {
            const size_t row = (size_t)row0[u] + r32; const int h = hq[u];
#pragma unroll
            for (int blk = 0; blk < 4; ++blk)
#pragma unroll
                for (int g = 0; g < 4; ++g) {
                    const int dv = 32 * blk + 8 * g + 4 * hi;
                    const u32x2 gt = *(const u32x2*)(QKV + row * QP + C_GR + h * 128 + dv);
                    const f32x4 wn = *(const f32x4*)(gnorm + h * 128 + dv);
                    const float g0 = __uint_as_float(gt.x << 16), g1 = __uint_as_float(gt.x & 0xffff0000u), g2 = __uint_as_float(gt.y << 16), g3 = __uint_as_float(gt.y & 0xffff0000u);
                    u32x2 w;
                    w.x = pk2(acc[u][blk][4 * g] * rs * wn[0] * siluf(g0), acc[u][blk][4 * g + 1] * rs * wn[1] * siluf(g1));
                    w.y = pk2(acc[u][blk][4 * g + 2] * rs * wn[2] * siluf(g2), acc[u][blk][4 * g + 3] * rs * wn[3] * siluf(g3));
                    *(u32x2*)(OB + row * DM + h * 128 + dv) = w;
                }
        }
    }
}

__device__ __forceinline__ void gla_readout_chunk(const bf16* QKV, const float* UT, bf16* OB, const float* gnorm, int bh, int cc, int lane) {
    asm volatile("" : "+v"(lane));
    const int r32 = lane & 31, hi = lane >> 5, b = bh >> 2, h = bh & 3;
    const int row0 = b * SEQ + (cc - 1) * 64;
    const float* Sp = UT + (size_t)(bh * NCH + cc) * 8192;
    f32x16 acc[2][4];
#pragma unroll
    for (int u = 0; u < 2; ++u)
#pragma unroll
        for (int blk = 0; blk < 4; ++blk) acc[u][blk] = (f32x16){};
#pragma unroll 1
    for (int j = 0; j < 4; ++j) {
        const bf16x8 bq0 = *(const bf16x8*)(QKV + (size_t)(row0 + r32) * QP + C_GQ + h * 64 + 16 * j + 8 * hi);
        const bf16x8 bq1 = *(const bf16x8*)(QKV + (size_t)(row0 + 32 + r32) * QP + C_GQ + h * 64 + 16 * j + 8 * hi);
#pragma unroll
        for (int blk = 0; blk < 4; ++blk) {
            const float* sp = Sp + (32 * blk + r32) * 64 + 16 * j + 8 * hi;
            const f32x4 s0 = *(const f32x4*)sp, s1 = *(const f32x4*)(sp + 4);
            u32x4 w; w.x = pk2(s0[0], s0[1]); w.y = pk2(s0[2], s0[3]); w.z = pk2(s1[0], s1[1]); w.w = pk2(s1[2], s1[3]);
            const bf16x8 sa = __builtin_bit_cast(bf16x8, w);
            acc[0][blk] = __builtin_amdgcn_mfma_f32_32x32x16_bf16(sa, bq0, acc[0][blk], 0, 0, 0);
            acc[1][blk] = __builtin_amdgcn_mfma_f32_32x32x16_bf16(sa, bq1, acc[1][blk], 0, 0, 0);
        }
    }
#pragma unroll
    for (int u = 0; u < 2; ++u) {
        float ss = 0.f;
#pragma unroll
        for (int blk = 0; blk < 4; ++blk)
#pragma unroll
            for (int r = 0; r < 16; ++r) ss += acc[u][blk][r] * acc[u][blk][r];
        ss += __shfl_xor(ss, 32);
        const float rs = rsqrtf(ss * (1.0f / 128.0f) + EPS);
        const size_t row = (size_t)row0 + 32 * u + r32;
#pragma unroll
        for (int blk = 0; blk < 4; ++blk)
#pragma unroll
            for (int g = 0; g < 4; ++g) {
                const int dv = 32 * blk + 8 * g + 4 * hi;
                const u32x2 gt = *(const u32x2*)(QKV + row * QP + C_GR + h * 128 + dv);
                const f32x4 wn = *(const f32x4*)(gnorm + h * 128 + dv);
                const float g0 = __uint_as_float(gt.x << 16), g1 = __uint_as_float(gt.x & 0xffff0000u), g2 = __uint_as_float(gt.y << 16), g3 = __uint_as_float(gt.y & 0xffff0000u);
                u32x2 w;
                w.x = pk2(acc[u][blk][4 * g] * rs * wn[0] * siluf(g0), acc[u][blk][4 * g + 1] * rs * wn[1] * siluf(g1));
                w.y = pk2(acc[u][blk][4 * g + 2] * rs * wn[2] * siluf(g2), acc[u][blk][4 * g + 3] * rs * wn[3] * siluf(g3));
                *(u32x2*)(OB + row * DM + h * 128 + dv) = w;
            }
    }
}

#define FRESH() KArgs ka_ = kargs(); Args a; a.x = gptr(ka_->x); a.meta = gptr(ka_->meta); a.attn_norm = gptr(ka_->attn_norm); a.w_in = gptr(ka_->w_in); a.w_au = gptr(ka_->w_au); a.b_alpha = gptr(ka_->b_alpha); a.b_forget = gptr(ka_->b_forget); a.gla_norm = gptr(ka_->gla_norm); a.fox_norm = gptr(ka_->fox_norm); a.w_out = gptr(ka_->w_out); a.ffn_norm = gptr(ka_->ffn_norm); a.w_up = gptr(ka_->w_up); a.conv_w = gptr(ka_->conv_w); a.conv_b = gptr(ka_->conv_b); a.w_down = gptr(ka_->w_down); a.final_norm = gptr(ka_->final_norm); a.out = gptr(ka_->out); a.ws = gptr(ka_->ws); unsigned char* ws = a.ws; \
    bf16* HB = (bf16*)(ws + WS_HB); bf16* OB = (bf16*)(ws + WS_OB); bf16* QKV = (bf16*)(ws + WS_QKV); bf16* A2 = (bf16*)(ws + WS_QKV); \
    float* UT = (float*)(ws + WS_UT); float* HF = (float*)(ws + WS_UT); float* HL = (float*)(ws + WS_UT + HFL_SIZE); \
    float* SM = (float*)(ws + WS_SM); float* CK = (float*)(ws + WS_CK); float* DEC = (float*)(ws + WS_DEC); float* HM = (float*)(ws + WS_HM); float* SSQ = (float*)(ws + WS_SSQ); \
    unsigned char* wl = ws + WS_W + (size_t)L * WL_SIZE; \
    (void)HB; (void)OB; (void)QKV; (void)A2; (void)UT; (void)HF; (void)HL; (void)SM; (void)CK; (void)DEC; (void)HM; (void)SSQ; (void)wl; \
    int G_ = gridDim.x, bx_ = blockIdx.x; asm volatile("" : "+s"(G_), "+s"(bx_)); const int G = G_, bx = bx_; (void)G; (void)bx; \
    int tid_ = threadIdx.x; asm volatile("" : "+v"(tid_)); const int tid = tid_, lane = tid & 63, wid = __builtin_amdgcn_readfirstlane(tid >> 6); \
    const int gw = bx * 8 + wid, NGW = G * 8, gt = bx * 512 + tid, NGT = G * 512; (void)lane; (void)gw; (void)NGW; (void)gt; (void)NGT;
#ifndef REP_A
#define REP_A 1
#endif
#ifndef REP_CA
#define REP_CA 1
#endif
#ifndef REP_F
#define REP_F 1
#endif
#ifndef REP_B
#define REP_B 1
#endif
#ifndef REP_D
#define REP_D 1
#endif
#define GSYNC_CG() do { asm volatile("s_waitcnt vmcnt(0) lgkmcnt(0)" ::: "memory"); grid.sync(); __builtin_amdgcn_fence(__ATOMIC_ACQUIRE, "agent"); asm volatile("s_waitcnt vmcnt(0)" ::: "memory"); } while (0)
#ifdef PROBE_PH
#define PH_END(id) do { const unsigned long long tn_ = __builtin_amdgcn_s_memrealtime(); if ((PROBE_PH >> (id)) & 1) tsync += tn_ - tlast; tlast = tn_; } while (0)
#else
#define PH_END(id) do {} while (0)
#endif
#ifdef PROBE_SYNC
#define GSYNC() do { const unsigned long long t0_ = __builtin_amdgcn_s_memrealtime(); xcd_barrier(xbar); tsync += __builtin_amdgcn_s_memrealtime() - t0_; } while (0)
#else
#define GSYNC() do { XcdBarrier xb_; xb_.bar = (unsigned*)(gptr(kargs()->ws) + WS_BAR); xb_.x = xb_xcc_id(); xb_.st = (volatile LAS unsigned*)(lds + HALO_OFF + 8192 + 1024); xcd_barrier(xb_); } while (0)
#endif
__global__ void __launch_bounds__(512, 2) fwd_kernel(Args a_unused) {
    extern __shared__ __attribute__((aligned(16))) unsigned char lds_raw[];
    LAS unsigned char* lds = (LAS unsigned char*)lds_raw;
    cg::grid_group grid = cg::this_grid();
#if defined(PROBE_SYNC) || defined(PROBE_PH)
    unsigned long long tsync = 0ull, tlast = __builtin_amdgcn_s_memrealtime(); (void)tlast;
#endif
    volatile LAS unsigned* xst = (volatile LAS unsigned*)(lds + HALO_OFF + 8192 + 1024);
    if (threadIdx.x < 2) xst[threadIdx.x] = 0u;
    __syncthreads();
    (void)xcd_barrier_post((unsigned*)(gptr(kargs()->ws) + WS_BAR), xst);
#ifndef REP_P
#define REP_P 1
#endif
    for (int rep = 0; rep < REP_P; ++rep) {
        const int L = 0; FRESH();
        LAS float* scr = (LAS float*)(lds + wid * 16384);
        constexpr int I_IN = 16 * (NINP / 32), I_OUT = 16 * 32, I_UP = 16 * (NUP / 32), I_DN = (DFF / 64) * 32, I_L = I_IN + I_OUT + I_UP + I_DN;
        for (int it = gw; it < DEPTH * I_L; it += NGW) {
            const int L = it / I_L; int r = it % I_L;
            unsigned char* wl = ws + WS_W + (size_t)L * WL_SIZE;
            if (r < I_IN) { const int nb = NINP / 32; tr_item(a.w_in + (size_t)L * DM * 3096, 3096, (bf16*)(wl + WL_IN), DM, a.attn_norm + L * DM, 0, scr, 64 * (r / nb), 32 * (r % nb), lane); continue; } r -= I_IN;
            if (r < I_OUT) { tr_item(a.w_out + (size_t)L * DM * DM, DM, (bf16*)(wl + WL_OUT), DM, nullptr, 1, scr, 64 * (r / 32), 32 * (r % 32), lane); continue; } r -= I_OUT;
            if (r < I_UP) { const int nb = NUP / 32; tr_item(a.w_up + (size_t)L * DM * NUP, NUP, (bf16*)(wl + WL_UP), DM, a.ffn_norm + L * DM, 2, scr, 64 * (r / nb), 32 * (r % nb), lane); continue; } r -= I_UP;
            tr_item(a.w_down + (size_t)L * DFF * DM, DM, (bf16*)(wl + WL_DN), DFF, nullptr, 3, scr, 64 * (r / 32), 32 * (r % 32), lane);
        }
        for (int i = gt; i < (256 - NMETA) * 4; i += NGT) SSQ[(size_t)(META0 + NMETA) * 4 + i] = 0.f;
        for (int r = gw; r < MREAL + 256; r += NGW) {
            if (r < MREAL) row_to_bf16(a.x + (size_t)r * DM, HB + (size_t)r * DM, SSQ + (size_t)r * 4, nullptr, lane);
            else if (r < MREAL + NMETA) row_to_bf16(a.meta + (size_t)(r - MREAL) * DM, HB + (size_t)r * DM, SSQ + (size_t)r * 4, HM + (size_t)(r - MREAL) * DM, lane);
            else {
#pragma unroll
                for (int j = 0; j < 4; ++j) { ((f32x4*)(HM + (size_t)(r - MREAL) * DM) + lane)[64 * j] = (f32x4){0.f, 0.f, 0.f, 0.f};
                    ((u32x2*)(HB + (size_t)r * DM) + lane)[64 * j] = (u32x2){0u, 0u}; ((u32x2*)(OB + (size_t)r * DM) + lane)[64 * j] = (u32x2){0u, 0u}; }
            }
        }
    }
    GSYNC_CG(); PH_END(0);

    for (int L = 0; L < DEPTH; ++L) {
#ifndef SKIP_A
        {
            FRESH();
            pg8::Gemm g{HB, (const bf16*)(wl + WL_IN), MROWS, NINP, DM}; pg8::StaticOrder S; S.init(MROWS, NINP, G, bx);
            EpiIn E{2 * L};
            for (int rep = 0; rep < REP_A; ++rep) pg8::gemm_phase<EpiIn, pg8::StaticOrder, true, true>(lds, g, S, E);
        }
#endif
        GSYNC(); PH_END(1);
#ifndef SKIP_B
        { FRESH();
        for (int rep = 0; rep < REP_B; ++rep) {
        for (int gr = bx; gr < 16 * NCH; gr += G) gla_u_group<2>(lds, QKV, SM, a.w_au + (size_t)L * 16 * 256, a.b_alpha + L * 256, UT, DEC, gr);
        for (int u = (G == 256) ? bx - 64 + ((bx < 64) ? 256 : 0) : bx; u < 64; u += G) fox_cumsum_unit(lds, SM, a.b_forget + L * 8, CK, u);
        }
        }
#endif
        GSYNC(); PH_END(2);
#ifndef SKIP_CS
        { FRESH();
        for (int e = gt; e < 32 * 2048; e += NGT) {
            const int bh = e >> 11, rem = (e & 2047) * 4, dk = rem & 63;
            float* up = UT + (size_t)bh * NCH * 8192 + rem; const float* dp = DEC + (size_t)bh * NCH * 64 + dk;
            f32x4 Sv = *(const f32x4*)up;
            for (int c0 = 1; c0 <= 64; c0 += 8) {
                f32x4 uu[8], dd[8];
#pragma unroll
                for (int i = 0; i < 8; ++i) { uu[i] = *(const f32x4*)(up + (size_t)(c0 + i) * 8192); dd[i] = *(const f32x4*)(dp + (c0 + i) * 64); }
#pragma unroll
                for (int i = 0; i < 8; ++i) { Sv = dd[i] * Sv + uu[i]; *(f32x4*)(up + (size_t)(c0 + i) * 8192) = Sv; }
            }
        }
#ifdef REP_SCAN
        for (int e = gt; e < 32 * 2048; e += NGT) {
            const int bh = e >> 11, rem = (e & 2047) * 4, dk = rem & 63;
            float* up = UT + (size_t)bh * NCH * 8192 + rem; const float* dp = DEC + (size_t)bh * NCH * 64 + dk;
            for (int c0 = 1; c0 <= 64; c0 += 8) {
                f32x4 uu[8], dd[8];
#pragma unroll
                for (int i = 0; i < 8; ++i) { uu[i] = *(const f32x4*)(up + (size_t)(c0 + i) * 8192); dd[i] = *(const f32x4*)(dp + (c0 + i) * 64); }
#pragma unroll
                for (int i = 0; i < 8; ++i) { *(f32x4*)(up + (size_t)(c0 + i) * 8192) = uu[i] + dd[i] * 0.f; }
            }
        }
#endif
        }
        { FRESH();
        for (int rep = 0; rep < REP_CA; ++rep)
        for (int v0 = bx; v0 < 256; v0 += G) {
            const int v = (G == 256) ? (v0 & 7) * 32 + (v0 >> 3) : v0;
            const int bhh = v >> 2, s = v & 3;
#pragma unroll 1
            for (int i = 0; i < 2; ++i) {
                const int qb = (i == 0) ? s : 7 - s;
                attn_unit(lds, QKV, CK, OB, a.fox_norm + L * 512, bhh >> 3, bhh & 7, qb);
            }
        }
#endif
#ifndef SKIP_CM
        }
        { FRESH();
#ifndef REP_CM
#define REP_CM 1
#endif
        for (int rep = 0; rep < REP_CM; ++rep)
        if (bx < NMETA) meta_attn(QKV, CK, OB, a.fox_norm + L * 512, bx);
        if (bx >= NMETA && bx < NMETA + 4 && wid == 0) { const int bhs[1] = {bx - NMETA}, ccs[1] = {0}, hfs[1] = {0}; gla_readout_wave<1>(QKV, UT, OB, a.gla_norm + L * 512, bhs, ccs, hfs, lane); }
        }
#endif
        GSYNC(); PH_END(3);
#ifndef SKIP_D
        { FRESH();
        for (int rep = 0; rep < REP_D; ++rep)
        for (int wu = gw; wu < 32 * 64; wu += NGW) gla_readout_chunk(QKV, UT, OB, a.gla_norm + L * 512, wu >> 6, 1 + (wu & 63), lane);
        }
#endif
        GSYNC(); PH_END(4);
#ifndef SKIP_E
        {
            FRESH();
            meta_rowgemm(OB + (size_t)META0 * DM, DM, (const bf16*)(wl + WL_OUT), DM, HM, HB, G, bx);
            pg8::Gemm g{OB, (const bf16*)(wl + WL_OUT), MREAL, DM, DM}; pg8::StaticOrder S; S.init(MREAL, DM, G, bx);
            if (L == 0) { EpiRes<true, false> E{2 * L + 1}; pg8::gemm_phase<EpiRes<true, false>, pg8::StaticOrder, true, true>(lds, g, S, E); }
            else { EpiRes<false, false> E{2 * L + 1}; pg8::gemm_phase<EpiRes<false, false>, pg8::StaticOrder, true, true>(lds, g, S, E); }
        }
#endif
        GSYNC(); PH_END(5);
#ifndef SKIP_F
        {
            FRESH();
            meta_up(lds, HB, (const bf16*)(wl + WL_UP), HM, a.conv_w + (size_t)L * 3 * NUP, a.conv_b + (size_t)L * NUP, A2, HL, G, bx);
            pg8::Gemm g{HB, (const bf16*)(wl + WL_UP), MREAL, NUP, DM}; pg8::StaticOrder S; S.init(MREAL, NUP, G, bx);
            EpiUp E{L};
            for (int rep = 0; rep < REP_F; ++rep) pg8::gemm_phase<EpiUp, pg8::StaticOrder, true, true>(lds, g, S, E);
        }
#endif
        GSYNC(); PH_END(6);
#ifndef SKIP_H
        {
            FRESH();
            const float* cw = a.conv_w + (size_t)L * 3 * NUP; const float* cb = a.conv_b + (size_t)L * NUP;
            { int pm = 0;
              for (int ui = 0; so_next_pm(MREAL / 256, DM / 256, G, bx, ui, pm); ++ui) {
                for (int i = tid; i < 2 * (DFF / 4); i += 512) {
                    const int c4 = i % (DFF / 4), rr = i / (DFF / 4);
                    const int ch = 4 * c4;
                    f32x4 hc[2];
#pragma unroll
                    for (int bj = 0; bj < 2; ++bj) {
                        const int c = bj * DFF + ch;
                        f32x4 P0 = {0.f, 0.f, 0.f, 0.f}, P1 = P0;
                        if (pm != 128) { const int src = (pm % 16 == 0) ? 128 : pm - 1; P0 = *(const f32x4*)(HL + (size_t)(src * 2) * NUP + c); P1 = *(const f32x4*)(HL + (size_t)(src * 2 + 1) * NUP + c); }
                        const f32x4 H0 = *(const f32x4*)(HF + (size_t)(pm * 2) * NUP + c), H1 = *(const f32x4*)(HF + (size_t)(pm * 2 + 1) * NUP + c);
                        const f32x4 x2 = rr == 0 ? P0 : P1, x1 = rr == 0 ? P1 : H0, x0 = rr == 0 ? H0 : H1;
                        hc[bj] = *(const f32x4*)(cb + c) + *(const f32x4*)(cw + c) * x2 + *(const f32x4*)(cw + NUP + c) * x1 + *(const f32x4*)(cw + 2 * NUP + c) * x0;
                    }
                    u32x2 w;
                    w.x = pk2(siluf(hc[1][0]) * hc[0][0], siluf(hc[1][1]) * hc[0][1]);
                    w.y = pk2(siluf(hc[1][2]) * hc[0][2], siluf(hc[1][3]) * hc[0][3]);
                    *(u32x2*)(A2 + (size_t)(pm * 256 + rr) * DFF + ch) = w;
                }
              }
            }
            asm volatile("s_waitcnt vmcnt(0)" ::: "memory"); __syncthreads();
            meta_rowgemm(A2 + (size_t)META0 * DFF, DFF, (const bf16*)(wl + WL_DN), DFF, HM, HB, G, bx);
            pg8::Gemm g{A2, (const bf16*)(wl + WL_DN), MREAL, DM, DFF}; pg8::StaticOrder S; S.init(MREAL, DM, G, bx);
            if (L == DEPTH - 1) { EpiRes<false, true> E{2 * L + 2}; pg8::gemm_phase<EpiRes<false, true>, pg8::StaticOrder, true, true>(lds, g, S, E); }
            else { EpiRes<false, false> E{2 * L + 2}; pg8::gemm_phase<EpiRes<false, false>, pg8::StaticOrder, true, true>(lds, g, S, E); }
        }
#endif
        GSYNC(); PH_END(7);
    }
    {
        const int L = 0; FRESH();
        const float* ssq = ssq_arr(ws, 8);
        for (int r = gw; r < MREAL; r += NGW) {
            const float rs = row_rstd(ssq, r);
            f32x4* p = (f32x4*)(a.out + (size_t)r * DM) + lane; const f32x4* wn = (const f32x4*)a.final_norm + lane;
#pragma unroll
            for (int j = 0; j < 4; ++j) p[64 * j] = p[64 * j] * rs * wn[64 * j];
        }
#if defined(PROBE_SYNC) || defined(PROBE_PH)
        asm volatile("s_waitcnt vmcnt(0)" ::: "memory"); __syncthreads();
        if (bx == PROBE_BLOCK && tid == 0) a.out[(size_t)PROBE_BLOCK * 16 * DM * 0 + 5] += floorf((float)tsync * 0.0002f + 0.5f);
#endif
    }
}

extern "C" void kernel_launch(void* const* d_in, const int* in_sizes, int n_in, void* d_out, int out_size, void* d_ws, size_t ws_size, hipStream_t stream) {
    static int grid = 0;
    if (grid == 0) {
        if (n_in != 16 || out_size != MREAL * DM || ws_size < WS_END) { fprintf(stderr, "kernel_launch: unexpected problem (n_in %d out %d ws %zu, need %zu)\n", n_in, out_size, ws_size, (size_t)WS_END); grid = -1; return; }
        int dev = 0, cus = 0, per = 0;
        (void)hipGetDevice(&dev); (void)hipDeviceGetAttribute(&cus, hipDeviceAttributeMultiprocessorCount, dev);
        (void)hipFuncSetAttribute((const void*)fwd_kernel, hipFuncAttributeMaxDynamicSharedMemorySize, LDS_BYTES);
        (void)hipOccupancyMaxActiveBlocksPerMultiprocessor(&per, (const void*)fwd_kernel, 512, LDS_BYTES);
        if (per < 1) per = 1;
        grid = cus * per;
        fprintf(stderr, "kernel_launch: grid %d (cus %d x %d), ws %zu\n", grid, cus, per, ws_size);
    }
    if (grid < 0) return;
    Args a{};
    const float** f = (const float**)&a;
    for (int i = 0; i < 16; ++i) f[i] = (const float*)d_in[i];
    a.out = (float*)d_out; a.ws = (unsigned char*)d_ws;
    (void)hipMemsetAsync((unsigned char*)d_ws + WS_BAR, 0, BAR_BYTES, stream);
    void* args[] = {&a};
    hipError_t e = hipLaunchCooperativeKernel((const void*)fwd_kernel, dim3(grid), dim3(512), args, LDS_BYTES, stream);
    if (e != hipSuccess) fprintf(stderr, "cooperative launch failed: %s (grid %d)\n", hipGetErrorString(e), grid);
}
```
